# Optimizing an MI355X kernel written in HIP

```python
import math
import jax, jax.numpy as jnp
from jax import lax
import numpy as np

D_MODEL = 1024
BATCH = 16
SEQ = 2048
DEPTH = 2

GRID_W = 64
CTX_LEN = 256
N_MIXERS = 2
N_MOD = 6
NORM_EPS = 1e-6
MLA_HEADS = 8
Q_LORA = 384
KV_LORA = 256
NOPE_DIM = 128
ROPE_DIM = 64
V_DIM = 128
ROPE_BASE = 10000.0
Q_BLOCK = 128
S5_GROUP = 16
S5_GROUPS = D_MODEL // S5_GROUP
S5_STATE = 64
S5_DT_MIN = 1e-3
S5_DT_MAX = 1e-1
N_EXPERTS = 64
TOP_K = 8
N_EXPERT_GROUPS = 8
TOPK_GROUPS = 4
D_EXPERT = 256
D_SHARED = 256
ROUTED_SCALE = 2.5
MOE_BLOCK = 128

kernel_name = "hybrid_mla_s5_moe_diffusion_trunk"


def rms_norm(x, g):
    xf = x.astype(jnp.float32)
    y = xf * lax.rsqrt(jnp.mean(xf * xf, axis=-1, keepdims=True) + NORM_EPS)
    return (y * g.astype(jnp.float32)).astype(x.dtype)


def modulate(h, shift, scale):
    return h * (1 + scale) + shift


def axial_rope_tables(n_tokens):
    rows = n_tokens // GRID_W
    row = jnp.repeat(jnp.arange(rows), GRID_W).astype(jnp.float32)
    col = jnp.tile(jnp.arange(GRID_W), rows).astype(jnp.float32)
    n_freq = ROPE_DIM // 4
    inv_freq = ROPE_BASE ** (-jnp.arange(n_freq, dtype=jnp.float32) / n_freq)
    ang = jnp.concatenate([row[:, None] * inv_freq, col[:, None] * inv_freq], axis=-1)
    return jnp.cos(ang), jnp.sin(ang)


def apply_rope(x, cos, sin):
    xf = x.astype(jnp.float32).reshape(*x.shape[:-1], ROPE_DIM // 2, 2)
    x0, x1 = xf[..., 0], xf[..., 1]
    out = jnp.stack([x0 * cos - x1 * sin, x0 * sin + x1 * cos], axis=-1)
    return out.reshape(x.shape).astype(x.dtype)


def mla_attend(q_nope, q_pe, k_nope, k_pe, v):
    scale = (NOPE_DIM + ROPE_DIM) ** -0.5
    s = (jnp.einsum('bqhd,bkhd->bhqk', q_nope, k_nope, preferred_element_type=jnp.float32)
         + jnp.einsum('bqhr,bkr->bhqk', q_pe, k_pe, preferred_element_type=jnp.float32)) * scale
    p = jax.nn.softmax(s, axis=-1).astype(v.dtype)
    return jnp.einsum('bhqk,bkhv->bqhv', p, v)


def blocked_attend(q_nope, q_pe, k_nope, k_pe, v):
    B, L, H, _ = q_nope.shape
    nb = L // Q_BLOCK

    def to_blocks(t):
        return jnp.moveaxis(t.reshape(B, nb, Q_BLOCK, *t.shape[2:]), 1, 0)

    out = lax.map(lambda qs: mla_attend(qs[0], qs[1], k_nope, k_pe, v),
                  (to_blocks(q_nope), to_blocks(q_pe)))
    return jnp.moveaxis(out, 0, 1).reshape(B, L, H, V_DIM)


def mla_mixer(h_ctx, h_lat, cos, sin, w_dqkv, g_q, g_kv, w_uq, w_ukv, w_o, need_ctx):
    B, L, _ = h_lat.shape
    n_ctx = h_ctx.shape[1]
    n_all = n_ctx + L
    h = jnp.concatenate([h_ctx, h_lat], axis=1)
    a = h @ w_dqkv
    c_q, c_kv, k_pe = jnp.split(a, [Q_LORA, Q_LORA + KV_LORA], axis=-1)
    q = (rms_norm(c_q, g_q) @ w_uq).reshape(B, n_all, MLA_HEADS, NOPE_DIM + ROPE_DIM)
    kv = (rms_norm(c_kv, g_kv) @ w_ukv).reshape(B, n_all, MLA_HEADS, NOPE_DIM + V_DIM)
    q_nope, q_pe = jnp.split(q, [NOPE_DIM], axis=-1)
    k_nope, v = jnp.split(kv, [NOPE_DIM], axis=-1)
    q_pe = apply_rope(q_pe, cos[:, None, :], sin[:, None, :])
    k_pe = apply_rope(k_pe, cos, sin)
    o_lat = blocked_attend(q_nope[:, n_ctx:], q_pe[:, n_ctx:], k_nope, k_pe, v)
    o_lat = o_lat.reshape(B, L, MLA_HEADS * V_DIM) @ w_o
    if not need_ctx:
        return o_lat, None
    o_ctx = mla_attend(q_nope[:, :n_ctx], q_pe[:, :n_ctx], k_nope[:, :n_ctx], k_pe[:, :n_ctx], v[:, :n_ctx])
    o_ctx = o_ctx.reshape(B, n_ctx, MLA_HEADS * V_DIM) @ w_o
    return o_lat, o_ctx


def _ssm_combine(e1, e2):
    a1, b1 = e1
    a2, b2 = e2
    return a1 * a2, a2 * b1 + b2


def diag_scan(bu, lam_bar, reverse):
    a = jnp.broadcast_to(lam_bar, (1, bu.shape[1]) + lam_bar.shape)
    return lax.associative_scan(_ssm_combine, (a, bu), axis=1, reverse=reverse)[1]


def s5_glu(y, w_glu, b_glu):
    z = jax.nn.gelu(y).astype(w_glu.dtype) @ w_glu + b_glu
    z1, z2 = jnp.split(z, 2, axis=-1)
    return z1 * jax.nn.sigmoid(z2)


def s5_mixer(h_ctx, h_lat, lam_re, lam_im, log_step, b_re, b_im, c_re, c_im, d_skip, w_glu, b_glu, need_ctx):
    B, L, D = h_lat.shape
    n_ctx = h_ctx.shape[1]
    f32 = jnp.float32
    u_ctx = h_ctx.astype(f32).reshape(B, n_ctx, S5_GROUPS, S5_GROUP).astype(jnp.complex64)
    u_lat = h_lat.astype(f32).reshape(B, L, S5_GROUPS, S5_GROUP).astype(jnp.complex64)
    dsk = d_skip.astype(f32)
    y_lat = h_lat.astype(f32) * dsk
    y_ctx = h_ctx.astype(f32) * dsk if need_ctx else None
    for direction in range(2):
        reverse = direction == 1
        lam = lax.complex(lam_re[direction].astype(f32), lam_im[direction].astype(f32))
        step = jnp.exp(log_step[direction].astype(f32))[:, None]
        lam_bar = jnp.exp(lam * step)
        b_bar = ((lam_bar - 1.0) / lam)[:, :, None] * lax.complex(
            b_re[direction].astype(f32), b_im[direction].astype(f32))
        c_mat = lax.complex(c_re[direction].astype(f32), c_im[direction].astype(f32))
        s_ctx = diag_scan(jnp.einsum('blgi,gpi->blgp', u_ctx, b_bar), lam_bar, reverse)
        h0 = s_ctx[:, 0] if reverse else s_ctx[:, -1]
        bu_lat = jnp.einsum('blgi,gpi->blgp', u_lat, b_bar)
        bu_lat = bu_lat.at[:, -1 if reverse else 0].add(lam_bar * h0)
        s_lat = diag_scan(bu_lat, lam_bar, reverse)
        y_lat = y_lat + jnp.einsum('blgp,gip->blgi', s_lat, c_mat).real.reshape(B, L, D)
        if need_ctx:
            y_ctx = y_ctx + jnp.einsum('blgp,gip->blgi', s_ctx, c_mat).real.reshape(B, n_ctx, D)
    o_lat = s5_glu(y_lat, w_glu, b_glu).astype(h_lat.dtype)
    o_ctx = s5_glu(y_ctx, w_glu, b_glu).astype(h_ctx.dtype) if need_ctx else None
    return o_lat, o_ctx


def swiglu(x, w_gate, w_up, w_down):
    return (jax.nn.silu(x @ w_gate) * (x @ w_up)) @ w_down


def moe_ffn(tok, w_router, router_bias, w_gate, w_up, w_down, sh_gate, sh_up, sh_down):
    T, D = tok.shape
    scores = jax.nn.sigmoid(tok.astype(jnp.float32) @ w_router.astype(jnp.float32))
    biased = scores + router_bias.astype(jnp.float32)
    grp = biased.reshape(T, N_EXPERT_GROUPS, N_EXPERTS // N_EXPERT_GROUPS)
    grp_score = lax.top_k(grp, 2)[0].sum(-1)
    _, gidx = lax.top_k(grp_score, TOPK_GROUPS)
    gmask = jax.nn.one_hot(gidx, N_EXPERT_GROUPS, dtype=jnp.bool_).any(axis=1)
    emask = jnp.repeat(gmask, N_EXPERTS // N_EXPERT_GROUPS, axis=1)
    _, eidx = lax.top_k(jnp.where(emask, biased, -jnp.inf), TOP_K)
    gates = jnp.take_along_axis(scores, eidx, axis=1)
    gates = gates / jnp.sum(gates, axis=-1, keepdims=True) * ROUTED_SCALE

    A = T * TOP_K
    flat_e = eidx.reshape(-1)
    flat_tok = jnp.repeat(jnp.arange(T), TOP_K)
    flat_w = gates.reshape(-1)
    order = jnp.argsort(flat_e)
    se, stok, sw = flat_e[order], flat_tok[order], flat_w[order]
    counts = jnp.bincount(flat_e, length=N_EXPERTS)
    padded = (counts + MOE_BLOCK - 1) // MOE_BLOCK * MOE_BLOCK
    pad_end = jnp.cumsum(padded)
    pad_start = pad_end - padded
    start = jnp.cumsum(counts) - counts
    dest = pad_start[se] + (jnp.arange(A) - start[se])
    n_blocks = -(-A // MOE_BLOCK) + N_EXPERTS
    buf = jnp.zeros((n_blocks * MOE_BLOCK, D), tok.dtype).at[dest].set(tok[stok])
    blk_e = jnp.minimum(jnp.searchsorted(pad_end, jnp.arange(n_blocks) * MOE_BLOCK, side='right'),
                        N_EXPERTS - 1)

    def expert_block(args):
        xb, e = args
        return swiglu(xb, w_gate[e], w_up[e], w_down[e])

    out = lax.map(expert_block, (buf.reshape(n_blocks, MOE_BLOCK, D), blk_e)).reshape(-1, D)
    y = out[dest] * sw[:, None].astype(out.dtype)
    routed = jax.ops.segment_sum(y, stok, num_segments=T)
    return routed + swiglu(tok, sh_gate, sh_up, sh_down)


def setup_inputs(seed: int = 0) -> dict:
    key = jax.random.key(seed)
    ks = iter(jax.random.split(key, 48))
    f32 = jnp.float32

    def nrm(shape, scale):
        return jax.random.normal(next(ks), shape, f32) * scale

    n_a = (DEPTH + N_MIXERS - 1) // N_MIXERS
    n_b = DEPTH // N_MIXERS
    D = D_MODEL
    G, P, I = S5_GROUPS, S5_STATE, S5_GROUP
    lam_im0 = jnp.broadcast_to(jnp.pi * jnp.arange(P, dtype=f32), (n_b, 2, G, P))
    return {
        "x": nrm((BATCH, SEQ, D), 1.0),
        "c": nrm((BATCH, D), 1.0),
        "ctx": nrm((BATCH, CTX_LEN, D), 1.0),
        "c_ctx": nrm((D,), 1.0),
        "ada_w": nrm((DEPTH, D, N_MOD * D), 0.5 * D ** -0.5),
        "ada_b": nrm((DEPTH, N_MOD * D), 0.02),
        "norm_g": 1.0 + nrm((DEPTH, 4, D), 0.02),
        "mla_w_dqkv": nrm((n_a, D, Q_LORA + KV_LORA + ROPE_DIM), D ** -0.5),
        "mla_g_q": 1.0 + nrm((n_a, Q_LORA), 0.02),
        "mla_g_kv": 1.0 + nrm((n_a, KV_LORA), 0.02),
        "mla_w_uq": nrm((n_a, Q_LORA, MLA_HEADS * (NOPE_DIM + ROPE_DIM)), Q_LORA ** -0.5),
        "mla_w_ukv": nrm((n_a, KV_LORA, MLA_HEADS * (NOPE_DIM + V_DIM)), KV_LORA ** -0.5),
        "mla_w_o": nrm((n_a, MLA_HEADS * V_DIM, D), (MLA_HEADS * V_DIM) ** -0.5),
        "s5_lam_re": -0.5 + nrm((n_b, 2, G, P), 0.01),
        "s5_lam_im": lam_im0 + nrm((n_b, 2, G, P), 0.01),
        "s5_log_step": jax.random.uniform(next(ks), (n_b, 2, G), f32,
                                          minval=math.log(S5_DT_MIN), maxval=math.log(S5_DT_MAX)),
        "s5_b_re": nrm((n_b, 2, G, P, I), (2 * I) ** -0.5),
        "s5_b_im": nrm((n_b, 2, G, P, I), (2 * I) ** -0.5),
        "s5_c_re": nrm((n_b, 2, G, I, P), (2 * P) ** -0.5),
        "s5_c_im": nrm((n_b, 2, G, I, P), (2 * P) ** -0.5),
        "s5_d": nrm((n_b, D), 1.0),
        "s5_w_glu": nrm((n_b, D, 2 * D), D ** -0.5),
        "s5_b_glu": nrm((n_b, 2 * D), 0.02),
        "moe_w_router": nrm((DEPTH, D, N_EXPERTS), D ** -0.5),
        "moe_bias": nrm((DEPTH, N_EXPERTS), 0.01),
        "moe_w_gate": nrm((DEPTH, N_EXPERTS, D, D_EXPERT), D ** -0.5),
        "moe_w_up": nrm((DEPTH, N_EXPERTS, D, D_EXPERT), D ** -0.5),
        "moe_w_down": nrm((DEPTH, N_EXPERTS, D_EXPERT, D), D_EXPERT ** -0.5),
        "sh_w_gate": nrm((DEPTH, D, D_SHARED), D ** -0.5),
        "sh_w_up": nrm((DEPTH, D, D_SHARED), D ** -0.5),
        "sh_w_down": nrm((DEPTH, D_SHARED, D), D_SHARED ** -0.5),
    }


def reference(x, c, ctx, c_ctx, ada_w, ada_b, norm_g,
              mla_w_dqkv, mla_g_q, mla_g_kv, mla_w_uq, mla_w_ukv, mla_w_o,
              s5_lam_re, s5_lam_im, s5_log_step, s5_b_re, s5_b_im, s5_c_re, s5_c_im,
              s5_d, s5_w_glu, s5_b_glu,
              moe_w_router, moe_bias, moe_w_gate, moe_w_up, moe_w_down,
              sh_w_gate, sh_w_up, sh_w_down):
    B, L, D = x.shape
    n_ctx = ctx.shape[1]
    cos_l, sin_l = axial_rope_tables(L)
    cos = jnp.concatenate([jnp.ones((n_ctx, ROPE_DIM // 2), jnp.float32), cos_l], axis=0)
    sin = jnp.concatenate([jnp.zeros((n_ctx, ROPE_DIM // 2), jnp.float32), sin_l], axis=0)
    silu_c = jax.nn.silu(c)
    silu_cc = jax.nn.silu(c_ctx)
    x_lat, x_ctx = x, ctx
    for i in range(DEPTH):
        need_ctx = i < DEPTH - 1
        j = i // N_MIXERS
        mod_lat = jnp.split((silu_c @ ada_w[i] + ada_b[i])[:, None, :], N_MOD, axis=-1)
        mod_ctx = jnp.split((silu_cc @ ada_w[i] + ada_b[i])[None, None, :], N_MOD, axis=-1)
        h_lat = modulate(rms_norm(x_lat, norm_g[i, 0]), mod_lat[0], mod_lat[1])
        h_ctx = modulate(rms_norm(x_ctx, norm_g[i, 0]), mod_ctx[0], mod_ctx[1])
        if i % N_MIXERS == 0:
            o_lat, o_ctx = mla_mixer(h_ctx, h_lat, cos, sin, mla_w_dqkv[j], mla_g_q[j], mla_g_kv[j],
                                     mla_w_uq[j], mla_w_ukv[j], mla_w_o[j], need_ctx)
        else:
            o_lat, o_ctx = s5_mixer(h_ctx, h_lat, s5_lam_re[j], s5_lam_im[j], s5_log_step[j],
                                    s5_b_re[j], s5_b_im[j], s5_c_re[j], s5_c_im[j], s5_d[j],
                                    s5_w_glu[j], s5_b_glu[j], need_ctx)
        x_lat = x_lat + mod_lat[2] * rms_norm(o_lat, norm_g[i, 1])
        f_lat_in = modulate(rms_norm(x_lat, norm_g[i, 2]), mod_lat[3], mod_lat[4])
        moe_args = (moe_w_router[i], moe_bias[i], moe_w_gate[i], moe_w_up[i], moe_w_down[i],
                    sh_w_gate[i], sh_w_up[i], sh_w_down[i])
        if need_ctx:
            x_ctx = x_ctx + mod_ctx[2] * rms_norm(o_ctx, norm_g[i, 1])
            f_ctx_in = modulate(rms_norm(x_ctx, norm_g[i, 2]), mod_ctx[3], mod_ctx[4])
            tok = jnp.concatenate([f_ctx_in.reshape(-1, D), f_lat_in.reshape(-1, D)], axis=0)
            f = moe_ffn(tok, *moe_args)
            f_ctx = f[:B * n_ctx].reshape(B, n_ctx, D)
            f_lat = f[B * n_ctx:].reshape(B, L, D)
            x_ctx = x_ctx + mod_ctx[5] * rms_norm(f_ctx, norm_g[i, 3])
        else:
            f_lat = moe_ffn(f_lat_in.reshape(-1, D), *moe_args).reshape(B, L, D)
        x_lat = x_lat + mod_lat[5] * rms_norm(f_lat, norm_g[i, 3])
    return x_lat
```

```cpp
#include <hip/hip_runtime.h>
#include <cstdio>
#include <cstdint>

#define GAS __attribute__((address_space(1)))
#define LAS __attribute__((address_space(3)))
typedef unsigned short bf16_t;
typedef short bf16x8 __attribute__((ext_vector_type(8)));
typedef short s16x4 __attribute__((ext_vector_type(4)));
typedef float f32x2 __attribute__((ext_vector_type(2)));
typedef float f32x4 __attribute__((ext_vector_type(4)));
typedef float f32x16 __attribute__((ext_vector_type(16)));
typedef unsigned u32x2 __attribute__((ext_vector_type(2)));
typedef unsigned u32x4 __attribute__((ext_vector_type(4)));

constexpr int DM = 1024, NBATCH = 16, SEQL = 2048, NCTX = 256;
constexpr int NCTXR = NBATCH * NCTX;
constexpr int NLATR = NBATCH * SEQL;
constexpr int NROWS = NCTXR + NLATR;
constexpr int NHEAD = 8, QLORA = 384, KVLORA = 256, NOPE = 128, ROPED = 64, VDIM = 128;
constexpr int NDQKV = 768;
constexpr int NQ = NHEAD * (NOPE + ROPED);
constexpr int NKV = NHEAD * (NOPE + VDIM);
constexpr int NEXP = 64, TOPK = 8, DEXP = 256;
constexpr float NORM_EPS = 1e-6f;
constexpr int NMOD = 6, MODW = NMOD * DM;

constexpr size_t MiB = 1u << 20;
constexpr size_t WS_CTL = 0, CTL_BYTES = 1 * MiB;
constexpr size_t WS_WDQKV = 1 * MiB;
constexpr size_t WS_WUQ   = WS_WDQKV + 1536 * 1024;
constexpr size_t WS_WUKV  = WS_WUQ + 1280 * 1024;
constexpr size_t WS_WO    = WS_WUKV + 1 * MiB;
constexpr size_t WS_WGLU  = WS_WO + 2 * MiB;
constexpr size_t WS_WSHR  = WS_WGLU + 4 * MiB;
constexpr size_t WS_WSHD  = WS_WSHR + 3 * MiB;
constexpr size_t WS_MOD   = 15 * MiB;
constexpr size_t WS_ROPE  = 16 * MiB;
constexpr size_t WS_W1    = 17 * MiB;
constexpr size_t WS_W2    = 81 * MiB;
constexpr size_t WS_XCTX  = 113 * MiB;
constexpr size_t WS_XN    = 129 * MiB;
constexpr size_t WS_ST    = 201 * MiB;
static_assert(WS_WSHD + 1 * MiB <= WS_MOD, "small weights fit");
constexpr size_t WS_KV   = WS_ST;
constexpr size_t WS_Q    = WS_ST + 144 * MiB;
constexpr size_t WS_OO   = WS_Q;
constexpr size_t WS_A1   = WS_ST + 252 * MiB;
constexpr size_t WS_O    = WS_A1;
constexpr size_t WS_KPE  = WS_ST + 324 * MiB;
constexpr size_t WS_SSQ1 = WS_ST + 329 * MiB;
constexpr size_t WS_SSQO = WS_ST + 332 * MiB;
constexpr size_t WS_END  = WS_ST + 402 * MiB;

constexpr int CW_BAR = 4096;

__device__ __forceinline__ unsigned cvt_pk_bf16(float lo, float hi) { unsigned r; asm volatile("v_cvt_pk_bf16_f32 %0, %1, %2" : "=v"(r) : "v"(lo), "v"(hi)); return r; }
__device__ __forceinline__ float bf_lo(unsigned w) { return __uint_as_float(w << 16); }
__device__ __forceinline__ float bf_hi(unsigned w) { return __uint_as_float(w & 0xffff0000u); }
__device__ __forceinline__ float wave_sum(float v) {
#pragma unroll
    for (int o = 1; o < 64; o <<= 1) v += __shfl_xor(v, o);
    return v;
}
__device__ __forceinline__ float silu_f(float v) { return v / (1.f + __expf(-v)); }
__device__ __forceinline__ float sigmoid_f(float v) { return 1.f / (1.f + __expf(-v)); }
__device__ __forceinline__ int mod_index(int row) { return row < NCTXR ? 16 : (row - NCTXR) / SEQL; }
__device__ __forceinline__ int opaque_tid() { int t = threadIdx.x; asm volatile("" : "+v"(t)); return t; }
__device__ __forceinline__ float gelu_tanh(float v) {
    const float z = 0.7978845608028654f * (v + 0.044715f * v * v * v);
    return v / (1.f + __expf(-2.f * z));
}
__device__ __forceinline__ unsigned char* opaque_ptr(unsigned char* p) { asm volatile("" : "+s"(p)); return p; }
#define XB_TMO      128
#define XB_XCNT(j)  (256  + 64 * (j))
#define XB_XSUB(j)  (1280 + 64 * (j))
#define XB_XGEN(j)  (2304 + 64 * (j))
#define XB_TOP      3328
#define XB_TOPGEN   3392
#define XCD_BAR_WORDS 3456
#define XB_SPIN_CAP (1u << 18)
__device__ __forceinline__ unsigned xb_ld(unsigned* p)              { return __hip_atomic_load(p, __ATOMIC_RELAXED, __HIP_MEMORY_SCOPE_AGENT); }
__device__ __forceinline__ unsigned xb_add(unsigned* p, unsigned v) { return __hip_atomic_fetch_add(p, v, __ATOMIC_RELAXED, __HIP_MEMORY_SCOPE_AGENT); }
__device__ __forceinline__ unsigned xb_xcc_id() { return (unsigned)__builtin_amdgcn_s_getreg((3 << 11) | 20) & 0xFu; }
#define XB_SPIN(cond, bar) do { unsigned _sp = 0; while (cond) { __builtin_amdgcn_s_sleep(1); \
    if ((++_sp & 255u) == 0u) { if (xb_ld(&(bar)[XB_TMO])) break; if (_sp > XB_SPIN_CAP) { atomicAdd(&(bar)[XB_TMO], 1u); break; } } } } while (0)
struct XcdBarrier { unsigned* bar; unsigned x; volatile LAS unsigned* st; };
__device__ __forceinline__ XcdBarrier xcd_barrier_post(unsigned* bar, volatile LAS unsigned* st) {
    XcdBarrier b; b.bar = bar; b.x = xb_xcc_id(); b.st = st;
    if (threadIdx.x == 0) (void)xb_add(&bar[XB_XCNT(b.x)], 1u);
    return b;
}
__device__ __forceinline__ void xcd_barrier_complete(unsigned* bar, unsigned x, unsigned& nloc, unsigned& nx) {
    const unsigned G = gridDim.x * gridDim.y * gridDim.z;
    unsigned sum, cnt, mine, sp = 0u;
    for (;;) {
        sum = 0u; cnt = 0u; mine = 0u;
#pragma unroll
        for (unsigned j = 0; j < 16; ++j) { const unsigned c = xb_ld(&bar[XB_XCNT(j)]); sum += c; cnt += (c > 0u) ? 1u : 0u; mine = (j == x) ? c : mine; }
        if (sum == G) break;
        __builtin_amdgcn_s_sleep(1);
        if ((++sp & 255u) == 0u) { if (xb_ld(&bar[XB_TMO])) break; if (sp > XB_SPIN_CAP) { atomicAdd(&bar[XB_TMO], 1u); break; } }
    }
    nloc = mine > 0u ? mine : 1u; nx = cnt > 0u ? cnt : 1u;
}
__device__ __forceinline__ void xcd_barrier(const XcdBarrier& b) {
    asm volatile("s_waitcnt vmcnt(0)" ::: "memory");
    __syncthreads();
    if (threadIdx.x == 0) {
        unsigned* bar = b.bar;
        __builtin_amdgcn_s_waitcnt(0);
        unsigned nloc = b.st[0], nx = b.st[1];
        if (nloc == 0u) { xcd_barrier_complete(bar, b.x, nloc, nx); b.st[0] = nloc; b.st[1] = nx; }
        const unsigned old = xb_add(&bar[XB_XSUB(b.x)], 1u);
        const unsigned gen = old / nloc;
        if (old + 1u == (gen + 1u) * nloc) {
            __builtin_amdgcn_fence(__ATOMIC_RELEASE, "agent");
            asm volatile("s_waitcnt vmcnt(0)" ::: "memory");
            const unsigned og = xb_add(&bar[XB_TOP], 1u);
            const unsigned tg = og / nx;
            if (og + 1u == (tg + 1u) * nx) xb_add(&bar[XB_TOPGEN], 1u);
            else XB_SPIN(xb_ld(&bar[XB_TOPGEN]) == tg, bar);
            __builtin_amdgcn_fence(__ATOMIC_ACQUIRE, "agent");
            xb_add(&bar[XB_XGEN(b.x)], 1u);
            asm volatile("s_waitcnt vmcnt(0)" ::: "memory");
        } else {
            XB_SPIN(xb_ld(&bar[XB_XGEN(b.x)]) == gen, bar);
            __builtin_amdgcn_fence(__ATOMIC_ACQUIRE, "agent");
            asm volatile("s_waitcnt vmcnt(0)" ::: "memory");
        }
    }
    __syncthreads();
}

namespace pg8 {
constexpr int BM = 256, BK = 64, HALF = 128, HTB = HALF * BK * 2, STAGE_BYTES = 8 * HTB, NXCD = 8, WGM = 8;
__host__ __device__ __forceinline__ int lds_byte(int r, int c) { const int st = (r >> 4) * 2 + (c >> 5), rr = r & 15, cc = c & 31, ob = rr * 64 + cc * 2; return st * 1024 + (ob ^ (((ob >> 9) & 1) << 5)); }
__host__ __device__ __forceinline__ void stage_rc(int b, int& R, int& C) { const int st = b / 1024, sb = b % 1024, swz = sb ^ (((sb >> 9) & 1) << 5); R = (st >> 1) * 16 + swz / 64; C = (st & 1) * 32 + (swz % 64) / 2; }
__host__ __device__ __forceinline__ int perm32(int rho) { const int n = rho >> 4, i = rho & 15; return 8 * (i >> 2) + 4 * n + (i & 3); }

__device__ __forceinline__ bool dense_order(int i, int G, int c, int nM, int nN, int& pm, int& pn) {
    const int nwg = nM * nN; const long L = (long)i * G + c; if (L >= nwg) return false;
    int wgid = (int)L; { const int q = nwg / NXCD, r = nwg % NXCD, xcd = wgid % NXCD, off = wgid / NXCD; wgid = (xcd < r ? xcd * (q + 1) : r * (q + 1) + (xcd - r) * q) + off; }
    const int nig = WGM * nN, gid = wgid / nig, fm = gid * WGM, gsz = (nM - fm) < WGM ? (nM - fm) : WGM;
    pm = __builtin_amdgcn_readfirstlane(fm + ((wgid % nig) % gsz)); pn = __builtin_amdgcn_readfirstlane((wgid % nig) / gsz); return true;
}

template <bool GATHER> struct UCtx { const char* a0[2]; const char* a1[2]; const char* b; unsigned vg[2][2]; };
template <> struct UCtx<false> { const char* a0[2]; const char* a1[2]; const char* b; };

template <class P>
__device__ __forceinline__ void gemm_phase(LAS unsigned char* lds, const P& pol) {
    typedef typename P::Unit Unit;
    const int tid = opaque_tid(), wid = __builtin_amdgcn_readfirstlane(tid >> 6), lane = tid & 63, wr = wid >> 2, wc = wid & 3, fr = lane & 15, fq = lane >> 4;
    constexpr int nt = P::NT;
    int Rr[2], Cc[2]; unsigned voffB[2], va0[2];
#pragma unroll
    for (int i = 0; i < 2; ++i) { stage_rc(tid * 16 + i * 8192, Rr[i], Cc[i]); const int Rb = P::PERM ? ((Rr[i] & ~31) + perm32(Rr[i] & 31)) : Rr[i];
        voffB[i] = (unsigned)(Rb * P::LDB + Cc[i] * 2); va0[i] = pol.lane_a0(Rr[i], Cc[i]); }
    constexpr size_t hstepB = (size_t)HALF * P::LDB;
    const unsigned ldsw = (unsigned)wid * 1024u;
    const int aoff = lds_byte(wr * 64 + fr, fq * 8), boff = lds_byte(wc * 32 + fr, fq * 8);
#define PG8_SA(b, h) (((b) * 2 + (h)) * HTB)
#define PG8_SB(b, h) ((4 + (b) * 2 + (h)) * HTB)
#define PG8_GL(bufoff, p0, p1) do { __builtin_amdgcn_global_load_lds((const unsigned*)(p0), (LAS unsigned*)(lds + (bufoff) + ldsw), 16, 0, 0); \
        __builtin_amdgcn_global_load_lds((const unsigned*)(p1), (LAS unsigned*)(lds + (bufoff) + ldsw + 8192), 16, 0, 0); } while (0)
#define PG8_STB(bufoff, U, h, kt) do { const char* _b = (U).b + (size_t)(h) * hstepB + (size_t)(kt) * 128; asm volatile("" : "+s"(_b)); PG8_GL(bufoff, _b + voffB[0], _b + voffB[1]); } while (0)
#define PG8_STA(bufoff, U, h, kt) do { const char* _a = (U).a0[h] + (size_t)(kt) * P::KS0; if constexpr (P::TWOSEG) { if ((kt) >= P::KT0) _a = (U).a1[h] + (size_t)((kt) - P::KT0) * P::KS1; } \
        unsigned _o0, _o1; if constexpr (P::GATHER) { _o0 = (U).vg[h][0]; _o1 = (U).vg[h][1]; } else { _o0 = va0[0]; _o1 = va0[1]; } \
        asm volatile("" : "+s"(_a)); PG8_GL(bufoff, _a + _o0, _a + _o1); } while (0)
#define PG8_LDA(dst, b, h) do { _Pragma("unroll") for (int m = 0; m < 4; ++m) _Pragma("unroll") for (int k = 0; k < 2; ++k) dst[m][k] = *(const LAS bf16x8*)(lds + PG8_SA(b, h) + aoff + m * 2048 + k * 1024); } while (0)
#define PG8_LDB(dst, b, h) do { _Pragma("unroll") for (int n = 0; n < 2; ++n) _Pragma("unroll") for (int k = 0; k < 2; ++k) dst[n][k] = *(const LAS bf16x8*)(lds + PG8_SB(b, h) + boff + n * 2048 + k * 1024); } while (0)
#define PG8_MMA(ai, bj, At, Bt) do { __builtin_amdgcn_s_setprio(1); _Pragma("unroll") for (int m = 0; m < 4; ++m) _Pragma("unroll") for (int n = 0; n < 2; ++n) _Pragma("unroll") for (int k = 0; k < 2; ++k) \
        acc[ai][bj][m][n] = __builtin_amdgcn_mfma_f32_16x16x32_bf16(Bt[n][k], At[m][k], acc[ai][bj][m][n], 0, 0, 0); __builtin_amdgcn_s_setprio(0); } while (0)
#define PG8_WAIT_V(n) asm volatile("s_waitcnt vmcnt(" #n ")" ::: "memory")
#define PG8_WAIT_L(n) asm volatile("s_waitcnt lgkmcnt(" #n ")" ::: "memory")
#define PG8_BAR __builtin_amdgcn_s_barrier()
#define PG8_SCHED __builtin_amdgcn_sched_barrier(0)
    Unit cur, nxt; int ui = 0;
    if (!pol.next(0, cur)) return;
    UCtx<P::GATHER> cc, nc;
    pol.ctx(cur, cc, Rr, Cc);
    f32x4 acc[2][2][4][2];
#pragma unroll
    for (int a = 0; a < 2; ++a)
#pragma unroll
        for (int b = 0; b < 2; ++b)
#pragma unroll
            for (int m = 0; m < 4; ++m)
#pragma unroll
                for (int n = 0; n < 2; ++n) acc[a][b][m][n] = (f32x4){0.f, 0.f, 0.f, 0.f};
    bf16x8 At[4][2], B0[2][2], B1[2][2];
    PG8_STB(PG8_SB(0, 0), cc, 0, 0); PG8_STB(PG8_SB(0, 1), cc, 1, 0); PG8_STA(PG8_SA(0, 0), cc, 0, 0); PG8_STA(PG8_SA(0, 1), cc, 1, 0);
    if (wr == 1) PG8_BAR;
    PG8_WAIT_V(2); PG8_BAR;
    PG8_STB(PG8_SB(1, 0), cc, 0, 1); PG8_STA(PG8_SA(1, 0), cc, 0, 1); PG8_STB(PG8_SB(1, 1), cc, 1, 1);
    PG8_WAIT_V(6); PG8_BAR;
    for (;;) {
        const bool has_next = pol.next(ui + 1, nxt);
        if (has_next) pol.ctx(nxt, nc, Rr, Cc); else nc = cc;
        for (int t = 0; t < nt; t += 2) {
            const bool last = (t == nt - 2);
            const int k2 = last ? 0 : t + 2, k3 = k2 + 1;
            PG8_LDB(B0, 0, 0); PG8_LDB(B1, 0, 1); PG8_SCHED; PG8_LDA(At, 0, 0); PG8_STA(PG8_SA(1, 1), cc, 1, t + 1);
            PG8_WAIT_V(8); PG8_WAIT_L(0); PG8_BAR; PG8_MMA(0, 0, At, B0); PG8_MMA(0, 1, At, B1); PG8_BAR; PG8_SCHED;
            PG8_LDA(At, 0, 1);
            if (last) { PG8_STB(PG8_SB(0, 0), nc, 0, 0); PG8_STB(PG8_SB(0, 1), nc, 1, 0); PG8_STA(PG8_SA(0, 0), nc, 0, 0); }
            else      { PG8_STB(PG8_SB(0, 0), cc, 0, k2); PG8_STB(PG8_SB(0, 1), cc, 1, k2); PG8_STA(PG8_SA(0, 0), cc, 0, k2); }
            PG8_WAIT_V(8); PG8_WAIT_L(0); PG8_BAR; PG8_MMA(1, 0, At, B0); PG8_MMA(1, 1, At, B1); PG8_BAR; PG8_SCHED;
            PG8_LDB(B0, 1, 0); PG8_LDB(B1, 1, 1); PG8_SCHED; PG8_LDA(At, 1, 0);
            if (last) { PG8_STA(PG8_SA(0, 1), nc, 1, 0); } else { PG8_STA(PG8_SA(0, 1), cc, 1, k2); }
            PG8_WAIT_V(8); PG8_WAIT_L(0); PG8_BAR; PG8_MMA(0, 0, At, B0); PG8_MMA(0, 1, At, B1); PG8_BAR; PG8_SCHED;
            PG8_LDA(At, 1, 1);
            if (last) { PG8_STB(PG8_SB(1, 0), nc, 0, 1); PG8_STB(PG8_SB(1, 1), nc, 1, 1); PG8_STA(PG8_SA(1, 0), nc, 0, 1); }
            else      { PG8_STB(PG8_SB(1, 0), cc, 0, k3); PG8_STB(PG8_SB(1, 1), cc, 1, k3); PG8_STA(PG8_SA(1, 0), cc, 0, k3); }
            PG8_WAIT_V(8); PG8_WAIT_L(0); PG8_BAR; PG8_MMA(1, 0, At, B0); PG8_MMA(1, 1, At, B1); PG8_BAR; PG8_SCHED;
        }
        if (wr == 0) PG8_BAR;
        pol.epi(acc, cur, wr, wc, fr, fq);
        if (!has_next) break;
#pragma unroll
        for (int a = 0; a < 2; ++a)
#pragma unroll
            for (int b = 0; b < 2; ++b)
#pragma unroll
                for (int m = 0; m < 4; ++m)
#pragma unroll
                    for (int n = 0; n < 2; ++n) acc[a][b][m][n] = (f32x4){0.f, 0.f, 0.f, 0.f};
        cur = nxt; cc = nc; ++ui;
        if (wr == 1) PG8_BAR;
    }
    PG8_WAIT_V(0);
    PG8_BAR;
#undef PG8_SA
#undef PG8_SB
#undef PG8_GL
#undef PG8_STB
#undef PG8_STA
#undef PG8_LDA
#undef PG8_LDB
#undef PG8_MMA
#undef PG8_WAIT_V
#undef PG8_WAIT_L
#undef PG8_BAR
#undef PG8_SCHED
}
}
struct DUnit { int pm, pn; };

template <int NT_, int LDA_, bool PERM_> struct DenseBase {
    static constexpr bool PERM = PERM_, GATHER = false, TWOSEG = false;
    static constexpr int NT = NT_, KT0 = NT_, KS0 = 128, KS1 = 128, LDB = NT_ * 128;
    typedef DUnit Unit;
    const char* A; const char* Bt; int nM, nN, G, c;
    __device__ __forceinline__ bool next(int i, Unit& u) const { return pg8::dense_order(i, G, c, nM, nN, u.pm, u.pn); }
    __device__ __forceinline__ void ctx(const Unit& u, pg8::UCtx<false>& x, const int (&)[2], const int (&)[2]) const {
        x.a0[0] = A + (size_t)u.pm * 256 * LDA_; x.a0[1] = x.a0[0] + (size_t)128 * LDA_; x.a1[0] = x.a0[0]; x.a1[1] = x.a0[1];
        x.b = Bt + (size_t)u.pn * 256 * LDB; }
    __device__ __forceinline__ unsigned lane_a0(int R, int C) const { return (unsigned)(R * LDA_ + C * 2); }
    __device__ __forceinline__ unsigned lane_a1(int, int) const { return 0u; }
};

__device__ __forceinline__ void store8(bf16_t* p, const f32x4& v0, const f32x4& v1) {
    u32x4 w; w.x = cvt_pk_bf16(v0[0], v0[1]); w.y = cvt_pk_bf16(v0[2], v0[3]); w.z = cvt_pk_bf16(v1[0], v1[1]); w.w = cvt_pk_bf16(v1[2], v1[3]); *(u32x4*)p = w; }
__device__ __forceinline__ float sq4(const f32x4& v) { return (v[0] * v[0] + v[1] * v[1]) + (v[2] * v[2] + v[3] * v[3]); }
__device__ __forceinline__ void rope8(f32x4& v0, f32x4& v1, const float* cs) {
    const f32x4 a = *(const f32x4*)cs, b = *(const f32x4*)(cs + 4);
    float x0, x1;
    x0 = v0[0]; x1 = v0[1]; v0[0] = x0 * a[0] - x1 * a[1]; v0[1] = x0 * a[1] + x1 * a[0];
    x0 = v0[2]; x1 = v0[3]; v0[2] = x0 * a[2] - x1 * a[3]; v0[3] = x0 * a[3] + x1 * a[2];
    x0 = v1[0]; x1 = v1[1]; v1[0] = x0 * b[0] - x1 * b[1]; v1[1] = x0 * b[1] + x1 * b[0];
    x0 = v1[2]; x1 = v1[3]; v1[2] = x0 * b[2] - x1 * b[3]; v1[3] = x0 * b[3] + x1 * b[2];
}

struct PolDqkv : DenseBase<16, 2048, true> {
    bf16_t* A1; float* SSQ1; bf16_t* KPE; const float* ROPE;
    __device__ __forceinline__ void epi(const f32x4 (&acc)[2][2][4][2], const DUnit& u, int wr, int wc, int fr, int fq) const {
#pragma unroll
        for (int ai = 0; ai < 2; ++ai)
#pragma unroll
            for (int m = 0; m < 4; ++m) {
                const int row = u.pm * 256 + ai * 128 + wr * 64 + m * 16 + fr;
                bf16_t* rowp = A1 + (size_t)row * NDQKV + u.pn * 256 + wc * 32 + 8 * fq;
                float s0 = sq4(acc[ai][0][m][0]) + sq4(acc[ai][0][m][1]), s1 = sq4(acc[ai][1][m][0]) + sq4(acc[ai][1][m][1]);
                store8(rowp, acc[ai][0][m][0], acc[ai][0][m][1]); store8(rowp + 128, acc[ai][1][m][0], acc[ai][1][m][1]);
                s0 += __shfl_xor(s0, 16); s0 += __shfl_xor(s0, 32); s1 += __shfl_xor(s1, 16); s1 += __shfl_xor(s1, 32);
                if (fq == 0) {
                    float* sp = SSQ1 + (size_t)row * 16;
                    if (u.pn == 0) sp[wc] = s0 + s1; else if (u.pn == 1) { sp[4 + wc] = s0; sp[8 + wc] = s1; } else sp[12 + wc] = s0;
                }
                if (u.pn == 2 && wc < 2) {
                    f32x4 v0 = acc[ai][1][m][0], v1 = acc[ai][1][m][1];
                    if (row >= NCTXR) { const int t = (row - NCTXR) & (SEQL - 1); rope8(v0, v1, ROPE + ((size_t)t * 32 + 16 * wc + 4 * fq) * 2); }
                    store8(KPE + (size_t)row * 64 + 32 * wc + 8 * fq, v0, v1);
                }
            }
    }
};

struct PolQup : DenseBase<6, NDQKV * 2, true> {
    bf16_t* Q; const float* SSQ1; const float* ROPE;
    __device__ __forceinline__ void epi(const f32x4 (&acc)[2][2][4][2], const DUnit& u, int wr, int wc, int fr, int fq) const {
#pragma unroll
        for (int ai = 0; ai < 2; ++ai)
#pragma unroll
            for (int m = 0; m < 4; ++m) {
                const int row = u.pm * 256 + ai * 128 + wr * 64 + m * 16 + fr;
                const f32x4 p0 = *(const f32x4*)(SSQ1 + (size_t)row * 16), p1 = *(const f32x4*)(SSQ1 + (size_t)row * 16 + 4);
                const float ss = ((p0[0] + p0[1]) + (p0[2] + p0[3])) + ((p1[0] + p1[1]) + (p1[2] + p1[3]));
                const float rstd = __builtin_amdgcn_rsqf(ss * (1.f / QLORA) + NORM_EPS);
#pragma unroll
                for (int bj = 0; bj < 2; ++bj) {
                    const int col = u.pn * 256 + bj * 128 + wc * 32 + 8 * fq, d = col % 192;
                    f32x4 v0 = acc[ai][bj][m][0] * rstd, v1 = acc[ai][bj][m][1] * rstd;
                    if (d >= NOPE && row >= NCTXR) { const int t = (row - NCTXR) & (SEQL - 1); rope8(v0, v1, ROPE + ((size_t)t * 32 + ((d - NOPE) >> 1)) * 2); }
                    store8(Q + (size_t)row * NQ + col, v0, v1); asm volatile("" ::: "memory");
                }
            }
    }
};

struct PolKVup : DenseBase<4, NDQKV * 2, true> {
    bf16_t* KV; const float* SSQ1;
    __device__ __forceinline__ void epi(const f32x4 (&acc)[2][2][4][2], const DUnit& u, int wr, int wc, int fr, int fq) const {
#pragma unroll
        for (int ai = 0; ai < 2; ++ai)
#pragma unroll
            for (int m = 0; m < 4; ++m) {
                const int row = u.pm * 256 + ai * 128 + wr * 64 + m * 16 + fr;
                const f32x4 p0 = *(const f32x4*)(SSQ1 + (size_t)row * 16 + 8), p1 = *(const f32x4*)(SSQ1 + (size_t)row * 16 + 12);
                const float ss = ((p0[0] + p0[1]) + (p0[2] + p0[3])) + ((p1[0] + p1[1]) + (p1[2] + p1[3]));
                const float rstd = __builtin_amdgcn_rsqf(ss * (1.f / KVLORA) + NORM_EPS);
                bf16_t* rowp = KV + (size_t)row * NKV + u.pn * 256 + wc * 32 + 8 * fq;
                store8(rowp, acc[ai][0][m][0] * rstd, acc[ai][0][m][1] * rstd); store8(rowp + 128, acc[ai][1][m][0] * rstd, acc[ai][1][m][1] * rstd);
            }
    }
};

struct PolWo : DenseBase<16, 2048, true> {
    bf16_t* OO; float* SSQO;
    __device__ __forceinline__ void epi(const f32x4 (&acc)[2][2][4][2], const DUnit& u, int wr, int wc, int fr, int fq) const {
#pragma unroll
        for (int ai = 0; ai < 2; ++ai)
#pragma unroll
            for (int m = 0; m < 4; ++m) {
                const int row = u.pm * 256 + ai * 128 + wr * 64 + m * 16 + fr;
                bf16_t* rowp = OO + (size_t)row * DM + u.pn * 256 + wc * 32 + 8 * fq;
                float s = (sq4(acc[ai][0][m][0]) + sq4(acc[ai][0][m][1])) + (sq4(acc[ai][1][m][0]) + sq4(acc[ai][1][m][1]));
                store8(rowp, acc[ai][0][m][0], acc[ai][0][m][1]); store8(rowp + 128, acc[ai][1][m][0], acc[ai][1][m][1]);
                s += __shfl_xor(s, 16); s += __shfl_xor(s, 32);
                if (fq == 0) SSQO[(size_t)row * 32 + u.pn * 4 + wc] = s;
            }
    }
};
namespace attn {
constexpr int NW = 8, QBLK = 32, KVBLK = 64, DQK = 192, DV = 128;
constexpr float SCALE = 0.07216878364870322f;
constexpr float THR = 8.f;
constexpr int SHM_V = KVBLK * DV * 2, SHM_K = KVBLK * DQK * 2;
constexpr int SHM_QPE = NW * 4096;
constexpr int SHM_ATTN = 2 * SHM_V + 2 * SHM_K + NW * 64 * 4 + SHM_QPE;
#define KSWZ(row, colB) ((row) * 384 + ((colB) ^ (((row) & 7) << 4)))
#define SBAR() __builtin_amdgcn_sched_barrier(0)
__device__ __forceinline__ int crow(int r, int hi) { return (r & 3) + 8 * (r >> 2) + 4 * hi; }
__device__ __forceinline__ unsigned cvtpk(float lo, float hi) { unsigned r; asm volatile("v_cvt_pk_bf16_f32 %0, %1, %2" : "=v"(r) : "v"(lo), "v"(hi)); return r; }

__device__ __forceinline__ void partialSM(f32x16& p0, f32x16& p1, float& m_reg, float& mn, float& alpha) {
  constexpr float C = SCALE * 1.4426950408889634f;
  float pmax = p0[0];
#pragma unroll
  for (int r = 1; r < 16; ++r) pmax = fmaxf(pmax, p0[r]);
#pragma unroll
  for (int r = 0; r < 16; ++r) pmax = fmaxf(pmax, p1[r]);
  { auto rr = __builtin_amdgcn_permlane32_swap(__float_as_uint(pmax), __float_as_uint(pmax), false, false);
    pmax = fmaxf(__uint_as_float(rr[0]), __uint_as_float(rr[1])); }
  if (__builtin_expect(__all(pmax - m_reg <= THR / SCALE), 1)) { mn = m_reg; alpha = 1.f; }
  else { mn = fmaxf(m_reg, pmax); alpha = __builtin_amdgcn_exp2f((m_reg - mn) * C); m_reg = mn; }
  float mnC = -mn * C;
#pragma unroll
  for (int r = 0; r < 16; ++r) p0[r] = fmaf(p0[r], C, mnC);
#pragma unroll
  for (int r = 0; r < 16; ++r) p1[r] = fmaf(p1[r], C, mnC);
#pragma unroll
  for (int r = 0; r < 16; ++r) p0[r] = __builtin_amdgcn_exp2f(p0[r]);
}
__device__ __forceinline__ void finishSM(f32x16& p0, f32x16& p1, float alpha, float& l_reg, bf16x8& pa0, bf16x8& pa1, bf16x8& pa2, bf16x8& pa3) {
#pragma unroll
  for (int r = 0; r < 16; ++r) p1[r] = __builtin_amdgcn_exp2f(p1[r]);
  float ps = 0;
#pragma unroll
  for (int r = 0; r < 16; ++r) ps += p0[r];
#pragma unroll
  for (int r = 0; r < 16; ++r) ps += p1[r];
  { auto rr = __builtin_amdgcn_permlane32_swap(__float_as_uint(ps), __float_as_uint(ps), false, false);
    ps = __uint_as_float(rr[0]) + __uint_as_float(rr[1]); }
  l_reg = l_reg * alpha + ps;
#define PK4(P, BASE, OUT) do { unsigned a0 = cvtpk(P[BASE + 0], P[BASE + 1]), a1 = cvtpk(P[BASE + 2], P[BASE + 3]);   \
    unsigned b0 = cvtpk(P[BASE + 4], P[BASE + 5]), b1 = cvtpk(P[BASE + 6], P[BASE + 7]);                              \
    auto r0 = __builtin_amdgcn_permlane32_swap(a0, b0, false, false); auto r1 = __builtin_amdgcn_permlane32_swap(a1, b1, false, false); \
    u32x4 w = {r0[0], r1[0], r0[1], r1[1]}; OUT = *reinterpret_cast<bf16x8*>(&w); } while (0)
  PK4(p0, 0, pa0); PK4(p0, 8, pa1); PK4(p1, 0, pa2); PK4(p1, 8, pa3);
#undef PK4
}
__device__ __forceinline__ void qkt(f32x16& p0, f32x16& p1, const char* Ks, const bf16x8* qr, const char* qpe, int r32, int hi) {
  p0 = f32x16{}; p1 = f32x16{};
#pragma unroll
  for (int d0 = 0; d0 < 12; ++d0) { int cb = (d0 * 16 + hi * 8) * 2;
    bf16x8 b0 = *reinterpret_cast<const bf16x8*>(Ks + KSWZ(r32, cb));
    bf16x8 b1 = *reinterpret_cast<const bf16x8*>(Ks + KSWZ(32 + r32, cb));
    const bf16x8 q = d0 < 8 ? qr[d0 < 8 ? d0 : 0] : *reinterpret_cast<const bf16x8*>(qpe + (d0 - 8) * 1024);
    p0 = __builtin_amdgcn_mfma_f32_32x32x16_bf16(b0, q, p0, 0, 0, 0);
    p1 = __builtin_amdgcn_mfma_f32_32x32x16_bf16(b1, q, p1, 0, 0, 0);
    if ((d0 & 3) == 3) SBAR(); }
}
__device__ __forceinline__ int v_st(int k, int c) { const int kk = (k & ~0xC) | ((k & 4) << 1) | ((k & 8) >> 1); return ((kk >> 3) * 4 + (c >> 5)) * 512 + ((kk & 7) * 32 + (c & 31)) * 2; }
__device__ __forceinline__ int v_rd_base(int lane) { return ((lane & 3) << 3) | (((lane >> 2) & 3) << 6) | (((lane >> 4) & 1) << 5) | (((lane >> 5) & 1) << 8); }
constexpr int v_rd_off(int d0, int ks, int half) { return d0 * 512 + ks * 4096 + half * 2048; }
template <int OFF> __device__ __forceinline__ s16x4 tr_read(int vb) {
  s16x4 r; asm volatile("ds_read_b64_tr_b16 %0, %1 offset:%2" : "=&v"(r) : "v"(vb), "i"(OFF) : "memory"); return r;
}
template <int D0> __device__ __forceinline__ void pv_one(f32x16& od, int vb, bf16x8 pa0, bf16x8 pa1, bf16x8 pa2, bf16x8 pa3) {
  const s16x4 l0 = tr_read<v_rd_off(D0, 0, 0)>(vb), h0 = tr_read<v_rd_off(D0, 0, 1)>(vb), l1 = tr_read<v_rd_off(D0, 1, 0)>(vb), h1 = tr_read<v_rd_off(D0, 1, 1)>(vb);
  const s16x4 l2 = tr_read<v_rd_off(D0, 2, 0)>(vb), h2 = tr_read<v_rd_off(D0, 2, 1)>(vb), l3 = tr_read<v_rd_off(D0, 3, 0)>(vb), h3 = tr_read<v_rd_off(D0, 3, 1)>(vb);
  asm volatile("s_waitcnt lgkmcnt(0)" ::: "memory"); SBAR();
#define PK(L, H) (bf16x8){L[0], L[1], L[2], L[3], H[0], H[1], H[2], H[3]}
  od = __builtin_amdgcn_mfma_f32_32x32x16_bf16(pa0, PK(l0, h0), od, 0, 0, 0);
  od = __builtin_amdgcn_mfma_f32_32x32x16_bf16(pa1, PK(l1, h1), od, 0, 0, 0);
  od = __builtin_amdgcn_mfma_f32_32x32x16_bf16(pa2, PK(l2, h2), od, 0, 0, 0);
  od = __builtin_amdgcn_mfma_f32_32x32x16_bf16(pa3, PK(l3, h3), od, 0, 0, 0);
#undef PK
}
__device__ __forceinline__ void pv_d0(f32x16* o, int vb, bf16x8 pa0, bf16x8 pa1, bf16x8 pa2, bf16x8 pa3) {
  pv_one<0>(o[0], vb, pa0, pa1, pa2, pa3); pv_one<1>(o[1], vb, pa0, pa1, pa2, pa3); pv_one<2>(o[2], vb, pa0, pa1, pa2, pa3); pv_one<3>(o[3], vb, pa0, pa1, pa2, pa3);
}

__device__ __forceinline__ void attn_unit(const bf16_t* __restrict__ Qg, const bf16_t* __restrict__ KVb, const bf16_t* __restrict__ KPE, bf16_t* __restrict__ Og,
                                          int qrow0, int h, int crow0, int lrow0, int NT, char* lds) {
  const int tid = opaque_tid(), wid = tid >> 6, lane = tid & 63, r32 = lane & 31, hi = lane >> 5;
  char* V_lds = lds; char* K_lds = lds + 2 * SHM_V;
  float* ws = (float*)(lds + 2 * SHM_V + 2 * SHM_K) + wid * 64; float* li_l = ws; float* al_l = ws + 32;
  float m_reg = -1e30f, l_reg = 0; f32x16 o[4] = {}; bf16x8 qr[8];
  char* qpe = lds + 2 * SHM_V + 2 * SHM_K + NW * 64 * 4 + wid * 4096 + lane * 16;
  const bf16_t* Qw = Qg + (size_t)(qrow0 + wid * QBLK + r32) * NQ + h * DQK + hi * 8;
#pragma unroll
  for (int d0 = 0; d0 < 8; ++d0) qr[d0] = *reinterpret_cast<const bf16x8*>(Qw + d0 * 16);
#pragma unroll
  for (int d0 = 8; d0 < 12; ++d0) *reinterpret_cast<bf16x8*>(qpe + (d0 - 8) * 1024) = *reinterpret_cast<const bf16x8*>(Qw + d0 * 16);
  const int sr = tid >> 4, sc = (tid & 15) * 8, vst0 = v_st(sr, sc), vst1 = v_st(32 + sr, sc);
  const int pr = tid >> 3, pc = (tid & 7) * 8;
  const int vb0 = (int)(uintptr_t)V_lds + v_rd_base(lane);
  bf16x8 vs0, vs1, ks0, ks1, kp;
#define TROW(j) ((j) < 4 ? crow0 + 64 * (j) : lrow0 + 64 * ((j) - 4))
#define SLOAD(j) do { const int k0_ = TROW(j); const bf16_t* kv0_ = KVb + (size_t)(k0_ + sr) * NKV + h * 256 + sc; const bf16_t* kv1_ = kv0_ + (size_t)32 * NKV; \
    vs0 = *reinterpret_cast<const bf16x8*>(kv0_ + 128); vs1 = *reinterpret_cast<const bf16x8*>(kv1_ + 128); \
    ks0 = *reinterpret_cast<const bf16x8*>(kv0_); ks1 = *reinterpret_cast<const bf16x8*>(kv1_); \
    kp = *reinterpret_cast<const bf16x8*>(KPE + (size_t)(k0_ + pr) * 64 + pc); } while (0)
#define SWRITE(b) do { *(bf16x8*)(V_lds + (b) * SHM_V + vst0) = vs0; *(bf16x8*)(V_lds + (b) * SHM_V + vst1) = vs1; \
    *(bf16x8*)(K_lds + (b) * SHM_K + KSWZ(sr, sc * 2)) = ks0; *(bf16x8*)(K_lds + (b) * SHM_K + KSWZ(32 + sr, sc * 2)) = ks1; \
    *(bf16x8*)(K_lds + (b) * SHM_K + KSWZ(pr, (128 + pc) * 2)) = kp; } while (0)
#define SWAIT() asm volatile("s_waitcnt vmcnt(0)" ::: "memory")
#define RESC(a) do { if (__any((a) < 1.f)) { if (hi == 0) al_l[r32] = (a); asm volatile("s_waitcnt lgkmcnt(0)" ::: "memory"); \
    _Pragma("unroll") for (int d = 0; d < 4; ++d) _Pragma("unroll") for (int r = 0; r < 16; ++r) o[d][r] *= al_l[crow(r, hi)]; } } while (0)
  f32x16 pA0, pA1, pB0, pB1; float mnA, mnB, alA, alB; bf16x8 pa0, pa1, pa2, pa3;
  SLOAD(0); SWAIT(); SWRITE(0); __syncthreads();
  qkt(pA0, pA1, K_lds, qr, qpe, r32, hi); partialSM(pA0, pA1, m_reg, mnA, alA);
  SLOAD(1);
  SWAIT(); SWRITE(1); __syncthreads();
  for (int j = 1; j + 1 < NT; j += 2) {
    SBAR(); qkt(pB0, pB1, K_lds + SHM_K, qr, qpe, r32, hi);
    finishSM(pA0, pA1, alA, l_reg, pa0, pa1, pa2, pa3); SBAR();
    SLOAD(j + 1); SBAR();
    pv_d0(o, vb0, pa0, pa1, pa2, pa3); partialSM(pB0, pB1, m_reg, mnB, alB);
    __syncthreads(); SWAIT(); SWRITE(0);
    RESC(alB); __syncthreads();
    SBAR(); qkt(pA0, pA1, K_lds, qr, qpe, r32, hi);
    finishSM(pB0, pB1, alB, l_reg, pa0, pa1, pa2, pa3); SBAR();
    SLOAD(j + 2); SBAR();
    pv_d0(o, vb0 + SHM_V, pa0, pa1, pa2, pa3); partialSM(pA0, pA1, m_reg, mnA, alA);
    __syncthreads(); SWAIT(); SWRITE(1);
    RESC(alA); __syncthreads();
  }
  SBAR(); qkt(pB0, pB1, K_lds + SHM_K, qr, qpe, r32, hi);
  finishSM(pA0, pA1, alA, l_reg, pa0, pa1, pa2, pa3); SBAR();
  pv_d0(o, vb0, pa0, pa1, pa2, pa3); partialSM(pB0, pB1, m_reg, mnB, alB);
  __syncthreads(); RESC(alB);
  finishSM(pB0, pB1, alB, l_reg, pa0, pa1, pa2, pa3); SBAR();
  pv_d0(o, vb0 + SHM_V, pa0, pa1, pa2, pa3);
  if (hi == 0) li_l[r32] = l_reg; asm volatile("s_waitcnt lgkmcnt(0)" ::: "memory");
  float rli[16];
#pragma unroll
  for (int r = 0; r < 16; ++r) rli[r] = __builtin_amdgcn_rcpf(li_l[crow(r, hi)]);
  bf16_t* Ow = Og + (size_t)(qrow0 + wid * QBLK) * DM + h * DV;
#pragma unroll
  for (int r = 0; r < 16; ++r) { const int orow = crow(r, hi);
#pragma unroll
    for (int d0 = 0; d0 < 4; ++d0) Ow[(size_t)orow * DM + d0 * 32 + r32] = (bf16_t)(cvtpk(o[d0][r] * rli[r], 0.f) & 0xffffu); }
  __syncthreads();
#undef TROW
#undef SLOAD
#undef SWRITE
#undef SWAIT
#undef RESC
}
#undef KSWZ
#undef SBAR
}
constexpr int NWAVES = 8;
constexpr int RING_BYTES = 131072, LDSCTL_OFF = RING_BYTES, LDS_BYTES = 147456;

struct Args {
    const float* in[31]; float* out; unsigned char* ws; int stage; int pad;
};
struct Frame {
    LAS unsigned char* lds; int vcu, G; unsigned char* ws;
};
constexpr int PTAB_OFF = 131072 + 512;
__device__ __forceinline__ const float* inp(const Frame& F, int i) {
    const LAS unsigned* t = (const LAS unsigned*)(F.lds + PTAB_OFF) + 2 * i;
    const unsigned lo = __builtin_amdgcn_readfirstlane(t[0]), hi = __builtin_amdgcn_readfirstlane(t[1]);
    return (const float*)(((unsigned long long)hi << 32) | lo);
}

__device__ __forceinline__ unsigned f2bf(float f) { unsigned u = __float_as_uint(f); return (u + 0x7fffu + ((u >> 16) & 1u)) >> 16; }
__device__ __forceinline__ unsigned pk2(float lo, float hi) { return f2bf(lo) | (f2bf(hi) << 16); }
__device__ __forceinline__ void cvt_item(const float* srcA, const float* srcB, const float* kscale, bf16_t* dst, int ld, int K, int nrows, int nvalid, int mode, int item, LAS float* scr, int lane) {
    const int nblk = nrows >> 5, kb = item / nblk, nb = item - kb * nblk, k0 = 64 * kb, n0 = 32 * nb;
    const float* src = srcA; int col = n0; bool valid = n0 < nvalid;
    if (mode == 1) { const int t = n0 >> 8, r = n0 & 255; src = r < 128 ? srcA : srcB; col = 128 * t + (r & 127); valid = true; }
#pragma unroll 8
    for (int i = 0; i < 32; ++i) { const int kk = 2 * i + (lane >> 5);
        float v = 0.f; if (valid) { v = src[(size_t)(k0 + kk) * ld + col + (lane & 31)]; if (kscale) v *= kscale[k0 + kk]; }
        scr[kk * 33 + (lane & 31)] = v; }
    asm volatile("s_waitcnt lgkmcnt(0)" ::: "memory");
    const int c = lane & 7;
#pragma unroll
    for (int j = 0; j < 4; ++j) { const int n = (lane >> 3) + 8 * j; const LAS float* s = scr + (8 * c) * 33 + n;
        u32x4 o; o.x = pk2(s[0 * 33], s[1 * 33]); o.y = pk2(s[2 * 33], s[3 * 33]); o.z = pk2(s[4 * 33], s[5 * 33]); o.w = pk2(s[6 * 33], s[7 * 33]);
        *(u32x4*)(dst + (size_t)(n0 + n) * K + k0 + 8 * c) = o; }
    asm volatile("s_waitcnt lgkmcnt(0)" ::: "memory");
}
constexpr int N_SMALL_JOBS = 11;
__device__ __forceinline__ void convert_small(const Args& a, Frame& F) {
    unsigned char* const wsl = opaque_ptr(a.ws);
    const int tid_ = opaque_tid(), lane_ = tid_ & 63, wave_ = __builtin_amdgcn_readfirstlane(tid_ >> 6);
    LAS float* scr = (LAS float*)(F.lds + wave_ * 16384);
    const int gw = F.vcu * NWAVES + wave_, NGW = F.G * NWAVES;
    unsigned char* ws = wsl;
    int base = 0;
#define SMALL_JOB(SA, SB, KS, DST, LD, KK, NR, NV, MODE) do { const int n_ = ((KK) >> 6) * ((NR) >> 5); const int first_ = ((gw - base) % NGW + NGW) % NGW; \
        for (int it = first_; it < n_; it += NGW) cvt_item(SA, SB, KS, DST, LD, KK, NR, NV, MODE, it, scr, lane_); base += n_; } while (0)
    SMALL_JOB(inp(F, 7), nullptr, nullptr, (bf16_t*)(ws + WS_WDQKV), 704, 1024, 768, 704, 0);
    SMALL_JOB(inp(F, 10), nullptr, inp(F, 8), (bf16_t*)(ws + WS_WUQ), 1536, 384, 1536, 1536, 0);
    SMALL_JOB(inp(F, 11), nullptr, inp(F, 9), (bf16_t*)(ws + WS_WUKV), 2048, 256, 2048, 2048, 0);
    SMALL_JOB(inp(F, 12), nullptr, nullptr, (bf16_t*)(ws + WS_WO), 1024, 1024, 1024, 1024, 0);
    SMALL_JOB(inp(F, 21), inp(F, 21) + 1024, nullptr, (bf16_t*)(ws + WS_WGLU), 2048, 1024, 2048, 2048, 1);
#pragma unroll 1
    for (int l = 0; l < 2; ++l) {
        SMALL_JOB(inp(F, 28) + (size_t)l * 1024 * 256, inp(F, 29) + (size_t)l * 1024 * 256, nullptr, (bf16_t*)(ws + WS_WSHR) + (size_t)l * 768 * 1024, 256, 1024, 512, 512, 1);
        SMALL_JOB(inp(F, 23) + (size_t)l * 1024 * 64, nullptr, nullptr, (bf16_t*)(ws + WS_WSHR) + (size_t)l * 768 * 1024 + (size_t)512 * 1024, 64, 1024, 256, 64, 0);
        SMALL_JOB(inp(F, 30) + (size_t)l * 256 * 1024, nullptr, nullptr, (bf16_t*)(ws + WS_WSHD) + (size_t)l * 1024 * 256, 1024, 256, 1024, 1024, 0);
    }
#undef SMALL_JOB
}
__device__ __forceinline__ void convert_experts(const Args& a, Frame& F, int layer) {
    unsigned char* const wsl = opaque_ptr(a.ws);
    const int tid_ = opaque_tid(), lane_ = tid_ & 63, wave_ = __builtin_amdgcn_readfirstlane(tid_ >> 6);
    LAS float* scr = (LAS float*)(F.lds + wave_ * 16384);
    const int gw = F.vcu * NWAVES + wave_, NGW = F.G * NWAVES;
    for (int it = gw; it < NEXP * 384; it += NGW) { const int e = it / 384, r = it - e * 384; const size_t eo = ((size_t)layer * NEXP + e) * 1024 * 256;
        if (r < 256) cvt_item(inp(F, 25) + eo, inp(F, 26) + eo, nullptr, (bf16_t*)(wsl + WS_W1) + (size_t)e * 512 * 1024, 256, 1024, 512, 512, 1, r, scr, lane_);
        else cvt_item(inp(F, 27) + eo, nullptr, nullptr, (bf16_t*)(wsl + WS_W2) + (size_t)e * 1024 * 256, 1024, 256, 1024, 1024, 0, r - 256, scr, lane_); }
}

__device__ __forceinline__ void mod_phase(const Args& a, Frame& F) {
    unsigned char* const wsl = opaque_ptr(a.ws);
    const int tid_ = opaque_tid(), lane_ = tid_ & 63, wave_ = __builtin_amdgcn_readfirstlane(tid_ >> 6);
    LAS float* sl = (LAS float*)F.lds;
    LAS float* red = sl + 17 * 1024;
    float* MOD = (float*)(wsl + WS_MOD);
    bool have = false;
    for (int u = F.vcu; u < 192; u += F.G) {
        if (!have) { for (int i = tid_; i < 17 * 1024; i += 512) { const float v = i < 16 * 1024 ? inp(F, 1)[i] : inp(F, 3)[i - 16 * 1024]; sl[i] = silu_f(v); } __syncthreads(); have = true; }
        const int l = u / 96, n0 = (u % 96) * 64, kg = tid_ >> 6, col = n0 + (tid_ & 63);
        const float* W = inp(F, 4) + (size_t)l * 1024 * MODW + col;
        float acc[17];
#pragma unroll
        for (int b = 0; b < 17; ++b) acc[b] = 0.f;
        for (int k = kg; k < 1024; k += 8) { const float w = W[(size_t)k * MODW];
#pragma unroll
            for (int b = 0; b < 17; ++b) acc[b] += sl[b * 1024 + k] * w; }
#pragma unroll
        for (int b = 0; b < 17; ++b) red[(kg * 17 + b) * 64 + (tid_ & 63)] = acc[b];
        __syncthreads();
        for (int i = tid_; i < 17 * 64; i += 512) { const int b = i >> 6, c = i & 63; float s = inp(F, 5)[(size_t)l * MODW + n0 + c];
#pragma unroll
            for (int g = 0; g < 8; ++g) s += red[(g * 17 + b) * 64 + c];
            MOD[((size_t)l * 17 + b) * MODW + n0 + c] = s; }
        __syncthreads();
    }
}
__device__ __forceinline__ void sincos_red(float ang, float& c, float& s) {
    const float k = rintf(ang * 0.15915494309189535f);
    float r = fmaf(-k, 6.2831854820251465f, ang); r = fmaf(-k, -1.7484555314695172e-07f, r);
    s = __sinf(r); c = __cosf(r);
}
__device__ __forceinline__ void rope_phase(const Args& a, Frame& F) {
    unsigned char* const wsl = opaque_ptr(a.ws);
    const int tid_ = opaque_tid(), lane_ = tid_ & 63, wave_ = __builtin_amdgcn_readfirstlane(tid_ >> 6);
    float* ROPE = (float*)(wsl + WS_ROPE);
    for (int i = (F.vcu * 512 + tid_); i < SEQL * 32; i += F.G * 512) { const int t = i >> 5, p = i & 31, j = p & 15;
        const float f = exp2f(-(float)j * (13.287712379549449f / 16.f)); const float pos = (float)(p < 16 ? (t >> 6) : (t & 63));
        float c, s; sincos_red(pos * f, c, s); ROPE[2 * i] = c; ROPE[2 * i + 1] = s; }
}

__device__ __forceinline__ const float* xrow_in(const Args& a, const Frame& F, int layer, int row) {
    unsigned char* const wsl = opaque_ptr(a.ws);
    if (layer == 0) return row < NCTXR ? inp(F, 2) + (size_t)row * DM : inp(F, 0) + (size_t)(row - NCTXR) * DM;
    return row < NCTXR ? (const float*)(wsl + WS_XCTX) + (size_t)row * DM : a.out + (size_t)(row - NCTXR) * DM;
}
__device__ __forceinline__ float* xrow_st(const Args& a, int row) {
    unsigned char* const wsl = opaque_ptr(a.ws); return row < NCTXR ? (float*)(wsl + WS_XCTX) + (size_t)row * DM : a.out + (size_t)(row - NCTXR) * DM; }
__device__ __forceinline__ void norm_mod_store(const f32x4 (&v)[4], const float* g, const float* shift, const float* scale, bf16_t* orow, int lane) {
    float s = 0.f;
#pragma unroll
    for (int j = 0; j < 4; ++j) s += sq4(v[j]);
    const float rstd = __builtin_amdgcn_rsqf(wave_sum(s) * (1.f / DM) + NORM_EPS);
#pragma unroll
    for (int j = 0; j < 4; ++j) { const int c = 4 * lane + 256 * j; const f32x4 gg = *(const f32x4*)(g + c), sh = *(const f32x4*)(shift + c), sc = *(const f32x4*)(scale + c);
        const f32x4 h = (v[j] * rstd * gg) * (sc + 1.f) + sh; u32x2 w; w.x = cvt_pk_bf16(h[0], h[1]); w.y = cvt_pk_bf16(h[2], h[3]); *(u32x2*)(orow + c) = w; }
}
__device__ __forceinline__ void h_phase(const Args& a, Frame& F, int layer, int row_lo) {
    unsigned char* const wsl = opaque_ptr(a.ws);
    const int tid_ = opaque_tid(), lane_ = tid_ & 63, wave_ = __builtin_amdgcn_readfirstlane(tid_ >> 6);
    const float* MOD = (const float*)(wsl + WS_MOD) + (size_t)layer * 17 * MODW; const float* g = inp(F, 6) + (size_t)(layer * 4 + 0) * DM; bf16_t* XN = (bf16_t*)(wsl + WS_XN);
    for (int row = row_lo + F.vcu * NWAVES + wave_; row < NROWS; row += F.G * NWAVES) {
        const float* x = xrow_in(a, F, layer, row); f32x4 v[4];
#pragma unroll
        for (int j = 0; j < 4; ++j) v[j] = *(const f32x4*)(x + 4 * lane_ + 256 * j);
        const float* m = MOD + (size_t)mod_index(row) * MODW;
        norm_mod_store(v, g, m + 0 * DM, m + 1 * DM, XN + (size_t)row * DM, lane_);
    }
}
__device__ __forceinline__ void postmix_phase(const Args& a, Frame& F, int layer, int row_lo, int NS) {
    unsigned char* const wsl = opaque_ptr(a.ws);
    const int tid_ = opaque_tid(), lane_ = tid_ & 63, wave_ = __builtin_amdgcn_readfirstlane(tid_ >> 6);
    const float* MOD = (const float*)(wsl + WS_MOD) + (size_t)layer * 17 * MODW; const float* g1 = inp(F, 6) + (size_t)(layer * 4 + 1) * DM; const float* g2 = inp(F, 6) + (size_t)(layer * 4 + 2) * DM;
    bf16_t* XN = (bf16_t*)(wsl + WS_XN); const bf16_t* OO = (const bf16_t*)(wsl + WS_OO); const float* SSQO = (const float*)(wsl + WS_SSQO);
    for (int row = row_lo + F.vcu * NWAVES + wave_; row < NROWS; row += F.G * NWAVES) {
        const float* x = xrow_in(a, F, layer, row); float* xo = xrow_st(a, row); const float* m = MOD + (size_t)mod_index(row) * MODW;
        float ss = lane_ < NS ? SSQO[(size_t)row * 32 + lane_] : 0.f; ss = wave_sum(ss);
        const float rstd = __builtin_amdgcn_rsqf(ss * (1.f / DM) + NORM_EPS);
        f32x4 v[4];
#pragma unroll
        for (int j = 0; j < 4; ++j) { const int c = 4 * lane_ + 256 * j; const u32x2 ow = *(const u32x2*)(OO + (size_t)row * DM + c);
            const f32x4 o = {bf_lo(ow.x), bf_hi(ow.x), bf_lo(ow.y), bf_hi(ow.y)}; const f32x4 gg = *(const f32x4*)(g1 + c), gt = *(const f32x4*)(m + 2 * DM + c);
            v[j] = *(const f32x4*)(x + c) + gt * (o * rstd * gg); *(f32x4*)(xo + c) = v[j]; }
        norm_mod_store(v, g2, m + 3 * DM, m + 4 * DM, XN + (size_t)row * DM, lane_);
    }
}
constexpr size_t WS_Y     = WS_ST;
constexpr size_t WS_H0    = WS_ST + 216 * MiB;
constexpr size_t WS_H1    = WS_ST + 278 * MiB;
constexpr size_t WS_HSH   = WS_ST + 340 * MiB;
constexpr size_t WS_LOG   = WS_ST + 358 * MiB;
constexpr size_t WS_SELI  = WS_ST + 367 * MiB;
constexpr size_t WS_SELW  = WS_SELI + (size_t)NROWS * 32;
constexpr size_t WS_LDST  = WS_ST + 370 * MiB;
constexpr size_t WS_LW    = WS_LDST + 1536 * 1024;
constexpr size_t WS_BLKCNT= WS_ST + 373 * MiB;
constexpr size_t WS_TINFO = WS_BLKCNT + 256 * 192 * 4;
constexpr int NLIST = 192;
static_assert(WS_TINFO + 4 * (512 + 1600) <= WS_ST + 374 * MiB, "MoE stage map");

template <int NT_, int LDA_, bool PERM_> struct DenseRow0 : DenseBase<NT_, LDA_, PERM_> { int row0; };

struct PolShr : DenseRow0<16, 2048, true> {
    bf16_t* HSH; float* LOG;
    __device__ __forceinline__ void epi(const f32x4 (&acc)[2][2][4][2], const DUnit& u, int wr, int wc, int fr, int fq) const {
#pragma unroll
        for (int ai = 0; ai < 2; ++ai)
#pragma unroll
            for (int m = 0; m < 4; ++m) {
                const int row = row0 + u.pm * 256 + ai * 128 + wr * 64 + m * 16 + fr;
                if (u.pn < 2) {
                    f32x4 h0, h1;
#pragma unroll
                    for (int j = 0; j < 4; ++j) { h0[j] = silu_f(acc[ai][0][m][0][j]) * acc[ai][1][m][0][j]; h1[j] = silu_f(acc[ai][0][m][1][j]) * acc[ai][1][m][1][j]; }
                    store8(HSH + (size_t)row * 256 + u.pn * 128 + wc * 32 + 8 * fq, h0, h1);
                } else if (wc < 2) {
                    float* lp = LOG + (size_t)row * 64 + wc * 32 + 8 * fq; *(f32x4*)lp = acc[ai][0][m][0]; *(f32x4*)(lp + 4) = acc[ai][0][m][1];
                }
            }
    }
};

__device__ __forceinline__ int slot_round(int s) { return s < 2 ? 0 : (s < 5 ? 1 : 2); }
__device__ __forceinline__ int slot_yrow(int s) { return s < 2 ? s + 1 : (s < 5 ? s - 2 : s - 5); }
__device__ __forceinline__ void route_phase(const Args& a, Frame& F, int layer, int row_lo, int tpb) {
    unsigned char* const wsl = opaque_ptr(a.ws);
    const int tid_ = opaque_tid(), lane = tid_ & 63, wave = __builtin_amdgcn_readfirstlane(tid_ >> 6);
    LAS int* cnt = (LAS int*)F.lds;
    for (int i = tid_; i < NLIST; i += 512) cnt[i] = 0;
    __syncthreads();
    const float* LOG = (const float*)(wsl + WS_LOG); int* SELI = (int*)(wsl + WS_SELI); float* SELW = (float*)(wsl + WS_SELW);
    const float bias = inp(F, 24)[layer * NEXP + lane];
    const int blk = F.vcu;
    for (int t = wave; t < tpb; t += NWAVES) {
        const int row = row_lo + blk * tpb + t;
        const float sc = sigmoid_f(LOG[(size_t)row * 64 + lane]), bs = sc + bias;
        float m1 = bs;
        m1 = fmaxf(m1, __shfl_xor(m1, 1)); m1 = fmaxf(m1, __shfl_xor(m1, 2)); m1 = fmaxf(m1, __shfl_xor(m1, 4));
        const unsigned long long eqm = __ballot(bs == m1);
        const int grp = lane >> 3; const unsigned gm = (unsigned)((eqm >> (grp * 8)) & 0xffull);
        float v2 = (bs == m1) ? -INFINITY : bs;
        v2 = fmaxf(v2, __shfl_xor(v2, 1)); v2 = fmaxf(v2, __shfl_xor(v2, 2)); v2 = fmaxf(v2, __shfl_xor(v2, 4));
        const float m2 = (__popc(gm) >= 2) ? m1 : v2;
        const float gs = m1 + m2;
        int grank = 0;
#pragma unroll
        for (int j = 0; j < 8; ++j) { const float o = __shfl(gs, j * 8); grank += (o > gs || (o == gs && j < grp)) ? 1 : 0; }
        const float mv = grank < 4 ? bs : -INFINITY;
        int rank = 0;
#pragma unroll 8
        for (int j = 0; j < 64; ++j) { const float o = __shfl(mv, j); rank += (o > mv || (o == mv && j < lane)) ? 1 : 0; }
        const bool sel = rank < TOPK && grank < 4;
        const float ssum = wave_sum(sel ? sc : 0.f);
        if (sel) { const int s = rank, l = slot_round(s) * 64 + lane;
            SELI[(size_t)row * 8 + s] = l | (slot_yrow(s) << 8); SELW[(size_t)row * 8 + s] = sc / ssum * 2.5f;
            atomicAdd((int*)&cnt[l], 1); }
    }
    __syncthreads();
    int* BLKCNT = (int*)(wsl + WS_BLKCNT);
    for (int i = tid_; i < NLIST; i += 512) BLKCNT[blk * NLIST + i] = cnt[i];
}
__device__ __forceinline__ void place_phase(const Args& a, Frame& F, int row_lo, int tpb) {
    unsigned char* const wsl = opaque_ptr(a.ws);
    const int tid_ = opaque_tid();
    LAS int* tot = (LAS int*)F.lds; LAS int* mine = tot + 256; LAS int* tst = mine + 256; LAS int* cur = tst + 256;
    const int* BLKCNT = (const int*)(wsl + WS_BLKCNT); const int blk = F.vcu;
    if (tid_ < NLIST) { int s = 0, m = 0; for (int b = 0; b < F.G; ++b) { const int c = BLKCNT[b * NLIST + tid_]; m += (b < blk) ? c : 0; s += c; } tot[tid_] = s; mine[tid_] = m; cur[tid_] = 0; }
    __syncthreads();
    if (tid_ == 0) { int acc = 0; for (int l = 0; l < NLIST; ++l) { tst[l] = acc; acc += (tot[l] + 255) >> 8; } tst[NLIST] = acc; }
    __syncthreads();
    int* TINFO = (int*)(wsl + WS_TINFO); int* LDST = (int*)(wsl + WS_LDST); float* LW = (float*)(wsl + WS_LW);
    if (blk == 0) {
        for (int i = tid_; i <= NLIST; i += 512) TINFO[i] = tst[i];
        for (int i = tid_; i < NLIST; i += 512) TINFO[256 + i] = tot[i];
        for (int l = 0; l < NLIST; ++l) { const int t0 = tst[l], t1 = tst[l + 1];
            for (int t = t0 + tid_; t < t1; t += 512) TINFO[512 + t] = l;
            const int c = tot[l], base = t0 * 256;
            for (int p = c + tid_; p < (t1 - t0) * 256; p += 512) LDST[base + p] = -1; }
    }
    const int* SELI = (const int*)(wsl + WS_SELI); const float* SELW = (const float*)(wsl + WS_SELW);
    for (int i = tid_; i < tpb * 8; i += 512) { const int row = row_lo + blk * tpb + (i >> 3), s = i & 7;
        const int v = SELI[(size_t)row * 8 + s], l = v & 0xff, yr = v >> 8;
        const int pos = tst[l] * 256 + mine[l] + atomicAdd((int*)&cur[l], 1);
        LDST[pos] = row * 3 + yr; LW[pos] = SELW[(size_t)row * 8 + s]; }
}

struct MUnit { int T, pn; };
struct PolMoe1 {
    static constexpr bool PERM = true, GATHER = true, TWOSEG = false;
    static constexpr int NT = 16, KT0 = 16, KS0 = 128, KS1 = 128, LDB = 2048;
    typedef MUnit Unit;
    const char* XN; const char* W1; bf16_t* H; const int* TINFO; const int* LDST; int T0, T1, G, c;
    __device__ __forceinline__ bool next(int i, Unit& u) const { const int L = i * G + c; u.T = T0 + (L >> 1); u.pn = L & 1; return u.T < T1; }
    __device__ __forceinline__ void ctx(const Unit& u, pg8::UCtx<true>& x, const int (&R)[2], const int (&C)[2]) const {
        const int e = __builtin_amdgcn_readfirstlane(TINFO[512 + u.T]) & 63;
        x.a0[0] = XN; x.a0[1] = XN; x.a1[0] = XN; x.a1[1] = XN; x.b = W1 + ((size_t)e * 512 + u.pn * 256) * LDB;
#pragma unroll
        for (int h = 0; h < 2; ++h)
#pragma unroll
            for (int i = 0; i < 2; ++i) { const int d = LDST[u.T * 256 + h * 128 + R[i]]; const int tok = d < 0 ? 0 : d / 3; x.vg[h][i] = (unsigned)tok * 2048u + (unsigned)C[i] * 2u; }
    }
    __device__ __forceinline__ unsigned lane_a0(int, int) const { return 0u; }
    __device__ __forceinline__ unsigned lane_a1(int, int) const { return 0u; }
    __device__ __forceinline__ void epi(const f32x4 (&acc)[2][2][4][2], const Unit& u, int wr, int wc, int fr, int fq) const {
#pragma unroll
        for (int ai = 0; ai < 2; ++ai)
#pragma unroll
            for (int m = 0; m < 4; ++m) {
                const int hrow = (u.T - T0) * 256 + ai * 128 + wr * 64 + m * 16 + fr;
                f32x4 h0, h1;
#pragma unroll
                for (int j = 0; j < 4; ++j) { h0[j] = silu_f(acc[ai][0][m][0][j]) * acc[ai][1][m][0][j]; h1[j] = silu_f(acc[ai][0][m][1][j]) * acc[ai][1][m][1][j]; }
                store8(H + (size_t)hrow * 256 + u.pn * 128 + wc * 32 + 8 * fq, h0, h1);
            }
    }
};
template <bool RMW> struct PolMoe2 {
    static constexpr bool PERM = true, GATHER = false, TWOSEG = false;
    static constexpr int NT = 4, KT0 = 4, KS0 = 128, KS1 = 128, LDB = 512;
    typedef MUnit Unit;
    const char* H; const char* W2; bf16_t* Y; const int* TINFO; const int* LDST; const float* LW; int T0, T1, G, c;
    __device__ __forceinline__ bool next(int i, Unit& u) const { const int L = i * G + c; u.T = T0 + (L >> 2); u.pn = L & 3; return u.T < T1; }
    __device__ __forceinline__ void ctx(const Unit& u, pg8::UCtx<false>& x, const int (&)[2], const int (&)[2]) const {
        const int e = __builtin_amdgcn_readfirstlane(TINFO[512 + u.T]) & 63;
        x.a0[0] = H + (size_t)(u.T - T0) * 256 * 512; x.a0[1] = x.a0[0] + 128 * 512; x.a1[0] = x.a0[0]; x.a1[1] = x.a0[1];
        x.b = W2 + ((size_t)e * 1024 + u.pn * 256) * LDB;
    }
    __device__ __forceinline__ unsigned lane_a0(int R, int C) const { return (unsigned)(R * 512 + C * 2); }
    __device__ __forceinline__ unsigned lane_a1(int, int) const { return 0u; }
    __device__ __forceinline__ void epi(const f32x4 (&acc)[2][2][4][2], const Unit& u, int wr, int wc, int fr, int fq) const {
#pragma unroll
        for (int ai = 0; ai < 2; ++ai)
#pragma unroll
            for (int m = 0; m < 4; ++m) {
                const int lp = u.T * 256 + ai * 128 + wr * 64 + m * 16 + fr;
                const int d = LDST[lp]; const float w = LW[lp];
                if (d >= 0) {
                    bf16_t* yp = Y + (size_t)d * DM + u.pn * 256 + wc * 32 + 8 * fq;
#pragma unroll
                    for (int bj = 0; bj < 2; ++bj) {
                        f32x4 v0 = acc[ai][bj][m][0] * w, v1 = acc[ai][bj][m][1] * w;
                        if (RMW) { const u32x4 o = *(const u32x4*)(yp + bj * 128);
                            v0 += (f32x4){bf_lo(o.x), bf_hi(o.x), bf_lo(o.y), bf_hi(o.y)}; v1 += (f32x4){bf_lo(o.z), bf_hi(o.z), bf_lo(o.w), bf_hi(o.w)}; }
                        store8(yp + bj * 128, v0, v1);
                    }
                }
            }
    }
};
struct PolShd : DenseRow0<4, 512, true> {
    bf16_t* Y;
    __device__ __forceinline__ void epi(const f32x4 (&acc)[2][2][4][2], const DUnit& u, int wr, int wc, int fr, int fq) const {
#pragma unroll
        for (int ai = 0; ai < 2; ++ai)
#pragma unroll
            for (int m = 0; m < 4; ++m) {
                const int row = row0 + u.pm * 256 + ai * 128 + wr * 64 + m * 16 + fr;
                bf16_t* yp = Y + (size_t)row * 3 * DM + u.pn * 256 + wc * 32 + 8 * fq;
                store8(yp, acc[ai][0][m][0], acc[ai][0][m][1]); store8(yp + 128, acc[ai][1][m][0], acc[ai][1][m][1]);
            }
    }
};

__device__ __forceinline__ void combine_phase(const Args& a, Frame& F, int layer, int row_lo) {
    unsigned char* const wsl = opaque_ptr(a.ws);
    const int tid_ = opaque_tid(), lane_ = tid_ & 63, wave_ = __builtin_amdgcn_readfirstlane(tid_ >> 6);
    const float* MOD = (const float*)(wsl + WS_MOD) + (size_t)layer * 17 * MODW; const float* g3 = inp(F, 6) + (size_t)(layer * 4 + 3) * DM;
    const float* MODn = (const float*)(wsl + WS_MOD) + (size_t)1 * 17 * MODW; const float* gn = inp(F, 6) + (size_t)(1 * 4 + 0) * DM;
    bf16_t* XN = (bf16_t*)(wsl + WS_XN); const bf16_t* Y = (const bf16_t*)(wsl + WS_Y);
    for (int row = row_lo + F.vcu * NWAVES + wave_; row < NROWS; row += F.G * NWAVES) {
        float* xo = xrow_st(a, row); const float* m = MOD + (size_t)mod_index(row) * MODW;
        f32x4 f[4]; float ss = 0.f;
#pragma unroll
        for (int j = 0; j < 4; ++j) { const int c = 4 * lane_ + 256 * j; f[j] = (f32x4){0.f, 0.f, 0.f, 0.f};
#pragma unroll
            for (int r = 0; r < 3; ++r) { const u32x2 w = *(const u32x2*)(Y + ((size_t)row * 3 + r) * DM + c); f[j] += (f32x4){bf_lo(w.x), bf_hi(w.x), bf_lo(w.y), bf_hi(w.y)}; }
            ss += sq4(f[j]); }
        const float rstd = __builtin_amdgcn_rsqf(wave_sum(ss) * (1.f / DM) + NORM_EPS);
        f32x4 v[4];
#pragma unroll
        for (int j = 0; j < 4; ++j) { const int c = 4 * lane_ + 256 * j; const f32x4 gg = *(const f32x4*)(g3 + c), gt = *(const f32x4*)(m + 5 * DM + c);
            v[j] = *(const f32x4*)(xo + c) + gt * (f[j] * rstd * gg); *(f32x4*)(xo + c) = v[j]; }
        if (layer == 0) { const float* mn = MODn + (size_t)mod_index(row) * MODW; norm_mod_store(v, gn, mn + 0 * DM, mn + 1 * DM, XN + (size_t)row * DM, lane_); }
    }
}
constexpr size_t WS_G    = WS_ST;
constexpr size_t WS_BTY  = WS_ST + 216 * MiB;
constexpr size_t WS_BTS  = WS_ST + 264 * MiB;
constexpr size_t WS_S    = WS_ST + 280 * MiB;
constexpr size_t WS_XIN  = WS_ST + 64 * MiB;
constexpr size_t WS_LAMT = WS_ROPE + 512 * 1024;
constexpr int S5_T = 32;

__device__ __forceinline__ f32x2 cmul(f32x2 a, f32x2 b) { return (f32x2){a.x * b.x - a.y * b.y, a.x * b.y + a.y * b.x}; }
__device__ __forceinline__ void s5_tables_group(const Args& a, Frame& F, int g) {
    unsigned char* const wsl = opaque_ptr(a.ws);
    const int tid = opaque_tid();
    LAS float* Kd = (LAS float*)F.lds; LAS f32x2* pw = (LAS f32x2*)(F.lds + 65536); LAS f32x2* bb = pw + 33 * 64; LAS f32x2* cm = bb + 64 * 16;
    bf16_t* BTY = (bf16_t*)(wsl + WS_BTY) + (size_t)g * 512 * 768; bf16_t* BTS = (bf16_t*)(wsl + WS_BTS) + (size_t)g * 256 * 512; float* LAMT = (float*)(wsl + WS_LAMT);
    const float* lre = inp(F, 13); const float* lim = inp(F, 14); const float* lst = inp(F, 15);
    const float* bre = inp(F, 16); const float* bim = inp(F, 17); const float* cre = inp(F, 18); const float* cim = inp(F, 19); const float* dsk = inp(F, 20);
    for (int d = 0; d < 2; ++d) {
        __syncthreads();
        const float step = __expf(lst[d * 64 + g]);
        for (int i = tid; i < 33 * 64; i += 512) { const int k = i >> 6, p = i & 63; const float lr = lre[(d * 64 + g) * 64 + p], li = lim[(d * 64 + g) * 64 + p];
            const float mag = __expf((float)k * lr * step); float c, s; sincos_red((float)k * (li * step), c, s); pw[i] = (f32x2){mag * c, mag * s}; }
        __syncthreads();
        for (int i = tid; i < 64 * 16; i += 512) { const int p = i >> 4; const float lr = lre[(d * 64 + g) * 64 + p], li = lim[(d * 64 + g) * 64 + p];
            const f32x2 lb = pw[64 + p]; const float inv = 1.f / (lr * lr + li * li);
            const f32x2 kap = {((lb.x - 1.f) * lr + lb.y * li) * inv, (lb.y * lr - (lb.x - 1.f) * li) * inv};
            const size_t o = ((size_t)(d * 64 + g) * 64 + p) * 16 + (i & 15); bb[i] = cmul(kap, (f32x2){bre[o], bim[o]}); }
        for (int i = tid; i < 16 * 64; i += 512) { const size_t o = (size_t)(d * 64 + g) * 1024 + i; cm[i] = (f32x2){cre[o], cim[o]}; }
        __syncthreads();
        if (tid < 64) { const f32x2 l32 = pw[32 * 64 + tid]; LAMT[((d * 64 + g) * 64 + tid) * 2] = l32.x; LAMT[((d * 64 + g) * 64 + tid) * 2 + 1] = l32.y; }
        for (int o = tid; o < 32 * 256; o += 512) { const int k = o >> 8, i = (o >> 4) & 15, j = o & 15; float acc = 0.f;
            for (int p = 0; p < 64; ++p) { const f32x2 t = cmul(cm[i * 64 + p], pw[k * 64 + p]); const f32x2 b = bb[p * 16 + j]; acc += t.x * b.x - t.y * b.y; }
            Kd[d * 8192 + o] = acc; }
        for (int o = tid; o < 512 * 64; o += 512) { const int n = o >> 6, p = o & 63, to = n >> 4, i = n & 15;
            const f32x2 w = cmul(cm[i * 64 + p], pw[(d == 0 ? to + 1 : 32 - to) * 64 + p]);
            *(unsigned*)(BTY + (size_t)n * 768 + 512 + 128 * d + 2 * p) = cvt_pk_bf16(w.x, -w.y); }
        for (int o = tid; o < 64 * 256; o += 512) { const int p = o >> 8, kk = (o & 255) * 2, ti = kk >> 4, j = kk & 15;
            const f32x2 pwv = pw[(d == 0 ? 31 - ti : ti) * 64 + p]; const f32x2 v0 = cmul(pwv, bb[p * 16 + j]), v1 = cmul(pwv, bb[p * 16 + j + 1]);
            *(unsigned*)(BTS + (size_t)(128 * d + 2 * p) * 512 + kk) = cvt_pk_bf16(v0.x, v1.x); *(unsigned*)(BTS + (size_t)(128 * d + 2 * p + 1) * 512 + kk) = cvt_pk_bf16(v0.y, v1.y); }
    }
    __syncthreads();
    for (int o = tid; o < 512 * 256; o += 512) { const int n = o >> 8, kk = (o & 255) * 2, to = n >> 4, i = n & 15, ti = kk >> 4, j = kk & 15;
        float v0, v1;
        if (to > ti) { v0 = Kd[(to - ti) * 256 + i * 16 + j]; v1 = Kd[(to - ti) * 256 + i * 16 + j + 1]; }
        else if (to < ti) { v0 = Kd[8192 + (ti - to) * 256 + i * 16 + j]; v1 = Kd[8192 + (ti - to) * 256 + i * 16 + j + 1]; }
        else { v0 = Kd[i * 16 + j] + Kd[8192 + i * 16 + j] + (i == j ? dsk[g * 16 + i] : 0.f); v1 = Kd[i * 16 + j + 1] + Kd[8192 + i * 16 + j + 1] + (i == j + 1 ? dsk[g * 16 + i] : 0.f); }
        *(unsigned*)(BTY + (size_t)n * 768 + kk) = cvt_pk_bf16(v0, v1); }
    __syncthreads();
}
__device__ __forceinline__ void s5_tables_phase(const Args& a, Frame& F) {
    unsigned char* const wsl = opaque_ptr(a.ws); for (int g = F.vcu; g < 64; g += F.G) s5_tables_group(a, F, g); }

struct SUnit { int g, pm, pn; };
struct PolS5S {
    static constexpr bool PERM = false, GATHER = false, TWOSEG = false;
    static constexpr int NT = 8, KT0 = 8, KS0 = 8192, KS1 = 128, LDB = 1024;
    typedef SUnit Unit;
    const char* XN; const char* BTS; float* S; int G, c;
    __device__ __forceinline__ bool next(int i, Unit& u) const { const int L = i * G + c; u.g = __builtin_amdgcn_readfirstlane(L / 5); u.pm = __builtin_amdgcn_readfirstlane(L % 5); u.pn = 0; return L < 320; }
    __device__ __forceinline__ void ctx(const Unit& u, pg8::UCtx<false>& x, const int (&)[2], const int (&)[2]) const {
        if (u.pm < 4) { x.a0[0] = XN + ((size_t)NCTXR + (size_t)u.pm * 256 * S5_T) * 2048 + u.g * 32; x.a0[1] = x.a0[0] + (size_t)128 * S5_T * 2048; }
        else { x.a0[0] = XN + u.g * 32; x.a0[1] = x.a0[0]; }
        x.a1[0] = x.a0[0]; x.a1[1] = x.a0[1]; x.b = BTS + (size_t)u.g * 256 * LDB;
    }
    __device__ __forceinline__ unsigned lane_a0(int R, int C) const { return (unsigned)(R * (S5_T * 2048) + (C >> 4) * 2048 + (C & 15) * 2); }
    __device__ __forceinline__ unsigned lane_a1(int, int) const { return 0u; }
    __device__ __forceinline__ void epi(const f32x4 (&acc)[2][2][4][2], const Unit& u, int wr, int wc, int fr, int fq) const {
#pragma unroll
        for (int ai = 0; ai < 2; ++ai) { if (u.pm == 4 && ai == 1) continue;
#pragma unroll
            for (int m = 0; m < 4; ++m) { const int r = u.pm * 256 + ai * 128 + wr * 64 + m * 16 + fr;
                float* sp = S + ((size_t)u.g * 1152 + r) * 256 + wc * 32 + 4 * fq;
#pragma unroll
                for (int bj = 0; bj < 2; ++bj)
#pragma unroll
                    for (int n = 0; n < 2; ++n) *(f32x4*)(sp + bj * 128 + n * 16) = acc[ai][bj][m][n]; } }
    }
};
__device__ __forceinline__ void s5_scan_phase(const Args& a, Frame& F) {
    unsigned char* const wsl = opaque_ptr(a.ws);
    const int tid = opaque_tid(); const float* S = (const float*)(wsl + WS_S); bf16_t* XIN = (bf16_t*)(wsl + WS_XIN); const float* LAMT = (const float*)(wsl + WS_LAMT);
    for (int idx = F.vcu * 512 + tid; idx < 64 * 16 * 2 * 64; idx += F.G * 512) {
        const int p = idx & 63, d = (idx >> 6) & 1, b = (idx >> 7) & 15, g = idx >> 11;
        const f32x2 Lm = *(const f32x2*)(LAMT + ((d * 64 + g) * 64 + p) * 2);
        const float* Sg = S + (size_t)g * 1152 * 256 + d * 128 + 2 * p; const int col = d * 128 + 2 * p; bf16_t* Xg = XIN + (size_t)(col >> 4) * 1024 + 16 * g + (col & 15);
        f32x2 x = {0.f, 0.f};
        f32x2 sv[8];
#pragma unroll
        for (int k = 0; k < 8; ++k) { const int c = d == 0 ? k : 7 - k; sv[k] = *(const f32x2*)(Sg + (size_t)(1024 + b * 8 + c) * 256); }
#pragma unroll
        for (int k = 0; k < 8; ++k) x = cmul(Lm, x) + sv[k];
        for (int c0 = 0; c0 < 64; c0 += 8) {
#pragma unroll
            for (int k = 0; k < 8; ++k) { const int c = d == 0 ? c0 + k : 63 - c0 - k; sv[k] = *(const f32x2*)(Sg + (size_t)(b * 64 + c) * 256); }
#pragma unroll
            for (int k = 0; k < 8; ++k) { const int c = d == 0 ? c0 + k : 63 - c0 - k; *(unsigned*)(Xg + (size_t)(b * 64 + c) * 32 * 1024) = cvt_pk_bf16(x.x, x.y); x = cmul(Lm, x) + sv[k]; }
        }
    }
}
struct PolS5Y {
    static constexpr bool PERM = true, GATHER = false, TWOSEG = true;
    static constexpr int NT = 12, KT0 = 8, KS0 = 8192, KS1 = 8192, LDB = 1536;
    typedef SUnit Unit;
    const char* XN; const char* XIN; const char* BTY; bf16_t* Gb; int G, c;
    __device__ __forceinline__ bool next(int i, Unit& u) const { const int L = i * G + c; u.g = __builtin_amdgcn_readfirstlane(L >> 3); u.pm = __builtin_amdgcn_readfirstlane((L >> 1) & 3); u.pn = L & 1; return L < 512; }
    __device__ __forceinline__ void ctx(const Unit& u, pg8::UCtx<false>& x, const int (&)[2], const int (&)[2]) const {
        x.a0[0] = XN + ((size_t)NCTXR + (size_t)u.pm * 256 * S5_T) * 2048 + u.g * 32; x.a0[1] = x.a0[0] + (size_t)128 * S5_T * 2048;
        x.a1[0] = XIN + (size_t)u.pm * 256 * S5_T * 2048 + u.g * 32; x.a1[1] = x.a1[0] + (size_t)128 * S5_T * 2048;
        x.b = BTY + ((size_t)u.g * 512 + u.pn * 256) * LDB;
    }
    __device__ __forceinline__ unsigned lane_a0(int R, int C) const { return (unsigned)(R * (S5_T * 2048) + (C >> 4) * 2048 + (C & 15) * 2); }
    __device__ __forceinline__ void epi(const f32x4 (&acc)[2][2][4][2], const Unit& u, int wr, int wc, int fr, int fq) const {
#pragma unroll
        for (int ai = 0; ai < 2; ++ai)
#pragma unroll
            for (int m = 0; m < 4; ++m) { const int r = u.pm * 256 + ai * 128 + wr * 64 + m * 16 + fr;
#pragma unroll
                for (int bj = 0; bj < 2; ++bj) { const int col = u.pn * 256 + bj * 128 + wc * 32 + 8 * fq, to = col >> 4, i0 = col & 15;
                    bf16_t* gp = Gb + ((size_t)r * S5_T + to) * DM + u.g * 16 + i0;
#pragma unroll
                    for (int n = 0; n < 2; ++n) { f32x4 v;
#pragma unroll
                        for (int j = 0; j < 4; ++j) v[j] = gelu_tanh(acc[ai][bj][m][n][j]);
                        u32x2 w; w.x = cvt_pk_bf16(v[0], v[1]); w.y = cvt_pk_bf16(v[2], v[3]); *(u32x2*)(gp + 4 * n) = w; asm volatile("" ::: "memory"); } } }
    }
};
struct PolGlu : DenseRow0<16, 2048, true> {
    bf16_t* OO; float* SSQO; const float* bias;
    __device__ __forceinline__ void epi(const f32x4 (&acc)[2][2][4][2], const DUnit& u, int wr, int wc, int fr, int fq) const {
        const int c0 = u.pn * 128 + wc * 32 + 8 * fq;
        const f32x4 b10 = *(const f32x4*)(bias + c0), b11 = *(const f32x4*)(bias + c0 + 4), b20 = *(const f32x4*)(bias + 1024 + c0), b21 = *(const f32x4*)(bias + 1024 + c0 + 4);
#pragma unroll
        for (int ai = 0; ai < 2; ++ai)
#pragma unroll
            for (int m = 0; m < 4; ++m) {
                const int row = row0 + u.pm * 256 + ai * 128 + wr * 64 + m * 16 + fr;
                f32x4 o0, o1;
#pragma unroll
                for (int j = 0; j < 4; ++j) { o0[j] = (acc[ai][0][m][0][j] + b10[j]) * sigmoid_f(acc[ai][1][m][0][j] + b20[j]); o1[j] = (acc[ai][0][m][1][j] + b11[j]) * sigmoid_f(acc[ai][1][m][1][j] + b21[j]); }
                float s = sq4(o0) + sq4(o1);
                store8(OO + (size_t)row * DM + c0, o0, o1);
                s += __shfl_xor(s, 16); s += __shfl_xor(s, 32);
                if (fq == 0) SSQO[(size_t)row * 32 + u.pn * 4 + wc] = s;
            }
    }
};
__device__ __forceinline__ void moe_stage(const Args& args, Frame& F, const XcdBarrier& bar, int layer, int row_lo) {
    const int nrows = NROWS - row_lo, tpb = nrows / F.G;
    {   unsigned char* ws = opaque_ptr(args.ws);
        PolShr p; p.A = (const char*)(ws + WS_XN) + (size_t)row_lo * 2048; p.Bt = (const char*)(ws + WS_WSHR) + (size_t)layer * 768 * 2048; p.nM = nrows / 256; p.nN = 3; p.G = F.G; p.c = (int)blockIdx.x;
        p.row0 = row_lo; p.HSH = (bf16_t*)(ws + WS_HSH); p.LOG = (float*)(ws + WS_LOG);
        pg8::gemm_phase(F.lds, p);
    }
    if (layer == 1 && args.stage == 7) return;
    xcd_barrier(bar);
    route_phase(args, F, layer, row_lo, tpb);
    if (layer == 1 && args.stage == 8) return;
    xcd_barrier(bar);
    place_phase(args, F, row_lo, tpb);
    if (layer == 1 && args.stage == 9) return;
    xcd_barrier(bar);
    const int* TINFO = (const int*)(opaque_ptr(args.ws) + WS_TINFO);
    const int ts0 = __builtin_amdgcn_readfirstlane(TINFO[0]), ts1 = __builtin_amdgcn_readfirstlane(TINFO[64]), ts2 = __builtin_amdgcn_readfirstlane(TINFO[128]), ts3 = __builtin_amdgcn_readfirstlane(TINFO[192]);
#define MOE_G1(TA, TB, HBUF) do { unsigned char* ws = opaque_ptr(args.ws); PolMoe1 p; p.XN = (const char*)(ws + WS_XN); p.W1 = (const char*)(ws + WS_W1); p.H = (bf16_t*)(ws + (HBUF)); p.TINFO = (const int*)(ws + WS_TINFO); p.LDST = (const int*)(ws + WS_LDST); p.T0 = (TA); p.T1 = (TB); p.G = F.G; p.c = (int)blockIdx.x; \
        pg8::gemm_phase(F.lds, p); } while (0)
#define MOE_G2(RMW, TA, TB, HBUF) do { unsigned char* ws = opaque_ptr(args.ws); PolMoe2<RMW> p; p.H = (const char*)(ws + (HBUF)); p.W2 = (const char*)(ws + WS_W2); p.Y = (bf16_t*)(ws + WS_Y); p.TINFO = (const int*)(ws + WS_TINFO); p.LDST = (const int*)(ws + WS_LDST); p.LW = (const float*)(ws + WS_LW); p.T0 = (TA); p.T1 = (TB); p.G = F.G; p.c = (int)blockIdx.x; \
        pg8::gemm_phase(F.lds, p); } while (0)
    MOE_G1(ts0, ts1, WS_H0);
    if (layer == 1 && args.stage == 10) return;
    xcd_barrier(bar);
    MOE_G2(false, ts0, ts1, WS_H0);
    {   unsigned char* ws = opaque_ptr(args.ws);
        PolShd p; p.A = (const char*)(ws + WS_HSH) + (size_t)row_lo * 512; p.Bt = (const char*)(ws + WS_WSHD) + (size_t)layer * 1024 * 512; p.nM = nrows / 256; p.nN = 4; p.G = F.G; p.c = (int)blockIdx.x;
        p.row0 = row_lo; p.Y = (bf16_t*)(ws + WS_Y);
        pg8::gemm_phase(F.lds, p);
    }
    MOE_G1(ts1, ts2, WS_H1);
    if (layer == 1 && args.stage == 11) return;
    xcd_barrier(bar);
    MOE_G2(true, ts1, ts2, WS_H1);
    MOE_G1(ts2, ts3, WS_H0);
    if (layer == 1 && args.stage == 12) return;
    xcd_barrier(bar);
    MOE_G2(true, ts2, ts3, WS_H0);
    if (layer == 1 && args.stage == 13) return;
    xcd_barrier(bar);
    if (layer == 0) { convert_experts(args, F, 1); s5_tables_phase(args, F); }
    combine_phase(args, F, layer, row_lo);
#undef MOE_G1
#undef MOE_G2
}

__global__ void __launch_bounds__(NWAVES * 64, 2) trunk_fwd(Args args) {
    extern __shared__ __attribute__((aligned(16))) unsigned char lds_raw[];
    Frame F;
    F.lds = (LAS unsigned char*)lds_raw;
    F.G = gridDim.x; { const int bx = blockIdx.x; F.vcu = (F.G % 8 == 0) ? (bx % 8) * (F.G / 8) + bx / 8 : bx; }
    F.ws = args.ws;
    volatile LAS unsigned* MISC = (volatile LAS unsigned*)(F.lds + LDSCTL_OFF);
    for (int u = threadIdx.x; u < (LDS_BYTES - LDSCTL_OFF) / 4; u += NWAVES * 64) ((LAS unsigned*)(F.lds + LDSCTL_OFF))[u] = 0u;
    __syncthreads();
    if (threadIdx.x < 31) ((LAS unsigned long long*)(F.lds + PTAB_OFF))[threadIdx.x] = (unsigned long long)args.in[threadIdx.x];
    __syncthreads();
    XcdBarrier bar = xcd_barrier_post((unsigned*)(args.ws + WS_CTL) + CW_BAR, MISC + 8);
#define GRID_BAR() xcd_barrier(bar)

    mod_phase(args, F);
    __syncthreads();
    convert_small(args, F);
    rope_phase(args, F);
    convert_experts(args, F, 0);
    GRID_BAR();
    h_phase(args, F, 0, 0);
    GRID_BAR();
    {   unsigned char* ws = opaque_ptr(args.ws);
        PolDqkv p; p.A = (const char*)(ws + WS_XN); p.Bt = (const char*)(ws + WS_WDQKV); p.nM = NROWS / 256; p.nN = 3; p.G = F.G; p.c = (int)blockIdx.x;
        p.A1 = (bf16_t*)(ws + WS_A1); p.SSQ1 = (float*)(ws + WS_SSQ1); p.KPE = (bf16_t*)(ws + WS_KPE); p.ROPE = (const float*)(ws + WS_ROPE);
        pg8::gemm_phase(F.lds, p);
    }
    GRID_BAR();
    {   unsigned char* ws = opaque_ptr(args.ws);
        PolQup p; p.A = (const char*)(ws + WS_A1); p.Bt = (const char*)(ws + WS_WUQ); p.nM = NROWS / 256; p.nN = NQ / 256; p.G = F.G; p.c = (int)blockIdx.x;
        p.Q = (bf16_t*)(ws + WS_Q); p.SSQ1 = (const float*)(ws + WS_SSQ1); p.ROPE = (const float*)(ws + WS_ROPE);
        pg8::gemm_phase(F.lds, p);
    }
    {   unsigned char* ws = opaque_ptr(args.ws);
        PolKVup p; p.A = (const char*)(ws + WS_A1) + QLORA * 2; p.Bt = (const char*)(ws + WS_WUKV); p.nM = NROWS / 256; p.nN = NKV / 256; p.G = F.G; p.c = (int)blockIdx.x;
        p.KV = (bf16_t*)(ws + WS_KV); p.SSQ1 = (const float*)(ws + WS_SSQ1);
        pg8::gemm_phase(F.lds, p);
    }
    GRID_BAR();
    {   unsigned char* ws = opaque_ptr(args.ws);
        const bf16_t* Qg = (const bf16_t*)(ws + WS_Q); const bf16_t* KVb = (const bf16_t*)(ws + WS_KV); const bf16_t* KPE = (const bf16_t*)(ws + WS_KPE); bf16_t* Og = (bf16_t*)(ws + WS_O);
        for (int u = F.vcu; u < 1024 + 128; u += F.G) {
            if (u < 1024) { const int bh = u >> 3, qb = u & 7, b = bh >> 3, h = bh & 7;
                attn::attn_unit(Qg, KVb, KPE, Og, NCTXR + b * SEQL + qb * 256, h, b * NCTX, NCTXR + b * SEQL, 36, (char*)lds_raw); }
            else { const int bh = u - 1024, b = bh >> 3, h = bh & 7;
                attn::attn_unit(Qg, KVb, KPE, Og, b * NCTX, h, b * NCTX, 0, 4, (char*)lds_raw); }
        }
    }
    GRID_BAR();
    {   unsigned char* ws = opaque_ptr(args.ws);
        PolWo p; p.A = (const char*)(ws + WS_O); p.Bt = (const char*)(ws + WS_WO); p.nM = NROWS / 256; p.nN = 4; p.G = F.G; p.c = (int)blockIdx.x;
        p.OO = (bf16_t*)(ws + WS_OO); p.SSQO = (float*)(ws + WS_SSQO);
        pg8::gemm_phase(F.lds, p);
    }
    GRID_BAR();
    postmix_phase(args, F, 0, 0, 16);
    GRID_BAR();
    moe_stage(args, F, bar, 0, 0);
    if (args.stage == 1) return;
    GRID_BAR();
    {   unsigned char* ws = opaque_ptr(args.ws);
        PolS5S p; p.XN = (const char*)(ws + WS_XN); p.BTS = (const char*)(ws + WS_BTS); p.S = (float*)(ws + WS_S); p.G = F.G; p.c = (int)blockIdx.x;
        pg8::gemm_phase(F.lds, p);
    }
    if (args.stage == 2) return;
    GRID_BAR();
    s5_scan_phase(args, F);
    if (args.stage == 3) return;
    GRID_BAR();
    {   unsigned char* ws = opaque_ptr(args.ws);
        PolS5Y p; p.XN = (const char*)(ws + WS_XN); p.XIN = (const char*)(ws + WS_XIN); p.BTY = (const char*)(ws + WS_BTY); p.Gb = (bf16_t*)(ws + WS_G); p.G = F.G; p.c = (int)blockIdx.x;
        pg8::gemm_phase(F.lds, p);
    }
    if (args.stage == 4) return;
    GRID_BAR();
    {   unsigned char* ws = opaque_ptr(args.ws);
        PolGlu p; p.A = (const char*)(ws + WS_G); p.Bt = (const char*)(ws + WS_WGLU); p.nM = NLATR / 256; p.nN = 8; p.G = F.G; p.c = (int)blockIdx.x;
        p.row0 = NCTXR; p.OO = (bf16_t*)(ws + WS_OO); p.SSQO = (float*)(ws + WS_SSQO); p.bias = inp(F, 22);
        pg8::gemm_phase(F.lds, p);
    }
    if (args.stage == 5) return;
    GRID_BAR();
    postmix_phase(args, F, 1, NCTXR, 32);
    if (args.stage == 6) return;
    GRID_BAR();
    moe_stage(args, F, bar, 1, NCTXR);
}

#ifndef DBG_STAGE
#define DBG_STAGE 0
#endif
extern "C" void kernel_launch(void* const* d_in, const int* in_sizes, int n_in, void* d_out, int out_size, void* d_ws, size_t ws_size, hipStream_t stream) {
    static int grid = 0;
    if (grid == 0) {
        if (n_in != 31 || out_size != NLATR * DM || ws_size < WS_END) { fprintf(stderr, "kernel_launch: unexpected shapes (n_in %d out %d ws %zu)\n", n_in, out_size, ws_size); grid = -1; return; }
        int dev = 0, cus = 0;
        if (hipGetDevice(&dev) != hipSuccess || hipDeviceGetAttribute(&cus, hipDeviceAttributeMultiprocessorCount, dev) != hipSuccess) { grid = -1; return; }
        if (hipFuncSetAttribute((const void*)trunk_fwd, hipFuncAttributeMaxDynamicSharedMemorySize, LDS_BYTES) != hipSuccess) { fprintf(stderr, "kernel_launch: hipFuncSetAttribute failed\n"); grid = -1; return; }
        (void)hipGetLastError();
        grid = cus;
    }
    if (grid < 0) return;
    (void)hipMemsetAsync((char*)d_ws + WS_CTL, 0, CTL_BYTES, stream);
    Args a{};
    for (int i = 0; i < 31; ++i) a.in[i] = (const float*)d_in[i];
    a.out = (float*)d_out; a.ws = (unsigned char*)d_ws; a.stage = DBG_STAGE; a.pad = 0;
    hipLaunchKernelGGL(trunk_fwd, dim3(grid), dim3(NWAVES * 64), LDS_BYTES, stream, a);
}
```

```cpp
#include <hip/hip_runtime.h>
#include <cstdio>
#include <cstdint>

#define GAS __attribute__((address_space(1)))
#define LAS __attribute__((address_space(3)))
typedef unsigned short bf16_t;
typedef short bf16x8 __attribute__((ext_vector_type(8)));
typedef short s16x4 __attribute__((ext_vector_type(4)));
typedef float f32x2 __attribute__((ext_vector_type(2)));
typedef float f32x4 __attribute__((ext_vector_type(4)));
typedef float f32x16 __attribute__((ext_vector_type(16)));
typedef unsigned u32x2 __attribute__((ext_vector_type(2)));
typedef unsigned u32x4 __attribute__((ext_vector_type(4)));

constexpr int DM = 1024, NBATCH = 16, SEQL = 2048, NCTX = 256;
constexpr int NCTXR = NBATCH * NCTX;
constexpr int NLATR = NBATCH * SEQL;
constexpr int NROWS = NCTXR + NLATR;
constexpr int NHEAD = 8, QLORA = 384, KVLORA = 256, NOPE = 128, ROPED = 64, VDIM = 128;
constexpr int NDQKV = 768;
constexpr int NQ = NHEAD * (NOPE + ROPED);
constexpr int NKV = NHEAD * (NOPE + VDIM);
constexpr int NEXP = 64, TOPK = 8, DEXP = 256;
constexpr float NORM_EPS = 1e-6f;
constexpr int NMOD = 6, MODW = NMOD * DM;

constexpr size_t MiB = 1u << 20;
constexpr size_t WS_CTL = 0, CTL_BYTES = 1 * MiB;
constexpr size_t WS_WDQKV = 1 * MiB;
constexpr size_t WS_WUQ   = WS_WDQKV + 1536 * 1024;
constexpr size_t WS_WUKV  = WS_WUQ + 1280 * 1024;
constexpr size_t WS_WO    = WS_WUKV + 1 * MiB;
constexpr size_t WS_WGLU  = WS_WO + 2 * MiB;
constexpr size_t WS_WSHR  = WS_WGLU + 4 * MiB;
constexpr size_t WS_WSHD  = WS_WSHR + 3 * MiB;
constexpr size_t WS_MOD   = 15 * MiB;
constexpr size_t WS_ROPE  = 16 * MiB;
constexpr size_t WS_W1    = 17 * MiB;
constexpr size_t WS_W2    = 81 * MiB;
constexpr size_t WS_XCTX  = 113 * MiB;
constexpr size_t WS_XN    = 129 * MiB;
constexpr size_t WS_ST    = 201 * MiB;
static_assert(WS_WSHD + 1 * MiB <= WS_MOD, "small weights fit");
constexpr size_t WS_KV   = WS_ST;
constexpr size_t WS_Q    = WS_ST + 144 * MiB;
constexpr size_t WS_OO   = WS_Q;
constexpr size_t WS_A1   = WS_ST + 252 * MiB;
constexpr size_t WS_O    = WS_A1;
constexpr size_t WS_KPE  = WS_ST + 324 * MiB;
constexpr size_t WS_SSQ1 = WS_ST + 329 * MiB;
constexpr size_t WS_SSQO = WS_ST + 332 * MiB;
constexpr size_t WS_END  = WS_ST + 402 * MiB;

constexpr int CW_BAR = 4096;

__device__ __forceinline__ unsigned cvt_pk_bf16(float lo, float hi) { unsigned r; asm volatile("v_cvt_pk_bf16_f32 %0, %1, %2" : "=v"(r) : "v"(lo), "v"(hi)); return r; }
__device__ __forceinline__ float bf_lo(unsigned w) { return __uint_as_float(w << 16); }
__device__ __forceinline__ float bf_hi(unsigned w) { return __uint_as_float(w & 0xffff0000u); }
__device__ __forceinline__ float wave_sum(float v) {
#pragma unroll
    for (int o = 1; o < 64; o <<= 1) v += __shfl_xor(v, o);
    return v;
}
__device__ __forceinline__ float silu_f(float v) { return v / (1.f + __expf(-v)); }
__device__ __forceinline__ float sigmoid_f(float v) { return 1.f / (1.f + __expf(-v)); }
__device__ __forceinline__ int mod_index(int row) { return row < NCTXR ? 16 : (row - NCTXR) / SEQL; }
__device__ __forceinline__ int opaque_tid() { int t = threadIdx.x; asm volatile("" : "+v"(t)); return t; }
__device__ __forceinline__ float gelu_tanh(float v) {
    const float z = 0.7978845608028654f * (v + 0.044715f * v * v * v);
    return v / (1.f + __expf(-2.f * z));
}
__device__ __forceinline__ unsigned char* opaque_ptr(unsigned char* p) {
    unsigned lo = __builtin_amdgcn_readfirstlane((unsigned)(unsigned long long)p), hi = __builtin_amdgcn_readfirstlane((unsigned)((unsigned long long)p >> 32));
    asm volatile("" : "+s"(lo), "+s"(hi)); return (unsigned char*)(((unsigned long long)hi << 32) | lo); }
#define XB_TMO      128
#define XB_XCNT(j)  (256  + 64 * (j))
#define XB_XSUB(j)  (1280 + 64 * (j))
#define XB_XGEN(j)  (2304 + 64 * (j))
#define XB_TOP      3328
#define XB_TOPGEN   3392
#define XCD_BAR_WORDS 3456
#define XB_SPIN_CAP (1u << 18)
__device__ __forceinline__ unsigned xb_ld(unsigned* p)              { return __hip_atomic_load(p, __ATOMIC_RELAXED, __HIP_MEMORY_SCOPE_AGENT); }
__device__ __forceinline__ unsigned xb_add(unsigned* p, unsigned v) { return __hip_atomic_fetch_add(p, v, __ATOMIC_RELAXED, __HIP_MEMORY_SCOPE_AGENT); }
__device__ __forceinline__ unsigned xb_xcc_id() { return (unsigned)__builtin_amdgcn_s_getreg((3 << 11) | 20) & 0xFu; }
#define XB_SPIN(cond, bar) do { unsigned _sp = 0; while (cond) { __builtin_amdgcn_s_sleep(1); \
    if ((++_sp & 255u) == 0u) { if (xb_ld(&(bar)[XB_TMO])) break; if (_sp > XB_SPIN_CAP) { atomicAdd(&(bar)[XB_TMO], 1u); break; } } } } while (0)
struct XcdBarrier { unsigned* bar; unsigned x; volatile LAS unsigned* st; };
__device__ __forceinline__ XcdBarrier xcd_barrier_post(unsigned* bar, volatile LAS unsigned* st) {
    XcdBarrier b; b.bar = bar; b.x = xb_xcc_id(); b.st = st;
    if (threadIdx.x == 0) (void)xb_add(&bar[XB_XCNT(b.x)], 1u);
    return b;
}
__device__ __forceinline__ void xcd_barrier_complete(unsigned* bar, unsigned x, unsigned& nloc, unsigned& nx) {
    const unsigned G = gridDim.x * gridDim.y * gridDim.z;
    unsigned sum, cnt, mine, sp = 0u;
    for (;;) {
        sum = 0u; cnt = 0u; mine = 0u;
#pragma unroll
        for (unsigned j = 0; j < 16; ++j) { const unsigned c = xb_ld(&bar[XB_XCNT(j)]); sum += c; cnt += (c > 0u) ? 1u : 0u; mine = (j == x) ? c : mine; }
        if (sum == G) break;
        __builtin_amdgcn_s_sleep(1);
        if ((++sp & 255u) == 0u) { if (xb_ld(&bar[XB_TMO])) break; if (sp > XB_SPIN_CAP) { atomicAdd(&bar[XB_TMO], 1u); break; } }
    }
    nloc = mine > 0u ? mine : 1u; nx = cnt > 0u ? cnt : 1u;
}
__device__ __forceinline__ void xcd_barrier(const XcdBarrier& b) {
    asm volatile("s_waitcnt vmcnt(0)" ::: "memory");
    __syncthreads();
    if (threadIdx.x == 0) {
        unsigned* bar = b.bar;
        __builtin_amdgcn_s_waitcnt(0);
        unsigned nloc = b.st[0], nx = b.st[1];
        if (nloc == 0u) { xcd_barrier_complete(bar, b.x, nloc, nx); b.st[0] = nloc; b.st[1] = nx; }
        const unsigned old = xb_add(&bar[XB_XSUB(b.x)], 1u);
        const unsigned gen = old / nloc;
        if (old + 1u == (gen + 1u) * nloc) {
            __builtin_amdgcn_fence(__ATOMIC_RELEASE, "agent");
            asm volatile("s_waitcnt vmcnt(0)" ::: "memory");
            const unsigned og = xb_add(&bar[XB_TOP], 1u);
            const unsigned tg = og / nx;
            if (og + 1u == (tg + 1u) * nx) xb_add(&bar[XB_TOPGEN], 1u);
            else XB_SPIN(xb_ld(&bar[XB_TOPGEN]) == tg, bar);
            __builtin_amdgcn_fence(__ATOMIC_ACQUIRE, "agent");
            xb_add(&bar[XB_XGEN(b.x)], 1u);
            asm volatile("s_waitcnt vmcnt(0)" ::: "memory");
        } else {
            XB_SPIN(xb_ld(&bar[XB_XGEN(b.x)]) == gen, bar);
            __builtin_amdgcn_fence(__ATOMIC_ACQUIRE, "agent");
            asm volatile("s_waitcnt vmcnt(0)" ::: "memory");
        }
    }
    __syncthreads();
}

namespace pg8 {
constexpr int BM = 256, BK = 64, HALF = 128, HTB = HALF * BK * 2, STAGE_BYTES = 8 * HTB, NXCD = 8, WGM = 8;
__host__ __device__ __forceinline__ int lds_byte(int r, int c) { const int st = (r >> 4) * 2 + (c >> 5), rr = r & 15, cc = c & 31, ob = rr * 64 + cc * 2; return st * 1024 + (ob ^ (((ob >> 9) & 1) << 5)); }
__host__ __device__ __forceinline__ void stage_rc(int b, int& R, int& C) { const int st = b / 1024, sb = b % 1024, swz = sb ^ (((sb >> 9) & 1) << 5); R = (st >> 1) * 16 + swz / 64; C = (st & 1) * 32 + (swz % 64) / 2; }
__host__ __device__ __forceinline__ int perm32(int rho) { const int n = rho >> 4, i = rho & 15; return 8 * (i >> 2) + 4 * n + (i & 3); }

__device__ __forceinline__ bool dense_order(int i, int G, int c, int nM, int nN, int& pm, int& pn) {
    const int nwg = nM * nN; const long L = (long)i * G + c; if (L >= nwg) return false;
    int wgid = (int)L; { const int q = nwg / NXCD, r = nwg % NXCD, xcd = wgid % NXCD, off = wgid / NXCD; wgid = (xcd < r ? xcd * (q + 1) : r * (q + 1) + (xcd - r) * q) + off; }
    const int nig = WGM * nN, gid = wgid / nig, fm = gid * WGM, gsz = (nM - fm) < WGM ? (nM - fm) : WGM;
    pm = __builtin_amdgcn_readfirstlane(fm + ((wgid % nig) % gsz)); pn = __builtin_amdgcn_readfirstlane((wgid % nig) / gsz); return true;
}

template <bool GATHER> struct UCtx { const char* a0[2]; const char* a1[2]; const char* b; unsigned vg[2][2]; };
template <> struct UCtx<false> { const char* a0[2]; const char* a1[2]; const char* b; };

template <class P>
__device__ __forceinline__ void gemm_phase(LAS unsigned char* lds, const P& pol) {
    typedef typename P::Unit Unit;
    const int tid = opaque_tid(), wid = __builtin_amdgcn_readfirstlane(tid >> 6), lane = tid & 63, wr = wid >> 2, wc = wid & 3, fr = lane & 15, fq = lane >> 4;
    constexpr int nt = P::NT;
    int Rr[2], Cc[2]; unsigned voffB[2], va0[2];
#pragma unroll
    for (int i = 0; i < 2; ++i) { stage_rc(tid * 16 + i * 8192, Rr[i], Cc[i]); const int Rb = P::PERM ? ((Rr[i] & ~31) + perm32(Rr[i] & 31)) : Rr[i];
        voffB[i] = (unsigned)(Rb * P::LDB + Cc[i] * 2); va0[i] = pol.lane_a0(Rr[i], Cc[i]); }
    constexpr size_t hstepB = (size_t)HALF * P::LDB;
    const unsigned ldsw = (unsigned)wid * 1024u;
    const int aoff = lds_byte(wr * 64 + fr, fq * 8), boff = lds_byte(wc * 32 + fr, fq * 8);
#define PG8_SA(b, h) (((b) * 2 + (h)) * HTB)
#define PG8_SB(b, h) ((4 + (b) * 2 + (h)) * HTB)
#define PG8_GL(bufoff, p0, p1) do { __builtin_amdgcn_global_load_lds((const unsigned*)(p0), (LAS unsigned*)(lds + (bufoff) + ldsw), 16, 0, 0); \
        __builtin_amdgcn_global_load_lds((const unsigned*)(p1), (LAS unsigned*)(lds + (bufoff) + ldsw + 8192), 16, 0, 0); } while (0)
#define PG8_STB(bufoff, U, h, kt) do { const char* _b = (U).b + (size_t)(h) * hstepB + (size_t)(kt) * 128; asm volatile("" : "+s"(_b)); PG8_GL(bufoff, _b + voffB[0], _b + voffB[1]); } while (0)
#define PG8_STA(bufoff, U, h, kt) do { const char* _a = (U).a0[h] + (size_t)(kt) * P::KS0; if constexpr (P::TWOSEG) { if ((kt) >= P::KT0) _a = (U).a1[h] + (size_t)((kt) - P::KT0) * P::KS1; } \
        unsigned _o0, _o1; if constexpr (P::GATHER) { _o0 = (U).vg[h][0]; _o1 = (U).vg[h][1]; } else { _o0 = va0[0]; _o1 = va0[1]; } \
        asm volatile("" : "+s"(_a)); PG8_GL(bufoff, _a + _o0, _a + _o1); } while (0)
#define PG8_LDA(dst, b, h) do { _Pragma("unroll") for (int m = 0; m < 4; ++m) _Pragma("unroll") for (int k = 0; k < 2; ++k) dst[m][k] = *(const LAS bf16x8*)(lds + PG8_SA(b, h) + aoff + m * 2048 + k * 1024); } while (0)
#define PG8_LDB(dst, b, h) do { _Pragma("unroll") for (int n = 0; n < 2; ++n) _Pragma("unroll") for (int k = 0; k < 2; ++k) dst[n][k] = *(const LAS bf16x8*)(lds + PG8_SB(b, h) + boff + n * 2048 + k * 1024); } while (0)
#define PG8_MMA(ai, bj, At, Bt) do { __builtin_amdgcn_s_setprio(1); _Pragma("unroll") for (int m = 0; m < 4; ++m) _Pragma("unroll") for (int n = 0; n < 2; ++n) _Pragma("unroll") for (int k = 0; k < 2; ++k) \
        acc[ai][bj][m][n] = __builtin_amdgcn_mfma_f32_16x16x32_bf16(Bt[n][k], At[m][k], acc[ai][bj][m][n], 0, 0, 0); __builtin_amdgcn_s_setprio(0); } while (0)
#define PG8_WAIT_V(n) asm volatile("s_waitcnt vmcnt(" #n ")" ::: "memory")
#define PG8_WAIT_L(n) asm volatile("s_waitcnt lgkmcnt(" #n ")" ::: "memory")
#define PG8_BAR __builtin_amdgcn_s_barrier()
#define PG8_SCHED __builtin_amdgcn_sched_barrier(0)
    Unit cur, nxt; int ui = 0;
    if (!pol.next(0, cur)) return;
    UCtx<P::GATHER> cc, nc;
    pol.ctx(cur, cc, Rr, Cc);
    f32x4 acc[2][2][4][2];
#pragma unroll
    for (int a = 0; a < 2; ++a)
#pragma unroll
        for (int b = 0; b < 2; ++b)
#pragma unroll
            for (int m = 0; m < 4; ++m)
#pragma unroll
                for (int n = 0; n < 2; ++n) acc[a][b][m][n] = (f32x4){0.f, 0.f, 0.f, 0.f};
    bf16x8 At[4][2], B0[2][2], B1[2][2];
    PG8_STB(PG8_SB(0, 0), cc, 0, 0); PG8_STB(PG8_SB(0, 1), cc, 1, 0); PG8_STA(PG8_SA(0, 0), cc, 0, 0); PG8_STA(PG8_SA(0, 1), cc, 1, 0);
    if (wr == 1) PG8_BAR;
    PG8_WAIT_V(2); PG8_BAR;
    PG8_STB(PG8_SB(1, 0), cc, 0, 1); PG8_STA(PG8_SA(1, 0), cc, 0, 1); PG8_STB(PG8_SB(1, 1), cc, 1, 1);
    PG8_WAIT_V(6); PG8_BAR;
    for (;;) {
        const bool has_next = pol.next(ui + 1, nxt);
        if (has_next) pol.ctx(nxt, nc, Rr, Cc); else nc = cc;
        for (int t = 0; t < nt; t += 2) {
            const bool last = (t == nt - 2);
            const int k2 = last ? 0 : t + 2, k3 = k2 + 1;
            PG8_LDB(B0, 0, 0); PG8_LDB(B1, 0, 1); PG8_SCHED; PG8_LDA(At, 0, 0); PG8_STA(PG8_SA(1, 1), cc, 1, t + 1);
            PG8_WAIT_V(8); PG8_WAIT_L(0); PG8_BAR; PG8_MMA(0, 0, At, B0); PG8_MMA(0, 1, At, B1); PG8_BAR; PG8_SCHED;
            PG8_LDA(At, 0, 1);
            if (last) { PG8_STB(PG8_SB(0, 0), nc, 0, 0); PG8_STB(PG8_SB(0, 1), nc, 1, 0); PG8_STA(PG8_SA(0, 0), nc, 0, 0); }
            else      { PG8_STB(PG8_SB(0, 0), cc, 0, k2); PG8_STB(PG8_SB(0, 1), cc, 1, k2); PG8_STA(PG8_SA(0, 0), cc, 0, k2); }
            PG8_WAIT_V(8); PG8_WAIT_L(0); PG8_BAR; PG8_MMA(1, 0, At, B0); PG8_MMA(1, 1, At, B1); PG8_BAR; PG8_SCHED;
            PG8_LDB(B0, 1, 0); PG8_LDB(B1, 1, 1); PG8_SCHED; PG8_LDA(At, 1, 0);
            if (last) { PG8_STA(PG8_SA(0, 1), nc, 1, 0); } else { PG8_STA(PG8_SA(0, 1), cc, 1, k2); }
            PG8_WAIT_V(8); PG8_WAIT_L(0); PG8_BAR; PG8_MMA(0, 0, At, B0); PG8_MMA(0, 1, At, B1); PG8_BAR; PG8_SCHED;
            PG8_LDA(At, 1, 1);
            if (last) { PG8_STB(PG8_SB(1, 0), nc, 0, 1); PG8_STB(PG8_SB(1, 1), nc, 1, 1); PG8_STA(PG8_SA(1, 0), nc, 0, 1); }
            else      { PG8_STB(PG8_SB(1, 0), cc, 0, k3); PG8_STB(PG8_SB(1, 1), cc, 1, k3); PG8_STA(PG8_SA(1, 0), cc, 0, k3); }
            PG8_WAIT_V(8); PG8_WAIT_L(0); PG8_BAR; PG8_MMA(1, 0, At, B0); PG8_MMA(1, 1, At, B1); PG8_BAR; PG8_SCHED;
        }
        if (wr == 0) PG8_BAR;
        pol.epi(acc, cur, wr, wc, fr, fq);
        if (!has_next) break;
#pragma unroll
        for (int a = 0; a < 2; ++a)
#pragma unroll
            for (int b = 0; b < 2; ++b)
#pragma unroll
                for (int m = 0; m < 4; ++m)
#pragma unroll
                    for (int n = 0; n < 2; ++n) acc[a][b][m][n] = (f32x4){0.f, 0.f, 0.f, 0.f};
        cur = nxt; cc = nc; ++ui;
        if (wr == 1) PG8_BAR;
    }
    PG8_WAIT_V(0);
    PG8_BAR;
#undef PG8_SA
#undef PG8_SB
#undef PG8_GL
#undef PG8_STB
#undef PG8_STA
#undef PG8_LDA
#undef PG8_LDB
#undef PG8_MMA
#undef PG8_WAIT_V
#undef PG8_WAIT_L
#undef PG8_BAR
#undef PG8_SCHED
}
}
struct DUnit { int pm, pn; };

template <int NT_, int LDA_, bool PERM_> struct DenseBase {
    static constexpr bool PERM = PERM_, GATHER = false, TWOSEG = false;
    static constexpr int NT = NT_, KT0 = NT_, KS0 = 128, KS1 = 128, LDB = NT_ * 128;
    typedef DUnit Unit;
    const char* A; const char* Bt; int nM, nN, G, c;
    __device__ __forceinline__ bool next(int i, Unit& u) const { return pg8::dense_order(i, G, c, nM, nN, u.pm, u.pn); }
    __device__ __forceinline__ void ctx(const Unit& u, pg8::UCtx<false>& x, const int (&)[2], const int (&)[2]) const {
        x.a0[0] = A + (size_t)u.pm * 256 * LDA_; x.a0[1] = x.a0[0] + (size_t)128 * LDA_; x.a1[0] = x.a0[0]; x.a1[1] = x.a0[1];
        x.b = Bt + (size_t)u.pn * 256 * LDB; }
    __device__ __forceinline__ unsigned lane_a0(int R, int C) const { return (unsigned)(R * LDA_ + C * 2); }
    __device__ __forceinline__ unsigned lane_a1(int, int) const { return 0u; }
};

__device__ __forceinline__ void store8(bf16_t* p, const f32x4& v0, const f32x4& v1) {
    u32x4 w; w.x = cvt_pk_bf16(v0[0], v0[1]); w.y = cvt_pk_bf16(v0[2], v0[3]); w.z = cvt_pk_bf16(v1[0], v1[1]); w.w = cvt_pk_bf16(v1[2], v1[3]); *(u32x4*)p = w; }
__device__ __forceinline__ float sq4(const f32x4& v) { return (v[0] * v[0] + v[1] * v[1]) + (v[2] * v[2] + v[3] * v[3]); }
__device__ __forceinline__ void rope8(f32x4& v0, f32x4& v1, const float* cs) {
    const f32x4 a = *(const f32x4*)cs, b = *(const f32x4*)(cs + 4);
    float x0, x1;
    x0 = v0[0]; x1 = v0[1]; v0[0] = x0 * a[0] - x1 * a[1]; v0[1] = x0 * a[1] + x1 * a[0];
    x0 = v0[2]; x1 = v0[3]; v0[2] = x0 * a[2] - x1 * a[3]; v0[3] = x0 * a[3] + x1 * a[2];
    x0 = v1[0]; x1 = v1[1]; v1[0] = x0 * b[0] - x1 * b[1]; v1[1] = x0 * b[1] + x1 * b[0];
    x0 = v1[2]; x1 = v1[3]; v1[2] = x0 * b[2] - x1 * b[3]; v1[3] = x0 * b[3] + x1 * b[2];
}

struct PolDqkv : DenseBase<16, 2048, true> {
    bf16_t* A1; float* SSQ1; bf16_t* KPE; const float* ROPE;
    __device__ __forceinline__ void epi(const f32x4 (&acc)[2][2][4][2], const DUnit& u, int wr, int wc, int fr, int fq) const {
#pragma unroll
        for (int ai = 0; ai < 2; ++ai)
#pragma unroll
            for (int m = 0; m < 4; ++m) {
                const int row = u.pm * 256 + ai * 128 + wr * 64 + m * 16 + fr;
                bf16_t* rowp = A1 + (size_t)row * NDQKV + u.pn * 256 + wc * 32 + 8 * fq;
                float s0 = sq4(acc[ai][0][m][0]) + sq4(acc[ai][0][m][1]), s1 = sq4(acc[ai][1][m][0]) + sq4(acc[ai][1][m][1]);
                store8(rowp, acc[ai][0][m][0], acc[ai][0][m][1]); store8(rowp + 128, acc[ai][1][m][0], acc[ai][1][m][1]);
                s0 += __shfl_xor(s0, 16); s0 += __shfl_xor(s0, 32); s1 += __shfl_xor(s1, 16); s1 += __shfl_xor(s1, 32);
                if (fq == 0) {
                    float* sp = SSQ1 + (size_t)row * 16;
                    if (u.pn == 0) sp[wc] = s0 + s1; else if (u.pn == 1) { sp[4 + wc] = s0; sp[8 + wc] = s1; } else sp[12 + wc] = s0;
                }
                if (u.pn == 2 && wc < 2) {
                    f32x4 v0 = acc[ai][1][m][0], v1 = acc[ai][1][m][1];
                    if (row >= NCTXR) { const int t = (row - NCTXR) & (SEQL - 1); rope8(v0, v1, ROPE + ((size_t)t * 32 + 16 * wc + 4 * fq) * 2); }
                    store8(KPE + (size_t)row * 64 + 32 * wc + 8 * fq, v0, v1);
                }
            }
    }
};

struct PolQup : DenseBase<6, NDQKV * 2, true> {
    bf16_t* Q; const float* SSQ1; const float* ROPE;
    __device__ __forceinline__ void epi(const f32x4 (&acc)[2][2][4][2], const DUnit& u, int wr, int wc, int fr, int fq) const {
#pragma unroll
        for (int ai = 0; ai < 2; ++ai)
#pragma unroll
            for (int m = 0; m < 4; ++m) {
                const int row = u.pm * 256 + ai * 128 + wr * 64 + m * 16 + fr;
                const f32x4 p0 = *(const f32x4*)(SSQ1 + (size_t)row * 16), p1 = *(const f32x4*)(SSQ1 + (size_t)row * 16 + 4);
                const float ss = ((p0[0] + p0[1]) + (p0[2] + p0[3])) + ((p1[0] + p1[1]) + (p1[2] + p1[3]));
                const float rstd = __builtin_amdgcn_rsqf(ss * (1.f / QLORA) + NORM_EPS);
#pragma unroll
                for (int bj = 0; bj < 2; ++bj) {
                    const int col = u.pn * 256 + bj * 128 + wc * 32 + 8 * fq, d = col % 192;
                    f32x4 v0 = acc[ai][bj][m][0] * rstd, v1 = acc[ai][bj][m][1] * rstd;
                    if (d >= NOPE && row >= NCTXR) { const int t = (row - NCTXR) & (SEQL - 1); rope8(v0, v1, ROPE + ((size_t)t * 32 + ((d - NOPE) >> 1)) * 2); }
                    store8(Q + (size_t)row * NQ + col, v0, v1); asm volatile("" ::: "memory");
                }
            }
    }
};

struct PolKVup : DenseBase<4, NDQKV * 2, true> {
    bf16_t* KV; const float* SSQ1;
    __device__ __forceinline__ void epi(const f32x4 (&acc)[2][2][4][2], const DUnit& u, int wr, int wc, int fr, int fq) const {
#pragma unroll
        for (int ai = 0; ai < 2; ++ai)
#pragma unroll
            for (int m = 0; m < 4; ++m) {
                const int row = u.pm * 256 + ai * 128 + wr * 64 + m * 16 + fr;
                const f32x4 p0 = *(const f32x4*)(SSQ1 + (size_t)row * 16 + 8), p1 = *(const f32x4*)(SSQ1 + (size_t)row * 16 + 12);
                const float ss = ((p0[0] + p0[1]) + (p0[2] + p0[3])) + ((p1[0] + p1[1]) + (p1[2] + p1[3]));
                const float rstd = __builtin_amdgcn_rsqf(ss * (1.f / KVLORA) + NORM_EPS);
                bf16_t* rowp = KV + (size_t)row * NKV + u.pn * 256 + wc * 32 + 8 * fq;
                store8(rowp, acc[ai][0][m][0] * rstd, acc[ai][0][m][1] * rstd); store8(rowp + 128, acc[ai][1][m][0] * rstd, acc[ai][1][m][1] * rstd);
            }
    }
};

struct PolWo : DenseBase<16, 2048, true> {
    bf16_t* OO; float* SSQO;
    __device__ __forceinline__ void epi(const f32x4 (&acc)[2][2][4][2], const DUnit& u, int wr, int wc, int fr, int fq) const {
#pragma unroll
        for (int ai = 0; ai < 2; ++ai)
#pragma unroll
            for (int m = 0; m < 4; ++m) {
                const int row = u.pm * 256 + ai * 128 + wr * 64 + m * 16 + fr;
                bf16_t* rowp = OO + (size_t)row * DM + u.pn * 256 + wc * 32 + 8 * fq;
                float s = (sq4(acc[ai][0][m][0]) + sq4(acc[ai][0][m][1])) + (sq4(acc[ai][1][m][0]) + sq4(acc[ai][1][m][1]));
                store8(rowp, acc[ai][0][m][0], acc[ai][0][m][1]); store8(rowp + 128, acc[ai][1][m][0], acc[ai][1][m][1]);
                s += __shfl_xor(s, 16); s += __shfl_xor(s, 32);
                if (fq == 0) SSQO[(size_t)row * 32 + u.pn * 4 + wc] = s;
            }
    }
};
namespace attn {
constexpr int NW = 8, QBLK = 32, KVBLK = 64, DQK = 192, DV = 128;
constexpr float SCALE = 0.07216878364870322f;
constexpr float THR = 8.f;
constexpr int SHM_V = KVBLK * DV * 2, SHM_K = KVBLK * DQK * 2;
constexpr int SHM_QPE = NW * 4096;
constexpr int SHM_ATTN = 2 * SHM_V + 2 * SHM_K + NW * 64 * 4 + SHM_QPE;
#define KSWZ(row, colB) ((row) * 384 + ((colB) ^ (((row) & 7) << 4)))
#define SBAR() __builtin_amdgcn_sched_barrier(0)
__device__ __forceinline__ int crow(int r, int hi) { return (r & 3) + 8 * (r >> 2) + 4 * hi; }
__device__ __forceinline__ unsigned cvtpk(float lo, float hi) { unsigned r; asm volatile("v_cvt_pk_bf16_f32 %0, %1, %2" : "=v"(r) : "v"(lo), "v"(hi)); return r; }

__device__ __forceinline__ void partialSM(f32x16& p0, f32x16& p1, float& m_reg, float& mn, float& alpha) {
  constexpr float C = SCALE * 1.4426950408889634f;
  float pmax = p0[0];
#pragma unroll
  for (int r = 1; r < 16; ++r) pmax = fmaxf(pmax, p0[r]);
#pragma unroll
  for (int r = 0; r < 16; ++r) pmax = fmaxf(pmax, p1[r]);
  { auto rr = __builtin_amdgcn_permlane32_swap(__float_as_uint(pmax), __float_as_uint(pmax), false, false);
    pmax = fmaxf(__uint_as_float(rr[0]), __uint_as_float(rr[1])); }
  if (__builtin_expect(__all(pmax - m_reg <= THR / SCALE), 1)) { mn = m_reg; alpha = 1.f; }
  else { mn = fmaxf(m_reg, pmax); alpha = __builtin_amdgcn_exp2f((m_reg - mn) * C); m_reg = mn; }
  float mnC = -mn * C;
#pragma unroll
  for (int r = 0; r < 16; ++r) p0[r] = fmaf(p0[r], C, mnC);
#pragma unroll
  for (int r = 0; r < 16; ++r) p1[r] = fmaf(p1[r], C, mnC);
#pragma unroll
  for (int r = 0; r < 16; ++r) p0[r] = __builtin_amdgcn_exp2f(p0[r]);
}
__device__ __forceinline__ void finishSM(f32x16& p0, f32x16& p1, float alpha, float& l_reg, bf16x8& pa0, bf16x8& pa1, bf16x8& pa2, bf16x8& pa3) {
#pragma unroll
  for (int r = 0; r < 16; ++r) p1[r] = __builtin_amdgcn_exp2f(p1[r]);
  float ps = 0;
#pragma unroll
  for (int r = 0; r < 16; ++r) ps += p0[r];
#pragma unroll
  for (int r = 0; r < 16; ++r) ps += p1[r];
  { auto rr = __builtin_amdgcn_permlane32_swap(__float_as_uint(ps), __float_as_uint(ps), false, false);
    ps = __uint_as_float(rr[0]) + __uint_as_float(rr[1]); }
  l_reg = l_reg * alpha + ps;
#define PK4(P, BASE, OUT) do { unsigned a0 = cvtpk(P[BASE + 0], P[BASE + 1]), a1 = cvtpk(P[BASE + 2], P[BASE + 3]);   \
    unsigned b0 = cvtpk(P[BASE + 4], P[BASE + 5]), b1 = cvtpk(P[BASE + 6], P[BASE + 7]);                              \
    auto r0 = __builtin_amdgcn_permlane32_swap(a0, b0, false, false); auto r1 = __builtin_amdgcn_permlane32_swap(a1, b1, false, false); \
    u32x4 w = {r0[0], r1[0], r0[1], r1[1]}; OUT = *reinterpret_cast<bf16x8*>(&w); } while (0)
  PK4(p0, 0, pa0); PK4(p0, 8, pa1); PK4(p1, 0, pa2); PK4(p1, 8, pa3);
#undef PK4
}
__device__ __forceinline__ void qkt(f32x16& p0, f32x16& p1, const char* Ks, const bf16x8* qr, const char* qpe, int r32, int hi) {
  p0 = f32x16{}; p1 = f32x16{};
#pragma unroll
  for (int d0 = 0; d0 < 12; ++d0) { int cb = (d0 * 16 + hi * 8) * 2;
    bf16x8 b0 = *reinterpret_cast<const bf16x8*>(Ks + KSWZ(r32, cb));
    bf16x8 b1 = *reinterpret_cast<const bf16x8*>(Ks + KSWZ(32 + r32, cb));
    const bf16x8 q = d0 < 8 ? qr[d0 < 8 ? d0 : 0] : *reinterpret_cast<const bf16x8*>(qpe + (d0 - 8) * 1024);
    p0 = __builtin_amdgcn_mfma_f32_32x32x16_bf16(b0, q, p0, 0, 0, 0);
    p1 = __builtin_amdgcn_mfma_f32_32x32x16_bf16(b1, q, p1, 0, 0, 0);
    if ((d0 & 3) == 3) SBAR(); }
}
__device__ __forceinline__ int v_st(int k, int c) { const int kk = (k & ~0xC) | ((k & 4) << 1) | ((k & 8) >> 1); return ((kk >> 3) * 4 + (c >> 5)) * 512 + ((kk & 7) * 32 + (c & 31)) * 2; }
__device__ __forceinline__ int v_rd_base(int lane) { return ((lane & 3) << 3) | (((lane >> 2) & 3) << 6) | (((lane >> 4) & 1) << 5) | (((lane >> 5) & 1) << 8); }
constexpr int v_rd_off(int d0, int ks, int half) { return d0 * 512 + ks * 4096 + half * 2048; }
template <int OFF> __device__ __forceinline__ s16x4 tr_read(int vb) {
  s16x4 r; asm volatile("ds_read_b64_tr_b16 %0, %1 offset:%2" : "=&v"(r) : "v"(vb), "i"(OFF) : "memory"); return r;
}
template <int D0> __device__ __forceinline__ void pv_one(f32x16& od, int vb, bf16x8 pa0, bf16x8 pa1, bf16x8 pa2, bf16x8 pa3) {
  const s16x4 l0 = tr_read<v_rd_off(D0, 0, 0)>(vb), h0 = tr_read<v_rd_off(D0, 0, 1)>(vb), l1 = tr_read<v_rd_off(D0, 1, 0)>(vb), h1 = tr_read<v_rd_off(D0, 1, 1)>(vb);
  const s16x4 l2 = tr_read<v_rd_off(D0, 2, 0)>(vb), h2 = tr_read<v_rd_off(D0, 2, 1)>(vb), l3 = tr_read<v_rd_off(D0, 3, 0)>(vb), h3 = tr_read<v_rd_off(D0, 3, 1)>(vb);
  asm volatile("s_waitcnt lgkmcnt(0)" ::: "memory"); SBAR();
#define PK(L, H) (bf16x8){L[0], L[1], L[2], L[3], H[0], H[1], H[2], H[3]}
  od = __builtin_amdgcn_mfma_f32_32x32x16_bf16(pa0, PK(l0, h0), od, 0, 0, 0);
  od = __builtin_amdgcn_mfma_f32_32x32x16_bf16(pa1, PK(l1, h1), od, 0, 0, 0);
  od = __builtin_amdgcn_mfma_f32_32x32x16_bf16(pa2, PK(l2, h2), od, 0, 0, 0);
  od = __builtin_amdgcn_mfma_f32_32x32x16_bf16(pa3, PK(l3, h3), od, 0, 0, 0);
#undef PK
}
__device__ __forceinline__ void pv_d0(f32x16* o, int vb, bf16x8 pa0, bf16x8 pa1, bf16x8 pa2, bf16x8 pa3) {
  pv_one<0>(o[0], vb, pa0, pa1, pa2, pa3); pv_one<1>(o[1], vb, pa0, pa1, pa2, pa3); pv_one<2>(o[2], vb, pa0, pa1, pa2, pa3); pv_one<3>(o[3], vb, pa0, pa1, pa2, pa3);
}

__device__ __forceinline__ void attn_unit(const bf16_t* __restrict__ Qg, const bf16_t* __restrict__ KVb, const bf16_t* __restrict__ KPE, bf16_t* __restrict__ Og,
                                          int qrow0, int h, int crow0, int lrow0, int NT, char* lds) {
  const int tid = opaque_tid(), wid = tid >> 6, lane = tid & 63, r32 = lane & 31, hi = lane >> 5;
  char* V_lds = lds; char* K_lds = lds + 2 * SHM_V;
  float* ws = (float*)(lds + 2 * SHM_V + 2 * SHM_K) + wid * 64; float* li_l = ws; float* al_l = ws + 32;
  float m_reg = -1e30f, l_reg = 0; f32x16 o[4] = {}; bf16x8 qr[8];
  char* qpe = lds + 2 * SHM_V + 2 * SHM_K + NW * 64 * 4 + wid * 4096 + lane * 16;
  const bf16_t* Qw = Qg + (size_t)(qrow0 + wid * QBLK + r32) * NQ + h * DQK + hi * 8;
#pragma unroll
  for (int d0 = 0; d0 < 8; ++d0) qr[d0] = *reinterpret_cast<const bf16x8*>(Qw + d0 * 16);
#pragma unroll
  for (int d0 = 8; d0 < 12; ++d0) *reinterpret_cast<bf16x8*>(qpe + (d0 - 8) * 1024) = *reinterpret_cast<const bf16x8*>(Qw + d0 * 16);
  const int sr = tid >> 4, sc = (tid & 15) * 8, vst0 = v_st(sr, sc), vst1 = v_st(32 + sr, sc);
  const int pr = tid >> 3, pc = (tid & 7) * 8;
  const int vb0 = (int)(uintptr_t)V_lds + v_rd_base(lane);
  bf16x8 vs0, vs1, ks0, ks1, kp;
#define TROW(j) ((j) < 4 ? crow0 + 64 * (j) : lrow0 + 64 * ((j) - 4))
#define SLOAD(j) do { const int k0_ = TROW(j); const bf16_t* kv0_ = KVb + (size_t)(k0_ + sr) * NKV + h * 256 + sc; const bf16_t* kv1_ = kv0_ + (size_t)32 * NKV; \
    vs0 = *reinterpret_cast<const bf16x8*>(kv0_ + 128); vs1 = *reinterpret_cast<const bf16x8*>(kv1_ + 128); \
    ks0 = *reinterpret_cast<const bf16x8*>(kv0_); ks1 = *reinterpret_cast<const bf16x8*>(kv1_); \
    kp = *reinterpret_cast<const bf16x8*>(KPE + (size_t)(k0_ + pr) * 64 + pc); } while (0)
#define SWRITE(b) do { *(bf16x8*)(V_lds + (b) * SHM_V + vst0) = vs0; *(bf16x8*)(V_lds + (b) * SHM_V + vst1) = vs1; \
    *(bf16x8*)(K_lds + (b) * SHM_K + KSWZ(sr, sc * 2)) = ks0; *(bf16x8*)(K_lds + (b) * SHM_K + KSWZ(32 + sr, sc * 2)) = ks1; \
    *(bf16x8*)(K_lds + (b) * SHM_K + KSWZ(pr, (128 + pc) * 2)) = kp; } while (0)
#define SWAIT() asm volatile("s_waitcnt vmcnt(0)" ::: "memory")
#define RESC(a) do { if (__any((a) < 1.f)) { if (hi == 0) al_l[r32] = (a); asm volatile("s_waitcnt lgkmcnt(0)" ::: "memory"); \
    _Pragma("unroll") for (int d = 0; d < 4; ++d) _Pragma("unroll") for (int r = 0; r < 16; ++r) o[d][r] *= al_l[crow(r, hi)]; } } while (0)
  f32x16 pA0, pA1, pB0, pB1; float mnA, mnB, alA, alB; bf16x8 pa0, pa1, pa2, pa3;
  SLOAD(0); SWAIT(); SWRITE(0); __syncthreads();
  qkt(pA0, pA1, K_lds, qr, qpe, r32, hi); partialSM(pA0, pA1, m_reg, mnA, alA);
  SLOAD(1);
  SWAIT(); SWRITE(1); __syncthreads();
  for (int j = 1; j + 1 < NT; j += 2) {
    SBAR(); qkt(pB0, pB1, K_lds + SHM_K, qr, qpe, r32, hi);
    finishSM(pA0, pA1, alA, l_reg, pa0, pa1, pa2, pa3); SBAR();
    SLOAD(j + 1); SBAR();
    pv_d0(o, vb0, pa0, pa1, pa2, pa3); partialSM(pB0, pB1, m_reg, mnB, alB);
    __syncthreads(); SWAIT(); SWRITE(0);
    RESC(alB); __syncthreads();
    SBAR(); qkt(pA0, pA1, K_lds, qr, qpe, r32, hi);
    finishSM(pB0, pB1, alB, l_reg, pa0, pa1, pa2, pa3); SBAR();
    SLOAD(j + 2); SBAR();
    pv_d0(o, vb0 + SHM_V, pa0, pa1, pa2, pa3); partialSM(pA0, pA1, m_reg, mnA, alA);
    __syncthreads(); SWAIT(); SWRITE(1);
    RESC(alA); __syncthreads();
  }
  SBAR(); qkt(pB0, pB1, K_lds + SHM_K, qr, qpe, r32, hi);
  finishSM(pA0, pA1, alA, l_reg, pa0, pa1, pa2, pa3); SBAR();
  pv_d0(o, vb0, pa0, pa1, pa2, pa3); partialSM(pB0, pB1, m_reg, mnB, alB);
  __syncthreads(); RESC(alB);
  finishSM(pB0, pB1, alB, l_reg, pa0, pa1, pa2, pa3); SBAR();
  pv_d0(o, vb0 + SHM_V, pa0, pa1, pa2, pa3);
  if (hi == 0) li_l[r32] = l_reg; asm volatile("s_waitcnt lgkmcnt(0)" ::: "memory");
  float rli[16];
#pragma unroll
  for (int r = 0; r < 16; ++r) rli[r] = __builtin_amdgcn_rcpf(li_l[crow(r, hi)]);
  bf16_t* Ow = Og + (size_t)(qrow0 + wid * QBLK) * DM + h * DV;
#pragma unroll
  for (int r = 0; r < 16; ++r) { const int orow = crow(r, hi);
#pragma unroll
    for (int d0 = 0; d0 < 4; ++d0) Ow[(size_t)orow * DM + d0 * 32 + r32] = (bf16_t)(cvtpk(o[d0][r] * rli[r], 0.f) & 0xffffu); }
  __syncthreads();
#undef TROW
#undef SLOAD
#undef SWRITE
#undef SWAIT
#undef RESC
}
#undef KSWZ
#undef SBAR
}
constexpr int NWAVES = 8;
constexpr int RING_BYTES = 131072, LDSCTL_OFF = RING_BYTES, LDS_BYTES = 147456;

struct Args {
    const float* in[31]; float* out; unsigned char* ws; int stage; int pad;
};
struct Frame {
    LAS unsigned char* lds; int vcu, G; unsigned char* ws;
};
constexpr int PTAB_OFF = 131072 + 512;
__device__ __forceinline__ const float* inp(const Frame& F, int i) {
    const LAS unsigned* t = (const LAS unsigned*)(F.lds + PTAB_OFF) + 2 * i;
    const unsigned lo = __builtin_amdgcn_readfirstlane(t[0]), hi = __builtin_amdgcn_readfirstlane(t[1]);
    return (const float*)(((unsigned long long)hi << 32) | lo);
}

__device__ __forceinline__ unsigned f2bf(float f) { unsigned u = __float_as_uint(f); return (u + 0x7fffu + ((u >> 16) & 1u)) >> 16; }
__device__ __forceinline__ unsigned pk2(float lo, float hi) { return f2bf(lo) | (f2bf(hi) << 16); }
__device__ __forceinline__ void cvt_item(const float* srcA, const float* srcB, const float* kscale, bf16_t* dst, int ld, int K, int nrows, int nvalid, int mode, int item, LAS float* scr, int lane) {
    const int nblk = nrows >> 5, kb = item / nblk, nb = item - kb * nblk, k0 = 64 * kb, n0 = 32 * nb;
    const float* src = srcA; int col = n0; bool valid = n0 < nvalid;
    if (mode == 1) { const int t = n0 >> 8, r = n0 & 255; src = r < 128 ? srcA : srcB; col = 128 * t + (r & 127); valid = true; }
    const int kk = lane >> 3, n4 = (lane & 7) * 4;
    f32x4 v[8];
    if (valid) {
        const float* sp = src + (size_t)(k0 + kk) * ld + col + n4;
#pragma unroll
        for (int i = 0; i < 8; ++i) v[i] = *(const f32x4*)(sp + (size_t)(8 * i) * ld);
        if (kscale) {
#pragma unroll
            for (int i = 0; i < 8; ++i) v[i] = v[i] * kscale[k0 + 8 * i + kk];
        }
    } else {
#pragma unroll
        for (int i = 0; i < 8; ++i) v[i] = (f32x4){0.f, 0.f, 0.f, 0.f};
    }
#pragma unroll
    for (int i = 0; i < 8; ++i) { LAS float* d = scr + (8 * i + kk) * 33 + n4; d[0] = v[i][0]; d[1] = v[i][1]; d[2] = v[i][2]; d[3] = v[i][3]; }
    asm volatile("s_waitcnt lgkmcnt(0)" ::: "memory");
    const int c = lane & 7;
#pragma unroll
    for (int j = 0; j < 4; ++j) { const int n = (lane >> 3) + 8 * j; const LAS float* s = scr + (8 * c) * 33 + n;
        u32x4 o; o.x = cvt_pk_bf16(s[0 * 33], s[1 * 33]); o.y = cvt_pk_bf16(s[2 * 33], s[3 * 33]); o.z = cvt_pk_bf16(s[4 * 33], s[5 * 33]); o.w = cvt_pk_bf16(s[6 * 33], s[7 * 33]);
        *(u32x4*)(dst + (size_t)(n0 + n) * K + k0 + 8 * c) = o; }
    asm volatile("s_waitcnt lgkmcnt(0)" ::: "memory");
}
constexpr int N_SMALL_JOBS = 11;
__device__ __forceinline__ void convert_small(const Args& a, Frame& F) {
    unsigned char* const wsl = opaque_ptr(a.ws);
    const int tid_ = opaque_tid(), lane_ = tid_ & 63, wave_ = __builtin_amdgcn_readfirstlane(tid_ >> 6);
    LAS float* scr = (LAS float*)(F.lds + wave_ * 16384);
    const int gw = F.vcu * NWAVES + wave_, NGW = F.G * NWAVES;
    unsigned char* ws = wsl;
    int base = 0;
#define SMALL_JOB(SA, SB, KS, DST, LD, KK, NR, NV, MODE) do { const int n_ = ((KK) >> 6) * ((NR) >> 5); const int first_ = ((gw - base) % NGW + NGW) % NGW; \
        for (int it = first_; it < n_; it += NGW) cvt_item(SA, SB, KS, DST, LD, KK, NR, NV, MODE, it, scr, lane_); base += n_; } while (0)
    SMALL_JOB(inp(F, 7), nullptr, nullptr, (bf16_t*)(ws + WS_WDQKV), 704, 1024, 768, 704, 0);
    SMALL_JOB(inp(F, 10), nullptr, inp(F, 8), (bf16_t*)(ws + WS_WUQ), 1536, 384, 1536, 1536, 0);
    SMALL_JOB(inp(F, 11), nullptr, inp(F, 9), (bf16_t*)(ws + WS_WUKV), 2048, 256, 2048, 2048, 0);
    SMALL_JOB(inp(F, 12), nullptr, nullptr, (bf16_t*)(ws + WS_WO), 1024, 1024, 1024, 1024, 0);
    SMALL_JOB(inp(F, 21), inp(F, 21) + 1024, nullptr, (bf16_t*)(ws + WS_WGLU), 2048, 1024, 2048, 2048, 1);
#pragma unroll 1
    for (int l = 0; l < 2; ++l) {
        SMALL_JOB(inp(F, 28) + (size_t)l * 1024 * 256, inp(F, 29) + (size_t)l * 1024 * 256, nullptr, (bf16_t*)(ws + WS_WSHR) + (size_t)l * 768 * 1024, 256, 1024, 512, 512, 1);
        SMALL_JOB(inp(F, 23) + (size_t)l * 1024 * 64, nullptr, nullptr, (bf16_t*)(ws + WS_WSHR) + (size_t)l * 768 * 1024 + (size_t)512 * 1024, 64, 1024, 256, 64, 0);
        SMALL_JOB(inp(F, 30) + (size_t)l * 256 * 1024, nullptr, nullptr, (bf16_t*)(ws + WS_WSHD) + (size_t)l * 1024 * 256, 1024, 256, 1024, 1024, 0);
    }
#undef SMALL_JOB
}
__device__ __forceinline__ void convert_experts(const Args& a, Frame& F, int layer) {
    unsigned char* const wsl = opaque_ptr(a.ws);
    const int tid_ = opaque_tid(), lane_ = tid_ & 63, wave_ = __builtin_amdgcn_readfirstlane(tid_ >> 6);
    LAS float* scr = (LAS float*)(F.lds + wave_ * 16384);
    const int gw = F.vcu * NWAVES + wave_, NGW = F.G * NWAVES;
    for (int it = gw; it < NEXP * 384; it += NGW) { const int e = it / 384, r = it - e * 384; const size_t eo = ((size_t)layer * NEXP + e) * 1024 * 256;
        if (r < 256) cvt_item(inp(F, 25) + eo, inp(F, 26) + eo, nullptr, (bf16_t*)(wsl + WS_W1) + (size_t)e * 512 * 1024, 256, 1024, 512, 512, 1, r, scr, lane_);
        else cvt_item(inp(F, 27) + eo, nullptr, nullptr, (bf16_t*)(wsl + WS_W2) + (size_t)e * 1024 * 256, 1024, 256, 1024, 1024, 0, r - 256, scr, lane_); }
}

__device__ __forceinline__ void mod_phase(const Args& a, Frame& F) {
    unsigned char* const wsl = opaque_ptr(a.ws);
    const int tid_ = opaque_tid(), lane_ = tid_ & 63, wave_ = __builtin_amdgcn_readfirstlane(tid_ >> 6);
    LAS float* sl = (LAS float*)F.lds;
    LAS float* red = sl + 17 * 1024;
    float* MOD = (float*)(wsl + WS_MOD);
    bool have = false;
    for (int u = F.vcu; u < 192; u += F.G) {
        if (!have) { for (int i = tid_; i < 17 * 1024; i += 512) { const float v = i < 16 * 1024 ? inp(F, 1)[i] : inp(F, 3)[i - 16 * 1024]; sl[i] = silu_f(v); } __syncthreads(); have = true; }
        const int l = u / 96, n0 = (u % 96) * 64, kg = tid_ >> 6, col = n0 + (tid_ & 63);
        const float* W = inp(F, 4) + (size_t)l * 1024 * MODW + col;
        float acc[17];
#pragma unroll
        for (int b = 0; b < 17; ++b) acc[b] = 0.f;
#pragma unroll 8
        for (int k = kg; k < 1024; k += 8) { const float w = W[(size_t)k * MODW];
#pragma unroll
            for (int b = 0; b < 17; ++b) acc[b] += sl[b * 1024 + k] * w; }
#pragma unroll
        for (int b = 0; b < 17; ++b) red[(kg * 17 + b) * 64 + (tid_ & 63)] = acc[b];
        __syncthreads();
        for (int i = tid_; i < 17 * 64; i += 512) { const int b = i >> 6, c = i & 63; float s = inp(F, 5)[(size_t)l * MODW + n0 + c];
#pragma unroll
            for (int g = 0; g < 8; ++g) s += red[(g * 17 + b) * 64 + c];
            MOD[((size_t)l * 17 + b) * MODW + n0 + c] = s; }
        __syncthreads();
    }
}
__device__ __forceinline__ void sincos_red(float ang, float& c, float& s) {
    const float k = rintf(ang * 0.15915494309189535f);
    float r = fmaf(-k, 6.2831854820251465f, ang); r = fmaf(-k, -1.7484555314695172e-07f, r);
    s = __sinf(r); c = __cosf(r);
}
__device__ __forceinline__ void rope_phase(const Args& a, Frame& F) {
    unsigned char* const wsl = opaque_ptr(a.ws);
    const int tid_ = opaque_tid(), lane_ = tid_ & 63, wave_ = __builtin_amdgcn_readfirstlane(tid_ >> 6);
    float* ROPE = (float*)(wsl + WS_ROPE);
    for (int i = (F.vcu * 512 + tid_); i < SEQL * 32; i += F.G * 512) { const int t = i >> 5, p = i & 31, j = p & 15;
        const float f = exp2f(-(float)j * (13.287712379549449f / 16.f)); const float pos = (float)(p < 16 ? (t >> 6) : (t & 63));
        float c, s; sincos_red(pos * f, c, s); ROPE[2 * i] = c; ROPE[2 * i + 1] = s; }
}

__device__ __forceinline__ const float* xrow_in(const Args& a, const Frame& F, int layer, int row) {
    unsigned char* const wsl = opaque_ptr(a.ws);
    if (layer == 0) return row < NCTXR ? inp(F, 2) + (size_t)row * DM : inp(F, 0) + (size_t)(row - NCTXR) * DM;
    return row < NCTXR ? (const float*)(wsl + WS_XCTX) + (size_t)row * DM : a.out + (size_t)(row - NCTXR) * DM;
}
__device__ __forceinline__ float* xrow_st(const Args& a, int row) {
    unsigned char* const wsl = opaque_ptr(a.ws); return row < NCTXR ? (float*)(wsl + WS_XCTX) + (size_t)row * DM : a.out + (size_t)(row - NCTXR) * DM; }
__device__ __forceinline__ void norm_mod_store(const f32x4 (&v)[4], const float* g, const float* shift, const float* scale, bf16_t* orow, int lane) {
    float s = 0.f;
#pragma unroll
    for (int j = 0; j < 4; ++j) s += sq4(v[j]);
    const float rstd = __builtin_amdgcn_rsqf(wave_sum(s) * (1.f / DM) + NORM_EPS);
#pragma unroll
    for (int j = 0; j < 4; ++j) { const int c = 4 * lane + 256 * j; const f32x4 gg = *(const f32x4*)(g + c), sh = *(const f32x4*)(shift + c), sc = *(const f32x4*)(scale + c);
        const f32x4 h = (v[j] * rstd * gg) * (sc + 1.f) + sh; u32x2 w; w.x = cvt_pk_bf16(h[0], h[1]); w.y = cvt_pk_bf16(h[2], h[3]); *(u32x2*)(orow + c) = w; }
}
__device__ __forceinline__ void h_phase(const Args& a, Frame& F, int layer, int row_lo) {
    unsigned char* const wsl = opaque_ptr(a.ws);
    const int tid_ = opaque_tid(), lane_ = tid_ & 63, wave_ = __builtin_amdgcn_readfirstlane(tid_ >> 6);
    const float* MOD = (const float*)(wsl + WS_MOD) + (size_t)layer * 17 * MODW; const float* g = inp(F, 6) + (size_t)(layer * 4 + 0) * DM; bf16_t* XN = (bf16_t*)(wsl + WS_XN);
    for (int row = row_lo + F.vcu * NWAVES + wave_; row < NROWS; row += F.G * NWAVES) {
        const float* x = xrow_in(a, F, layer, row); f32x4 v[4];
#pragma unroll
        for (int j = 0; j < 4; ++j) v[j] = *(const f32x4*)(x + 4 * lane_ + 256 * j);
        const float* m = MOD + (size_t)mod_index(row) * MODW;
        norm_mod_store(v, g, m + 0 * DM, m + 1 * DM, XN + (size_t)row * DM, lane_);
    }
}
__device__ __forceinline__ void postmix_phase(const Args& a, Frame& F, int layer, int row_lo, int NS) {
    unsigned char* const wsl = opaque_ptr(a.ws);
    const int tid_ = opaque_tid(), lane_ = tid_ & 63, wave_ = __builtin_amdgcn_readfirstlane(tid_ >> 6);
    const float* MOD = (const float*)(wsl + WS_MOD) + (size_t)layer * 17 * MODW; const float* g1 = inp(F, 6) + (size_t)(layer * 4 + 1) * DM; const float* g2 = inp(F, 6) + (size_t)(layer * 4 + 2) * DM;
    bf16_t* XN = (bf16_t*)(wsl + WS_XN); const bf16_t* OO = (const bf16_t*)(wsl + WS_OO); const float* SSQO = (const float*)(wsl + WS_SSQO);
    for (int row = row_lo + F.vcu * NWAVES + wave_; row < NROWS; row += F.G * NWAVES) {
        const float* x = xrow_in(a, F, layer, row); float* xo = xrow_st(a, row); const float* m = MOD + (size_t)mod_index(row) * MODW;
        float ss = lane_ < NS ? SSQO[(size_t)row * 32 + lane_] : 0.f; ss = wave_sum(ss);
        const float rstd = __builtin_amdgcn_rsqf(ss * (1.f / DM) + NORM_EPS);
        f32x4 v[4];
#pragma unroll
        for (int j = 0; j < 4; ++j) { const int c = 4 * lane_ + 256 * j; const u32x2 ow = *(const u32x2*)(OO + (size_t)row * DM + c);
            const f32x4 o = {bf_lo(ow.x), bf_hi(ow.x), bf_lo(ow.y), bf_hi(ow.y)}; const f32x4 gg = *(const f32x4*)(g1 + c), gt = *(const f32x4*)(m + 2 * DM + c);
            v[j] = *(const f32x4*)(x + c) + gt * (o * rstd * gg); *(f32x4*)(xo + c) = v[j]; }
        norm_mod_store(v, g2, m + 3 * DM, m + 4 * DM, XN + (size_t)row * DM, lane_);
    }
}
constexpr size_t WS_Y     = WS_ST;
constexpr size_t WS_H0    = WS_ST + 216 * MiB;
constexpr size_t WS_H1    = WS_ST + 278 * MiB;
constexpr size_t WS_HSH   = WS_ST + 340 * MiB;
constexpr size_t WS_LOG   = WS_ST + 358 * MiB;
constexpr size_t WS_SELI  = WS_ST + 367 * MiB;
constexpr size_t WS_SELW  = WS_SELI + (size_t)NROWS * 32;
constexpr size_t WS_LDST  = WS_ST + 370 * MiB;
constexpr size_t WS_LW    = WS_LDST + 1536 * 1024;
constexpr size_t WS_BLKCNT= WS_ST + 373 * MiB;
constexpr size_t WS_TINFO = WS_BLKCNT + 256 * 192 * 4;
constexpr int NLIST = 192;
static_assert(WS_TINFO + 4 * (512 + 1600) <= WS_ST + 374 * MiB, "MoE stage map");

template <int NT_, int LDA_, bool PERM_> struct DenseRow0 : DenseBase<NT_, LDA_, PERM_> { int row0; };

struct PolShr : DenseRow0<16, 2048, true> {
    bf16_t* HSH; float* LOG;
    __device__ __forceinline__ void epi(const f32x4 (&acc)[2][2][4][2], const DUnit& u, int wr, int wc, int fr, int fq) const {
#pragma unroll
        for (int ai = 0; ai < 2; ++ai)
#pragma unroll
            for (int m = 0; m < 4; ++m) {
                const int row = row0 + u.pm * 256 + ai * 128 + wr * 64 + m * 16 + fr;
                if (u.pn < 2) {
                    f32x4 h0, h1;
#pragma unroll
                    for (int j = 0; j < 4; ++j) { h0[j] = silu_f(acc[ai][0][m][0][j]) * acc[ai][1][m][0][j]; h1[j] = silu_f(acc[ai][0][m][1][j]) * acc[ai][1][m][1][j]; }
                    store8(HSH + (size_t)row * 256 + u.pn * 128 + wc * 32 + 8 * fq, h0, h1);
                } else if (wc < 2) {
                    float* lp = LOG + (size_t)row * 64 + wc * 32 + 8 * fq; *(f32x4*)lp = acc[ai][0][m][0]; *(f32x4*)(lp + 4) = acc[ai][0][m][1];
                }
            }
    }
};

__device__ __forceinline__ int slot_round(int s) { return s < 2 ? 0 : (s < 5 ? 1 : 2); }
__device__ __forceinline__ int slot_yrow(int s) { return s < 2 ? s + 1 : (s < 5 ? s - 2 : s - 5); }
__device__ __forceinline__ void route_phase(const Args& a, Frame& F, int layer, int row_lo, int tpb) {
    unsigned char* const wsl = opaque_ptr(a.ws);
    const int tid_ = opaque_tid(), lane = tid_ & 63, wave = __builtin_amdgcn_readfirstlane(tid_ >> 6);
    LAS int* cnt = (LAS int*)F.lds;
    for (int i = tid_; i < NLIST; i += 512) cnt[i] = 0;
    __syncthreads();
    const float* LOG = (const float*)(wsl + WS_LOG); int* SELI = (int*)(wsl + WS_SELI); float* SELW = (float*)(wsl + WS_SELW);
    const float bias = inp(F, 24)[layer * NEXP + lane];
    const int blk = F.vcu;
    for (int t = wave; t < tpb; t += NWAVES) {
        const int row = row_lo + blk * tpb + t;
        const float sc = sigmoid_f(LOG[(size_t)row * 64 + lane]), bs = sc + bias;
        float m1 = bs;
        m1 = fmaxf(m1, __shfl_xor(m1, 1)); m1 = fmaxf(m1, __shfl_xor(m1, 2)); m1 = fmaxf(m1, __shfl_xor(m1, 4));
        const unsigned long long eqm = __ballot(bs == m1);
        const int grp = lane >> 3; const unsigned gm = (unsigned)((eqm >> (grp * 8)) & 0xffull);
        float v2 = (bs == m1) ? -INFINITY : bs;
        v2 = fmaxf(v2, __shfl_xor(v2, 1)); v2 = fmaxf(v2, __shfl_xor(v2, 2)); v2 = fmaxf(v2, __shfl_xor(v2, 4));
        const float m2 = (__popc(gm) >= 2) ? m1 : v2;
        const float gs = m1 + m2;
        int grank = 0;
#pragma unroll
        for (int j = 0; j < 8; ++j) { const float o = __shfl(gs, j * 8); grank += (o > gs || (o == gs && j < grp)) ? 1 : 0; }
        const float mv = grank < 4 ? bs : -INFINITY;
        int rank = 0;
#pragma unroll 8
        for (int j = 0; j < 64; ++j) { const float o = __shfl(mv, j); rank += (o > mv || (o == mv && j < lane)) ? 1 : 0; }
        const bool sel = rank < TOPK && grank < 4;
        const float ssum = wave_sum(sel ? sc : 0.f);
        if (sel) { const int s = rank, l = slot_round(s) * 64 + lane;
            SELI[(size_t)row * 8 + s] = l | (slot_yrow(s) << 8); SELW[(size_t)row * 8 + s] = sc / ssum * 2.5f;
            atomicAdd((int*)&cnt[l], 1); }
    }
    __syncthreads();
    int* BLKCNT = (int*)(wsl + WS_BLKCNT);
    for (int i = tid_; i < NLIST; i += 512) BLKCNT[blk * NLIST + i] = cnt[i];
}
__device__ __forceinline__ void place_phase(const Args& a, Frame& F, int row_lo, int tpb) {
    unsigned char* const wsl = opaque_ptr(a.ws);
    const int tid_ = opaque_tid();
    LAS int* tot = (LAS int*)F.lds; LAS int* mine = tot + 256; LAS int* tst = mine + 256; LAS int* cur = tst + 256;
    const int* BLKCNT = (const int*)(wsl + WS_BLKCNT); const int blk = F.vcu;
    if (tid_ < NLIST) { int s = 0, m = 0; for (int b = 0; b < F.G; ++b) { const int c = BLKCNT[b * NLIST + tid_]; m += (b < blk) ? c : 0; s += c; } tot[tid_] = s; mine[tid_] = m; cur[tid_] = 0; }
    __syncthreads();
    if (tid_ == 0) { int acc = 0; for (int l = 0; l < NLIST; ++l) { tst[l] = acc; acc += (tot[l] + 255) >> 8; } tst[NLIST] = acc; }
    __syncthreads();
    int* TINFO = (int*)(wsl + WS_TINFO); int* LDST = (int*)(wsl + WS_LDST); float* LW = (float*)(wsl + WS_LW);
    if (blk == 0) {
        for (int i = tid_; i <= NLIST; i += 512) TINFO[i] = tst[i];
        for (int i = tid_; i < NLIST; i += 512) TINFO[256 + i] = tot[i];
        for (int l = 0; l < NLIST; ++l) { const int t0 = tst[l], t1 = tst[l + 1];
            for (int t = t0 + tid_; t < t1; t += 512) TINFO[512 + t] = l;
            const int c = tot[l], base = t0 * 256;
            for (int p = c + tid_; p < (t1 - t0) * 256; p += 512) LDST[base + p] = -1; }
    }
    const int* SELI = (const int*)(wsl + WS_SELI); const float* SELW = (const float*)(wsl + WS_SELW);
    for (int i = tid_; i < tpb * 8; i += 512) { const int row = row_lo + blk * tpb + (i >> 3), s = i & 7;
        const int v = SELI[(size_t)row * 8 + s], l = v & 0xff, yr = v >> 8;
        const int pos = tst[l] * 256 + mine[l] + atomicAdd((int*)&cur[l], 1);
        LDST[pos] = row * 3 + yr; LW[pos] = SELW[(size_t)row * 8 + s]; }
}

struct MUnit { int T, pn; };
struct PolMoe1 {
    static constexpr bool PERM = true, GATHER = true, TWOSEG = false;
    static constexpr int NT = 16, KT0 = 16, KS0 = 128, KS1 = 128, LDB = 2048;
    typedef MUnit Unit;
    const char* XN; const char* W1; bf16_t* H; const int* TINFO; const int* LDST; int T0, T1, G, c;
    __device__ __forceinline__ bool next(int i, Unit& u) const { const int L = i * G + c; u.T = T0 + (L >> 1); u.pn = L & 1; return u.T < T1; }
    __device__ __forceinline__ void ctx(const Unit& u, pg8::UCtx<true>& x, const int (&R)[2], const int (&C)[2]) const {
        const int e = __builtin_amdgcn_readfirstlane(TINFO[512 + u.T]) & 63;
        x.a0[0] = XN; x.a0[1] = XN; x.a1[0] = XN; x.a1[1] = XN; x.b = W1 + ((size_t)e * 512 + u.pn * 256) * LDB;
#pragma unroll
        for (int h = 0; h < 2; ++h)
#pragma unroll
            for (int i = 0; i < 2; ++i) { const int d = LDST[u.T * 256 + h * 128 + R[i]]; const int tok = d < 0 ? 0 : d / 3; x.vg[h][i] = (unsigned)tok * 2048u + (unsigned)C[i] * 2u; }
    }
    __device__ __forceinline__ unsigned lane_a0(int, int) const { return 0u; }
    __device__ __forceinline__ unsigned lane_a1(int, int) const { return 0u; }
    __device__ __forceinline__ void epi(const f32x4 (&acc)[2][2][4][2], const Unit& u, int wr, int wc, int fr, int fq) const {
#pragma unroll
        for (int ai = 0; ai < 2; ++ai)
#pragma unroll
            for (int m = 0; m < 4; ++m) {
                const int hrow = (u.T - T0) * 256 + ai * 128 + wr * 64 + m * 16 + fr;
                f32x4 h0, h1;
#pragma unroll
                for (int j = 0; j < 4; ++j) { h0[j] = silu_f(acc[ai][0][m][0][j]) * acc[ai][1][m][0][j]; h1[j] = silu_f(acc[ai][0][m][1][j]) * acc[ai][1][m][1][j]; }
                store8(H + (size_t)hrow * 256 + u.pn * 128 + wc * 32 + 8 * fq, h0, h1);
            }
    }
};
template <bool RMW> struct PolMoe2 {
    static constexpr bool PERM = true, GATHER = false, TWOSEG = false;
    static constexpr int NT = 4, KT0 = 4, KS0 = 128, KS1 = 128, LDB = 512;
    typedef MUnit Unit;
    const char* H; const char* W2; bf16_t* Y; const int* TINFO; const int* LDST; const float* LW; int T0, T1, G, c;
    __device__ __forceinline__ bool next(int i, Unit& u) const { const int L = i * G + c; u.T = T0 + (L >> 2); u.pn = L & 3; return u.T < T1; }
    __device__ __forceinline__ void ctx(const Unit& u, pg8::UCtx<false>& x, const int (&)[2], const int (&)[2]) const {
        const int e = __builtin_amdgcn_readfirstlane(TINFO[512 + u.T]) & 63;
        x.a0[0] = H + (size_t)(u.T - T0) * 256 * 512; x.a0[1] = x.a0[0] + 128 * 512; x.a1[0] = x.a0[0]; x.a1[1] = x.a0[1];
        x.b = W2 + ((size_t)e * 1024 + u.pn * 256) * LDB;
    }
    __device__ __forceinline__ unsigned lane_a0(int R, int C) const { return (unsigned)(R * 512 + C * 2); }
    __device__ __forceinline__ unsigned lane_a1(int, int) const { return 0u; }
    __device__ __forceinline__ void epi(const f32x4 (&acc)[2][2][4][2], const Unit& u, int wr, int wc, int fr, int fq) const {
#pragma unroll
        for (int ai = 0; ai < 2; ++ai)
#pragma unroll
            for (int m = 0; m < 4; ++m) {
                const int lp = u.T * 256 + ai * 128 + wr * 64 + m * 16 + fr;
                const int d = LDST[lp]; const float w = LW[lp];
                if (d >= 0) {
                    bf16_t* yp = Y + (size_t)d * DM + u.pn * 256 + wc * 32 + 8 * fq;
#pragma unroll
                    for (int bj = 0; bj < 2; ++bj) {
                        f32x4 v0 = acc[ai][bj][m][0] * w, v1 = acc[ai][bj][m][1] * w;
                        if (RMW) { const u32x4 o = *(const u32x4*)(yp + bj * 128);
                            v0 += (f32x4){bf_lo(o.x), bf_hi(o.x), bf_lo(o.y), bf_hi(o.y)}; v1 += (f32x4){bf_lo(o.z), bf_hi(o.z), bf_lo(o.w), bf_hi(o.w)}; }
                        store8(yp + bj * 128, v0, v1);
                    }
                }
            }
    }
};
struct PolShd : DenseRow0<4, 512, true> {
    bf16_t* Y;
    __device__ __forceinline__ void epi(const f32x4 (&acc)[2][2][4][2], const DUnit& u, int wr, int wc, int fr, int fq) const {
#pragma unroll
        for (int ai = 0; ai < 2; ++ai)
#pragma unroll
            for (int m = 0; m < 4; ++m) {
                const int row = row0 + u.pm * 256 + ai * 128 + wr * 64 + m * 16 + fr;
                bf16_t* yp = Y + (size_t)row * 3 * DM + u.pn * 256 + wc * 32 + 8 * fq;
                store8(yp, acc[ai][0][m][0], acc[ai][0][m][1]); store8(yp + 128, acc[ai][1][m][0], acc[ai][1][m][1]);
            }
    }
};

__device__ __forceinline__ void combine_phase(const Args& a, Frame& F, int layer, int row_lo) {
    unsigned char* const wsl = opaque_ptr(a.ws);
    const int tid_ = opaque_tid(), lane_ = tid_ & 63, wave_ = __builtin_amdgcn_readfirstlane(tid_ >> 6);
    const float* MOD = (const float*)(wsl + WS_MOD) + (size_t)layer * 17 * MODW; const float* g3 = inp(F, 6) + (size_t)(layer * 4 + 3) * DM;
    const float* MODn = (const float*)(wsl + WS_MOD) + (size_t)1 * 17 * MODW; const float* gn = inp(F, 6) + (size_t)(1 * 4 + 0) * DM;
    bf16_t* XN = (bf16_t*)(wsl + WS_XN); const bf16_t* Y = (const bf16_t*)(wsl + WS_Y);
    for (int row = row_lo + F.vcu * NWAVES + wave_; row < NROWS; row += F.G * NWAVES) {
        float* xo = xrow_st(a, row); const float* m = MOD + (size_t)mod_index(row) * MODW;
        f32x4 f[4]; float ss = 0.f;
#pragma unroll
        for (int j = 0; j < 4; ++j) { const int c = 4 * lane_ + 256 * j; f[j] = (f32x4){0.f, 0.f, 0.f, 0.f};
#pragma unroll
            for (int r = 0; r < 3; ++r) { const u32x2 w = *(const u32x2*)(Y + ((size_t)row * 3 + r) * DM + c); f[j] += (f32x4){bf_lo(w.x), bf_hi(w.x), bf_lo(w.y), bf_hi(w.y)}; }
            ss += sq4(f[j]); }
        const float rstd = __builtin_amdgcn_rsqf(wave_sum(ss) * (1.f / DM) + NORM_EPS);
        f32x4 v[4];
#pragma unroll
        for (int j = 0; j < 4; ++j) { const int c = 4 * lane_ + 256 * j; const f32x4 gg = *(const f32x4*)(g3 + c), gt = *(const f32x4*)(m + 5 * DM + c);
            v[j] = *(const f32x4*)(xo + c) + gt * (f[j] * rstd * gg); *(f32x4*)(xo + c) = v[j]; }
        if (layer == 0) { const float* mn = MODn + (size_t)mod_index(row) * MODW; norm_mod_store(v, gn, mn + 0 * DM, mn + 1 * DM, XN + (size_t)row * DM, lane_); }
    }
}
constexpr size_t WS_G    = WS_ST;
constexpr size_t WS_BTY  = WS_ST + 216 * MiB;
constexpr size_t WS_BTS  = WS_ST + 264 * MiB;
constexpr size_t WS_S    = WS_ST + 280 * MiB;
constexpr size_t WS_XIN  = WS_ST + 64 * MiB;
constexpr size_t WS_LAMT = WS_ROPE + 512 * 1024;
constexpr int S5_T = 32;

__device__ __forceinline__ f32x2 cmul(f32x2 a, f32x2 b) { return (f32x2){a.x * b.x - a.y * b.y, a.x * b.y + a.y * b.x}; }
__device__ __forceinline__ void s5_tables_group(const Args& a, Frame& F, int g) {
    unsigned char* const wsl = opaque_ptr(a.ws);
    const int tid = opaque_tid();
    LAS float* Kd = (LAS float*)F.lds; LAS f32x2* pw = (LAS f32x2*)(F.lds + 65536); LAS f32x2* bb = pw + 33 * 64; LAS f32x2* cm = bb + 64 * 16;
    bf16_t* BTY = (bf16_t*)(wsl + WS_BTY) + (size_t)g * 512 * 768; bf16_t* BTS = (bf16_t*)(wsl + WS_BTS) + (size_t)g * 256 * 512; float* LAMT = (float*)(wsl + WS_LAMT);
    const float* lre = inp(F, 13); const float* lim = inp(F, 14); const float* lst = inp(F, 15);
    const float* bre = inp(F, 16); const float* bim = inp(F, 17); const float* cre = inp(F, 18); const float* cim = inp(F, 19); const float* dsk = inp(F, 20);
    for (int d = 0; d < 2; ++d) {
        __syncthreads();
        const float step = __expf(lst[d * 64 + g]);
        for (int i = tid; i < 33 * 64; i += 512) { const int k = i >> 6, p = i & 63; const float lr = lre[(d * 64 + g) * 64 + p], li = lim[(d * 64 + g) * 64 + p];
            const float mag = __expf((float)k * lr * step); float c, s; sincos_red((float)k * (li * step), c, s); pw[i] = (f32x2){mag * c, mag * s}; }
        __syncthreads();
        for (int i = tid; i < 64 * 16; i += 512) { const int p = i >> 4; const float lr = lre[(d * 64 + g) * 64 + p], li = lim[(d * 64 + g) * 64 + p];
            const f32x2 lb = pw[64 + p]; const float inv = 1.f / (lr * lr + li * li);
            const f32x2 kap = {((lb.x - 1.f) * lr + lb.y * li) * inv, (lb.y * lr - (lb.x - 1.f) * li) * inv};
            const size_t o = ((size_t)(d * 64 + g) * 64 + p) * 16 + (i & 15); bb[i] = cmul(kap, (f32x2){bre[o], bim[o]}); }
        for (int i = tid; i < 16 * 64; i += 512) { const size_t o = (size_t)(d * 64 + g) * 1024 + i; cm[i] = (f32x2){cre[o], cim[o]}; }
        __syncthreads();
        if (tid < 64) { const f32x2 l32 = pw[32 * 64 + tid]; LAMT[((d * 64 + g) * 64 + tid) * 2] = l32.x; LAMT[((d * 64 + g) * 64 + tid) * 2 + 1] = l32.y; }
        for (int o = tid; o < 32 * 256; o += 512) { const int k = o >> 8, i = (o >> 4) & 15, j = o & 15; float acc = 0.f;
            for (int p = 0; p < 64; ++p) { const f32x2 t = cmul(cm[i * 64 + p], pw[k * 64 + p]); const f32x2 b = bb[p * 16 + j]; acc += t.x * b.x - t.y * b.y; }
            Kd[d * 8192 + o] = acc; }
        for (int o = tid; o < 512 * 64; o += 512) { const int n = o >> 6, p = o & 63, to = n >> 4, i = n & 15;
            const f32x2 w = cmul(cm[i * 64 + p], pw[(d == 0 ? to + 1 : 32 - to) * 64 + p]);
            *(unsigned*)(BTY + (size_t)n * 768 + 512 + 128 * d + 2 * p) = cvt_pk_bf16(w.x, -w.y); }
        for (int o = tid; o < 64 * 256; o += 512) { const int p = o >> 8, kk = (o & 255) * 2, ti = kk >> 4, j = kk & 15;
            const f32x2 pwv = pw[(d == 0 ? 31 - ti : ti) * 64 + p]; const f32x2 v0 = cmul(pwv, bb[p * 16 + j]), v1 = cmul(pwv, bb[p * 16 + j + 1]);
            *(unsigned*)(BTS + (size_t)(128 * d + 2 * p) * 512 + kk) = cvt_pk_bf16(v0.x, v1.x); *(unsigned*)(BTS + (size_t)(128 * d + 2 * p + 1) * 512 + kk) = cvt_pk_bf16(v0.y, v1.y); }
    }
    __syncthreads();
    for (int o = tid; o < 512 * 256; o += 512) { const int n = o >> 8, kk = (o & 255) * 2, to = n >> 4, i = n & 15, ti = kk >> 4, j = kk & 15;
        float v0, v1;
        if (to > ti) { v0 = Kd[(to - ti) * 256 + i * 16 + j]; v1 = Kd[(to - ti) * 256 + i * 16 + j + 1]; }
        else if (to < ti) { v0 = Kd[8192 + (ti - to) * 256 + i * 16 + j]; v1 = Kd[8192 + (ti - to) * 256 + i * 16 + j + 1]; }
        else { v0 = Kd[i * 16 + j] + Kd[8192 + i * 16 + j] + (i == j ? dsk[g * 16 + i] : 0.f); v1 = Kd[i * 16 + j + 1] + Kd[8192 + i * 16 + j + 1] + (i == j + 1 ? dsk[g * 16 + i] : 0.f); }
        *(unsigned*)(BTY + (size_t)n * 768 + kk) = cvt_pk_bf16(v0, v1); }
    __syncthreads();
}
__device__ __forceinline__ void s5_tables_phase(const Args& a, Frame& F) {
    unsigned char* const wsl = opaque_ptr(a.ws); for (int g = F.vcu; g < 64; g += F.G) s5_tables_group(a, F, g); }

struct SUnit { int g, pm, pn; };
struct PolS5S {
    static constexpr bool PERM = false, GATHER = false, TWOSEG = false;
    static constexpr int NT = 8, KT0 = 8, KS0 = 8192, KS1 = 128, LDB = 1024;
    typedef SUnit Unit;
    const char* XN; const char* BTS; float* S; int G, c;
    __device__ __forceinline__ bool next(int i, Unit& u) const { const int L = i * G + c; u.g = __builtin_amdgcn_readfirstlane(L / 5); u.pm = __builtin_amdgcn_readfirstlane(L % 5); u.pn = 0; return L < 320; }
    __device__ __forceinline__ void ctx(const Unit& u, pg8::UCtx<false>& x, const int (&)[2], const int (&)[2]) const {
        if (u.pm < 4) { x.a0[0] = XN + ((size_t)NCTXR + (size_t)u.pm * 256 * S5_T) * 2048 + u.g * 32; x.a0[1] = x.a0[0] + (size_t)128 * S5_T * 2048; }
        else { x.a0[0] = XN + u.g * 32; x.a0[1] = x.a0[0]; }
        x.a1[0] = x.a0[0]; x.a1[1] = x.a0[1]; x.b = BTS + (size_t)u.g * 256 * LDB;
    }
    __device__ __forceinline__ unsigned lane_a0(int R, int C) const { return (unsigned)(R * (S5_T * 2048) + (C >> 4) * 2048 + (C & 15) * 2); }
    __device__ __forceinline__ unsigned lane_a1(int, int) const { return 0u; }
    __device__ __forceinline__ void epi(const f32x4 (&acc)[2][2][4][2], const Unit& u, int wr, int wc, int fr, int fq) const {
#pragma unroll
        for (int ai = 0; ai < 2; ++ai) { if (u.pm == 4 && ai == 1) continue;
#pragma unroll
            for (int m = 0; m < 4; ++m) { const int r = u.pm * 256 + ai * 128 + wr * 64 + m * 16 + fr;
                float* sp = S + ((size_t)u.g * 1152 + r) * 256 + wc * 32 + 4 * fq;
#pragma unroll
                for (int bj = 0; bj < 2; ++bj)
#pragma unroll
                    for (int n = 0; n < 2; ++n) *(f32x4*)(sp + bj * 128 + n * 16) = acc[ai][bj][m][n]; } }
    }
};
__device__ __forceinline__ void s5_scan_phase(const Args& a, Frame& F) {
    unsigned char* const wsl = opaque_ptr(a.ws);
    const int tid = opaque_tid(); const float* S = (const float*)(wsl + WS_S); bf16_t* XIN = (bf16_t*)(wsl + WS_XIN); const float* LAMT = (const float*)(wsl + WS_LAMT);
    for (int idx = F.vcu * 512 + tid; idx < 64 * 16 * 2 * 64; idx += F.G * 512) {
        const int p = idx & 63, d = (idx >> 6) & 1, b = (idx >> 7) & 15, g = idx >> 11;
        const f32x2 Lm = *(const f32x2*)(LAMT + ((d * 64 + g) * 64 + p) * 2);
        const float* Sg = S + (size_t)g * 1152 * 256 + d * 128 + 2 * p; const int col = d * 128 + 2 * p; bf16_t* Xg = XIN + (size_t)(col >> 4) * 1024 + 16 * g + (col & 15);
        f32x2 x = {0.f, 0.f};
        f32x2 sv[8];
#pragma unroll
        for (int k = 0; k < 8; ++k) { const int c = d == 0 ? k : 7 - k; sv[k] = *(const f32x2*)(Sg + (size_t)(1024 + b * 8 + c) * 256); }
#pragma unroll
        for (int k = 0; k < 8; ++k) x = cmul(Lm, x) + sv[k];
        for (int c0 = 0; c0 < 64; c0 += 8) {
#pragma unroll
            for (int k = 0; k < 8; ++k) { const int c = d == 0 ? c0 + k : 63 - c0 - k; sv[k] = *(const f32x2*)(Sg + (size_t)(b * 64 + c) * 256); }
#pragma unroll
            for (int k = 0; k < 8; ++k) { const int c = d == 0 ? c0 + k : 63 - c0 - k; *(unsigned*)(Xg + (size_t)(b * 64 + c) * 32 * 1024) = cvt_pk_bf16(x.x, x.y); x = cmul(Lm, x) + sv[k]; }
        }
    }
}
struct PolS5Y {
    static constexpr bool PERM = true, GATHER = false, TWOSEG = true;
    static constexpr int NT = 12, KT0 = 8, KS0 = 8192, KS1 = 8192, LDB = 1536;
    typedef SUnit Unit;
    const char* XN; const char* XIN; const char* BTY; bf16_t* Gb; int G, c;
    __device__ __forceinline__ bool next(int i, Unit& u) const { const int L = i * G + c; u.g = __builtin_amdgcn_readfirstlane(L >> 3); u.pm = __builtin_amdgcn_readfirstlane((L >> 1) & 3); u.pn = L & 1; return L < 512; }
    __device__ __forceinline__ void ctx(const Unit& u, pg8::UCtx<false>& x, const int (&)[2], const int (&)[2]) const {
        x.a0[0] = XN + ((size_t)NCTXR + (size_t)u.pm * 256 * S5_T) * 2048 + u.g * 32; x.a0[1] = x.a0[0] + (size_t)128 * S5_T * 2048;
        x.a1[0] = XIN + (size_t)u.pm * 256 * S5_T * 2048 + u.g * 32; x.a1[1] = x.a1[0] + (size_t)128 * S5_T * 2048;
        x.b = BTY + ((size_t)u.g * 512 + u.pn * 256) * LDB;
    }
    __device__ __forceinline__ unsigned lane_a0(int R, int C) const { return (unsigned)(R * (S5_T * 2048) + (C >> 4) * 2048 + (C & 15) * 2); }
    __device__ __forceinline__ void epi(const f32x4 (&acc)[2][2][4][2], const Unit& u, int wr, int wc, int fr, int fq) const {
#pragma unroll
        for (int ai = 0; ai < 2; ++ai)
#pragma unroll
            for (int m = 0; m < 4; ++m) { const int r = u.pm * 256 + ai * 128 + wr * 64 + m * 16 + fr;
#pragma unroll
                for (int bj = 0; bj < 2; ++bj) { const int col = u.pn * 256 + bj * 128 + wc * 32 + 8 * fq, to = col >> 4, i0 = col & 15;
                    bf16_t* gp = Gb + ((size_t)r * S5_T + to) * DM + u.g * 16 + i0;
#pragma unroll
                    for (int n = 0; n < 2; ++n) { f32x4 v;
#pragma unroll
                        for (int j = 0; j < 4; ++j) v[j] = gelu_tanh(acc[ai][bj][m][n][j]);
                        u32x2 w; w.x = cvt_pk_bf16(v[0], v[1]); w.y = cvt_pk_bf16(v[2], v[3]); *(u32x2*)(gp + 4 * n) = w; asm volatile("" ::: "memory"); } } }
    }
};
struct PolGlu : DenseRow0<16, 2048, true> {
    bf16_t* OO; float* SSQO; const float* bias;
    __device__ __forceinline__ void epi(const f32x4 (&acc)[2][2][4][2], const DUnit& u, int wr, int wc, int fr, int fq) const {
        const int c0 = u.pn * 128 + wc * 32 + 8 * fq;
        const f32x4 b10 = *(const f32x4*)(bias + c0), b11 = *(const f32x4*)(bias + c0 + 4), b20 = *(const f32x4*)(bias + 1024 + c0), b21 = *(const f32x4*)(bias + 1024 + c0 + 4);
#pragma unroll
        for (int ai = 0; ai < 2; ++ai)
#pragma unroll
            for (int m = 0; m < 4; ++m) {
                const int row = row0 + u.pm * 256 + ai * 128 + wr * 64 + m * 16 + fr;
                f32x4 o0, o1;
#pragma unroll
                for (int j = 0; j < 4; ++j) { o0[j] = (acc[ai][0][m][0][j] + b10[j]) * sigmoid_f(acc[ai][1][m][0][j] + b20[j]); o1[j] = (acc[ai][0][m][1][j] + b11[j]) * sigmoid_f(acc[ai][1][m][1][j] + b21[j]); }
                float s = sq4(o0) + sq4(o1);
                store8(OO + (size_t)row * DM + c0, o0, o1);
                s += __shfl_xor(s, 16); s += __shfl_xor(s, 32);
                if (fq == 0) SSQO[(size_t)row * 32 + u.pn * 4 + wc] = s;
            }
    }
};
#ifndef REP_ATTN
#define REP_ATTN 1
#endif
#ifndef REP_MISC
#define REP_MISC 1
#endif
#ifndef REP_DENSE
#define REP_DENSE 1
#endif
#ifndef REP_G2A
#define REP_G2A 1
#endif
#ifndef REP_G1
#define REP_G1 1
#endif
__device__ __forceinline__ void moe_stage(const Args& args, Frame& F, const XcdBarrier& bar, int layer, int row_lo) {
    const int nrows = NROWS - row_lo, tpb = nrows / F.G;
    {   unsigned char* ws = opaque_ptr(args.ws);
        PolShr p; p.A = (const char*)(ws + WS_XN) + (size_t)row_lo * 2048; p.Bt = (const char*)(ws + WS_WSHR) + (size_t)layer * 768 * 2048; p.nM = nrows / 256; p.nN = 3; p.G = F.G; p.c = (int)blockIdx.x;
        p.row0 = row_lo; p.HSH = (bf16_t*)(ws + WS_HSH); p.LOG = (float*)(ws + WS_LOG);
        for (int rep_ = 0; rep_ < REP_DENSE; ++rep_) pg8::gemm_phase(F.lds, p);
    }
    if (layer == 1 && args.stage == 7) return;
    xcd_barrier(bar);
    route_phase(args, F, layer, row_lo, tpb);
#if REP_MISC == 2
    __syncthreads(); route_phase(args, F, layer, row_lo, tpb);
#endif
    if (layer == 1 && args.stage == 8) return;
    xcd_barrier(bar);
    place_phase(args, F, row_lo, tpb);
#if REP_MISC == 2
    __syncthreads(); place_phase(args, F, row_lo, tpb);
#endif
    if (layer == 1 && args.stage == 9) return;
    xcd_barrier(bar);
    const int* TINFO = (const int*)(opaque_ptr(args.ws) + WS_TINFO);
    const int ts0 = __builtin_amdgcn_readfirstlane(TINFO[0]), ts1 = __builtin_amdgcn_readfirstlane(TINFO[64]), ts2 = __builtin_amdgcn_readfirstlane(TINFO[128]), ts3 = __builtin_amdgcn_readfirstlane(TINFO[192]);
#define MOE_G1(TA, TB, HBUF) for (int rep_ = 0; rep_ < REP_G1; ++rep_) do { unsigned char* ws = opaque_ptr(args.ws); PolMoe1 p; p.XN = (const char*)(ws + WS_XN); p.W1 = (const char*)(ws + WS_W1); p.H = (bf16_t*)(ws + (HBUF)); p.TINFO = (const int*)(ws + WS_TINFO); p.LDST = (const int*)(ws + WS_LDST); p.T0 = (TA); p.T1 = (TB); p.G = F.G; p.c = (int)blockIdx.x; \
        pg8::gemm_phase(F.lds, p); } while (0)
#define MOE_G2(RMW, TA, TB, HBUF) do { unsigned char* ws = opaque_ptr(args.ws); PolMoe2<RMW> p; p.H = (const char*)(ws + (HBUF)); p.W2 = (const char*)(ws + WS_W2); p.Y = (bf16_t*)(ws + WS_Y); p.TINFO = (const int*)(ws + WS_TINFO); p.LDST = (const int*)(ws + WS_LDST); p.LW = (const float*)(ws + WS_LW); p.T0 = (TA); p.T1 = (TB); p.G = F.G; p.c = (int)blockIdx.x; \
        pg8::gemm_phase(F.lds, p); } while (0)
    MOE_G1(ts0, ts1, WS_H0);
    if (layer == 1 && args.stage == 10) return;
    xcd_barrier(bar);
    for (int rep2_ = 0; rep2_ < REP_G2A; ++rep2_) MOE_G2(false, ts0, ts1, WS_H0);
    {   unsigned char* ws = opaque_ptr(args.ws);
        PolShd p; p.A = (const char*)(ws + WS_HSH) + (size_t)row_lo * 512; p.Bt = (const char*)(ws + WS_WSHD) + (size_t)layer * 1024 * 512; p.nM = nrows / 256; p.nN = 4; p.G = F.G; p.c = (int)blockIdx.x;
        p.row0 = row_lo; p.Y = (bf16_t*)(ws + WS_Y);
        for (int rep_ = 0; rep_ < REP_G2A; ++rep_) pg8::gemm_phase(F.lds, p);
    }
    MOE_G1(ts1, ts2, WS_H1);
    if (layer == 1 && args.stage == 11) return;
    xcd_barrier(bar);
    MOE_G2(true, ts1, ts2, WS_H1);
    MOE_G1(ts2, ts3, WS_H0);
    if (layer == 1 && args.stage == 12) return;
    xcd_barrier(bar);
    MOE_G2(true, ts2, ts3, WS_H0);
    if (layer == 1 && args.stage == 13) return;
    xcd_barrier(bar);
    if (layer == 0) { convert_experts(args, F, 1); s5_tables_phase(args, F); }
    combine_phase(args, F, layer, row_lo);
#undef MOE_G1
#undef MOE_G2
}

__global__ void __launch_bounds__(NWAVES * 64, 2) trunk_fwd(Args args) {
    extern __shared__ __attribute__((aligned(16))) unsigned char lds_raw[];
    Frame F;
    F.lds = (LAS unsigned char*)lds_raw;
    F.G = gridDim.x; { const int bx = blockIdx.x; F.vcu = (F.G % 8 == 0) ? (bx % 8) * (F.G / 8) + bx / 8 : bx; }
    F.ws = args.ws;
    volatile LAS unsigned* MISC = (volatile LAS unsigned*)(F.lds + LDSCTL_OFF);
    for (int u = threadIdx.x; u < (LDS_BYTES - LDSCTL_OFF) / 4; u += NWAVES * 64) ((LAS unsigned*)(F.lds + LDSCTL_OFF))[u] = 0u;
    __syncthreads();
    if (threadIdx.x < 31) ((LAS unsigned long long*)(F.lds + PTAB_OFF))[threadIdx.x] = (unsigned long long)args.in[threadIdx.x];
    __syncthreads();
    XcdBarrier bar = xcd_barrier_post((unsigned*)(args.ws + WS_CTL) + CW_BAR, MISC + 8);
#define GRID_BAR() xcd_barrier(bar)

    mod_phase(args, F);
    __syncthreads();
    convert_small(args, F);
    rope_phase(args, F);
    convert_experts(args, F, 0);
#if REP_MISC == 2
    __syncthreads();
    mod_phase(args, F);
    __syncthreads();
    convert_small(args, F);
    rope_phase(args, F);
    convert_experts(args, F, 0);
#endif
    GRID_BAR();
    h_phase(args, F, 0, 0);
    GRID_BAR();
    {   unsigned char* ws = opaque_ptr(args.ws);
        PolDqkv p; p.A = (const char*)(ws + WS_XN); p.Bt = (const char*)(ws + WS_WDQKV); p.nM = NROWS / 256; p.nN = 3; p.G = F.G; p.c = (int)blockIdx.x;
        p.A1 = (bf16_t*)(ws + WS_A1); p.SSQ1 = (float*)(ws + WS_SSQ1); p.KPE = (bf16_t*)(ws + WS_KPE); p.ROPE = (const float*)(ws + WS_ROPE);
        for (int rep_ = 0; rep_ < REP_DENSE; ++rep_) pg8::gemm_phase(F.lds, p);
    }
    GRID_BAR();
    {   unsigned char* ws = opaque_ptr(args.ws);
        PolQup p; p.A = (const char*)(ws + WS_A1); p.Bt = (const char*)(ws + WS_WUQ); p.nM = NROWS / 256; p.nN = NQ / 256; p.G = F.G; p.c = (int)blockIdx.x;
        p.Q = (bf16_t*)(ws + WS_Q); p.SSQ1 = (const float*)(ws + WS_SSQ1); p.ROPE = (const float*)(ws + WS_ROPE);
        for (int rep_ = 0; rep_ < REP_DENSE; ++rep_) pg8::gemm_phase(F.lds, p);
    }
    {   unsigned char* ws = opaque_ptr(args.ws);
        PolKVup p; p.A = (const char*)(ws + WS_A1) + QLORA * 2; p.Bt = (const char*)(ws + WS_WUKV); p.nM = NROWS / 256; p.nN = NKV / 256; p.G = F.G; p.c = (int)blockIdx.x;
        p.KV = (bf16_t*)(ws + WS_KV); p.SSQ1 = (const float*)(ws + WS_SSQ1);
        for (int rep_ = 0; rep_ < REP_DENSE; ++rep_) pg8::gemm_phase(F.lds, p);
    }
    GRID_BAR();
    {   unsigned char* ws = opaque_ptr(args.ws);
        const bf16_t* Qg = (const bf16_t*)(ws + WS_Q); const bf16_t* KVb = (const bf16_t*)(ws + WS_KV); const bf16_t* KPE = (const bf16_t*)(ws + WS_KPE); bf16_t* Og = (bf16_t*)(ws + WS_O);
        for (int rep_ = 0; rep_ < REP_ATTN; ++rep_)
        for (int u = F.vcu; u < 1024 + 128; u += F.G) {
            if (u < 1024) { const int bh = u >> 3, qb = u & 7, b = bh >> 3, h = bh & 7;
                attn::attn_unit(Qg, KVb, KPE, Og, NCTXR + b * SEQL + qb * 256, h, b * NCTX, NCTXR + b * SEQL, 36, (char*)lds_raw); }
            else { const int bh = u - 1024, b = bh >> 3, h = bh & 7;
                attn::attn_unit(Qg, KVb, KPE, Og, b * NCTX, h, b * NCTX, 0, 4, (char*)lds_raw); }
        }
    }
    GRID_BAR();
    {   unsigned char* ws = opaque_ptr(args.ws);
        PolWo p; p.A = (const char*)(ws + WS_O); p.Bt = (const char*)(ws + WS_WO); p.nM = NROWS / 256; p.nN = 4; p.G = F.G; p.c = (int)blockIdx.x;
        p.OO = (bf16_t*)(ws + WS_OO); p.SSQO = (float*)(ws + WS_SSQO);
        for (int rep_ = 0; rep_ < REP_DENSE; ++rep_) pg8::gemm_phase(F.lds, p);
    }
    GRID_BAR();
    postmix_phase(args, F, 0, 0, 16);
    GRID_BAR();
    moe_stage(args, F, bar, 0, 0);
    if (args.stage == 1) return;
    GRID_BAR();
    {   unsigned char* ws = opaque_ptr(args.ws);
        PolS5S p; p.XN = (const char*)(ws + WS_XN); p.BTS = (const char*)(ws + WS_BTS); p.S = (float*)(ws + WS_S); p.G = F.G; p.c = (int)blockIdx.x;
        for (int rep_ = 0; rep_ < REP_DENSE; ++rep_) pg8::gemm_phase(F.lds, p);
    }
    if (args.stage == 2) return;
    GRID_BAR();
    s5_scan_phase(args, F);
#if REP_MISC == 2
    s5_scan_phase(args, F);
#endif
    if (args.stage == 3) return;
    GRID_BAR();
    {   unsigned char* ws = opaque_ptr(args.ws);
        PolS5Y p; p.XN = (const char*)(ws + WS_XN); p.XIN = (const char*)(ws + WS_XIN); p.BTY = (const char*)(ws + WS_BTY); p.Gb = (bf16_t*)(ws + WS_G); p.G = F.G; p.c = (int)blockIdx.x;
        for (int rep_ = 0; rep_ < REP_DENSE; ++rep_) pg8::gemm_phase(F.lds, p);
    }
    if (args.stage == 4) return;
    GRID_BAR();
    {   unsigned char* ws = opaque_ptr(args.ws);
        PolGlu p; p.A = (const char*)(ws + WS_G); p.Bt = (const char*)(ws + WS_WGLU); p.nM = NLATR / 256; p.nN = 8; p.G = F.G; p.c = (int)blockIdx.x;
        p.row0 = NCTXR; p.OO = (bf16_t*)(ws + WS_OO); p.SSQO = (float*)(ws + WS_SSQO); p.bias = inp(F, 22);
        for (int rep_ = 0; rep_ < REP_DENSE; ++rep_) pg8::gemm_phase(F.lds, p);
    }
    if (args.stage == 5) return;
    GRID_BAR();
    postmix_phase(args, F, 1, NCTXR, 32);
    if (args.stage == 6) return;
    GRID_BAR();
    moe_stage(args, F, bar, 1, NCTXR);
}

#ifndef DBG_STAGE
#define DBG_STAGE 0
#endif
extern "C" void kernel_launch(void* const* d_in, const int* in_sizes, int n_in, void* d_out, int out_size, void* d_ws, size_t ws_size, hipStream_t stream) {
    static int grid = 0;
    if (grid == 0) {
        if (n_in != 31 || out_size != NLATR * DM || ws_size < WS_END) { fprintf(stderr, "kernel_launch: unexpected shapes (n_in %d out %d ws %zu)\n", n_in, out_size, ws_size); grid = -1; return; }
        int dev = 0, cus = 0;
        if (hipGetDevice(&dev) != hipSuccess || hipDeviceGetAttribute(&cus, hipDeviceAttributeMultiprocessorCount, dev) != hipSuccess) { grid = -1; return; }
        if (hipFuncSetAttribute((const void*)trunk_fwd, hipFuncAttributeMaxDynamicSharedMemorySize, LDS_BYTES) != hipSuccess) { fprintf(stderr, "kernel_launch: hipFuncSetAttribute failed\n"); grid = -1; return; }
        (void)hipGetLastError();
        grid = cus;
    }
    if (grid < 0) return;
    (void)hipMemsetAsync((char*)d_ws + WS_CTL, 0, CTL_BYTES, stream);
    Args a{};
    for (int i = 0; i < 31; ++i) a.in[i] = (const float*)d_in[i];
    a.out = (float*)d_out; a.ws = (unsigned char*)d_ws; a.stage = DBG_STAGE; a.pad = 0;
    hipLaunchKernelGGL(trunk_fwd, dim3(grid), dim3(NWAVES * 64), LDS_BYTES, stream, a);
}
```

```cpp
#include <hip/hip_runtime.h>
#include <cstdio>
#include <cstdint>

#define GAS __attribute__((address_space(1)))
#define LAS __attribute__((address_space(3)))
typedef unsigned short bf16_t;
typedef short bf16x8 __attribute__((ext_vector_type(8)));
typedef short s16x4 __attribute__((ext_vector_type(4)));
typedef float f32x2 __attribute__((ext_vector_type(2)));
typedef float f32x4 __attribute__((ext_vector_type(4)));
typedef float f32x16 __attribute__((ext_vector_type(16)));
typedef unsigned u32x2 __attribute__((ext_vector_type(2)));
typedef unsigned u32x4 __attribute__((ext_vector_type(4)));

constexpr int DM = 1024, NBATCH = 16, SEQL = 2048, NCTX = 256;
constexpr int NCTXR = NBATCH * NCTX;
constexpr int NLATR = NBATCH * SEQL;
constexpr int NROWS = NCTXR + NLATR;
constexpr int NHEAD = 8, QLORA = 384, KVLORA = 256, NOPE = 128, ROPED = 64, VDIM = 128;
constexpr int NDQKV = 768;
constexpr int NQ = NHEAD * (NOPE + ROPED);
constexpr int NKV = NHEAD * (NOPE + VDIM);
constexpr int NEXP = 64, TOPK = 8, DEXP = 256;
constexpr float NORM_EPS = 1e-6f;
constexpr int NMOD = 6, MODW = NMOD * DM;

constexpr size_t MiB = 1u << 20;
constexpr size_t WS_CTL = 0, CTL_BYTES = 1 * MiB;
constexpr size_t WS_WDQKV = 1 * MiB;
constexpr size_t WS_WUQ   = WS_WDQKV + 1536 * 1024;
constexpr size_t WS_WUKV  = WS_WUQ + 1280 * 1024;
constexpr size_t WS_WO    = WS_WUKV + 1 * MiB;
constexpr size_t WS_WGLU  = WS_WO + 2 * MiB;
constexpr size_t WS_WSHR  = WS_WGLU + 4 * MiB;
constexpr size_t WS_WSHD  = WS_WSHR + 3 * MiB;
constexpr size_t WS_MOD   = 15 * MiB;
constexpr size_t WS_ROPE  = 16 * MiB;
constexpr size_t WS_W1    = 17 * MiB;
constexpr size_t WS_W2    = 81 * MiB;
constexpr size_t WS_XCTX  = 113 * MiB;
constexpr size_t WS_XN    = 129 * MiB;
constexpr size_t WS_ST    = 201 * MiB;
static_assert(WS_WSHD + 1 * MiB <= WS_MOD, "small weights fit");
constexpr size_t WS_KV   = WS_ST;
constexpr size_t WS_Q    = WS_ST + 144 * MiB;
constexpr size_t WS_OO   = WS_Q;
constexpr size_t WS_A1   = WS_ST + 252 * MiB;
constexpr size_t WS_O    = WS_A1;
constexpr size_t WS_KPE  = WS_ST + 324 * MiB;
constexpr size_t WS_SSQ1 = WS_ST + 329 * MiB;
constexpr size_t WS_SSQO = WS_ST + 332 * MiB;
constexpr size_t WS_END  = WS_ST + 402 * MiB;

constexpr int CW_BAR = 4096;

__device__ __forceinline__ unsigned cvt_pk_bf16(float lo, float hi) { unsigned r; asm volatile("v_cvt_pk_bf16_f32 %0, %1, %2" : "=v"(r) : "v"(lo), "v"(hi)); return r; }
__device__ __forceinline__ float bf_lo(unsigned w) { return __uint_as_float(w << 16); }
__device__ __forceinline__ float bf_hi(unsigned w) { return __uint_as_float(w & 0xffff0000u); }
__device__ __forceinline__ float wave_sum(float v) {
#pragma unroll
    for (int o = 1; o < 64; o <<= 1) v += __shfl_xor(v, o);
    return v;
}
__device__ __forceinline__ float silu_f(float v) { return v / (1.f + __expf(-v)); }
__device__ __forceinline__ float sigmoid_f(float v) { return 1.f / (1.f + __expf(-v)); }
__device__ __forceinline__ int mod_index(int row) { return row < NCTXR ? 16 : (row - NCTXR) / SEQL; }
__device__ __forceinline__ int opaque_tid() { int t = threadIdx.x; asm volatile("" : "+v"(t)); return t; }
__device__ __forceinline__ float gelu_tanh(float v) {
    const float z = 0.7978845608028654f * (v + 0.044715f * v * v * v);
    return v / (1.f + __expf(-2.f * z));
}
__device__ __forceinline__ unsigned char* opaque_ptr(unsigned char* p) {
    unsigned lo = __builtin_amdgcn_readfirstlane((unsigned)(unsigned long long)p), hi = __builtin_amdgcn_readfirstlane((unsigned)((unsigned long long)p >> 32));
    asm volatile("" : "+s"(lo), "+s"(hi)); return (unsigned char*)(((unsigned long long)hi << 32) | lo); }
#define XB_TMO      128
#define XB_XCNT(j)  (256  + 64 * (j))
#define XB_XSUB(j)  (1280 + 64 * (j))
#define XB_XGEN(j)  (2304 + 64 * (j))
#define XB_TOP      3328
#define XB_TOPGEN   3392
#define XCD_BAR_WORDS 3456
#define XB_SPIN_CAP (1u << 18)
__device__ __forceinline__ unsigned xb_ld(unsigned* p)              { return __hip_atomic_load(p, __ATOMIC_RELAXED, __HIP_MEMORY_SCOPE_AGENT); }
__device__ __forceinline__ unsigned xb_add(unsigned* p, unsigned v) { return __hip_atomic_fetch_add(p, v, __ATOMIC_RELAXED, __HIP_MEMORY_SCOPE_AGENT); }
__device__ __forceinline__ unsigned xb_xcc_id() { return (unsigned)__builtin_amdgcn_s_getreg((3 << 11) | 20) & 0xFu; }
#define XB_SPIN(cond, bar) do { unsigned _sp = 0; while (cond) { __builtin_amdgcn_s_sleep(1); \
    if ((++_sp & 255u) == 0u) { if (xb_ld(&(bar)[XB_TMO])) break; if (_sp > XB_SPIN_CAP) { atomicAdd(&(bar)[XB_TMO], 1u); break; } } } } while (0)
struct XcdBarrier { unsigned* bar; unsigned x; volatile LAS unsigned* st; };
__device__ __forceinline__ XcdBarrier xcd_barrier_post(unsigned* bar, volatile LAS unsigned* st) {
    XcdBarrier b; b.bar = bar; b.x = xb_xcc_id(); b.st = st;
    if (threadIdx.x == 0) (void)xb_add(&bar[XB_XCNT(b.x)], 1u);
    return b;
}
__device__ __forceinline__ void xcd_barrier_complete(unsigned* bar, unsigned x, unsigned& nloc, unsigned& nx) {
    const unsigned G = gridDim.x * gridDim.y * gridDim.z;
    unsigned sum, cnt, mine, sp = 0u;
    for (;;) {
        sum = 0u; cnt = 0u; mine = 0u;
#pragma unroll
        for (unsigned j = 0; j < 16; ++j) { const unsigned c = xb_ld(&bar[XB_XCNT(j)]); sum += c; cnt += (c > 0u) ? 1u : 0u; mine = (j == x) ? c : mine; }
        if (sum == G) break;
        __builtin_amdgcn_s_sleep(1);
        if ((++sp & 255u) == 0u) { if (xb_ld(&bar[XB_TMO])) break; if (sp > XB_SPIN_CAP) { atomicAdd(&bar[XB_TMO], 1u); break; } }
    }
    nloc = mine > 0u ? mine : 1u; nx = cnt > 0u ? cnt : 1u;
}
__device__ __forceinline__ void xcd_barrier(const XcdBarrier& b) {
    asm volatile("s_waitcnt vmcnt(0)" ::: "memory");
    __syncthreads();
    if (threadIdx.x == 0) {
        unsigned* bar = b.bar;
        __builtin_amdgcn_s_waitcnt(0);
        unsigned nloc = b.st[0], nx = b.st[1];
        if (nloc == 0u) { xcd_barrier_complete(bar, b.x, nloc, nx); b.st[0] = nloc; b.st[1] = nx; }
        const unsigned old = xb_add(&bar[XB_XSUB(b.x)], 1u);
        const unsigned gen = old / nloc;
        if (old + 1u == (gen + 1u) * nloc) {
            __builtin_amdgcn_fence(__ATOMIC_RELEASE, "agent");
            asm volatile("s_waitcnt vmcnt(0)" ::: "memory");
            const unsigned og = xb_add(&bar[XB_TOP], 1u);
            const unsigned tg = og / nx;
            if (og + 1u == (tg + 1u) * nx) xb_add(&bar[XB_TOPGEN], 1u);
            else XB_SPIN(xb_ld(&bar[XB_TOPGEN]) == tg, bar);
            __builtin_amdgcn_fence(__ATOMIC_ACQUIRE, "agent");
            xb_add(&bar[XB_XGEN(b.x)], 1u);
            asm volatile("s_waitcnt vmcnt(0)" ::: "memory");
        } else {
            XB_SPIN(xb_ld(&bar[XB_XGEN(b.x)]) == gen, bar);
            __builtin_amdgcn_fence(__ATOMIC_ACQUIRE, "agent");
            asm volatile("s_waitcnt vmcnt(0)" ::: "memory");
        }
    }
    __syncthreads();
}

namespace pg8 {
constexpr int BM = 256, BK = 64, HALF = 128, HTB = HALF * BK * 2, STAGE_BYTES = 8 * HTB, NXCD = 8, WGM = 8;
__host__ __device__ __forceinline__ int lds_byte(int r, int c) { const int st = (r >> 4) * 2 + (c >> 5), rr = r & 15, cc = c & 31, ob = rr * 64 + cc * 2; return st * 1024 + (ob ^ (((ob >> 9) & 1) << 5)); }
__host__ __device__ __forceinline__ void stage_rc(int b, int& R, int& C) { const int st = b / 1024, sb = b % 1024, swz = sb ^ (((sb >> 9) & 1) << 5); R = (st >> 1) * 16 + swz / 64; C = (st & 1) * 32 + (swz % 64) / 2; }
__host__ __device__ __forceinline__ int perm32(int rho) { const int n = rho >> 4, i = rho & 15; return 8 * (i >> 2) + 4 * n + (i & 3); }

__device__ __forceinline__ bool dense_order(int i, int G, int c, int nM, int nN, int& pm, int& pn) {
    const int nwg = nM * nN; const long L = (long)i * G + c; if (L >= nwg) return false;
    int wgid = (int)L; { const int q = nwg / NXCD, r = nwg % NXCD, xcd = wgid % NXCD, off = wgid / NXCD; wgid = (xcd < r ? xcd * (q + 1) : r * (q + 1) + (xcd - r) * q) + off; }
    const int nig = WGM * nN, gid = wgid / nig, fm = gid * WGM, gsz = (nM - fm) < WGM ? (nM - fm) : WGM;
    pm = __builtin_amdgcn_readfirstlane(fm + ((wgid % nig) % gsz)); pn = __builtin_amdgcn_readfirstlane((wgid % nig) / gsz); return true;
}

template <bool GATHER> struct UCtx { const char* a0[2]; const char* a1[2]; const char* b; unsigned vg[2][2]; };
template <> struct UCtx<false> { const char* a0[2]; const char* a1[2]; const char* b; };

template <class P>
__device__ __forceinline__ void gemm_phase(LAS unsigned char* lds, const P& pol) {
    typedef typename P::Unit Unit;
    const int tid = opaque_tid(), wid = __builtin_amdgcn_readfirstlane(tid >> 6), lane = tid & 63, wr = wid >> 2, wc = wid & 3, fr = lane & 15, fq = lane >> 4;
    constexpr int nt = P::NT;
    int Rr[2], Cc[2]; unsigned voffB[2], va0[2];
#pragma unroll
    for (int i = 0; i < 2; ++i) { stage_rc(tid * 16 + i * 8192, Rr[i], Cc[i]); const int Rb = P::PERM ? ((Rr[i] & ~31) + perm32(Rr[i] & 31)) : Rr[i];
        voffB[i] = (unsigned)(Rb * P::LDB + Cc[i] * 2); va0[i] = pol.lane_a0(Rr[i], Cc[i]); }
    constexpr size_t hstepB = (size_t)HALF * P::LDB;
    const unsigned ldsw = (unsigned)wid * 1024u;
    const int aoff = lds_byte(wr * 64 + fr, fq * 8), boff = lds_byte(wc * 32 + fr, fq * 8);
#define PG8_SA(b, h) (((b) * 2 + (h)) * HTB)
#define PG8_SB(b, h) ((4 + (b) * 2 + (h)) * HTB)
#define PG8_GL(bufoff, p0, p1) do { __builtin_amdgcn_global_load_lds((const unsigned*)(p0), (LAS unsigned*)(lds + (bufoff) + ldsw), 16, 0, 0); \
        __builtin_amdgcn_global_load_lds((const unsigned*)(p1), (LAS unsigned*)(lds + (bufoff) + ldsw + 8192), 16, 0, 0); } while (0)
#define PG8_STB(bufoff, U, h, kt) do { const char* _b = (U).b + (size_t)(h) * hstepB + (size_t)(kt) * 128; asm volatile("" : "+s"(_b)); PG8_GL(bufoff, _b + voffB[0], _b + voffB[1]); } while (0)
#define PG8_STA(bufoff, U, h, kt) do { const char* _a = (U).a0[h] + (size_t)(kt) * P::KS0; if constexpr (P::TWOSEG) { if ((kt) >= P::KT0) _a = (U).a1[h] + (size_t)((kt) - P::KT0) * P::KS1; } \
        unsigned _o0, _o1; if constexpr (P::GATHER) { _o0 = (U).vg[h][0]; _o1 = (U).vg[h][1]; } else { _o0 = va0[0]; _o1 = va0[1]; } \
        asm volatile("" : "+s"(_a)); PG8_GL(bufoff, _a + _o0, _a + _o1); } while (0)
#define PG8_LDA(dst, b, h) do { _Pragma("unroll") for (int m = 0; m < 4; ++m) _Pragma("unroll") for (int k = 0; k < 2; ++k) dst[m][k] = *(const LAS bf16x8*)(lds + PG8_SA(b, h) + aoff + m * 2048 + k * 1024); } while (0)
#define PG8_LDB(dst, b, h) do { _Pragma("unroll") for (int n = 0; n < 2; ++n) _Pragma("unroll") for (int k = 0; k < 2; ++k) dst[n][k] = *(const LAS bf16x8*)(lds + PG8_SB(b, h) + boff + n * 2048 + k * 1024); } while (0)
#define PG8_MMA(ai, bj, At, Bt) do { __builtin_amdgcn_s_setprio(1); _Pragma("unroll") for (int m = 0; m < 4; ++m) _Pragma("unroll") for (int n = 0; n < 2; ++n) _Pragma("unroll") for (int k = 0; k < 2; ++k) \
        acc[ai][bj][m][n] = __builtin_amdgcn_mfma_f32_16x16x32_bf16(Bt[n][k], At[m][k], acc[ai][bj][m][n], 0, 0, 0); __builtin_amdgcn_s_setprio(0); } while (0)
#define PG8_WAIT_V(n) asm volatile("s_waitcnt vmcnt(" #n ")" ::: "memory")
#define PG8_WAIT_L(n) asm volatile("s_waitcnt lgkmcnt(" #n ")" ::: "memory")
#define PG8_BAR __builtin_amdgcn_s_barrier()
#define PG8_SCHED __builtin_amdgcn_sched_barrier(0)
    Unit cur, nxt; int ui = 0;
    if (!pol.next(0, cur)) return;
    UCtx<P::GATHER> cc, nc;
    pol.ctx(cur, cc, Rr, Cc);
    f32x4 acc[2][2][4][2];
#pragma unroll
    for (int a = 0; a < 2; ++a)
#pragma unroll
        for (int b = 0; b < 2; ++b)
#pragma unroll
            for (int m = 0; m < 4; ++m)
#pragma unroll
                for (int n = 0; n < 2; ++n) acc[a][b][m][n] = (f32x4){0.f, 0.f, 0.f, 0.f};
    bf16x8 At[4][2], B0[2][2], B1[2][2];
    PG8_STB(PG8_SB(0, 0), cc, 0, 0); PG8_STB(PG8_SB(0, 1), cc, 1, 0); PG8_STA(PG8_SA(0, 0), cc, 0, 0); PG8_STA(PG8_SA(0, 1), cc, 1, 0);
    if (wr == 1) PG8_BAR;
    PG8_WAIT_V(2); PG8_BAR;
    PG8_STB(PG8_SB(1, 0), cc, 0, 1); PG8_STA(PG8_SA(1, 0), cc, 0, 1); PG8_STB(PG8_SB(1, 1), cc, 1, 1);
    PG8_WAIT_V(6); PG8_BAR;
    for (;;) {
        const bool has_next = pol.next(ui + 1, nxt);
        if (has_next) pol.ctx(nxt, nc, Rr, Cc); else nc = cc;
        for (int t = 0; t < nt; t += 2) {
            const bool last = (t == nt - 2);
            const int k2 = last ? 0 : t + 2, k3 = k2 + 1;
            PG8_LDB(B0, 0, 0); PG8_LDB(B1, 0, 1); PG8_SCHED; PG8_LDA(At, 0, 0); PG8_STA(PG8_SA(1, 1), cc, 1, t + 1);
            PG8_WAIT_V(8); PG8_WAIT_L(0); PG8_BAR; PG8_MMA(0, 0, At, B0); PG8_MMA(0, 1, At, B1); PG8_BAR; PG8_SCHED;
            PG8_LDA(At, 0, 1);
            if (last) { PG8_STB(PG8_SB(0, 0), nc, 0, 0); PG8_STB(PG8_SB(0, 1), nc, 1, 0); PG8_STA(PG8_SA(0, 0), nc, 0, 0); }
            else      { PG8_STB(PG8_SB(0, 0), cc, 0, k2); PG8_STB(PG8_SB(0, 1), cc, 1, k2); PG8_STA(PG8_SA(0, 0), cc, 0, k2); }
            PG8_WAIT_V(8); PG8_WAIT_L(0); PG8_BAR; PG8_MMA(1, 0, At, B0); PG8_MMA(1, 1, At, B1); PG8_BAR; PG8_SCHED;
            PG8_LDB(B0, 1, 0); PG8_LDB(B1, 1, 1); PG8_SCHED; PG8_LDA(At, 1, 0);
            if (last) { PG8_STA(PG8_SA(0, 1), nc, 1, 0); } else { PG8_STA(PG8_SA(0, 1), cc, 1, k2); }
            PG8_WAIT_V(8); PG8_WAIT_L(0); PG8_BAR; PG8_MMA(0, 0, At, B0); PG8_MMA(0, 1, At, B1); PG8_BAR; PG8_SCHED;
            PG8_LDA(At, 1, 1);
            if (last) { PG8_STB(PG8_SB(1, 0), nc, 0, 1); PG8_STB(PG8_SB(1, 1), nc, 1, 1); PG8_STA(PG8_SA(1, 0), nc, 0, 1); }
            else      { PG8_STB(PG8_SB(1, 0), cc, 0, k3); PG8_STB(PG8_SB(1, 1), cc, 1, k3); PG8_STA(PG8_SA(1, 0), cc, 0, k3); }
            PG8_WAIT_V(8); PG8_WAIT_L(0); PG8_BAR; PG8_MMA(1, 0, At, B0); PG8_MMA(1, 1, At, B1); PG8_BAR; PG8_SCHED;
        }
        if (wr == 0) PG8_BAR;
        pol.epi(acc, cur, wr, wc, fr, fq);
        if (!has_next) break;
#pragma unroll
        for (int a = 0; a < 2; ++a)
#pragma unroll
            for (int b = 0; b < 2; ++b)
#pragma unroll
                for (int m = 0; m < 4; ++m)
#pragma unroll
                    for (int n = 0; n < 2; ++n) acc[a][b][m][n] = (f32x4){0.f, 0.f, 0.f, 0.f};
        cur = nxt; cc = nc; ++ui;
        if (wr == 1) PG8_BAR;
    }
    PG8_WAIT_V(0);
    PG8_BAR;
#undef PG8_SA
#undef PG8_SB
#undef PG8_GL
#undef PG8_STB
#undef PG8_STA
#undef PG8_LDA
#undef PG8_LDB
#undef PG8_MMA
#undef PG8_WAIT_V
#undef PG8_WAIT_L
#undef PG8_BAR
#undef PG8_SCHED
}
}
struct DUnit { int pm, pn; };

template <int NT_, int LDA_, bool PERM_> struct DenseBase {
    static constexpr bool PERM = PERM_, GATHER = false, TWOSEG = false;
    static constexpr int NT = NT_, KT0 = NT_, KS0 = 128, KS1 = 128, LDB = NT_ * 128;
    typedef DUnit Unit;
    const char* A; const char* Bt; int nM, nN, G, c;
    __device__ __forceinline__ bool next(int i, Unit& u) const { return pg8::dense_order(i, G, c, nM, nN, u.pm, u.pn); }
    __device__ __forceinline__ void ctx(const Unit& u, pg8::UCtx<false>& x, const int (&)[2], const int (&)[2]) const {
        x.a0[0] = A + (size_t)u.pm * 256 * LDA_; x.a0[1] = x.a0[0] + (size_t)128 * LDA_; x.a1[0] = x.a0[0]; x.a1[1] = x.a0[1];
        x.b = Bt + (size_t)u.pn * 256 * LDB; }
    __device__ __forceinline__ unsigned lane_a0(int R, int C) const { return (unsigned)(R * LDA_ + C * 2); }
    __device__ __forceinline__ unsigned lane_a1(int, int) const { return 0u; }
};

__device__ __forceinline__ void store8(bf16_t* p, const f32x4& v0, const f32x4& v1) {
    u32x4 w; w.x = cvt_pk_bf16(v0[0], v0[1]); w.y = cvt_pk_bf16(v0[2], v0[3]); w.z = cvt_pk_bf16(v1[0], v1[1]); w.w = cvt_pk_bf16(v1[2], v1[3]); *(u32x4*)p = w; }
__device__ __forceinline__ float sq4(const f32x4& v) { return (v[0] * v[0] + v[1] * v[1]) + (v[2] * v[2] + v[3] * v[3]); }
__device__ __forceinline__ void rope8(f32x4& v0, f32x4& v1, const float* cs) {
    const f32x4 a = *(const f32x4*)cs, b = *(const f32x4*)(cs + 4);
    float x0, x1;
    x0 = v0[0]; x1 = v0[1]; v0[0] = x0 * a[0] - x1 * a[1]; v0[1] = x0 * a[1] + x1 * a[0];
    x0 = v0[2]; x1 = v0[3]; v0[2] = x0 * a[2] - x1 * a[3]; v0[3] = x0 * a[3] + x1 * a[2];
    x0 = v1[0]; x1 = v1[1]; v1[0] = x0 * b[0] - x1 * b[1]; v1[1] = x0 * b[1] + x1 * b[0];
    x0 = v1[2]; x1 = v1[3]; v1[2] = x0 * b[2] - x1 * b[3]; v1[3] = x0 * b[3] + x1 * b[2];
}

struct PolDqkv : DenseBase<16, 2048, true> {
    bf16_t* A1; float* SSQ1; bf16_t* KPE; const float* ROPE;
    __device__ __forceinline__ void epi(const f32x4 (&acc)[2][2][4][2], const DUnit& u, int wr, int wc, int fr, int fq) const {
#pragma unroll
        for (int ai = 0; ai < 2; ++ai)
#pragma unroll
            for (int m = 0; m < 4; ++m) {
                const int row = u.pm * 256 + ai * 128 + wr * 64 + m * 16 + fr;
                bf16_t* rowp = A1 + (size_t)row * NDQKV + u.pn * 256 + wc * 32 + 8 * fq;
                float s0 = sq4(acc[ai][0][m][0]) + sq4(acc[ai][0][m][1]), s1 = sq4(acc[ai][1][m][0]) + sq4(acc[ai][1][m][1]);
                store8(rowp, acc[ai][0][m][0], acc[ai][0][m][1]); store8(rowp + 128, acc[ai][1][m][0], acc[ai][1][m][1]);
                s0 += __shfl_xor(s0, 16); s0 += __shfl_xor(s0, 32); s1 += __shfl_xor(s1, 16); s1 += __shfl_xor(s1, 32);
                if (fq == 0) {
                    float* sp = SSQ1 + (size_t)row * 16;
                    if (u.pn == 0) sp[wc] = s0 + s1; else if (u.pn == 1) { sp[4 + wc] = s0; sp[8 + wc] = s1; } else sp[12 + wc] = s0;
                }
                if (u.pn == 2 && wc < 2) {
                    f32x4 v0 = acc[ai][1][m][0], v1 = acc[ai][1][m][1];
                    if (row >= NCTXR) { const int t = (row - NCTXR) & (SEQL - 1); rope8(v0, v1, ROPE + ((size_t)t * 32 + 16 * wc + 4 * fq) * 2); }
                    store8(KPE + (size_t)row * 64 + 32 * wc + 8 * fq, v0, v1);
                }
            }
    }
};

struct PolQup : DenseBase<6, NDQKV * 2, true> {
    bf16_t* Q; const float* SSQ1;
    __device__ __forceinline__ void epi(const f32x4 (&acc)[2][2][4][2], const DUnit& u, int wr, int wc, int fr, int fq) const {
#pragma unroll
        for (int ai = 0; ai < 2; ++ai) {
            f32x4 p0[4], p1[4];
#pragma unroll
            for (int m = 0; m < 4; ++m) { const int row = u.pm * 256 + ai * 128 + wr * 64 + m * 16 + fr; p0[m] = *(const f32x4*)(SSQ1 + (size_t)row * 16); p1[m] = *(const f32x4*)(SSQ1 + (size_t)row * 16 + 4); }
#pragma unroll
            for (int m = 0; m < 4; ++m) {
                const int row = u.pm * 256 + ai * 128 + wr * 64 + m * 16 + fr;
                const float ss = ((p0[m][0] + p0[m][1]) + (p0[m][2] + p0[m][3])) + ((p1[m][0] + p1[m][1]) + (p1[m][2] + p1[m][3]));
                const float rstd = __builtin_amdgcn_rsqf(ss * (1.f / QLORA) + NORM_EPS);
                bf16_t* rowp = Q + (size_t)row * NQ + u.pn * 256 + wc * 32 + 8 * fq;
                store8(rowp, acc[ai][0][m][0] * rstd, acc[ai][0][m][1] * rstd); store8(rowp + 128, acc[ai][1][m][0] * rstd, acc[ai][1][m][1] * rstd);
            }
            asm volatile("" ::: "memory");
        }
    }
};

struct PolKVup : DenseBase<4, NDQKV * 2, true> {
    bf16_t* KV; const float* SSQ1;
    __device__ __forceinline__ void epi(const f32x4 (&acc)[2][2][4][2], const DUnit& u, int wr, int wc, int fr, int fq) const {
#pragma unroll
        for (int ai = 0; ai < 2; ++ai) {
            f32x4 p0[4], p1[4];
#pragma unroll
            for (int m = 0; m < 4; ++m) { const int row = u.pm * 256 + ai * 128 + wr * 64 + m * 16 + fr; p0[m] = *(const f32x4*)(SSQ1 + (size_t)row * 16 + 8); p1[m] = *(const f32x4*)(SSQ1 + (size_t)row * 16 + 12); }
#pragma unroll
            for (int m = 0; m < 4; ++m) {
                const int row = u.pm * 256 + ai * 128 + wr * 64 + m * 16 + fr;
                const float ss = ((p0[m][0] + p0[m][1]) + (p0[m][2] + p0[m][3])) + ((p1[m][0] + p1[m][1]) + (p1[m][2] + p1[m][3]));
                const float rstd = __builtin_amdgcn_rsqf(ss * (1.f / KVLORA) + NORM_EPS);
                bf16_t* rowp = KV + (size_t)row * NKV + u.pn * 256 + wc * 32 + 8 * fq;
                store8(rowp, acc[ai][0][m][0] * rstd, acc[ai][0][m][1] * rstd); store8(rowp + 128, acc[ai][1][m][0] * rstd, acc[ai][1][m][1] * rstd);
            }
            asm volatile("" ::: "memory");
        }
    }
};

struct PolWo : DenseBase<16, 2048, true> {
    bf16_t* OO; float* SSQO;
    __device__ __forceinline__ void epi(const f32x4 (&acc)[2][2][4][2], const DUnit& u, int wr, int wc, int fr, int fq) const {
#pragma unroll
        for (int ai = 0; ai < 2; ++ai)
#pragma unroll
            for (int m = 0; m < 4; ++m) {
                const int row = u.pm * 256 + ai * 128 + wr * 64 + m * 16 + fr;
                bf16_t* rowp = OO + (size_t)row * DM + u.pn * 256 + wc * 32 + 8 * fq;
                float s = (sq4(acc[ai][0][m][0]) + sq4(acc[ai][0][m][1])) + (sq4(acc[ai][1][m][0]) + sq4(acc[ai][1][m][1]));
                store8(rowp, acc[ai][0][m][0], acc[ai][0][m][1]); store8(rowp + 128, acc[ai][1][m][0], acc[ai][1][m][1]);
                s += __shfl_xor(s, 16); s += __shfl_xor(s, 32);
                if (fq == 0) SSQO[(size_t)row * 32 + u.pn * 4 + wc] = s;
            }
    }
};
namespace attn {
constexpr int NW = 8, QBLK = 32, KVBLK = 64, DQK = 192, DV = 128;
constexpr float SCALE = 0.07216878364870322f;
constexpr float THR = 8.f;
constexpr int SHM_V = KVBLK * DV * 2, SHM_K = KVBLK * DQK * 2;
constexpr int SHM_QPE = NW * 4096;
constexpr int SHM_ATTN = 2 * SHM_V + 2 * SHM_K + NW * 64 * 4 + SHM_QPE;
#define KSWZ(row, colB) ((row) * 384 + ((colB) ^ (((row) & 7) << 4)))
#define SBAR() __builtin_amdgcn_sched_barrier(0)
__device__ __forceinline__ int crow(int r, int hi) { return (r & 3) + 8 * (r >> 2) + 4 * hi; }
__device__ __forceinline__ unsigned cvtpk(float lo, float hi) { unsigned r; asm volatile("v_cvt_pk_bf16_f32 %0, %1, %2" : "=v"(r) : "v"(lo), "v"(hi)); return r; }

__device__ __forceinline__ void partialSM(f32x16& p0, f32x16& p1, float& m_reg, float& mn, float& alpha) {
  constexpr float C = SCALE * 1.4426950408889634f;
  float pmax = p0[0];
#pragma unroll
  for (int r = 1; r < 16; ++r) pmax = fmaxf(pmax, p0[r]);
#pragma unroll
  for (int r = 0; r < 16; ++r) pmax = fmaxf(pmax, p1[r]);
  { auto rr = __builtin_amdgcn_permlane32_swap(__float_as_uint(pmax), __float_as_uint(pmax), false, false);
    pmax = fmaxf(__uint_as_float(rr[0]), __uint_as_float(rr[1])); }
  if (__builtin_expect(__all(pmax - m_reg <= THR / SCALE), 1)) { mn = m_reg; alpha = 1.f; }
  else { mn = fmaxf(m_reg, pmax); alpha = __builtin_amdgcn_exp2f((m_reg - mn) * C); m_reg = mn; }
  float mnC = -mn * C;
#pragma unroll
  for (int r = 0; r < 16; ++r) p0[r] = fmaf(p0[r], C, mnC);
#pragma unroll
  for (int r = 0; r < 16; ++r) p1[r] = fmaf(p1[r], C, mnC);
#pragma unroll
  for (int r = 0; r < 16; ++r) p0[r] = __builtin_amdgcn_exp2f(p0[r]);
}
__device__ __forceinline__ void finishSM(f32x16& p0, f32x16& p1, float alpha, float& l_reg, bf16x8& pa0, bf16x8& pa1, bf16x8& pa2, bf16x8& pa3) {
#pragma unroll
  for (int r = 0; r < 16; ++r) p1[r] = __builtin_amdgcn_exp2f(p1[r]);
  float ps = 0;
#pragma unroll
  for (int r = 0; r < 16; ++r) ps += p0[r];
#pragma unroll
  for (int r = 0; r < 16; ++r) ps += p1[r];
  { auto rr = __builtin_amdgcn_permlane32_swap(__float_as_uint(ps), __float_as_uint(ps), false, false);
    ps = __uint_as_float(rr[0]) + __uint_as_float(rr[1]); }
  l_reg = l_reg * alpha + ps;
#define PK4(P, BASE, OUT) do { unsigned a0 = cvtpk(P[BASE + 0], P[BASE + 1]), a1 = cvtpk(P[BASE + 2], P[BASE + 3]);   \
    unsigned b0 = cvtpk(P[BASE + 4], P[BASE + 5]), b1 = cvtpk(P[BASE + 6], P[BASE + 7]);                              \
    auto r0 = __builtin_amdgcn_permlane32_swap(a0, b0, false, false); auto r1 = __builtin_amdgcn_permlane32_swap(a1, b1, false, false); \
    u32x4 w = {r0[0], r1[0], r0[1], r1[1]}; OUT = *reinterpret_cast<bf16x8*>(&w); } while (0)
  PK4(p0, 0, pa0); PK4(p0, 8, pa1); PK4(p1, 0, pa2); PK4(p1, 8, pa3);
#undef PK4
}
__device__ __forceinline__ void qkt(f32x16& p0, f32x16& p1, const char* Ks, const bf16x8* qr, const char* qpe, int r32, int hi) {
  p0 = f32x16{}; p1 = f32x16{};
#pragma unroll
  for (int d0 = 0; d0 < 12; ++d0) { int cb = (d0 * 16 + hi * 8) * 2;
    bf16x8 b0 = *reinterpret_cast<const bf16x8*>(Ks + KSWZ(r32, cb));
    bf16x8 b1 = *reinterpret_cast<const bf16x8*>(Ks + KSWZ(32 + r32, cb));
    const bf16x8 q = d0 < 8 ? qr[d0 < 8 ? d0 : 0] : *reinterpret_cast<const bf16x8*>(qpe + (d0 - 8) * 1024);
    p0 = __builtin_amdgcn_mfma_f32_32x32x16_bf16(b0, q, p0, 0, 0, 0);
    p1 = __builtin_amdgcn_mfma_f32_32x32x16_bf16(b1, q, p1, 0, 0, 0);
    if ((d0 & 3) == 3) SBAR(); }
}
__device__ __forceinline__ int v_st(int k, int c) { const int kk = (k & ~0xC) | ((k & 4) << 1) | ((k & 8) >> 1); return ((kk >> 3) * 4 + (c >> 5)) * 512 + ((kk & 7) * 32 + (c & 31)) * 2; }
__device__ __forceinline__ int v_rd_base(int lane) { return ((lane & 3) << 3) | (((lane >> 2) & 3) << 6) | (((lane >> 4) & 1) << 5) | (((lane >> 5) & 1) << 8); }
constexpr int v_rd_off(int d0, int ks, int half) { return d0 * 512 + ks * 4096 + half * 2048; }
template <int OFF> __device__ __forceinline__ s16x4 tr_read(int vb) {
  s16x4 r; asm volatile("ds_read_b64_tr_b16 %0, %1 offset:%2" : "=&v"(r) : "v"(vb), "i"(OFF) : "memory"); return r;
}
template <int D0> __device__ __forceinline__ void pv_one(f32x16& od, int vb, bf16x8 pa0, bf16x8 pa1, bf16x8 pa2, bf16x8 pa3) {
  const s16x4 l0 = tr_read<v_rd_off(D0, 0, 0)>(vb), h0 = tr_read<v_rd_off(D0, 0, 1)>(vb), l1 = tr_read<v_rd_off(D0, 1, 0)>(vb), h1 = tr_read<v_rd_off(D0, 1, 1)>(vb);
  const s16x4 l2 = tr_read<v_rd_off(D0, 2, 0)>(vb), h2 = tr_read<v_rd_off(D0, 2, 1)>(vb), l3 = tr_read<v_rd_off(D0, 3, 0)>(vb), h3 = tr_read<v_rd_off(D0, 3, 1)>(vb);
  asm volatile("s_waitcnt lgkmcnt(0)" ::: "memory"); SBAR();
#define PK(L, H) (bf16x8){L[0], L[1], L[2], L[3], H[0], H[1], H[2], H[3]}
  od = __builtin_amdgcn_mfma_f32_32x32x16_bf16(pa0, PK(l0, h0), od, 0, 0, 0);
  od = __builtin_amdgcn_mfma_f32_32x32x16_bf16(pa1, PK(l1, h1), od, 0, 0, 0);
  od = __builtin_amdgcn_mfma_f32_32x32x16_bf16(pa2, PK(l2, h2), od, 0, 0, 0);
  od = __builtin_amdgcn_mfma_f32_32x32x16_bf16(pa3, PK(l3, h3), od, 0, 0, 0);
#undef PK
}
__device__ __forceinline__ void pv_d0(f32x16* o, int vb, bf16x8 pa0, bf16x8 pa1, bf16x8 pa2, bf16x8 pa3) {
  pv_one<0>(o[0], vb, pa0, pa1, pa2, pa3); pv_one<1>(o[1], vb, pa0, pa1, pa2, pa3); pv_one<2>(o[2], vb, pa0, pa1, pa2, pa3); pv_one<3>(o[3], vb, pa0, pa1, pa2, pa3);
}

__device__ __forceinline__ void attn_unit(const bf16_t* __restrict__ Qg, const bf16_t* __restrict__ KVb, const bf16_t* __restrict__ KPE, bf16_t* __restrict__ Og, const float* __restrict__ ROPE,
                                          int qrow0, int qt0, int h, int crow0, int lrow0, int NT, char* lds) {
  const int tid = opaque_tid(), wid = tid >> 6, lane = tid & 63, r32 = lane & 31, hi = lane >> 5;
  char* V_lds = lds; char* K_lds = lds + 2 * SHM_V;
  float* ws = (float*)(lds + 2 * SHM_V + 2 * SHM_K) + wid * 64; float* li_l = ws; float* al_l = ws + 32;
  float m_reg = -1e30f, l_reg = 0; f32x16 o[4] = {}; bf16x8 qr[8];
  char* qpe = lds + 2 * SHM_V + 2 * SHM_K + NW * 64 * 4 + wid * 4096 + lane * 16;
  const bf16_t* Qw = Qg + (size_t)(qrow0 + wid * QBLK + r32) * NQ + h * DQK + hi * 8;
#pragma unroll
  for (int d0 = 0; d0 < 8; ++d0) qr[d0] = *reinterpret_cast<const bf16x8*>(Qw + d0 * 16);
#pragma unroll
  for (int d0 = 8; d0 < 12; ++d0) {
    u32x4 qv = *reinterpret_cast<const u32x4*>(Qw + d0 * 16);
    if (qt0 >= 0) { const float* cs = ROPE + ((size_t)(qt0 + wid * QBLK + r32) * 32 + 8 * (d0 - 8) + 4 * hi) * 2; const f32x4 ca = *(const f32x4*)cs, cb = *(const f32x4*)(cs + 4);
      float x0, x1;
      x0 = bf_lo(qv.x); x1 = bf_hi(qv.x); qv.x = cvtpk(x0 * ca[0] - x1 * ca[1], x0 * ca[1] + x1 * ca[0]);
      x0 = bf_lo(qv.y); x1 = bf_hi(qv.y); qv.y = cvtpk(x0 * ca[2] - x1 * ca[3], x0 * ca[3] + x1 * ca[2]);
      x0 = bf_lo(qv.z); x1 = bf_hi(qv.z); qv.z = cvtpk(x0 * cb[0] - x1 * cb[1], x0 * cb[1] + x1 * cb[0]);
      x0 = bf_lo(qv.w); x1 = bf_hi(qv.w); qv.w = cvtpk(x0 * cb[2] - x1 * cb[3], x0 * cb[3] + x1 * cb[2]); }
    *reinterpret_cast<u32x4*>(qpe + (d0 - 8) * 1024) = qv; }
  const int sr = tid >> 4, sc = (tid & 15) * 8, vst0 = v_st(sr, sc), vst1 = v_st(32 + sr, sc);
  const int pr = tid >> 3, pc = (tid & 7) * 8;
  const int vb0 = (int)(uintptr_t)V_lds + v_rd_base(lane);
  bf16x8 vs0, vs1, ks0, ks1, kp;
#define TROW(j) ((j) < 4 ? crow0 + 64 * (j) : lrow0 + 64 * ((j) - 4))
#define SLOAD(j) do { const int k0_ = TROW(j); const bf16_t* kv0_ = KVb + (size_t)(k0_ + sr) * NKV + h * 256 + sc; const bf16_t* kv1_ = kv0_ + (size_t)32 * NKV; \
    vs0 = *reinterpret_cast<const bf16x8*>(kv0_ + 128); vs1 = *reinterpret_cast<const bf16x8*>(kv1_ + 128); \
    ks0 = *reinterpret_cast<const bf16x8*>(kv0_); ks1 = *reinterpret_cast<const bf16x8*>(kv1_); \
    kp = *reinterpret_cast<const bf16x8*>(KPE + (size_t)(k0_ + pr) * 64 + pc); } while (0)
#define SWRITE(b) do { *(bf16x8*)(V_lds + (b) * SHM_V + vst0) = vs0; *(bf16x8*)(V_lds + (b) * SHM_V + vst1) = vs1; \
    *(bf16x8*)(K_lds + (b) * SHM_K + KSWZ(sr, sc * 2)) = ks0; *(bf16x8*)(K_lds + (b) * SHM_K + KSWZ(32 + sr, sc * 2)) = ks1; \
    *(bf16x8*)(K_lds + (b) * SHM_K + KSWZ(pr, (128 + pc) * 2)) = kp; } while (0)
#define SWAIT() asm volatile("s_waitcnt vmcnt(0)" ::: "memory")
#define RESC(a) do { if (__any((a) < 1.f)) { if (hi == 0) al_l[r32] = (a); asm volatile("s_waitcnt lgkmcnt(0)" ::: "memory"); \
    _Pragma("unroll") for (int d = 0; d < 4; ++d) _Pragma("unroll") for (int r = 0; r < 16; ++r) o[d][r] *= al_l[crow(r, hi)]; } } while (0)
  f32x16 pA0, pA1, pB0, pB1; float mnA, mnB, alA, alB; bf16x8 pa0, pa1, pa2, pa3;
  SLOAD(0); SWAIT(); SWRITE(0); __syncthreads();
  qkt(pA0, pA1, K_lds, qr, qpe, r32, hi); partialSM(pA0, pA1, m_reg, mnA, alA);
  SLOAD(1);
  SWAIT(); SWRITE(1); __syncthreads();
  for (int j = 1; j + 1 < NT; j += 2) {
    SBAR(); qkt(pB0, pB1, K_lds + SHM_K, qr, qpe, r32, hi);
    finishSM(pA0, pA1, alA, l_reg, pa0, pa1, pa2, pa3); SBAR();
    SLOAD(j + 1); SBAR();
    pv_d0(o, vb0, pa0, pa1, pa2, pa3); partialSM(pB0, pB1, m_reg, mnB, alB);
    __syncthreads(); SWAIT(); SWRITE(0);
    RESC(alB); __syncthreads();
    SBAR(); qkt(pA0, pA1, K_lds, qr, qpe, r32, hi);
    finishSM(pB0, pB1, alB, l_reg, pa0, pa1, pa2, pa3); SBAR();
    SLOAD(j + 2); SBAR();
    pv_d0(o, vb0 + SHM_V, pa0, pa1, pa2, pa3); partialSM(pA0, pA1, m_reg, mnA, alA);
    __syncthreads(); SWAIT(); SWRITE(1);
    RESC(alA); __syncthreads();
  }
  SBAR(); qkt(pB0, pB1, K_lds + SHM_K, qr, qpe, r32, hi);
  finishSM(pA0, pA1, alA, l_reg, pa0, pa1, pa2, pa3); SBAR();
  pv_d0(o, vb0, pa0, pa1, pa2, pa3); partialSM(pB0, pB1, m_reg, mnB, alB);
  __syncthreads(); RESC(alB);
  finishSM(pB0, pB1, alB, l_reg, pa0, pa1, pa2, pa3); SBAR();
  pv_d0(o, vb0 + SHM_V, pa0, pa1, pa2, pa3);
  if (hi == 0) li_l[r32] = l_reg; asm volatile("s_waitcnt lgkmcnt(0)" ::: "memory");
  float rli[16];
#pragma unroll
  for (int r = 0; r < 16; ++r) rli[r] = __builtin_amdgcn_rcpf(li_l[crow(r, hi)]);
  bf16_t* Ow = Og + (size_t)(qrow0 + wid * QBLK) * DM + h * DV;
#pragma unroll
  for (int r = 0; r < 16; ++r) { const int orow = crow(r, hi);
#pragma unroll
    for (int d0 = 0; d0 < 4; ++d0) Ow[(size_t)orow * DM + d0 * 32 + r32] = (bf16_t)(cvtpk(o[d0][r] * rli[r], 0.f) & 0xffffu); }
  __syncthreads();
#undef TROW
#undef SLOAD
#undef SWRITE
#undef SWAIT
#undef RESC
}
#undef KSWZ
#undef SBAR
}
constexpr int NWAVES = 8;
constexpr int RING_BYTES = 131072, LDSCTL_OFF = RING_BYTES, LDS_BYTES = 147456;

struct Args {
    const float* in[31]; float* out; unsigned char* ws; int stage; int pad;
};
struct Frame {
    LAS unsigned char* lds; int vcu, G; unsigned char* ws;
};
constexpr int PTAB_OFF = 131072 + 512;
__device__ __forceinline__ const float* inp(const Frame& F, int i) {
    const LAS unsigned* t = (const LAS unsigned*)(F.lds + PTAB_OFF) + 2 * i;
    const unsigned lo = __builtin_amdgcn_readfirstlane(t[0]), hi = __builtin_amdgcn_readfirstlane(t[1]);
    return (const float*)(((unsigned long long)hi << 32) | lo);
}

__device__ __forceinline__ unsigned f2bf(float f) { unsigned u = __float_as_uint(f); return (u + 0x7fffu + ((u >> 16) & 1u)) >> 16; }
__device__ __forceinline__ unsigned pk2(float lo, float hi) { return f2bf(lo) | (f2bf(hi) << 16); }
__device__ __forceinline__ void cvt_item(const float* srcA, const float* srcB, const float* kscale, bf16_t* dst, int ld, int K, int nrows, int nvalid, int mode, int item, LAS float* scr, int lane) {
    const int nblk = nrows >> 5, kb = item / nblk, nb = item - kb * nblk, k0 = 64 * kb, n0 = 32 * nb;
    const float* src = srcA; int col = n0; bool valid = n0 < nvalid;
    if (mode == 1) { const int t = n0 >> 8, r = n0 & 255; src = r < 128 ? srcA : srcB; col = 128 * t + (r & 127); valid = true; }
    const int kk = lane >> 3, n4 = (lane & 7) * 4;
    f32x4 v[8];
    if (valid) {
        const float* sp = src + (size_t)(k0 + kk) * ld + col + n4;
#pragma unroll
        for (int i = 0; i < 8; ++i) v[i] = *(const f32x4*)(sp + (size_t)(8 * i) * ld);
        if (kscale) {
#pragma unroll
            for (int i = 0; i < 8; ++i) v[i] = v[i] * kscale[k0 + 8 * i + kk];
        }
    } else {
#pragma unroll
        for (int i = 0; i < 8; ++i) v[i] = (f32x4){0.f, 0.f, 0.f, 0.f};
    }
#pragma unroll
    for (int i = 0; i < 8; ++i) { LAS float* d = scr + (8 * i + kk) * 33 + n4; d[0] = v[i][0]; d[1] = v[i][1]; d[2] = v[i][2]; d[3] = v[i][3]; }
    asm volatile("s_waitcnt lgkmcnt(0)" ::: "memory");
    const int c = lane & 7;
#pragma unroll
    for (int j = 0; j < 4; ++j) { const int n = (lane >> 3) + 8 * j; const LAS float* s = scr + (8 * c) * 33 + n;
        u32x4 o; o.x = cvt_pk_bf16(s[0 * 33], s[1 * 33]); o.y = cvt_pk_bf16(s[2 * 33], s[3 * 33]); o.z = cvt_pk_bf16(s[4 * 33], s[5 * 33]); o.w = cvt_pk_bf16(s[6 * 33], s[7 * 33]);
        *(u32x4*)(dst + (size_t)(n0 + n) * K + k0 + 8 * c) = o; }
    asm volatile("s_waitcnt lgkmcnt(0)" ::: "memory");
}
constexpr int N_SMALL_JOBS = 11;
__device__ __forceinline__ void convert_small(const Args& a, Frame& F) {
    unsigned char* const wsl = opaque_ptr(a.ws);
    const int tid_ = opaque_tid(), lane_ = tid_ & 63, wave_ = __builtin_amdgcn_readfirstlane(tid_ >> 6);
    LAS float* scr = (LAS float*)(F.lds + wave_ * 16384);
    const int gw = F.vcu * NWAVES + wave_, NGW = F.G * NWAVES;
    unsigned char* ws = wsl;
    int base = 0;
#define SMALL_JOB(SA, SB, KS, DST, LD, KK, NR, NV, MODE) do { const int n_ = ((KK) >> 6) * ((NR) >> 5); const int first_ = ((gw - base) % NGW + NGW) % NGW; \
        for (int it = first_; it < n_; it += NGW) cvt_item(SA, SB, KS, DST, LD, KK, NR, NV, MODE, it, scr, lane_); base += n_; } while (0)
    SMALL_JOB(inp(F, 7), nullptr, nullptr, (bf16_t*)(ws + WS_WDQKV), 704, 1024, 768, 704, 0);
    SMALL_JOB(inp(F, 10), nullptr, inp(F, 8), (bf16_t*)(ws + WS_WUQ), 1536, 384, 1536, 1536, 0);
    SMALL_JOB(inp(F, 11), nullptr, inp(F, 9), (bf16_t*)(ws + WS_WUKV), 2048, 256, 2048, 2048, 0);
    SMALL_JOB(inp(F, 12), nullptr, nullptr, (bf16_t*)(ws + WS_WO), 1024, 1024, 1024, 1024, 0);
    SMALL_JOB(inp(F, 21), inp(F, 21) + 1024, nullptr, (bf16_t*)(ws + WS_WGLU), 2048, 1024, 2048, 2048, 1);
#pragma unroll 1
    for (int l = 0; l < 2; ++l) {
        SMALL_JOB(inp(F, 28) + (size_t)l * 1024 * 256, inp(F, 29) + (size_t)l * 1024 * 256, nullptr, (bf16_t*)(ws + WS_WSHR) + (size_t)l * 768 * 1024, 256, 1024, 512, 512, 1);
        SMALL_JOB(inp(F, 23) + (size_t)l * 1024 * 64, nullptr, nullptr, (bf16_t*)(ws + WS_WSHR) + (size_t)l * 768 * 1024 + (size_t)512 * 1024, 64, 1024, 256, 64, 0);
        SMALL_JOB(inp(F, 30) + (size_t)l * 256 * 1024, nullptr, nullptr, (bf16_t*)(ws + WS_WSHD) + (size_t)l * 1024 * 256, 1024, 256, 1024, 1024, 0);
    }
#undef SMALL_JOB
}
__device__ __forceinline__ void convert_experts(const Args& a, Frame& F, int layer, int skip) {
    unsigned char* const wsl = opaque_ptr(a.ws);
    const int tid_ = opaque_tid(), lane_ = tid_ & 63, wave_ = __builtin_amdgcn_readfirstlane(tid_ >> 6);
    LAS float* scr = (LAS float*)(F.lds + wave_ * 16384);
    const int gw = (F.vcu - skip) * NWAVES + wave_, NGW = (F.G - skip) * NWAVES;
    for (int it = gw; it < NEXP * 384; it += NGW) { const int e = it / 384, r = it - e * 384; const size_t eo = ((size_t)layer * NEXP + e) * 1024 * 256;
        if (r < 256) cvt_item(inp(F, 25) + eo, inp(F, 26) + eo, nullptr, (bf16_t*)(wsl + WS_W1) + (size_t)e * 512 * 1024, 256, 1024, 512, 512, 1, r, scr, lane_);
        else cvt_item(inp(F, 27) + eo, nullptr, nullptr, (bf16_t*)(wsl + WS_W2) + (size_t)e * 1024 * 256, 1024, 256, 1024, 1024, 0, r - 256, scr, lane_); }
}

__device__ __forceinline__ void mod_phase(const Args& a, Frame& F) {
    unsigned char* const wsl = opaque_ptr(a.ws);
    const int tid_ = opaque_tid(), lane_ = tid_ & 63, wave_ = __builtin_amdgcn_readfirstlane(tid_ >> 6);
    LAS float* sl = (LAS float*)F.lds;
    LAS float* red = sl + 17 * 1024;
    float* MOD = (float*)(wsl + WS_MOD);
    bool have = false;
    for (int u = F.vcu; u < 256; u += F.G) {
        if (!have) { for (int i = tid_; i < 17 * 1024; i += 512) { const float v = i < 16 * 1024 ? inp(F, 1)[i] : inp(F, 3)[i - 16 * 1024]; sl[i] = silu_f(v); } __syncthreads(); have = true; }
        const int l = u >> 7, n0 = (u & 127) * 48, kg = tid_ >> 6, cl = (tid_ & 63) < 48 ? (tid_ & 63) : 47, col = n0 + cl;
        const float* W = inp(F, 4) + (size_t)l * 1024 * MODW + col;
        float acc[17];
#pragma unroll
        for (int b = 0; b < 17; ++b) acc[b] = 0.f;
#pragma unroll 8
        for (int k = kg; k < 1024; k += 8) { const float w = W[(size_t)k * MODW];
#pragma unroll
            for (int b = 0; b < 17; ++b) acc[b] += sl[b * 1024 + k] * w; }
#pragma unroll
        for (int b = 0; b < 17; ++b) red[(kg * 17 + b) * 64 + (tid_ & 63)] = acc[b];
        __syncthreads();
        for (int i = tid_; i < 17 * 64; i += 512) { const int b = i >> 6, c = i & 63; if (c >= 48) continue; float s = inp(F, 5)[(size_t)l * MODW + n0 + c];
#pragma unroll
            for (int g = 0; g < 8; ++g) s += red[(g * 17 + b) * 64 + c];
            MOD[((size_t)l * 17 + b) * MODW + n0 + c] = s; }
        __syncthreads();
    }
}
__device__ __forceinline__ void sincos_red(float ang, float& c, float& s) {
    const float k = rintf(ang * 0.15915494309189535f);
    float r = fmaf(-k, 6.2831854820251465f, ang); r = fmaf(-k, -1.7484555314695172e-07f, r);
    s = __sinf(r); c = __cosf(r);
}
__device__ __forceinline__ void rope_phase(const Args& a, Frame& F) {
    unsigned char* const wsl = opaque_ptr(a.ws);
    const int tid_ = opaque_tid(), lane_ = tid_ & 63, wave_ = __builtin_amdgcn_readfirstlane(tid_ >> 6);
    float* ROPE = (float*)(wsl + WS_ROPE);
    for (int i = (F.vcu * 512 + tid_); i < SEQL * 32; i += F.G * 512) { const int t = i >> 5, p = i & 31, j = p & 15;
        const float f = exp2f(-(float)j * (13.287712379549449f / 16.f)); const float pos = (float)(p < 16 ? (t >> 6) : (t & 63));
        float c, s; sincos_red(pos * f, c, s); ROPE[2 * i] = c; ROPE[2 * i + 1] = s; }
}

__device__ __forceinline__ const float* xrow_in(const Args& a, const Frame& F, int layer, int row) {
    unsigned char* const wsl = opaque_ptr(a.ws);
    if (layer == 0) return row < NCTXR ? inp(F, 2) + (size_t)row * DM : inp(F, 0) + (size_t)(row - NCTXR) * DM;
    return row < NCTXR ? (const float*)(wsl + WS_XCTX) + (size_t)row * DM : a.out + (size_t)(row - NCTXR) * DM;
}
__device__ __forceinline__ float* xrow_st(const Args& a, int row) {
    unsigned char* const wsl = opaque_ptr(a.ws); return row < NCTXR ? (float*)(wsl + WS_XCTX) + (size_t)row * DM : a.out + (size_t)(row - NCTXR) * DM; }
__device__ __forceinline__ void norm_mod_store(const f32x4 (&v)[4], const float* g, const float* shift, const float* scale, bf16_t* orow, int lane) {
    float s = 0.f;
#pragma unroll
    for (int j = 0; j < 4; ++j) s += sq4(v[j]);
    const float rstd = __builtin_amdgcn_rsqf(wave_sum(s) * (1.f / DM) + NORM_EPS);
#pragma unroll
    for (int j = 0; j < 4; ++j) { const int c = 4 * lane + 256 * j; const f32x4 gg = *(const f32x4*)(g + c), sh = *(const f32x4*)(shift + c), sc = *(const f32x4*)(scale + c);
        const f32x4 h = (v[j] * rstd * gg) * (sc + 1.f) + sh; u32x2 w; w.x = cvt_pk_bf16(h[0], h[1]); w.y = cvt_pk_bf16(h[2], h[3]); *(u32x2*)(orow + c) = w; }
}
__device__ __forceinline__ void h_phase(const Args& a, Frame& F, int layer, int row_lo) {
    unsigned char* const wsl = opaque_ptr(a.ws);
    const int tid_ = opaque_tid(), lane_ = tid_ & 63, wave_ = __builtin_amdgcn_readfirstlane(tid_ >> 6);
    const float* MOD = (const float*)(wsl + WS_MOD) + (size_t)layer * 17 * MODW; const float* g = inp(F, 6) + (size_t)(layer * 4 + 0) * DM; bf16_t* XN = (bf16_t*)(wsl + WS_XN);
    for (int row = row_lo + F.vcu * NWAVES + wave_; row < NROWS; row += F.G * NWAVES) {
        const float* x = xrow_in(a, F, layer, row); f32x4 v[4];
#pragma unroll
        for (int j = 0; j < 4; ++j) v[j] = *(const f32x4*)(x + 4 * lane_ + 256 * j);
        const float* m = MOD + (size_t)mod_index(row) * MODW;
        norm_mod_store(v, g, m + 0 * DM, m + 1 * DM, XN + (size_t)row * DM, lane_);
    }
}
__device__ __forceinline__ void postmix_phase(const Args& a, Frame& F, int layer, int row_lo, int NS) {
    unsigned char* const wsl = opaque_ptr(a.ws);
    const int tid_ = opaque_tid(), lane_ = tid_ & 63, wave_ = __builtin_amdgcn_readfirstlane(tid_ >> 6);
    const float* MOD = (const float*)(wsl + WS_MOD) + (size_t)layer * 17 * MODW; const float* g1 = inp(F, 6) + (size_t)(layer * 4 + 1) * DM; const float* g2 = inp(F, 6) + (size_t)(layer * 4 + 2) * DM;
    bf16_t* XN = (bf16_t*)(wsl + WS_XN); const bf16_t* OO = (const bf16_t*)(wsl + WS_OO); const float* SSQO = (const float*)(wsl + WS_SSQO);
    for (int row = row_lo + F.vcu * NWAVES + wave_; row < NROWS; row += F.G * NWAVES) {
        const float* x = xrow_in(a, F, layer, row); float* xo = xrow_st(a, row); const float* m = MOD + (size_t)mod_index(row) * MODW;
        float ss = lane_ < NS ? SSQO[(size_t)row * 32 + lane_] : 0.f; ss = wave_sum(ss);
        const float rstd = __builtin_amdgcn_rsqf(ss * (1.f / DM) + NORM_EPS);
        f32x4 v[4];
#pragma unroll
        for (int j = 0; j < 4; ++j) { const int c = 4 * lane_ + 256 * j; const u32x2 ow = *(const u32x2*)(OO + (size_t)row * DM + c);
            const f32x4 o = {bf_lo(ow.x), bf_hi(ow.x), bf_lo(ow.y), bf_hi(ow.y)}; const f32x4 gg = *(const f32x4*)(g1 + c), gt = *(const f32x4*)(m + 2 * DM + c);
            v[j] = *(const f32x4*)(x + c) + gt * (o * rstd * gg); *(f32x4*)(xo + c) = v[j]; }
        norm_mod_store(v, g2, m + 3 * DM, m + 4 * DM, XN + (size_t)row * DM, lane_);
    }
}
constexpr size_t WS_Y     = WS_ST;
constexpr size_t WS_H0    = WS_ST + 216 * MiB;
constexpr size_t WS_H1    = WS_ST + 278 * MiB;
constexpr size_t WS_HSH   = WS_ST + 340 * MiB;
constexpr size_t WS_LOG   = WS_ST + 358 * MiB;
constexpr size_t WS_SELI  = WS_ST + 367 * MiB;
constexpr size_t WS_SELW  = WS_SELI + (size_t)NROWS * 32;
constexpr size_t WS_LDST  = WS_ST + 370 * MiB;
constexpr size_t WS_LW    = WS_LDST + 1536 * 1024;
constexpr size_t WS_BLKCNT= WS_ST + 373 * MiB;
constexpr size_t WS_TINFO = WS_BLKCNT + 256 * 192 * 4;
constexpr int NLIST = 192;
static_assert(WS_TINFO + 4 * (512 + 1600) <= WS_ST + 374 * MiB, "MoE stage map");

template <int NT_, int LDA_, bool PERM_> struct DenseRow0 : DenseBase<NT_, LDA_, PERM_> { int row0; };

struct PolShr : DenseRow0<16, 2048, true> {
    bf16_t* HSH; float* LOG;
    __device__ __forceinline__ void epi(const f32x4 (&acc)[2][2][4][2], const DUnit& u, int wr, int wc, int fr, int fq) const {
#pragma unroll
        for (int ai = 0; ai < 2; ++ai)
#pragma unroll
            for (int m = 0; m < 4; ++m) {
                const int row = row0 + u.pm * 256 + ai * 128 + wr * 64 + m * 16 + fr;
                if (u.pn < 2) {
                    f32x4 h0, h1;
#pragma unroll
                    for (int j = 0; j < 4; ++j) { h0[j] = silu_f(acc[ai][0][m][0][j]) * acc[ai][1][m][0][j]; h1[j] = silu_f(acc[ai][0][m][1][j]) * acc[ai][1][m][1][j]; }
                    store8(HSH + (size_t)row * 256 + u.pn * 128 + wc * 32 + 8 * fq, h0, h1);
                } else if (wc < 2) {
                    float* lp = LOG + (size_t)row * 64 + wc * 32 + 8 * fq; *(f32x4*)lp = acc[ai][0][m][0]; *(f32x4*)(lp + 4) = acc[ai][0][m][1];
                }
            }
    }
};

__device__ __forceinline__ int slot_round(int s) { return s < 2 ? 0 : (s < 5 ? 1 : 2); }
__device__ __forceinline__ int slot_yrow(int s) { return s < 2 ? s + 1 : (s < 5 ? s - 2 : s - 5); }
__device__ __forceinline__ void route_phase(const Args& a, Frame& F, int layer, int row_lo, int tpb) {
    unsigned char* const wsl = opaque_ptr(a.ws);
    const int tid_ = opaque_tid(), lane = tid_ & 63, wave = __builtin_amdgcn_readfirstlane(tid_ >> 6);
    LAS int* cnt = (LAS int*)F.lds;
    for (int i = tid_; i < NLIST; i += 512) cnt[i] = 0;
    __syncthreads();
    const float* LOG = (const float*)(wsl + WS_LOG); int* SELI = (int*)(wsl + WS_SELI); float* SELW = (float*)(wsl + WS_SELW);
    const float bias = inp(F, 24)[layer * NEXP + lane];
    const int blk = F.vcu;
    float lg_next = LOG[(size_t)(row_lo + blk * tpb + wave) * 64 + lane];
    for (int t = wave; t < tpb; t += NWAVES) {
        const int row = row_lo + blk * tpb + t;
        const float lg = lg_next; if (t + NWAVES < tpb) lg_next = LOG[(size_t)(row + NWAVES) * 64 + lane];
        const float sc = sigmoid_f(lg), bs = sc + bias;
        float m1 = bs;
        m1 = fmaxf(m1, __shfl_xor(m1, 1)); m1 = fmaxf(m1, __shfl_xor(m1, 2)); m1 = fmaxf(m1, __shfl_xor(m1, 4));
        const unsigned long long eqm = __ballot(bs == m1);
        const int grp = lane >> 3; const unsigned gm = (unsigned)((eqm >> (grp * 8)) & 0xffull);
        float v2 = (bs == m1) ? -INFINITY : bs;
        v2 = fmaxf(v2, __shfl_xor(v2, 1)); v2 = fmaxf(v2, __shfl_xor(v2, 2)); v2 = fmaxf(v2, __shfl_xor(v2, 4));
        const float m2 = (__popc(gm) >= 2) ? m1 : v2;
        const float gs = m1 + m2;
        int grank = 0;
#pragma unroll
        for (int j = 0; j < 8; ++j) { const float o = __shfl(gs, j * 8); grank += (o > gs || (o == gs && j < grp)) ? 1 : 0; }
        const float mv = grank < 4 ? bs : -INFINITY;
        int rank = 0;
#pragma unroll 8
        for (int j = 0; j < 64; ++j) { const float o = __shfl(mv, j); rank += (o > mv || (o == mv && j < lane)) ? 1 : 0; }
        const bool sel = rank < TOPK && grank < 4;
        const float ssum = wave_sum(sel ? sc : 0.f);
        if (sel) { const int s = rank, l = slot_round(s) * 64 + lane;
            SELI[(size_t)row * 8 + s] = l | (slot_yrow(s) << 8); SELW[(size_t)row * 8 + s] = sc / ssum * 2.5f;
            atomicAdd((int*)&cnt[l], 1); }
    }
    __syncthreads();
    int* BLKCNT = (int*)(wsl + WS_BLKCNT);
    for (int i = tid_; i < NLIST; i += 512) BLKCNT[blk * NLIST + i] = cnt[i];
}
__device__ __forceinline__ void place_phase(const Args& a, Frame& F, int row_lo, int tpb) {
    unsigned char* const wsl = opaque_ptr(a.ws);
    const int tid_ = opaque_tid();
    LAS int* tot = (LAS int*)F.lds; LAS int* mine = tot + 256; LAS int* tst = mine + 256; LAS int* cur = tst + 256;
    const int* BLKCNT = (const int*)(wsl + WS_BLKCNT); const int blk = F.vcu;
    if (tid_ < 256) { tot[tid_] = 0; mine[tid_] = 0; cur[tid_] = 0; }
    __syncthreads();
    if (tid_ < 2 * NLIST) { const int l = tid_ % NLIST, b0 = (tid_ / NLIST) * 128; int s = 0, m = 0;
#pragma unroll 16
        for (int b = b0; b < b0 + 128; ++b) { const int c = (b < F.G) ? BLKCNT[b * NLIST + l] : 0; m += (b < blk) ? c : 0; s += c; }
        atomicAdd((int*)&tot[l], s); atomicAdd((int*)&mine[l], m); }
    __syncthreads();
    if (tid_ == 0) { int acc = 0; for (int l = 0; l < NLIST; ++l) { tst[l] = acc; acc += (tot[l] + 255) >> 8; } tst[NLIST] = acc; }
    __syncthreads();
    int* TINFO = (int*)(wsl + WS_TINFO); int* LDST = (int*)(wsl + WS_LDST); float* LW = (float*)(wsl + WS_LW);
    if (blk == 0) {
        for (int i = tid_; i <= NLIST; i += 512) TINFO[i] = tst[i];
        for (int i = tid_; i < NLIST; i += 512) TINFO[256 + i] = tot[i];
        const int lane = tid_ & 63, wv = tid_ >> 6;
        for (int l = wv; l < NLIST; l += NWAVES) { const int t0 = tst[l], t1 = tst[l + 1];
            for (int t = t0 + lane; t < t1; t += 64) TINFO[512 + t] = l;
            const int c = tot[l], base = t0 * 256;
            for (int p = c + lane; p < (t1 - t0) * 256; p += 64) LDST[base + p] = -1; }
    }
    const int* SELI = (const int*)(wsl + WS_SELI); const float* SELW = (const float*)(wsl + WS_SELW);
    for (int i = tid_; i < tpb * 8; i += 512) { const int row = row_lo + blk * tpb + (i >> 3), s = i & 7;
        const int v = SELI[(size_t)row * 8 + s], l = v & 0xff, yr = v >> 8;
        const int pos = tst[l] * 256 + mine[l] + atomicAdd((int*)&cur[l], 1);
        LDST[pos] = row * 3 + yr; LW[pos] = SELW[(size_t)row * 8 + s]; }
}

struct MUnit { int T, pn; };
struct PolMoe1 {
    static constexpr bool PERM = true, GATHER = true, TWOSEG = false;
    static constexpr int NT = 16, KT0 = 16, KS0 = 128, KS1 = 128, LDB = 2048;
    typedef MUnit Unit;
    const char* XN; const char* W1; bf16_t* H; const int* TINFO; const int* LDST; int T0, T1, G, c;
    __device__ __forceinline__ bool next(int i, Unit& u) const { const int L = i * G + c; u.T = T0 + (L >> 1); u.pn = L & 1; return u.T < T1; }
    __device__ __forceinline__ void ctx(const Unit& u, pg8::UCtx<true>& x, const int (&R)[2], const int (&C)[2]) const {
        const int e = __builtin_amdgcn_readfirstlane(TINFO[512 + u.T]) & 63;
        x.a0[0] = XN; x.a0[1] = XN; x.a1[0] = XN; x.a1[1] = XN; x.b = W1 + ((size_t)e * 512 + u.pn * 256) * LDB;
#pragma unroll
        for (int h = 0; h < 2; ++h)
#pragma unroll
            for (int i = 0; i < 2; ++i) { const int d = LDST[u.T * 256 + h * 128 + R[i]]; const int tok = d < 0 ? 0 : d / 3; x.vg[h][i] = (unsigned)tok * 2048u + (unsigned)C[i] * 2u; }
    }
    __device__ __forceinline__ unsigned lane_a0(int, int) const { return 0u; }
    __device__ __forceinline__ unsigned lane_a1(int, int) const { return 0u; }
    __device__ __forceinline__ void epi(const f32x4 (&acc)[2][2][4][2], const Unit& u, int wr, int wc, int fr, int fq) const {
#pragma unroll
        for (int ai = 0; ai < 2; ++ai)
#pragma unroll
            for (int m = 0; m < 4; ++m) {
                const int hrow = (u.T - T0) * 256 + ai * 128 + wr * 64 + m * 16 + fr;
                f32x4 h0, h1;
#pragma unroll
                for (int j = 0; j < 4; ++j) { h0[j] = silu_f(acc[ai][0][m][0][j]) * acc[ai][1][m][0][j]; h1[j] = silu_f(acc[ai][0][m][1][j]) * acc[ai][1][m][1][j]; }
                store8(H + (size_t)hrow * 256 + u.pn * 128 + wc * 32 + 8 * fq, h0, h1);
            }
    }
};
template <bool RMW> struct PolMoe2 {
    static constexpr bool PERM = true, GATHER = false, TWOSEG = false;
    static constexpr int NT = 4, KT0 = 4, KS0 = 128, KS1 = 128, LDB = 512;
    typedef MUnit Unit;
    const char* H; const char* W2; bf16_t* Y; const int* TINFO; const int* LDST; const float* LW; int T0, T1, G, c;
    __device__ __forceinline__ bool next(int i, Unit& u) const { const int L = i * G + c; u.T = T0 + (L >> 2); u.pn = L & 3; return u.T < T1; }
    __device__ __forceinline__ void ctx(const Unit& u, pg8::UCtx<false>& x, const int (&)[2], const int (&)[2]) const {
        const int e = __builtin_amdgcn_readfirstlane(TINFO[512 + u.T]) & 63;
        x.a0[0] = H + (size_t)(u.T - T0) * 256 * 512; x.a0[1] = x.a0[0] + 128 * 512; x.a1[0] = x.a0[0]; x.a1[1] = x.a0[1];
        x.b = W2 + ((size_t)e * 1024 + u.pn * 256) * LDB;
    }
    __device__ __forceinline__ unsigned lane_a0(int R, int C) const { return (unsigned)(R * 512 + C * 2); }
    __device__ __forceinline__ unsigned lane_a1(int, int) const { return 0u; }
    __device__ __forceinline__ void epi(const f32x4 (&acc)[2][2][4][2], const Unit& u, int wr, int wc, int fr, int fq) const {
        const int cofs = u.pn * 256 + wc * 32 + 8 * fq;
#pragma unroll
        for (int ai = 0; ai < 2; ++ai) {
            int d[4]; float w[4];
#pragma unroll
            for (int m = 0; m < 4; ++m) { const int lp = u.T * 256 + ai * 128 + wr * 64 + m * 16 + fr; d[m] = LDST[lp]; w[m] = LW[lp]; }
            u32x4 o[4][2];
            if (RMW) {
#pragma unroll
                for (int m = 0; m < 4; ++m) { const bf16_t* yp = Y + (size_t)(d[m] < 0 ? 0 : d[m]) * DM + cofs; o[m][0] = *(const u32x4*)yp; o[m][1] = *(const u32x4*)(yp + 128); }
            }
#pragma unroll
            for (int m = 0; m < 4; ++m) {
                if (d[m] >= 0) {
                    bf16_t* yp = Y + (size_t)d[m] * DM + cofs; const float ww = w[m];
#pragma unroll
                    for (int bj = 0; bj < 2; ++bj) {
                        f32x4 v0 = acc[ai][bj][m][0] * ww, v1 = acc[ai][bj][m][1] * ww;
                        if (RMW) { const u32x4 q = o[m][bj];
                            v0 += (f32x4){bf_lo(q.x), bf_hi(q.x), bf_lo(q.y), bf_hi(q.y)}; v1 += (f32x4){bf_lo(q.z), bf_hi(q.z), bf_lo(q.w), bf_hi(q.w)}; }
                        store8(yp + bj * 128, v0, v1);
                    }
                }
            }
            asm volatile("" ::: "memory");
        }
    }
};
struct PolShd : DenseRow0<4, 512, true> {
    bf16_t* Y;
    __device__ __forceinline__ void epi(const f32x4 (&acc)[2][2][4][2], const DUnit& u, int wr, int wc, int fr, int fq) const {
#pragma unroll
        for (int ai = 0; ai < 2; ++ai)
#pragma unroll
            for (int m = 0; m < 4; ++m) {
                const int row = row0 + u.pm * 256 + ai * 128 + wr * 64 + m * 16 + fr;
                bf16_t* yp = Y + (size_t)row * 3 * DM + u.pn * 256 + wc * 32 + 8 * fq;
                store8(yp, acc[ai][0][m][0], acc[ai][0][m][1]); store8(yp + 128, acc[ai][1][m][0], acc[ai][1][m][1]);
            }
    }
};

__device__ __forceinline__ void combine_phase(const Args& a, Frame& F, int layer, int row_lo) {
    unsigned char* const wsl = opaque_ptr(a.ws);
    const int tid_ = opaque_tid(), lane_ = tid_ & 63, wave_ = __builtin_amdgcn_readfirstlane(tid_ >> 6);
    const float* MOD = (const float*)(wsl + WS_MOD) + (size_t)layer * 17 * MODW; const float* g3 = inp(F, 6) + (size_t)(layer * 4 + 3) * DM;
    const float* MODn = (const float*)(wsl + WS_MOD) + (size_t)1 * 17 * MODW; const float* gn = inp(F, 6) + (size_t)(1 * 4 + 0) * DM;
    bf16_t* XN = (bf16_t*)(wsl + WS_XN); const bf16_t* Y = (const bf16_t*)(wsl + WS_Y);
    for (int row = row_lo + F.vcu * NWAVES + wave_; row < NROWS; row += F.G * NWAVES) {
        float* xo = xrow_st(a, row); const float* m = MOD + (size_t)mod_index(row) * MODW;
        f32x4 f[4]; float ss = 0.f;
#pragma unroll
        for (int j = 0; j < 4; ++j) { const int c = 4 * lane_ + 256 * j; f[j] = (f32x4){0.f, 0.f, 0.f, 0.f};
#pragma unroll
            for (int r = 0; r < 3; ++r) { const u32x2 w = *(const u32x2*)(Y + ((size_t)row * 3 + r) * DM + c); f[j] += (f32x4){bf_lo(w.x), bf_hi(w.x), bf_lo(w.y), bf_hi(w.y)}; }
            ss += sq4(f[j]); }
        const float rstd = __builtin_amdgcn_rsqf(wave_sum(ss) * (1.f / DM) + NORM_EPS);
        f32x4 v[4];
#pragma unroll
        for (int j = 0; j < 4; ++j) { const int c = 4 * lane_ + 256 * j; const f32x4 gg = *(const f32x4*)(g3 + c), gt = *(const f32x4*)(m + 5 * DM + c);
            v[j] = *(const f32x4*)(xo + c) + gt * (f[j] * rstd * gg); *(f32x4*)(xo + c) = v[j]; }
        if (layer == 0) { const float* mn = MODn + (size_t)mod_index(row) * MODW; norm_mod_store(v, gn, mn + 0 * DM, mn + 1 * DM, XN + (size_t)row * DM, lane_); }
    }
}
constexpr size_t WS_G    = WS_ST;
constexpr size_t WS_BTY  = WS_ST + 216 * MiB;
constexpr size_t WS_BTS  = WS_ST + 264 * MiB;
constexpr size_t WS_S    = WS_ST + 280 * MiB;
constexpr size_t WS_XIN  = WS_ST + 64 * MiB;
constexpr size_t WS_LAMT = WS_ROPE + 512 * 1024;
constexpr int S5_T = 32;

__device__ __forceinline__ f32x2 cmul(f32x2 a, f32x2 b) { return (f32x2){a.x * b.x - a.y * b.y, a.x * b.y + a.y * b.x}; }
__device__ __forceinline__ void s5_tables_group(const Args& a, Frame& F, int g) {
    unsigned char* const wsl = opaque_ptr(a.ws);
    const int tid = opaque_tid();
    LAS float* Kd = (LAS float*)F.lds; LAS f32x2* pw = (LAS f32x2*)(F.lds + 65536); LAS f32x2* bb = pw + 33 * 64; LAS f32x2* cm = bb + 64 * 16;
    bf16_t* BTY = (bf16_t*)(wsl + WS_BTY) + (size_t)g * 512 * 768; bf16_t* BTS = (bf16_t*)(wsl + WS_BTS) + (size_t)g * 256 * 512; float* LAMT = (float*)(wsl + WS_LAMT);
    const float* lre = inp(F, 13); const float* lim = inp(F, 14); const float* lst = inp(F, 15);
    const float* bre = inp(F, 16); const float* bim = inp(F, 17); const float* cre = inp(F, 18); const float* cim = inp(F, 19); const float* dsk = inp(F, 20);
    for (int d = 0; d < 2; ++d) {
        __syncthreads();
        const float step = __expf(lst[d * 64 + g]);
        for (int i = tid; i < 33 * 64; i += 512) { const int k = i >> 6, p = i & 63; const float lr = lre[(d * 64 + g) * 64 + p], li = lim[(d * 64 + g) * 64 + p];
            const float mag = __expf((float)k * lr * step); float c, s; sincos_red((float)k * (li * step), c, s); pw[i] = (f32x2){mag * c, mag * s}; }
        __syncthreads();
        for (int i = tid; i < 64 * 16; i += 512) { const int p = i >> 4; const float lr = lre[(d * 64 + g) * 64 + p], li = lim[(d * 64 + g) * 64 + p];
            const f32x2 lb = pw[64 + p]; const float inv = 1.f / (lr * lr + li * li);
            const f32x2 kap = {((lb.x - 1.f) * lr + lb.y * li) * inv, (lb.y * lr - (lb.x - 1.f) * li) * inv};
            const size_t o = ((size_t)(d * 64 + g) * 64 + p) * 16 + (i & 15); bb[i] = cmul(kap, (f32x2){bre[o], bim[o]}); }
        for (int i = tid; i < 16 * 64; i += 512) { const size_t o = (size_t)(d * 64 + g) * 1024 + i; cm[i] = (f32x2){cre[o], cim[o]}; }
        __syncthreads();
        if (tid < 64) { const f32x2 l32 = pw[32 * 64 + tid]; LAMT[((d * 64 + g) * 64 + tid) * 2] = l32.x; LAMT[((d * 64 + g) * 64 + tid) * 2 + 1] = l32.y; }
        for (int o = tid; o < 32 * 256; o += 512) { const int k = o >> 8, i = (o >> 4) & 15, j = o & 15; float acc = 0.f;
            for (int p = 0; p < 64; ++p) { const f32x2 t = cmul(cm[i * 64 + p], pw[k * 64 + p]); const f32x2 b = bb[p * 16 + j]; acc += t.x * b.x - t.y * b.y; }
            Kd[d * 8192 + o] = acc; }
        for (int o = tid; o < 512 * 64; o += 512) { const int n = o >> 6, p = o & 63, to = n >> 4, i = n & 15;
            const f32x2 w = cmul(cm[i * 64 + p], pw[(d == 0 ? to + 1 : 32 - to) * 64 + p]);
            *(unsigned*)(BTY + (size_t)n * 768 + 512 + 128 * d + 2 * p) = cvt_pk_bf16(w.x, -w.y); }
        for (int o = tid; o < 64 * 256; o += 512) { const int p = o >> 8, kk = (o & 255) * 2, ti = kk >> 4, j = kk & 15;
            const f32x2 pwv = pw[(d == 0 ? 31 - ti : ti) * 64 + p]; const f32x2 v0 = cmul(pwv, bb[p * 16 + j]), v1 = cmul(pwv, bb[p * 16 + j + 1]);
            *(unsigned*)(BTS + (size_t)(128 * d + 2 * p) * 512 + kk) = cvt_pk_bf16(v0.x, v1.x); *(unsigned*)(BTS + (size_t)(128 * d + 2 * p + 1) * 512 + kk) = cvt_pk_bf16(v0.y, v1.y); }
    }
    __syncthreads();
    for (int o = tid; o < 512 * 256; o += 512) { const int n = o >> 8, kk = (o & 255) * 2, to = n >> 4, i = n & 15, ti = kk >> 4, j = kk & 15;
        float v0, v1;
        if (to > ti) { v0 = Kd[(to - ti) * 256 + i * 16 + j]; v1 = Kd[(to - ti) * 256 + i * 16 + j + 1]; }
        else if (to < ti) { v0 = Kd[8192 + (ti - to) * 256 + i * 16 + j]; v1 = Kd[8192 + (ti - to) * 256 + i * 16 + j + 1]; }
        else { v0 = Kd[i * 16 + j] + Kd[8192 + i * 16 + j] + (i == j ? dsk[g * 16 + i] : 0.f); v1 = Kd[i * 16 + j + 1] + Kd[8192 + i * 16 + j + 1] + (i == j + 1 ? dsk[g * 16 + i] : 0.f); }
        *(unsigned*)(BTY + (size_t)n * 768 + kk) = cvt_pk_bf16(v0, v1); }
    __syncthreads();
}
__device__ __forceinline__ void s5_tables_phase(const Args& a, Frame& F) {
    unsigned char* const wsl = opaque_ptr(a.ws); for (int g = F.vcu; g < 64; g += F.G) s5_tables_group(a, F, g); }

struct SUnit { int g, pm, pn; };
struct PolS5S {
    static constexpr bool PERM = false, GATHER = false, TWOSEG = false;
    static constexpr int NT = 8, KT0 = 8, KS0 = 8192, KS1 = 128, LDB = 1024;
    typedef SUnit Unit;
    const char* XN; const char* BTS; float* S; int G, c;
    __device__ __forceinline__ bool next(int i, Unit& u) const { const int L = i * G + c; u.g = __builtin_amdgcn_readfirstlane(L / 5); u.pm = __builtin_amdgcn_readfirstlane(L % 5); u.pn = 0; return L < 320; }
    __device__ __forceinline__ void ctx(const Unit& u, pg8::UCtx<false>& x, const int (&)[2], const int (&)[2]) const {
        if (u.pm < 4) { x.a0[0] = XN + ((size_t)NCTXR + (size_t)u.pm * 256 * S5_T) * 2048 + u.g * 32; x.a0[1] = x.a0[0] + (size_t)128 * S5_T * 2048; }
        else { x.a0[0] = XN + u.g * 32; x.a0[1] = x.a0[0]; }
        x.a1[0] = x.a0[0]; x.a1[1] = x.a0[1]; x.b = BTS + (size_t)u.g * 256 * LDB;
    }
    __device__ __forceinline__ unsigned lane_a0(int R, int C) const { return (unsigned)(R * (S5_T * 2048) + (C >> 4) * 2048 + (C & 15) * 2); }
    __device__ __forceinline__ unsigned lane_a1(int, int) const { return 0u; }
    __device__ __forceinline__ void epi(const f32x4 (&acc)[2][2][4][2], const Unit& u, int wr, int wc, int fr, int fq) const {
#pragma unroll
        for (int ai = 0; ai < 2; ++ai) { if (u.pm == 4 && ai == 1) continue;
#pragma unroll
            for (int m = 0; m < 4; ++m) { const int r = u.pm * 256 + ai * 128 + wr * 64 + m * 16 + fr;
                float* sp = S + ((size_t)u.g * 1152 + r) * 256 + wc * 32 + 4 * fq;
#pragma unroll
                for (int bj = 0; bj < 2; ++bj)
#pragma unroll
                    for (int n = 0; n < 2; ++n) *(f32x4*)(sp + bj * 128 + n * 16) = acc[ai][bj][m][n]; } }
    }
};
__device__ __forceinline__ void s5_scan_phase(const Args& a, Frame& F) {
    unsigned char* const wsl = opaque_ptr(a.ws);
    const int tid = opaque_tid(); const float* S = (const float*)(wsl + WS_S); bf16_t* XIN = (bf16_t*)(wsl + WS_XIN); const float* LAMT = (const float*)(wsl + WS_LAMT);
    for (int idx = F.vcu * 512 + tid; idx < 64 * 16 * 2 * 64; idx += F.G * 512) {
        const int p = idx & 63, d = (idx >> 6) & 1, b = (idx >> 7) & 15, g = idx >> 11;
        const f32x2 Lm = *(const f32x2*)(LAMT + ((d * 64 + g) * 64 + p) * 2);
        const float* Sg = S + (size_t)g * 1152 * 256 + d * 128 + 2 * p; const int col = d * 128 + 2 * p; bf16_t* Xg = XIN + (size_t)(col >> 4) * 1024 + 16 * g + (col & 15);
        f32x2 x = {0.f, 0.f};
        f32x2 sv[8];
#pragma unroll
        for (int k = 0; k < 8; ++k) { const int c = d == 0 ? k : 7 - k; sv[k] = *(const f32x2*)(Sg + (size_t)(1024 + b * 8 + c) * 256); }
#pragma unroll
        for (int k = 0; k < 8; ++k) x = cmul(Lm, x) + sv[k];
        for (int c0 = 0; c0 < 64; c0 += 8) {
#pragma unroll
            for (int k = 0; k < 8; ++k) { const int c = d == 0 ? c0 + k : 63 - c0 - k; sv[k] = *(const f32x2*)(Sg + (size_t)(b * 64 + c) * 256); }
#pragma unroll
            for (int k = 0; k < 8; ++k) { const int c = d == 0 ? c0 + k : 63 - c0 - k; *(unsigned*)(Xg + (size_t)(b * 64 + c) * 32 * 1024) = cvt_pk_bf16(x.x, x.y); x = cmul(Lm, x) + sv[k]; }
        }
    }
}
struct PolS5Y {
    static constexpr bool PERM = true, GATHER = false, TWOSEG = true;
    static constexpr int NT = 12, KT0 = 8, KS0 = 8192, KS1 = 8192, LDB = 1536;
    typedef SUnit Unit;
    const char* XN; const char* XIN; const char* BTY; bf16_t* Gb; int G, c;
    __device__ __forceinline__ bool next(int i, Unit& u) const { const int L = i * G + c; u.g = __builtin_amdgcn_readfirstlane(L >> 3); u.pm = __builtin_amdgcn_readfirstlane((L >> 1) & 3); u.pn = L & 1; return L < 512; }
    __device__ __forceinline__ void ctx(const Unit& u, pg8::UCtx<false>& x, const int (&)[2], const int (&)[2]) const {
        x.a0[0] = XN + ((size_t)NCTXR + (size_t)u.pm * 256 * S5_T) * 2048 + u.g * 32; x.a0[1] = x.a0[0] + (size_t)128 * S5_T * 2048;
        x.a1[0] = XIN + (size_t)u.pm * 256 * S5_T * 2048 + u.g * 32; x.a1[1] = x.a1[0] + (size_t)128 * S5_T * 2048;
        x.b = BTY + ((size_t)u.g * 512 + u.pn * 256) * LDB;
    }
    __device__ __forceinline__ unsigned lane_a0(int R, int C) const { return (unsigned)(R * (S5_T * 2048) + (C >> 4) * 2048 + (C & 15) * 2); }
    __device__ __forceinline__ void epi(const f32x4 (&acc)[2][2][4][2], const Unit& u, int wr, int wc, int fr, int fq) const {
#pragma unroll
        for (int ai = 0; ai < 2; ++ai)
#pragma unroll
            for (int m = 0; m < 4; ++m) { const int r = u.pm * 256 + ai * 128 + wr * 64 + m * 16 + fr;
#pragma unroll
                for (int bj = 0; bj < 2; ++bj) { const int col = u.pn * 256 + bj * 128 + wc * 32 + 8 * fq, to = col >> 4, i0 = col & 15;
                    bf16_t* gp = Gb + ((size_t)r * S5_T + to) * DM + u.g * 16 + i0;
#pragma unroll
                    for (int n = 0; n < 2; ++n) { f32x4 v;
#pragma unroll
                        for (int j = 0; j < 4; ++j) v[j] = gelu_tanh(acc[ai][bj][m][n][j]);
                        u32x2 w; w.x = cvt_pk_bf16(v[0], v[1]); w.y = cvt_pk_bf16(v[2], v[3]); *(u32x2*)(gp + 4 * n) = w; asm volatile("" ::: "memory"); } } }
    }
};
struct PolGlu : DenseRow0<16, 2048, true> {
    bf16_t* OO; float* SSQO; const float* bias;
    __device__ __forceinline__ void epi(const f32x4 (&acc)[2][2][4][2], const DUnit& u, int wr, int wc, int fr, int fq) const {
        const int c0 = u.pn * 128 + wc * 32 + 8 * fq;
        const f32x4 b10 = *(const f32x4*)(bias + c0), b11 = *(const f32x4*)(bias + c0 + 4), b20 = *(const f32x4*)(bias + 1024 + c0), b21 = *(const f32x4*)(bias + 1024 + c0 + 4);
#pragma unroll
        for (int ai = 0; ai < 2; ++ai)
#pragma unroll
            for (int m = 0; m < 4; ++m) {
                const int row = row0 + u.pm * 256 + ai * 128 + wr * 64 + m * 16 + fr;
                f32x4 o0, o1;
#pragma unroll
                for (int j = 0; j < 4; ++j) { o0[j] = (acc[ai][0][m][0][j] + b10[j]) * sigmoid_f(acc[ai][1][m][0][j] + b20[j]); o1[j] = (acc[ai][0][m][1][j] + b11[j]) * sigmoid_f(acc[ai][1][m][1][j] + b21[j]); }
                float s = sq4(o0) + sq4(o1);
                store8(OO + (size_t)row * DM + c0, o0, o1);
                s += __shfl_xor(s, 16); s += __shfl_xor(s, 32);
                if (fq == 0) SSQO[(size_t)row * 32 + u.pn * 4 + wc] = s;
            }
    }
};
#ifndef REP_ATTN
#define REP_ATTN 1
#endif
#ifndef REP_MISC
#define REP_MISC 1
#endif
#ifndef REP_DENSE
#define REP_DENSE 1
#endif
#ifndef REP_G2A
#define REP_G2A 1
#endif
#ifndef REP_G1
#define REP_G1 1
#endif
__device__ __forceinline__ void moe_stage(const Args& args, Frame& F, const XcdBarrier& bar, int layer, int row_lo) {
    const int nrows = NROWS - row_lo, tpb = nrows / F.G;
    {   unsigned char* ws = opaque_ptr(args.ws);
        PolShr p; p.A = (const char*)(ws + WS_XN) + (size_t)row_lo * 2048; p.Bt = (const char*)(ws + WS_WSHR) + (size_t)layer * 768 * 2048; p.nM = nrows / 256; p.nN = 3; p.G = F.G; p.c = (int)blockIdx.x;
        p.row0 = row_lo; p.HSH = (bf16_t*)(ws + WS_HSH); p.LOG = (float*)(ws + WS_LOG);
        for (int rep_ = 0; rep_ < REP_DENSE; ++rep_) pg8::gemm_phase(F.lds, p);
    }
    if (layer == 1 && args.stage == 7) return;
    xcd_barrier(bar);
    route_phase(args, F, layer, row_lo, tpb);
#if REP_MISC == 2
    __syncthreads(); route_phase(args, F, layer, row_lo, tpb);
#endif
    if (layer == 1 && args.stage == 8) return;
    xcd_barrier(bar);
    place_phase(args, F, row_lo, tpb);
#if REP_MISC == 2
    __syncthreads(); place_phase(args, F, row_lo, tpb);
#endif
    if (layer == 1 && args.stage == 9) return;
    xcd_barrier(bar);
    const int* TINFO = (const int*)(opaque_ptr(args.ws) + WS_TINFO);
    const int ts0 = __builtin_amdgcn_readfirstlane(TINFO[0]), ts1 = __builtin_amdgcn_readfirstlane(TINFO[64]), ts2 = __builtin_amdgcn_readfirstlane(TINFO[128]), ts3 = __builtin_amdgcn_readfirstlane(TINFO[192]);
#define MOE_G1(TA, TB, HBUF) for (int rep_ = 0; rep_ < REP_G1; ++rep_) do { unsigned char* ws = opaque_ptr(args.ws); PolMoe1 p; p.XN = (const char*)(ws + WS_XN); p.W1 = (const char*)(ws + WS_W1); p.H = (bf16_t*)(ws + (HBUF)); p.TINFO = (const int*)(ws + WS_TINFO); p.LDST = (const int*)(ws + WS_LDST); p.T0 = (TA); p.T1 = (TB); p.G = F.G; p.c = (int)blockIdx.x; \
        pg8::gemm_phase(F.lds, p); } while (0)
#define MOE_G2(RMW, TA, TB, HBUF) do { unsigned char* ws = opaque_ptr(args.ws); PolMoe2<RMW> p; p.H = (const char*)(ws + (HBUF)); p.W2 = (const char*)(ws + WS_W2); p.Y = (bf16_t*)(ws + WS_Y); p.TINFO = (const int*)(ws + WS_TINFO); p.LDST = (const int*)(ws + WS_LDST); p.LW = (const float*)(ws + WS_LW); p.T0 = (TA); p.T1 = (TB); p.G = F.G; p.c = (int)blockIdx.x; \
        pg8::gemm_phase(F.lds, p); } while (0)
    MOE_G1(ts0, ts1, WS_H0);
    if (layer == 1 && args.stage == 10) return;
    xcd_barrier(bar);
#define MOE_SHD() do { unsigned char* ws = opaque_ptr(args.ws); PolShd p; p.A = (const char*)(ws + WS_HSH) + (size_t)row_lo * 512; p.Bt = (const char*)(ws + WS_WSHD) + (size_t)layer * 1024 * 512; p.nM = nrows / 256; p.nN = 4; p.G = F.G; p.c = (int)blockIdx.x; \
        p.row0 = row_lo; p.Y = (bf16_t*)(ws + WS_Y); pg8::gemm_phase(F.lds, p); } while (0)
    if (blockIdx.x & 1) { MOE_G1(ts1, ts2, WS_H1); MOE_G2(false, ts0, ts1, WS_H0); MOE_SHD(); }
    else { MOE_G2(false, ts0, ts1, WS_H0); MOE_SHD(); MOE_G1(ts1, ts2, WS_H1); }
    if (layer == 1 && args.stage == 11) return;
    xcd_barrier(bar);
    if (blockIdx.x & 1) { MOE_G1(ts2, ts3, WS_H0); MOE_G2(true, ts1, ts2, WS_H1); }
    else { MOE_G2(true, ts1, ts2, WS_H1); MOE_G1(ts2, ts3, WS_H0); }
    if (layer == 1 && args.stage == 12) return;
    xcd_barrier(bar);
    MOE_G2(true, ts2, ts3, WS_H0);
    if (layer == 1 && args.stage == 13) return;
    xcd_barrier(bar);
    if (layer == 0) { if (F.vcu < 64) s5_tables_phase(args, F); else convert_experts(args, F, 1, 64); }
    combine_phase(args, F, layer, row_lo);
#undef MOE_SHD
#undef MOE_G1
#undef MOE_G2
}

__global__ void __launch_bounds__(NWAVES * 64, 2) trunk_fwd(Args args) {
    extern __shared__ __attribute__((aligned(16))) unsigned char lds_raw[];
    Frame F;
    F.lds = (LAS unsigned char*)lds_raw;
    F.G = gridDim.x; { const int bx = blockIdx.x; F.vcu = (F.G % 8 == 0) ? (bx % 8) * (F.G / 8) + bx / 8 : bx; }
    F.ws = args.ws;
    volatile LAS unsigned* MISC = (volatile LAS unsigned*)(F.lds + LDSCTL_OFF);
    for (int u = threadIdx.x; u < (LDS_BYTES - LDSCTL_OFF) / 4; u += NWAVES * 64) ((LAS unsigned*)(F.lds + LDSCTL_OFF))[u] = 0u;
    __syncthreads();
    if (threadIdx.x < 31) ((LAS unsigned long long*)(F.lds + PTAB_OFF))[threadIdx.x] = (unsigned long long)args.in[threadIdx.x];
    __syncthreads();
    XcdBarrier bar = xcd_barrier_post((unsigned*)(args.ws + WS_CTL) + CW_BAR, MISC + 8);
#define GRID_BAR() xcd_barrier(bar)

    mod_phase(args, F);
    __syncthreads();
    convert_small(args, F);
    rope_phase(args, F);
    convert_experts(args, F, 0, 0);
#if REP_MISC == 2
    __syncthreads();
    mod_phase(args, F);
    __syncthreads();
    convert_small(args, F);
    rope_phase(args, F);
    convert_experts(args, F, 0, 0);
#endif
    GRID_BAR();
    h_phase(args, F, 0, 0);
    GRID_BAR();
    {   unsigned char* ws = opaque_ptr(args.ws);
        PolDqkv p; p.A = (const char*)(ws + WS_XN); p.Bt = (const char*)(ws + WS_WDQKV); p.nM = NROWS / 256; p.nN = 3; p.G = F.G; p.c = (int)blockIdx.x;
        p.A1 = (bf16_t*)(ws + WS_A1); p.SSQ1 = (float*)(ws + WS_SSQ1); p.KPE = (bf16_t*)(ws + WS_KPE); p.ROPE = (const float*)(ws + WS_ROPE);
        for (int rep_ = 0; rep_ < REP_DENSE; ++rep_) pg8::gemm_phase(F.lds, p);
    }
    GRID_BAR();
    {   unsigned char* ws = opaque_ptr(args.ws);
        PolQup p; p.A = (const char*)(ws + WS_A1); p.Bt = (const char*)(ws + WS_WUQ); p.nM = NROWS / 256; p.nN = NQ / 256; p.G = F.G; p.c = (int)blockIdx.x;
        p.Q = (bf16_t*)(ws + WS_Q); p.SSQ1 = (const float*)(ws + WS_SSQ1);
        for (int rep_ = 0; rep_ < REP_DENSE; ++rep_) pg8::gemm_phase(F.lds, p);
    }
    {   unsigned char* ws = opaque_ptr(args.ws);
        PolKVup p; p.A = (const char*)(ws + WS_A1) + QLORA * 2; p.Bt = (const char*)(ws + WS_WUKV); p.nM = NROWS / 256; p.nN = NKV / 256; p.G = F.G; p.c = (int)blockIdx.x;
        p.KV = (bf16_t*)(ws + WS_KV); p.SSQ1 = (const float*)(ws + WS_SSQ1);
        for (int rep_ = 0; rep_ < REP_DENSE; ++rep_) pg8::gemm_phase(F.lds, p);
    }
    GRID_BAR();
    {   unsigned char* ws = opaque_ptr(args.ws);
        const bf16_t* Qg = (const bf16_t*)(ws + WS_Q); const bf16_t* KVb = (const bf16_t*)(ws + WS_KV); const bf16_t* KPE = (const bf16_t*)(ws + WS_KPE); bf16_t* Og = (bf16_t*)(ws + WS_O); const float* RP = (const float*)(ws + WS_ROPE);
        for (int rep_ = 0; rep_ < REP_ATTN; ++rep_)
        for (int u = F.vcu; u < 1024 + 128; u += F.G) {
            if (u < 1024) { const int bh = u >> 3, qb = u & 7, b = bh >> 3, h = bh & 7;
                attn::attn_unit(Qg, KVb, KPE, Og, RP, NCTXR + b * SEQL + qb * 256, qb * 256, h, b * NCTX, NCTXR + b * SEQL, 36, (char*)lds_raw); }
            else { const int bh = u - 1024, b = bh >> 3, h = bh & 7;
                attn::attn_unit(Qg, KVb, KPE, Og, RP, b * NCTX, -1, h, b * NCTX, 0, 4, (char*)lds_raw); }
        }
    }
    GRID_BAR();
    {   unsigned char* ws = opaque_ptr(args.ws);
        PolWo p; p.A = (const char*)(ws + WS_O); p.Bt = (const char*)(ws + WS_WO); p.nM = NROWS / 256; p.nN = 4; p.G = F.G; p.c = (int)blockIdx.x;
        p.OO = (bf16_t*)(ws + WS_OO); p.SSQO = (float*)(ws + WS_SSQO);
        for (int rep_ = 0; rep_ < REP_DENSE; ++rep_) pg8::gemm_phase(F.lds, p);
    }
    GRID_BAR();
    postmix_phase(args, F, 0, 0, 16);
    GRID_BAR();
    moe_stage(args, F, bar, 0, 0);
    if (args.stage == 1) return;
    GRID_BAR();
    {   unsigned char* ws = opaque_ptr(args.ws);
        PolS5S p; p.XN = (const char*)(ws + WS_XN); p.BTS = (const char*)(ws + WS_BTS); p.S = (float*)(ws + WS_S); p.G = F.G; p.c = (int)blockIdx.x;
        for (int rep_ = 0; rep_ < REP_DENSE; ++rep_) pg8::gemm_phase(F.lds, p);
    }
    if (args.stage == 2) return;
    GRID_BAR();
    s5_scan_phase(args, F);
#if REP_MISC == 2
    s5_scan_phase(args, F);
#endif
    if (args.stage == 3) return;
    GRID_BAR();
    {   unsigned char* ws = opaque_ptr(args.ws);
        PolS5Y p; p.XN = (const char*)(ws + WS_XN); p.XIN = (const char*)(ws + WS_XIN); p.BTY = (const char*)(ws + WS_BTY); p.Gb = (bf16_t*)(ws + WS_G); p.G = F.G; p.c = (int)blockIdx.x;
        for (int rep_ = 0; rep_ < REP_DENSE; ++rep_) pg8::gemm_phase(F.lds, p);
    }
    if (args.stage == 4) return;
    GRID_BAR();
    {   unsigned char* ws = opaque_ptr(args.ws);
        PolGlu p; p.A = (const char*)(ws + WS_G); p.Bt = (const char*)(ws + WS_WGLU); p.nM = NLATR / 256; p.nN = 8; p.G = F.G; p.c = (int)blockIdx.x;
        p.row0 = NCTXR; p.OO = (bf16_t*)(ws + WS_OO); p.SSQO = (float*)(ws + WS_SSQO); p.bias = inp(F, 22);
        for (int rep_ = 0; rep_ < REP_DENSE; ++rep_) pg8::gemm_phase(F.lds, p);
    }
    if (args.stage == 5) return;
    GRID_BAR();
    postmix_phase(args, F, 1, NCTXR, 32);
    if (args.stage == 6) return;
    GRID_BAR();
    moe_stage(args, F, bar, 1, NCTXR);
}

#ifndef DBG_STAGE
#define DBG_STAGE 0
#endif
extern "C" void kernel_launch(void* const* d_in, const int* in_sizes, int n_in, void* d_out, int out_size, void* d_ws, size_t ws_size, hipStream_t stream) {
    static int grid = 0;
    if (grid == 0) {
        if (n_in != 31 || out_size != NLATR * DM || ws_size < WS_END) { fprintf(stderr, "kernel_launch: unexpected shapes (n_in %d out %d ws %zu)\n", n_in, out_size, ws_size); grid = -1; return; }
        int dev = 0, cus = 0;
        if (hipGetDevice(&dev) != hipSuccess || hipDeviceGetAttribute(&cus, hipDeviceAttributeMultiprocessorCount, dev) != hipSuccess) { grid = -1; return; }
        if (hipFuncSetAttribute((const void*)trunk_fwd, hipFuncAttributeMaxDynamicSharedMemorySize, LDS_BYTES) != hipSuccess) { fprintf(stderr, "kernel_launch: hipFuncSetAttribute failed\n"); grid = -1; return; }
        (void)hipGetLastError();
        grid = cus;
    }
    if (grid < 0) return;
    (void)hipMemsetAsync((char*)d_ws + WS_CTL, 0, CTL_BYTES, stream);
    Args a{};
    for (int i = 0; i < 31; ++i) a.in[i] = (const float*)d_in[i];
    a.out = (float*)d_out; a.ws = (unsigned char*)d_ws; a.stage = DBG_STAGE; a.pad = 0;
    hipLaunchKernelGGL(trunk_fwd, dim3(grid), dim3(NWAVES * 64), LDS_BYTES, stream, a);
}
```

```cpp
#include <hip/hip_runtime.h>
#include <cstdio>
#include <cstdint>

#define GAS __attribute__((address_space(1)))
#define LAS __attribute__((address_space(3)))
typedef unsigned short bf16_t;
typedef short bf16x8 __attribute__((ext_vector_type(8)));
typedef short s16x4 __attribute__((ext_vector_type(4)));
typedef float f32x2 __attribute__((ext_vector_type(2)));
typedef float f32x4 __attribute__((ext_vector_type(4)));
typedef float f32x16 __attribute__((ext_vector_type(16)));
typedef unsigned u32x2 __attribute__((ext_vector_type(2)));
typedef unsigned u32x4 __attribute__((ext_vector_type(4)));

constexpr int DM = 1024, NBATCH = 16, SEQL = 2048, NCTX = 256;
constexpr int NCTXR = NBATCH * NCTX;
constexpr int NLATR = NBATCH * SEQL;
constexpr int NROWS = NCTXR + NLATR;
constexpr int NHEAD = 8, QLORA = 384, KVLORA = 256, NOPE = 128, ROPED = 64, VDIM = 128;
constexpr int NDQKV = 768;
constexpr int NQ = NHEAD * (NOPE + ROPED);
constexpr int NKV = NHEAD * (NOPE + VDIM);
constexpr int NEXP = 64, TOPK = 8, DEXP = 256;
constexpr float NORM_EPS = 1e-6f;
constexpr int NMOD = 6, MODW = NMOD * DM;

constexpr size_t MiB = 1u << 20;
constexpr size_t WS_CTL = 0, CTL_BYTES = 1 * MiB;
constexpr size_t WS_WDQKV = 1 * MiB;
constexpr size_t WS_WUQ   = WS_WDQKV + 1536 * 1024;
constexpr size_t WS_WUKV  = WS_WUQ + 1280 * 1024;
constexpr size_t WS_WO    = WS_WUKV + 1 * MiB;
constexpr size_t WS_WGLU  = WS_WO + 2 * MiB;
constexpr size_t WS_WSHR  = WS_WGLU + 4 * MiB;
constexpr size_t WS_WSHD  = WS_WSHR + 3 * MiB;
constexpr size_t WS_MOD   = 15 * MiB;
constexpr size_t WS_ROPE  = 16 * MiB;
constexpr size_t WS_W1    = 17 * MiB;
constexpr size_t WS_W2    = 81 * MiB;
constexpr size_t WS_XCTX  = 113 * MiB;
constexpr size_t WS_XN    = 129 * MiB;
constexpr size_t WS_ST    = 201 * MiB;
static_assert(WS_WSHD + 1 * MiB <= WS_MOD, "small weights fit");
constexpr size_t WS_KV   = WS_ST;
constexpr size_t WS_Q    = WS_ST + 144 * MiB;
constexpr size_t WS_OO   = WS_Q;
constexpr size_t WS_A1   = WS_ST + 252 * MiB;
constexpr size_t WS_O    = WS_A1;
constexpr size_t WS_KPE  = WS_ST + 324 * MiB;
constexpr size_t WS_SSQ1 = WS_ST + 329 * MiB;
constexpr size_t WS_SSQO = WS_ST + 332 * MiB;
constexpr size_t WS_END  = WS_ST + 402 * MiB;

constexpr int CW_BAR = 4096;

__device__ __forceinline__ unsigned cvt_pk_bf16(float lo, float hi) { unsigned r; asm volatile("v_cvt_pk_bf16_f32 %0, %1, %2" : "=v"(r) : "v"(lo), "v"(hi)); return r; }
__device__ __forceinline__ float bf_lo(unsigned w) { return __uint_as_float(w << 16); }
__device__ __forceinline__ float bf_hi(unsigned w) { return __uint_as_float(w & 0xffff0000u); }
__device__ __forceinline__ float wave_sum(float v) {
#pragma unroll
    for (int o = 1; o < 64; o <<= 1) v += __shfl_xor(v, o);
    return v;
}
__device__ __forceinline__ float silu_f(float v) { return v / (1.f + __expf(-v)); }
__device__ __forceinline__ float sigmoid_f(float v) { return 1.f / (1.f + __expf(-v)); }
__device__ __forceinline__ int mod_index(int row) { return row < NCTXR ? 16 : (row - NCTXR) / SEQL; }
__device__ __forceinline__ int opaque_tid() { int t = threadIdx.x; asm volatile("" : "+v"(t)); return t; }
__device__ __forceinline__ float gelu_tanh(float v) {
    const float z = 0.7978845608028654f * (v + 0.044715f * v * v * v);
    return v / (1.f + __expf(-2.f * z));
}
__device__ __forceinline__ unsigned char* opaque_ptr(unsigned char* p) {
    unsigned lo = __builtin_amdgcn_readfirstlane((unsigned)(unsigned long long)p), hi = __builtin_amdgcn_readfirstlane((unsigned)((unsigned long long)p >> 32));
    asm volatile("" : "+s"(lo), "+s"(hi)); return (unsigned char*)(((unsigned long long)hi << 32) | lo); }
constexpr float Y_SCALE = 64.f, Y_INV = 1.f / 64.f, Y_MAX = 448.f;
__device__ __forceinline__ unsigned fp8_pack4(const f32x4& v) {
    const float a = fminf(fmaxf(v[0] * Y_SCALE, -Y_MAX), Y_MAX), b = fminf(fmaxf(v[1] * Y_SCALE, -Y_MAX), Y_MAX), c = fminf(fmaxf(v[2] * Y_SCALE, -Y_MAX), Y_MAX), d = fminf(fmaxf(v[3] * Y_SCALE, -Y_MAX), Y_MAX);
    int p = __builtin_amdgcn_cvt_pk_fp8_f32(a, b, 0, false); p = __builtin_amdgcn_cvt_pk_fp8_f32(c, d, p, true); return (unsigned)p; }
__device__ __forceinline__ f32x4 fp8_unpack4(unsigned w) {
    const f32x2 lo = __builtin_amdgcn_cvt_pk_f32_fp8((int)w, false), hi = __builtin_amdgcn_cvt_pk_f32_fp8((int)w, true);
    return (f32x4){lo.x * Y_INV, lo.y * Y_INV, hi.x * Y_INV, hi.y * Y_INV}; }
#define XB_TMO      128
#define XB_XCNT(j)  (256  + 64 * (j))
#define XB_XSUB(j)  (1280 + 64 * (j))
#define XB_XGEN(j)  (2304 + 64 * (j))
#define XB_TOP      3328
#define XB_TOPGEN   3392
#define XCD_BAR_WORDS 3456
#define XB_SPIN_CAP (1u << 18)
__device__ __forceinline__ unsigned xb_ld(unsigned* p)              { return __hip_atomic_load(p, __ATOMIC_RELAXED, __HIP_MEMORY_SCOPE_AGENT); }
__device__ __forceinline__ unsigned xb_add(unsigned* p, unsigned v) { return __hip_atomic_fetch_add(p, v, __ATOMIC_RELAXED, __HIP_MEMORY_SCOPE_AGENT); }
__device__ __forceinline__ unsigned xb_xcc_id() { return (unsigned)__builtin_amdgcn_s_getreg((3 << 11) | 20) & 0xFu; }
#define XB_SPIN(cond, bar) do { unsigned _sp = 0; while (cond) { __builtin_amdgcn_s_sleep(1); \
    if ((++_sp & 255u) == 0u) { if (xb_ld(&(bar)[XB_TMO])) break; if (_sp > XB_SPIN_CAP) { atomicAdd(&(bar)[XB_TMO], 1u); break; } } } } while (0)
struct XcdBarrier { unsigned* bar; unsigned x; volatile LAS unsigned* st; };
__device__ __forceinline__ XcdBarrier xcd_barrier_post(unsigned* bar, volatile LAS unsigned* st) {
    XcdBarrier b; b.bar = bar; b.x = xb_xcc_id(); b.st = st;
    if (threadIdx.x == 0) (void)xb_add(&bar[XB_XCNT(b.x)], 1u);
    return b;
}
__device__ __forceinline__ void xcd_barrier_complete(unsigned* bar, unsigned x, unsigned& nloc, unsigned& nx) {
    const unsigned G = gridDim.x * gridDim.y * gridDim.z;
    unsigned sum, cnt, mine, sp = 0u;
    for (;;) {
        sum = 0u; cnt = 0u; mine = 0u;
#pragma unroll
        for (unsigned j = 0; j < 16; ++j) { const unsigned c = xb_ld(&bar[XB_XCNT(j)]); sum += c; cnt += (c > 0u) ? 1u : 0u; mine = (j == x) ? c : mine; }
        if (sum == G) break;
        __builtin_amdgcn_s_sleep(1);
        if ((++sp & 255u) == 0u) { if (xb_ld(&bar[XB_TMO])) break; if (sp > XB_SPIN_CAP) { atomicAdd(&bar[XB_TMO], 1u); break; } }
    }
    nloc = mine > 0u ? mine : 1u; nx = cnt > 0u ? cnt : 1u;
}
__device__ __forceinline__ void xcd_barrier(const XcdBarrier& b) {
    asm volatile("s_waitcnt vmcnt(0)" ::: "memory");
    __syncthreads();
    if (threadIdx.x == 0) {
        unsigned* bar = b.bar;
        __builtin_amdgcn_s_waitcnt(0);
        unsigned nloc = b.st[0], nx = b.st[1];
        if (nloc == 0u) { xcd_barrier_complete(bar, b.x, nloc, nx); b.st[0] = nloc; b.st[1] = nx; }
        const unsigned old = xb_add(&bar[XB_XSUB(b.x)], 1u);
        const unsigned gen = old / nloc;
        if (old + 1u == (gen + 1u) * nloc) {
            __builtin_amdgcn_fence(__ATOMIC_RELEASE, "agent");
            asm volatile("s_waitcnt vmcnt(0)" ::: "memory");
            const unsigned og = xb_add(&bar[XB_TOP], 1u);
            const unsigned tg = og / nx;
            if (og + 1u == (tg + 1u) * nx) xb_add(&bar[XB_TOPGEN], 1u);
            else XB_SPIN(xb_ld(&bar[XB_TOPGEN]) == tg, bar);
            __builtin_amdgcn_fence(__ATOMIC_ACQUIRE, "agent");
            xb_add(&bar[XB_XGEN(b.x)], 1u);
            asm volatile("s_waitcnt vmcnt(0)" ::: "memory");
        } else {
            XB_SPIN(xb_ld(&bar[XB_XGEN(b.x)]) == gen, bar);
            __builtin_amdgcn_fence(__ATOMIC_ACQUIRE, "agent");
            asm volatile("s_waitcnt vmcnt(0)" ::: "memory");
        }
    }
    __syncthreads();
}

namespace pg8 {
constexpr int BM = 256, BK = 64, HALF = 128, HTB = HALF * BK * 2, STAGE_BYTES = 8 * HTB, NXCD = 8, WGM = 8;
__host__ __device__ __forceinline__ int lds_byte(int r, int c) { const int st = (r >> 4) * 2 + (c >> 5), rr = r & 15, cc = c & 31, ob = rr * 64 + cc * 2; return st * 1024 + (ob ^ (((ob >> 9) & 1) << 5)); }
__host__ __device__ __forceinline__ void stage_rc(int b, int& R, int& C) { const int st = b / 1024, sb = b % 1024, swz = sb ^ (((sb >> 9) & 1) << 5); R = (st >> 1) * 16 + swz / 64; C = (st & 1) * 32 + (swz % 64) / 2; }
__host__ __device__ __forceinline__ int perm32(int rho) { const int n = rho >> 4, i = rho & 15; return 8 * (i >> 2) + 4 * n + (i & 3); }

__device__ __forceinline__ bool dense_order(int i, int G, int c, int nM, int nN, int& pm, int& pn) {
    const int nwg = nM * nN; const long L = (long)i * G + c; if (L >= nwg) return false;
    int wgid = (int)L; { const int q = nwg / NXCD, r = nwg % NXCD, xcd = wgid % NXCD, off = wgid / NXCD; wgid = (xcd < r ? xcd * (q + 1) : r * (q + 1) + (xcd - r) * q) + off; }
    const int nig = WGM * nN, gid = wgid / nig, fm = gid * WGM, gsz = (nM - fm) < WGM ? (nM - fm) : WGM;
    pm = __builtin_amdgcn_readfirstlane(fm + ((wgid % nig) % gsz)); pn = __builtin_amdgcn_readfirstlane((wgid % nig) / gsz); return true;
}

template <bool GATHER> struct UCtx { const char* a0[2]; const char* a1[2]; const char* b; unsigned vg[2][2]; };
template <> struct UCtx<false> { const char* a0[2]; const char* a1[2]; const char* b; };

template <class P>
__device__ __forceinline__ void gemm_phase(LAS unsigned char* lds, const P& pol) {
    typedef typename P::Unit Unit;
    const int tid = opaque_tid(), wid = __builtin_amdgcn_readfirstlane(tid >> 6), lane = tid & 63, wr = wid >> 2, wc = wid & 3, fr = lane & 15, fq = lane >> 4;
    constexpr int nt = P::NT;
    int Rr[2], Cc[2]; unsigned voffB[2], va0[2];
#pragma unroll
    for (int i = 0; i < 2; ++i) { stage_rc(tid * 16 + i * 8192, Rr[i], Cc[i]); const int Rb = P::PERM ? ((Rr[i] & ~31) + perm32(Rr[i] & 31)) : Rr[i];
        voffB[i] = (unsigned)(Rb * P::LDB + Cc[i] * 2); va0[i] = pol.lane_a0(Rr[i], Cc[i]); }
    constexpr size_t hstepB = (size_t)HALF * P::LDB;
    const unsigned ldsw = (unsigned)wid * 1024u;
    const int aoff = lds_byte(wr * 64 + fr, fq * 8), boff = lds_byte(wc * 32 + fr, fq * 8);
#define PG8_SA(b, h) (((b) * 2 + (h)) * HTB)
#define PG8_SB(b, h) ((4 + (b) * 2 + (h)) * HTB)
#define PG8_GL(bufoff, p0, p1) do { __builtin_amdgcn_global_load_lds((const unsigned*)(p0), (LAS unsigned*)(lds + (bufoff) + ldsw), 16, 0, 0); \
        __builtin_amdgcn_global_load_lds((const unsigned*)(p1), (LAS unsigned*)(lds + (bufoff) + ldsw + 8192), 16, 0, 0); } while (0)
#define PG8_STB(bufoff, U, h, kt) do { const char* _b = (U).b + (size_t)(h) * hstepB + (size_t)(kt) * 128; asm volatile("" : "+s"(_b)); PG8_GL(bufoff, _b + voffB[0], _b + voffB[1]); } while (0)
#define PG8_STA(bufoff, U, h, kt) do { const char* _a = (U).a0[h] + (size_t)(kt) * P::KS0; if constexpr (P::TWOSEG) { if ((kt) >= P::KT0) _a = (U).a1[h] + (size_t)((kt) - P::KT0) * P::KS1; } \
        unsigned _o0, _o1; if constexpr (P::GATHER) { _o0 = (U).vg[h][0]; _o1 = (U).vg[h][1]; } else { _o0 = va0[0]; _o1 = va0[1]; } \
        asm volatile("" : "+s"(_a)); PG8_GL(bufoff, _a + _o0, _a + _o1); } while (0)
#define PG8_LDA(dst, b, h) do { _Pragma("unroll") for (int m = 0; m < 4; ++m) _Pragma("unroll") for (int k = 0; k < 2; ++k) dst[m][k] = *(const LAS bf16x8*)(lds + PG8_SA(b, h) + aoff + m * 2048 + k * 1024); } while (0)
#define PG8_LDB(dst, b, h) do { _Pragma("unroll") for (int n = 0; n < 2; ++n) _Pragma("unroll") for (int k = 0; k < 2; ++k) dst[n][k] = *(const LAS bf16x8*)(lds + PG8_SB(b, h) + boff + n * 2048 + k * 1024); } while (0)
#define PG8_MMA(ai, bj, At, Bt) do { __builtin_amdgcn_s_setprio(1); _Pragma("unroll") for (int m = 0; m < 4; ++m) _Pragma("unroll") for (int n = 0; n < 2; ++n) _Pragma("unroll") for (int k = 0; k < 2; ++k) \
        acc[ai][bj][m][n] = __builtin_amdgcn_mfma_f32_16x16x32_bf16(Bt[n][k], At[m][k], acc[ai][bj][m][n], 0, 0, 0); __builtin_amdgcn_s_setprio(0); } while (0)
#define PG8_WAIT_V(n) asm volatile("s_waitcnt vmcnt(" #n ")" ::: "memory")
#define PG8_WAIT_L(n) asm volatile("s_waitcnt lgkmcnt(" #n ")" ::: "memory")
#define PG8_BAR __builtin_amdgcn_s_barrier()
#define PG8_SCHED __builtin_amdgcn_sched_barrier(0)
    Unit cur, nxt; int ui = 0;
    if (!pol.next(0, cur)) return;
    UCtx<P::GATHER> cc, nc;
    pol.ctx(cur, cc, Rr, Cc);
    f32x4 acc[2][2][4][2];
#pragma unroll
    for (int a = 0; a < 2; ++a)
#pragma unroll
        for (int b = 0; b < 2; ++b)
#pragma unroll
            for (int m = 0; m < 4; ++m)
#pragma unroll
                for (int n = 0; n < 2; ++n) acc[a][b][m][n] = (f32x4){0.f, 0.f, 0.f, 0.f};
    bf16x8 At[4][2], B0[2][2], B1[2][2];
    PG8_STB(PG8_SB(0, 0), cc, 0, 0); PG8_STB(PG8_SB(0, 1), cc, 1, 0); PG8_STA(PG8_SA(0, 0), cc, 0, 0); PG8_STA(PG8_SA(0, 1), cc, 1, 0);
    if (wr == 1) PG8_BAR;
    PG8_WAIT_V(2); PG8_BAR;
    PG8_STB(PG8_SB(1, 0), cc, 0, 1); PG8_STA(PG8_SA(1, 0), cc, 0, 1); PG8_STB(PG8_SB(1, 1), cc, 1, 1);
    PG8_WAIT_V(6); PG8_BAR;
    for (;;) {
        const bool has_next = pol.next(ui + 1, nxt);
        if (has_next) pol.ctx(nxt, nc, Rr, Cc); else nc = cc;
        for (int t = 0; t < nt; t += 2) {
            const bool last = (t == nt - 2);
            const int k2 = last ? 0 : t + 2, k3 = k2 + 1;
            PG8_LDB(B0, 0, 0); PG8_LDB(B1, 0, 1); PG8_SCHED; PG8_LDA(At, 0, 0); PG8_STA(PG8_SA(1, 1), cc, 1, t + 1);
            PG8_WAIT_V(8); PG8_WAIT_L(0); PG8_BAR; PG8_MMA(0, 0, At, B0); PG8_MMA(0, 1, At, B1); PG8_BAR; PG8_SCHED;
            PG8_LDA(At, 0, 1);
            if (last) { PG8_STB(PG8_SB(0, 0), nc, 0, 0); PG8_STB(PG8_SB(0, 1), nc, 1, 0); PG8_STA(PG8_SA(0, 0), nc, 0, 0); }
            else      { PG8_STB(PG8_SB(0, 0), cc, 0, k2); PG8_STB(PG8_SB(0, 1), cc, 1, k2); PG8_STA(PG8_SA(0, 0), cc, 0, k2); }
            PG8_WAIT_V(8); PG8_WAIT_L(0); PG8_BAR; PG8_MMA(1, 0, At, B0); PG8_MMA(1, 1, At, B1); PG8_BAR; PG8_SCHED;
            PG8_LDB(B0, 1, 0); PG8_LDB(B1, 1, 1); PG8_SCHED; PG8_LDA(At, 1, 0);
            if (last) { PG8_STA(PG8_SA(0, 1), nc, 1, 0); } else { PG8_STA(PG8_SA(0, 1), cc, 1, k2); }
            PG8_WAIT_V(8); PG8_WAIT_L(0); PG8_BAR; PG8_MMA(0, 0, At, B0); PG8_MMA(0, 1, At, B1); PG8_BAR; PG8_SCHED;
            PG8_LDA(At, 1, 1);
            if (last) { PG8_STB(PG8_SB(1, 0), nc, 0, 1); PG8_STB(PG8_SB(1, 1), nc, 1, 1); PG8_STA(PG8_SA(1, 0), nc, 0, 1); }
            else      { PG8_STB(PG8_SB(1, 0), cc, 0, k3); PG8_STB(PG8_SB(1, 1), cc, 1, k3); PG8_STA(PG8_SA(1, 0), cc, 0, k3); }
            PG8_WAIT_V(8); PG8_WAIT_L(0); PG8_BAR; PG8_MMA(1, 0, At, B0); PG8_MMA(1, 1, At, B1); PG8_BAR; PG8_SCHED;
        }
        if (wr == 0) PG8_BAR;
        pol.epi(acc, cur, wr, wc, fr, fq);
        if (!has_next) break;
#pragma unroll
        for (int a = 0; a < 2; ++a)
#pragma unroll
            for (int b = 0; b < 2; ++b)
#pragma unroll
                for (int m = 0; m < 4; ++m)
#pragma unroll
                    for (int n = 0; n < 2; ++n) acc[a][b][m][n] = (f32x4){0.f, 0.f, 0.f, 0.f};
        cur = nxt; cc = nc; ++ui;
        if (wr == 1) PG8_BAR;
    }
    PG8_WAIT_V(0);
    PG8_BAR;
#undef PG8_SA
#undef PG8_SB
#undef PG8_GL
#undef PG8_STB
#undef PG8_STA
#undef PG8_LDA
#undef PG8_LDB
#undef PG8_MMA
#undef PG8_WAIT_V
#undef PG8_WAIT_L
#undef PG8_BAR
#undef PG8_SCHED
}
}
struct DUnit { int pm, pn; };

template <int NT_, int LDA_, bool PERM_> struct DenseBase {
    static constexpr bool PERM = PERM_, GATHER = false, TWOSEG = false;
    static constexpr int NT = NT_, KT0 = NT_, KS0 = 128, KS1 = 128, LDB = NT_ * 128;
    typedef DUnit Unit;
    const char* A; const char* Bt; int nM, nN, G, c;
    __device__ __forceinline__ bool next(int i, Unit& u) const { return pg8::dense_order(i, G, c, nM, nN, u.pm, u.pn); }
    __device__ __forceinline__ void ctx(const Unit& u, pg8::UCtx<false>& x, const int (&)[2], const int (&)[2]) const {
        x.a0[0] = A + (size_t)u.pm * 256 * LDA_; x.a0[1] = x.a0[0] + (size_t)128 * LDA_; x.a1[0] = x.a0[0]; x.a1[1] = x.a0[1];
        x.b = Bt + (size_t)u.pn * 256 * LDB; }
    __device__ __forceinline__ unsigned lane_a0(int R, int C) const { return (unsigned)(R * LDA_ + C * 2); }
    __device__ __forceinline__ unsigned lane_a1(int, int) const { return 0u; }
};

__device__ __forceinline__ void store8(bf16_t* p, const f32x4& v0, const f32x4& v1) {
    u32x4 w; w.x = cvt_pk_bf16(v0[0], v0[1]); w.y = cvt_pk_bf16(v0[2], v0[3]); w.z = cvt_pk_bf16(v1[0], v1[1]); w.w = cvt_pk_bf16(v1[2], v1[3]); *(u32x4*)p = w; }
__device__ __forceinline__ float sq4(const f32x4& v) { return (v[0] * v[0] + v[1] * v[1]) + (v[2] * v[2] + v[3] * v[3]); }
__device__ __forceinline__ void rope8(f32x4& v0, f32x4& v1, const float* cs) {
    const f32x4 a = *(const f32x4*)cs, b = *(const f32x4*)(cs + 4);
    float x0, x1;
    x0 = v0[0]; x1 = v0[1]; v0[0] = x0 * a[0] - x1 * a[1]; v0[1] = x0 * a[1] + x1 * a[0];
    x0 = v0[2]; x1 = v0[3]; v0[2] = x0 * a[2] - x1 * a[3]; v0[3] = x0 * a[3] + x1 * a[2];
    x0 = v1[0]; x1 = v1[1]; v1[0] = x0 * b[0] - x1 * b[1]; v1[1] = x0 * b[1] + x1 * b[0];
    x0 = v1[2]; x1 = v1[3]; v1[2] = x0 * b[2] - x1 * b[3]; v1[3] = x0 * b[3] + x1 * b[2];
}

struct PolDqkv : DenseBase<16, 2048, true> {
    bf16_t* A1; float* SSQ1; bf16_t* KPE; const float* ROPE;
    __device__ __forceinline__ void epi(const f32x4 (&acc)[2][2][4][2], const DUnit& u, int wr, int wc, int fr, int fq) const {
#pragma unroll
        for (int ai = 0; ai < 2; ++ai)
#pragma unroll
            for (int m = 0; m < 4; ++m) {
                const int row = u.pm * 256 + ai * 128 + wr * 64 + m * 16 + fr;
                bf16_t* rowp = A1 + (size_t)row * NDQKV + u.pn * 256 + wc * 32 + 8 * fq;
                float s0 = sq4(acc[ai][0][m][0]) + sq4(acc[ai][0][m][1]), s1 = sq4(acc[ai][1][m][0]) + sq4(acc[ai][1][m][1]);
                store8(rowp, acc[ai][0][m][0], acc[ai][0][m][1]); store8(rowp + 128, acc[ai][1][m][0], acc[ai][1][m][1]);
                s0 += __shfl_xor(s0, 16); s0 += __shfl_xor(s0, 32); s1 += __shfl_xor(s1, 16); s1 += __shfl_xor(s1, 32);
                if (fq == 0) {
                    float* sp = SSQ1 + (size_t)row * 16;
                    if (u.pn == 0) sp[wc] = s0 + s1; else if (u.pn == 1) { sp[4 + wc] = s0; sp[8 + wc] = s1; } else sp[12 + wc] = s0;
                }
                if (u.pn == 2 && wc < 2) {
                    f32x4 v0 = acc[ai][1][m][0], v1 = acc[ai][1][m][1];
                    if (row >= NCTXR) { const int t = (row - NCTXR) & (SEQL - 1); rope8(v0, v1, ROPE + ((size_t)t * 32 + 16 * wc + 4 * fq) * 2); }
                    store8(KPE + (size_t)row * 64 + 32 * wc + 8 * fq, v0, v1);
                }
            }
    }
};

struct PolQup : DenseBase<6, NDQKV * 2, true> {
    bf16_t* Q; const float* SSQ1;
    __device__ __forceinline__ void epi(const f32x4 (&acc)[2][2][4][2], const DUnit& u, int wr, int wc, int fr, int fq) const {
#pragma unroll
        for (int ai = 0; ai < 2; ++ai) {
            f32x4 p0[4], p1[4];
#pragma unroll
            for (int m = 0; m < 4; ++m) { const int row = u.pm * 256 + ai * 128 + wr * 64 + m * 16 + fr; p0[m] = *(const f32x4*)(SSQ1 + (size_t)row * 16); p1[m] = *(const f32x4*)(SSQ1 + (size_t)row * 16 + 4); }
#pragma unroll
            for (int m = 0; m < 4; ++m) {
                const int row = u.pm * 256 + ai * 128 + wr * 64 + m * 16 + fr;
                const float ss = ((p0[m][0] + p0[m][1]) + (p0[m][2] + p0[m][3])) + ((p1[m][0] + p1[m][1]) + (p1[m][2] + p1[m][3]));
                const float rstd = __builtin_amdgcn_rsqf(ss * (1.f / QLORA) + NORM_EPS);
                bf16_t* rowp = Q + (size_t)row * NQ + u.pn * 256 + wc * 32 + 8 * fq;
                store8(rowp, acc[ai][0][m][0] * rstd, acc[ai][0][m][1] * rstd); store8(rowp + 128, acc[ai][1][m][0] * rstd, acc[ai][1][m][1] * rstd);
            }
            asm volatile("" ::: "memory");
        }
    }
};

struct PolKVup : DenseBase<4, NDQKV * 2, true> {
    bf16_t* KV; const float* SSQ1;
    __device__ __forceinline__ void epi(const f32x4 (&acc)[2][2][4][2], const DUnit& u, int wr, int wc, int fr, int fq) const {
#pragma unroll
        for (int ai = 0; ai < 2; ++ai) {
            f32x4 p0[4], p1[4];
#pragma unroll
            for (int m = 0; m < 4; ++m) { const int row = u.pm * 256 + ai * 128 + wr * 64 + m * 16 + fr; p0[m] = *(const f32x4*)(SSQ1 + (size_t)row * 16 + 8); p1[m] = *(const f32x4*)(SSQ1 + (size_t)row * 16 + 12); }
#pragma unroll
            for (int m = 0; m < 4; ++m) {
                const int row = u.pm * 256 + ai * 128 + wr * 64 + m * 16 + fr;
                const float ss = ((p0[m][0] + p0[m][1]) + (p0[m][2] + p0[m][3])) + ((p1[m][0] + p1[m][1]) + (p1[m][2] + p1[m][3]));
                const float rstd = __builtin_amdgcn_rsqf(ss * (1.f / KVLORA) + NORM_EPS);
                bf16_t* rowp = KV + (size_t)row * NKV + u.pn * 256 + wc * 32 + 8 * fq;
                store8(rowp, acc[ai][0][m][0] * rstd, acc[ai][0][m][1] * rstd); store8(rowp + 128, acc[ai][1][m][0] * rstd, acc[ai][1][m][1] * rstd);
            }
            asm volatile("" ::: "memory");
        }
    }
};

struct PolWo : DenseBase<16, 2048, true> {
    bf16_t* OO; float* SSQO;
    __device__ __forceinline__ void epi(const f32x4 (&acc)[2][2][4][2], const DUnit& u, int wr, int wc, int fr, int fq) const {
#pragma unroll
        for (int ai = 0; ai < 2; ++ai)
#pragma unroll
            for (int m = 0; m < 4; ++m) {
                const int row = u.pm * 256 + ai * 128 + wr * 64 + m * 16 + fr;
                bf16_t* rowp = OO + (size_t)row * DM + u.pn * 256 + wc * 32 + 8 * fq;
                float s = (sq4(acc[ai][0][m][0]) + sq4(acc[ai][0][m][1])) + (sq4(acc[ai][1][m][0]) + sq4(acc[ai][1][m][1]));
                store8(rowp, acc[ai][0][m][0], acc[ai][0][m][1]); store8(rowp + 128, acc[ai][1][m][0], acc[ai][1][m][1]);
                s += __shfl_xor(s, 16); s += __shfl_xor(s, 32);
                if (fq == 0) SSQO[(size_t)row * 32 + u.pn * 4 + wc] = s;
            }
    }
};
namespace attn {
constexpr int NW = 8, QBLK = 32, KVBLK = 64, DQK = 192, DV = 128;
constexpr float SCALE = 0.07216878364870322f;
constexpr float THR = 8.f;
constexpr int SHM_V = KVBLK * DV * 2, SHM_K = KVBLK * DQK * 2;
constexpr int SHM_QPE = NW * 4096;
constexpr int SHM_ATTN = 2 * SHM_V + 2 * SHM_K + NW * 64 * 4 + SHM_QPE;
#define KSWZ(row, colB) ((row) * 384 + ((colB) ^ (((row) & 7) << 4)))
#define SBAR() __builtin_amdgcn_sched_barrier(0)
__device__ __forceinline__ int crow(int r, int hi) { return (r & 3) + 8 * (r >> 2) + 4 * hi; }
__device__ __forceinline__ unsigned cvtpk(float lo, float hi) { unsigned r; asm volatile("v_cvt_pk_bf16_f32 %0, %1, %2" : "=v"(r) : "v"(lo), "v"(hi)); return r; }

__device__ __forceinline__ void partialSM(f32x16& p0, f32x16& p1, float& m_reg, float& mn, float& alpha) {
  constexpr float C = SCALE * 1.4426950408889634f;
  float pmax = p0[0];
#pragma unroll
  for (int r = 1; r < 16; ++r) pmax = fmaxf(pmax, p0[r]);
#pragma unroll
  for (int r = 0; r < 16; ++r) pmax = fmaxf(pmax, p1[r]);
  { auto rr = __builtin_amdgcn_permlane32_swap(__float_as_uint(pmax), __float_as_uint(pmax), false, false);
    pmax = fmaxf(__uint_as_float(rr[0]), __uint_as_float(rr[1])); }
  if (__builtin_expect(__all(pmax - m_reg <= THR / SCALE), 1)) { mn = m_reg; alpha = 1.f; }
  else { mn = fmaxf(m_reg, pmax); alpha = __builtin_amdgcn_exp2f((m_reg - mn) * C); m_reg = mn; }
  float mnC = -mn * C;
#pragma unroll
  for (int r = 0; r < 16; ++r) p0[r] = fmaf(p0[r], C, mnC);
#pragma unroll
  for (int r = 0; r < 16; ++r) p1[r] = fmaf(p1[r], C, mnC);
#pragma unroll
  for (int r = 0; r < 16; ++r) p0[r] = __builtin_amdgcn_exp2f(p0[r]);
}
__device__ __forceinline__ void finishSM(f32x16& p0, f32x16& p1, float alpha, float& l_reg, bf16x8& pa0, bf16x8& pa1, bf16x8& pa2, bf16x8& pa3) {
#pragma unroll
  for (int r = 0; r < 16; ++r) p1[r] = __builtin_amdgcn_exp2f(p1[r]);
  float ps = 0;
#pragma unroll
  for (int r = 0; r < 16; ++r) ps += p0[r];
#pragma unroll
  for (int r = 0; r < 16; ++r) ps += p1[r];
  { auto rr = __builtin_amdgcn_permlane32_swap(__float_as_uint(ps), __float_as_uint(ps), false, false);
    ps = __uint_as_float(rr[0]) + __uint_as_float(rr[1]); }
  l_reg = l_reg * alpha + ps;
#define PK4(P, BASE, OUT) do { unsigned a0 = cvtpk(P[BASE + 0], P[BASE + 1]), a1 = cvtpk(P[BASE + 2], P[BASE + 3]);   \
    unsigned b0 = cvtpk(P[BASE + 4], P[BASE + 5]), b1 = cvtpk(P[BASE + 6], P[BASE + 7]);                              \
    auto r0 = __builtin_amdgcn_permlane32_swap(a0, b0, false, false); auto r1 = __builtin_amdgcn_permlane32_swap(a1, b1, false, false); \
    u32x4 w = {r0[0], r1[0], r0[1], r1[1]}; OUT = *reinterpret_cast<bf16x8*>(&w); } while (0)
  PK4(p0, 0, pa0); PK4(p0, 8, pa1); PK4(p1, 0, pa2); PK4(p1, 8, pa3);
#undef PK4
}
__device__ __forceinline__ void qkt(f32x16& p0, f32x16& p1, const char* Ks, const bf16x8* qr, const char* qpe, int r32, int hi) {
  p0 = f32x16{}; p1 = f32x16{};
#pragma unroll
  for (int d0 = 0; d0 < 12; ++d0) { int cb = (d0 * 16 + hi * 8) * 2;
    bf16x8 b0 = *reinterpret_cast<const bf16x8*>(Ks + KSWZ(r32, cb));
    bf16x8 b1 = *reinterpret_cast<const bf16x8*>(Ks + KSWZ(32 + r32, cb));
    const bf16x8 q = d0 < 8 ? qr[d0 < 8 ? d0 : 0] : *reinterpret_cast<const bf16x8*>(qpe + (d0 - 8) * 1024);
    p0 = __builtin_amdgcn_mfma_f32_32x32x16_bf16(b0, q, p0, 0, 0, 0);
    p1 = __builtin_amdgcn_mfma_f32_32x32x16_bf16(b1, q, p1, 0, 0, 0);
    if ((d0 & 3) == 3) SBAR(); }
}
__device__ __forceinline__ int v_st(int k, int c) { const int kk = (k & ~0xC) | ((k & 4) << 1) | ((k & 8) >> 1); return ((kk >> 3) * 4 + (c >> 5)) * 512 + ((kk & 7) * 32 + (c & 31)) * 2; }
__device__ __forceinline__ int v_rd_base(int lane) { return ((lane & 3) << 3) | (((lane >> 2) & 3) << 6) | (((lane >> 4) & 1) << 5) | (((lane >> 5) & 1) << 8); }
constexpr int v_rd_off(int d0, int ks, int half) { return d0 * 512 + ks * 4096 + half * 2048; }
template <int OFF> __device__ __forceinline__ s16x4 tr_read(int vb) {
  s16x4 r; asm volatile("ds_read_b64_tr_b16 %0, %1 offset:%2" : "=&v"(r) : "v"(vb), "i"(OFF) : "memory"); return r;
}
template <int D0> __device__ __forceinline__ void pv_one(f32x16& od, int vb, bf16x8 pa0, bf16x8 pa1, bf16x8 pa2, bf16x8 pa3) {
  const s16x4 l0 = tr_read<v_rd_off(D0, 0, 0)>(vb), h0 = tr_read<v_rd_off(D0, 0, 1)>(vb), l1 = tr_read<v_rd_off(D0, 1, 0)>(vb), h1 = tr_read<v_rd_off(D0, 1, 1)>(vb);
  const s16x4 l2 = tr_read<v_rd_off(D0, 2, 0)>(vb), h2 = tr_read<v_rd_off(D0, 2, 1)>(vb), l3 = tr_read<v_rd_off(D0, 3, 0)>(vb), h3 = tr_read<v_rd_off(D0, 3, 1)>(vb);
  asm volatile("s_waitcnt lgkmcnt(0)" ::: "memory"); SBAR();
#define PK(L, H) (bf16x8){L[0], L[1], L[2], L[3], H[0], H[1], H[2], H[3]}
  od = __builtin_amdgcn_mfma_f32_32x32x16_bf16(pa0, PK(l0, h0), od, 0, 0, 0);
  od = __builtin_amdgcn_mfma_f32_32x32x16_bf16(pa1, PK(l1, h1), od, 0, 0, 0);
  od = __builtin_amdgcn_mfma_f32_32x32x16_bf16(pa2, PK(l2, h2), od, 0, 0, 0);
  od = __builtin_amdgcn_mfma_f32_32x32x16_bf16(pa3, PK(l3, h3), od, 0, 0, 0);
#undef PK
}
__device__ __forceinline__ void pv_d0(f32x16* o, int vb, bf16x8 pa0, bf16x8 pa1, bf16x8 pa2, bf16x8 pa3) {
  pv_one<0>(o[0], vb, pa0, pa1, pa2, pa3); pv_one<1>(o[1], vb, pa0, pa1, pa2, pa3); pv_one<2>(o[2], vb, pa0, pa1, pa2, pa3); pv_one<3>(o[3], vb, pa0, pa1, pa2, pa3);
}

__device__ __forceinline__ void attn_unit(const bf16_t* __restrict__ Qg, const bf16_t* __restrict__ KVb, const bf16_t* __restrict__ KPE, bf16_t* __restrict__ Og, const float* __restrict__ ROPE,
                                          int qrow0, int qt0, int h, int crow0, int lrow0, int NT, char* lds) {
  const int tid = opaque_tid(), wid = tid >> 6, lane = tid & 63, r32 = lane & 31, hi = lane >> 5;
  char* V_lds = lds; char* K_lds = lds + 2 * SHM_V;
  float* ws = (float*)(lds + 2 * SHM_V + 2 * SHM_K) + wid * 64; float* li_l = ws; float* al_l = ws + 32;
  float m_reg = -1e30f, l_reg = 0; f32x16 o[4] = {}; bf16x8 qr[8];
  char* qpe = lds + 2 * SHM_V + 2 * SHM_K + NW * 64 * 4 + wid * 4096 + lane * 16;
  const bf16_t* Qw = Qg + (size_t)(qrow0 + wid * QBLK + r32) * NQ + h * DQK + hi * 8;
#pragma unroll
  for (int d0 = 0; d0 < 8; ++d0) qr[d0] = *reinterpret_cast<const bf16x8*>(Qw + d0 * 16);
#pragma unroll
  for (int d0 = 8; d0 < 12; ++d0) {
    u32x4 qv = *reinterpret_cast<const u32x4*>(Qw + d0 * 16);
    if (qt0 >= 0) { const float* cs = ROPE + ((size_t)(qt0 + wid * QBLK + r32) * 32 + 8 * (d0 - 8) + 4 * hi) * 2; const f32x4 ca = *(const f32x4*)cs, cb = *(const f32x4*)(cs + 4);
      float x0, x1;
      x0 = bf_lo(qv.x); x1 = bf_hi(qv.x); qv.x = cvtpk(x0 * ca[0] - x1 * ca[1], x0 * ca[1] + x1 * ca[0]);
      x0 = bf_lo(qv.y); x1 = bf_hi(qv.y); qv.y = cvtpk(x0 * ca[2] - x1 * ca[3], x0 * ca[3] + x1 * ca[2]);
      x0 = bf_lo(qv.z); x1 = bf_hi(qv.z); qv.z = cvtpk(x0 * cb[0] - x1 * cb[1], x0 * cb[1] + x1 * cb[0]);
      x0 = bf_lo(qv.w); x1 = bf_hi(qv.w); qv.w = cvtpk(x0 * cb[2] - x1 * cb[3], x0 * cb[3] + x1 * cb[2]); }
    *reinterpret_cast<u32x4*>(qpe + (d0 - 8) * 1024) = qv; }
  const int sr = tid >> 4, sc = (tid & 15) * 8, vst0 = v_st(sr, sc), vst1 = v_st(32 + sr, sc);
  const int pr = tid >> 3, pc = (tid & 7) * 8;
  const int vb0 = (int)(uintptr_t)V_lds + v_rd_base(lane);
  bf16x8 vs0, vs1, ks0, ks1, kp;
#define TROW(j) ((j) < 4 ? crow0 + 64 * (j) : lrow0 + 64 * ((j) - 4))
#define SLOAD(j) do { const int k0_ = TROW(j); const bf16_t* kv0_ = KVb + (size_t)(k0_ + sr) * NKV + h * 256 + sc; const bf16_t* kv1_ = kv0_ + (size_t)32 * NKV; \
    vs0 = *reinterpret_cast<const bf16x8*>(kv0_ + 128); vs1 = *reinterpret_cast<const bf16x8*>(kv1_ + 128); \
    ks0 = *reinterpret_cast<const bf16x8*>(kv0_); ks1 = *reinterpret_cast<const bf16x8*>(kv1_); \
    kp = *reinterpret_cast<const bf16x8*>(KPE + (size_t)(k0_ + pr) * 64 + pc); } while (0)
#define SWRITE(b) do { *(bf16x8*)(V_lds + (b) * SHM_V + vst0) = vs0; *(bf16x8*)(V_lds + (b) * SHM_V + vst1) = vs1; \
    *(bf16x8*)(K_lds + (b) * SHM_K + KSWZ(sr, sc * 2)) = ks0; *(bf16x8*)(K_lds + (b) * SHM_K + KSWZ(32 + sr, sc * 2)) = ks1; \
    *(bf16x8*)(K_lds + (b) * SHM_K + KSWZ(pr, (128 + pc) * 2)) = kp; } while (0)
#define SWAIT() asm volatile("s_waitcnt vmcnt(0)" ::: "memory")
#define RESC(a) do { if (__any((a) < 1.f)) { if (hi == 0) al_l[r32] = (a); asm volatile("s_waitcnt lgkmcnt(0)" ::: "memory"); \
    _Pragma("unroll") for (int d = 0; d < 4; ++d) _Pragma("unroll") for (int r = 0; r < 16; ++r) o[d][r] *= al_l[crow(r, hi)]; } } while (0)
  f32x16 pA0, pA1, pB0, pB1; float mnA, mnB, alA, alB; bf16x8 pa0, pa1, pa2, pa3;
  SLOAD(0); SWAIT(); SWRITE(0); __syncthreads();
  qkt(pA0, pA1, K_lds, qr, qpe, r32, hi); partialSM(pA0, pA1, m_reg, mnA, alA);
  SLOAD(1);
  SWAIT(); SWRITE(1); __syncthreads();
  for (int j = 1; j + 1 < NT; j += 2) {
    SBAR(); qkt(pB0, pB1, K_lds + SHM_K, qr, qpe, r32, hi);
    finishSM(pA0, pA1, alA, l_reg, pa0, pa1, pa2, pa3); SBAR();
    SLOAD(j + 1); SBAR();
    pv_d0(o, vb0, pa0, pa1, pa2, pa3); partialSM(pB0, pB1, m_reg, mnB, alB);
    __syncthreads(); SWAIT(); SWRITE(0);
    RESC(alB); __syncthreads();
    SBAR(); qkt(pA0, pA1, K_lds, qr, qpe, r32, hi);
    finishSM(pB0, pB1, alB, l_reg, pa0, pa1, pa2, pa3); SBAR();
    SLOAD(j + 2); SBAR();
    pv_d0(o, vb0 + SHM_V, pa0, pa1, pa2, pa3); partialSM(pA0, pA1, m_reg, mnA, alA);
    __syncthreads(); SWAIT(); SWRITE(1);
    RESC(alA); __syncthreads();
  }
  SBAR(); qkt(pB0, pB1, K_lds + SHM_K, qr, qpe, r32, hi);
  finishSM(pA0, pA1, alA, l_reg, pa0, pa1, pa2, pa3); SBAR();
  pv_d0(o, vb0, pa0, pa1, pa2, pa3); partialSM(pB0, pB1, m_reg, mnB, alB);
  __syncthreads(); RESC(alB);
  finishSM(pB0, pB1, alB, l_reg, pa0, pa1, pa2, pa3); SBAR();
  pv_d0(o, vb0 + SHM_V, pa0, pa1, pa2, pa3);
  if (hi == 0) li_l[r32] = l_reg; asm volatile("s_waitcnt lgkmcnt(0)" ::: "memory");
  float rli[16];
#pragma unroll
  for (int r = 0; r < 16; ++r) rli[r] = __builtin_amdgcn_rcpf(li_l[crow(r, hi)]);
  bf16_t* Ow = Og + (size_t)(qrow0 + wid * QBLK) * DM + h * DV;
#pragma unroll
  for (int r = 0; r < 16; ++r) { const int orow = crow(r, hi);
#pragma unroll
    for (int d0 = 0; d0 < 4; ++d0) Ow[(size_t)orow * DM + d0 * 32 + r32] = (bf16_t)(cvtpk(o[d0][r] * rli[r], 0.f) & 0xffffu); }
  __syncthreads();
#undef TROW
#undef SLOAD
#undef SWRITE
#undef SWAIT
#undef RESC
}
#undef KSWZ
#undef SBAR
}
constexpr int NWAVES = 8;
constexpr int RING_BYTES = 131072, LDSCTL_OFF = RING_BYTES, LDS_BYTES = 147456;

struct Args {
    const float* in[31]; float* out; unsigned char* ws; int stage; int pad;
};
struct Frame {
    LAS unsigned char* lds; int vcu, G; unsigned char* ws;
};
constexpr int PTAB_OFF = 131072 + 512;
__device__ __forceinline__ const float* inp(const Frame& F, int i) {
    const LAS unsigned* t = (const LAS unsigned*)(F.lds + PTAB_OFF) + 2 * i;
    const unsigned lo = __builtin_amdgcn_readfirstlane(t[0]), hi = __builtin_amdgcn_readfirstlane(t[1]);
    return (const float*)(((unsigned long long)hi << 32) | lo);
}

__device__ __forceinline__ unsigned f2bf(float f) { unsigned u = __float_as_uint(f); return (u + 0x7fffu + ((u >> 16) & 1u)) >> 16; }
__device__ __forceinline__ unsigned pk2(float lo, float hi) { return f2bf(lo) | (f2bf(hi) << 16); }
__device__ __forceinline__ void cvt_item(const float* srcA, const float* srcB, const float* kscale, bf16_t* dst, int ld, int K, int nrows, int nvalid, int mode, int item, LAS float* scr, int lane) {
    const int nblk = nrows >> 5, kb = item / nblk, nb = item - kb * nblk, k0 = 64 * kb, n0 = 32 * nb;
    const float* src = srcA; int col = n0; bool valid = n0 < nvalid;
    if (mode == 1) { const int t = n0 >> 8, r = n0 & 255; src = r < 128 ? srcA : srcB; col = 128 * t + (r & 127); valid = true; }
    const int kk = lane >> 3, n4 = (lane & 7) * 4;
    f32x4 v[8];
    if (valid) {
        const float* sp = src + (size_t)(k0 + kk) * ld + col + n4;
#pragma unroll
        for (int i = 0; i < 8; ++i) v[i] = *(const f32x4*)(sp + (size_t)(8 * i) * ld);
        if (kscale) {
#pragma unroll
            for (int i = 0; i < 8; ++i) v[i] = v[i] * kscale[k0 + 8 * i + kk];
        }
    } else {
#pragma unroll
        for (int i = 0; i < 8; ++i) v[i] = (f32x4){0.f, 0.f, 0.f, 0.f};
    }
#pragma unroll
    for (int i = 0; i < 8; ++i) { LAS float* d = scr + (8 * i + kk) * 33 + n4; d[0] = v[i][0]; d[1] = v[i][1]; d[2] = v[i][2]; d[3] = v[i][3]; }
    asm volatile("s_waitcnt lgkmcnt(0)" ::: "memory");
    const int c = lane & 7;
#pragma unroll
    for (int j = 0; j < 4; ++j) { const int n = (lane >> 3) + 8 * j; const LAS float* s = scr + (8 * c) * 33 + n;
        u32x4 o; o.x = cvt_pk_bf16(s[0 * 33], s[1 * 33]); o.y = cvt_pk_bf16(s[2 * 33], s[3 * 33]); o.z = cvt_pk_bf16(s[4 * 33], s[5 * 33]); o.w = cvt_pk_bf16(s[6 * 33], s[7 * 33]);
        *(u32x4*)(dst + (size_t)(n0 + n) * K + k0 + 8 * c) = o; }
    asm volatile("s_waitcnt lgkmcnt(0)" ::: "memory");
}
constexpr int N_SMALL_JOBS = 11;
__device__ __forceinline__ void convert_small(const Args& a, Frame& F) {
    unsigned char* const wsl = opaque_ptr(a.ws);
    const int tid_ = opaque_tid(), lane_ = tid_ & 63, wave_ = __builtin_amdgcn_readfirstlane(tid_ >> 6);
    LAS float* scr = (LAS float*)(F.lds + wave_ * 16384);
    const int gw = F.vcu * NWAVES + wave_, NGW = F.G * NWAVES;
    unsigned char* ws = wsl;
    int base = 0;
#define SMALL_JOB(SA, SB, KS, DST, LD, KK, NR, NV, MODE) do { const int n_ = ((KK) >> 6) * ((NR) >> 5); const int first_ = ((gw - base) % NGW + NGW) % NGW; \
        for (int it = first_; it < n_; it += NGW) cvt_item(SA, SB, KS, DST, LD, KK, NR, NV, MODE, it, scr, lane_); base += n_; } while (0)
    SMALL_JOB(inp(F, 7), nullptr, nullptr, (bf16_t*)(ws + WS_WDQKV), 704, 1024, 768, 704, 0);
    SMALL_JOB(inp(F, 10), nullptr, inp(F, 8), (bf16_t*)(ws + WS_WUQ), 1536, 384, 1536, 1536, 0);
    SMALL_JOB(inp(F, 11), nullptr, inp(F, 9), (bf16_t*)(ws + WS_WUKV), 2048, 256, 2048, 2048, 0);
    SMALL_JOB(inp(F, 12), nullptr, nullptr, (bf16_t*)(ws + WS_WO), 1024, 1024, 1024, 1024, 0);
    SMALL_JOB(inp(F, 21), inp(F, 21) + 1024, nullptr, (bf16_t*)(ws + WS_WGLU), 2048, 1024, 2048, 2048, 1);
#pragma unroll 1
    for (int l = 0; l < 2; ++l) {
        SMALL_JOB(inp(F, 28) + (size_t)l * 1024 * 256, inp(F, 29) + (size_t)l * 1024 * 256, nullptr, (bf16_t*)(ws + WS_WSHR) + (size_t)l * 768 * 1024, 256, 1024, 512, 512, 1);
        SMALL_JOB(inp(F, 23) + (size_t)l * 1024 * 64, nullptr, nullptr, (bf16_t*)(ws + WS_WSHR) + (size_t)l * 768 * 1024 + (size_t)512 * 1024, 64, 1024, 256, 64, 0);
        SMALL_JOB(inp(F, 30) + (size_t)l * 256 * 1024, nullptr, nullptr, (bf16_t*)(ws + WS_WSHD) + (size_t)l * 1024 * 256, 1024, 256, 1024, 1024, 0);
    }
#undef SMALL_JOB
}
__device__ __forceinline__ void convert_experts(const Args& a, Frame& F, int layer, int skip) {
    unsigned char* const wsl = opaque_ptr(a.ws);
    const int tid_ = opaque_tid(), lane_ = tid_ & 63, wave_ = __builtin_amdgcn_readfirstlane(tid_ >> 6);
    LAS float* scr = (LAS float*)(F.lds + wave_ * 16384);
    const int gw = (F.vcu - skip) * NWAVES + wave_, NGW = (F.G - skip) * NWAVES;
    for (int it = gw; it < NEXP * 384; it += NGW) { const int e = it / 384, r = it - e * 384; const size_t eo = ((size_t)layer * NEXP + e) * 1024 * 256;
        if (r < 256) cvt_item(inp(F, 25) + eo, inp(F, 26) + eo, nullptr, (bf16_t*)(wsl + WS_W1) + (size_t)e * 512 * 1024, 256, 1024, 512, 512, 1, r, scr, lane_);
        else cvt_item(inp(F, 27) + eo, nullptr, nullptr, (bf16_t*)(wsl + WS_W2) + (size_t)e * 1024 * 256, 1024, 256, 1024, 1024, 0, r - 256, scr, lane_); }
}

__device__ __forceinline__ void mod_phase(const Args& a, Frame& F) {
    unsigned char* const wsl = opaque_ptr(a.ws);
    const int tid_ = opaque_tid(), lane_ = tid_ & 63, wave_ = __builtin_amdgcn_readfirstlane(tid_ >> 6);
    LAS float* sl = (LAS float*)F.lds;
    LAS float* red = sl + 17 * 1024;
    float* MOD = (float*)(wsl + WS_MOD);
    bool have = false;
    for (int u = F.vcu; u < 256; u += F.G) {
        if (!have) { for (int i = tid_; i < 17 * 1024; i += 512) { const float v = i < 16 * 1024 ? inp(F, 1)[i] : inp(F, 3)[i - 16 * 1024]; sl[i] = silu_f(v); } __syncthreads(); have = true; }
        const int l = u >> 7, n0 = (u & 127) * 48, kg = tid_ >> 6, cl = (tid_ & 63) < 48 ? (tid_ & 63) : 47, col = n0 + cl;
        const float* W = inp(F, 4) + (size_t)l * 1024 * MODW + col;
        float acc[17];
#pragma unroll
        for (int b = 0; b < 17; ++b) acc[b] = 0.f;
#pragma unroll 8
        for (int k = kg; k < 1024; k += 8) { const float w = W[(size_t)k * MODW];
#pragma unroll
            for (int b = 0; b < 17; ++b) acc[b] += sl[b * 1024 + k] * w; }
#pragma unroll
        for (int b = 0; b < 17; ++b) red[(kg * 17 + b) * 64 + (tid_ & 63)] = acc[b];
        __syncthreads();
        for (int i = tid_; i < 17 * 64; i += 512) { const int b = i >> 6, c = i & 63; if (c >= 48) continue; float s = inp(F, 5)[(size_t)l * MODW + n0 + c];
#pragma unroll
            for (int g = 0; g < 8; ++g) s += red[(g * 17 + b) * 64 + c];
            MOD[((size_t)l * 17 + b) * MODW + n0 + c] = s; }
        __syncthreads();
    }
}
__device__ __forceinline__ void sincos_red(float ang, float& c, float& s) {
    const float k = rintf(ang * 0.15915494309189535f);
    float r = fmaf(-k, 6.2831854820251465f, ang); r = fmaf(-k, -1.7484555314695172e-07f, r);
    s = __sinf(r); c = __cosf(r);
}
__device__ __forceinline__ void rope_phase(const Args& a, Frame& F) {
    unsigned char* const wsl = opaque_ptr(a.ws);
    const int tid_ = opaque_tid(), lane_ = tid_ & 63, wave_ = __builtin_amdgcn_readfirstlane(tid_ >> 6);
    float* ROPE = (float*)(wsl + WS_ROPE);
    for (int i = (F.vcu * 512 + tid_); i < SEQL * 32; i += F.G * 512) { const int t = i >> 5, p = i & 31, j = p & 15;
        const float f = exp2f(-(float)j * (13.287712379549449f / 16.f)); const float pos = (float)(p < 16 ? (t >> 6) : (t & 63));
        float c, s; sincos_red(pos * f, c, s); ROPE[2 * i] = c; ROPE[2 * i + 1] = s; }
}

__device__ __forceinline__ const float* xrow_in(const Args& a, const Frame& F, int layer, int row) {
    unsigned char* const wsl = opaque_ptr(a.ws);
    if (layer == 0) return row < NCTXR ? inp(F, 2) + (size_t)row * DM : inp(F, 0) + (size_t)(row - NCTXR) * DM;
    return row < NCTXR ? (const float*)(wsl + WS_XCTX) + (size_t)row * DM : a.out + (size_t)(row - NCTXR) * DM;
}
__device__ __forceinline__ float* xrow_st(const Args& a, int row) {
    unsigned char* const wsl = opaque_ptr(a.ws); return row < NCTXR ? (float*)(wsl + WS_XCTX) + (size_t)row * DM : a.out + (size_t)(row - NCTXR) * DM; }
__device__ __forceinline__ void norm_mod_store(const f32x4 (&v)[4], const float* g, const float* shift, const float* scale, bf16_t* orow, int lane) {
    float s = 0.f;
#pragma unroll
    for (int j = 0; j < 4; ++j) s += sq4(v[j]);
    const float rstd = __builtin_amdgcn_rsqf(wave_sum(s) * (1.f / DM) + NORM_EPS);
#pragma unroll
    for (int j = 0; j < 4; ++j) { const int c = 4 * lane + 256 * j; const f32x4 gg = *(const f32x4*)(g + c), sh = *(const f32x4*)(shift + c), sc = *(const f32x4*)(scale + c);
        const f32x4 h = (v[j] * rstd * gg) * (sc + 1.f) + sh; u32x2 w; w.x = cvt_pk_bf16(h[0], h[1]); w.y = cvt_pk_bf16(h[2], h[3]); *(u32x2*)(orow + c) = w; }
}
__device__ __forceinline__ void h_phase(const Args& a, Frame& F, int layer, int row_lo) {
    unsigned char* const wsl = opaque_ptr(a.ws);
    const int tid_ = opaque_tid(), lane_ = tid_ & 63, wave_ = __builtin_amdgcn_readfirstlane(tid_ >> 6);
    const float* MOD = (const float*)(wsl + WS_MOD) + (size_t)layer * 17 * MODW; const float* g = inp(F, 6) + (size_t)(layer * 4 + 0) * DM; bf16_t* XN = (bf16_t*)(wsl + WS_XN);
    const int stride = F.G * NWAVES; int row = row_lo + F.vcu * NWAVES + wave_;
    f32x4 nx[4];
    if (row < NROWS) { const float* x = xrow_in(a, F, layer, row);
#pragma unroll
        for (int j = 0; j < 4; ++j) nx[j] = *(const f32x4*)(x + 4 * lane_ + 256 * j); }
    for (; row < NROWS; row += stride) {
        f32x4 v[4];
#pragma unroll
        for (int j = 0; j < 4; ++j) v[j] = nx[j];
        if (row + stride < NROWS) { const float* x = xrow_in(a, F, layer, row + stride);
#pragma unroll
            for (int j = 0; j < 4; ++j) nx[j] = *(const f32x4*)(x + 4 * lane_ + 256 * j); }
        const float* m = MOD + (size_t)mod_index(row) * MODW;
        norm_mod_store(v, g, m + 0 * DM, m + 1 * DM, XN + (size_t)row * DM, lane_);
    }
}
__device__ __forceinline__ void postmix_phase(const Args& a, Frame& F, int layer, int row_lo, int NS) {
    unsigned char* const wsl = opaque_ptr(a.ws);
    const int tid_ = opaque_tid(), lane_ = tid_ & 63, wave_ = __builtin_amdgcn_readfirstlane(tid_ >> 6);
    const float* MOD = (const float*)(wsl + WS_MOD) + (size_t)layer * 17 * MODW; const float* g1 = inp(F, 6) + (size_t)(layer * 4 + 1) * DM; const float* g2 = inp(F, 6) + (size_t)(layer * 4 + 2) * DM;
    bf16_t* XN = (bf16_t*)(wsl + WS_XN); const bf16_t* OO = (const bf16_t*)(wsl + WS_OO); const float* SSQO = (const float*)(wsl + WS_SSQO);
    const int stride = F.G * NWAVES; int row = row_lo + F.vcu * NWAVES + wave_;
    f32x4 nx[4]; u32x2 no[4]; float nss = 0.f;
#define PM_LOAD(R) do { const float* x_ = xrow_in(a, F, layer, (R)); \
        _Pragma("unroll") for (int j = 0; j < 4; ++j) { const int c = 4 * lane_ + 256 * j; nx[j] = *(const f32x4*)(x_ + c); no[j] = *(const u32x2*)(OO + (size_t)(R) * DM + c); } \
        nss = lane_ < NS ? SSQO[(size_t)(R) * 32 + lane_] : 0.f; } while (0)
    if (row < NROWS) PM_LOAD(row);
    for (; row < NROWS; row += stride) {
        f32x4 xv[4]; u32x2 ov[4]; float ss = nss;
#pragma unroll
        for (int j = 0; j < 4; ++j) { xv[j] = nx[j]; ov[j] = no[j]; }
        if (row + stride < NROWS) PM_LOAD(row + stride);
        float* xo = xrow_st(a, row); const float* m = MOD + (size_t)mod_index(row) * MODW;
        ss = wave_sum(ss);
        const float rstd = __builtin_amdgcn_rsqf(ss * (1.f / DM) + NORM_EPS);
        f32x4 v[4];
#pragma unroll
        for (int j = 0; j < 4; ++j) { const int c = 4 * lane_ + 256 * j;
            const f32x4 o = {bf_lo(ov[j].x), bf_hi(ov[j].x), bf_lo(ov[j].y), bf_hi(ov[j].y)}; const f32x4 gg = *(const f32x4*)(g1 + c), gt = *(const f32x4*)(m + 2 * DM + c);
            v[j] = xv[j] + gt * (o * rstd * gg); *(f32x4*)(xo + c) = v[j]; }
        norm_mod_store(v, g2, m + 3 * DM, m + 4 * DM, XN + (size_t)row * DM, lane_);
    }
#undef PM_LOAD
}
constexpr size_t WS_Y     = WS_ST;
constexpr size_t WS_H0    = WS_ST + 216 * MiB;
constexpr size_t WS_H1    = WS_ST + 278 * MiB;
constexpr size_t WS_HSH   = WS_ST + 340 * MiB;
constexpr size_t WS_LOG   = WS_ST + 358 * MiB;
constexpr size_t WS_SELI  = WS_ST + 367 * MiB;
constexpr size_t WS_SELW  = WS_SELI + (size_t)NROWS * 32;
constexpr size_t WS_LDST  = WS_ST + 370 * MiB;
constexpr size_t WS_LW    = WS_LDST + 1536 * 1024;
constexpr size_t WS_BLKCNT= WS_ST + 373 * MiB;
constexpr size_t WS_TINFO = WS_BLKCNT + 256 * 192 * 4;
constexpr int NLIST = 192;
static_assert(WS_TINFO + 4 * (512 + 1600) <= WS_ST + 374 * MiB, "MoE stage map");

template <int NT_, int LDA_, bool PERM_> struct DenseRow0 : DenseBase<NT_, LDA_, PERM_> { int row0; };

struct PolShr : DenseRow0<16, 2048, true> {
    bf16_t* HSH; float* LOG;
    __device__ __forceinline__ void epi(const f32x4 (&acc)[2][2][4][2], const DUnit& u, int wr, int wc, int fr, int fq) const {
#pragma unroll
        for (int ai = 0; ai < 2; ++ai)
#pragma unroll
            for (int m = 0; m < 4; ++m) {
                const int row = row0 + u.pm * 256 + ai * 128 + wr * 64 + m * 16 + fr;
                if (u.pn < 2) {
                    f32x4 h0, h1;
#pragma unroll
                    for (int j = 0; j < 4; ++j) { h0[j] = silu_f(acc[ai][0][m][0][j]) * acc[ai][1][m][0][j]; h1[j] = silu_f(acc[ai][0][m][1][j]) * acc[ai][1][m][1][j]; }
                    store8(HSH + (size_t)row * 256 + u.pn * 128 + wc * 32 + 8 * fq, h0, h1);
                } else if (wc < 2) {
                    float* lp = LOG + (size_t)row * 64 + wc * 32 + 8 * fq; *(f32x4*)lp = acc[ai][0][m][0]; *(f32x4*)(lp + 4) = acc[ai][0][m][1];
                }
            }
    }
};

__device__ __forceinline__ int slot_round(int s) { return s < 2 ? 0 : (s < 5 ? 1 : 2); }
__device__ __forceinline__ int slot_yrow(int s) { return s < 2 ? s + 1 : (s < 5 ? s - 2 : s - 5); }
__device__ __forceinline__ void route_phase(const Args& a, Frame& F, int layer, int row_lo, int tpb) {
    unsigned char* const wsl = opaque_ptr(a.ws);
    const int tid_ = opaque_tid(), lane = tid_ & 63, wave = __builtin_amdgcn_readfirstlane(tid_ >> 6);
    LAS int* cnt = (LAS int*)F.lds;
    for (int i = tid_; i < NLIST; i += 512) cnt[i] = 0;
    __syncthreads();
    const float* LOG = (const float*)(wsl + WS_LOG); int* SELI = (int*)(wsl + WS_SELI); float* SELW = (float*)(wsl + WS_SELW);
    const float bias = inp(F, 24)[layer * NEXP + lane];
    const int blk = F.vcu;
    float lg_next = LOG[(size_t)(row_lo + blk * tpb + wave) * 64 + lane];
    for (int t = wave; t < tpb; t += NWAVES) {
        const int row = row_lo + blk * tpb + t;
        const float lg = lg_next; if (t + NWAVES < tpb) lg_next = LOG[(size_t)(row + NWAVES) * 64 + lane];
        const float sc = sigmoid_f(lg), bs = sc + bias;
        float m1 = bs;
        m1 = fmaxf(m1, __shfl_xor(m1, 1)); m1 = fmaxf(m1, __shfl_xor(m1, 2)); m1 = fmaxf(m1, __shfl_xor(m1, 4));
        const unsigned long long eqm = __ballot(bs == m1);
        const int grp = lane >> 3; const unsigned gm = (unsigned)((eqm >> (grp * 8)) & 0xffull);
        float v2 = (bs == m1) ? -INFINITY : bs;
        v2 = fmaxf(v2, __shfl_xor(v2, 1)); v2 = fmaxf(v2, __shfl_xor(v2, 2)); v2 = fmaxf(v2, __shfl_xor(v2, 4));
        const float m2 = (__popc(gm) >= 2) ? m1 : v2;
        const float gs = m1 + m2;
        int grank = 0;
#pragma unroll
        for (int j = 0; j < 8; ++j) { const float o = __shfl(gs, j * 8); grank += (o > gs || (o == gs && j < grp)) ? 1 : 0; }
        const float mv = grank < 4 ? bs : -INFINITY;
        int rank = 0;
#pragma unroll 8
        for (int j = 0; j < 64; ++j) { const float o = __shfl(mv, j); rank += (o > mv || (o == mv && j < lane)) ? 1 : 0; }
        const bool sel = rank < TOPK && grank < 4;
        const float ssum = wave_sum(sel ? sc : 0.f);
        if (sel) { const int s = rank, l = slot_round(s) * 64 + lane;
            SELI[(size_t)row * 8 + s] = l | (slot_yrow(s) << 8); SELW[(size_t)row * 8 + s] = sc / ssum * 2.5f;
            atomicAdd((int*)&cnt[l], 1); }
    }
    __syncthreads();
    int* BLKCNT = (int*)(wsl + WS_BLKCNT);
    for (int i = tid_; i < NLIST; i += 512) BLKCNT[blk * NLIST + i] = cnt[i];
}
__device__ __forceinline__ void place_phase(const Args& a, Frame& F, int row_lo, int tpb) {
    unsigned char* const wsl = opaque_ptr(a.ws);
    const int tid_ = opaque_tid();
    LAS int* tot = (LAS int*)F.lds; LAS int* mine = tot + 256; LAS int* tst = mine + 256; LAS int* cur = tst + 256;
    const int* BLKCNT = (const int*)(wsl + WS_BLKCNT); const int blk = F.vcu;
    if (tid_ < 256) { tot[tid_] = 0; mine[tid_] = 0; cur[tid_] = 0; }
    __syncthreads();
    if (tid_ < 2 * NLIST) { const int l = tid_ % NLIST, b0 = (tid_ / NLIST) * 128; int s = 0, m = 0;
#pragma unroll 16
        for (int b = b0; b < b0 + 128; ++b) { const int c = (b < F.G) ? BLKCNT[b * NLIST + l] : 0; m += (b < blk) ? c : 0; s += c; }
        atomicAdd((int*)&tot[l], s); atomicAdd((int*)&mine[l], m); }
    __syncthreads();
    if (tid_ == 0) { int acc = 0; for (int l = 0; l < NLIST; ++l) { tst[l] = acc; acc += (tot[l] + 255) >> 8; } tst[NLIST] = acc; }
    __syncthreads();
    int* TINFO = (int*)(wsl + WS_TINFO); int* LDST = (int*)(wsl + WS_LDST); float* LW = (float*)(wsl + WS_LW);
    if (blk == 0) {
        for (int i = tid_; i <= NLIST; i += 512) TINFO[i] = tst[i];
        for (int i = tid_; i < NLIST; i += 512) TINFO[256 + i] = tot[i];
        const int lane = tid_ & 63, wv = tid_ >> 6;
        for (int l = wv; l < NLIST; l += NWAVES) { const int t0 = tst[l], t1 = tst[l + 1];
            for (int t = t0 + lane; t < t1; t += 64) TINFO[512 + t] = l;
            const int c = tot[l], base = t0 * 256;
            for (int p = c + lane; p < (t1 - t0) * 256; p += 64) LDST[base + p] = -1; }
    }
    const int* SELI = (const int*)(wsl + WS_SELI); const float* SELW = (const float*)(wsl + WS_SELW);
    for (int i = tid_; i < tpb * 8; i += 512) { const int row = row_lo + blk * tpb + (i >> 3), s = i & 7;
        const int v = SELI[(size_t)row * 8 + s], l = v & 0xff, yr = v >> 8;
        const int pos = tst[l] * 256 + mine[l] + atomicAdd((int*)&cur[l], 1);
        LDST[pos] = row * 3 + yr; LW[pos] = SELW[(size_t)row * 8 + s]; }
}

struct MUnit { int T, pn; };
struct PolMoe1 {
    static constexpr bool PERM = true, GATHER = true, TWOSEG = false;
    static constexpr int NT = 16, KT0 = 16, KS0 = 128, KS1 = 128, LDB = 2048;
    typedef MUnit Unit;
    const char* XN; const char* W1; bf16_t* H; const int* TINFO; const int* LDST; int T0, T1, G, c;
    __device__ __forceinline__ bool next(int i, Unit& u) const { const int L = i * G + c; u.T = T0 + (L >> 1); u.pn = L & 1; return u.T < T1; }
    __device__ __forceinline__ void ctx(const Unit& u, pg8::UCtx<true>& x, const int (&R)[2], const int (&C)[2]) const {
        const int e = __builtin_amdgcn_readfirstlane(TINFO[512 + u.T]) & 63;
        x.a0[0] = XN; x.a0[1] = XN; x.a1[0] = XN; x.a1[1] = XN; x.b = W1 + ((size_t)e * 512 + u.pn * 256) * LDB;
#pragma unroll
        for (int h = 0; h < 2; ++h)
#pragma unroll
            for (int i = 0; i < 2; ++i) { const int d = LDST[u.T * 256 + h * 128 + R[i]]; const int tok = d < 0 ? 0 : d / 3; x.vg[h][i] = (unsigned)tok * 2048u + (unsigned)C[i] * 2u; }
    }
    __device__ __forceinline__ unsigned lane_a0(int, int) const { return 0u; }
    __device__ __forceinline__ unsigned lane_a1(int, int) const { return 0u; }
    __device__ __forceinline__ void epi(const f32x4 (&acc)[2][2][4][2], const Unit& u, int wr, int wc, int fr, int fq) const {
#pragma unroll
        for (int ai = 0; ai < 2; ++ai)
#pragma unroll
            for (int m = 0; m < 4; ++m) {
                const int hrow = (u.T - T0) * 256 + ai * 128 + wr * 64 + m * 16 + fr;
                f32x4 h0, h1;
#pragma unroll
                for (int j = 0; j < 4; ++j) { h0[j] = silu_f(acc[ai][0][m][0][j]) * acc[ai][1][m][0][j]; h1[j] = silu_f(acc[ai][0][m][1][j]) * acc[ai][1][m][1][j]; }
                store8(H + (size_t)hrow * 256 + u.pn * 128 + wc * 32 + 8 * fq, h0, h1);
            }
    }
};
template <bool RMW> struct PolMoe2 {
    static constexpr bool PERM = true, GATHER = false, TWOSEG = false;
    static constexpr int NT = 4, KT0 = 4, KS0 = 128, KS1 = 128, LDB = 512;
    typedef MUnit Unit;
    const char* H; const char* W2; unsigned char* Y; const int* TINFO; const int* LDST; const float* LW; int T0, T1, G, c;
    __device__ __forceinline__ bool next(int i, Unit& u) const { const int L = i * G + c; u.T = T0 + (L >> 2); u.pn = L & 3; return u.T < T1; }
    __device__ __forceinline__ void ctx(const Unit& u, pg8::UCtx<false>& x, const int (&)[2], const int (&)[2]) const {
        const int e = __builtin_amdgcn_readfirstlane(TINFO[512 + u.T]) & 63;
        x.a0[0] = H + (size_t)(u.T - T0) * 256 * 512; x.a0[1] = x.a0[0] + 128 * 512; x.a1[0] = x.a0[0]; x.a1[1] = x.a0[1];
        x.b = W2 + ((size_t)e * 1024 + u.pn * 256) * LDB;
    }
    __device__ __forceinline__ unsigned lane_a0(int R, int C) const { return (unsigned)(R * 512 + C * 2); }
    __device__ __forceinline__ unsigned lane_a1(int, int) const { return 0u; }
    __device__ __forceinline__ void epi(const f32x4 (&acc)[2][2][4][2], const Unit& u, int wr, int wc, int fr, int fq) const {
        const int cofs = u.pn * 256 + wc * 32 + 8 * fq;
#pragma unroll
        for (int ai = 0; ai < 2; ++ai) {
            int d[4]; float w[4];
#pragma unroll
            for (int m = 0; m < 4; ++m) { const int lp = u.T * 256 + ai * 128 + wr * 64 + m * 16 + fr; d[m] = LDST[lp]; w[m] = LW[lp]; }
            u32x2 o[4][2];
            if (RMW) {
#pragma unroll
                for (int m = 0; m < 4; ++m) { const unsigned char* yp = Y + (size_t)(d[m] < 0 ? 0 : d[m]) * DM + cofs; o[m][0] = *(const u32x2*)yp; o[m][1] = *(const u32x2*)(yp + 128); }
            }
#pragma unroll
            for (int m = 0; m < 4; ++m) {
                if (d[m] >= 0) {
                    unsigned char* yp = Y + (size_t)d[m] * DM + cofs; const float ww = w[m];
#pragma unroll
                    for (int bj = 0; bj < 2; ++bj) {
                        f32x4 v0 = acc[ai][bj][m][0] * ww, v1 = acc[ai][bj][m][1] * ww;
                        if (RMW) { v0 += fp8_unpack4(o[m][bj].x); v1 += fp8_unpack4(o[m][bj].y); }
                        u32x2 q; q.x = fp8_pack4(v0); q.y = fp8_pack4(v1); *(u32x2*)(yp + bj * 128) = q;
                    }
                }
            }
            asm volatile("" ::: "memory");
        }
    }
};
struct PolShd : DenseRow0<4, 512, true> {
    unsigned char* Y;
    __device__ __forceinline__ void epi(const f32x4 (&acc)[2][2][4][2], const DUnit& u, int wr, int wc, int fr, int fq) const {
#pragma unroll
        for (int ai = 0; ai < 2; ++ai)
#pragma unroll
            for (int m = 0; m < 4; ++m) {
                const int row = row0 + u.pm * 256 + ai * 128 + wr * 64 + m * 16 + fr;
                unsigned char* yp = Y + (size_t)row * 3 * DM + u.pn * 256 + wc * 32 + 8 * fq;
                u32x2 q0, q1; q0.x = fp8_pack4(acc[ai][0][m][0]); q0.y = fp8_pack4(acc[ai][0][m][1]); q1.x = fp8_pack4(acc[ai][1][m][0]); q1.y = fp8_pack4(acc[ai][1][m][1]);
                *(u32x2*)yp = q0; *(u32x2*)(yp + 128) = q1;
            }
    }
};

__device__ __forceinline__ void combine_phase(const Args& a, Frame& F, int layer, int row_lo) {
    unsigned char* const wsl = opaque_ptr(a.ws);
    const int tid_ = opaque_tid(), lane_ = tid_ & 63, wave_ = __builtin_amdgcn_readfirstlane(tid_ >> 6);
    const float* MOD = (const float*)(wsl + WS_MOD) + (size_t)layer * 17 * MODW; const float* g3 = inp(F, 6) + (size_t)(layer * 4 + 3) * DM;
    const float* MODn = (const float*)(wsl + WS_MOD) + (size_t)1 * 17 * MODW; const float* gn = inp(F, 6) + (size_t)(1 * 4 + 0) * DM;
    bf16_t* XN = (bf16_t*)(wsl + WS_XN); const unsigned char* Y = (const unsigned char*)(wsl + WS_Y);
    const int stride = F.G * NWAVES; int row = row_lo + F.vcu * NWAVES + wave_;
    f32x4 nx[4]; unsigned ny[4][3];
#define CB_LOAD(R) do { const float* x_ = xrow_st(a, (R)); \
        _Pragma("unroll") for (int j = 0; j < 4; ++j) { const int c = 4 * lane_ + 256 * j; nx[j] = *(const f32x4*)(x_ + c); \
            _Pragma("unroll") for (int r = 0; r < 3; ++r) ny[j][r] = *(const unsigned*)(Y + ((size_t)(R) * 3 + r) * DM + c); } } while (0)
    if (row < NROWS) CB_LOAD(row);
    for (; row < NROWS; row += stride) {
        float* xo = xrow_st(a, row); const float* m = MOD + (size_t)mod_index(row) * MODW;
        f32x4 f[4], xv[4]; float ss = 0.f;
#pragma unroll
        for (int j = 0; j < 4; ++j) { xv[j] = nx[j]; f[j] = (f32x4){0.f, 0.f, 0.f, 0.f};
#pragma unroll
            for (int r = 0; r < 3; ++r) f[j] += fp8_unpack4(ny[j][r]);
            ss += sq4(f[j]); }
        if (row + stride < NROWS) CB_LOAD(row + stride);
        const float rstd = __builtin_amdgcn_rsqf(wave_sum(ss) * (1.f / DM) + NORM_EPS);
        f32x4 v[4];
#pragma unroll
        for (int j = 0; j < 4; ++j) { const int c = 4 * lane_ + 256 * j; const f32x4 gg = *(const f32x4*)(g3 + c), gt = *(const f32x4*)(m + 5 * DM + c);
            v[j] = xv[j] + gt * (f[j] * rstd * gg); *(f32x4*)(xo + c) = v[j]; }
        if (layer == 0) { const float* mn = MODn + (size_t)mod_index(row) * MODW; norm_mod_store(v, gn, mn + 0 * DM, mn + 1 * DM, XN + (size_t)row * DM, lane_); }
    }
#undef CB_LOAD
}
constexpr size_t WS_G    = WS_ST;
constexpr size_t WS_BTY  = WS_ST + 216 * MiB;
constexpr size_t WS_BTS  = WS_ST + 264 * MiB;
constexpr size_t WS_S    = WS_ST + 280 * MiB;
constexpr size_t WS_XIN  = WS_ST + 64 * MiB;
constexpr size_t WS_LAMT = WS_ROPE + 512 * 1024;
constexpr int S5_T = 32;

__device__ __forceinline__ f32x2 cmul(f32x2 a, f32x2 b) { return (f32x2){a.x * b.x - a.y * b.y, a.x * b.y + a.y * b.x}; }
__device__ __forceinline__ void s5_tables_group(const Args& a, Frame& F, int g) {
    unsigned char* const wsl = opaque_ptr(a.ws);
    const int tid = opaque_tid();
    LAS float* Kd = (LAS float*)F.lds; LAS f32x2* pw = (LAS f32x2*)(F.lds + 65536); LAS f32x2* bb = pw + 33 * 64; LAS f32x2* cm = bb + 64 * 16;
    bf16_t* BTY = (bf16_t*)(wsl + WS_BTY) + (size_t)g * 512 * 768; bf16_t* BTS = (bf16_t*)(wsl + WS_BTS) + (size_t)g * 256 * 512; float* LAMT = (float*)(wsl + WS_LAMT);
    const float* lre = inp(F, 13); const float* lim = inp(F, 14); const float* lst = inp(F, 15);
    const float* bre = inp(F, 16); const float* bim = inp(F, 17); const float* cre = inp(F, 18); const float* cim = inp(F, 19); const float* dsk = inp(F, 20);
    for (int d = 0; d < 2; ++d) {
        __syncthreads();
        const float step = __expf(lst[d * 64 + g]);
        for (int i = tid; i < 33 * 64; i += 512) { const int k = i >> 6, p = i & 63; const float lr = lre[(d * 64 + g) * 64 + p], li = lim[(d * 64 + g) * 64 + p];
            const float mag = __expf((float)k * lr * step); float c, s; sincos_red((float)k * (li * step), c, s); pw[i] = (f32x2){mag * c, mag * s}; }
        __syncthreads();
        for (int i = tid; i < 64 * 16; i += 512) { const int p = i >> 4; const float lr = lre[(d * 64 + g) * 64 + p], li = lim[(d * 64 + g) * 64 + p];
            const f32x2 lb = pw[64 + p]; const float inv = 1.f / (lr * lr + li * li);
            const f32x2 kap = {((lb.x - 1.f) * lr + lb.y * li) * inv, (lb.y * lr - (lb.x - 1.f) * li) * inv};
            const size_t o = ((size_t)(d * 64 + g) * 64 + p) * 16 + (i & 15); bb[i] = cmul(kap, (f32x2){bre[o], bim[o]}); }
        for (int i = tid; i < 16 * 64; i += 512) { const size_t o = (size_t)(d * 64 + g) * 1024 + i; cm[i] = (f32x2){cre[o], cim[o]}; }
        __syncthreads();
        if (tid < 64) { const f32x2 l32 = pw[32 * 64 + tid]; LAMT[((d * 64 + g) * 64 + tid) * 2] = l32.x; LAMT[((d * 64 + g) * 64 + tid) * 2 + 1] = l32.y; }
        for (int o = tid; o < 32 * 256; o += 512) { const int k = o >> 8, i = (o >> 4) & 15, j = o & 15; float acc = 0.f;
            for (int p = 0; p < 64; ++p) { const f32x2 t = cmul(cm[i * 64 + p], pw[k * 64 + p]); const f32x2 b = bb[p * 16 + j]; acc += t.x * b.x - t.y * b.y; }
            Kd[d * 8192 + o] = acc; }
        for (int o = tid; o < 512 * 64; o += 512) { const int n = o >> 6, p = o & 63, to = n >> 4, i = n & 15;
            const f32x2 w = cmul(cm[i * 64 + p], pw[(d == 0 ? to + 1 : 32 - to) * 64 + p]);
            *(unsigned*)(BTY + (size_t)n * 768 + 512 + 128 * d + 2 * p) = cvt_pk_bf16(w.x, -w.y); }
        for (int o = tid; o < 64 * 256; o += 512) { const int p = o >> 8, kk = (o & 255) * 2, ti = kk >> 4, j = kk & 15;
            const f32x2 pwv = pw[(d == 0 ? 31 - ti : ti) * 64 + p]; const f32x2 v0 = cmul(pwv, bb[p * 16 + j]), v1 = cmul(pwv, bb[p * 16 + j + 1]);
            *(unsigned*)(BTS + (size_t)(128 * d + 2 * p) * 512 + kk) = cvt_pk_bf16(v0.x, v1.x); *(unsigned*)(BTS + (size_t)(128 * d + 2 * p + 1) * 512 + kk) = cvt_pk_bf16(v0.y, v1.y); }
    }
    __syncthreads();
    for (int o = tid; o < 512 * 256; o += 512) { const int n = o >> 8, kk = (o & 255) * 2, to = n >> 4, i = n & 15, ti = kk >> 4, j = kk & 15;
        float v0, v1;
        if (to > ti) { v0 = Kd[(to - ti) * 256 + i * 16 + j]; v1 = Kd[(to - ti) * 256 + i * 16 + j + 1]; }
        else if (to < ti) { v0 = Kd[8192 + (ti - to) * 256 + i * 16 + j]; v1 = Kd[8192 + (ti - to) * 256 + i * 16 + j + 1]; }
        else { v0 = Kd[i * 16 + j] + Kd[8192 + i * 16 + j] + (i == j ? dsk[g * 16 + i] : 0.f); v1 = Kd[i * 16 + j + 1] + Kd[8192 + i * 16 + j + 1] + (i == j + 1 ? dsk[g * 16 + i] : 0.f); }
        *(unsigned*)(BTY + (size_t)n * 768 + kk) = cvt_pk_bf16(v0, v1); }
    __syncthreads();
}
__device__ __forceinline__ void s5_tables_phase(const Args& a, Frame& F) {
    unsigned char* const wsl = opaque_ptr(a.ws); for (int g = F.vcu; g < 64; g += F.G) s5_tables_group(a, F, g); }

struct SUnit { int g, pm, pn; };
struct PolS5S {
    static constexpr bool PERM = false, GATHER = false, TWOSEG = false;
    static constexpr int NT = 8, KT0 = 8, KS0 = 8192, KS1 = 128, LDB = 1024;
    typedef SUnit Unit;
    const char* XN; const char* BTS; float* S; int G, c;
    __device__ __forceinline__ bool next(int i, Unit& u) const { const int L = i * G + c; u.g = __builtin_amdgcn_readfirstlane(L / 5); u.pm = __builtin_amdgcn_readfirstlane(L % 5); u.pn = 0; return L < 320; }
    __device__ __forceinline__ void ctx(const Unit& u, pg8::UCtx<false>& x, const int (&)[2], const int (&)[2]) const {
        if (u.pm < 4) { x.a0[0] = XN + ((size_t)NCTXR + (size_t)u.pm * 256 * S5_T) * 2048 + u.g * 32; x.a0[1] = x.a0[0] + (size_t)128 * S5_T * 2048; }
        else { x.a0[0] = XN + u.g * 32; x.a0[1] = x.a0[0]; }
        x.a1[0] = x.a0[0]; x.a1[1] = x.a0[1]; x.b = BTS + (size_t)u.g * 256 * LDB;
    }
    __device__ __forceinline__ unsigned lane_a0(int R, int C) const { return (unsigned)(R * (S5_T * 2048) + (C >> 4) * 2048 + (C & 15) * 2); }
    __device__ __forceinline__ unsigned lane_a1(int, int) const { return 0u; }
    __device__ __forceinline__ void epi(const f32x4 (&acc)[2][2][4][2], const Unit& u, int wr, int wc, int fr, int fq) const {
#pragma unroll
        for (int ai = 0; ai < 2; ++ai) { if (u.pm == 4 && ai == 1) continue;
#pragma unroll
            for (int m = 0; m < 4; ++m) { const int r = u.pm * 256 + ai * 128 + wr * 64 + m * 16 + fr;
                float* sp = S + ((size_t)u.g * 1152 + r) * 256 + wc * 32 + 4 * fq;
#pragma unroll
                for (int bj = 0; bj < 2; ++bj)
#pragma unroll
                    for (int n = 0; n < 2; ++n) *(f32x4*)(sp + bj * 128 + n * 16) = acc[ai][bj][m][n]; } }
    }
};
__device__ __forceinline__ void s5_scan_phase(const Args& a, Frame& F) {
    unsigned char* const wsl = opaque_ptr(a.ws);
    const int tid = opaque_tid(); const float* S = (const float*)(wsl + WS_S); bf16_t* XIN = (bf16_t*)(wsl + WS_XIN); const float* LAMT = (const float*)(wsl + WS_LAMT);
    for (int idx = F.vcu * 512 + tid; idx < 64 * 16 * 2 * 64; idx += F.G * 512) {
        const int p = idx & 63, d = (idx >> 6) & 1, b = (idx >> 7) & 15, g = idx >> 11;
        const f32x2 Lm = *(const f32x2*)(LAMT + ((d * 64 + g) * 64 + p) * 2);
        const float* Sg = S + (size_t)g * 1152 * 256 + d * 128 + 2 * p; const int col = d * 128 + 2 * p; bf16_t* Xg = XIN + (size_t)(col >> 4) * 1024 + 16 * g + (col & 15);
        f32x2 x = {0.f, 0.f};
        f32x2 sv[8];
#pragma unroll
        for (int k = 0; k < 8; ++k) { const int c = d == 0 ? k : 7 - k; sv[k] = *(const f32x2*)(Sg + (size_t)(1024 + b * 8 + c) * 256); }
#pragma unroll
        for (int k = 0; k < 8; ++k) x = cmul(Lm, x) + sv[k];
        for (int c0 = 0; c0 < 64; c0 += 8) {
#pragma unroll
            for (int k = 0; k < 8; ++k) { const int c = d == 0 ? c0 + k : 63 - c0 - k; sv[k] = *(const f32x2*)(Sg + (size_t)(b * 64 + c) * 256); }
#pragma unroll
            for (int k = 0; k < 8; ++k) { const int c = d == 0 ? c0 + k : 63 - c0 - k; *(unsigned*)(Xg + (size_t)(b * 64 + c) * 32 * 1024) = cvt_pk_bf16(x.x, x.y); x = cmul(Lm, x) + sv[k]; }
        }
    }
}
struct PolS5Y {
    static constexpr bool PERM = true, GATHER = false, TWOSEG = true;
    static constexpr int NT = 12, KT0 = 8, KS0 = 8192, KS1 = 8192, LDB = 1536;
    typedef SUnit Unit;
    const char* XN; const char* XIN; const char* BTY; bf16_t* Gb; int G, c;
    __device__ __forceinline__ bool next(int i, Unit& u) const { const int L = i * G + c; u.g = __builtin_amdgcn_readfirstlane(L >> 3); u.pm = __builtin_amdgcn_readfirstlane((L >> 1) & 3); u.pn = L & 1; return L < 512; }
    __device__ __forceinline__ void ctx(const Unit& u, pg8::UCtx<false>& x, const int (&)[2], const int (&)[2]) const {
        x.a0[0] = XN + ((size_t)NCTXR + (size_t)u.pm * 256 * S5_T) * 2048 + u.g * 32; x.a0[1] = x.a0[0] + (size_t)128 * S5_T * 2048;
        x.a1[0] = XIN + (size_t)u.pm * 256 * S5_T * 2048 + u.g * 32; x.a1[1] = x.a1[0] + (size_t)128 * S5_T * 2048;
        x.b = BTY + ((size_t)u.g * 512 + u.pn * 256) * LDB;
    }
    __device__ __forceinline__ unsigned lane_a0(int R, int C) const { return (unsigned)(R * (S5_T * 2048) + (C >> 4) * 2048 + (C & 15) * 2); }
    __device__ __forceinline__ void epi(const f32x4 (&acc)[2][2][4][2], const Unit& u, int wr, int wc, int fr, int fq) const {
#pragma unroll
        for (int ai = 0; ai < 2; ++ai)
#pragma unroll
            for (int m = 0; m < 4; ++m) { const int r = u.pm * 256 + ai * 128 + wr * 64 + m * 16 + fr;
#pragma unroll
                for (int bj = 0; bj < 2; ++bj) { const int col = u.pn * 256 + bj * 128 + wc * 32 + 8 * fq, to = col >> 4, i0 = col & 15;
                    bf16_t* gp = Gb + ((size_t)r * S5_T + to) * DM + u.g * 16 + i0;
#pragma unroll
                    for (int n = 0; n < 2; ++n) { f32x4 v;
#pragma unroll
                        for (int j = 0; j < 4; ++j) v[j] = gelu_tanh(acc[ai][bj][m][n][j]);
                        u32x2 w; w.x = cvt_pk_bf16(v[0], v[1]); w.y = cvt_pk_bf16(v[2], v[3]); *(u32x2*)(gp + 4 * n) = w; asm volatile("" ::: "memory"); } } }
    }
};
struct PolGlu : DenseRow0<16, 2048, true> {
    bf16_t* OO; float* SSQO; const float* bias;
    __device__ __forceinline__ void epi(const f32x4 (&acc)[2][2][4][2], const DUnit& u, int wr, int wc, int fr, int fq) const {
        const int c0 = u.pn * 128 + wc * 32 + 8 * fq;
        const f32x4 b10 = *(const f32x4*)(bias + c0), b11 = *(const f32x4*)(bias + c0 + 4), b20 = *(const f32x4*)(bias + 1024 + c0), b21 = *(const f32x4*)(bias + 1024 + c0 + 4);
#pragma unroll
        for (int ai = 0; ai < 2; ++ai)
#pragma unroll
            for (int m = 0; m < 4; ++m) {
                const int row = row0 + u.pm * 256 + ai * 128 + wr * 64 + m * 16 + fr;
                f32x4 o0, o1;
#pragma unroll
                for (int j = 0; j < 4; ++j) { o0[j] = (acc[ai][0][m][0][j] + b10[j]) * sigmoid_f(acc[ai][1][m][0][j] + b20[j]); o1[j] = (acc[ai][0][m][1][j] + b11[j]) * sigmoid_f(acc[ai][1][m][1][j] + b21[j]); }
                float s = sq4(o0) + sq4(o1);
                store8(OO + (size_t)row * DM + c0, o0, o1);
                s += __shfl_xor(s, 16); s += __shfl_xor(s, 32);
                if (fq == 0) SSQO[(size_t)row * 32 + u.pn * 4 + wc] = s;
            }
    }
};
#ifndef REP_ATTN
#define REP_ATTN 1
#endif
#ifndef REP_MISC
#define REP_MISC 1
#endif
#ifndef REP_DENSE
#define REP_DENSE 1
#endif
#ifndef REP_G2A
#define REP_G2A 1
#endif
#ifndef REP_H
#define REP_H 1
#endif
#ifndef REP_G1
#define REP_G1 1
#endif
__device__ __forceinline__ void moe_stage(const Args& args, Frame& F, const XcdBarrier& bar, int layer, int row_lo) {
    const int nrows = NROWS - row_lo, tpb = nrows / F.G;
    {   unsigned char* ws = opaque_ptr(args.ws);
        PolShr p; p.A = (const char*)(ws + WS_XN) + (size_t)row_lo * 2048; p.Bt = (const char*)(ws + WS_WSHR) + (size_t)layer * 768 * 2048; p.nM = nrows / 256; p.nN = 3; p.G = F.G; p.c = (int)blockIdx.x;
        p.row0 = row_lo; p.HSH = (bf16_t*)(ws + WS_HSH); p.LOG = (float*)(ws + WS_LOG);
        for (int rep_ = 0; rep_ < REP_DENSE; ++rep_) pg8::gemm_phase(F.lds, p);
    }
    if (layer == 1 && args.stage == 7) return;
    xcd_barrier(bar);
    route_phase(args, F, layer, row_lo, tpb);
#if REP_MISC == 2
    __syncthreads(); route_phase(args, F, layer, row_lo, tpb);
#endif
    if (layer == 1 && args.stage == 8) return;
    xcd_barrier(bar);
    place_phase(args, F, row_lo, tpb);
#if REP_MISC == 2
    __syncthreads(); place_phase(args, F, row_lo, tpb);
#endif
    if (layer == 1 && args.stage == 9) return;
    xcd_barrier(bar);
    const int* TINFO = (const int*)(opaque_ptr(args.ws) + WS_TINFO);
    const int ts0 = __builtin_amdgcn_readfirstlane(TINFO[0]), ts1 = __builtin_amdgcn_readfirstlane(TINFO[64]), ts2 = __builtin_amdgcn_readfirstlane(TINFO[128]), ts3 = __builtin_amdgcn_readfirstlane(TINFO[192]);
#define MOE_G1(TA, TB, HBUF) for (int rep_ = 0; rep_ < REP_G1; ++rep_) do { unsigned char* ws = opaque_ptr(args.ws); PolMoe1 p; p.XN = (const char*)(ws + WS_XN); p.W1 = (const char*)(ws + WS_W1); p.H = (bf16_t*)(ws + (HBUF)); p.TINFO = (const int*)(ws + WS_TINFO); p.LDST = (const int*)(ws + WS_LDST); p.T0 = (TA); p.T1 = (TB); p.G = F.G; p.c = (int)blockIdx.x; \
        pg8::gemm_phase(F.lds, p); } while (0)
#define MOE_G2(RMW, TA, TB, HBUF) do { unsigned char* ws = opaque_ptr(args.ws); PolMoe2<RMW> p; p.H = (const char*)(ws + (HBUF)); p.W2 = (const char*)(ws + WS_W2); p.Y = (unsigned char*)(ws + WS_Y); p.TINFO = (const int*)(ws + WS_TINFO); p.LDST = (const int*)(ws + WS_LDST); p.LW = (const float*)(ws + WS_LW); p.T0 = (TA); p.T1 = (TB); p.G = F.G; p.c = (int)blockIdx.x; \
        pg8::gemm_phase(F.lds, p); } while (0)
    MOE_G1(ts0, ts1, WS_H0);
    if (layer == 1 && args.stage == 10) return;
    xcd_barrier(bar);
#define MOE_SHD() do { unsigned char* ws = opaque_ptr(args.ws); PolShd p; p.A = (const char*)(ws + WS_HSH) + (size_t)row_lo * 512; p.Bt = (const char*)(ws + WS_WSHD) + (size_t)layer * 1024 * 512; p.nM = nrows / 256; p.nN = 4; p.G = F.G; p.c = (int)blockIdx.x; \
        p.row0 = row_lo; p.Y = (unsigned char*)(ws + WS_Y); pg8::gemm_phase(F.lds, p); } while (0)
#if REP_G2A == 2
    MOE_G2(false, ts0, ts1, WS_H0); MOE_SHD();
#endif
    if (blockIdx.x & 1) { MOE_G1(ts1, ts2, WS_H1); MOE_G2(false, ts0, ts1, WS_H0); MOE_SHD(); }
    else { MOE_G2(false, ts0, ts1, WS_H0); MOE_SHD(); MOE_G1(ts1, ts2, WS_H1); }
    if (layer == 1 && args.stage == 11) return;
    xcd_barrier(bar);
    if (blockIdx.x & 1) { MOE_G1(ts2, ts3, WS_H0); MOE_G2(true, ts1, ts2, WS_H1); }
    else { MOE_G2(true, ts1, ts2, WS_H1); MOE_G1(ts2, ts3, WS_H0); }
    if (layer == 1 && args.stage == 12) return;
    xcd_barrier(bar);
    MOE_G2(true, ts2, ts3, WS_H0);
    if (layer == 1 && args.stage == 13) return;
    xcd_barrier(bar);
    if (layer == 0) { if (F.vcu < 64) s5_tables_phase(args, F); else convert_experts(args, F, 1, 64); }
    combine_phase(args, F, layer, row_lo);
#undef MOE_SHD
#undef MOE_G1
#undef MOE_G2
}

__global__ void __launch_bounds__(NWAVES * 64, 2) trunk_fwd(Args args) {
    extern __shared__ __attribute__((aligned(16))) unsigned char lds_raw[];
    Frame F;
    F.lds = (LAS unsigned char*)lds_raw;
    F.G = gridDim.x; { const int bx = blockIdx.x; F.vcu = (F.G % 8 == 0) ? (bx % 8) * (F.G / 8) + bx / 8 : bx; }
    F.ws = args.ws;
    volatile LAS unsigned* MISC = (volatile LAS unsigned*)(F.lds + LDSCTL_OFF);
    for (int u = threadIdx.x; u < (LDS_BYTES - LDSCTL_OFF) / 4; u += NWAVES * 64) ((LAS unsigned*)(F.lds + LDSCTL_OFF))[u] = 0u;
    __syncthreads();
    if (threadIdx.x < 31) ((LAS unsigned long long*)(F.lds + PTAB_OFF))[threadIdx.x] = (unsigned long long)args.in[threadIdx.x];
    __syncthreads();
    XcdBarrier bar = xcd_barrier_post((unsigned*)(args.ws + WS_CTL) + CW_BAR, MISC + 8);
#define GRID_BAR() xcd_barrier(bar)

    mod_phase(args, F);
    __syncthreads();
    convert_small(args, F);
    rope_phase(args, F);
    convert_experts(args, F, 0, 0);
#if REP_MISC == 2
    __syncthreads();
    mod_phase(args, F);
    __syncthreads();
    convert_small(args, F);
    rope_phase(args, F);
    convert_experts(args, F, 0, 0);
#endif
    GRID_BAR();
    h_phase(args, F, 0, 0);
#if REP_H == 2
    h_phase(args, F, 0, 0);
#endif
    GRID_BAR();
    {   unsigned char* ws = opaque_ptr(args.ws);
        PolDqkv p; p.A = (const char*)(ws + WS_XN); p.Bt = (const char*)(ws + WS_WDQKV); p.nM = NROWS / 256; p.nN = 3; p.G = F.G; p.c = (int)blockIdx.x;
        p.A1 = (bf16_t*)(ws + WS_A1); p.SSQ1 = (float*)(ws + WS_SSQ1); p.KPE = (bf16_t*)(ws + WS_KPE); p.ROPE = (const float*)(ws + WS_ROPE);
        for (int rep_ = 0; rep_ < REP_DENSE; ++rep_) pg8::gemm_phase(F.lds, p);
    }
    GRID_BAR();
    {   unsigned char* ws = opaque_ptr(args.ws);
        PolQup p; p.A = (const char*)(ws + WS_A1); p.Bt = (const char*)(ws + WS_WUQ); p.nM = NROWS / 256; p.nN = NQ / 256; p.G = F.G; p.c = (int)blockIdx.x;
        p.Q = (bf16_t*)(ws + WS_Q); p.SSQ1 = (const float*)(ws + WS_SSQ1);
        for (int rep_ = 0; rep_ < REP_DENSE; ++rep_) pg8::gemm_phase(F.lds, p);
    }
    {   unsigned char* ws = opaque_ptr(args.ws);
        PolKVup p; p.A = (const char*)(ws + WS_A1) + QLORA * 2; p.Bt = (const char*)(ws + WS_WUKV); p.nM = NROWS / 256; p.nN = NKV / 256; p.G = F.G; p.c = (int)blockIdx.x;
        p.KV = (bf16_t*)(ws + WS_KV); p.SSQ1 = (const float*)(ws + WS_SSQ1);
        for (int rep_ = 0; rep_ < REP_DENSE; ++rep_) pg8::gemm_phase(F.lds, p);
    }
    GRID_BAR();
    {   unsigned char* ws = opaque_ptr(args.ws);
        const bf16_t* Qg = (const bf16_t*)(ws + WS_Q); const bf16_t* KVb = (const bf16_t*)(ws + WS_KV); const bf16_t* KPE = (const bf16_t*)(ws + WS_KPE); bf16_t* Og = (bf16_t*)(ws + WS_O); const float* RP = (const float*)(ws + WS_ROPE);
        for (int rep_ = 0; rep_ < REP_ATTN; ++rep_)
        for (int u = F.vcu; u < 1024 + 128; u += F.G) {
            if (u < 1024) { const int bh = u >> 3, qb = u & 7, b = bh >> 3, h = bh & 7;
                attn::attn_unit(Qg, KVb, KPE, Og, RP, NCTXR + b * SEQL + qb * 256, qb * 256, h, b * NCTX, NCTXR + b * SEQL, 36, (char*)lds_raw); }
            else { const int bh = u - 1024, b = bh >> 3, h = bh & 7;
                attn::attn_unit(Qg, KVb, KPE, Og, RP, b * NCTX, -1, h, b * NCTX, 0, 4, (char*)lds_raw); }
        }
    }
    GRID_BAR();
    {   unsigned char* ws = opaque_ptr(args.ws);
        PolWo p; p.A = (const char*)(ws + WS_O); p.Bt = (const char*)(ws + WS_WO); p.nM = NROWS / 256; p.nN = 4; p.G = F.G; p.c = (int)blockIdx.x;
        p.OO = (bf16_t*)(ws + WS_OO); p.SSQO = (float*)(ws + WS_SSQO);
        for (int rep_ = 0; rep_ < REP_DENSE; ++rep_) pg8::gemm_phase(F.lds, p);
    }
    GRID_BAR();
    postmix_phase(args, F, 0, 0, 16);
    GRID_BAR();
    moe_stage(args, F, bar, 0, 0);
    if (args.stage == 1) return;
    GRID_BAR();
    {   unsigned char* ws = opaque_ptr(args.ws);
        PolS5S p; p.XN = (const char*)(ws + WS_XN); p.BTS = (const char*)(ws + WS_BTS); p.S = (float*)(ws + WS_S); p.G = F.G; p.c = (int)blockIdx.x;
        for (int rep_ = 0; rep_ < REP_DENSE; ++rep_) pg8::gemm_phase(F.lds, p);
    }
    if (args.stage == 2) return;
    GRID_BAR();
    s5_scan_phase(args, F);
#if REP_MISC == 2
    s5_scan_phase(args, F);
#endif
    if (args.stage == 3) return;
    GRID_BAR();
    {   unsigned char* ws = opaque_ptr(args.ws);
        PolS5Y p; p.XN = (const char*)(ws + WS_XN); p.XIN = (const char*)(ws + WS_XIN); p.BTY = (const char*)(ws + WS_BTY); p.Gb = (bf16_t*)(ws + WS_G); p.G = F.G; p.c = (int)blockIdx.x;
        for (int rep_ = 0; rep_ < REP_DENSE; ++rep_) pg8::gemm_phase(F.lds, p);
    }
    if (args.stage == 4) return;
    GRID_BAR();
    {   unsigned char* ws = opaque_ptr(args.ws);
        PolGlu p; p.A = (const char*)(ws + WS_G); p.Bt = (const char*)(ws + WS_WGLU); p.nM = NLATR / 256; p.nN = 8; p.G = F.G; p.c = (int)blockIdx.x;
        p.row0 = NCTXR; p.OO = (bf16_t*)(ws + WS_OO); p.SSQO = (float*)(ws + WS_SSQO); p.bias = inp(F, 22);
        for (int rep_ = 0; rep_ < REP_DENSE; ++rep_) pg8::gemm_phase(F.lds, p);
    }
    if (args.stage == 5) return;
    GRID_BAR();
    postmix_phase(args, F, 1, NCTXR, 32);
    if (args.stage == 6) return;
    GRID_BAR();
    moe_stage(args, F, bar, 1, NCTXR);
}

#ifndef DBG_STAGE
#define DBG_STAGE 0
#endif
extern "C" void kernel_launch(void* const* d_in, const int* in_sizes, int n_in, void* d_out, int out_size, void* d_ws, size_t ws_size, hipStream_t stream) {
    static int grid = 0;
    if (grid == 0) {
        if (n_in != 31 || out_size != NLATR * DM || ws_size < WS_END) { fprintf(stderr, "kernel_launch: unexpected shapes (n_in %d out %d ws %zu)\n", n_in, out_size, ws_size); grid = -1; return; }
        int dev = 0, cus = 0;
        if (hipGetDevice(&dev) != hipSuccess || hipDeviceGetAttribute(&cus, hipDeviceAttributeMultiprocessorCount, dev) != hipSuccess) { grid = -1; return; }
        if (hipFuncSetAttribute((const void*)trunk_fwd, hipFuncAttributeMaxDynamicSharedMemorySize, LDS_BYTES) != hipSuccess) { fprintf(stderr, "kernel_launch: hipFuncSetAttribute failed\n"); grid = -1; return; }
        (void)hipGetLastError();
        grid = cus;
    }
    if (grid < 0) return;
    (void)hipMemsetAsync((char*)d_ws + WS_CTL, 0, CTL_BYTES, stream);
    Args a{};
    for (int i = 0; i < 31; ++i) a.in[i] = (const float*)d_in[i];
    a.out = (float*)d_out; a.ws = (unsigned char*)d_ws; a.stage = DBG_STAGE; a.pad = 0;
    hipLaunchKernelGGL(trunk_fwd, dim3(grid), dim3(NWAVES * 64), LDS_BYTES, stream, a);
}
```

```cpp
#include <hip/hip_runtime.h>
#include <cstdio>
#include <cstdint>

#define GAS __attribute__((address_space(1)))
#define LAS __attribute__((address_space(3)))
typedef unsigned short bf16_t;
typedef short bf16x8 __attribute__((ext_vector_type(8)));
typedef short s16x4 __attribute__((ext_vector_type(4)));
typedef float f32x2 __attribute__((ext_vector_type(2)));
typedef float f32x4 __attribute__((ext_vector_type(4)));
typedef float f32x16 __attribute__((ext_vector_type(16)));
typedef unsigned u32x2 __attribute__((ext_vector_type(2)));
typedef unsigned u32x4 __attribute__((ext_vector_type(4)));

constexpr int DM = 1024, NBATCH = 16, SEQL = 2048, NCTX = 256;
constexpr int NCTXR = NBATCH * NCTX;
constexpr int NLATR = NBATCH * SEQL;
constexpr int NROWS = NCTXR + NLATR;
constexpr int NHEAD = 8, QLORA = 384, KVLORA = 256, NOPE = 128, ROPED = 64, VDIM = 128;
constexpr int NDQKV = 768;
constexpr int NQ = NHEAD * (NOPE + ROPED);
constexpr int NKV = NHEAD * (NOPE + VDIM);
constexpr int NEXP = 64, TOPK = 8, DEXP = 256;
constexpr float NORM_EPS = 1e-6f;
constexpr int NMOD = 6, MODW = NMOD * DM;

constexpr size_t MiB = 1u << 20;
constexpr size_t WS_CTL = 0, CTL_BYTES = 1 * MiB;
constexpr size_t WS_WDQKV = 1 * MiB;
constexpr size_t WS_WUQ   = WS_WDQKV + 1536 * 1024;
constexpr size_t WS_WUKV  = WS_WUQ + 1280 * 1024;
constexpr size_t WS_WO    = WS_WUKV + 1 * MiB;
constexpr size_t WS_WGLU  = WS_WO + 2 * MiB;
constexpr size_t WS_WSHR  = WS_WGLU + 4 * MiB;
constexpr size_t WS_WSHD  = WS_WSHR + 3 * MiB;
constexpr size_t WS_MOD   = 15 * MiB;
constexpr size_t WS_ROPE  = 16 * MiB;
constexpr size_t WS_W1    = 17 * MiB;
constexpr size_t WS_W2    = 81 * MiB;
constexpr size_t WS_XCTX  = 113 * MiB;
constexpr size_t WS_XN    = 129 * MiB;
constexpr size_t WS_ST    = 201 * MiB;
static_assert(WS_WSHD + 1 * MiB <= WS_MOD, "small weights fit");
constexpr size_t WS_KV   = WS_ST;
constexpr size_t WS_Q    = WS_ST + 144 * MiB;
constexpr size_t WS_OO   = WS_Q;
constexpr size_t WS_A1   = WS_ST + 252 * MiB;
constexpr size_t WS_O    = WS_A1;
constexpr size_t WS_KPE  = WS_ST + 324 * MiB;
constexpr size_t WS_SSQ1 = WS_ST + 329 * MiB;
constexpr size_t WS_SSQO = WS_ST + 332 * MiB;
constexpr size_t WS_END  = WS_ST + 402 * MiB;

constexpr int CW_BAR = 4096;

__device__ __forceinline__ unsigned cvt_pk_bf16(float lo, float hi) { unsigned r; asm volatile("v_cvt_pk_bf16_f32 %0, %1, %2" : "=v"(r) : "v"(lo), "v"(hi)); return r; }
__device__ __forceinline__ float bf_lo(unsigned w) { return __uint_as_float(w << 16); }
__device__ __forceinline__ float bf_hi(unsigned w) { return __uint_as_float(w & 0xffff0000u); }
__device__ __forceinline__ float wave_sum(float v) {
#pragma unroll
    for (int o = 1; o < 64; o <<= 1) v += __shfl_xor(v, o);
    return v;
}
__device__ __forceinline__ float silu_f(float v) { return v * __builtin_amdgcn_rcpf(1.f + __builtin_amdgcn_exp2f(-1.4426950408889634f * v)); }
__device__ __forceinline__ float sigmoid_f(float v) { return __builtin_amdgcn_rcpf(1.f + __builtin_amdgcn_exp2f(-1.4426950408889634f * v)); }
__device__ __forceinline__ int mod_index(int row) { return row < NCTXR ? 16 : (row - NCTXR) / SEQL; }
__device__ __forceinline__ int opaque_tid() { int t = threadIdx.x; asm volatile("" : "+v"(t)); return t; }
__device__ __forceinline__ float gelu_tanh(float v) {
    const float z = 0.7978845608028654f * (v + 0.044715f * v * v * v);
    return v * __builtin_amdgcn_rcpf(1.f + __builtin_amdgcn_exp2f(-2.8853900817779268f * z));
}
__device__ __forceinline__ unsigned char* opaque_ptr(unsigned char* p) {
    unsigned lo = __builtin_amdgcn_readfirstlane((unsigned)(unsigned long long)p), hi = __builtin_amdgcn_readfirstlane((unsigned)((unsigned long long)p >> 32));
    asm volatile("" : "+s"(lo), "+s"(hi)); return (unsigned char*)(((unsigned long long)hi << 32) | lo); }
constexpr float Y_SCALE = 64.f, Y_INV = 1.f / 64.f, Y_MAX = 448.f;
__device__ __forceinline__ unsigned fp8_pack4(const f32x4& v) {
    const float a = fminf(fmaxf(v[0] * Y_SCALE, -Y_MAX), Y_MAX), b = fminf(fmaxf(v[1] * Y_SCALE, -Y_MAX), Y_MAX), c = fminf(fmaxf(v[2] * Y_SCALE, -Y_MAX), Y_MAX), d = fminf(fmaxf(v[3] * Y_SCALE, -Y_MAX), Y_MAX);
    int p = __builtin_amdgcn_cvt_pk_fp8_f32(a, b, 0, false); p = __builtin_amdgcn_cvt_pk_fp8_f32(c, d, p, true); return (unsigned)p; }
__device__ __forceinline__ f32x4 fp8_unpack4(unsigned w) {
    const f32x2 lo = __builtin_amdgcn_cvt_pk_f32_fp8((int)w, false), hi = __builtin_amdgcn_cvt_pk_f32_fp8((int)w, true);
    return (f32x4){lo.x * Y_INV, lo.y * Y_INV, hi.x * Y_INV, hi.y * Y_INV}; }
#define XB_TMO      128
#define XB_XCNT(j)  (256  + 64 * (j))
#define XB_XSUB(j)  (1280 + 64 * (j))
#define XB_XGEN(j)  (2304 + 64 * (j))
#define XB_TOP      3328
#define XB_TOPGEN   3392
#define XCD_BAR_WORDS 3456
#define XB_SPIN_CAP (1u << 18)
__device__ __forceinline__ unsigned xb_ld(unsigned* p)              { return __hip_atomic_load(p, __ATOMIC_RELAXED, __HIP_MEMORY_SCOPE_AGENT); }
__device__ __forceinline__ unsigned xb_add(unsigned* p, unsigned v) { return __hip_atomic_fetch_add(p, v, __ATOMIC_RELAXED, __HIP_MEMORY_SCOPE_AGENT); }
__device__ __forceinline__ unsigned xb_xcc_id() { return (unsigned)__builtin_amdgcn_s_getreg((3 << 11) | 20) & 0xFu; }
#define XB_SPIN(cond, bar) do { unsigned _sp = 0; while (cond) { __builtin_amdgcn_s_sleep(1); \
    if ((++_sp & 255u) == 0u) { if (xb_ld(&(bar)[XB_TMO])) break; if (_sp > XB_SPIN_CAP) { atomicAdd(&(bar)[XB_TMO], 1u); break; } } } } while (0)
struct XcdBarrier { unsigned* bar; unsigned x; volatile LAS unsigned* st; };
__device__ __forceinline__ XcdBarrier xcd_barrier_post(unsigned* bar, volatile LAS unsigned* st) {
    XcdBarrier b; b.bar = bar; b.x = xb_xcc_id(); b.st = st;
    if (threadIdx.x == 0) (void)xb_add(&bar[XB_XCNT(b.x)], 1u);
    return b;
}
__device__ __forceinline__ void xcd_barrier_complete(unsigned* bar, unsigned x, unsigned& nloc, unsigned& nx) {
    const unsigned G = gridDim.x * gridDim.y * gridDim.z;
    unsigned sum, cnt, mine, sp = 0u;
    for (;;) {
        sum = 0u; cnt = 0u; mine = 0u;
#pragma unroll
        for (unsigned j = 0; j < 16; ++j) { const unsigned c = xb_ld(&bar[XB_XCNT(j)]); sum += c; cnt += (c > 0u) ? 1u : 0u; mine = (j == x) ? c : mine; }
        if (sum == G) break;
        __builtin_amdgcn_s_sleep(1);
        if ((++sp & 255u) == 0u) { if (xb_ld(&bar[XB_TMO])) break; if (sp > XB_SPIN_CAP) { atomicAdd(&bar[XB_TMO], 1u); break; } }
    }
    nloc = mine > 0u ? mine : 1u; nx = cnt > 0u ? cnt : 1u;
}
__device__ __forceinline__ void xcd_barrier(const XcdBarrier& b) {
    asm volatile("s_waitcnt vmcnt(0)" ::: "memory");
    __syncthreads();
    if (threadIdx.x == 0) {
        unsigned* bar = b.bar;
        __builtin_amdgcn_s_waitcnt(0);
        unsigned nloc = b.st[0], nx = b.st[1];
        if (nloc == 0u) { xcd_barrier_complete(bar, b.x, nloc, nx); b.st[0] = nloc; b.st[1] = nx; }
        const unsigned old = xb_add(&bar[XB_XSUB(b.x)], 1u);
        const unsigned gen = old / nloc;
        if (old + 1u == (gen + 1u) * nloc) {
            __builtin_amdgcn_fence(__ATOMIC_RELEASE, "agent");
            asm volatile("s_waitcnt vmcnt(0)" ::: "memory");
            const unsigned og = xb_add(&bar[XB_TOP], 1u);
            const unsigned tg = og / nx;
            if (og + 1u == (tg + 1u) * nx) xb_add(&bar[XB_TOPGEN], 1u);
            else XB_SPIN(xb_ld(&bar[XB_TOPGEN]) == tg, bar);
            __builtin_amdgcn_fence(__ATOMIC_ACQUIRE, "agent");
            xb_add(&bar[XB_XGEN(b.x)], 1u);
            asm volatile("s_waitcnt vmcnt(0)" ::: "memory");
        } else {
            XB_SPIN(xb_ld(&bar[XB_XGEN(b.x)]) == gen, bar);
            __builtin_amdgcn_fence(__ATOMIC_ACQUIRE, "agent");
            asm volatile("s_waitcnt vmcnt(0)" ::: "memory");
        }
    }
    __syncthreads();
}

namespace pg8 {
constexpr int BM = 256, BK = 64, HALF = 128, HTB = HALF * BK * 2, STAGE_BYTES = 8 * HTB, NXCD = 8, WGM = 8;
__host__ __device__ __forceinline__ int lds_byte(int r, int c) { const int st = (r >> 4) * 2 + (c >> 5), rr = r & 15, cc = c & 31, ob = rr * 64 + cc * 2; return st * 1024 + (ob ^ (((ob >> 9) & 1) << 5)); }
__host__ __device__ __forceinline__ void stage_rc(int b, int& R, int& C) { const int st = b / 1024, sb = b % 1024, swz = sb ^ (((sb >> 9) & 1) << 5); R = (st >> 1) * 16 + swz / 64; C = (st & 1) * 32 + (swz % 64) / 2; }
__host__ __device__ __forceinline__ int perm32(int rho) { const int n = rho >> 4, i = rho & 15; return 8 * (i >> 2) + 4 * n + (i & 3); }

__device__ __forceinline__ bool dense_order(int i, int G, int c, int nM, int nN, int& pm, int& pn) {
    const int nwg = nM * nN; const long L = (long)i * G + c; if (L >= nwg) return false;
    int wgid = (int)L; { const int q = nwg / NXCD, r = nwg % NXCD, xcd = wgid % NXCD, off = wgid / NXCD; wgid = (xcd < r ? xcd * (q + 1) : r * (q + 1) + (xcd - r) * q) + off; }
    const int nig = WGM * nN, gid = wgid / nig, fm = gid * WGM, gsz = (nM - fm) < WGM ? (nM - fm) : WGM;
    pm = __builtin_amdgcn_readfirstlane(fm + ((wgid % nig) % gsz)); pn = __builtin_amdgcn_readfirstlane((wgid % nig) / gsz); return true;
}

template <bool GATHER> struct UCtx { const char* a0[2]; const char* a1[2]; const char* b; unsigned vg[2][2]; };
template <> struct UCtx<false> { const char* a0[2]; const char* a1[2]; const char* b; };

template <class P>
__device__ __forceinline__ void gemm_phase(LAS unsigned char* lds, const P& pol) {
    typedef typename P::Unit Unit;
    const int tid = opaque_tid(), wid = __builtin_amdgcn_readfirstlane(tid >> 6), lane = tid & 63, wr = wid >> 2, wc = wid & 3, fr = lane & 15, fq = lane >> 4;
    constexpr int nt = P::NT;
    int Rr[2], Cc[2]; unsigned voffB[2], va0[2];
#pragma unroll
    for (int i = 0; i < 2; ++i) { stage_rc(tid * 16 + i * 8192, Rr[i], Cc[i]); const int Rb = P::PERM ? ((Rr[i] & ~31) + perm32(Rr[i] & 31)) : Rr[i];
        voffB[i] = (unsigned)(Rb * P::LDB + Cc[i] * 2); va0[i] = pol.lane_a0(Rr[i], Cc[i]); }
    constexpr size_t hstepB = (size_t)HALF * P::LDB;
    const unsigned ldsw = (unsigned)wid * 1024u;
    const int aoff = lds_byte(wr * 64 + fr, fq * 8), boff = lds_byte(wc * 32 + fr, fq * 8);
#define PG8_SA(b, h) (((b) * 2 + (h)) * HTB)
#define PG8_SB(b, h) ((4 + (b) * 2 + (h)) * HTB)
#define PG8_GL(bufoff, p0, p1) do { __builtin_amdgcn_global_load_lds((const unsigned*)(p0), (LAS unsigned*)(lds + (bufoff) + ldsw), 16, 0, 0); \
        __builtin_amdgcn_global_load_lds((const unsigned*)(p1), (LAS unsigned*)(lds + (bufoff) + ldsw + 8192), 16, 0, 0); } while (0)
#define PG8_STB(bufoff, U, h, kt) do { const char* _b = (U).b + (size_t)(h) * hstepB + (size_t)(kt) * 128; asm volatile("" : "+s"(_b)); PG8_GL(bufoff, _b + voffB[0], _b + voffB[1]); } while (0)
#define PG8_STA(bufoff, U, h, kt) do { const char* _a = (U).a0[h] + (size_t)(kt) * P::KS0; if constexpr (P::TWOSEG) { if ((kt) >= P::KT0) _a = (U).a1[h] + (size_t)((kt) - P::KT0) * P::KS1; } \
        unsigned _o0, _o1; if constexpr (P::GATHER) { _o0 = (U).vg[h][0]; _o1 = (U).vg[h][1]; } else { _o0 = va0[0]; _o1 = va0[1]; } \
        asm volatile("" : "+s"(_a)); PG8_GL(bufoff, _a + _o0, _a + _o1); } while (0)
#define PG8_LDA(dst, b, h) do { _Pragma("unroll") for (int m = 0; m < 4; ++m) _Pragma("unroll") for (int k = 0; k < 2; ++k) dst[m][k] = *(const LAS bf16x8*)(lds + PG8_SA(b, h) + aoff + m * 2048 + k * 1024); } while (0)
#define PG8_LDB(dst, b, h) do { _Pragma("unroll") for (int n = 0; n < 2; ++n) _Pragma("unroll") for (int k = 0; k < 2; ++k) dst[n][k] = *(const LAS bf16x8*)(lds + PG8_SB(b, h) + boff + n * 2048 + k * 1024); } while (0)
#define PG8_MMA(ai, bj, At, Bt) do { __builtin_amdgcn_s_setprio(1); _Pragma("unroll") for (int m = 0; m < 4; ++m) _Pragma("unroll") for (int n = 0; n < 2; ++n) _Pragma("unroll") for (int k = 0; k < 2; ++k) \
        acc[ai][bj][m][n] = __builtin_amdgcn_mfma_f32_16x16x32_bf16(Bt[n][k], At[m][k], acc[ai][bj][m][n], 0, 0, 0); __builtin_amdgcn_s_setprio(0); } while (0)
#define PG8_WAIT_V(n) asm volatile("s_waitcnt vmcnt(" #n ")" ::: "memory")
#define PG8_WAIT_L(n) asm volatile("s_waitcnt lgkmcnt(" #n ")" ::: "memory")
#define PG8_BAR __builtin_amdgcn_s_barrier()
#define PG8_SCHED __builtin_amdgcn_sched_barrier(0)
    Unit cur, nxt; int ui = 0;
    if (!pol.next(0, cur)) return;
    UCtx<P::GATHER> cc, nc;
    pol.ctx(cur, cc, Rr, Cc);
    f32x4 acc[2][2][4][2];
#pragma unroll
    for (int a = 0; a < 2; ++a)
#pragma unroll
        for (int b = 0; b < 2; ++b)
#pragma unroll
            for (int m = 0; m < 4; ++m)
#pragma unroll
                for (int n = 0; n < 2; ++n) acc[a][b][m][n] = (f32x4){0.f, 0.f, 0.f, 0.f};
    bf16x8 At[4][2], B0[2][2], B1[2][2];
    PG8_STB(PG8_SB(0, 0), cc, 0, 0); PG8_STB(PG8_SB(0, 1), cc, 1, 0); PG8_STA(PG8_SA(0, 0), cc, 0, 0); PG8_STA(PG8_SA(0, 1), cc, 1, 0);
    if (wr == 1) PG8_BAR;
    PG8_WAIT_V(2); PG8_BAR;
    PG8_STB(PG8_SB(1, 0), cc, 0, 1); PG8_STA(PG8_SA(1, 0), cc, 0, 1); PG8_STB(PG8_SB(1, 1), cc, 1, 1);
    PG8_WAIT_V(6); PG8_BAR;
    for (;;) {
        const bool has_next = pol.next(ui + 1, nxt);
        if (has_next) pol.ctx(nxt, nc, Rr, Cc); else nc = cc;
        for (int t = 0; t < nt; t += 2) {
            const bool last = (t == nt - 2);
            const int k2 = last ? 0 : t + 2, k3 = k2 + 1;
            PG8_LDB(B0, 0, 0); PG8_LDB(B1, 0, 1); PG8_SCHED; PG8_LDA(At, 0, 0); PG8_STA(PG8_SA(1, 1), cc, 1, t + 1);
            PG8_WAIT_V(8); PG8_WAIT_L(0); PG8_BAR; PG8_MMA(0, 0, At, B0); PG8_MMA(0, 1, At, B1); PG8_BAR; PG8_SCHED;
            PG8_LDA(At, 0, 1);
            if (last) { PG8_STB(PG8_SB(0, 0), nc, 0, 0); PG8_STB(PG8_SB(0, 1), nc, 1, 0); PG8_STA(PG8_SA(0, 0), nc, 0, 0); }
            else      { PG8_STB(PG8_SB(0, 0), cc, 0, k2); PG8_STB(PG8_SB(0, 1), cc, 1, k2); PG8_STA(PG8_SA(0, 0), cc, 0, k2); }
            PG8_WAIT_V(8); PG8_WAIT_L(0); PG8_BAR; PG8_MMA(1, 0, At, B0); PG8_MMA(1, 1, At, B1); PG8_BAR; PG8_SCHED;
            PG8_LDB(B0, 1, 0); PG8_LDB(B1, 1, 1); PG8_SCHED; PG8_LDA(At, 1, 0);
            if (last) { PG8_STA(PG8_SA(0, 1), nc, 1, 0); } else { PG8_STA(PG8_SA(0, 1), cc, 1, k2); }
            PG8_WAIT_V(8); PG8_WAIT_L(0); PG8_BAR; PG8_MMA(0, 0, At, B0); PG8_MMA(0, 1, At, B1); PG8_BAR; PG8_SCHED;
            PG8_LDA(At, 1, 1);
            if (last) { PG8_STB(PG8_SB(1, 0), nc, 0, 1); PG8_STB(PG8_SB(1, 1), nc, 1, 1); PG8_STA(PG8_SA(1, 0), nc, 0, 1); }
            else      { PG8_STB(PG8_SB(1, 0), cc, 0, k3); PG8_STB(PG8_SB(1, 1), cc, 1, k3); PG8_STA(PG8_SA(1, 0), cc, 0, k3); }
            PG8_WAIT_V(8); PG8_WAIT_L(0); PG8_BAR; PG8_MMA(1, 0, At, B0); PG8_MMA(1, 1, At, B1); PG8_BAR; PG8_SCHED;
        }
        if (wr == 0) PG8_BAR;
        pol.epi(acc, cur, wr, wc, fr, fq);
        if (!has_next) break;
#pragma unroll
        for (int a = 0; a < 2; ++a)
#pragma unroll
            for (int b = 0; b < 2; ++b)
#pragma unroll
                for (int m = 0; m < 4; ++m)
#pragma unroll
                    for (int n = 0; n < 2; ++n) acc[a][b][m][n] = (f32x4){0.f, 0.f, 0.f, 0.f};
        cur = nxt; cc = nc; ++ui;
        if (wr == 1) PG8_BAR;
    }
    PG8_WAIT_V(0);
    PG8_BAR;
#undef PG8_SA
#undef PG8_SB
#undef PG8_GL
#undef PG8_STB
#undef PG8_STA
#undef PG8_LDA
#undef PG8_LDB
#undef PG8_MMA
#undef PG8_WAIT_V
#undef PG8_WAIT_L
#undef PG8_BAR
#undef PG8_SCHED
}
}
struct DUnit { int pm, pn; };

template <int NT_, int LDA_, bool PERM_> struct DenseBase {
    static constexpr bool PERM = PERM_, GATHER = false, TWOSEG = false;
    static constexpr int NT = NT_, KT0 = NT_, KS0 = 128, KS1 = 128, LDB = NT_ * 128;
    typedef DUnit Unit;
    const char* A; const char* Bt; int nM, nN, G, c;
    __device__ __forceinline__ bool next(int i, Unit& u) const { return pg8::dense_order(i, G, c, nM, nN, u.pm, u.pn); }
    __device__ __forceinline__ void ctx(const Unit& u, pg8::UCtx<false>& x, const int (&)[2], const int (&)[2]) const {
        x.a0[0] = A + (size_t)u.pm * 256 * LDA_; x.a0[1] = x.a0[0] + (size_t)128 * LDA_; x.a1[0] = x.a0[0]; x.a1[1] = x.a0[1];
        x.b = Bt + (size_t)u.pn * 256 * LDB; }
    __device__ __forceinline__ unsigned lane_a0(int R, int C) const { return (unsigned)(R * LDA_ + C * 2); }
    __device__ __forceinline__ unsigned lane_a1(int, int) const { return 0u; }
};

__device__ __forceinline__ void store8(bf16_t* p, const f32x4& v0, const f32x4& v1) {
    u32x4 w; w.x = cvt_pk_bf16(v0[0], v0[1]); w.y = cvt_pk_bf16(v0[2], v0[3]); w.z = cvt_pk_bf16(v1[0], v1[1]); w.w = cvt_pk_bf16(v1[2], v1[3]); *(u32x4*)p = w; }
__device__ __forceinline__ float sq4(const f32x4& v) { return (v[0] * v[0] + v[1] * v[1]) + (v[2] * v[2] + v[3] * v[3]); }
__device__ __forceinline__ void rope8(f32x4& v0, f32x4& v1, const float* cs) {
    const f32x4 a = *(const f32x4*)cs, b = *(const f32x4*)(cs + 4);
    float x0, x1;
    x0 = v0[0]; x1 = v0[1]; v0[0] = x0 * a[0] - x1 * a[1]; v0[1] = x0 * a[1] + x1 * a[0];
    x0 = v0[2]; x1 = v0[3]; v0[2] = x0 * a[2] - x1 * a[3]; v0[3] = x0 * a[3] + x1 * a[2];
    x0 = v1[0]; x1 = v1[1]; v1[0] = x0 * b[0] - x1 * b[1]; v1[1] = x0 * b[1] + x1 * b[0];
    x0 = v1[2]; x1 = v1[3]; v1[2] = x0 * b[2] - x1 * b[3]; v1[3] = x0 * b[3] + x1 * b[2];
}

struct PolDqkv : DenseBase<16, 2048, true> {
    bf16_t* A1; float* SSQ1; bf16_t* KPE; const float* ROPE;
    __device__ __forceinline__ void epi(const f32x4 (&acc)[2][2][4][2], const DUnit& u, int wr, int wc, int fr, int fq) const {
#pragma unroll
        for (int ai = 0; ai < 2; ++ai)
#pragma unroll
            for (int m = 0; m < 4; ++m) {
                const int row = u.pm * 256 + ai * 128 + wr * 64 + m * 16 + fr;
                bf16_t* rowp = A1 + (size_t)row * NDQKV + u.pn * 256 + wc * 32 + 8 * fq;
                float s0 = sq4(acc[ai][0][m][0]) + sq4(acc[ai][0][m][1]), s1 = sq4(acc[ai][1][m][0]) + sq4(acc[ai][1][m][1]);
                store8(rowp, acc[ai][0][m][0], acc[ai][0][m][1]); store8(rowp + 128, acc[ai][1][m][0], acc[ai][1][m][1]);
                s0 += __shfl_xor(s0, 16); s0 += __shfl_xor(s0, 32); s1 += __shfl_xor(s1, 16); s1 += __shfl_xor(s1, 32);
                if (fq == 0) {
                    float* sp = SSQ1 + (size_t)row * 16;
                    if (u.pn == 0) sp[wc] = s0 + s1; else if (u.pn == 1) { sp[4 + wc] = s0; sp[8 + wc] = s1; } else sp[12 + wc] = s0;
                }
                if (u.pn == 2 && wc < 2) {
                    f32x4 v0 = acc[ai][1][m][0], v1 = acc[ai][1][m][1];
                    if (row >= NCTXR) { const int t = (row - NCTXR) & (SEQL - 1); rope8(v0, v1, ROPE + ((size_t)t * 32 + 16 * wc + 4 * fq) * 2); }
                    store8(KPE + (size_t)row * 64 + 32 * wc + 8 * fq, v0, v1);
                }
            }
    }
};

struct PolQup : DenseBase<6, NDQKV * 2, true> {
    bf16_t* Q; const float* SSQ1;
    __device__ __forceinline__ void epi(const f32x4 (&acc)[2][2][4][2], const DUnit& u, int wr, int wc, int fr, int fq) const {
#pragma unroll
        for (int ai = 0; ai < 2; ++ai) {
            f32x4 p0[4], p1[4];
#pragma unroll
            for (int m = 0; m < 4; ++m) { const int row = u.pm * 256 + ai * 128 + wr * 64 + m * 16 + fr; p0[m] = *(const f32x4*)(SSQ1 + (size_t)row * 16); p1[m] = *(const f32x4*)(SSQ1 + (size_t)row * 16 + 4); }
#pragma unroll
            for (int m = 0; m < 4; ++m) {
                const int row = u.pm * 256 + ai * 128 + wr * 64 + m * 16 + fr;
                const float ss = ((p0[m][0] + p0[m][1]) + (p0[m][2] + p0[m][3])) + ((p1[m][0] + p1[m][1]) + (p1[m][2] + p1[m][3]));
                const float rstd = __builtin_amdgcn_rsqf(ss * (1.f / QLORA) + NORM_EPS);
                bf16_t* rowp = Q + (size_t)row * NQ + u.pn * 256 + wc * 32 + 8 * fq;
                store8(rowp, acc[ai][0][m][0] * rstd, acc[ai][0][m][1] * rstd); store8(rowp + 128, acc[ai][1][m][0] * rstd, acc[ai][1][m][1] * rstd);
            }
            asm volatile("" ::: "memory");
        }
    }
};

struct PolKVup : DenseBase<4, NDQKV * 2, true> {
    bf16_t* KV; const float* SSQ1;
    __device__ __forceinline__ void epi(const f32x4 (&acc)[2][2][4][2], const DUnit& u, int wr, int wc, int fr, int fq) const {
#pragma unroll
        for (int ai = 0; ai < 2; ++ai) {
            f32x4 p0[4], p1[4];
#pragma unroll
            for (int m = 0; m < 4; ++m) { const int row = u.pm * 256 + ai * 128 + wr * 64 + m * 16 + fr; p0[m] = *(const f32x4*)(SSQ1 + (size_t)row * 16 + 8); p1[m] = *(const f32x4*)(SSQ1 + (size_t)row * 16 + 12); }
#pragma unroll
            for (int m = 0; m < 4; ++m) {
                const int row = u.pm * 256 + ai * 128 + wr * 64 + m * 16 + fr;
                const float ss = ((p0[m][0] + p0[m][1]) + (p0[m][2] + p0[m][3])) + ((p1[m][0] + p1[m][1]) + (p1[m][2] + p1[m][3]));
                const float rstd = __builtin_amdgcn_rsqf(ss * (1.f / KVLORA) + NORM_EPS);
                bf16_t* rowp = KV + (size_t)row * NKV + u.pn * 256 + wc * 32 + 8 * fq;
                store8(rowp, acc[ai][0][m][0] * rstd, acc[ai][0][m][1] * rstd); store8(rowp + 128, acc[ai][1][m][0] * rstd, acc[ai][1][m][1] * rstd);
            }
            asm volatile("" ::: "memory");
        }
    }
};

struct PolWo : DenseBase<16, 2048, true> {
    bf16_t* OO; float* SSQO;
    __device__ __forceinline__ void epi(const f32x4 (&acc)[2][2][4][2], const DUnit& u, int wr, int wc, int fr, int fq) const {
#pragma unroll
        for (int ai = 0; ai < 2; ++ai)
#pragma unroll
            for (int m = 0; m < 4; ++m) {
                const int row = u.pm * 256 + ai * 128 + wr * 64 + m * 16 + fr;
                bf16_t* rowp = OO + (size_t)row * DM + u.pn * 256 + wc * 32 + 8 * fq;
                float s = (sq4(acc[ai][0][m][0]) + sq4(acc[ai][0][m][1])) + (sq4(acc[ai][1][m][0]) + sq4(acc[ai][1][m][1]));
                store8(rowp, acc[ai][0][m][0], acc[ai][0][m][1]); store8(rowp + 128, acc[ai][1][m][0], acc[ai][1][m][1]);
                s += __shfl_xor(s, 16); s += __shfl_xor(s, 32);
                if (fq == 0) SSQO[(size_t)row * 32 + u.pn * 4 + wc] = s;
            }
    }
};
namespace attn {
constexpr int NW = 8, QBLK = 32, KVBLK = 64, DQK = 192, DV = 128;
constexpr float SCALE = 0.07216878364870322f;
constexpr float THR = 8.f;
constexpr int SHM_V = KVBLK * DV * 2, SHM_K = KVBLK * DQK * 2;
constexpr int SHM_QPE = NW * 4096;
constexpr int SHM_ATTN = 2 * SHM_V + 2 * SHM_K + NW * 64 * 4 + SHM_QPE;
#define KSWZ(row, colB) ((row) * 384 + ((colB) ^ (((row) & 7) << 4)))
#define SBAR() __builtin_amdgcn_sched_barrier(0)
__device__ __forceinline__ int crow(int r, int hi) { return (r & 3) + 8 * (r >> 2) + 4 * hi; }
__device__ __forceinline__ unsigned cvtpk(float lo, float hi) { unsigned r; asm volatile("v_cvt_pk_bf16_f32 %0, %1, %2" : "=v"(r) : "v"(lo), "v"(hi)); return r; }

__device__ __forceinline__ void partialSM(f32x16& p0, f32x16& p1, float& m_reg, float& mn, float& alpha) {
  constexpr float C = SCALE * 1.4426950408889634f;
  float pmax = p0[0];
#pragma unroll
  for (int r = 1; r < 16; ++r) pmax = fmaxf(pmax, p0[r]);
#pragma unroll
  for (int r = 0; r < 16; ++r) pmax = fmaxf(pmax, p1[r]);
  { auto rr = __builtin_amdgcn_permlane32_swap(__float_as_uint(pmax), __float_as_uint(pmax), false, false);
    pmax = fmaxf(__uint_as_float(rr[0]), __uint_as_float(rr[1])); }
  if (__builtin_expect(__all(pmax - m_reg <= THR / SCALE), 1)) { mn = m_reg; alpha = 1.f; }
  else { mn = fmaxf(m_reg, pmax); alpha = __builtin_amdgcn_exp2f((m_reg - mn) * C); m_reg = mn; }
  float mnC = -mn * C;
#pragma unroll
  for (int r = 0; r < 16; ++r) p0[r] = fmaf(p0[r], C, mnC);
#pragma unroll
  for (int r = 0; r < 16; ++r) p1[r] = fmaf(p1[r], C, mnC);
#pragma unroll
  for (int r = 0; r < 16; ++r) p0[r] = __builtin_amdgcn_exp2f(p0[r]);
}
__device__ __forceinline__ void finishSM(f32x16& p0, f32x16& p1, float alpha, float& l_reg, bf16x8& pa0, bf16x8& pa1, bf16x8& pa2, bf16x8& pa3) {
#pragma unroll
  for (int r = 0; r < 16; ++r) p1[r] = __builtin_amdgcn_exp2f(p1[r]);
  float ps = 0;
#pragma unroll
  for (int r = 0; r < 16; ++r) ps += p0[r];
#pragma unroll
  for (int r = 0; r < 16; ++r) ps += p1[r];
  { auto rr = __builtin_amdgcn_permlane32_swap(__float_as_uint(ps), __float_as_uint(ps), false, false);
    ps = __uint_as_float(rr[0]) + __uint_as_float(rr[1]); }
  l_reg = l_reg * alpha + ps;
#define PK4(P, BASE, OUT) do { unsigned a0 = cvtpk(P[BASE + 0], P[BASE + 1]), a1 = cvtpk(P[BASE + 2], P[BASE + 3]);   \
    unsigned b0 = cvtpk(P[BASE + 4], P[BASE + 5]), b1 = cvtpk(P[BASE + 6], P[BASE + 7]);                              \
    auto r0 = __builtin_amdgcn_permlane32_swap(a0, b0, false, false); auto r1 = __builtin_amdgcn_permlane32_swap(a1, b1, false, false); \
    u32x4 w = {r0[0], r1[0], r0[1], r1[1]}; OUT = *reinterpret_cast<bf16x8*>(&w); } while (0)
  PK4(p0, 0, pa0); PK4(p0, 8, pa1); PK4(p1, 0, pa2); PK4(p1, 8, pa3);
#undef PK4
}
__device__ __forceinline__ void qkt(f32x16& p0, f32x16& p1, const char* Ks, const bf16x8* qr, const char* qpe, int r32, int hi) {
  p0 = f32x16{}; p1 = f32x16{};
#pragma unroll
  for (int d0 = 0; d0 < 12; ++d0) { int cb = (d0 * 16 + hi * 8) * 2;
    bf16x8 b0 = *reinterpret_cast<const bf16x8*>(Ks + KSWZ(r32, cb));
    bf16x8 b1 = *reinterpret_cast<const bf16x8*>(Ks + KSWZ(32 + r32, cb));
    const bf16x8 q = d0 < 8 ? qr[d0 < 8 ? d0 : 0] : *reinterpret_cast<const bf16x8*>(qpe + (d0 - 8) * 1024);
    p0 = __builtin_amdgcn_mfma_f32_32x32x16_bf16(b0, q, p0, 0, 0, 0);
    p1 = __builtin_amdgcn_mfma_f32_32x32x16_bf16(b1, q, p1, 0, 0, 0);
    if ((d0 & 3) == 3) SBAR(); }
}
__device__ __forceinline__ int v_st(int k, int c) { const int kk = (k & ~0xC) | ((k & 4) << 1) | ((k & 8) >> 1); return ((kk >> 3) * 4 + (c >> 5)) * 512 + ((kk & 7) * 32 + (c & 31)) * 2; }
__device__ __forceinline__ int v_rd_base(int lane) { return ((lane & 3) << 3) | (((lane >> 2) & 3) << 6) | (((lane >> 4) & 1) << 5) | (((lane >> 5) & 1) << 8); }
constexpr int v_rd_off(int d0, int ks, int half) { return d0 * 512 + ks * 4096 + half * 2048; }
template <int OFF> __device__ __forceinline__ s16x4 tr_read(int vb) {
  s16x4 r; asm volatile("ds_read_b64_tr_b16 %0, %1 offset:%2" : "=&v"(r) : "v"(vb), "i"(OFF) : "memory"); return r;
}
template <int D0> __device__ __forceinline__ void pv_one(f32x16& od, int vb, bf16x8 pa0, bf16x8 pa1, bf16x8 pa2, bf16x8 pa3) {
  const s16x4 l0 = tr_read<v_rd_off(D0, 0, 0)>(vb), h0 = tr_read<v_rd_off(D0, 0, 1)>(vb), l1 = tr_read<v_rd_off(D0, 1, 0)>(vb), h1 = tr_read<v_rd_off(D0, 1, 1)>(vb);
  const s16x4 l2 = tr_read<v_rd_off(D0, 2, 0)>(vb), h2 = tr_read<v_rd_off(D0, 2, 1)>(vb), l3 = tr_read<v_rd_off(D0, 3, 0)>(vb), h3 = tr_read<v_rd_off(D0, 3, 1)>(vb);
  asm volatile("s_waitcnt lgkmcnt(0)" ::: "memory"); SBAR();
#define PK(L, H) (bf16x8){L[0], L[1], L[2], L[3], H[0], H[1], H[2], H[3]}
  od = __builtin_amdgcn_mfma_f32_32x32x16_bf16(pa0, PK(l0, h0), od, 0, 0, 0);
  od = __builtin_amdgcn_mfma_f32_32x32x16_bf16(pa1, PK(l1, h1), od, 0, 0, 0);
  od = __builtin_amdgcn_mfma_f32_32x32x16_bf16(pa2, PK(l2, h2), od, 0, 0, 0);
  od = __builtin_amdgcn_mfma_f32_32x32x16_bf16(pa3, PK(l3, h3), od, 0, 0, 0);
#undef PK
}
__device__ __forceinline__ void pv_d0(f32x16* o, int vb, bf16x8 pa0, bf16x8 pa1, bf16x8 pa2, bf16x8 pa3) {
  pv_one<0>(o[0], vb, pa0, pa1, pa2, pa3); pv_one<1>(o[1], vb, pa0, pa1, pa2, pa3); pv_one<2>(o[2], vb, pa0, pa1, pa2, pa3); pv_one<3>(o[3], vb, pa0, pa1, pa2, pa3);
}

__device__ __forceinline__ void attn_unit(const bf16_t* __restrict__ Qg, const bf16_t* __restrict__ KVb, const bf16_t* __restrict__ KPE, bf16_t* __restrict__ Og, const float* __restrict__ ROPE,
                                          int qrow0, int qt0, int h, int crow0, int lrow0, int NT, char* lds) {
  const int tid = opaque_tid(), wid = tid >> 6, lane = tid & 63, r32 = lane & 31, hi = lane >> 5;
  char* V_lds = lds; char* K_lds = lds + 2 * SHM_V;
  float* ws = (float*)(lds + 2 * SHM_V + 2 * SHM_K) + wid * 64; float* li_l = ws; float* al_l = ws + 32;
  float m_reg = -1e30f, l_reg = 0; f32x16 o[4] = {}; bf16x8 qr[8];
  char* qpe = lds + 2 * SHM_V + 2 * SHM_K + NW * 64 * 4 + wid * 4096 + lane * 16;
  const bf16_t* Qw = Qg + (size_t)(qrow0 + wid * QBLK + r32) * NQ + h * DQK + hi * 8;
#pragma unroll
  for (int d0 = 0; d0 < 8; ++d0) qr[d0] = *reinterpret_cast<const bf16x8*>(Qw + d0 * 16);
#pragma unroll
  for (int d0 = 8; d0 < 12; ++d0) {
    u32x4 qv = *reinterpret_cast<const u32x4*>(Qw + d0 * 16);
    if (qt0 >= 0) { const float* cs = ROPE + ((size_t)(qt0 + wid * QBLK + r32) * 32 + 8 * (d0 - 8) + 4 * hi) * 2; const f32x4 ca = *(const f32x4*)cs, cb = *(const f32x4*)(cs + 4);
      float x0, x1;
      x0 = bf_lo(qv.x); x1 = bf_hi(qv.x); qv.x = cvtpk(x0 * ca[0] - x1 * ca[1], x0 * ca[1] + x1 * ca[0]);
      x0 = bf_lo(qv.y); x1 = bf_hi(qv.y); qv.y = cvtpk(x0 * ca[2] - x1 * ca[3], x0 * ca[3] + x1 * ca[2]);
      x0 = bf_lo(qv.z); x1 = bf_hi(qv.z); qv.z = cvtpk(x0 * cb[0] - x1 * cb[1], x0 * cb[1] + x1 * cb[0]);
      x0 = bf_lo(qv.w); x1 = bf_hi(qv.w); qv.w = cvtpk(x0 * cb[2] - x1 * cb[3], x0 * cb[3] + x1 * cb[2]); }
    *reinterpret_cast<u32x4*>(qpe + (d0 - 8) * 1024) = qv; }
  const int sr = tid >> 4, sc = (tid & 15) * 8, vst0 = v_st(sr, sc), vst1 = v_st(32 + sr, sc);
  const int pr = tid >> 3, pc = (tid & 7) * 8;
  const int vb0 = (int)(uintptr_t)V_lds + v_rd_base(lane);
  bf16x8 vs0, vs1, ks0, ks1, kp;
#define TROW(j) ((j) < 4 ? crow0 + 64 * (j) : lrow0 + 64 * ((j) - 4))
#define SLOAD(j) do { const int k0_ = TROW(j); const bf16_t* kv0_ = KVb + (size_t)(k0_ + sr) * NKV + h * 256 + sc; const bf16_t* kv1_ = kv0_ + (size_t)32 * NKV; \
    vs0 = *reinterpret_cast<const bf16x8*>(kv0_ + 128); vs1 = *reinterpret_cast<const bf16x8*>(kv1_ + 128); \
    ks0 = *reinterpret_cast<const bf16x8*>(kv0_); ks1 = *reinterpret_cast<const bf16x8*>(kv1_); \
    kp = *reinterpret_cast<const bf16x8*>(KPE + (size_t)(k0_ + pr) * 64 + pc); } while (0)
#define SWRITE(b) do { *(bf16x8*)(V_lds + (b) * SHM_V + vst0) = vs0; *(bf16x8*)(V_lds + (b) * SHM_V + vst1) = vs1; \
    *(bf16x8*)(K_lds + (b) * SHM_K + KSWZ(sr, sc * 2)) = ks0; *(bf16x8*)(K_lds + (b) * SHM_K + KSWZ(32 + sr, sc * 2)) = ks1; \
    *(bf16x8*)(K_lds + (b) * SHM_K + KSWZ(pr, (128 + pc) * 2)) = kp; } while (0)
#define SWAIT() asm volatile("s_waitcnt vmcnt(0)" ::: "memory")
#define RESC(a) do { if (__any((a) < 1.f)) { if (hi == 0) al_l[r32] = (a); asm volatile("s_waitcnt lgkmcnt(0)" ::: "memory"); \
    _Pragma("unroll") for (int d = 0; d < 4; ++d) _Pragma("unroll") for (int r = 0; r < 16; ++r) o[d][r] *= al_l[crow(r, hi)]; } } while (0)
  f32x16 pA0, pA1, pB0, pB1; float mnA, mnB, alA, alB; bf16x8 pa0, pa1, pa2, pa3;
  SLOAD(0); SWAIT(); SWRITE(0); __syncthreads();
  qkt(pA0, pA1, K_lds, qr, qpe, r32, hi); partialSM(pA0, pA1, m_reg, mnA, alA);
  SLOAD(1);
  SWAIT(); SWRITE(1); __syncthreads();
  for (int j = 1; j + 1 < NT; j += 2) {
    SBAR(); qkt(pB0, pB1, K_lds + SHM_K, qr, qpe, r32, hi);
    finishSM(pA0, pA1, alA, l_reg, pa0, pa1, pa2, pa3); SBAR();
    SLOAD(j + 1); SBAR();
    pv_d0(o, vb0, pa0, pa1, pa2, pa3); partialSM(pB0, pB1, m_reg, mnB, alB);
    __syncthreads(); SWAIT(); SWRITE(0);
    RESC(alB); __syncthreads();
    SBAR(); qkt(pA0, pA1, K_lds, qr, qpe, r32, hi);
    finishSM(pB0, pB1, alB, l_reg, pa0, pa1, pa2, pa3); SBAR();
    SLOAD(j + 2); SBAR();
    pv_d0(o, vb0 + SHM_V, pa0, pa1, pa2, pa3); partialSM(pA0, pA1, m_reg, mnA, alA);
    __syncthreads(); SWAIT(); SWRITE(1);
    RESC(alA); __syncthreads();
  }
  SBAR(); qkt(pB0, pB1, K_lds + SHM_K, qr, qpe, r32, hi);
  finishSM(pA0, pA1, alA, l_reg, pa0, pa1, pa2, pa3); SBAR();
  pv_d0(o, vb0, pa0, pa1, pa2, pa3); partialSM(pB0, pB1, m_reg, mnB, alB);
  __syncthreads(); RESC(alB);
  finishSM(pB0, pB1, alB, l_reg, pa0, pa1, pa2, pa3); SBAR();
  pv_d0(o, vb0 + SHM_V, pa0, pa1, pa2, pa3);
  if (hi == 0) li_l[r32] = l_reg; asm volatile("s_waitcnt lgkmcnt(0)" ::: "memory");
  float rli[16];
#pragma unroll
  for (int r = 0; r < 16; ++r) rli[r] = __builtin_amdgcn_rcpf(li_l[crow(r, hi)]);
  bf16_t* Ow = Og + (size_t)(qrow0 + wid * QBLK) * DM + h * DV;
#pragma unroll
  for (int r = 0; r < 16; ++r) { const int orow = crow(r, hi);
#pragma unroll
    for (int d0 = 0; d0 < 4; ++d0) Ow[(size_t)orow * DM + d0 * 32 + r32] = (bf16_t)(cvtpk(o[d0][r] * rli[r], 0.f) & 0xffffu); }
  __syncthreads();
#undef TROW
#undef SLOAD
#undef SWRITE
#undef SWAIT
#undef RESC
}
#undef KSWZ
#undef SBAR
}
constexpr int NWAVES = 8;
constexpr int RING_BYTES = 131072, LDSCTL_OFF = RING_BYTES, LDS_BYTES = 147456;

struct Args {
    const float* in[31]; float* out; unsigned char* ws; int stage; int pad;
};
struct Frame {
    LAS unsigned char* lds; int vcu, G; unsigned char* ws;
};
constexpr int PTAB_OFF = 131072 + 512;
__device__ __forceinline__ const float* inp(const Frame& F, int i) {
    const LAS unsigned* t = (const LAS unsigned*)(F.lds + PTAB_OFF) + 2 * i;
    const unsigned lo = __builtin_amdgcn_readfirstlane(t[0]), hi = __builtin_amdgcn_readfirstlane(t[1]);
    return (const float*)(((unsigned long long)hi << 32) | lo);
}

__device__ __forceinline__ unsigned f2bf(float f) { unsigned u = __float_as_uint(f); return (u + 0x7fffu + ((u >> 16) & 1u)) >> 16; }
__device__ __forceinline__ unsigned pk2(float lo, float hi) { return f2bf(lo) | (f2bf(hi) << 16); }
__device__ __forceinline__ void cvt_item(const float* srcA, const float* srcB, const float* kscale, bf16_t* dst, int ld, int K, int nrows, int nvalid, int mode, int item, LAS float* scr, int lane) {
    const int nblk = nrows >> 5, kb = item / nblk, nb = item - kb * nblk, k0 = 64 * kb, n0 = 32 * nb;
    const float* src = srcA; int col = n0; bool valid = n0 < nvalid;
    if (mode == 1) { const int t = n0 >> 8, r = n0 & 255; src = r < 128 ? srcA : srcB; col = 128 * t + (r & 127); valid = true; }
    const int kk = lane >> 3, n4 = (lane & 7) * 4;
    f32x4 v[8];
    if (valid) {
        const float* sp = src + (size_t)(k0 + kk) * ld + col + n4;
#pragma unroll
        for (int i = 0; i < 8; ++i) v[i] = *(const f32x4*)(sp + (size_t)(8 * i) * ld);
        if (kscale) {
#pragma unroll
            for (int i = 0; i < 8; ++i) v[i] = v[i] * kscale[k0 + 8 * i + kk];
        }
    } else {
#pragma unroll
        for (int i = 0; i < 8; ++i) v[i] = (f32x4){0.f, 0.f, 0.f, 0.f};
    }
#pragma unroll
    for (int i = 0; i < 8; ++i) { LAS float* d = scr + (8 * i + kk) * 33 + n4; d[0] = v[i][0]; d[1] = v[i][1]; d[2] = v[i][2]; d[3] = v[i][3]; }
    asm volatile("s_waitcnt lgkmcnt(0)" ::: "memory");
    const int c = lane & 7;
#pragma unroll
    for (int j = 0; j < 4; ++j) { const int n = (lane >> 3) + 8 * j; const LAS float* s = scr + (8 * c) * 33 + n;
        u32x4 o; o.x = cvt_pk_bf16(s[0 * 33], s[1 * 33]); o.y = cvt_pk_bf16(s[2 * 33], s[3 * 33]); o.z = cvt_pk_bf16(s[4 * 33], s[5 * 33]); o.w = cvt_pk_bf16(s[6 * 33], s[7 * 33]);
        *(u32x4*)(dst + (size_t)(n0 + n) * K + k0 + 8 * c) = o; }
    asm volatile("s_waitcnt lgkmcnt(0)" ::: "memory");
}
constexpr int N_SMALL_JOBS = 11;
__device__ __forceinline__ void convert_small(const Args& a, Frame& F) {
    unsigned char* const wsl = opaque_ptr(a.ws);
    const int tid_ = opaque_tid(), lane_ = tid_ & 63, wave_ = __builtin_amdgcn_readfirstlane(tid_ >> 6);
    LAS float* scr = (LAS float*)(F.lds + wave_ * 16384);
    const int gw = F.vcu * NWAVES + wave_, NGW = F.G * NWAVES;
    unsigned char* ws = wsl;
    int base = 0;
#define SMALL_JOB(SA, SB, KS, DST, LD, KK, NR, NV, MODE) do { const int n_ = ((KK) >> 6) * ((NR) >> 5); const int first_ = ((gw - base) % NGW + NGW) % NGW; \
        for (int it = first_; it < n_; it += NGW) cvt_item(SA, SB, KS, DST, LD, KK, NR, NV, MODE, it, scr, lane_); base += n_; } while (0)
    SMALL_JOB(inp(F, 7), nullptr, nullptr, (bf16_t*)(ws + WS_WDQKV), 704, 1024, 768, 704, 0);
    SMALL_JOB(inp(F, 10), nullptr, inp(F, 8), (bf16_t*)(ws + WS_WUQ), 1536, 384, 1536, 1536, 0);
    SMALL_JOB(inp(F, 11), nullptr, inp(F, 9), (bf16_t*)(ws + WS_WUKV), 2048, 256, 2048, 2048, 0);
    SMALL_JOB(inp(F, 12), nullptr, nullptr, (bf16_t*)(ws + WS_WO), 1024, 1024, 1024, 1024, 0);
    SMALL_JOB(inp(F, 21), inp(F, 21) + 1024, nullptr, (bf16_t*)(ws + WS_WGLU), 2048, 1024, 2048, 2048, 1);
#pragma unroll 1
    for (int l = 0; l < 2; ++l) {
        SMALL_JOB(inp(F, 28) + (size_t)l * 1024 * 256, inp(F, 29) + (size_t)l * 1024 * 256, nullptr, (bf16_t*)(ws + WS_WSHR) + (size_t)l * 768 * 1024, 256, 1024, 512, 512, 1);
        SMALL_JOB(inp(F, 23) + (size_t)l * 1024 * 64, nullptr, nullptr, (bf16_t*)(ws + WS_WSHR) + (size_t)l * 768 * 1024 + (size_t)512 * 1024, 64, 1024, 256, 64, 0);
        SMALL_JOB(inp(F, 30) + (size_t)l * 256 * 1024, nullptr, nullptr, (bf16_t*)(ws + WS_WSHD) + (size_t)l * 1024 * 256, 1024, 256, 1024, 1024, 0);
    }
#undef SMALL_JOB
}
__device__ __forceinline__ void convert_experts(const Args& a, Frame& F, int layer, int skip) {
    unsigned char* const wsl = opaque_ptr(a.ws);
    const int tid_ = opaque_tid(), lane_ = tid_ & 63, wave_ = __builtin_amdgcn_readfirstlane(tid_ >> 6);
    LAS float* scr = (LAS float*)(F.lds + wave_ * 16384);
    const int gw = (F.vcu - skip) * NWAVES + wave_, NGW = (F.G - skip) * NWAVES;
    for (int it = gw; it < NEXP * 384; it += NGW) { const int e = it / 384, r = it - e * 384; const size_t eo = ((size_t)layer * NEXP + e) * 1024 * 256;
        if (r < 256) cvt_item(inp(F, 25) + eo, inp(F, 26) + eo, nullptr, (bf16_t*)(wsl + WS_W1) + (size_t)e * 512 * 1024, 256, 1024, 512, 512, 1, r, scr, lane_);
        else cvt_item(inp(F, 27) + eo, nullptr, nullptr, (bf16_t*)(wsl + WS_W2) + (size_t)e * 1024 * 256, 1024, 256, 1024, 1024, 0, r - 256, scr, lane_); }
}

__device__ __forceinline__ void mod_phase(const Args& a, Frame& F) {
    unsigned char* const wsl = opaque_ptr(a.ws);
    const int tid_ = opaque_tid(), lane_ = tid_ & 63, wave_ = __builtin_amdgcn_readfirstlane(tid_ >> 6);
    LAS float* sl = (LAS float*)F.lds;
    LAS float* red = sl + 17 * 1024;
    float* MOD = (float*)(wsl + WS_MOD);
    bool have = false;
    for (int u = F.vcu; u < 256; u += F.G) {
        if (!have) { for (int i = tid_; i < 17 * 1024; i += 512) { const float v = i < 16 * 1024 ? inp(F, 1)[i] : inp(F, 3)[i - 16 * 1024]; sl[i] = silu_f(v); } __syncthreads(); have = true; }
        const int l = u >> 7, n0 = (u & 127) * 48, kg = tid_ >> 6, cl = (tid_ & 63) < 48 ? (tid_ & 63) : 47, col = n0 + cl;
        const float* W = inp(F, 4) + (size_t)l * 1024 * MODW + col;
        float acc[17];
#pragma unroll
        for (int b = 0; b < 17; ++b) acc[b] = 0.f;
#pragma unroll 8
        for (int k = kg; k < 1024; k += 8) { const float w = W[(size_t)k * MODW];
#pragma unroll
            for (int b = 0; b < 17; ++b) acc[b] += sl[b * 1024 + k] * w; }
#pragma unroll
        for (int b = 0; b < 17; ++b) red[(kg * 17 + b) * 64 + (tid_ & 63)] = acc[b];
        __syncthreads();
        for (int i = tid_; i < 17 * 64; i += 512) { const int b = i >> 6, c = i & 63; if (c >= 48) continue; float s = inp(F, 5)[(size_t)l * MODW + n0 + c];
#pragma unroll
            for (int g = 0; g < 8; ++g) s += red[(g * 17 + b) * 64 + c];
            MOD[((size_t)l * 17 + b) * MODW + n0 + c] = s; }
        __syncthreads();
    }
}
__device__ __forceinline__ void sincos_red(float ang, float& c, float& s) {
    const float k = rintf(ang * 0.15915494309189535f);
    float r = fmaf(-k, 6.2831854820251465f, ang); r = fmaf(-k, -1.7484555314695172e-07f, r);
    s = __sinf(r); c = __cosf(r);
}
__device__ __forceinline__ void rope_phase(const Args& a, Frame& F) {
    unsigned char* const wsl = opaque_ptr(a.ws);
    const int tid_ = opaque_tid(), lane_ = tid_ & 63, wave_ = __builtin_amdgcn_readfirstlane(tid_ >> 6);
    float* ROPE = (float*)(wsl + WS_ROPE);
    for (int i = (F.vcu * 512 + tid_); i < SEQL * 32; i += F.G * 512) { const int t = i >> 5, p = i & 31, j = p & 15;
        const float f = exp2f(-(float)j * (13.287712379549449f / 16.f)); const float pos = (float)(p < 16 ? (t >> 6) : (t & 63));
        float c, s; sincos_red(pos * f, c, s); ROPE[2 * i] = c; ROPE[2 * i + 1] = s; }
}

__device__ __forceinline__ const float* xrow_in(const Args& a, const Frame& F, int layer, int row) {
    unsigned char* const wsl = opaque_ptr(a.ws);
    if (layer == 0) return row < NCTXR ? inp(F, 2) + (size_t)row * DM : inp(F, 0) + (size_t)(row - NCTXR) * DM;
    return row < NCTXR ? (const float*)(wsl + WS_XCTX) + (size_t)row * DM : a.out + (size_t)(row - NCTXR) * DM;
}
__device__ __forceinline__ float* xrow_st(const Args& a, int row) {
    unsigned char* const wsl = opaque_ptr(a.ws); return row < NCTXR ? (float*)(wsl + WS_XCTX) + (size_t)row * DM : a.out + (size_t)(row - NCTXR) * DM; }
__device__ __forceinline__ void norm_mod_store(const f32x4 (&v)[4], const float* g, const float* shift, const float* scale, bf16_t* orow, int lane) {
    float s = 0.f;
#pragma unroll
    for (int j = 0; j < 4; ++j) s += sq4(v[j]);
    const float rstd = __builtin_amdgcn_rsqf(wave_sum(s) * (1.f / DM) + NORM_EPS);
#pragma unroll
    for (int j = 0; j < 4; ++j) { const int c = 4 * lane + 256 * j; const f32x4 gg = *(const f32x4*)(g + c), sh = *(const f32x4*)(shift + c), sc = *(const f32x4*)(scale + c);
        const f32x4 h = (v[j] * rstd * gg) * (sc + 1.f) + sh; u32x2 w; w.x = cvt_pk_bf16(h[0], h[1]); w.y = cvt_pk_bf16(h[2], h[3]); *(u32x2*)(orow + c) = w; }
}
__device__ __forceinline__ void h_phase(const Args& a, Frame& F, int layer, int row_lo) {
    unsigned char* const wsl = opaque_ptr(a.ws);
    const int tid_ = opaque_tid(), lane_ = tid_ & 63, wave_ = __builtin_amdgcn_readfirstlane(tid_ >> 6);
    const float* MOD = (const float*)(wsl + WS_MOD) + (size_t)layer * 17 * MODW; const float* g = inp(F, 6) + (size_t)(layer * 4 + 0) * DM; bf16_t* XN = (bf16_t*)(wsl + WS_XN);
    const int stride = F.G * NWAVES; int row = row_lo + F.vcu * NWAVES + wave_;
    f32x4 nx[4];
    if (row < NROWS) { const float* x = xrow_in(a, F, layer, row);
#pragma unroll
        for (int j = 0; j < 4; ++j) nx[j] = *(const f32x4*)(x + 4 * lane_ + 256 * j); }
    for (; row < NROWS; row += stride) {
        f32x4 v[4];
#pragma unroll
        for (int j = 0; j < 4; ++j) v[j] = nx[j];
        if (row + stride < NROWS) { const float* x = xrow_in(a, F, layer, row + stride);
#pragma unroll
            for (int j = 0; j < 4; ++j) nx[j] = *(const f32x4*)(x + 4 * lane_ + 256 * j); }
        const float* m = MOD + (size_t)mod_index(row) * MODW;
        norm_mod_store(v, g, m + 0 * DM, m + 1 * DM, XN + (size_t)row * DM, lane_);
    }
}
__device__ __forceinline__ void postmix_phase(const Args& a, Frame& F, int layer, int row_lo, int NS) {
    unsigned char* const wsl = opaque_ptr(a.ws);
    const int tid_ = opaque_tid(), lane_ = tid_ & 63, wave_ = __builtin_amdgcn_readfirstlane(tid_ >> 6);
    const float* MOD = (const float*)(wsl + WS_MOD) + (size_t)layer * 17 * MODW; const float* g1 = inp(F, 6) + (size_t)(layer * 4 + 1) * DM; const float* g2 = inp(F, 6) + (size_t)(layer * 4 + 2) * DM;
    bf16_t* XN = (bf16_t*)(wsl + WS_XN); const bf16_t* OO = (const bf16_t*)(wsl + WS_OO); const float* SSQO = (const float*)(wsl + WS_SSQO);
    const int stride = F.G * NWAVES; int row = row_lo + F.vcu * NWAVES + wave_;
    f32x4 nx[4]; u32x2 no[4]; float nss = 0.f;
#define PM_LOAD(R) do { const float* x_ = xrow_in(a, F, layer, (R)); \
        _Pragma("unroll") for (int j = 0; j < 4; ++j) { const int c = 4 * lane_ + 256 * j; nx[j] = *(const f32x4*)(x_ + c); no[j] = *(const u32x2*)(OO + (size_t)(R) * DM + c); } \
        nss = lane_ < NS ? SSQO[(size_t)(R) * 32 + lane_] : 0.f; } while (0)
    if (row < NROWS) PM_LOAD(row);
    for (; row < NROWS; row += stride) {
        f32x4 xv[4]; u32x2 ov[4]; float ss = nss;
#pragma unroll
        for (int j = 0; j < 4; ++j) { xv[j] = nx[j]; ov[j] = no[j]; }
        if (row + stride < NROWS) PM_LOAD(row + stride);
        float* xo = xrow_st(a, row); const float* m = MOD + (size_t)mod_index(row) * MODW;
        ss = wave_sum(ss);
        const float rstd = __builtin_amdgcn_rsqf(ss * (1.f / DM) + NORM_EPS);
        f32x4 v[4];
#pragma unroll
        for (int j = 0; j < 4; ++j) { const int c = 4 * lane_ + 256 * j;
            const f32x4 o = {bf_lo(ov[j].x), bf_hi(ov[j].x), bf_lo(ov[j].y), bf_hi(ov[j].y)}; const f32x4 gg = *(const f32x4*)(g1 + c), gt = *(const f32x4*)(m + 2 * DM + c);
            v[j] = xv[j] + gt * (o * rstd * gg); *(f32x4*)(xo + c) = v[j]; }
        norm_mod_store(v, g2, m + 3 * DM, m + 4 * DM, XN + (size_t)row * DM, lane_);
    }
#undef PM_LOAD
}
constexpr size_t WS_Y     = WS_ST;
constexpr size_t WS_H0    = WS_ST + 216 * MiB;
constexpr size_t WS_H1    = WS_ST + 278 * MiB;
constexpr size_t WS_HSH   = WS_ST + 340 * MiB;
constexpr size_t WS_LOG   = WS_ST + 358 * MiB;
constexpr size_t WS_SELI  = WS_ST + 367 * MiB;
constexpr size_t WS_SELW  = WS_SELI + (size_t)NROWS * 32;
constexpr size_t WS_LDST  = WS_ST + 370 * MiB;
constexpr size_t WS_LW    = WS_LDST + 1536 * 1024;
constexpr size_t WS_BLKCNT= WS_ST + 373 * MiB;
constexpr size_t WS_TINFO = WS_BLKCNT + 256 * 192 * 4;
constexpr int NLIST = 192;
static_assert(WS_TINFO + 4 * (512 + 1600) <= WS_ST + 374 * MiB, "MoE stage map");

template <int NT_, int LDA_, bool PERM_> struct DenseRow0 : DenseBase<NT_, LDA_, PERM_> { int row0; };

struct PolShr : DenseRow0<16, 2048, true> {
    bf16_t* HSH; float* LOG;
    __device__ __forceinline__ void epi(const f32x4 (&acc)[2][2][4][2], const DUnit& u, int wr, int wc, int fr, int fq) const {
#pragma unroll
        for (int ai = 0; ai < 2; ++ai)
#pragma unroll
            for (int m = 0; m < 4; ++m) {
                const int row = row0 + u.pm * 256 + ai * 128 + wr * 64 + m * 16 + fr;
                if (u.pn < 2) {
                    f32x4 h0, h1;
#pragma unroll
                    for (int j = 0; j < 4; ++j) { h0[j] = silu_f(acc[ai][0][m][0][j]) * acc[ai][1][m][0][j]; h1[j] = silu_f(acc[ai][0][m][1][j]) * acc[ai][1][m][1][j]; }
                    store8(HSH + (size_t)row * 256 + u.pn * 128 + wc * 32 + 8 * fq, h0, h1);
                } else if (wc < 2) {
                    float* lp = LOG + (size_t)row * 64 + wc * 32 + 8 * fq; *(f32x4*)lp = acc[ai][0][m][0]; *(f32x4*)(lp + 4) = acc[ai][0][m][1];
                }
            }
    }
};

__device__ __forceinline__ int slot_round(int s) { return s < 2 ? 0 : (s < 5 ? 1 : 2); }
__device__ __forceinline__ int slot_yrow(int s) { return s < 2 ? s + 1 : (s < 5 ? s - 2 : s - 5); }
__device__ __forceinline__ void route_phase(const Args& a, Frame& F, int layer, int row_lo, int tpb) {
    unsigned char* const wsl = opaque_ptr(a.ws);
    const int tid_ = opaque_tid(), lane = tid_ & 63, wave = __builtin_amdgcn_readfirstlane(tid_ >> 6);
    LAS int* cnt = (LAS int*)F.lds;
    for (int i = tid_; i < NLIST; i += 512) cnt[i] = 0;
    __syncthreads();
    const float* LOG = (const float*)(wsl + WS_LOG); int* SELI = (int*)(wsl + WS_SELI); float* SELW = (float*)(wsl + WS_SELW);
    const float bias = inp(F, 24)[layer * NEXP + lane];
    const int blk = F.vcu;
    float lg_next = LOG[(size_t)(row_lo + blk * tpb + wave) * 64 + lane];
    for (int t = wave; t < tpb; t += NWAVES) {
        const int row = row_lo + blk * tpb + t;
        const float lg = lg_next; if (t + NWAVES < tpb) lg_next = LOG[(size_t)(row + NWAVES) * 64 + lane];
        const float sc = sigmoid_f(lg), bs = sc + bias;
        float m1 = bs;
        m1 = fmaxf(m1, __shfl_xor(m1, 1)); m1 = fmaxf(m1, __shfl_xor(m1, 2)); m1 = fmaxf(m1, __shfl_xor(m1, 4));
        const unsigned long long eqm = __ballot(bs == m1);
        const int grp = lane >> 3; const unsigned gm = (unsigned)((eqm >> (grp * 8)) & 0xffull);
        float v2 = (bs == m1) ? -INFINITY : bs;
        v2 = fmaxf(v2, __shfl_xor(v2, 1)); v2 = fmaxf(v2, __shfl_xor(v2, 2)); v2 = fmaxf(v2, __shfl_xor(v2, 4));
        const float m2 = (__popc(gm) >= 2) ? m1 : v2;
        const float gs = m1 + m2;
        int grank = 0;
#pragma unroll
        for (int j = 0; j < 8; ++j) { const float o = __shfl(gs, j * 8); grank += (o > gs || (o == gs && j < grp)) ? 1 : 0; }
        const float mv = grank < 4 ? bs : -INFINITY;
        int rank = 0;
#pragma unroll 8
        for (int j = 0; j < 64; ++j) { const float o = __shfl(mv, j); rank += (o > mv || (o == mv && j < lane)) ? 1 : 0; }
        const bool sel = rank < TOPK && grank < 4;
        const float ssum = wave_sum(sel ? sc : 0.f);
        if (sel) { const int s = rank, l = slot_round(s) * 64 + lane;
            SELI[(size_t)row * 8 + s] = l | (slot_yrow(s) << 8); SELW[(size_t)row * 8 + s] = sc / ssum * 2.5f;
            atomicAdd((int*)&cnt[l], 1); }
    }
    __syncthreads();
    int* BLKCNT = (int*)(wsl + WS_BLKCNT);
    for (int i = tid_; i < NLIST; i += 512) BLKCNT[blk * NLIST + i] = cnt[i];
}
__device__ __forceinline__ void place_phase(const Args& a, Frame& F, int row_lo, int tpb) {
    unsigned char* const wsl = opaque_ptr(a.ws);
    const int tid_ = opaque_tid();
    LAS int* tot = (LAS int*)F.lds; LAS int* mine = tot + 256; LAS int* tst = mine + 256; LAS int* cur = tst + 256;
    const int* BLKCNT = (const int*)(wsl + WS_BLKCNT); const int blk = F.vcu;
    if (tid_ < 256) { tot[tid_] = 0; mine[tid_] = 0; cur[tid_] = 0; }
    __syncthreads();
    if (tid_ < 2 * NLIST) { const int l = tid_ % NLIST, b0 = (tid_ / NLIST) * 128; int s = 0, m = 0;
#pragma unroll 16
        for (int b = b0; b < b0 + 128; ++b) { const int c = (b < F.G) ? BLKCNT[b * NLIST + l] : 0; m += (b < blk) ? c : 0; s += c; }
        atomicAdd((int*)&tot[l], s); atomicAdd((int*)&mine[l], m); }
    __syncthreads();
    if (tid_ == 0) { int acc = 0; for (int l = 0; l < NLIST; ++l) { tst[l] = acc; acc += (tot[l] + 255) >> 8; } tst[NLIST] = acc; }
    __syncthreads();
    int* TINFO = (int*)(wsl + WS_TINFO); int* LDST = (int*)(wsl + WS_LDST); float* LW = (float*)(wsl + WS_LW);
    if (blk == 0) {
        for (int i = tid_; i <= NLIST; i += 512) TINFO[i] = tst[i];
        for (int i = tid_; i < NLIST; i += 512) TINFO[256 + i] = tot[i];
        const int lane = tid_ & 63, wv = tid_ >> 6;
        for (int l = wv; l < NLIST; l += NWAVES) { const int t0 = tst[l], t1 = tst[l + 1];
            for (int t = t0 + lane; t < t1; t += 64) TINFO[512 + t] = l;
            const int c = tot[l], base = t0 * 256;
            for (int p = c + lane; p < (t1 - t0) * 256; p += 64) LDST[base + p] = -1; }
    }
    const int* SELI = (const int*)(wsl + WS_SELI); const float* SELW = (const float*)(wsl + WS_SELW);
    for (int i = tid_; i < tpb * 8; i += 512) { const int row = row_lo + blk * tpb + (i >> 3), s = i & 7;
        const int v = SELI[(size_t)row * 8 + s], l = v & 0xff, yr = v >> 8;
        const int pos = tst[l] * 256 + mine[l] + atomicAdd((int*)&cur[l], 1);
        LDST[pos] = row * 3 + yr; LW[pos] = SELW[(size_t)row * 8 + s]; }
}

struct MUnit { int T, pn; };
struct PolMoe1 {
    static constexpr bool PERM = true, GATHER = true, TWOSEG = false;
    static constexpr int NT = 16, KT0 = 16, KS0 = 128, KS1 = 128, LDB = 2048;
    typedef MUnit Unit;
    const char* XN; const char* W1; bf16_t* H; const int* TINFO; const int* LDST; int T0, T1, G, c;
    __device__ __forceinline__ bool next(int i, Unit& u) const { const int L = i * G + c; u.T = T0 + (L >> 1); u.pn = L & 1; return u.T < T1; }
    __device__ __forceinline__ void ctx(const Unit& u, pg8::UCtx<true>& x, const int (&R)[2], const int (&C)[2]) const {
        const int e = __builtin_amdgcn_readfirstlane(TINFO[512 + u.T]) & 63;
        x.a0[0] = XN; x.a0[1] = XN; x.a1[0] = XN; x.a1[1] = XN; x.b = W1 + ((size_t)e * 512 + u.pn * 256) * LDB;
#pragma unroll
        for (int h = 0; h < 2; ++h)
#pragma unroll
            for (int i = 0; i < 2; ++i) { const int d = LDST[u.T * 256 + h * 128 + R[i]]; const int tok = d < 0 ? 0 : d / 3; x.vg[h][i] = (unsigned)tok * 2048u + (unsigned)C[i] * 2u; }
    }
    __device__ __forceinline__ unsigned lane_a0(int, int) const { return 0u; }
    __device__ __forceinline__ unsigned lane_a1(int, int) const { return 0u; }
    __device__ __forceinline__ void epi(const f32x4 (&acc)[2][2][4][2], const Unit& u, int wr, int wc, int fr, int fq) const {
#pragma unroll
        for (int ai = 0; ai < 2; ++ai)
#pragma unroll
            for (int m = 0; m < 4; ++m) {
                const int hrow = (u.T - T0) * 256 + ai * 128 + wr * 64 + m * 16 + fr;
                f32x4 h0, h1;
#pragma unroll
                for (int j = 0; j < 4; ++j) { h0[j] = silu_f(acc[ai][0][m][0][j]) * acc[ai][1][m][0][j]; h1[j] = silu_f(acc[ai][0][m][1][j]) * acc[ai][1][m][1][j]; }
                store8(H + (size_t)hrow * 256 + u.pn * 128 + wc * 32 + 8 * fq, h0, h1);
            }
    }
};
template <bool RMW> struct PolMoe2 {
    static constexpr bool PERM = true, GATHER = false, TWOSEG = false;
    static constexpr int NT = 4, KT0 = 4, KS0 = 128, KS1 = 128, LDB = 512;
    typedef MUnit Unit;
    const char* H; const char* W2; unsigned char* Y; const int* TINFO; const int* LDST; const float* LW; int T0, T1, G, c;
    __device__ __forceinline__ bool next(int i, Unit& u) const { const int L = i * G + c; u.T = T0 + (L >> 2); u.pn = L & 3; return u.T < T1; }
    __device__ __forceinline__ void ctx(const Unit& u, pg8::UCtx<false>& x, const int (&)[2], const int (&)[2]) const {
        const int e = __builtin_amdgcn_readfirstlane(TINFO[512 + u.T]) & 63;
        x.a0[0] = H + (size_t)(u.T - T0) * 256 * 512; x.a0[1] = x.a0[0] + 128 * 512; x.a1[0] = x.a0[0]; x.a1[1] = x.a0[1];
        x.b = W2 + ((size_t)e * 1024 + u.pn * 256) * LDB;
    }
    __device__ __forceinline__ unsigned lane_a0(int R, int C) const { return (unsigned)(R * 512 + C * 2); }
    __device__ __forceinline__ unsigned lane_a1(int, int) const { return 0u; }
    __device__ __forceinline__ void epi(const f32x4 (&acc)[2][2][4][2], const Unit& u, int wr, int wc, int fr, int fq) const {
        const int cofs = u.pn * 256 + wc * 32 + 8 * fq;
#pragma unroll
        for (int ai = 0; ai < 2; ++ai) {
            int d[4]; float w[4];
#pragma unroll
            for (int m = 0; m < 4; ++m) { const int lp = u.T * 256 + ai * 128 + wr * 64 + m * 16 + fr; d[m] = LDST[lp]; w[m] = LW[lp]; }
            u32x2 o[4][2];
            if (RMW) {
#pragma unroll
                for (int m = 0; m < 4; ++m) { const unsigned char* yp = Y + (size_t)(d[m] < 0 ? 0 : d[m]) * DM + cofs; o[m][0] = *(const u32x2*)yp; o[m][1] = *(const u32x2*)(yp + 128); }
            }
#pragma unroll
            for (int m = 0; m < 4; ++m) {
                if (d[m] >= 0) {
                    unsigned char* yp = Y + (size_t)d[m] * DM + cofs; const float ww = w[m];
#pragma unroll
                    for (int bj = 0; bj < 2; ++bj) {
                        f32x4 v0 = acc[ai][bj][m][0] * ww, v1 = acc[ai][bj][m][1] * ww;
                        if (RMW) { v0 += fp8_unpack4(o[m][bj].x); v1 += fp8_unpack4(o[m][bj].y); }
                        u32x2 q; q.x = fp8_pack4(v0); q.y = fp8_pack4(v1); *(u32x2*)(yp + bj * 128) = q;
                    }
                }
            }
            asm volatile("" ::: "memory");
        }
    }
};
struct PolShd : DenseRow0<4, 512, true> {
    unsigned char* Y;
    __device__ __forceinline__ void epi(const f32x4 (&acc)[2][2][4][2], const DUnit& u, int wr, int wc, int fr, int fq) const {
#pragma unroll
        for (int ai = 0; ai < 2; ++ai)
#pragma unroll
            for (int m = 0; m < 4; ++m) {
                const int row = row0 + u.pm * 256 + ai * 128 + wr * 64 + m * 16 + fr;
                unsigned char* yp = Y + (size_t)row * 3 * DM + u.pn * 256 + wc * 32 + 8 * fq;
                u32x2 q0, q1; q0.x = fp8_pack4(acc[ai][0][m][0]); q0.y = fp8_pack4(acc[ai][0][m][1]); q1.x = fp8_pack4(acc[ai][1][m][0]); q1.y = fp8_pack4(acc[ai][1][m][1]);
                *(u32x2*)yp = q0; *(u32x2*)(yp + 128) = q1;
            }
    }
};

__device__ __forceinline__ void combine_phase(const Args& a, Frame& F, int layer, int row_lo) {
    unsigned char* const wsl = opaque_ptr(a.ws);
    const int tid_ = opaque_tid(), lane_ = tid_ & 63, wave_ = __builtin_amdgcn_readfirstlane(tid_ >> 6);
    const float* MOD = (const float*)(wsl + WS_MOD) + (size_t)layer * 17 * MODW; const float* g3 = inp(F, 6) + (size_t)(layer * 4 + 3) * DM;
    const float* MODn = (const float*)(wsl + WS_MOD) + (size_t)1 * 17 * MODW; const float* gn = inp(F, 6) + (size_t)(1 * 4 + 0) * DM;
    bf16_t* XN = (bf16_t*)(wsl + WS_XN); const unsigned char* Y = (const unsigned char*)(wsl + WS_Y);
    const int stride = F.G * NWAVES; int row = row_lo + F.vcu * NWAVES + wave_;
    f32x4 nx[4]; unsigned ny[4][3];
#define CB_LOAD(R) do { const float* x_ = xrow_st(a, (R)); \
        _Pragma("unroll") for (int j = 0; j < 4; ++j) { const int c = 4 * lane_ + 256 * j; nx[j] = *(const f32x4*)(x_ + c); \
            _Pragma("unroll") for (int r = 0; r < 3; ++r) ny[j][r] = *(const unsigned*)(Y + ((size_t)(R) * 3 + r) * DM + c); } } while (0)
    if (row < NROWS) CB_LOAD(row);
    for (; row < NROWS; row += stride) {
        float* xo = xrow_st(a, row); const float* m = MOD + (size_t)mod_index(row) * MODW;
        f32x4 f[4], xv[4]; float ss = 0.f;
#pragma unroll
        for (int j = 0; j < 4; ++j) { xv[j] = nx[j]; f[j] = (f32x4){0.f, 0.f, 0.f, 0.f};
#pragma unroll
            for (int r = 0; r < 3; ++r) f[j] += fp8_unpack4(ny[j][r]);
            ss += sq4(f[j]); }
        if (row + stride < NROWS) CB_LOAD(row + stride);
        const float rstd = __builtin_amdgcn_rsqf(wave_sum(ss) * (1.f / DM) + NORM_EPS);
        f32x4 v[4];
#pragma unroll
        for (int j = 0; j < 4; ++j) { const int c = 4 * lane_ + 256 * j; const f32x4 gg = *(const f32x4*)(g3 + c), gt = *(const f32x4*)(m + 5 * DM + c);
            v[j] = xv[j] + gt * (f[j] * rstd * gg); *(f32x4*)(xo + c) = v[j]; }
        if (layer == 0) { const float* mn = MODn + (size_t)mod_index(row) * MODW; norm_mod_store(v, gn, mn + 0 * DM, mn + 1 * DM, XN + (size_t)row * DM, lane_); }
    }
#undef CB_LOAD
}
constexpr size_t WS_G    = WS_ST;
constexpr size_t WS_BTY  = WS_ST + 216 * MiB;
constexpr size_t WS_BTS  = WS_ST + 264 * MiB;
constexpr size_t WS_S    = WS_ST + 280 * MiB;
constexpr size_t WS_XIN  = WS_ST + 64 * MiB;
constexpr size_t WS_LAMT = WS_ROPE + 512 * 1024;
constexpr int S5_T = 32;

constexpr size_t WS_KD   = WS_ST + 130 * MiB;
__device__ __forceinline__ f32x2 cmul(f32x2 a, f32x2 b) { return (f32x2){a.x * b.x - a.y * b.y, a.x * b.y + a.y * b.x}; }
__device__ __forceinline__ void s5_tables_unit(const Args& a, Frame& F, int g, int d) {
    unsigned char* const wsl = opaque_ptr(a.ws);
    const int tid = opaque_tid();
    LAS f32x2* pw = (LAS f32x2*)F.lds; LAS f32x2* bb = pw + 33 * 64; LAS f32x2* cm = bb + 64 * 16;
    bf16_t* BTY = (bf16_t*)(wsl + WS_BTY) + (size_t)g * 512 * 768; bf16_t* BTS = (bf16_t*)(wsl + WS_BTS) + (size_t)g * 256 * 512; float* LAMT = (float*)(wsl + WS_LAMT);
    float* KD = (float*)(wsl + WS_KD) + (size_t)(g * 2 + d) * 8192;
    const float* lre = inp(F, 13); const float* lim = inp(F, 14); const float* lst = inp(F, 15);
    const float* bre = inp(F, 16); const float* bim = inp(F, 17); const float* cre = inp(F, 18); const float* cim = inp(F, 19);
    __syncthreads();
    const float step = __expf(lst[d * 64 + g]);
    for (int i = tid; i < 33 * 64; i += 512) { const int k = i >> 6, p = i & 63; const float lr = lre[(d * 64 + g) * 64 + p], li = lim[(d * 64 + g) * 64 + p];
        const float mag = __expf((float)k * lr * step); float c, s; sincos_red((float)k * (li * step), c, s); pw[i] = (f32x2){mag * c, mag * s}; }
    __syncthreads();
    for (int i = tid; i < 64 * 16; i += 512) { const int p = i >> 4; const float lr = lre[(d * 64 + g) * 64 + p], li = lim[(d * 64 + g) * 64 + p];
        const f32x2 lb = pw[64 + p]; const float inv = 1.f / (lr * lr + li * li);
        const f32x2 kap = {((lb.x - 1.f) * lr + lb.y * li) * inv, (lb.y * lr - (lb.x - 1.f) * li) * inv};
        const size_t o = ((size_t)(d * 64 + g) * 64 + p) * 16 + (i & 15); bb[i] = cmul(kap, (f32x2){bre[o], bim[o]}); }
    for (int i = tid; i < 16 * 64; i += 512) { const size_t o = (size_t)(d * 64 + g) * 1024 + i; cm[i] = (f32x2){cre[o], cim[o]}; }
    __syncthreads();
    if (tid < 64) { const f32x2 l32 = pw[32 * 64 + tid]; LAMT[((d * 64 + g) * 64 + tid) * 2] = l32.x; LAMT[((d * 64 + g) * 64 + tid) * 2 + 1] = l32.y; }
    { const int k = tid >> 4, ib = (tid >> 2) & 3, jb = tid & 3; float acc[4][4];
#pragma unroll
      for (int x = 0; x < 4; ++x)
#pragma unroll
        for (int y = 0; y < 4; ++y) acc[x][y] = 0.f;
      for (int p = 0; p < 64; ++p) { const f32x2 w = pw[k * 64 + p]; f32x2 t[4], b[4];
#pragma unroll
        for (int x = 0; x < 4; ++x) { t[x] = cmul(cm[(4 * ib + x) * 64 + p], w); b[x] = bb[p * 16 + 4 * jb + x]; }
#pragma unroll
        for (int x = 0; x < 4; ++x)
#pragma unroll
            for (int y = 0; y < 4; ++y) acc[x][y] += t[x].x * b[y].x - t[x].y * b[y].y; }
#pragma unroll
      for (int x = 0; x < 4; ++x) *(f32x4*)(KD + k * 256 + (4 * ib + x) * 16 + 4 * jb) = (f32x4){acc[x][0], acc[x][1], acc[x][2], acc[x][3]}; }
    for (int o = tid; o < 512 * 64; o += 512) { const int n = o >> 6, p = o & 63, to = n >> 4, i = n & 15;
        const f32x2 w = cmul(cm[i * 64 + p], pw[(d == 0 ? to + 1 : 32 - to) * 64 + p]);
        *(unsigned*)(BTY + (size_t)n * 768 + 512 + 128 * d + 2 * p) = cvt_pk_bf16(w.x, -w.y); }
    for (int o = tid; o < 64 * 256; o += 512) { const int p = o >> 8, kk = (o & 255) * 2, ti = kk >> 4, j = kk & 15;
        const f32x2 pwv = pw[(d == 0 ? 31 - ti : ti) * 64 + p]; const f32x2 v0 = cmul(pwv, bb[p * 16 + j]), v1 = cmul(pwv, bb[p * 16 + j + 1]);
        *(unsigned*)(BTS + (size_t)(128 * d + 2 * p) * 512 + kk) = cvt_pk_bf16(v0.x, v1.x); *(unsigned*)(BTS + (size_t)(128 * d + 2 * p + 1) * 512 + kk) = cvt_pk_bf16(v0.y, v1.y); }
    __syncthreads();
}
__device__ __forceinline__ void s5_tables_phase(const Args& a, Frame& F) { for (int u = F.vcu; u < 128; u += F.G) s5_tables_unit(a, F, u >> 1, u & 1); }
__device__ __forceinline__ void s5_toeplitz_phase(const Args& a, Frame& F) {
    unsigned char* const wsl = opaque_ptr(a.ws);
    const int tid = opaque_tid(); LAS float* Kd = (LAS float*)F.lds; const float* dsk = inp(F, 20);
    for (int u = F.vcu; u < 256; u += F.G) { const int g = u >> 2, q = u & 3;
        const float* KD = (const float*)(wsl + WS_KD) + (size_t)g * 16384; bf16_t* BTY = (bf16_t*)(wsl + WS_BTY) + (size_t)g * 512 * 768;
        __syncthreads();
        for (int i = tid; i < 4096; i += 512) *(f32x4*)(Kd + 4 * i) = *(const f32x4*)(KD + 4 * i);
        __syncthreads();
        for (int o = tid; o < 128 * 256; o += 512) { const int n = 128 * q + (o >> 8), kk = (o & 255) * 2, to = n >> 4, i = n & 15, ti = kk >> 4, j = kk & 15;
            float v0, v1;
            if (to > ti) { v0 = Kd[(to - ti) * 256 + i * 16 + j]; v1 = Kd[(to - ti) * 256 + i * 16 + j + 1]; }
            else if (to < ti) { v0 = Kd[8192 + (ti - to) * 256 + i * 16 + j]; v1 = Kd[8192 + (ti - to) * 256 + i * 16 + j + 1]; }
            else { v0 = Kd[i * 16 + j] + Kd[8192 + i * 16 + j] + (i == j ? dsk[g * 16 + i] : 0.f); v1 = Kd[i * 16 + j + 1] + Kd[8192 + i * 16 + j + 1] + (i == j + 1 ? dsk[g * 16 + i] : 0.f); }
            *(unsigned*)(BTY + (size_t)n * 768 + kk) = cvt_pk_bf16(v0, v1); }
    }
    __syncthreads();
}

struct SUnit { int g, pm, pn; };
struct PolS5S {
    static constexpr bool PERM = false, GATHER = false, TWOSEG = false;
    static constexpr int NT = 8, KT0 = 8, KS0 = 8192, KS1 = 128, LDB = 1024;
    typedef SUnit Unit;
    const char* XN; const char* BTS; float* S; int G, c;
    __device__ __forceinline__ bool next(int i, Unit& u) const { const int L = i * G + c; u.g = __builtin_amdgcn_readfirstlane(L / 5); u.pm = __builtin_amdgcn_readfirstlane(L % 5); u.pn = 0; return L < 320; }
    __device__ __forceinline__ void ctx(const Unit& u, pg8::UCtx<false>& x, const int (&)[2], const int (&)[2]) const {
        if (u.pm < 4) { x.a0[0] = XN + ((size_t)NCTXR + (size_t)u.pm * 256 * S5_T) * 2048 + u.g * 32; x.a0[1] = x.a0[0] + (size_t)128 * S5_T * 2048; }
        else { x.a0[0] = XN + u.g * 32; x.a0[1] = x.a0[0]; }
        x.a1[0] = x.a0[0]; x.a1[1] = x.a0[1]; x.b = BTS + (size_t)u.g * 256 * LDB;
    }
    __device__ __forceinline__ unsigned lane_a0(int R, int C) const { return (unsigned)(R * (S5_T * 2048) + (C >> 4) * 2048 + (C & 15) * 2); }
    __device__ __forceinline__ unsigned lane_a1(int, int) const { return 0u; }
    __device__ __forceinline__ void epi(const f32x4 (&acc)[2][2][4][2], const Unit& u, int wr, int wc, int fr, int fq) const {
#pragma unroll
        for (int ai = 0; ai < 2; ++ai) { if (u.pm == 4 && ai == 1) continue;
#pragma unroll
            for (int m = 0; m < 4; ++m) { const int r = u.pm * 256 + ai * 128 + wr * 64 + m * 16 + fr;
                float* sp = S + ((size_t)u.g * 1152 + r) * 256 + wc * 32 + 4 * fq;
#pragma unroll
                for (int bj = 0; bj < 2; ++bj)
#pragma unroll
                    for (int n = 0; n < 2; ++n) *(f32x4*)(sp + bj * 128 + n * 16) = acc[ai][bj][m][n]; } }
    }
};
__device__ __forceinline__ void s5_scan_phase(const Args& a, Frame& F) {
    unsigned char* const wsl = opaque_ptr(a.ws);
    const int tid = opaque_tid(); const float* S = (const float*)(wsl + WS_S); bf16_t* XIN = (bf16_t*)(wsl + WS_XIN); const float* LAMT = (const float*)(wsl + WS_LAMT);
    for (int idx = F.vcu * 512 + tid; idx < 64 * 16 * 2 * 64; idx += F.G * 512) {
        const int p = idx & 63, d = (idx >> 6) & 1, b = (idx >> 7) & 15, g = idx >> 11;
        const f32x2 Lm = *(const f32x2*)(LAMT + ((d * 64 + g) * 64 + p) * 2);
        const float* Sg = S + (size_t)g * 1152 * 256 + d * 128 + 2 * p; const int col = d * 128 + 2 * p; bf16_t* Xg = XIN + (size_t)(col >> 4) * 1024 + 16 * g + (col & 15);
        f32x2 x = {0.f, 0.f};
        f32x2 sv[8];
#pragma unroll
        for (int k = 0; k < 8; ++k) { const int c = d == 0 ? k : 7 - k; sv[k] = *(const f32x2*)(Sg + (size_t)(1024 + b * 8 + c) * 256); }
#pragma unroll
        for (int k = 0; k < 8; ++k) x = cmul(Lm, x) + sv[k];
        for (int c0 = 0; c0 < 64; c0 += 8) {
#pragma unroll
            for (int k = 0; k < 8; ++k) { const int c = d == 0 ? c0 + k : 63 - c0 - k; sv[k] = *(const f32x2*)(Sg + (size_t)(b * 64 + c) * 256); }
#pragma unroll
            for (int k = 0; k < 8; ++k) { const int c = d == 0 ? c0 + k : 63 - c0 - k; *(unsigned*)(Xg + (size_t)(b * 64 + c) * 32 * 1024) = cvt_pk_bf16(x.x, x.y); x = cmul(Lm, x) + sv[k]; }
        }
    }
}
struct PolS5Y {
    static constexpr bool PERM = true, GATHER = false, TWOSEG = true;
    static constexpr int NT = 12, KT0 = 8, KS0 = 8192, KS1 = 8192, LDB = 1536;
    typedef SUnit Unit;
    const char* XN; const char* XIN; const char* BTY; bf16_t* Gb; int G, c;
    __device__ __forceinline__ bool next(int i, Unit& u) const { const int L = i * G + c; u.g = __builtin_amdgcn_readfirstlane(L >> 3); u.pm = __builtin_amdgcn_readfirstlane((L >> 1) & 3); u.pn = L & 1; return L < 512; }
    __device__ __forceinline__ void ctx(const Unit& u, pg8::UCtx<false>& x, const int (&)[2], const int (&)[2]) const {
        x.a0[0] = XN + ((size_t)NCTXR + (size_t)u.pm * 256 * S5_T) * 2048 + u.g * 32; x.a0[1] = x.a0[0] + (size_t)128 * S5_T * 2048;
        x.a1[0] = XIN + (size_t)u.pm * 256 * S5_T * 2048 + u.g * 32; x.a1[1] = x.a1[0] + (size_t)128 * S5_T * 2048;
        x.b = BTY + ((size_t)u.g * 512 + u.pn * 256) * LDB;
    }
    __device__ __forceinline__ unsigned lane_a0(int R, int C) const { return (unsigned)(R * (S5_T * 2048) + (C >> 4) * 2048 + (C & 15) * 2); }
    __device__ __forceinline__ void epi(const f32x4 (&acc)[2][2][4][2], const Unit& u, int wr, int wc, int fr, int fq) const {
#pragma unroll
        for (int ai = 0; ai < 2; ++ai)
#pragma unroll
            for (int m = 0; m < 4; ++m) { const int r = u.pm * 256 + ai * 128 + wr * 64 + m * 16 + fr;
#pragma unroll
                for (int bj = 0; bj < 2; ++bj) { const int col = u.pn * 256 + bj * 128 + wc * 32 + 8 * fq, to = col >> 4, i0 = col & 15;
                    bf16_t* gp = Gb + ((size_t)r * S5_T + to) * DM + u.g * 16 + i0;
#pragma unroll
                    for (int n = 0; n < 2; ++n) { f32x4 v;
#pragma unroll
                        for (int j = 0; j < 4; ++j) v[j] = gelu_tanh(acc[ai][bj][m][n][j]);
                        u32x2 w; w.x = cvt_pk_bf16(v[0], v[1]); w.y = cvt_pk_bf16(v[2], v[3]); *(u32x2*)(gp + 4 * n) = w; asm volatile("" ::: "memory"); } } }
    }
};
struct PolGlu : DenseRow0<16, 2048, true> {
    bf16_t* OO; float* SSQO; const float* bias;
    __device__ __forceinline__ void epi(const f32x4 (&acc)[2][2][4][2], const DUnit& u, int wr, int wc, int fr, int fq) const {
        const int c0 = u.pn * 128 + wc * 32 + 8 * fq;
        const f32x4 b10 = *(const f32x4*)(bias + c0), b11 = *(const f32x4*)(bias + c0 + 4), b20 = *(const f32x4*)(bias + 1024 + c0), b21 = *(const f32x4*)(bias + 1024 + c0 + 4);
#pragma unroll
        for (int ai = 0; ai < 2; ++ai)
#pragma unroll
            for (int m = 0; m < 4; ++m) {
                const int row = row0 + u.pm * 256 + ai * 128 + wr * 64 + m * 16 + fr;
                f32x4 o0, o1;
#pragma unroll
                for (int j = 0; j < 4; ++j) { o0[j] = (acc[ai][0][m][0][j] + b10[j]) * sigmoid_f(acc[ai][1][m][0][j] + b20[j]); o1[j] = (acc[ai][0][m][1][j] + b11[j]) * sigmoid_f(acc[ai][1][m][1][j] + b21[j]); }
                float s = sq4(o0) + sq4(o1);
                store8(OO + (size_t)row * DM + c0, o0, o1);
                s += __shfl_xor(s, 16); s += __shfl_xor(s, 32);
                if (fq == 0) SSQO[(size_t)row * 32 + u.pn * 4 + wc] = s;
            }
    }
};
#ifndef REP_ATTN
#define REP_ATTN 1
#endif
#ifndef REP_MISC
#define REP_MISC 1
#endif
#ifndef REP_DENSE
#define REP_DENSE 1
#endif
#ifndef REP_G2A
#define REP_G2A 1
#endif
#ifndef REP_P11X
#define REP_P11X 1
#endif
#ifndef REP_PM0
#define REP_PM0 1
#endif
#ifndef REP_H
#define REP_H 1
#endif
#ifndef REP_G1
#define REP_G1 1
#endif
__device__ __forceinline__ void moe_stage(const Args& args, Frame& F, const XcdBarrier& bar, int layer, int row_lo) {
    const int nrows = NROWS - row_lo, tpb = nrows / F.G;
    {   unsigned char* ws = opaque_ptr(args.ws);
        PolShr p; p.A = (const char*)(ws + WS_XN) + (size_t)row_lo * 2048; p.Bt = (const char*)(ws + WS_WSHR) + (size_t)layer * 768 * 2048; p.nM = nrows / 256; p.nN = 3; p.G = F.G; p.c = (int)blockIdx.x;
        p.row0 = row_lo; p.HSH = (bf16_t*)(ws + WS_HSH); p.LOG = (float*)(ws + WS_LOG);
        for (int rep_ = 0; rep_ < REP_DENSE; ++rep_) pg8::gemm_phase(F.lds, p);
    }
    if (layer == 1 && args.stage == 7) return;
    xcd_barrier(bar);
    route_phase(args, F, layer, row_lo, tpb);
#if REP_MISC == 2
    __syncthreads(); route_phase(args, F, layer, row_lo, tpb);
#endif
    if (layer == 1 && args.stage == 8) return;
    xcd_barrier(bar);
    place_phase(args, F, row_lo, tpb);
#if REP_MISC == 2
    __syncthreads(); place_phase(args, F, row_lo, tpb);
#endif
    if (layer == 1 && args.stage == 9) return;
    xcd_barrier(bar);
    const int* TINFO = (const int*)(opaque_ptr(args.ws) + WS_TINFO);
    const int ts0 = __builtin_amdgcn_readfirstlane(TINFO[0]), ts1 = __builtin_amdgcn_readfirstlane(TINFO[64]), ts2 = __builtin_amdgcn_readfirstlane(TINFO[128]), ts3 = __builtin_amdgcn_readfirstlane(TINFO[192]);
#define MOE_G1(TA, TB, HBUF) for (int rep_ = 0; rep_ < REP_G1; ++rep_) do { unsigned char* ws = opaque_ptr(args.ws); PolMoe1 p; p.XN = (const char*)(ws + WS_XN); p.W1 = (const char*)(ws + WS_W1); p.H = (bf16_t*)(ws + (HBUF)); p.TINFO = (const int*)(ws + WS_TINFO); p.LDST = (const int*)(ws + WS_LDST); p.T0 = (TA); p.T1 = (TB); p.G = F.G; p.c = (int)blockIdx.x; \
        pg8::gemm_phase(F.lds, p); } while (0)
#define MOE_G2(RMW, TA, TB, HBUF) do { unsigned char* ws = opaque_ptr(args.ws); PolMoe2<RMW> p; p.H = (const char*)(ws + (HBUF)); p.W2 = (const char*)(ws + WS_W2); p.Y = (unsigned char*)(ws + WS_Y); p.TINFO = (const int*)(ws + WS_TINFO); p.LDST = (const int*)(ws + WS_LDST); p.LW = (const float*)(ws + WS_LW); p.T0 = (TA); p.T1 = (TB); p.G = F.G; p.c = (int)blockIdx.x; \
        pg8::gemm_phase(F.lds, p); } while (0)
    MOE_G1(ts0, ts1, WS_H0);
    if (layer == 1 && args.stage == 10) return;
    xcd_barrier(bar);
#define MOE_SHD() do { unsigned char* ws = opaque_ptr(args.ws); PolShd p; p.A = (const char*)(ws + WS_HSH) + (size_t)row_lo * 512; p.Bt = (const char*)(ws + WS_WSHD) + (size_t)layer * 1024 * 512; p.nM = nrows / 256; p.nN = 4; p.G = F.G; p.c = (int)blockIdx.x; \
        p.row0 = row_lo; p.Y = (unsigned char*)(ws + WS_Y); pg8::gemm_phase(F.lds, p); } while (0)
#if REP_G2A == 2
    MOE_G2(false, ts0, ts1, WS_H0); MOE_SHD();
#endif
    if (blockIdx.x & 1) { MOE_G1(ts1, ts2, WS_H1); MOE_G2(false, ts0, ts1, WS_H0); MOE_SHD(); }
    else { MOE_G2(false, ts0, ts1, WS_H0); MOE_SHD(); MOE_G1(ts1, ts2, WS_H1); }
    if (layer == 1 && args.stage == 11) return;
    xcd_barrier(bar);
    if (blockIdx.x & 1) { MOE_G1(ts2, ts3, WS_H0); MOE_G2(true, ts1, ts2, WS_H1); }
    else { MOE_G2(true, ts1, ts2, WS_H1); MOE_G1(ts2, ts3, WS_H0); }
    if (layer == 1 && args.stage == 12) return;
    xcd_barrier(bar);
    MOE_G2(true, ts2, ts3, WS_H0);
    if (layer == 1 && args.stage == 13) return;
    xcd_barrier(bar);
    if (layer == 0) { s5_tables_phase(args, F); convert_experts(args, F, 1, 0); }
#if REP_P11X == 2
    __syncthreads();
    if (layer == 0) { s5_tables_phase(args, F); convert_experts(args, F, 1, 0); }
#endif
    combine_phase(args, F, layer, row_lo);
#undef MOE_SHD
#undef MOE_G1
#undef MOE_G2
}

__global__ void __launch_bounds__(NWAVES * 64, 2) trunk_fwd(Args args) {
    extern __shared__ __attribute__((aligned(16))) unsigned char lds_raw[];
    Frame F;
    F.lds = (LAS unsigned char*)lds_raw;
    F.G = gridDim.x; { const int bx = blockIdx.x; F.vcu = (F.G % 8 == 0) ? (bx % 8) * (F.G / 8) + bx / 8 : bx; }
    F.ws = args.ws;
    volatile LAS unsigned* MISC = (volatile LAS unsigned*)(F.lds + LDSCTL_OFF);
    for (int u = threadIdx.x; u < (LDS_BYTES - LDSCTL_OFF) / 4; u += NWAVES * 64) ((LAS unsigned*)(F.lds + LDSCTL_OFF))[u] = 0u;
    __syncthreads();
    if (threadIdx.x < 31) ((LAS unsigned long long*)(F.lds + PTAB_OFF))[threadIdx.x] = (unsigned long long)args.in[threadIdx.x];
    __syncthreads();
    XcdBarrier bar = xcd_barrier_post((unsigned*)(args.ws + WS_CTL) + CW_BAR, MISC + 8);
#define GRID_BAR() xcd_barrier(bar)

    mod_phase(args, F);
    __syncthreads();
    convert_small(args, F);
    rope_phase(args, F);
    convert_experts(args, F, 0, 0);
#if REP_MISC == 2
    __syncthreads();
    mod_phase(args, F);
    __syncthreads();
    convert_small(args, F);
    rope_phase(args, F);
    convert_experts(args, F, 0, 0);
#endif
    GRID_BAR();
    h_phase(args, F, 0, 0);
#if REP_H == 2
    h_phase(args, F, 0, 0);
#endif
    GRID_BAR();
    {   unsigned char* ws = opaque_ptr(args.ws);
        PolDqkv p; p.A = (const char*)(ws + WS_XN); p.Bt = (const char*)(ws + WS_WDQKV); p.nM = NROWS / 256; p.nN = 3; p.G = F.G; p.c = (int)blockIdx.x;
        p.A1 = (bf16_t*)(ws + WS_A1); p.SSQ1 = (float*)(ws + WS_SSQ1); p.KPE = (bf16_t*)(ws + WS_KPE); p.ROPE = (const float*)(ws + WS_ROPE);
        for (int rep_ = 0; rep_ < REP_DENSE; ++rep_) pg8::gemm_phase(F.lds, p);
    }
    GRID_BAR();
    {   unsigned char* ws = opaque_ptr(args.ws);
        PolQup p; p.A = (const char*)(ws + WS_A1); p.Bt = (const char*)(ws + WS_WUQ); p.nM = NROWS / 256; p.nN = NQ / 256; p.G = F.G; p.c = (int)blockIdx.x;
        p.Q = (bf16_t*)(ws + WS_Q); p.SSQ1 = (const float*)(ws + WS_SSQ1);
        for (int rep_ = 0; rep_ < REP_DENSE; ++rep_) pg8::gemm_phase(F.lds, p);
    }
    {   unsigned char* ws = opaque_ptr(args.ws);
        PolKVup p; p.A = (const char*)(ws + WS_A1) + QLORA * 2; p.Bt = (const char*)(ws + WS_WUKV); p.nM = NROWS / 256; p.nN = NKV / 256; p.G = F.G; p.c = (int)blockIdx.x;
        p.KV = (bf16_t*)(ws + WS_KV); p.SSQ1 = (const float*)(ws + WS_SSQ1);
        for (int rep_ = 0; rep_ < REP_DENSE; ++rep_) pg8::gemm_phase(F.lds, p);
    }
    GRID_BAR();
    {   unsigned char* ws = opaque_ptr(args.ws);
        const bf16_t* Qg = (const bf16_t*)(ws + WS_Q); const bf16_t* KVb = (const bf16_t*)(ws + WS_KV); const bf16_t* KPE = (const bf16_t*)(ws + WS_KPE); bf16_t* Og = (bf16_t*)(ws + WS_O); const float* RP = (const float*)(ws + WS_ROPE);
        for (int rep_ = 0; rep_ < REP_ATTN; ++rep_)
        for (int u = F.vcu; u < 1024 + 128; u += F.G) {
            if (u < 1024) { const int bh = u >> 3, qb = u & 7, b = bh >> 3, h = bh & 7;
                attn::attn_unit(Qg, KVb, KPE, Og, RP, NCTXR + b * SEQL + qb * 256, qb * 256, h, b * NCTX, NCTXR + b * SEQL, 36, (char*)lds_raw); }
            else { const int bh = u - 1024, b = bh >> 3, h = bh & 7;
                attn::attn_unit(Qg, KVb, KPE, Og, RP, b * NCTX, -1, h, b * NCTX, 0, 4, (char*)lds_raw); }
        }
    }
    GRID_BAR();
    {   unsigned char* ws = opaque_ptr(args.ws);
        PolWo p; p.A = (const char*)(ws + WS_O); p.Bt = (const char*)(ws + WS_WO); p.nM = NROWS / 256; p.nN = 4; p.G = F.G; p.c = (int)blockIdx.x;
        p.OO = (bf16_t*)(ws + WS_OO); p.SSQO = (float*)(ws + WS_SSQO);
        for (int rep_ = 0; rep_ < REP_DENSE; ++rep_) pg8::gemm_phase(F.lds, p);
    }
    GRID_BAR();
    postmix_phase(args, F, 0, 0, 16);
#if REP_PM0 == 2
    postmix_phase(args, F, 0, 0, 16);
#endif
    GRID_BAR();
    moe_stage(args, F, bar, 0, 0);
    if (args.stage == 1) return;
    GRID_BAR();
    {   unsigned char* ws = opaque_ptr(args.ws);
        PolS5S p; p.XN = (const char*)(ws + WS_XN); p.BTS = (const char*)(ws + WS_BTS); p.S = (float*)(ws + WS_S); p.G = F.G; p.c = (int)blockIdx.x;
        for (int rep_ = 0; rep_ < REP_DENSE; ++rep_) pg8::gemm_phase(F.lds, p);
    }
    if (args.stage == 2) return;
    GRID_BAR();
    s5_toeplitz_phase(args, F);
    s5_scan_phase(args, F);
#if REP_MISC == 2
    s5_scan_phase(args, F);
#endif
    if (args.stage == 3) return;
    GRID_BAR();
    {   unsigned char* ws = opaque_ptr(args.ws);
        PolS5Y p; p.XN = (const char*)(ws + WS_XN); p.XIN = (const char*)(ws + WS_XIN); p.BTY = (const char*)(ws + WS_BTY); p.Gb = (bf16_t*)(ws + WS_G); p.G = F.G; p.c = (int)blockIdx.x;
        for (int rep_ = 0; rep_ < REP_DENSE; ++rep_) pg8::gemm_phase(F.lds, p);
    }
    if (args.stage == 4) return;
    GRID_BAR();
    {   unsigned char* ws = opaque_ptr(args.ws);
        PolGlu p; p.A = (const char*)(ws + WS_G); p.Bt = (const char*)(ws + WS_WGLU); p.nM = NLATR / 256; p.nN = 8; p.G = F.G; p.c = (int)blockIdx.x;
        p.row0 = NCTXR; p.OO = (bf16_t*)(ws + WS_OO); p.SSQO = (float*)(ws + WS_SSQO); p.bias = inp(F, 22);
        for (int rep_ = 0; rep_ < REP_DENSE; ++rep_) pg8::gemm_phase(F.lds, p);
    }
    if (args.stage == 5) return;
    GRID_BAR();
    postmix_phase(args, F, 1, NCTXR, 32);
    if (args.stage == 6) return;
    GRID_BAR();
    moe_stage(args, F, bar, 1, NCTXR);
}

#ifndef DBG_STAGE
#define DBG_STAGE 0
#endif
extern "C" void kernel_launch(void* const* d_in, const int* in_sizes, int n_in, void* d_out, int out_size, void* d_ws, size_t ws_size, hipStream_t stream) {
    static int grid = 0;
    if (grid == 0) {
        if (n_in != 31 || out_size != NLATR * DM || ws_size < WS_END) { fprintf(stderr, "kernel_launch: unexpected shapes (n_in %d out %d ws %zu)\n", n_in, out_size, ws_size); grid = -1; return; }
        int dev = 0, cus = 0;
        if (hipGetDevice(&dev) != hipSuccess || hipDeviceGetAttribute(&cus, hipDeviceAttributeMultiprocessorCount, dev) != hipSuccess) { grid = -1; return; }
        if (hipFuncSetAttribute((const void*)trunk_fwd, hipFuncAttributeMaxDynamicSharedMemorySize, LDS_BYTES) != hipSuccess) { fprintf(stderr, "kernel_launch: hipFuncSetAttribute failed\n"); grid = -1; return; }
        (void)hipGetLastError();
        grid = cus;
    }
    if (grid < 0) return;
    (void)hipMemsetAsync((char*)d_ws + WS_CTL, 0, CTL_BYTES, stream);
    Args a{};
    for (int i = 0; i < 31; ++i) a.in[i] = (const float*)d_in[i];
    a.out = (float*)d_out; a.ws = (unsigned char*)d_ws; a.stage = DBG_STAGE; a.pad = 0;
    hipLaunchKernelGGL(trunk_fwd, dim3(grid), dim3(NWAVES * 64), LDS_BYTES, stream, a);
}
```

```cpp
#include <hip/hip_runtime.h>
#include <cstdio>
#include <cstdint>

#define GAS __attribute__((address_space(1)))
#define LAS __attribute__((address_space(3)))
typedef unsigned short bf16_t;
typedef short bf16x8 __attribute__((ext_vector_type(8)));
typedef short s16x4 __attribute__((ext_vector_type(4)));
typedef float f32x2 __attribute__((ext_vector_type(2)));
typedef float f32x4 __attribute__((ext_vector_type(4)));
typedef float f32x16 __attribute__((ext_vector_type(16)));
typedef unsigned u32x2 __attribute__((ext_vector_type(2)));
typedef unsigned u32x4 __attribute__((ext_vector_type(4)));

constexpr int DM = 1024, NBATCH = 16, SEQL = 2048, NCTX = 256;
constexpr int NCTXR = NBATCH * NCTX;
constexpr int NLATR = NBATCH * SEQL;
constexpr int NROWS = NCTXR + NLATR;
constexpr int NHEAD = 8, QLORA = 384, KVLORA = 256, NOPE = 128, ROPED = 64, VDIM = 128;
constexpr int NDQKV = 768;
constexpr int NQ = NHEAD * (NOPE + ROPED);
constexpr int NKV = NHEAD * (NOPE + VDIM);
constexpr int NEXP = 64, TOPK = 8, DEXP = 256;
constexpr float NORM_EPS = 1e-6f;
constexpr int NMOD = 6, MODW = NMOD * DM;

constexpr size_t MiB = 1u << 20;
constexpr size_t WS_CTL = 0, CTL_BYTES = 1 * MiB;
constexpr size_t WS_WDQKV = 1 * MiB;
constexpr size_t WS_WUQ   = WS_WDQKV + 1536 * 1024;
constexpr size_t WS_WUKV  = WS_WUQ + 1280 * 1024;
constexpr size_t WS_WO    = WS_WUKV + 1 * MiB;
constexpr size_t WS_WGLU  = WS_WO + 2 * MiB;
constexpr size_t WS_WSHR  = WS_WGLU + 4 * MiB;
constexpr size_t WS_WSHD  = WS_WSHR + 3 * MiB;
constexpr size_t WS_MOD   = 15 * MiB;
constexpr size_t WS_ROPE  = 16 * MiB;
constexpr size_t WS_W1    = 17 * MiB;
constexpr size_t WS_W2    = 81 * MiB;
constexpr size_t WS_XCTX  = 113 * MiB;
constexpr size_t WS_XN    = 129 * MiB;
constexpr size_t WS_ST    = 201 * MiB;
static_assert(WS_WSHD + 1 * MiB <= WS_MOD, "small weights fit");
constexpr size_t WS_KV   = WS_ST;
constexpr size_t WS_Q    = WS_ST + 144 * MiB;
constexpr size_t WS_OO   = WS_Q;
constexpr size_t WS_A1   = WS_ST + 252 * MiB;
constexpr size_t WS_O    = WS_A1;
constexpr size_t WS_KPE  = WS_ST + 324 * MiB;
constexpr size_t WS_SSQ1 = WS_ST + 329 * MiB;
constexpr size_t WS_SSQO = WS_ST + 332 * MiB;
constexpr size_t WS_END  = WS_ST + 402 * MiB;

constexpr int CW_BAR = 4096;

__device__ __forceinline__ unsigned cvt_pk_bf16(float lo, float hi) { unsigned r; asm volatile("v_cvt_pk_bf16_f32 %0, %1, %2" : "=v"(r) : "v"(lo), "v"(hi)); return r; }
__device__ __forceinline__ float bf_lo(unsigned w) { return __uint_as_float(w << 16); }
__device__ __forceinline__ float bf_hi(unsigned w) { return __uint_as_float(w & 0xffff0000u); }
__device__ __forceinline__ float wave_sum(float v) {
#pragma unroll
    for (int o = 1; o < 64; o <<= 1) v += __shfl_xor(v, o);
    return v;
}
__device__ __forceinline__ float silu_f(float v) { return v * __builtin_amdgcn_rcpf(1.f + __builtin_amdgcn_exp2f(-1.4426950408889634f * v)); }
__device__ __forceinline__ float sigmoid_f(float v) { return __builtin_amdgcn_rcpf(1.f + __builtin_amdgcn_exp2f(-1.4426950408889634f * v)); }
__device__ __forceinline__ int mod_index(int row) { return row < NCTXR ? 16 : (row - NCTXR) / SEQL; }
__device__ __forceinline__ int opaque_tid() { int t = threadIdx.x; asm volatile("" : "+v"(t)); return t; }
__device__ __forceinline__ float gelu_tanh(float v) {
    const float z = 0.7978845608028654f * (v + 0.044715f * v * v * v);
    return v * __builtin_amdgcn_rcpf(1.f + __builtin_amdgcn_exp2f(-2.8853900817779268f * z));
}
__device__ __forceinline__ unsigned char* opaque_ptr(unsigned char* p) {
    unsigned lo = __builtin_amdgcn_readfirstlane((unsigned)(unsigned long long)p), hi = __builtin_amdgcn_readfirstlane((unsigned)((unsigned long long)p >> 32));
    asm volatile("" : "+s"(lo), "+s"(hi)); return (unsigned char*)(((unsigned long long)hi << 32) | lo); }
constexpr float Y_SCALE = 64.f, Y_INV = 1.f / 64.f, Y_MAX = 448.f;
__device__ __forceinline__ unsigned fp8_pack4(const f32x4& v) {
    const float a = fminf(fmaxf(v[0] * Y_SCALE, -Y_MAX), Y_MAX), b = fminf(fmaxf(v[1] * Y_SCALE, -Y_MAX), Y_MAX), c = fminf(fmaxf(v[2] * Y_SCALE, -Y_MAX), Y_MAX), d = fminf(fmaxf(v[3] * Y_SCALE, -Y_MAX), Y_MAX);
    int p = __builtin_amdgcn_cvt_pk_fp8_f32(a, b, 0, false); p = __builtin_amdgcn_cvt_pk_fp8_f32(c, d, p, true); return (unsigned)p; }
__device__ __forceinline__ f32x4 fp8_unpack4(unsigned w) {
    const f32x2 lo = __builtin_amdgcn_cvt_pk_f32_fp8((int)w, false), hi = __builtin_amdgcn_cvt_pk_f32_fp8((int)w, true);
    return (f32x4){lo.x * Y_INV, lo.y * Y_INV, hi.x * Y_INV, hi.y * Y_INV}; }
#define XB_TMO      128
#define XB_XCNT(j)  (256  + 64 * (j))
#define XB_XSUB(j)  (1280 + 64 * (j))
#define XB_XGEN(j)  (2304 + 64 * (j))
#define XB_TOP      3328
#define XB_TOPGEN   3392
#define XCD_BAR_WORDS 3456
#define XB_SPIN_CAP (1u << 18)
__device__ __forceinline__ unsigned xb_ld(unsigned* p)              { return __hip_atomic_load(p, __ATOMIC_RELAXED, __HIP_MEMORY_SCOPE_AGENT); }
__device__ __forceinline__ unsigned xb_add(unsigned* p, unsigned v) { return __hip_atomic_fetch_add(p, v, __ATOMIC_RELAXED, __HIP_MEMORY_SCOPE_AGENT); }
__device__ __forceinline__ unsigned xb_xcc_id() { return (unsigned)__builtin_amdgcn_s_getreg((3 << 11) | 20) & 0xFu; }
#define XB_SPIN(cond, bar) do { unsigned _sp = 0; while (cond) { __builtin_amdgcn_s_sleep(1); \
    if ((++_sp & 255u) == 0u) { if (xb_ld(&(bar)[XB_TMO])) break; if (_sp > XB_SPIN_CAP) { atomicAdd(&(bar)[XB_TMO], 1u); break; } } } } while (0)
struct XcdBarrier { unsigned* bar; unsigned x; volatile LAS unsigned* st; };
__device__ __forceinline__ XcdBarrier xcd_barrier_post(unsigned* bar, volatile LAS unsigned* st) {
    XcdBarrier b; b.bar = bar; b.x = xb_xcc_id(); b.st = st;
    if (threadIdx.x == 0) (void)xb_add(&bar[XB_XCNT(b.x)], 1u);
    return b;
}
__device__ __forceinline__ void xcd_barrier_complete(unsigned* bar, unsigned x, unsigned& nloc, unsigned& nx) {
    const unsigned G = gridDim.x * gridDim.y * gridDim.z;
    unsigned sum, cnt, mine, sp = 0u;
    for (;;) {
        sum = 0u; cnt = 0u; mine = 0u;
#pragma unroll
        for (unsigned j = 0; j < 16; ++j) { const unsigned c = xb_ld(&bar[XB_XCNT(j)]); sum += c; cnt += (c > 0u) ? 1u : 0u; mine = (j == x) ? c : mine; }
        if (sum == G) break;
        __builtin_amdgcn_s_sleep(1);
        if ((++sp & 255u) == 0u) { if (xb_ld(&bar[XB_TMO])) break; if (sp > XB_SPIN_CAP) { atomicAdd(&bar[XB_TMO], 1u); break; } }
    }
    nloc = mine > 0u ? mine : 1u; nx = cnt > 0u ? cnt : 1u;
}
__device__ __forceinline__ void xcd_barrier(const XcdBarrier& b) {
    asm volatile("s_waitcnt vmcnt(0)" ::: "memory");
    __syncthreads();
    if (threadIdx.x == 0) {
        unsigned* bar = b.bar;
        __builtin_amdgcn_s_waitcnt(0);
        unsigned nloc = b.st[0], nx = b.st[1];
        if (nloc == 0u) { xcd_barrier_complete(bar, b.x, nloc, nx); b.st[0] = nloc; b.st[1] = nx; }
        const unsigned old = xb_add(&bar[XB_XSUB(b.x)], 1u);
        const unsigned gen = old / nloc;
        if (old + 1u == (gen + 1u) * nloc) {
            __builtin_amdgcn_fence(__ATOMIC_RELEASE, "agent");
            asm volatile("s_waitcnt vmcnt(0)" ::: "memory");
            const unsigned og = xb_add(&bar[XB_TOP], 1u);
            const unsigned tg = og / nx;
            if (og + 1u == (tg + 1u) * nx) xb_add(&bar[XB_TOPGEN], 1u);
            else XB_SPIN(xb_ld(&bar[XB_TOPGEN]) == tg, bar);
            __builtin_amdgcn_fence(__ATOMIC_ACQUIRE, "agent");
            xb_add(&bar[XB_XGEN(b.x)], 1u);
            asm volatile("s_waitcnt vmcnt(0)" ::: "memory");
        } else {
            XB_SPIN(xb_ld(&bar[XB_XGEN(b.x)]) == gen, bar);
            __builtin_amdgcn_fence(__ATOMIC_ACQUIRE, "agent");
            asm volatile("s_waitcnt vmcnt(0)" ::: "memory");
        }
    }
    __syncthreads();
}

namespace pg8 {
constexpr int BM = 256, BK = 64, HALF = 128, HTB = HALF * BK * 2, STAGE_BYTES = 8 * HTB, NXCD = 8, WGM = 8;
__host__ __device__ __forceinline__ int lds_byte(int r, int c) { const int st = (r >> 4) * 2 + (c >> 5), rr = r & 15, cc = c & 31, ob = rr * 64 + cc * 2; return st * 1024 + (ob ^ (((ob >> 9) & 1) << 5)); }
__host__ __device__ __forceinline__ void stage_rc(int b, int& R, int& C) { const int st = b / 1024, sb = b % 1024, swz = sb ^ (((sb >> 9) & 1) << 5); R = (st >> 1) * 16 + swz / 64; C = (st & 1) * 32 + (swz % 64) / 2; }
__host__ __device__ __forceinline__ int perm32(int rho) { const int n = rho >> 4, i = rho & 15; return 8 * (i >> 2) + 4 * n + (i & 3); }

__device__ __forceinline__ bool dense_order(int i, int G, int c, int nM, int nN, int& pm, int& pn) {
    const int nwg = nM * nN; const long L = (long)i * G + c; if (L >= nwg) return false;
    int wgid = (int)L; { const int q = nwg / NXCD, r = nwg % NXCD, xcd = wgid % NXCD, off = wgid / NXCD; wgid = (xcd < r ? xcd * (q + 1) : r * (q + 1) + (xcd - r) * q) + off; }
    const int nig = WGM * nN, gid = wgid / nig, fm = gid * WGM, gsz = (nM - fm) < WGM ? (nM - fm) : WGM;
    pm = __builtin_amdgcn_readfirstlane(fm + ((wgid % nig) % gsz)); pn = __builtin_amdgcn_readfirstlane((wgid % nig) / gsz); return true;
}

template <bool GATHER> struct UCtx { const char* a0[2]; const char* a1[2]; const char* b; unsigned vg[2][2]; };
template <> struct UCtx<false> { const char* a0[2]; const char* a1[2]; const char* b; };

template <class P>
__device__ __forceinline__ void gemm_phase(LAS unsigned char* lds, const P& pol) {
    typedef typename P::Unit Unit;
    const int tid = opaque_tid(), wid = __builtin_amdgcn_readfirstlane(tid >> 6), lane = tid & 63, wr = wid >> 2, wc = wid & 3, fr = lane & 15, fq = lane >> 4;
    constexpr int nt = P::NT;
    int Rr[2], Cc[2]; unsigned voffB[2], va0[2];
#pragma unroll
    for (int i = 0; i < 2; ++i) { stage_rc(tid * 16 + i * 8192, Rr[i], Cc[i]); const int Rb = P::PERM ? ((Rr[i] & ~31) + perm32(Rr[i] & 31)) : Rr[i];
        voffB[i] = (unsigned)(Rb * P::LDB + Cc[i] * 2); va0[i] = pol.lane_a0(Rr[i], Cc[i]); }
    constexpr size_t hstepB = (size_t)HALF * P::LDB;
    const unsigned ldsw = (unsigned)wid * 1024u;
    const int aoff = lds_byte(wr * 64 + fr, fq * 8), boff = lds_byte(wc * 32 + fr, fq * 8);
#define PG8_SA(b, h) (((b) * 2 + (h)) * HTB)
#define PG8_SB(b, h) ((4 + (b) * 2 + (h)) * HTB)
#define PG8_GL(bufoff, p0, p1) do { __builtin_amdgcn_global_load_lds((const unsigned*)(p0), (LAS unsigned*)(lds + (bufoff) + ldsw), 16, 0, 0); \
        __builtin_amdgcn_global_load_lds((const unsigned*)(p1), (LAS unsigned*)(lds + (bufoff) + ldsw + 8192), 16, 0, 0); } while (0)
#define PG8_STB(bufoff, U, h, kt) do { const char* _b = (U).b + (size_t)(h) * hstepB + (size_t)(kt) * 128; asm volatile("" : "+s"(_b)); PG8_GL(bufoff, _b + voffB[0], _b + voffB[1]); } while (0)
#define PG8_STA(bufoff, U, h, kt) do { const char* _a = (U).a0[h] + (size_t)(kt) * P::KS0; if constexpr (P::TWOSEG) { if ((kt) >= P::KT0) _a = (U).a1[h] + (size_t)((kt) - P::KT0) * P::KS1; } \
        unsigned _o0, _o1; if constexpr (P::GATHER) { _o0 = (U).vg[h][0]; _o1 = (U).vg[h][1]; } else { _o0 = va0[0]; _o1 = va0[1]; } \
        asm volatile("" : "+s"(_a)); PG8_GL(bufoff, _a + _o0, _a + _o1); } while (0)
#define PG8_LDA(dst, b, h) do { _Pragma("unroll") for (int m = 0; m < 4; ++m) _Pragma("unroll") for (int k = 0; k < 2; ++k) dst[m][k] = *(const LAS bf16x8*)(lds + PG8_SA(b, h) + aoff + m * 2048 + k * 1024); } while (0)
#define PG8_LDB(dst, b, h) do { _Pragma("unroll") for (int n = 0; n < 2; ++n) _Pragma("unroll") for (int k = 0; k < 2; ++k) dst[n][k] = *(const LAS bf16x8*)(lds + PG8_SB(b, h) + boff + n * 2048 + k * 1024); } while (0)
#define PG8_MMA(ai, bj, At, Bt) do { __builtin_amdgcn_s_setprio(1); _Pragma("unroll") for (int m = 0; m < 4; ++m) _Pragma("unroll") for (int n = 0; n < 2; ++n) _Pragma("unroll") for (int k = 0; k < 2; ++k) \
        acc[ai][bj][m][n] = __builtin_amdgcn_mfma_f32_16x16x32_bf16(Bt[n][k], At[m][k], acc[ai][bj][m][n], 0, 0, 0); __builtin_amdgcn_s_setprio(0); } while (0)
#define PG8_WAIT_V(n) asm volatile("s_waitcnt vmcnt(" #n ")" ::: "memory")
#define PG8_WAIT_L(n) asm volatile("s_waitcnt lgkmcnt(" #n ")" ::: "memory")
#define PG8_BAR __builtin_amdgcn_s_barrier()
#define PG8_SCHED __builtin_amdgcn_sched_barrier(0)
    Unit cur, nxt; int ui = 0;
    if (!pol.next(0, cur)) return;
    UCtx<P::GATHER> cc, nc;
    pol.ctx(cur, cc, Rr, Cc);
    f32x4 acc[2][2][4][2];
#pragma unroll
    for (int a = 0; a < 2; ++a)
#pragma unroll
        for (int b = 0; b < 2; ++b)
#pragma unroll
            for (int m = 0; m < 4; ++m)
#pragma unroll
                for (int n = 0; n < 2; ++n) acc[a][b][m][n] = (f32x4){0.f, 0.f, 0.f, 0.f};
    bf16x8 At[4][2], B0[2][2], B1[2][2];
    PG8_STB(PG8_SB(0, 0), cc, 0, 0); PG8_STB(PG8_SB(0, 1), cc, 1, 0); PG8_STA(PG8_SA(0, 0), cc, 0, 0); PG8_STA(PG8_SA(0, 1), cc, 1, 0);
    if (wr == 1) PG8_BAR;
    PG8_WAIT_V(2); PG8_BAR;
    PG8_STB(PG8_SB(1, 0), cc, 0, 1); PG8_STA(PG8_SA(1, 0), cc, 0, 1); PG8_STB(PG8_SB(1, 1), cc, 1, 1);
    PG8_WAIT_V(6); PG8_BAR;
    for (;;) {
        const bool has_next = pol.next(ui + 1, nxt);
        if (has_next) pol.ctx(nxt, nc, Rr, Cc); else nc = cc;
        for (int t = 0; t < nt; t += 2) {
            const bool last = (t == nt - 2);
            const int k2 = last ? 0 : t + 2, k3 = k2 + 1;
            PG8_LDB(B0, 0, 0); PG8_LDB(B1, 0, 1); PG8_SCHED; PG8_LDA(At, 0, 0); PG8_STA(PG8_SA(1, 1), cc, 1, t + 1);
            PG8_WAIT_V(8); PG8_WAIT_L(0); PG8_BAR; PG8_MMA(0, 0, At, B0); PG8_MMA(0, 1, At, B1); PG8_BAR; PG8_SCHED;
            PG8_LDA(At, 0, 1);
            if (last) { PG8_STB(PG8_SB(0, 0), nc, 0, 0); PG8_STB(PG8_SB(0, 1), nc, 1, 0); PG8_STA(PG8_SA(0, 0), nc, 0, 0); }
            else      { PG8_STB(PG8_SB(0, 0), cc, 0, k2); PG8_STB(PG8_SB(0, 1), cc, 1, k2); PG8_STA(PG8_SA(0, 0), cc, 0, k2); }
            PG8_WAIT_V(8); PG8_WAIT_L(0); PG8_BAR; PG8_MMA(1, 0, At, B0); PG8_MMA(1, 1, At, B1); PG8_BAR; PG8_SCHED;
            PG8_LDB(B0, 1, 0); PG8_LDB(B1, 1, 1); PG8_SCHED; PG8_LDA(At, 1, 0);
            if (last) { PG8_STA(PG8_SA(0, 1), nc, 1, 0); } else { PG8_STA(PG8_SA(0, 1), cc, 1, k2); }
            PG8_WAIT_V(8); PG8_WAIT_L(0); PG8_BAR; PG8_MMA(0, 0, At, B0); PG8_MMA(0, 1, At, B1); PG8_BAR; PG8_SCHED;
            PG8_LDA(At, 1, 1);
            if (last) { PG8_STB(PG8_SB(1, 0), nc, 0, 1); PG8_STB(PG8_SB(1, 1), nc, 1, 1); PG8_STA(PG8_SA(1, 0), nc, 0, 1); }
            else      { PG8_STB(PG8_SB(1, 0), cc, 0, k3); PG8_STB(PG8_SB(1, 1), cc, 1, k3); PG8_STA(PG8_SA(1, 0), cc, 0, k3); }
            PG8_WAIT_V(8); PG8_WAIT_L(0); PG8_BAR; PG8_MMA(1, 0, At, B0); PG8_MMA(1, 1, At, B1); PG8_BAR; PG8_SCHED;
        }
        if (wr == 0) PG8_BAR;
        pol.epi(acc, cur, wr, wc, fr, fq);
        if (!has_next) break;
#pragma unroll
        for (int a = 0; a < 2; ++a)
#pragma unroll
            for (int b = 0; b < 2; ++b)
#pragma unroll
                for (int m = 0; m < 4; ++m)
#pragma unroll
                    for (int n = 0; n < 2; ++n) acc[a][b][m][n] = (f32x4){0.f, 0.f, 0.f, 0.f};
        cur = nxt; cc = nc; ++ui;
        if (wr == 1) PG8_BAR;
    }
    PG8_WAIT_V(0);
    PG8_BAR;
#undef PG8_SA
#undef PG8_SB
#undef PG8_GL
#undef PG8_STB
#undef PG8_STA
#undef PG8_LDA
#undef PG8_LDB
#undef PG8_MMA
#undef PG8_WAIT_V
#undef PG8_WAIT_L
#undef PG8_BAR
#undef PG8_SCHED
}
}
struct DUnit { int pm, pn; };

template <int NT_, int LDA_, bool PERM_> struct DenseBase {
    static constexpr bool PERM = PERM_, GATHER = false, TWOSEG = false;
    static constexpr int NT = NT_, KT0 = NT_, KS0 = 128, KS1 = 128, LDB = NT_ * 128;
    typedef DUnit Unit;
    const char* A; const char* Bt; int nM, nN, G, c;
    __device__ __forceinline__ bool next(int i, Unit& u) const { return pg8::dense_order(i, G, c, nM, nN, u.pm, u.pn); }
    __device__ __forceinline__ void ctx(const Unit& u, pg8::UCtx<false>& x, const int (&)[2], const int (&)[2]) const {
        x.a0[0] = A + (size_t)u.pm * 256 * LDA_; x.a0[1] = x.a0[0] + (size_t)128 * LDA_; x.a1[0] = x.a0[0]; x.a1[1] = x.a0[1];
        x.b = Bt + (size_t)u.pn * 256 * LDB; }
    __device__ __forceinline__ unsigned lane_a0(int R, int C) const { return (unsigned)(R * LDA_ + C * 2); }
    __device__ __forceinline__ unsigned lane_a1(int, int) const { return 0u; }
};

__device__ __forceinline__ void store8(bf16_t* p, const f32x4& v0, const f32x4& v1) {
    u32x4 w; w.x = cvt_pk_bf16(v0[0], v0[1]); w.y = cvt_pk_bf16(v0[2], v0[3]); w.z = cvt_pk_bf16(v1[0], v1[1]); w.w = cvt_pk_bf16(v1[2], v1[3]); *(u32x4*)p = w; }
__device__ __forceinline__ float sq4(const f32x4& v) { return (v[0] * v[0] + v[1] * v[1]) + (v[2] * v[2] + v[3] * v[3]); }
__device__ __forceinline__ void rope8(f32x4& v0, f32x4& v1, const float* cs) {
    const f32x4 a = *(const f32x4*)cs, b = *(const f32x4*)(cs + 4);
    float x0, x1;
    x0 = v0[0]; x1 = v0[1]; v0[0] = x0 * a[0] - x1 * a[1]; v0[1] = x0 * a[1] + x1 * a[0];
    x0 = v0[2]; x1 = v0[3]; v0[2] = x0 * a[2] - x1 * a[3]; v0[3] = x0 * a[3] + x1 * a[2];
    x0 = v1[0]; x1 = v1[1]; v1[0] = x0 * b[0] - x1 * b[1]; v1[1] = x0 * b[1] + x1 * b[0];
    x0 = v1[2]; x1 = v1[3]; v1[2] = x0 * b[2] - x1 * b[3]; v1[3] = x0 * b[3] + x1 * b[2];
}

struct PolDqkv : DenseBase<16, 2048, true> {
    bf16_t* A1; float* SSQ1; bf16_t* KPE; const float* ROPE;
    __device__ __forceinline__ void epi(const f32x4 (&acc)[2][2][4][2], const DUnit& u, int wr, int wc, int fr, int fq) const {
#pragma unroll
        for (int ai = 0; ai < 2; ++ai)
#pragma unroll
            for (int m = 0; m < 4; ++m) {
                const int row = u.pm * 256 + ai * 128 + wr * 64 + m * 16 + fr;
                bf16_t* rowp = A1 + (size_t)row * NDQKV + u.pn * 256 + wc * 32 + 8 * fq;
                float s0 = sq4(acc[ai][0][m][0]) + sq4(acc[ai][0][m][1]), s1 = sq4(acc[ai][1][m][0]) + sq4(acc[ai][1][m][1]);
                store8(rowp, acc[ai][0][m][0], acc[ai][0][m][1]); store8(rowp + 128, acc[ai][1][m][0], acc[ai][1][m][1]);
                s0 += __shfl_xor(s0, 16); s0 += __shfl_xor(s0, 32); s1 += __shfl_xor(s1, 16); s1 += __shfl_xor(s1, 32);
                if (fq == 0) {
                    float* sp = SSQ1 + (size_t)row * 16;
                    if (u.pn == 0) sp[wc] = s0 + s1; else if (u.pn == 1) { sp[4 + wc] = s0; sp[8 + wc] = s1; } else sp[12 + wc] = s0;
                }
                if (u.pn == 2 && wc < 2) {
                    f32x4 v0 = acc[ai][1][m][0], v1 = acc[ai][1][m][1];
                    if (row >= NCTXR) { const int t = (row - NCTXR) & (SEQL - 1); rope8(v0, v1, ROPE + ((size_t)t * 32 + 16 * wc + 4 * fq) * 2); }
                    store8(KPE + (size_t)row * 64 + 32 * wc + 8 * fq, v0, v1);
                }
            }
    }
};

struct PolQup : DenseBase<6, NDQKV * 2, true> {
    bf16_t* Q; const float* SSQ1;
    __device__ __forceinline__ void epi(const f32x4 (&acc)[2][2][4][2], const DUnit& u, int wr, int wc, int fr, int fq) const {
#pragma unroll
        for (int ai = 0; ai < 2; ++ai) {
            f32x4 p0[4], p1[4];
#pragma unroll
            for (int m = 0; m < 4; ++m) { const int row = u.pm * 256 + ai * 128 + wr * 64 + m * 16 + fr; p0[m] = *(const f32x4*)(SSQ1 + (size_t)row * 16); p1[m] = *(const f32x4*)(SSQ1 + (size_t)row * 16 + 4); }
#pragma unroll
            for (int m = 0; m < 4; ++m) {
                const int row = u.pm * 256 + ai * 128 + wr * 64 + m * 16 + fr;
                const float ss = ((p0[m][0] + p0[m][1]) + (p0[m][2] + p0[m][3])) + ((p1[m][0] + p1[m][1]) + (p1[m][2] + p1[m][3]));
                const float rstd = __builtin_amdgcn_rsqf(ss * (1.f / QLORA) + NORM_EPS);
                bf16_t* rowp = Q + (size_t)row * NQ + u.pn * 256 + wc * 32 + 8 * fq;
                store8(rowp, acc[ai][0][m][0] * rstd, acc[ai][0][m][1] * rstd); store8(rowp + 128, acc[ai][1][m][0] * rstd, acc[ai][1][m][1] * rstd);
            }
            asm volatile("" ::: "memory");
        }
    }
};

struct PolKVup : DenseBase<4, NDQKV * 2, true> {
    bf16_t* KV; const float* SSQ1;
    __device__ __forceinline__ void epi(const f32x4 (&acc)[2][2][4][2], const DUnit& u, int wr, int wc, int fr, int fq) const {
#pragma unroll
        for (int ai = 0; ai < 2; ++ai) {
            f32x4 p0[4], p1[4];
#pragma unroll
            for (int m = 0; m < 4; ++m) { const int row = u.pm * 256 + ai * 128 + wr * 64 + m * 16 + fr; p0[m] = *(const f32x4*)(SSQ1 + (size_t)row * 16 + 8); p1[m] = *(const f32x4*)(SSQ1 + (size_t)row * 16 + 12); }
#pragma unroll
            for (int m = 0; m < 4; ++m) {
                const int row = u.pm * 256 + ai * 128 + wr * 64 + m * 16 + fr;
                const float ss = ((p0[m][0] + p0[m][1]) + (p0[m][2] + p0[m][3])) + ((p1[m][0] + p1[m][1]) + (p1[m][2] + p1[m][3]));
                const float rstd = __builtin_amdgcn_rsqf(ss * (1.f / KVLORA) + NORM_EPS);
                bf16_t* rowp = KV + (size_t)row * NKV + u.pn * 256 + wc * 32 + 8 * fq;
                store8(rowp, acc[ai][0][m][0] * rstd, acc[ai][0][m][1] * rstd); store8(rowp + 128, acc[ai][1][m][0] * rstd, acc[ai][1][m][1] * rstd);
            }
            asm volatile("" ::: "memory");
        }
    }
};

struct PolWo : DenseBase<16, 2048, true> {
    bf16_t* OO; float* SSQO;
    __device__ __forceinline__ void epi(const f32x4 (&acc)[2][2][4][2], const DUnit& u, int wr, int wc, int fr, int fq) const {
#pragma unroll
        for (int ai = 0; ai < 2; ++ai)
#pragma unroll
            for (int m = 0; m < 4; ++m) {
                const int row = u.pm * 256 + ai * 128 + wr * 64 + m * 16 + fr;
                bf16_t* rowp = OO + (size_t)row * DM + u.pn * 256 + wc * 32 + 8 * fq;
                float s = (sq4(acc[ai][0][m][0]) + sq4(acc[ai][0][m][1])) + (sq4(acc[ai][1][m][0]) + sq4(acc[ai][1][m][1]));
                store8(rowp, acc[ai][0][m][0], acc[ai][0][m][1]); store8(rowp + 128, acc[ai][1][m][0], acc[ai][1][m][1]);
                s += __shfl_xor(s, 16); s += __shfl_xor(s, 32);
                if (fq == 0) SSQO[(size_t)row * 32 + u.pn * 4 + wc] = s;
            }
    }
};
namespace attn {
constexpr int NW = 8, QBLK = 32, KVBLK = 64, DQK = 192, DV = 128;
constexpr float SCALE = 0.07216878364870322f;
constexpr float THR = 8.f;
constexpr int SHM_V = KVBLK * DV * 2, SHM_K = KVBLK * DQK * 2;
constexpr int SHM_QPE = NW * 4096;
constexpr int SHM_ATTN = 2 * SHM_V + 2 * SHM_K + NW * 64 * 4 + SHM_QPE;
#define KSWZ(row, colB) ((row) * 384 + ((colB) ^ (((row) & 7) << 4)))
#define SBAR() __builtin_amdgcn_sched_barrier(0)
__device__ __forceinline__ int crow(int r, int hi) { return (r & 3) + 8 * (r >> 2) + 4 * hi; }
__device__ __forceinline__ unsigned cvtpk(float lo, float hi) { unsigned r; asm volatile("v_cvt_pk_bf16_f32 %0, %1, %2" : "=v"(r) : "v"(lo), "v"(hi)); return r; }

__device__ __forceinline__ void partialSM(f32x16& p0, f32x16& p1, float& m_reg, float& mn, float& alpha) {
  constexpr float C = SCALE * 1.4426950408889634f;
  float pmax = p0[0];
#pragma unroll
  for (int r = 1; r < 16; ++r) pmax = fmaxf(pmax, p0[r]);
#pragma unroll
  for (int r = 0; r < 16; ++r) pmax = fmaxf(pmax, p1[r]);
  { auto rr = __builtin_amdgcn_permlane32_swap(__float_as_uint(pmax), __float_as_uint(pmax), false, false);
    pmax = fmaxf(__uint_as_float(rr[0]), __uint_as_float(rr[1])); }
  if (__builtin_expect(__all(pmax - m_reg <= THR / SCALE), 1)) { mn = m_reg; alpha = 1.f; }
  else { mn = fmaxf(m_reg, pmax); alpha = __builtin_amdgcn_exp2f((m_reg - mn) * C); m_reg = mn; }
  float mnC = -mn * C;
#pragma unroll
  for (int r = 0; r < 16; ++r) p0[r] = fmaf(p0[r], C, mnC);
#pragma unroll
  for (int r = 0; r < 16; ++r) p1[r] = fmaf(p1[r], C, mnC);
#pragma unroll
  for (int r = 0; r < 16; ++r) p0[r] = __builtin_amdgcn_exp2f(p0[r]);
}
__device__ __forceinline__ void finishSM(f32x16& p0, f32x16& p1, float alpha, float& l_reg, bf16x8& pa0, bf16x8& pa1, bf16x8& pa2, bf16x8& pa3) {
#pragma unroll
  for (int r = 0; r < 16; ++r) p1[r] = __builtin_amdgcn_exp2f(p1[r]);
  float ps = 0;
#pragma unroll
  for (int r = 0; r < 16; ++r) ps += p0[r];
#pragma unroll
  for (int r = 0; r < 16; ++r) ps += p1[r];
  { auto rr = __builtin_amdgcn_permlane32_swap(__float_as_uint(ps), __float_as_uint(ps), false, false);
    ps = __uint_as_float(rr[0]) + __uint_as_float(rr[1]); }
  l_reg = l_reg * alpha + ps;
#define PK4(P, BASE, OUT) do { unsigned a0 = cvtpk(P[BASE + 0], P[BASE + 1]), a1 = cvtpk(P[BASE + 2], P[BASE + 3]);   \
    unsigned b0 = cvtpk(P[BASE + 4], P[BASE + 5]), b1 = cvtpk(P[BASE + 6], P[BASE + 7]);                              \
    auto r0 = __builtin_amdgcn_permlane32_swap(a0, b0, false, false); auto r1 = __builtin_amdgcn_permlane32_swap(a1, b1, false, false); \
    u32x4 w = {r0[0], r1[0], r0[1], r1[1]}; OUT = *reinterpret_cast<bf16x8*>(&w); } while (0)
  PK4(p0, 0, pa0); PK4(p0, 8, pa1); PK4(p1, 0, pa2); PK4(p1, 8, pa3);
#undef PK4
}
__device__ __forceinline__ void qkt(f32x16& p0, f32x16& p1, const char* Ks, const bf16x8* qr, const char* qpe, int r32, int hi) {
  p0 = f32x16{}; p1 = f32x16{};
#pragma unroll
  for (int d0 = 0; d0 < 12; ++d0) { int cb = (d0 * 16 + hi * 8) * 2;
    bf16x8 b0 = *reinterpret_cast<const bf16x8*>(Ks + KSWZ(r32, cb));
    bf16x8 b1 = *reinterpret_cast<const bf16x8*>(Ks + KSWZ(32 + r32, cb));
    const bf16x8 q = d0 < 8 ? qr[d0 < 8 ? d0 : 0] : *reinterpret_cast<const bf16x8*>(qpe + (d0 - 8) * 1024);
    p0 = __builtin_amdgcn_mfma_f32_32x32x16_bf16(b0, q, p0, 0, 0, 0);
    p1 = __builtin_amdgcn_mfma_f32_32x32x16_bf16(b1, q, p1, 0, 0, 0);
    if ((d0 & 3) == 3) SBAR(); }
}
__device__ __forceinline__ int v_st(int k, int c) { const int kk = (k & ~0xC) | ((k & 4) << 1) | ((k & 8) >> 1); return ((kk >> 3) * 4 + (c >> 5)) * 512 + ((kk & 7) * 32 + (c & 31)) * 2; }
__device__ __forceinline__ int v_rd_base(int lane) { return ((lane & 3) << 3) | (((lane >> 2) & 3) << 6) | (((lane >> 4) & 1) << 5) | (((lane >> 5) & 1) << 8); }
constexpr int v_rd_off(int d0, int ks, int half) { return d0 * 512 + ks * 4096 + half * 2048; }
template <int OFF> __device__ __forceinline__ s16x4 tr_read(int vb) {
  s16x4 r; asm volatile("ds_read_b64_tr_b16 %0, %1 offset:%2" : "=&v"(r) : "v"(vb), "i"(OFF) : "memory"); return r;
}
template <int D0> __device__ __forceinline__ void pv_one(f32x16& od, int vb, bf16x8 pa0, bf16x8 pa1, bf16x8 pa2, bf16x8 pa3) {
  const s16x4 l0 = tr_read<v_rd_off(D0, 0, 0)>(vb), h0 = tr_read<v_rd_off(D0, 0, 1)>(vb), l1 = tr_read<v_rd_off(D0, 1, 0)>(vb), h1 = tr_read<v_rd_off(D0, 1, 1)>(vb);
  const s16x4 l2 = tr_read<v_rd_off(D0, 2, 0)>(vb), h2 = tr_read<v_rd_off(D0, 2, 1)>(vb), l3 = tr_read<v_rd_off(D0, 3, 0)>(vb), h3 = tr_read<v_rd_off(D0, 3, 1)>(vb);
  asm volatile("s_waitcnt lgkmcnt(0)" ::: "memory"); SBAR();
#define PK(L, H) (bf16x8){L[0], L[1], L[2], L[3], H[0], H[1], H[2], H[3]}
  od = __builtin_amdgcn_mfma_f32_32x32x16_bf16(pa0, PK(l0, h0), od, 0, 0, 0);
  od = __builtin_amdgcn_mfma_f32_32x32x16_bf16(pa1, PK(l1, h1), od, 0, 0, 0);
  od = __builtin_amdgcn_mfma_f32_32x32x16_bf16(pa2, PK(l2, h2), od, 0, 0, 0);
  od = __builtin_amdgcn_mfma_f32_32x32x16_bf16(pa3, PK(l3, h3), od, 0, 0, 0);
#undef PK
}
__device__ __forceinline__ void pv_d0(f32x16* o, int vb, bf16x8 pa0, bf16x8 pa1, bf16x8 pa2, bf16x8 pa3) {
  pv_one<0>(o[0], vb, pa0, pa1, pa2, pa3); pv_one<1>(o[1], vb, pa0, pa1, pa2, pa3); pv_one<2>(o[2], vb, pa0, pa1, pa2, pa3); pv_one<3>(o[3], vb, pa0, pa1, pa2, pa3);
}

__device__ __forceinline__ void attn_unit(const bf16_t* __restrict__ Qg, const bf16_t* __restrict__ KVb, const bf16_t* __restrict__ KPE, bf16_t* __restrict__ Og, const float* __restrict__ ROPE,
                                          int qrow0, int qt0, int h, int crow0, int lrow0, int NT, char* lds) {
  const int tid = opaque_tid(), wid = tid >> 6, lane = tid & 63, r32 = lane & 31, hi = lane >> 5;
  char* V_lds = lds; char* K_lds = lds + 2 * SHM_V;
  float* ws = (float*)(lds + 2 * SHM_V + 2 * SHM_K) + wid * 64; float* li_l = ws; float* al_l = ws + 32;
  float m_reg = -1e30f, l_reg = 0; f32x16 o[4] = {}; bf16x8 qr[8];
  char* qpe = lds + 2 * SHM_V + 2 * SHM_K + NW * 64 * 4 + wid * 4096 + lane * 16;
  const bf16_t* Qw = Qg + (size_t)(qrow0 + wid * QBLK + r32) * NQ + h * DQK + hi * 8;
#pragma unroll
  for (int d0 = 0; d0 < 8; ++d0) qr[d0] = *reinterpret_cast<const bf16x8*>(Qw + d0 * 16);
#pragma unroll
  for (int d0 = 8; d0 < 12; ++d0) {
    u32x4 qv = *reinterpret_cast<const u32x4*>(Qw + d0 * 16);
    if (qt0 >= 0) { const float* cs = ROPE + ((size_t)(qt0 + wid * QBLK + r32) * 32 + 8 * (d0 - 8) + 4 * hi) * 2; const f32x4 ca = *(const f32x4*)cs, cb = *(const f32x4*)(cs + 4);
      float x0, x1;
      x0 = bf_lo(qv.x); x1 = bf_hi(qv.x); qv.x = cvtpk(x0 * ca[0] - x1 * ca[1], x0 * ca[1] + x1 * ca[0]);
      x0 = bf_lo(qv.y); x1 = bf_hi(qv.y); qv.y = cvtpk(x0 * ca[2] - x1 * ca[3], x0 * ca[3] + x1 * ca[2]);
      x0 = bf_lo(qv.z); x1 = bf_hi(qv.z); qv.z = cvtpk(x0 * cb[0] - x1 * cb[1], x0 * cb[1] + x1 * cb[0]);
      x0 = bf_lo(qv.w); x1 = bf_hi(qv.w); qv.w = cvtpk(x0 * cb[2] - x1 * cb[3], x0 * cb[3] + x1 * cb[2]); }
    *reinterpret_cast<u32x4*>(qpe + (d0 - 8) * 1024) = qv; }
  const int sr = tid >> 4, sc = (tid & 15) * 8, vst0 = v_st(sr, sc), vst1 = v_st(32 + sr, sc);
  const int pr = tid >> 3, pc = (tid & 7) * 8;
  const int vb0 = (int)(uintptr_t)V_lds + v_rd_base(lane);
  bf16x8 vs0, vs1, ks0, ks1, kp;
#define TROW(j) ((j) < 4 ? crow0 + 64 * (j) : lrow0 + 64 * ((j) - 4))
#define SLOAD(j) do { const int k0_ = TROW(j); const bf16_t* kv0_ = KVb + (size_t)(k0_ + sr) * NKV + h * 256 + sc; const bf16_t* kv1_ = kv0_ + (size_t)32 * NKV; \
    vs0 = *reinterpret_cast<const bf16x8*>(kv0_ + 128); vs1 = *reinterpret_cast<const bf16x8*>(kv1_ + 128); \
    ks0 = *reinterpret_cast<const bf16x8*>(kv0_); ks1 = *reinterpret_cast<const bf16x8*>(kv1_); \
    kp = *reinterpret_cast<const bf16x8*>(KPE + (size_t)(k0_ + pr) * 64 + pc); } while (0)
#define SWRITE(b) do { *(bf16x8*)(V_lds + (b) * SHM_V + vst0) = vs0; *(bf16x8*)(V_lds + (b) * SHM_V + vst1) = vs1; \
    *(bf16x8*)(K_lds + (b) * SHM_K + KSWZ(sr, sc * 2)) = ks0; *(bf16x8*)(K_lds + (b) * SHM_K + KSWZ(32 + sr, sc * 2)) = ks1; \
    *(bf16x8*)(K_lds + (b) * SHM_K + KSWZ(pr, (128 + pc) * 2)) = kp; } while (0)
#define SWAIT() asm volatile("s_waitcnt vmcnt(0)" ::: "memory")
#define RESC(a) do { if (__any((a) < 1.f)) { if (hi == 0) al_l[r32] = (a); asm volatile("s_waitcnt lgkmcnt(0)" ::: "memory"); \
    _Pragma("unroll") for (int d = 0; d < 4; ++d) _Pragma("unroll") for (int r = 0; r < 16; ++r) o[d][r] *= al_l[crow(r, hi)]; } } while (0)
  f32x16 pA0, pA1, pB0, pB1; float mnA, mnB, alA, alB; bf16x8 pa0, pa1, pa2, pa3;
  SLOAD(0); SWAIT(); SWRITE(0); __syncthreads();
  qkt(pA0, pA1, K_lds, qr, qpe, r32, hi); partialSM(pA0, pA1, m_reg, mnA, alA);
  SLOAD(1);
  SWAIT(); SWRITE(1); __syncthreads();
  for (int j = 1; j + 1 < NT; j += 2) {
    SBAR(); qkt(pB0, pB1, K_lds + SHM_K, qr, qpe, r32, hi);
    finishSM(pA0, pA1, alA, l_reg, pa0, pa1, pa2, pa3); SBAR();
    SLOAD(j + 1); SBAR();
    pv_d0(o, vb0, pa0, pa1, pa2, pa3); partialSM(pB0, pB1, m_reg, mnB, alB);
    __syncthreads(); SWAIT(); SWRITE(0);
    RESC(alB); __syncthreads();
    SBAR(); qkt(pA0, pA1, K_lds, qr, qpe, r32, hi);
    finishSM(pB0, pB1, alB, l_reg, pa0, pa1, pa2, pa3); SBAR();
    SLOAD(j + 2); SBAR();
    pv_d0(o, vb0 + SHM_V, pa0, pa1, pa2, pa3); partialSM(pA0, pA1, m_reg, mnA, alA);
    __syncthreads(); SWAIT(); SWRITE(1);
    RESC(alA); __syncthreads();
  }
  SBAR(); qkt(pB0, pB1, K_lds + SHM_K, qr, qpe, r32, hi);
  finishSM(pA0, pA1, alA, l_reg, pa0, pa1, pa2, pa3); SBAR();
  pv_d0(o, vb0, pa0, pa1, pa2, pa3); partialSM(pB0, pB1, m_reg, mnB, alB);
  __syncthreads(); RESC(alB);
  finishSM(pB0, pB1, alB, l_reg, pa0, pa1, pa2, pa3); SBAR();
  pv_d0(o, vb0 + SHM_V, pa0, pa1, pa2, pa3);
  if (hi == 0) li_l[r32] = l_reg; asm volatile("s_waitcnt lgkmcnt(0)" ::: "memory");
  float rli[16];
#pragma unroll
  for (int r = 0; r < 16; ++r) rli[r] = __builtin_amdgcn_rcpf(li_l[crow(r, hi)]);
  bf16_t* Ow = Og + (size_t)(qrow0 + wid * QBLK) * DM + h * DV;
#pragma unroll
  for (int r = 0; r < 16; ++r) { const int orow = crow(r, hi);
#pragma unroll
    for (int d0 = 0; d0 < 4; ++d0) Ow[(size_t)orow * DM + d0 * 32 + r32] = (bf16_t)(cvtpk(o[d0][r] * rli[r], 0.f) & 0xffffu); }
  __syncthreads();
#undef TROW
#undef SLOAD
#undef SWRITE
#undef SWAIT
#undef RESC
}
#undef KSWZ
#undef SBAR
}
constexpr int NWAVES = 8;
constexpr int RING_BYTES = 131072, LDSCTL_OFF = RING_BYTES, LDS_BYTES = 147456;

struct Args {
    const float* in[31]; float* out; unsigned char* ws; int stage; int pad;
};
struct Frame {
    LAS unsigned char* lds; int vcu, G; unsigned char* ws;
};
constexpr int PTAB_OFF = 131072 + 512;
__device__ __forceinline__ const float* inp(const Frame& F, int i) {
    const LAS unsigned* t = (const LAS unsigned*)(F.lds + PTAB_OFF) + 2 * i;
    const unsigned lo = __builtin_amdgcn_readfirstlane(t[0]), hi = __builtin_amdgcn_readfirstlane(t[1]);
    return (const float*)(((unsigned long long)hi << 32) | lo);
}

__device__ __forceinline__ unsigned f2bf(float f) { unsigned u = __float_as_uint(f); return (u + 0x7fffu + ((u >> 16) & 1u)) >> 16; }
__device__ __forceinline__ unsigned pk2(float lo, float hi) { return f2bf(lo) | (f2bf(hi) << 16); }
__device__ __forceinline__ void cvt_item(const float* srcA, const float* srcB, const float* kscale, bf16_t* dst, int ld, int K, int nrows, int nvalid, int mode, int item, LAS float* scr, int lane) {
    const int nblk = nrows >> 5, kb = item / nblk, nb = item - kb * nblk, k0 = 64 * kb, n0 = 32 * nb;
    const float* src = srcA; int col = n0; bool valid = n0 < nvalid;
    if (mode == 1) { const int t = n0 >> 8, r = n0 & 255; src = r < 128 ? srcA : srcB; col = 128 * t + (r & 127); valid = true; }
    const int kk = lane >> 3, n4 = (lane & 7) * 4;
    f32x4 v[8];
    if (valid) {
        const float* sp = src + (size_t)(k0 + kk) * ld + col + n4;
#pragma unroll
        for (int i = 0; i < 8; ++i) v[i] = *(const f32x4*)(sp + (size_t)(8 * i) * ld);
        if (kscale) {
#pragma unroll
            for (int i = 0; i < 8; ++i) v[i] = v[i] * kscale[k0 + 8 * i + kk];
        }
    } else {
#pragma unroll
        for (int i = 0; i < 8; ++i) v[i] = (f32x4){0.f, 0.f, 0.f, 0.f};
    }
#pragma unroll
    for (int i = 0; i < 8; ++i) { LAS float* d = scr + (8 * i + kk) * 33 + n4; d[0] = v[i][0]; d[1] = v[i][1]; d[2] = v[i][2]; d[3] = v[i][3]; }
    asm volatile("s_waitcnt lgkmcnt(0)" ::: "memory");
    const int c = lane & 7;
#pragma unroll
    for (int j = 0; j < 4; ++j) { const int n = (lane >> 3) + 8 * j; const LAS float* s = scr + (8 * c) * 33 + n;
        u32x4 o; o.x = cvt_pk_bf16(s[0 * 33], s[1 * 33]); o.y = cvt_pk_bf16(s[2 * 33], s[3 * 33]); o.z = cvt_pk_bf16(s[4 * 33], s[5 * 33]); o.w = cvt_pk_bf16(s[6 * 33], s[7 * 33]);
        *(u32x4*)(dst + (size_t)(n0 + n) * K + k0 + 8 * c) = o; }
    asm volatile("s_waitcnt lgkmcnt(0)" ::: "memory");
}
constexpr int N_SMALL_JOBS = 11;
__device__ __forceinline__ void convert_small(const Args& a, Frame& F) {
    unsigned char* const wsl = opaque_ptr(a.ws);
    const int tid_ = opaque_tid(), lane_ = tid_ & 63, wave_ = __builtin_amdgcn_readfirstlane(tid_ >> 6);
    LAS float* scr = (LAS float*)(F.lds + wave_ * 16384);
    const int gw = F.vcu * NWAVES + wave_, NGW = F.G * NWAVES;
    unsigned char* ws = wsl;
    int base = 0;
#define SMALL_JOB(SA, SB, KS, DST, LD, KK, NR, NV, MODE) do { const int n_ = ((KK) >> 6) * ((NR) >> 5); const int first_ = ((gw - base) % NGW + NGW) % NGW; \
        for (int it = first_; it < n_; it += NGW) cvt_item(SA, SB, KS, DST, LD, KK, NR, NV, MODE, it, scr, lane_); base += n_; } while (0)
    SMALL_JOB(inp(F, 7), nullptr, nullptr, (bf16_t*)(ws + WS_WDQKV), 704, 1024, 768, 704, 0);
    SMALL_JOB(inp(F, 10), nullptr, inp(F, 8), (bf16_t*)(ws + WS_WUQ), 1536, 384, 1536, 1536, 0);
    SMALL_JOB(inp(F, 11), nullptr, inp(F, 9), (bf16_t*)(ws + WS_WUKV), 2048, 256, 2048, 2048, 0);
    SMALL_JOB(inp(F, 12), nullptr, nullptr, (bf16_t*)(ws + WS_WO), 1024, 1024, 1024, 1024, 0);
    SMALL_JOB(inp(F, 21), inp(F, 21) + 1024, nullptr, (bf16_t*)(ws + WS_WGLU), 2048, 1024, 2048, 2048, 1);
#pragma unroll 1
    for (int l = 0; l < 2; ++l) {
        SMALL_JOB(inp(F, 28) + (size_t)l * 1024 * 256, inp(F, 29) + (size_t)l * 1024 * 256, nullptr, (bf16_t*)(ws + WS_WSHR) + (size_t)l * 768 * 1024, 256, 1024, 512, 512, 1);
        SMALL_JOB(inp(F, 23) + (size_t)l * 1024 * 64, nullptr, nullptr, (bf16_t*)(ws + WS_WSHR) + (size_t)l * 768 * 1024 + (size_t)512 * 1024, 64, 1024, 256, 64, 0);
        SMALL_JOB(inp(F, 30) + (size_t)l * 256 * 1024, nullptr, nullptr, (bf16_t*)(ws + WS_WSHD) + (size_t)l * 1024 * 256, 1024, 256, 1024, 1024, 0);
    }
#undef SMALL_JOB
}
__device__ __forceinline__ void convert_experts(const Args& a, Frame& F, int layer, int skip) {
    unsigned char* const wsl = opaque_ptr(a.ws);
    const int tid_ = opaque_tid(), lane_ = tid_ & 63, wave_ = __builtin_amdgcn_readfirstlane(tid_ >> 6);
    LAS float* scr = (LAS float*)(F.lds + wave_ * 16384);
    const int gw = (F.vcu - skip) * NWAVES + wave_, NGW = (F.G - skip) * NWAVES;
    for (int it = gw; it < NEXP * 384; it += NGW) { const int e = it / 384, r = it - e * 384; const size_t eo = ((size_t)layer * NEXP + e) * 1024 * 256;
        if (r < 256) cvt_item(inp(F, 25) + eo, inp(F, 26) + eo, nullptr, (bf16_t*)(wsl + WS_W1) + (size_t)e * 512 * 1024, 256, 1024, 512, 512, 1, r, scr, lane_);
        else cvt_item(inp(F, 27) + eo, nullptr, nullptr, (bf16_t*)(wsl + WS_W2) + (size_t)e * 1024 * 256, 1024, 256, 1024, 1024, 0, r - 256, scr, lane_); }
}

__device__ __forceinline__ void mod_phase(const Args& a, Frame& F) {
    unsigned char* const wsl = opaque_ptr(a.ws);
    const int tid_ = opaque_tid(), lane_ = tid_ & 63, wave_ = __builtin_amdgcn_readfirstlane(tid_ >> 6);
    LAS float* sl = (LAS float*)F.lds;
    LAS float* red = sl + 17 * 1024;
    float* MOD = (float*)(wsl + WS_MOD);
    bool have = false;
    for (int u = F.vcu; u < 256; u += F.G) {
        if (!have) { for (int i = tid_; i < 17 * 1024; i += 512) { const float v = i < 16 * 1024 ? inp(F, 1)[i] : inp(F, 3)[i - 16 * 1024]; sl[i] = silu_f(v); } __syncthreads(); have = true; }
        const int l = u >> 7, n0 = (u & 127) * 48, kg = tid_ >> 6, cl = (tid_ & 63) < 48 ? (tid_ & 63) : 47, col = n0 + cl;
        const float* W = inp(F, 4) + (size_t)l * 1024 * MODW + col;
        float acc[17];
#pragma unroll
        for (int b = 0; b < 17; ++b) acc[b] = 0.f;
#pragma unroll 8
        for (int k = kg; k < 1024; k += 8) { const float w = W[(size_t)k * MODW];
#pragma unroll
            for (int b = 0; b < 17; ++b) acc[b] += sl[b * 1024 + k] * w; }
#pragma unroll
        for (int b = 0; b < 17; ++b) red[(kg * 17 + b) * 64 + (tid_ & 63)] = acc[b];
        __syncthreads();
        for (int i = tid_; i < 17 * 64; i += 512) { const int b = i >> 6, c = i & 63; if (c >= 48) continue; float s = inp(F, 5)[(size_t)l * MODW + n0 + c];
#pragma unroll
            for (int g = 0; g < 8; ++g) s += red[(g * 17 + b) * 64 + c];
            MOD[((size_t)l * 17 + b) * MODW + n0 + c] = s; }
        __syncthreads();
    }
}
__device__ __forceinline__ void sincos_red(float ang, float& c, float& s) {
    const float k = rintf(ang * 0.15915494309189535f);
    float r = fmaf(-k, 6.2831854820251465f, ang); r = fmaf(-k, -1.7484555314695172e-07f, r);
    s = __sinf(r); c = __cosf(r);
}
__device__ __forceinline__ void rope_phase(const Args& a, Frame& F) {
    unsigned char* const wsl = opaque_ptr(a.ws);
    const int tid_ = opaque_tid(), lane_ = tid_ & 63, wave_ = __builtin_amdgcn_readfirstlane(tid_ >> 6);
    float* ROPE = (float*)(wsl + WS_ROPE);
    for (int i = (F.vcu * 512 + tid_); i < SEQL * 32; i += F.G * 512) { const int t = i >> 5, p = i & 31, j = p & 15;
        const float f = exp2f(-(float)j * (13.287712379549449f / 16.f)); const float pos = (float)(p < 16 ? (t >> 6) : (t & 63));
        float c, s; sincos_red(pos * f, c, s); ROPE[2 * i] = c; ROPE[2 * i + 1] = s; }
}

__device__ __forceinline__ const float* xrow_in(const Args& a, const Frame& F, int layer, int row) {
    unsigned char* const wsl = opaque_ptr(a.ws);
    if (layer == 0) return row < NCTXR ? inp(F, 2) + (size_t)row * DM : inp(F, 0) + (size_t)(row - NCTXR) * DM;
    return row < NCTXR ? (const float*)(wsl + WS_XCTX) + (size_t)row * DM : a.out + (size_t)(row - NCTXR) * DM;
}
__device__ __forceinline__ float* xrow_st(const Args& a, int row) {
    unsigned char* const wsl = opaque_ptr(a.ws); return row < NCTXR ? (float*)(wsl + WS_XCTX) + (size_t)row * DM : a.out + (size_t)(row - NCTXR) * DM; }
struct NormMod { f32x4 A[4], B[4]; };
__device__ __forceinline__ void normmod_load(NormMod& p, const float* g, const float* shift, const float* scale, int lane) {
#pragma unroll
    for (int j = 0; j < 4; ++j) { const int c = 4 * lane + 256 * j; p.A[j] = *(const f32x4*)(g + c) * (*(const f32x4*)(scale + c) + 1.f); p.B[j] = *(const f32x4*)(shift + c); }
}
__device__ __forceinline__ void norm_mod_store(const f32x4 (&v)[4], const NormMod& p, bf16_t* orow, int lane) {
    float s = 0.f;
#pragma unroll
    for (int j = 0; j < 4; ++j) s += sq4(v[j]);
    const float rstd = __builtin_amdgcn_rsqf(wave_sum(s) * (1.f / DM) + NORM_EPS);
#pragma unroll
    for (int j = 0; j < 4; ++j) { const int c = 4 * lane + 256 * j; const f32x4 h = (v[j] * rstd) * p.A[j] + p.B[j];
        u32x2 w; w.x = cvt_pk_bf16(h[0], h[1]); w.y = cvt_pk_bf16(h[2], h[3]); *(u32x2*)(orow + c) = w; }
}
__device__ __forceinline__ void h_phase(const Args& a, Frame& F, int layer, int row_lo) {
    unsigned char* const wsl = opaque_ptr(a.ws);
    const int tid_ = opaque_tid(), lane_ = tid_ & 63, wave_ = __builtin_amdgcn_readfirstlane(tid_ >> 6);
    const float* MOD = (const float*)(wsl + WS_MOD) + (size_t)layer * 17 * MODW; const float* g = inp(F, 6) + (size_t)(layer * 4 + 0) * DM; bf16_t* XN = (bf16_t*)(wsl + WS_XN);
    const int rpw = (NROWS - row_lo) / (F.G * NWAVES); int row = row_lo + (F.vcu * NWAVES + wave_) * rpw; const int rend = row + rpw;
    f32x4 nx[4]; NormMod nm; int cur_mi = -1;
    if (row < rend) { const float* x = xrow_in(a, F, layer, row);
#pragma unroll
        for (int j = 0; j < 4; ++j) nx[j] = *(const f32x4*)(x + 4 * lane_ + 256 * j); }
    for (; row < rend; ++row) {
        f32x4 v[4];
#pragma unroll
        for (int j = 0; j < 4; ++j) v[j] = nx[j];
        if (row + 1 < rend) { const float* x = xrow_in(a, F, layer, row + 1);
#pragma unroll
            for (int j = 0; j < 4; ++j) nx[j] = *(const f32x4*)(x + 4 * lane_ + 256 * j); }
        const int mi = mod_index(row);
        if (mi != cur_mi) { const float* m = MOD + (size_t)mi * MODW; normmod_load(nm, g, m + 0 * DM, m + 1 * DM, lane_); cur_mi = mi; }
        norm_mod_store(v, nm, XN + (size_t)row * DM, lane_);
    }
}
__device__ __forceinline__ void postmix_phase(const Args& a, Frame& F, int layer, int row_lo, int NS) {
    unsigned char* const wsl = opaque_ptr(a.ws);
    const int tid_ = opaque_tid(), lane_ = tid_ & 63, wave_ = __builtin_amdgcn_readfirstlane(tid_ >> 6);
    const float* MOD = (const float*)(wsl + WS_MOD) + (size_t)layer * 17 * MODW; const float* g1 = inp(F, 6) + (size_t)(layer * 4 + 1) * DM; const float* g2 = inp(F, 6) + (size_t)(layer * 4 + 2) * DM;
    bf16_t* XN = (bf16_t*)(wsl + WS_XN); const bf16_t* OO = (const bf16_t*)(wsl + WS_OO); const float* SSQO = (const float*)(wsl + WS_SSQO);
    const int rpw = (NROWS - row_lo) / (F.G * NWAVES); int row = row_lo + (F.vcu * NWAVES + wave_) * rpw; const int rend = row + rpw;
    f32x4 nx[4]; u32x2 no[4]; float nss = 0.f; NormMod nm; f32x4 P1[4]; int cur_mi = -1;
#define PM_LOAD(R) do { const float* x_ = xrow_in(a, F, layer, (R)); \
        _Pragma("unroll") for (int j = 0; j < 4; ++j) { const int c = 4 * lane_ + 256 * j; nx[j] = *(const f32x4*)(x_ + c); no[j] = *(const u32x2*)(OO + (size_t)(R) * DM + c); } \
        nss = lane_ < NS ? SSQO[(size_t)(R) * 32 + lane_] : 0.f; } while (0)
    if (row < rend) PM_LOAD(row);
    for (; row < rend; ++row) {
        f32x4 xv[4]; u32x2 ov[4]; float ss = nss;
#pragma unroll
        for (int j = 0; j < 4; ++j) { xv[j] = nx[j]; ov[j] = no[j]; }
        if (row + 1 < rend) PM_LOAD(row + 1);
        const int mi = mod_index(row);
        if (mi != cur_mi) { const float* m = MOD + (size_t)mi * MODW; normmod_load(nm, g2, m + 3 * DM, m + 4 * DM, lane_);
#pragma unroll
            for (int j = 0; j < 4; ++j) { const int c = 4 * lane_ + 256 * j; P1[j] = *(const f32x4*)(g1 + c) * *(const f32x4*)(m + 2 * DM + c); }
            cur_mi = mi; }
        float* xo = xrow_st(a, row);
        ss = wave_sum(ss);
        const float rstd = __builtin_amdgcn_rsqf(ss * (1.f / DM) + NORM_EPS);
        f32x4 v[4];
#pragma unroll
        for (int j = 0; j < 4; ++j) { const int c = 4 * lane_ + 256 * j;
            const f32x4 o = {bf_lo(ov[j].x), bf_hi(ov[j].x), bf_lo(ov[j].y), bf_hi(ov[j].y)};
            v[j] = xv[j] + P1[j] * (o * rstd); *(f32x4*)(xo + c) = v[j]; }
        norm_mod_store(v, nm, XN + (size_t)row * DM, lane_);
    }
#undef PM_LOAD
}
constexpr size_t WS_Y     = WS_ST;
constexpr size_t WS_H0    = WS_ST + 216 * MiB;
constexpr size_t WS_H1    = WS_ST + 278 * MiB;
constexpr size_t WS_HSH   = WS_ST + 340 * MiB;
constexpr size_t WS_LOG   = WS_ST + 358 * MiB;
constexpr size_t WS_SELI  = WS_ST + 367 * MiB;
constexpr size_t WS_SELW  = WS_SELI + (size_t)NROWS * 32;
constexpr size_t WS_LDST  = WS_ST + 370 * MiB;
constexpr size_t WS_LW    = WS_LDST + 1536 * 1024;
constexpr size_t WS_BLKCNT= WS_ST + 373 * MiB;
constexpr size_t WS_TINFO = WS_BLKCNT + 256 * 192 * 4;
constexpr int NLIST = 192;
static_assert(WS_TINFO + 4 * (512 + 1600) <= WS_ST + 374 * MiB, "MoE stage map");

template <int NT_, int LDA_, bool PERM_> struct DenseRow0 : DenseBase<NT_, LDA_, PERM_> { int row0; };

struct PolShr : DenseRow0<16, 2048, true> {
    bf16_t* HSH; float* LOG;
    __device__ __forceinline__ void epi(const f32x4 (&acc)[2][2][4][2], const DUnit& u, int wr, int wc, int fr, int fq) const {
#pragma unroll
        for (int ai = 0; ai < 2; ++ai)
#pragma unroll
            for (int m = 0; m < 4; ++m) {
                const int row = row0 + u.pm * 256 + ai * 128 + wr * 64 + m * 16 + fr;
                if (u.pn < 2) {
                    f32x4 h0, h1;
#pragma unroll
                    for (int j = 0; j < 4; ++j) { h0[j] = silu_f(acc[ai][0][m][0][j]) * acc[ai][1][m][0][j]; h1[j] = silu_f(acc[ai][0][m][1][j]) * acc[ai][1][m][1][j]; }
                    store8(HSH + (size_t)row * 256 + u.pn * 128 + wc * 32 + 8 * fq, h0, h1);
                } else if (wc < 2) {
                    float* lp = LOG + (size_t)row * 64 + wc * 32 + 8 * fq; *(f32x4*)lp = acc[ai][0][m][0]; *(f32x4*)(lp + 4) = acc[ai][0][m][1];
                }
            }
    }
};

__device__ __forceinline__ int slot_round(int s) { return s < 2 ? 0 : (s < 5 ? 1 : 2); }
__device__ __forceinline__ int slot_yrow(int s) { return s < 2 ? s + 1 : (s < 5 ? s - 2 : s - 5); }
__device__ __forceinline__ void route_phase(const Args& a, Frame& F, int layer, int row_lo, int tpb) {
    unsigned char* const wsl = opaque_ptr(a.ws);
    const int tid_ = opaque_tid(), lane = tid_ & 63, wave = __builtin_amdgcn_readfirstlane(tid_ >> 6);
    LAS int* cnt = (LAS int*)F.lds;
    for (int i = tid_; i < NLIST; i += 512) cnt[i] = 0;
    __syncthreads();
    const float* LOG = (const float*)(wsl + WS_LOG); int* SELI = (int*)(wsl + WS_SELI); float* SELW = (float*)(wsl + WS_SELW);
    const float bias = inp(F, 24)[layer * NEXP + lane];
    const int blk = F.vcu;
    float lg_next = LOG[(size_t)(row_lo + blk * tpb + wave) * 64 + lane];
    for (int t = wave; t < tpb; t += NWAVES) {
        const int row = row_lo + blk * tpb + t;
        const float lg = lg_next; if (t + NWAVES < tpb) lg_next = LOG[(size_t)(row + NWAVES) * 64 + lane];
        const float sc = sigmoid_f(lg), bs = sc + bias;
        float m1 = bs;
        m1 = fmaxf(m1, __shfl_xor(m1, 1)); m1 = fmaxf(m1, __shfl_xor(m1, 2)); m1 = fmaxf(m1, __shfl_xor(m1, 4));
        const unsigned long long eqm = __ballot(bs == m1);
        const int grp = lane >> 3; const unsigned gm = (unsigned)((eqm >> (grp * 8)) & 0xffull);
        float v2 = (bs == m1) ? -INFINITY : bs;
        v2 = fmaxf(v2, __shfl_xor(v2, 1)); v2 = fmaxf(v2, __shfl_xor(v2, 2)); v2 = fmaxf(v2, __shfl_xor(v2, 4));
        const float m2 = (__popc(gm) >= 2) ? m1 : v2;
        const float gs = m1 + m2;
        int grank = 0;
#pragma unroll
        for (int j = 0; j < 8; ++j) { const float o = __shfl(gs, j * 8); grank += (o > gs || (o == gs && j < grp)) ? 1 : 0; }
        const float mv = grank < 4 ? bs : -INFINITY;
        int rank = 0;
#pragma unroll 8
        for (int j = 0; j < 64; ++j) { const float o = __shfl(mv, j); rank += (o > mv || (o == mv && j < lane)) ? 1 : 0; }
        const bool sel = rank < TOPK && grank < 4;
        const float ssum = wave_sum(sel ? sc : 0.f);
        if (sel) { const int s = rank, l = slot_round(s) * 64 + lane;
            SELI[(size_t)row * 8 + s] = l | (slot_yrow(s) << 8); SELW[(size_t)row * 8 + s] = sc / ssum * 2.5f;
            atomicAdd((int*)&cnt[l], 1); }
    }
    __syncthreads();
    int* BLKCNT = (int*)(wsl + WS_BLKCNT);
    for (int i = tid_; i < NLIST; i += 512) BLKCNT[blk * NLIST + i] = cnt[i];
}
__device__ __forceinline__ void place_phase(const Args& a, Frame& F, int row_lo, int tpb) {
    unsigned char* const wsl = opaque_ptr(a.ws);
    const int tid_ = opaque_tid();
    LAS int* tot = (LAS int*)F.lds; LAS int* mine = tot + 256; LAS int* tst = mine + 256; LAS int* cur = tst + 256;
    const int* BLKCNT = (const int*)(wsl + WS_BLKCNT); const int blk = F.vcu;
    if (tid_ < 256) { tot[tid_] = 0; mine[tid_] = 0; cur[tid_] = 0; }
    __syncthreads();
    if (tid_ < 2 * NLIST) { const int l = tid_ % NLIST, b0 = (tid_ / NLIST) * 128; int s = 0, m = 0;
#pragma unroll 16
        for (int b = b0; b < b0 + 128; ++b) { const int c = (b < F.G) ? BLKCNT[b * NLIST + l] : 0; m += (b < blk) ? c : 0; s += c; }
        atomicAdd((int*)&tot[l], s); atomicAdd((int*)&mine[l], m); }
    __syncthreads();
    if (tid_ == 0) { int acc = 0; for (int l = 0; l < NLIST; ++l) { tst[l] = acc; acc += (tot[l] + 255) >> 8; } tst[NLIST] = acc; }
    __syncthreads();
    int* TINFO = (int*)(wsl + WS_TINFO); int* LDST = (int*)(wsl + WS_LDST); float* LW = (float*)(wsl + WS_LW);
    if (blk == 0) {
        for (int i = tid_; i <= NLIST; i += 512) TINFO[i] = tst[i];
        for (int i = tid_; i < NLIST; i += 512) TINFO[256 + i] = tot[i];
        const int lane = tid_ & 63, wv = tid_ >> 6;
        for (int l = wv; l < NLIST; l += NWAVES) { const int t0 = tst[l], t1 = tst[l + 1];
            for (int t = t0 + lane; t < t1; t += 64) TINFO[512 + t] = l;
            const int c = tot[l], base = t0 * 256;
            for (int p = c + lane; p < (t1 - t0) * 256; p += 64) LDST[base + p] = -1; }
    }
    const int* SELI = (const int*)(wsl + WS_SELI); const float* SELW = (const float*)(wsl + WS_SELW);
    for (int i = tid_; i < tpb * 8; i += 512) { const int row = row_lo + blk * tpb + (i >> 3), s = i & 7;
        const int v = SELI[(size_t)row * 8 + s], l = v & 0xff, yr = v >> 8;
        const int pos = tst[l] * 256 + mine[l] + atomicAdd((int*)&cur[l], 1);
        LDST[pos] = row * 3 + yr; LW[pos] = SELW[(size_t)row * 8 + s]; }
}

struct MUnit { int T, pn; };
struct PolMoe1 {
    static constexpr bool PERM = true, GATHER = true, TWOSEG = false;
    static constexpr int NT = 16, KT0 = 16, KS0 = 128, KS1 = 128, LDB = 2048;
    typedef MUnit Unit;
    const char* XN; const char* W1; bf16_t* H; const int* TINFO; const int* LDST; int T0, T1, G, c;
    __device__ __forceinline__ bool next(int i, Unit& u) const { const int L = i * G + c; u.T = T0 + (L >> 1); u.pn = L & 1; return u.T < T1; }
    __device__ __forceinline__ void ctx(const Unit& u, pg8::UCtx<true>& x, const int (&R)[2], const int (&C)[2]) const {
        const int e = __builtin_amdgcn_readfirstlane(TINFO[512 + u.T]) & 63;
        x.a0[0] = XN; x.a0[1] = XN; x.a1[0] = XN; x.a1[1] = XN; x.b = W1 + ((size_t)e * 512 + u.pn * 256) * LDB;
#pragma unroll
        for (int h = 0; h < 2; ++h)
#pragma unroll
            for (int i = 0; i < 2; ++i) { const int d = LDST[u.T * 256 + h * 128 + R[i]]; const int tok = d < 0 ? 0 : d / 3; x.vg[h][i] = (unsigned)tok * 2048u + (unsigned)C[i] * 2u; }
    }
    __device__ __forceinline__ unsigned lane_a0(int, int) const { return 0u; }
    __device__ __forceinline__ unsigned lane_a1(int, int) const { return 0u; }
    __device__ __forceinline__ void epi(const f32x4 (&acc)[2][2][4][2], const Unit& u, int wr, int wc, int fr, int fq) const {
#pragma unroll
        for (int ai = 0; ai < 2; ++ai)
#pragma unroll
            for (int m = 0; m < 4; ++m) {
                const int hrow = (u.T - T0) * 256 + ai * 128 + wr * 64 + m * 16 + fr;
                f32x4 h0, h1;
#pragma unroll
                for (int j = 0; j < 4; ++j) { h0[j] = silu_f(acc[ai][0][m][0][j]) * acc[ai][1][m][0][j]; h1[j] = silu_f(acc[ai][0][m][1][j]) * acc[ai][1][m][1][j]; }
                store8(H + (size_t)hrow * 256 + u.pn * 128 + wc * 32 + 8 * fq, h0, h1);
            }
    }
};
template <bool RMW> struct PolMoe2 {
    static constexpr bool PERM = true, GATHER = false, TWOSEG = false;
    static constexpr int NT = 4, KT0 = 4, KS0 = 128, KS1 = 128, LDB = 512;
    typedef MUnit Unit;
    const char* H; const char* W2; unsigned char* Y; const int* TINFO; const int* LDST; const float* LW; int T0, T1, G, c;
    __device__ __forceinline__ bool next(int i, Unit& u) const { const int L = i * G + c; u.T = T0 + (L >> 2); u.pn = L & 3; return u.T < T1; }
    __device__ __forceinline__ void ctx(const Unit& u, pg8::UCtx<false>& x, const int (&)[2], const int (&)[2]) const {
        const int e = __builtin_amdgcn_readfirstlane(TINFO[512 + u.T]) & 63;
        x.a0[0] = H + (size_t)(u.T - T0) * 256 * 512; x.a0[1] = x.a0[0] + 128 * 512; x.a1[0] = x.a0[0]; x.a1[1] = x.a0[1];
        x.b = W2 + ((size_t)e * 1024 + u.pn * 256) * LDB;
    }
    __device__ __forceinline__ unsigned lane_a0(int R, int C) const { return (unsigned)(R * 512 + C * 2); }
    __device__ __forceinline__ unsigned lane_a1(int, int) const { return 0u; }
    __device__ __forceinline__ void epi(const f32x4 (&acc)[2][2][4][2], const Unit& u, int wr, int wc, int fr, int fq) const {
        const int cofs = u.pn * 256 + wc * 32 + 8 * fq;
#pragma unroll
        for (int ai = 0; ai < 2; ++ai) {
            int d[4]; float w[4];
#pragma unroll
            for (int m = 0; m < 4; ++m) { const int lp = u.T * 256 + ai * 128 + wr * 64 + m * 16 + fr; d[m] = LDST[lp]; w[m] = LW[lp]; }
            u32x2 o[4][2];
            if (RMW) {
#pragma unroll
                for (int m = 0; m < 4; ++m) { const unsigned char* yp = Y + (size_t)(d[m] < 0 ? 0 : d[m]) * DM + cofs; o[m][0] = *(const u32x2*)yp; o[m][1] = *(const u32x2*)(yp + 128); }
            }
#pragma unroll
            for (int m = 0; m < 4; ++m) {
                if (d[m] >= 0) {
                    unsigned char* yp = Y + (size_t)d[m] * DM + cofs; const float ww = w[m];
#pragma unroll
                    for (int bj = 0; bj < 2; ++bj) {
                        f32x4 v0 = acc[ai][bj][m][0] * ww, v1 = acc[ai][bj][m][1] * ww;
                        if (RMW) { v0 += fp8_unpack4(o[m][bj].x); v1 += fp8_unpack4(o[m][bj].y); }
                        u32x2 q; q.x = fp8_pack4(v0); q.y = fp8_pack4(v1); *(u32x2*)(yp + bj * 128) = q;
                    }
                }
            }
            asm volatile("" ::: "memory");
        }
    }
};
struct PolShd : DenseRow0<4, 512, true> {
    unsigned char* Y;
    __device__ __forceinline__ void epi(const f32x4 (&acc)[2][2][4][2], const DUnit& u, int wr, int wc, int fr, int fq) const {
#pragma unroll
        for (int ai = 0; ai < 2; ++ai)
#pragma unroll
            for (int m = 0; m < 4; ++m) {
                const int row = row0 + u.pm * 256 + ai * 128 + wr * 64 + m * 16 + fr;
                unsigned char* yp = Y + (size_t)row * 3 * DM + u.pn * 256 + wc * 32 + 8 * fq;
                u32x2 q0, q1; q0.x = fp8_pack4(acc[ai][0][m][0]); q0.y = fp8_pack4(acc[ai][0][m][1]); q1.x = fp8_pack4(acc[ai][1][m][0]); q1.y = fp8_pack4(acc[ai][1][m][1]);
                *(u32x2*)yp = q0; *(u32x2*)(yp + 128) = q1;
            }
    }
};

__device__ __forceinline__ void combine_phase(const Args& a, Frame& F, int layer, int row_lo) {
    unsigned char* const wsl = opaque_ptr(a.ws);
    const int tid_ = opaque_tid(), lane_ = tid_ & 63, wave_ = __builtin_amdgcn_readfirstlane(tid_ >> 6);
    const float* MOD = (const float*)(wsl + WS_MOD) + (size_t)layer * 17 * MODW; const float* g3 = inp(F, 6) + (size_t)(layer * 4 + 3) * DM;
    const float* MODn = (const float*)(wsl + WS_MOD) + (size_t)1 * 17 * MODW; const float* gn = inp(F, 6) + (size_t)(1 * 4 + 0) * DM;
    bf16_t* XN = (bf16_t*)(wsl + WS_XN); const unsigned char* Y = (const unsigned char*)(wsl + WS_Y);
    const int rpw = (NROWS - row_lo) / (F.G * NWAVES); int row = row_lo + (F.vcu * NWAVES + wave_) * rpw; const int rend = row + rpw;
    f32x4 nx[4]; unsigned ny[4][3]; NormMod nm; f32x4 P3[4]; int cur_mi = -1;
#define CB_LOAD(R) do { const float* x_ = xrow_st(a, (R)); \
        _Pragma("unroll") for (int j = 0; j < 4; ++j) { const int c = 4 * lane_ + 256 * j; nx[j] = *(const f32x4*)(x_ + c); \
            _Pragma("unroll") for (int r = 0; r < 3; ++r) ny[j][r] = *(const unsigned*)(Y + ((size_t)(R) * 3 + r) * DM + c); } } while (0)
    if (row < rend) CB_LOAD(row);
    for (; row < rend; ++row) {
        float* xo = xrow_st(a, row);
        f32x4 f[4], xv[4]; float ss = 0.f;
#pragma unroll
        for (int j = 0; j < 4; ++j) { xv[j] = nx[j]; f[j] = (f32x4){0.f, 0.f, 0.f, 0.f};
#pragma unroll
            for (int r = 0; r < 3; ++r) f[j] += fp8_unpack4(ny[j][r]);
            ss += sq4(f[j]); }
        if (row + 1 < rend) CB_LOAD(row + 1);
        const int mi = mod_index(row);
        if (mi != cur_mi) { const float* m = MOD + (size_t)mi * MODW;
#pragma unroll
            for (int j = 0; j < 4; ++j) { const int c = 4 * lane_ + 256 * j; P3[j] = *(const f32x4*)(g3 + c) * *(const f32x4*)(m + 5 * DM + c); }
            if (layer == 0) { const float* mn = MODn + (size_t)mi * MODW; normmod_load(nm, gn, mn + 0 * DM, mn + 1 * DM, lane_); }
            cur_mi = mi; }
        const float rstd = __builtin_amdgcn_rsqf(wave_sum(ss) * (1.f / DM) + NORM_EPS);
        f32x4 v[4];
#pragma unroll
        for (int j = 0; j < 4; ++j) { const int c = 4 * lane_ + 256 * j; v[j] = xv[j] + P3[j] * (f[j] * rstd); *(f32x4*)(xo + c) = v[j]; }
        if (layer == 0) norm_mod_store(v, nm, XN + (size_t)row * DM, lane_);
    }
#undef CB_LOAD
}
constexpr size_t WS_G    = WS_ST;
constexpr size_t WS_BTY  = WS_ST + 216 * MiB;
constexpr size_t WS_BTS  = WS_ST + 264 * MiB;
constexpr size_t WS_S    = WS_ST + 280 * MiB;
constexpr size_t WS_XIN  = WS_ST + 64 * MiB;
constexpr size_t WS_LAMT = WS_ROPE + 512 * 1024;
constexpr int S5_T = 32;

constexpr size_t WS_KD   = WS_ST + 130 * MiB;
__device__ __forceinline__ f32x2 cmul(f32x2 a, f32x2 b) { return (f32x2){a.x * b.x - a.y * b.y, a.x * b.y + a.y * b.x}; }
__device__ __forceinline__ void s5_tables_unit(const Args& a, Frame& F, int g, int d) {
    unsigned char* const wsl = opaque_ptr(a.ws);
    const int tid = opaque_tid();
    LAS f32x2* pw = (LAS f32x2*)F.lds; LAS f32x2* bb = pw + 33 * 64; LAS f32x2* cm = bb + 64 * 16;
    bf16_t* BTY = (bf16_t*)(wsl + WS_BTY) + (size_t)g * 512 * 768; bf16_t* BTS = (bf16_t*)(wsl + WS_BTS) + (size_t)g * 256 * 512; float* LAMT = (float*)(wsl + WS_LAMT);
    float* KD = (float*)(wsl + WS_KD) + (size_t)(g * 2 + d) * 8192;
    const float* lre = inp(F, 13); const float* lim = inp(F, 14); const float* lst = inp(F, 15);
    const float* bre = inp(F, 16); const float* bim = inp(F, 17); const float* cre = inp(F, 18); const float* cim = inp(F, 19);
    __syncthreads();
    const float step = __expf(lst[d * 64 + g]);
    for (int i = tid; i < 33 * 64; i += 512) { const int k = i >> 6, p = i & 63; const float lr = lre[(d * 64 + g) * 64 + p], li = lim[(d * 64 + g) * 64 + p];
        const float mag = __expf((float)k * lr * step); float c, s; sincos_red((float)k * (li * step), c, s); pw[i] = (f32x2){mag * c, mag * s}; }
    __syncthreads();
    for (int i = tid; i < 64 * 16; i += 512) { const int p = i >> 4; const float lr = lre[(d * 64 + g) * 64 + p], li = lim[(d * 64 + g) * 64 + p];
        const f32x2 lb = pw[64 + p]; const float inv = 1.f / (lr * lr + li * li);
        const f32x2 kap = {((lb.x - 1.f) * lr + lb.y * li) * inv, (lb.y * lr - (lb.x - 1.f) * li) * inv};
        const size_t o = ((size_t)(d * 64 + g) * 64 + p) * 16 + (i & 15); bb[i] = cmul(kap, (f32x2){bre[o], bim[o]}); }
    for (int i = tid; i < 16 * 64; i += 512) { const size_t o = (size_t)(d * 64 + g) * 1024 + i; cm[i] = (f32x2){cre[o], cim[o]}; }
    __syncthreads();
    if (tid < 64) { const f32x2 l32 = pw[32 * 64 + tid]; LAMT[((d * 64 + g) * 64 + tid) * 2] = l32.x; LAMT[((d * 64 + g) * 64 + tid) * 2 + 1] = l32.y; }
    { const int k = tid >> 4, ib = (tid >> 2) & 3, jb = tid & 3; float acc[4][4];
#pragma unroll
      for (int x = 0; x < 4; ++x)
#pragma unroll
        for (int y = 0; y < 4; ++y) acc[x][y] = 0.f;
      for (int p = 0; p < 64; ++p) { const f32x2 w = pw[k * 64 + p]; f32x2 t[4], b[4];
#pragma unroll
        for (int x = 0; x < 4; ++x) { t[x] = cmul(cm[(4 * ib + x) * 64 + p], w); b[x] = bb[p * 16 + 4 * jb + x]; }
#pragma unroll
        for (int x = 0; x < 4; ++x)
#pragma unroll
            for (int y = 0; y < 4; ++y) acc[x][y] += t[x].x * b[y].x - t[x].y * b[y].y; }
#pragma unroll
      for (int x = 0; x < 4; ++x) *(f32x4*)(KD + k * 256 + (4 * ib + x) * 16 + 4 * jb) = (f32x4){acc[x][0], acc[x][1], acc[x][2], acc[x][3]}; }
    for (int o = tid; o < 512 * 64; o += 512) { const int n = o >> 6, p = o & 63, to = n >> 4, i = n & 15;
        const f32x2 w = cmul(cm[i * 64 + p], pw[(d == 0 ? to + 1 : 32 - to) * 64 + p]);
        *(unsigned*)(BTY + (size_t)n * 768 + 512 + 128 * d + 2 * p) = cvt_pk_bf16(w.x, -w.y); }
    for (int o = tid; o < 64 * 256; o += 512) { const int p = o >> 8, kk = (o & 255) * 2, ti = kk >> 4, j = kk & 15;
        const f32x2 pwv = pw[(d == 0 ? 31 - ti : ti) * 64 + p]; const f32x2 v0 = cmul(pwv, bb[p * 16 + j]), v1 = cmul(pwv, bb[p * 16 + j + 1]);
        *(unsigned*)(BTS + (size_t)(128 * d + 2 * p) * 512 + kk) = cvt_pk_bf16(v0.x, v1.x); *(unsigned*)(BTS + (size_t)(128 * d + 2 * p + 1) * 512 + kk) = cvt_pk_bf16(v0.y, v1.y); }
    __syncthreads();
}
__device__ __forceinline__ void s5_tables_phase(const Args& a, Frame& F) { for (int u = F.vcu; u < 128; u += F.G) s5_tables_unit(a, F, u >> 1, u & 1); }
__device__ __forceinline__ void s5_toeplitz_phase(const Args& a, Frame& F) {
    unsigned char* const wsl = opaque_ptr(a.ws);
    const int tid = opaque_tid(); LAS float* Kd = (LAS float*)F.lds; const float* dsk = inp(F, 20);
    for (int u = F.vcu; u < 256; u += F.G) { const int g = u >> 2, q = u & 3;
        const float* KD = (const float*)(wsl + WS_KD) + (size_t)g * 16384; bf16_t* BTY = (bf16_t*)(wsl + WS_BTY) + (size_t)g * 512 * 768;
        __syncthreads();
        for (int i = tid; i < 4096; i += 512) *(f32x4*)(Kd + 4 * i) = *(const f32x4*)(KD + 4 * i);
        __syncthreads();
        for (int o = tid; o < 128 * 256; o += 512) { const int n = 128 * q + (o >> 8), kk = (o & 255) * 2, to = n >> 4, i = n & 15, ti = kk >> 4, j = kk & 15;
            float v0, v1;
            if (to > ti) { v0 = Kd[(to - ti) * 256 + i * 16 + j]; v1 = Kd[(to - ti) * 256 + i * 16 + j + 1]; }
            else if (to < ti) { v0 = Kd[8192 + (ti - to) * 256 + i * 16 + j]; v1 = Kd[8192 + (ti - to) * 256 + i * 16 + j + 1]; }
            else { v0 = Kd[i * 16 + j] + Kd[8192 + i * 16 + j] + (i == j ? dsk[g * 16 + i] : 0.f); v1 = Kd[i * 16 + j + 1] + Kd[8192 + i * 16 + j + 1] + (i == j + 1 ? dsk[g * 16 + i] : 0.f); }
            *(unsigned*)(BTY + (size_t)n * 768 + kk) = cvt_pk_bf16(v0, v1); }
    }
    __syncthreads();
}

struct SUnit { int g, pm, pn; };
struct PolS5S {
    static constexpr bool PERM = false, GATHER = false, TWOSEG = false;
    static constexpr int NT = 8, KT0 = 8, KS0 = 8192, KS1 = 128, LDB = 1024;
    typedef SUnit Unit;
    const char* XN; const char* BTS; float* S; int G, c;
    __device__ __forceinline__ bool next(int i, Unit& u) const { const int L = i * G + c; u.g = __builtin_amdgcn_readfirstlane(L / 5); u.pm = __builtin_amdgcn_readfirstlane(L % 5); u.pn = 0; return L < 320; }
    __device__ __forceinline__ void ctx(const Unit& u, pg8::UCtx<false>& x, const int (&)[2], const int (&)[2]) const {
        if (u.pm < 4) { x.a0[0] = XN + ((size_t)NCTXR + (size_t)u.pm * 256 * S5_T) * 2048 + u.g * 32; x.a0[1] = x.a0[0] + (size_t)128 * S5_T * 2048; }
        else { x.a0[0] = XN + u.g * 32; x.a0[1] = x.a0[0]; }
        x.a1[0] = x.a0[0]; x.a1[1] = x.a0[1]; x.b = BTS + (size_t)u.g * 256 * LDB;
    }
    __device__ __forceinline__ unsigned lane_a0(int R, int C) const { return (unsigned)(R * (S5_T * 2048) + (C >> 4) * 2048 + (C & 15) * 2); }
    __device__ __forceinline__ unsigned lane_a1(int, int) const { return 0u; }
    __device__ __forceinline__ void epi(const f32x4 (&acc)[2][2][4][2], const Unit& u, int wr, int wc, int fr, int fq) const {
#pragma unroll
        for (int ai = 0; ai < 2; ++ai) { if (u.pm == 4 && ai == 1) continue;
#pragma unroll
            for (int m = 0; m < 4; ++m) { const int r = u.pm * 256 + ai * 128 + wr * 64 + m * 16 + fr;
                float* sp = S + ((size_t)u.g * 1152 + r) * 256 + wc * 32 + 4 * fq;
#pragma unroll
                for (int bj = 0; bj < 2; ++bj)
#pragma unroll
                    for (int n = 0; n < 2; ++n) *(f32x4*)(sp + bj * 128 + n * 16) = acc[ai][bj][m][n]; } }
    }
};
__device__ __forceinline__ void s5_scan_phase(const Args& a, Frame& F) {
    unsigned char* const wsl = opaque_ptr(a.ws);
    const int tid = opaque_tid(); const float* S = (const float*)(wsl + WS_S); bf16_t* XIN = (bf16_t*)(wsl + WS_XIN); const float* LAMT = (const float*)(wsl + WS_LAMT);
    for (int idx = F.vcu * 512 + tid; idx < 64 * 16 * 2 * 64; idx += F.G * 512) {
        const int p = idx & 63, d = (idx >> 6) & 1, b = (idx >> 7) & 15, g = idx >> 11;
        const f32x2 Lm = *(const f32x2*)(LAMT + ((d * 64 + g) * 64 + p) * 2);
        const float* Sg = S + (size_t)g * 1152 * 256 + d * 128 + 2 * p; const int col = d * 128 + 2 * p; bf16_t* Xg = XIN + (size_t)(col >> 4) * 1024 + 16 * g + (col & 15);
        f32x2 x = {0.f, 0.f};
        f32x2 sv[8];
#pragma unroll
        for (int k = 0; k < 8; ++k) { const int c = d == 0 ? k : 7 - k; sv[k] = *(const f32x2*)(Sg + (size_t)(1024 + b * 8 + c) * 256); }
#pragma unroll
        for (int k = 0; k < 8; ++k) x = cmul(Lm, x) + sv[k];
        for (int c0 = 0; c0 < 64; c0 += 8) {
#pragma unroll
            for (int k = 0; k < 8; ++k) { const int c = d == 0 ? c0 + k : 63 - c0 - k; sv[k] = *(const f32x2*)(Sg + (size_t)(b * 64 + c) * 256); }
#pragma unroll
            for (int k = 0; k < 8; ++k) { const int c = d == 0 ? c0 + k : 63 - c0 - k; *(unsigned*)(Xg + (size_t)(b * 64 + c) * 32 * 1024) = cvt_pk_bf16(x.x, x.y); x = cmul(Lm, x) + sv[k]; }
        }
    }
}
struct PolS5Y {
    static constexpr bool PERM = true, GATHER = false, TWOSEG = true;
    static constexpr int NT = 12, KT0 = 8, KS0 = 8192, KS1 = 8192, LDB = 1536;
    typedef SUnit Unit;
    const char* XN; const char* XIN; const char* BTY; bf16_t* Gb; int G, c;
    __device__ __forceinline__ bool next(int i, Unit& u) const { const int L = i * G + c; u.g = __builtin_amdgcn_readfirstlane(L >> 3); u.pm = __builtin_amdgcn_readfirstlane((L >> 1) & 3); u.pn = L & 1; return L < 512; }
    __device__ __forceinline__ void ctx(const Unit& u, pg8::UCtx<false>& x, const int (&)[2], const int (&)[2]) const {
        x.a0[0] = XN + ((size_t)NCTXR + (size_t)u.pm * 256 * S5_T) * 2048 + u.g * 32; x.a0[1] = x.a0[0] + (size_t)128 * S5_T * 2048;
        x.a1[0] = XIN + (size_t)u.pm * 256 * S5_T * 2048 + u.g * 32; x.a1[1] = x.a1[0] + (size_t)128 * S5_T * 2048;
        x.b = BTY + ((size_t)u.g * 512 + u.pn * 256) * LDB;
    }
    __device__ __forceinline__ unsigned lane_a0(int R, int C) const { return (unsigned)(R * (S5_T * 2048) + (C >> 4) * 2048 + (C & 15) * 2); }
    __device__ __forceinline__ void epi(const f32x4 (&acc)[2][2][4][2], const Unit& u, int wr, int wc, int fr, int fq) const {
#pragma unroll
        for (int ai = 0; ai < 2; ++ai)
#pragma unroll
            for (int m = 0; m < 4; ++m) { const int r = u.pm * 256 + ai * 128 + wr * 64 + m * 16 + fr;
#pragma unroll
                for (int bj = 0; bj < 2; ++bj) { const int col = u.pn * 256 + bj * 128 + wc * 32 + 8 * fq, to = col >> 4, i0 = col & 15;
                    bf16_t* gp = Gb + ((size_t)r * S5_T + to) * DM + u.g * 16 + i0;
#pragma unroll
                    for (int n = 0; n < 2; ++n) { f32x4 v;
#pragma unroll
                        for (int j = 0; j < 4; ++j) v[j] = gelu_tanh(acc[ai][bj][m][n][j]);
                        u32x2 w; w.x = cvt_pk_bf16(v[0], v[1]); w.y = cvt_pk_bf16(v[2], v[3]); *(u32x2*)(gp + 4 * n) = w; asm volatile("" ::: "memory"); } } }
    }
};
struct PolGlu : DenseRow0<16, 2048, true> {
    bf16_t* OO; float* SSQO; const float* bias;
    __device__ __forceinline__ void epi(const f32x4 (&acc)[2][2][4][2], const DUnit& u, int wr, int wc, int fr, int fq) const {
        const int c0 = u.pn * 128 + wc * 32 + 8 * fq;
        const f32x4 b10 = *(const f32x4*)(bias + c0), b11 = *(const f32x4*)(bias + c0 + 4), b20 = *(const f32x4*)(bias + 1024 + c0), b21 = *(const f32x4*)(bias + 1024 + c0 + 4);
#pragma unroll
        for (int ai = 0; ai < 2; ++ai)
#pragma unroll
            for (int m = 0; m < 4; ++m) {
                const int row = row0 + u.pm * 256 + ai * 128 + wr * 64 + m * 16 + fr;
                f32x4 o0, o1;
#pragma unroll
                for (int j = 0; j < 4; ++j) { o0[j] = (acc[ai][0][m][0][j] + b10[j]) * sigmoid_f(acc[ai][1][m][0][j] + b20[j]); o1[j] = (acc[ai][0][m][1][j] + b11[j]) * sigmoid_f(acc[ai][1][m][1][j] + b21[j]); }
                float s = sq4(o0) + sq4(o1);
                store8(OO + (size_t)row * DM + c0, o0, o1);
                s += __shfl_xor(s, 16); s += __shfl_xor(s, 32);
                if (fq == 0) SSQO[(size_t)row * 32 + u.pn * 4 + wc] = s;
            }
    }
};
#ifndef REP_ATTN
#define REP_ATTN 1
#endif
#ifndef REP_MISC
#define REP_MISC 1
#endif
#ifndef REP_DENSE
#define REP_DENSE 1
#endif
#ifndef REP_G2A
#define REP_G2A 1
#endif
#ifndef REP_P11X
#define REP_P11X 1
#endif
#ifndef REP_PM0
#define REP_PM0 1
#endif
#ifndef REP_H
#define REP_H 1
#endif
#ifndef REP_G1
#define REP_G1 1
#endif
__device__ __forceinline__ void moe_stage(const Args& args, Frame& F, const XcdBarrier& bar, int layer, int row_lo) {
    const int nrows = NROWS - row_lo, tpb = nrows / F.G;
    {   unsigned char* ws = opaque_ptr(args.ws);
        PolShr p; p.A = (const char*)(ws + WS_XN) + (size_t)row_lo * 2048; p.Bt = (const char*)(ws + WS_WSHR) + (size_t)layer * 768 * 2048; p.nM = nrows / 256; p.nN = 3; p.G = F.G; p.c = (int)blockIdx.x;
        p.row0 = row_lo; p.HSH = (bf16_t*)(ws + WS_HSH); p.LOG = (float*)(ws + WS_LOG);
        for (int rep_ = 0; rep_ < REP_DENSE; ++rep_) pg8::gemm_phase(F.lds, p);
    }
    if (layer == 1 && args.stage == 7) return;
    xcd_barrier(bar);
    route_phase(args, F, layer, row_lo, tpb);
#if REP_MISC == 2
    __syncthreads(); route_phase(args, F, layer, row_lo, tpb);
#endif
    if (layer == 1 && args.stage == 8) return;
    xcd_barrier(bar);
    place_phase(args, F, row_lo, tpb);
#if REP_MISC == 2
    __syncthreads(); place_phase(args, F, row_lo, tpb);
#endif
    if (layer == 1 && args.stage == 9) return;
    xcd_barrier(bar);
    const int* TINFO = (const int*)(opaque_ptr(args.ws) + WS_TINFO);
    const int ts0 = __builtin_amdgcn_readfirstlane(TINFO[0]), ts1 = __builtin_amdgcn_readfirstlane(TINFO[64]), ts2 = __builtin_amdgcn_readfirstlane(TINFO[128]), ts3 = __builtin_amdgcn_readfirstlane(TINFO[192]);
#define MOE_G1(TA, TB, HBUF) for (int rep_ = 0; rep_ < REP_G1; ++rep_) do { unsigned char* ws = opaque_ptr(args.ws); PolMoe1 p; p.XN = (const char*)(ws + WS_XN); p.W1 = (const char*)(ws + WS_W1); p.H = (bf16_t*)(ws + (HBUF)); p.TINFO = (const int*)(ws + WS_TINFO); p.LDST = (const int*)(ws + WS_LDST); p.T0 = (TA); p.T1 = (TB); p.G = F.G; p.c = (int)blockIdx.x; \
        pg8::gemm_phase(F.lds, p); } while (0)
#define MOE_G2(RMW, TA, TB, HBUF) do { unsigned char* ws = opaque_ptr(args.ws); PolMoe2<RMW> p; p.H = (const char*)(ws + (HBUF)); p.W2 = (const char*)(ws + WS_W2); p.Y = (unsigned char*)(ws + WS_Y); p.TINFO = (const int*)(ws + WS_TINFO); p.LDST = (const int*)(ws + WS_LDST); p.LW = (const float*)(ws + WS_LW); p.T0 = (TA); p.T1 = (TB); p.G = F.G; p.c = (int)blockIdx.x; \
        pg8::gemm_phase(F.lds, p); } while (0)
    MOE_G1(ts0, ts1, WS_H0);
    if (layer == 1 && args.stage == 10) return;
    xcd_barrier(bar);
#define MOE_SHD() do { unsigned char* ws = opaque_ptr(args.ws); PolShd p; p.A = (const char*)(ws + WS_HSH) + (size_t)row_lo * 512; p.Bt = (const char*)(ws + WS_WSHD) + (size_t)layer * 1024 * 512; p.nM = nrows / 256; p.nN = 4; p.G = F.G; p.c = (int)blockIdx.x; \
        p.row0 = row_lo; p.Y = (unsigned char*)(ws + WS_Y); pg8::gemm_phase(F.lds, p); } while (0)
#if REP_G2A == 2
    MOE_G2(false, ts0, ts1, WS_H0); MOE_SHD();
#endif
    if (blockIdx.x & 1) { MOE_G1(ts1, ts2, WS_H1); MOE_G2(false, ts0, ts1, WS_H0); MOE_SHD(); }
    else { MOE_G2(false, ts0, ts1, WS_H0); MOE_SHD(); MOE_G1(ts1, ts2, WS_H1); }
    if (layer == 1 && args.stage == 11) return;
    xcd_barrier(bar);
    if (blockIdx.x & 1) { MOE_G1(ts2, ts3, WS_H0); MOE_G2(true, ts1, ts2, WS_H1); }
    else { MOE_G2(true, ts1, ts2, WS_H1); MOE_G1(ts2, ts3, WS_H0); }
    if (layer == 1 && args.stage == 12) return;
    xcd_barrier(bar);
    MOE_G2(true, ts2, ts3, WS_H0);
    if (layer == 1 && args.stage == 13) return;
    xcd_barrier(bar);
    if (layer == 0) { s5_tables_phase(args, F); convert_experts(args, F, 1, 0); }
#if REP_P11X == 2
    __syncthreads();
    if (layer == 0) { s5_tables_phase(args, F); convert_experts(args, F, 1, 0); }
#endif
    combine_phase(args, F, layer, row_lo);
#undef MOE_SHD
#undef MOE_G1
#undef MOE_G2
}

__global__ void __launch_bounds__(NWAVES * 64, 2) trunk_fwd(Args args) {
    extern __shared__ __attribute__((aligned(16))) unsigned char lds_raw[];
    Frame F;
    F.lds = (LAS unsigned char*)lds_raw;
    F.G = gridDim.x; { const int bx = blockIdx.x; F.vcu = (F.G % 8 == 0) ? (bx % 8) * (F.G / 8) + bx / 8 : bx; }
    F.ws = args.ws;
    volatile LAS unsigned* MISC = (volatile LAS unsigned*)(F.lds + LDSCTL_OFF);
    for (int u = threadIdx.x; u < (LDS_BYTES - LDSCTL_OFF) / 4; u += NWAVES * 64) ((LAS unsigned*)(F.lds + LDSCTL_OFF))[u] = 0u;
    __syncthreads();
    if (threadIdx.x < 31) ((LAS unsigned long long*)(F.lds + PTAB_OFF))[threadIdx.x] = (unsigned long long)args.in[threadIdx.x];
    __syncthreads();
    XcdBarrier bar = xcd_barrier_post((unsigned*)(args.ws + WS_CTL) + CW_BAR, MISC + 8);
#define GRID_BAR() xcd_barrier(bar)

    mod_phase(args, F);
    __syncthreads();
    convert_small(args, F);
    rope_phase(args, F);
    convert_experts(args, F, 0, 0);
#if REP_MISC == 2
    __syncthreads();
    mod_phase(args, F);
    __syncthreads();
    convert_small(args, F);
    rope_phase(args, F);
    convert_experts(args, F, 0, 0);
#endif
    GRID_BAR();
    h_phase(args, F, 0, 0);
#if REP_H == 2
    h_phase(args, F, 0, 0);
#endif
    GRID_BAR();
    {   unsigned char* ws = opaque_ptr(args.ws);
        PolDqkv p; p.A = (const char*)(ws + WS_XN); p.Bt = (const char*)(ws + WS_WDQKV); p.nM = NROWS / 256; p.nN = 3; p.G = F.G; p.c = (int)blockIdx.x;
        p.A1 = (bf16_t*)(ws + WS_A1); p.SSQ1 = (float*)(ws + WS_SSQ1); p.KPE = (bf16_t*)(ws + WS_KPE); p.ROPE = (const float*)(ws + WS_ROPE);
        for (int rep_ = 0; rep_ < REP_DENSE; ++rep_) pg8::gemm_phase(F.lds, p);
    }
    GRID_BAR();
    {   unsigned char* ws = opaque_ptr(args.ws);
        PolQup p; p.A = (const char*)(ws + WS_A1); p.Bt = (const char*)(ws + WS_WUQ); p.nM = NROWS / 256; p.nN = NQ / 256; p.G = F.G; p.c = (int)blockIdx.x;
        p.Q = (bf16_t*)(ws + WS_Q); p.SSQ1 = (const float*)(ws + WS_SSQ1);
        for (int rep_ = 0; rep_ < REP_DENSE; ++rep_) pg8::gemm_phase(F.lds, p);
    }
    {   unsigned char* ws = opaque_ptr(args.ws);
        PolKVup p; p.A = (const char*)(ws + WS_A1) + QLORA * 2; p.Bt = (const char*)(ws + WS_WUKV); p.nM = NROWS / 256; p.nN = NKV / 256; p.G = F.G; p.c = (int)blockIdx.x;
        p.KV = (bf16_t*)(ws + WS_KV); p.SSQ1 = (const float*)(ws + WS_SSQ1);
        for (int rep_ = 0; rep_ < REP_DENSE; ++rep_) pg8::gemm_phase(F.lds, p);
    }
    GRID_BAR();
    {   unsigned char* ws = opaque_ptr(args.ws);
        const bf16_t* Qg = (const bf16_t*)(ws + WS_Q); const bf16_t* KVb = (const bf16_t*)(ws + WS_KV); const bf16_t* KPE = (const bf16_t*)(ws + WS_KPE); bf16_t* Og = (bf16_t*)(ws + WS_O); const float* RP = (const float*)(ws + WS_ROPE);
        for (int rep_ = 0; rep_ < REP_ATTN; ++rep_)
        for (int u = F.vcu; u < 1024 + 128; u += F.G) {
            if (u < 1024) { const int bh = u >> 3, qb = u & 7, b = bh >> 3, h = bh & 7;
                attn::attn_unit(Qg, KVb, KPE, Og, RP, NCTXR + b * SEQL + qb * 256, qb * 256, h, b * NCTX, NCTXR + b * SEQL, 36, (char*)lds_raw); }
            else { const int bh = u - 1024, b = bh >> 3, h = bh & 7;
                attn::attn_unit(Qg, KVb, KPE, Og, RP, b * NCTX, -1, h, b * NCTX, 0, 4, (char*)lds_raw); }
        }
    }
    GRID_BAR();
    {   unsigned char* ws = opaque_ptr(args.ws);
        PolWo p; p.A = (const char*)(ws + WS_O); p.Bt = (const char*)(ws + WS_WO); p.nM = NROWS / 256; p.nN = 4; p.G = F.G; p.c = (int)blockIdx.x;
        p.OO = (bf16_t*)(ws + WS_OO); p.SSQO = (float*)(ws + WS_SSQO);
        for (int rep_ = 0; rep_ < REP_DENSE; ++rep_) pg8::gemm_phase(F.lds, p);
    }
    GRID_BAR();
    postmix_phase(args, F, 0, 0, 16);
#if REP_PM0 == 2
    postmix_phase(args, F, 0, 0, 16);
#endif
    GRID_BAR();
    moe_stage(args, F, bar, 0, 0);
    if (args.stage == 1) return;
    GRID_BAR();
    {   unsigned char* ws = opaque_ptr(args.ws);
        PolS5S p; p.XN = (const char*)(ws + WS_XN); p.BTS = (const char*)(ws + WS_BTS); p.S = (float*)(ws + WS_S); p.G = F.G; p.c = (int)blockIdx.x;
        for (int rep_ = 0; rep_ < REP_DENSE; ++rep_) pg8::gemm_phase(F.lds, p);
    }
    if (args.stage == 2) return;
    GRID_BAR();
    s5_toeplitz_phase(args, F);
    s5_scan_phase(args, F);
#if REP_MISC == 2
    s5_scan_phase(args, F);
#endif
    if (args.stage == 3) return;
    GRID_BAR();
    {   unsigned char* ws = opaque_ptr(args.ws);
        PolS5Y p; p.XN = (const char*)(ws + WS_XN); p.XIN = (const char*)(ws + WS_XIN); p.BTY = (const char*)(ws + WS_BTY); p.Gb = (bf16_t*)(ws + WS_G); p.G = F.G; p.c = (int)blockIdx.x;
        for (int rep_ = 0; rep_ < REP_DENSE; ++rep_) pg8::gemm_phase(F.lds, p);
    }
    if (args.stage == 4) return;
    GRID_BAR();
    {   unsigned char* ws = opaque_ptr(args.ws);
        PolGlu p; p.A = (const char*)(ws + WS_G); p.Bt = (const char*)(ws + WS_WGLU); p.nM = NLATR / 256; p.nN = 8; p.G = F.G; p.c = (int)blockIdx.x;
        p.row0 = NCTXR; p.OO = (bf16_t*)(ws + WS_OO); p.SSQO = (float*)(ws + WS_SSQO); p.bias = inp(F, 22);
        for (int rep_ = 0; rep_ < REP_DENSE; ++rep_) pg8::gemm_phase(F.lds, p);
    }
    if (args.stage == 5) return;
    GRID_BAR();
    postmix_phase(args, F, 1, NCTXR, 32);
    if (args.stage == 6) return;
    GRID_BAR();
    moe_stage(args, F, bar, 1, NCTXR);
}

#ifndef DBG_STAGE
#define DBG_STAGE 0
#endif
extern "C" void kernel_launch(void* const* d_in, const int* in_sizes, int n_in, void* d_out, int out_size, void* d_ws, size_t ws_size, hipStream_t stream) {
    static int grid = 0;
    if (grid == 0) {
        if (n_in != 31 || out_size != NLATR * DM || ws_size < WS_END) { fprintf(stderr, "kernel_launch: unexpected shapes (n_in %d out %d ws %zu)\n", n_in, out_size, ws_size); grid = -1; return; }
        int dev = 0, cus = 0;
        if (hipGetDevice(&dev) != hipSuccess || hipDeviceGetAttribute(&cus, hipDeviceAttributeMultiprocessorCount, dev) != hipSuccess) { grid = -1; return; }
        if (hipFuncSetAttribute((const void*)trunk_fwd, hipFuncAttributeMaxDynamicSharedMemorySize, LDS_BYTES) != hipSuccess) { fprintf(stderr, "kernel_launch: hipFuncSetAttribute failed\n"); grid = -1; return; }
        (void)hipGetLastError();
        grid = cus;
    }
    if (grid < 0) return;
    (void)hipMemsetAsync((char*)d_ws + WS_CTL, 0, CTL_BYTES, stream);
    Args a{};
    for (int i = 0; i < 31; ++i) a.in[i] = (const float*)d_in[i];
    a.out = (float*)d_out; a.ws = (unsigned char*)d_ws; a.stage = DBG_STAGE; a.pad = 0;
    hipLaunchKernelGGL(trunk_fwd, dim3(grid), dim3(NWAVES * 64), LDS_BYTES, stream, a);
}
```

```cpp
#include <hip/hip_runtime.h>
#include <cstdio>
#include <cstdint>

#define GAS __attribute__((address_space(1)))
#define LAS __attribute__((address_space(3)))
typedef unsigned short bf16_t;
typedef short bf16x8 __attribute__((ext_vector_type(8)));
typedef short s16x4 __attribute__((ext_vector_type(4)));
typedef float f32x2 __attribute__((ext_vector_type(2)));
typedef float f32x4 __attribute__((ext_vector_type(4)));
typedef float f32x16 __attribute__((ext_vector_type(16)));
typedef unsigned u32x2 __attribute__((ext_vector_type(2)));
typedef unsigned u32x4 __attribute__((ext_vector_type(4)));

constexpr int DM = 1024, NBATCH = 16, SEQL = 2048, NCTX = 256;
constexpr int NCTXR = NBATCH * NCTX;
constexpr int NLATR = NBATCH * SEQL;
constexpr int NROWS = NCTXR + NLATR;
constexpr int NHEAD = 8, QLORA = 384, KVLORA = 256, NOPE = 128, ROPED = 64, VDIM = 128;
constexpr int NDQKV = 768;
constexpr int NQ = NHEAD * (NOPE + ROPED);
constexpr int NKV = NHEAD * (NOPE + VDIM);
constexpr int NEXP = 64, TOPK = 8, DEXP = 256;
constexpr float NORM_EPS = 1e-6f;
constexpr int NMOD = 6, MODW = NMOD * DM;

constexpr size_t MiB = 1u << 20;
constexpr size_t WS_CTL = 0, CTL_BYTES = 1 * MiB;
constexpr size_t WS_WDQKV = 1 * MiB;
constexpr size_t WS_WUQ   = WS_WDQKV + 1536 * 1024;
constexpr size_t WS_WUKV  = WS_WUQ + 1280 * 1024;
constexpr size_t WS_WO    = WS_WUKV + 1 * MiB;
constexpr size_t WS_WGLU  = WS_WO + 2 * MiB;
constexpr size_t WS_WSHR  = WS_WGLU + 4 * MiB;
constexpr size_t WS_WSHD  = WS_WSHR + 3 * MiB;
constexpr size_t WS_MOD   = 15 * MiB;
constexpr size_t WS_ROPE  = 16 * MiB;
constexpr size_t WS_W1    = 17 * MiB;
constexpr size_t WS_W2    = 81 * MiB;
constexpr size_t WS_XCTX  = 113 * MiB;
constexpr size_t WS_XN    = 129 * MiB;
constexpr size_t WS_ST    = 201 * MiB;
static_assert(WS_WSHD + 1 * MiB <= WS_MOD, "small weights fit");
constexpr size_t WS_KV   = WS_ST;
constexpr size_t WS_Q    = WS_ST + 144 * MiB;
constexpr size_t WS_OO   = WS_Q;
constexpr size_t WS_A1   = WS_ST + 252 * MiB;
constexpr size_t WS_O    = WS_A1;
constexpr size_t WS_KPE  = WS_ST + 324 * MiB;
constexpr size_t WS_SSQ1 = WS_ST + 329 * MiB;
constexpr size_t WS_SSQO = WS_ST + 332 * MiB;
constexpr size_t WS_END  = WS_ST + 402 * MiB;

constexpr int CW_BAR = 4096;

__device__ __forceinline__ unsigned cvt_pk_bf16(float lo, float hi) { unsigned r; asm volatile("v_cvt_pk_bf16_f32 %0, %1, %2" : "=v"(r) : "v"(lo), "v"(hi)); return r; }
__device__ __forceinline__ float bf_lo(unsigned w) { return __uint_as_float(w << 16); }
__device__ __forceinline__ float bf_hi(unsigned w) { return __uint_as_float(w & 0xffff0000u); }
__device__ __forceinline__ float wave_sum(float v) {
#pragma unroll
    for (int o = 1; o < 64; o <<= 1) v += __shfl_xor(v, o);
    return v;
}
__device__ __forceinline__ float silu_f(float v) { return v * __builtin_amdgcn_rcpf(1.f + __builtin_amdgcn_exp2f(-1.4426950408889634f * v)); }
__device__ __forceinline__ float sigmoid_f(float v) { return __builtin_amdgcn_rcpf(1.f + __builtin_amdgcn_exp2f(-1.4426950408889634f * v)); }
__device__ __forceinline__ int mod_index(int row) { return row < NCTXR ? 16 : (row - NCTXR) / SEQL; }
__device__ __forceinline__ int opaque_tid() { int t = threadIdx.x; asm volatile("" : "+v"(t)); return t; }
__device__ __forceinline__ float gelu_tanh(float v) {
    const float z = 0.7978845608028654f * (v + 0.044715f * v * v * v);
    return v * __builtin_amdgcn_rcpf(1.f + __builtin_amdgcn_exp2f(-2.8853900817779268f * z));
}
__device__ __forceinline__ unsigned char* opaque_ptr(unsigned char* p) {
    unsigned lo = __builtin_amdgcn_readfirstlane((unsigned)(unsigned long long)p), hi = __builtin_amdgcn_readfirstlane((unsigned)((unsigned long long)p >> 32));
    asm volatile("" : "+s"(lo), "+s"(hi)); return (unsigned char*)(((unsigned long long)hi << 32) | lo); }
constexpr float Y_SCALE = 64.f, Y_INV = 1.f / 64.f, Y_MAX = 448.f;
__device__ __forceinline__ unsigned fp8_pack4(const f32x4& v) {
    const float a = fminf(fmaxf(v[0] * Y_SCALE, -Y_MAX), Y_MAX), b = fminf(fmaxf(v[1] * Y_SCALE, -Y_MAX), Y_MAX), c = fminf(fmaxf(v[2] * Y_SCALE, -Y_MAX), Y_MAX), d = fminf(fmaxf(v[3] * Y_SCALE, -Y_MAX), Y_MAX);
    int p = __builtin_amdgcn_cvt_pk_fp8_f32(a, b, 0, false); p = __builtin_amdgcn_cvt_pk_fp8_f32(c, d, p, true); return (unsigned)p; }
__device__ __forceinline__ f32x4 fp8_unpack4(unsigned w) {
    const f32x2 lo = __builtin_amdgcn_cvt_pk_f32_fp8((int)w, false), hi = __builtin_amdgcn_cvt_pk_f32_fp8((int)w, true);
    return (f32x4){lo.x * Y_INV, lo.y * Y_INV, hi.x * Y_INV, hi.y * Y_INV}; }
#define XB_TMO      128
#define XB_XCNT(j)  (256  + 64 * (j))
#define XB_XSUB(j)  (1280 + 64 * (j))
#define XB_XGEN(j)  (2304 + 64 * (j))
#define XB_TOP      3328
#define XB_TOPGEN   3392
#define XCD_BAR_WORDS 3456
#define XB_SPIN_CAP (1u << 18)
__device__ __forceinline__ unsigned xb_ld(unsigned* p)              { return __hip_atomic_load(p, __ATOMIC_RELAXED, __HIP_MEMORY_SCOPE_AGENT); }
__device__ __forceinline__ unsigned xb_add(unsigned* p, unsigned v) { return __hip_atomic_fetch_add(p, v, __ATOMIC_RELAXED, __HIP_MEMORY_SCOPE_AGENT); }
__device__ __forceinline__ unsigned xb_xcc_id() { return (unsigned)__builtin_amdgcn_s_getreg((3 << 11) | 20) & 0xFu; }
#define XB_SPIN(cond, bar) do { unsigned _sp = 0; while (cond) { __builtin_amdgcn_s_sleep(1); \
    if ((++_sp & 255u) == 0u) { if (xb_ld(&(bar)[XB_TMO])) break; if (_sp > XB_SPIN_CAP) { atomicAdd(&(bar)[XB_TMO], 1u); break; } } } } while (0)
struct XcdBarrier { unsigned* bar; unsigned x; volatile LAS unsigned* st; };
__device__ __forceinline__ XcdBarrier xcd_barrier_post(unsigned* bar, volatile LAS unsigned* st) {
    XcdBarrier b; b.bar = bar; b.x = xb_xcc_id(); b.st = st;
    if (threadIdx.x == 0) (void)xb_add(&bar[XB_XCNT(b.x)], 1u);
    return b;
}
__device__ __forceinline__ void xcd_barrier_complete(unsigned* bar, unsigned x, unsigned& nloc, unsigned& nx) {
    const unsigned G = gridDim.x * gridDim.y * gridDim.z;
    unsigned sum, cnt, mine, sp = 0u;
    for (;;) {
        sum = 0u; cnt = 0u; mine = 0u;
#pragma unroll
        for (unsigned j = 0; j < 16; ++j) { const unsigned c = xb_ld(&bar[XB_XCNT(j)]); sum += c; cnt += (c > 0u) ? 1u : 0u; mine = (j == x) ? c : mine; }
        if (sum == G) break;
        __builtin_amdgcn_s_sleep(1);
        if ((++sp & 255u) == 0u) { if (xb_ld(&bar[XB_TMO])) break; if (sp > XB_SPIN_CAP) { atomicAdd(&bar[XB_TMO], 1u); break; } }
    }
    nloc = mine > 0u ? mine : 1u; nx = cnt > 0u ? cnt : 1u;
}
__device__ __forceinline__ void xcd_barrier(const XcdBarrier& b) {
    asm volatile("s_waitcnt vmcnt(0)" ::: "memory");
    __syncthreads();
    if (threadIdx.x == 0) {
        unsigned* bar = b.bar;
        __builtin_amdgcn_s_waitcnt(0);
        unsigned nloc = b.st[0], nx = b.st[1];
        if (nloc == 0u) { xcd_barrier_complete(bar, b.x, nloc, nx); b.st[0] = nloc; b.st[1] = nx; }
        const unsigned old = xb_add(&bar[XB_XSUB(b.x)], 1u);
        const unsigned gen = old / nloc;
        if (old + 1u == (gen + 1u) * nloc) {
            __builtin_amdgcn_fence(__ATOMIC_RELEASE, "agent");
            asm volatile("s_waitcnt vmcnt(0)" ::: "memory");
            const unsigned og = xb_add(&bar[XB_TOP], 1u);
            const unsigned tg = og / nx;
            if (og + 1u == (tg + 1u) * nx) xb_add(&bar[XB_TOPGEN], 1u);
            else XB_SPIN(xb_ld(&bar[XB_TOPGEN]) == tg, bar);
            __builtin_amdgcn_fence(__ATOMIC_ACQUIRE, "agent");
            xb_add(&bar[XB_XGEN(b.x)], 1u);
            asm volatile("s_waitcnt vmcnt(0)" ::: "memory");
        } else {
            XB_SPIN(xb_ld(&bar[XB_XGEN(b.x)]) == gen, bar);
            __builtin_amdgcn_fence(__ATOMIC_ACQUIRE, "agent");
            asm volatile("s_waitcnt vmcnt(0)" ::: "memory");
        }
    }
    __syncthreads();
}

namespace pg8 {
constexpr int BM = 256, BK = 64, HALF = 128, HTB = HALF * BK * 2, STAGE_BYTES = 8 * HTB, NXCD = 8, WGM = 8;
__host__ __device__ __forceinline__ int lds_byte(int r, int c) { const int st = (r >> 4) * 2 + (c >> 5), rr = r & 15, cc = c & 31, ob = rr * 64 + cc * 2; return st * 1024 + (ob ^ (((ob >> 9) & 1) << 5)); }
__host__ __device__ __forceinline__ void stage_rc(int b, int& R, int& C) { const int st = b / 1024, sb = b % 1024, swz = sb ^ (((sb >> 9) & 1) << 5); R = (st >> 1) * 16 + swz / 64; C = (st & 1) * 32 + (swz % 64) / 2; }
__host__ __device__ __forceinline__ int perm32(int rho) { const int n = rho >> 4, i = rho & 15; return 8 * (i >> 2) + 4 * n + (i & 3); }

__device__ __forceinline__ bool dense_order(int i, int G, int c, int nM, int nN, int& pm, int& pn) {
    const int nwg = nM * nN; const long L = (long)i * G + c; if (L >= nwg) return false;
    int wgid = (int)L; { const int q = nwg / NXCD, r = nwg % NXCD, xcd = wgid % NXCD, off = wgid / NXCD; wgid = (xcd < r ? xcd * (q + 1) : r * (q + 1) + (xcd - r) * q) + off; }
    const int nig = WGM * nN, gid = wgid / nig, fm = gid * WGM, gsz = (nM - fm) < WGM ? (nM - fm) : WGM;
    pm = __builtin_amdgcn_readfirstlane(fm + ((wgid % nig) % gsz)); pn = __builtin_amdgcn_readfirstlane((wgid % nig) / gsz); return true;
}

template <bool GATHER> struct UCtx { const char* a0[2]; const char* a1[2]; const char* b; unsigned vg[2][2]; };
template <> struct UCtx<false> { const char* a0[2]; const char* a1[2]; const char* b; };

template <class P>
__device__ __forceinline__ void gemm_phase(LAS unsigned char* lds, const P& pol) {
    typedef typename P::Unit Unit;
    const int tid = opaque_tid(), wid = __builtin_amdgcn_readfirstlane(tid >> 6), lane = tid & 63, wr = wid >> 2, wc = wid & 3, fr = lane & 15, fq = lane >> 4;
    constexpr int nt = P::NT;
    int Rr[2], Cc[2]; unsigned voffB[2], va0[2];
#pragma unroll
    for (int i = 0; i < 2; ++i) { stage_rc(tid * 16 + i * 8192, Rr[i], Cc[i]); const int Rb = P::PERM ? ((Rr[i] & ~31) + perm32(Rr[i] & 31)) : Rr[i];
        voffB[i] = (unsigned)(Rb * P::LDB + Cc[i] * 2); va0[i] = pol.lane_a0(Rr[i], Cc[i]); }
    constexpr size_t hstepB = (size_t)HALF * P::LDB;
    const unsigned ldsw = (unsigned)wid * 1024u;
    const int aoff = lds_byte(wr * 64 + fr, fq * 8), boff = lds_byte(wc * 32 + fr, fq * 8);
#define PG8_SA(b, h) (((b) * 2 + (h)) * HTB)
#define PG8_SB(b, h) ((4 + (b) * 2 + (h)) * HTB)
#define PG8_GL(bufoff, p0, p1) do { __builtin_amdgcn_global_load_lds((const unsigned*)(p0), (LAS unsigned*)(lds + (bufoff) + ldsw), 16, 0, 0); \
        __builtin_amdgcn_global_load_lds((const unsigned*)(p1), (LAS unsigned*)(lds + (bufoff) + ldsw + 8192), 16, 0, 0); } while (0)
#define PG8_STB(bufoff, U, h, kt) do { const char* _b = (U).b + (size_t)(h) * hstepB + (size_t)(kt) * 128; asm volatile("" : "+s"(_b)); PG8_GL(bufoff, _b + voffB[0], _b + voffB[1]); } while (0)
#define PG8_STA(bufoff, U, h, kt) do { const char* _a = (U).a0[h] + (size_t)(kt) * P::KS0; if constexpr (P::TWOSEG) { if ((kt) >= P::KT0) _a = (U).a1[h] + (size_t)((kt) - P::KT0) * P::KS1; } \
        unsigned _o0, _o1; if constexpr (P::GATHER) { _o0 = (U).vg[h][0]; _o1 = (U).vg[h][1]; } else { _o0 = va0[0]; _o1 = va0[1]; } \
        asm volatile("" : "+s"(_a)); PG8_GL(bufoff, _a + _o0, _a + _o1); } while (0)
#define PG8_LDA(dst, b, h) do { _Pragma("unroll") for (int m = 0; m < 4; ++m) _Pragma("unroll") for (int k = 0; k < 2; ++k) dst[m][k] = *(const LAS bf16x8*)(lds + PG8_SA(b, h) + aoff + m * 2048 + k * 1024); } while (0)
#define PG8_LDB(dst, b, h) do { _Pragma("unroll") for (int n = 0; n < 2; ++n) _Pragma("unroll") for (int k = 0; k < 2; ++k) dst[n][k] = *(const LAS bf16x8*)(lds + PG8_SB(b, h) + boff + n * 2048 + k * 1024); } while (0)
#define PG8_MMA(ai, bj, At, Bt) do { __builtin_amdgcn_s_setprio(1); _Pragma("unroll") for (int m = 0; m < 4; ++m) _Pragma("unroll") for (int n = 0; n < 2; ++n) _Pragma("unroll") for (int k = 0; k < 2; ++k) \
        acc[ai][bj][m][n] = __builtin_amdgcn_mfma_f32_16x16x32_bf16(Bt[n][k], At[m][k], acc[ai][bj][m][n], 0, 0, 0); __builtin_amdgcn_s_setprio(0); } while (0)
#define PG8_WAIT_V(n) asm volatile("s_waitcnt vmcnt(" #n ")" ::: "memory")
#define PG8_WAIT_L(n) asm volatile("s_waitcnt lgkmcnt(" #n ")" ::: "memory")
#define PG8_BAR __builtin_amdgcn_s_barrier()
#define PG8_SCHED __builtin_amdgcn_sched_barrier(0)
    Unit cur, nxt; int ui = 0;
    if (!pol.next(0, cur)) return;
    UCtx<P::GATHER> cc, nc;
    pol.ctx(cur, cc, Rr, Cc);
    f32x4 acc[2][2][4][2];
#pragma unroll
    for (int a = 0; a < 2; ++a)
#pragma unroll
        for (int b = 0; b < 2; ++b)
#pragma unroll
            for (int m = 0; m < 4; ++m)
#pragma unroll
                for (int n = 0; n < 2; ++n) acc[a][b][m][n] = (f32x4){0.f, 0.f, 0.f, 0.f};
    bf16x8 At[4][2], B0[2][2], B1[2][2];
    PG8_STB(PG8_SB(0, 0), cc, 0, 0); PG8_STB(PG8_SB(0, 1), cc, 1, 0); PG8_STA(PG8_SA(0, 0), cc, 0, 0); PG8_STA(PG8_SA(0, 1), cc, 1, 0);
    if (wr == 1) PG8_BAR;
    PG8_WAIT_V(2); PG8_BAR;
    PG8_STB(PG8_SB(1, 0), cc, 0, 1); PG8_STA(PG8_SA(1, 0), cc, 0, 1); PG8_STB(PG8_SB(1, 1), cc, 1, 1);
    PG8_WAIT_V(6); PG8_BAR;
    for (;;) {
        const bool has_next = pol.next(ui + 1, nxt);
        if (has_next) pol.ctx(nxt, nc, Rr, Cc); else nc = cc;
        for (int t = 0; t < nt; t += 2) {
            const bool last = (t == nt - 2);
            const int k2 = last ? 0 : t + 2, k3 = k2 + 1;
            PG8_LDB(B0, 0, 0); PG8_LDB(B1, 0, 1); PG8_SCHED; PG8_LDA(At, 0, 0); PG8_STA(PG8_SA(1, 1), cc, 1, t + 1);
            PG8_WAIT_V(8); PG8_WAIT_L(0); PG8_BAR; PG8_MMA(0, 0, At, B0); PG8_MMA(0, 1, At, B1); PG8_BAR; PG8_SCHED;
            PG8_LDA(At, 0, 1);
            if (last) { PG8_STB(PG8_SB(0, 0), nc, 0, 0); PG8_STB(PG8_SB(0, 1), nc, 1, 0); PG8_STA(PG8_SA(0, 0), nc, 0, 0); }
            else      { PG8_STB(PG8_SB(0, 0), cc, 0, k2); PG8_STB(PG8_SB(0, 1), cc, 1, k2); PG8_STA(PG8_SA(0, 0), cc, 0, k2); }
            PG8_WAIT_V(8); PG8_WAIT_L(0); PG8_BAR; PG8_MMA(1, 0, At, B0); PG8_MMA(1, 1, At, B1); PG8_BAR; PG8_SCHED;
            PG8_LDB(B0, 1, 0); PG8_LDB(B1, 1, 1); PG8_SCHED; PG8_LDA(At, 1, 0);
            if (last) { PG8_STA(PG8_SA(0, 1), nc, 1, 0); } else { PG8_STA(PG8_SA(0, 1), cc, 1, k2); }
            PG8_WAIT_V(8); PG8_WAIT_L(0); PG8_BAR; PG8_MMA(0, 0, At, B0); PG8_MMA(0, 1, At, B1); PG8_BAR; PG8_SCHED;
            PG8_LDA(At, 1, 1);
            if (last) { PG8_STB(PG8_SB(1, 0), nc, 0, 1); PG8_STB(PG8_SB(1, 1), nc, 1, 1); PG8_STA(PG8_SA(1, 0), nc, 0, 1); }
            else      { PG8_STB(PG8_SB(1, 0), cc, 0, k3); PG8_STB(PG8_SB(1, 1), cc, 1, k3); PG8_STA(PG8_SA(1, 0), cc, 0, k3); }
            PG8_WAIT_V(8); PG8_WAIT_L(0); PG8_BAR; PG8_MMA(1, 0, At, B0); PG8_MMA(1, 1, At, B1); PG8_BAR; PG8_SCHED;
        }
        if (wr == 0) PG8_BAR;
        pol.epi(acc, cur, wr, wc, fr, fq);
        if (!has_next) break;
#pragma unroll
        for (int a = 0; a < 2; ++a)
#pragma unroll
            for (int b = 0; b < 2; ++b)
#pragma unroll
                for (int m = 0; m < 4; ++m)
#pragma unroll
                    for (int n = 0; n < 2; ++n) acc[a][b][m][n] = (f32x4){0.f, 0.f, 0.f, 0.f};
        cur = nxt; cc = nc; ++ui;
        if (wr == 1) PG8_BAR;
    }
    PG8_WAIT_V(0);
    PG8_BAR;
#undef PG8_SA
#undef PG8_SB
#undef PG8_GL
#undef PG8_STB
#undef PG8_STA
#undef PG8_LDA
#undef PG8_LDB
#undef PG8_MMA
#undef PG8_WAIT_V
#undef PG8_WAIT_L
#undef PG8_BAR
#undef PG8_SCHED
}
}
struct DUnit { int pm, pn; };

template <int NT_, int LDA_, bool PERM_> struct DenseBase {
    static constexpr bool PERM = PERM_, GATHER = false, TWOSEG = false;
    static constexpr int NT = NT_, KT0 = NT_, KS0 = 128, KS1 = 128, LDB = NT_ * 128;
    typedef DUnit Unit;
    const char* A; const char* Bt; int nM, nN, G, c;
    __device__ __forceinline__ bool next(int i, Unit& u) const { return pg8::dense_order(i, G, c, nM, nN, u.pm, u.pn); }
    __device__ __forceinline__ void ctx(const Unit& u, pg8::UCtx<false>& x, const int (&)[2], const int (&)[2]) const {
        x.a0[0] = A + (size_t)u.pm * 256 * LDA_; x.a0[1] = x.a0[0] + (size_t)128 * LDA_; x.a1[0] = x.a0[0]; x.a1[1] = x.a0[1];
        x.b = Bt + (size_t)u.pn * 256 * LDB; }
    __device__ __forceinline__ unsigned lane_a0(int R, int C) const { return (unsigned)(R * LDA_ + C * 2); }
    __device__ __forceinline__ unsigned lane_a1(int, int) const { return 0u; }
};

__device__ __forceinline__ void store8(bf16_t* p, const f32x4& v0, const f32x4& v1) {
    u32x4 w; w.x = cvt_pk_bf16(v0[0], v0[1]); w.y = cvt_pk_bf16(v0[2], v0[3]); w.z = cvt_pk_bf16(v1[0], v1[1]); w.w = cvt_pk_bf16(v1[2], v1[3]); *(u32x4*)p = w; }
__device__ __forceinline__ float sq4(const f32x4& v) { return (v[0] * v[0] + v[1] * v[1]) + (v[2] * v[2] + v[3] * v[3]); }
__device__ __forceinline__ void rope8(f32x4& v0, f32x4& v1, const float* cs) {
    const f32x4 a = *(const f32x4*)cs, b = *(const f32x4*)(cs + 4);
    float x0, x1;
    x0 = v0[0]; x1 = v0[1]; v0[0] = x0 * a[0] - x1 * a[1]; v0[1] = x0 * a[1] + x1 * a[0];
    x0 = v0[2]; x1 = v0[3]; v0[2] = x0 * a[2] - x1 * a[3]; v0[3] = x0 * a[3] + x1 * a[2];
    x0 = v1[0]; x1 = v1[1]; v1[0] = x0 * b[0] - x1 * b[1]; v1[1] = x0 * b[1] + x1 * b[0];
    x0 = v1[2]; x1 = v1[3]; v1[2] = x0 * b[2] - x1 * b[3]; v1[3] = x0 * b[3] + x1 * b[2];
}

struct PolDqkv : DenseBase<16, 2048, true> {
    bf16_t* A1; float* SSQ1; bf16_t* KPE; const float* ROPE;
    __device__ __forceinline__ void epi(const f32x4 (&acc)[2][2][4][2], const DUnit& u, int wr, int wc, int fr, int fq) const {
#pragma unroll
        for (int ai = 0; ai < 2; ++ai)
#pragma unroll
            for (int m = 0; m < 4; ++m) {
                const int row = u.pm * 256 + ai * 128 + wr * 64 + m * 16 + fr;
                bf16_t* rowp = A1 + (size_t)row * NDQKV + u.pn * 256 + wc * 32 + 8 * fq;
                float s0 = sq4(acc[ai][0][m][0]) + sq4(acc[ai][0][m][1]), s1 = sq4(acc[ai][1][m][0]) + sq4(acc[ai][1][m][1]);
                store8(rowp, acc[ai][0][m][0], acc[ai][0][m][1]); store8(rowp + 128, acc[ai][1][m][0], acc[ai][1][m][1]);
                s0 += __shfl_xor(s0, 16); s0 += __shfl_xor(s0, 32); s1 += __shfl_xor(s1, 16); s1 += __shfl_xor(s1, 32);
                if (fq == 0) {
                    float* sp = SSQ1 + (size_t)row * 16;
                    if (u.pn == 0) sp[wc] = s0 + s1; else if (u.pn == 1) { sp[4 + wc] = s0; sp[8 + wc] = s1; } else sp[12 + wc] = s0;
                }
                if (u.pn == 2 && wc < 2) {
                    f32x4 v0 = acc[ai][1][m][0], v1 = acc[ai][1][m][1];
                    if (row >= NCTXR) { const int t = (row - NCTXR) & (SEQL - 1); rope8(v0, v1, ROPE + ((size_t)t * 32 + 16 * wc + 4 * fq) * 2); }
                    store8(KPE + (size_t)row * 64 + 32 * wc + 8 * fq, v0, v1);
                }
            }
    }
};

struct PolQup : DenseBase<6, NDQKV * 2, true> {
    bf16_t* Q; const float* SSQ1;
    __device__ __forceinline__ void epi(const f32x4 (&acc)[2][2][4][2], const DUnit& u, int wr, int wc, int fr, int fq) const {
#pragma unroll
        for (int ai = 0; ai < 2; ++ai) {
            f32x4 p0[4], p1[4];
#pragma unroll
            for (int m = 0; m < 4; ++m) { const int row = u.pm * 256 + ai * 128 + wr * 64 + m * 16 + fr; p0[m] = *(const f32x4*)(SSQ1 + (size_t)row * 16); p1[m] = *(const f32x4*)(SSQ1 + (size_t)row * 16 + 4); }
#pragma unroll
            for (int m = 0; m < 4; ++m) {
                const int row = u.pm * 256 + ai * 128 + wr * 64 + m * 16 + fr;
                const float ss = ((p0[m][0] + p0[m][1]) + (p0[m][2] + p0[m][3])) + ((p1[m][0] + p1[m][1]) + (p1[m][2] + p1[m][3]));
                const float rstd = __builtin_amdgcn_rsqf(ss * (1.f / QLORA) + NORM_EPS);
                bf16_t* rowp = Q + (size_t)row * NQ + u.pn * 256 + wc * 32 + 8 * fq;
                store8(rowp, acc[ai][0][m][0] * rstd, acc[ai][0][m][1] * rstd); store8(rowp + 128, acc[ai][1][m][0] * rstd, acc[ai][1][m][1] * rstd);
            }
            asm volatile("" ::: "memory");
        }
    }
};

struct PolKVup : DenseBase<4, NDQKV * 2, true> {
    bf16_t* KV; const float* SSQ1;
    __device__ __forceinline__ void epi(const f32x4 (&acc)[2][2][4][2], const DUnit& u, int wr, int wc, int fr, int fq) const {
#pragma unroll
        for (int ai = 0; ai < 2; ++ai) {
            f32x4 p0[4], p1[4];
#pragma unroll
            for (int m = 0; m < 4; ++m) { const int row = u.pm * 256 + ai * 128 + wr * 64 + m * 16 + fr; p0[m] = *(const f32x4*)(SSQ1 + (size_t)row * 16 + 8); p1[m] = *(const f32x4*)(SSQ1 + (size_t)row * 16 + 12); }
#pragma unroll
            for (int m = 0; m < 4; ++m) {
                const int row = u.pm * 256 + ai * 128 + wr * 64 + m * 16 + fr;
                const float ss = ((p0[m][0] + p0[m][1]) + (p0[m][2] + p0[m][3])) + ((p1[m][0] + p1[m][1]) + (p1[m][2] + p1[m][3]));
                const float rstd = __builtin_amdgcn_rsqf(ss * (1.f / KVLORA) + NORM_EPS);
                bf16_t* rowp = KV + (size_t)row * NKV + u.pn * 256 + wc * 32 + 8 * fq;
                store8(rowp, acc[ai][0][m][0] * rstd, acc[ai][0][m][1] * rstd); store8(rowp + 128, acc[ai][1][m][0] * rstd, acc[ai][1][m][1] * rstd);
            }
            asm volatile("" ::: "memory");
        }
    }
};

struct PolWo : DenseBase<16, 2048, true> {
    bf16_t* OO; float* SSQO;
    __device__ __forceinline__ void epi(const f32x4 (&acc)[2][2][4][2], const DUnit& u, int wr, int wc, int fr, int fq) const {
#pragma unroll
        for (int ai = 0; ai < 2; ++ai)
#pragma unroll
            for (int m = 0; m < 4; ++m) {
                const int row = u.pm * 256 + ai * 128 + wr * 64 + m * 16 + fr;
                bf16_t* rowp = OO + (size_t)row * DM + u.pn * 256 + wc * 32 + 8 * fq;
                float s = (sq4(acc[ai][0][m][0]) + sq4(acc[ai][0][m][1])) + (sq4(acc[ai][1][m][0]) + sq4(acc[ai][1][m][1]));
                store8(rowp, acc[ai][0][m][0], acc[ai][0][m][1]); store8(rowp + 128, acc[ai][1][m][0], acc[ai][1][m][1]);
                s += __shfl_xor(s, 16); s += __shfl_xor(s, 32);
                if (fq == 0) SSQO[(size_t)row * 32 + u.pn * 4 + wc] = s;
            }
    }
};
namespace attn {
constexpr int NW = 8, QBLK = 32, KVBLK = 64, DQK = 192, DV = 128;
constexpr float SCALE = 0.07216878364870322f;
constexpr float THR = 8.f;
constexpr int SHM_V = KVBLK * DV * 2, SHM_K = KVBLK * DQK * 2;
constexpr int SHM_QPE = NW * 4096;
constexpr int SHM_ATTN = 2 * SHM_V + 2 * SHM_K + NW * 64 * 4 + SHM_QPE;
#define KSWZ(row, colB) ((row) * 384 + ((colB) ^ (((row) & 7) << 4)))
#define SBAR() __builtin_amdgcn_sched_barrier(0)
__device__ __forceinline__ int crow(int r, int hi) { return (r & 3) + 8 * (r >> 2) + 4 * hi; }
__device__ __forceinline__ unsigned cvtpk(float lo, float hi) { unsigned r; asm volatile("v_cvt_pk_bf16_f32 %0, %1, %2" : "=v"(r) : "v"(lo), "v"(hi)); return r; }

__device__ __forceinline__ void partialSM(f32x16& p0, f32x16& p1, float& m_reg, float& mn, float& alpha) {
  constexpr float C = SCALE * 1.4426950408889634f;
  float pmax = p0[0];
#pragma unroll
  for (int r = 1; r < 16; ++r) pmax = fmaxf(pmax, p0[r]);
#pragma unroll
  for (int r = 0; r < 16; ++r) pmax = fmaxf(pmax, p1[r]);
  { auto rr = __builtin_amdgcn_permlane32_swap(__float_as_uint(pmax), __float_as_uint(pmax), false, false);
    pmax = fmaxf(__uint_as_float(rr[0]), __uint_as_float(rr[1])); }
  if (__builtin_expect(__all(pmax - m_reg <= THR / SCALE), 1)) { mn = m_reg; alpha = 1.f; }
  else { mn = fmaxf(m_reg, pmax); alpha = __builtin_amdgcn_exp2f((m_reg - mn) * C); m_reg = mn; }
  float mnC = -mn * C;
#pragma unroll
  for (int r = 0; r < 16; ++r) p0[r] = fmaf(p0[r], C, mnC);
#pragma unroll
  for (int r = 0; r < 16; ++r) p1[r] = fmaf(p1[r], C, mnC);
#pragma unroll
  for (int r = 0; r < 16; ++r) p0[r] = __builtin_amdgcn_exp2f(p0[r]);
}
__device__ __forceinline__ void finishSM(f32x16& p0, f32x16& p1, float alpha, float& l_reg, bf16x8& pa0, bf16x8& pa1, bf16x8& pa2, bf16x8& pa3) {
#pragma unroll
  for (int r = 0; r < 16; ++r) p1[r] = __builtin_amdgcn_exp2f(p1[r]);
  float ps = 0;
#pragma unroll
  for (int r = 0; r < 16; ++r) ps += p0[r];
#pragma unroll
  for (int r = 0; r < 16; ++r) ps += p1[r];
  { auto rr = __builtin_amdgcn_permlane32_swap(__float_as_uint(ps), __float_as_uint(ps), false, false);
    ps = __uint_as_float(rr[0]) + __uint_as_float(rr[1]); }
  l_reg = l_reg * alpha + ps;
#define PK4(P, BASE, OUT) do { unsigned a0 = cvtpk(P[BASE + 0], P[BASE + 1]), a1 = cvtpk(P[BASE + 2], P[BASE + 3]);   \
    unsigned b0 = cvtpk(P[BASE + 4], P[BASE + 5]), b1 = cvtpk(P[BASE + 6], P[BASE + 7]);                              \
    auto r0 = __builtin_amdgcn_permlane32_swap(a0, b0, false, false); auto r1 = __builtin_amdgcn_permlane32_swap(a1, b1, false, false); \
    u32x4 w = {r0[0], r1[0], r0[1], r1[1]}; OUT = *reinterpret_cast<bf16x8*>(&w); } while (0)
  PK4(p0, 0, pa0); PK4(p0, 8, pa1); PK4(p1, 0, pa2); PK4(p1, 8, pa3);
#undef PK4
}
__device__ __forceinline__ void qkt(f32x16& p0, f32x16& p1, const char* Ks, const bf16x8* qr, const char* qpe, int r32, int hi) {
  p0 = f32x16{}; p1 = f32x16{};
#pragma unroll
  for (int d0 = 0; d0 < 12; ++d0) { int cb = (d0 * 16 + hi * 8) * 2;
    bf16x8 b0 = *reinterpret_cast<const bf16x8*>(Ks + KSWZ(r32, cb));
    bf16x8 b1 = *reinterpret_cast<const bf16x8*>(Ks + KSWZ(32 + r32, cb));
    const bf16x8 q = d0 < 8 ? qr[d0 < 8 ? d0 : 0] : *reinterpret_cast<const bf16x8*>(qpe + (d0 - 8) * 1024);
    p0 = __builtin_amdgcn_mfma_f32_32x32x16_bf16(b0, q, p0, 0, 0, 0);
    p1 = __builtin_amdgcn_mfma_f32_32x32x16_bf16(b1, q, p1, 0, 0, 0);
    if ((d0 & 3) == 3) SBAR(); }
}
__device__ __forceinline__ int v_st(int k, int c) { const int kk = (k & ~0xC) | ((k & 4) << 1) | ((k & 8) >> 1); return ((kk >> 3) * 4 + (c >> 5)) * 512 + ((kk & 7) * 32 + (c & 31)) * 2; }
__device__ __forceinline__ int v_rd_base(int lane) { return ((lane & 3) << 3) | (((lane >> 2) & 3) << 6) | (((lane >> 4) & 1) << 5) | (((lane >> 5) & 1) << 8); }
constexpr int v_rd_off(int d0, int ks, int half) { return d0 * 512 + ks * 4096 + half * 2048; }
template <int OFF> __device__ __forceinline__ s16x4 tr_read(int vb) {
  s16x4 r; asm volatile("ds_read_b64_tr_b16 %0, %1 offset:%2" : "=&v"(r) : "v"(vb), "i"(OFF) : "memory"); return r;
}
template <int D0> __device__ __forceinline__ void pv_one(f32x16& od, int vb, bf16x8 pa0, bf16x8 pa1, bf16x8 pa2, bf16x8 pa3) {
  const s16x4 l0 = tr_read<v_rd_off(D0, 0, 0)>(vb), h0 = tr_read<v_rd_off(D0, 0, 1)>(vb), l1 = tr_read<v_rd_off(D0, 1, 0)>(vb), h1 = tr_read<v_rd_off(D0, 1, 1)>(vb);
  const s16x4 l2 = tr_read<v_rd_off(D0, 2, 0)>(vb), h2 = tr_read<v_rd_off(D0, 2, 1)>(vb), l3 = tr_read<v_rd_off(D0, 3, 0)>(vb), h3 = tr_read<v_rd_off(D0, 3, 1)>(vb);
  asm volatile("s_waitcnt lgkmcnt(0)" ::: "memory"); SBAR();
#define PK(L, H) (bf16x8){L[0], L[1], L[2], L[3], H[0], H[1], H[2], H[3]}
  od = __builtin_amdgcn_mfma_f32_32x32x16_bf16(pa0, PK(l0, h0), od, 0, 0, 0);
  od = __builtin_amdgcn_mfma_f32_32x32x16_bf16(pa1, PK(l1, h1), od, 0, 0, 0);
  od = __builtin_amdgcn_mfma_f32_32x32x16_bf16(pa2, PK(l2, h2), od, 0, 0, 0);
  od = __builtin_amdgcn_mfma_f32_32x32x16_bf16(pa3, PK(l3, h3), od, 0, 0, 0);
#undef PK
}
__device__ __forceinline__ void pv_d0(f32x16* o, int vb, bf16x8 pa0, bf16x8 pa1, bf16x8 pa2, bf16x8 pa3) {
  pv_one<0>(o[0], vb, pa0, pa1, pa2, pa3); pv_one<1>(o[1], vb, pa0, pa1, pa2, pa3); pv_one<2>(o[2], vb, pa0, pa1, pa2, pa3); pv_one<3>(o[3], vb, pa0, pa1, pa2, pa3);
}

__device__ __forceinline__ void attn_unit(const bf16_t* __restrict__ Qg, const bf16_t* __restrict__ KVb, const bf16_t* __restrict__ KPE, bf16_t* __restrict__ Og, const float* __restrict__ ROPE,
                                          int qrow0, int qt0, int h, int crow0, int lrow0, int NT, char* lds) {
  const int tid = opaque_tid(), wid = tid >> 6, lane = tid & 63, r32 = lane & 31, hi = lane >> 5;
  char* V_lds = lds; char* K_lds = lds + 2 * SHM_V;
  float* ws = (float*)(lds + 2 * SHM_V + 2 * SHM_K) + wid * 64; float* li_l = ws; float* al_l = ws + 32;
  float m_reg = -1e30f, l_reg = 0; f32x16 o[4] = {}; bf16x8 qr[8];
  char* qpe = lds + 2 * SHM_V + 2 * SHM_K + NW * 64 * 4 + wid * 4096 + lane * 16;
  const bf16_t* Qw = Qg + (size_t)(qrow0 + wid * QBLK + r32) * NQ + h * DQK + hi * 8;
#pragma unroll
  for (int d0 = 0; d0 < 8; ++d0) qr[d0] = *reinterpret_cast<const bf16x8*>(Qw + d0 * 16);
#pragma unroll
  for (int d0 = 8; d0 < 12; ++d0) {
    u32x4 qv = *reinterpret_cast<const u32x4*>(Qw + d0 * 16);
    if (qt0 >= 0) { const float* cs = ROPE + ((size_t)(qt0 + wid * QBLK + r32) * 32 + 8 * (d0 - 8) + 4 * hi) * 2; const f32x4 ca = *(const f32x4*)cs, cb = *(const f32x4*)(cs + 4);
      float x0, x1;
      x0 = bf_lo(qv.x); x1 = bf_hi(qv.x); qv.x = cvtpk(x0 * ca[0] - x1 * ca[1], x0 * ca[1] + x1 * ca[0]);
      x0 = bf_lo(qv.y); x1 = bf_hi(qv.y); qv.y = cvtpk(x0 * ca[2] - x1 * ca[3], x0 * ca[3] + x1 * ca[2]);
      x0 = bf_lo(qv.z); x1 = bf_hi(qv.z); qv.z = cvtpk(x0 * cb[0] - x1 * cb[1], x0 * cb[1] + x1 * cb[0]);
      x0 = bf_lo(qv.w); x1 = bf_hi(qv.w); qv.w = cvtpk(x0 * cb[2] - x1 * cb[3], x0 * cb[3] + x1 * cb[2]); }
    *reinterpret_cast<u32x4*>(qpe + (d0 - 8) * 1024) = qv; }
  const int sr = tid >> 4, sc = (tid & 15) * 8, vst0 = v_st(sr, sc), vst1 = v_st(32 + sr, sc);
  const int pr = tid >> 3, pc = (tid & 7) * 8;
  const int vb0 = (int)(uintptr_t)V_lds + v_rd_base(lane);
  bf16x8 vs0, vs1, ks0, ks1, kp;
#define TROW(j) ((j) < 4 ? crow0 + 64 * (j) : lrow0 + 64 * ((j) - 4))
#define SLOAD(j) do { const int k0_ = TROW(j); const bf16_t* kv0_ = KVb + (size_t)(k0_ + sr) * NKV + h * 256 + sc; const bf16_t* kv1_ = kv0_ + (size_t)32 * NKV; \
    vs0 = *reinterpret_cast<const bf16x8*>(kv0_ + 128); vs1 = *reinterpret_cast<const bf16x8*>(kv1_ + 128); \
    ks0 = *reinterpret_cast<const bf16x8*>(kv0_); ks1 = *reinterpret_cast<const bf16x8*>(kv1_); \
    kp = *reinterpret_cast<const bf16x8*>(KPE + (size_t)(k0_ + pr) * 64 + pc); } while (0)
#define SWRITE(b) do { *(bf16x8*)(V_lds + (b) * SHM_V + vst0) = vs0; *(bf16x8*)(V_lds + (b) * SHM_V + vst1) = vs1; \
    *(bf16x8*)(K_lds + (b) * SHM_K + KSWZ(sr, sc * 2)) = ks0; *(bf16x8*)(K_lds + (b) * SHM_K + KSWZ(32 + sr, sc * 2)) = ks1; \
    *(bf16x8*)(K_lds + (b) * SHM_K + KSWZ(pr, (128 + pc) * 2)) = kp; } while (0)
#define SWAIT() asm volatile("s_waitcnt vmcnt(0)" ::: "memory")
#define RESC(a) do { if (__any((a) < 1.f)) { if (hi == 0) al_l[r32] = (a); asm volatile("s_waitcnt lgkmcnt(0)" ::: "memory"); \
    _Pragma("unroll") for (int d = 0; d < 4; ++d) _Pragma("unroll") for (int r = 0; r < 16; ++r) o[d][r] *= al_l[crow(r, hi)]; } } while (0)
  f32x16 pA0, pA1, pB0, pB1; float mnA, mnB, alA, alB; bf16x8 pa0, pa1, pa2, pa3;
  SLOAD(0); SWAIT(); SWRITE(0); __syncthreads();
  qkt(pA0, pA1, K_lds, qr, qpe, r32, hi); partialSM(pA0, pA1, m_reg, mnA, alA);
  SLOAD(1);
  SWAIT(); SWRITE(1); __syncthreads();
  for (int j = 1; j + 1 < NT; j += 2) {
    SBAR(); qkt(pB0, pB1, K_lds + SHM_K, qr, qpe, r32, hi);
    finishSM(pA0, pA1, alA, l_reg, pa0, pa1, pa2, pa3); SBAR();
    SLOAD(j + 1); SBAR();
    pv_d0(o, vb0, pa0, pa1, pa2, pa3); partialSM(pB0, pB1, m_reg, mnB, alB);
    __syncthreads(); SWAIT(); SWRITE(0);
    RESC(alB); __syncthreads();
    SBAR(); qkt(pA0, pA1, K_lds, qr, qpe, r32, hi);
    finishSM(pB0, pB1, alB, l_reg, pa0, pa1, pa2, pa3); SBAR();
    SLOAD(j + 2); SBAR();
    pv_d0(o, vb0 + SHM_V, pa0, pa1, pa2, pa3); partialSM(pA0, pA1, m_reg, mnA, alA);
    __syncthreads(); SWAIT(); SWRITE(1);
    RESC(alA); __syncthreads();
  }
  SBAR(); qkt(pB0, pB1, K_lds + SHM_K, qr, qpe, r32, hi);
  finishSM(pA0, pA1, alA, l_reg, pa0, pa1, pa2, pa3); SBAR();
  pv_d0(o, vb0, pa0, pa1, pa2, pa3); partialSM(pB0, pB1, m_reg, mnB, alB);
  __syncthreads(); RESC(alB);
  finishSM(pB0, pB1, alB, l_reg, pa0, pa1, pa2, pa3); SBAR();
  pv_d0(o, vb0 + SHM_V, pa0, pa1, pa2, pa3);
  if (hi == 0) li_l[r32] = l_reg; asm volatile("s_waitcnt lgkmcnt(0)" ::: "memory");
  float rli[16];
#pragma unroll
  for (int r = 0; r < 16; ++r) rli[r] = __builtin_amdgcn_rcpf(li_l[crow(r, hi)]);
  bf16_t* Ow = Og + (size_t)(qrow0 + wid * QBLK) * DM + h * DV;
#pragma unroll
  for (int r = 0; r < 16; ++r) { const int orow = crow(r, hi);
#pragma unroll
    for (int d0 = 0; d0 < 4; ++d0) Ow[(size_t)orow * DM + d0 * 32 + r32] = (bf16_t)(cvtpk(o[d0][r] * rli[r], 0.f) & 0xffffu); }
  __syncthreads();
#undef TROW
#undef SLOAD
#undef SWRITE
#undef SWAIT
#undef RESC
}
#undef KSWZ
#undef SBAR
}
constexpr int NWAVES = 8;
constexpr int RING_BYTES = 131072, LDSCTL_OFF = RING_BYTES, LDS_BYTES = 147456;

struct Args {
    const float* in[31]; float* out; unsigned char* ws; int stage; int pad;
};
struct Frame {
    LAS unsigned char* lds; int vcu, G; unsigned char* ws;
};
constexpr int PTAB_OFF = 131072 + 512;
__device__ __forceinline__ const float* inp(const Frame& F, int i) {
    const LAS unsigned* t = (const LAS unsigned*)(F.lds + PTAB_OFF) + 2 * i;
    const unsigned lo = __builtin_amdgcn_readfirstlane(t[0]), hi = __builtin_amdgcn_readfirstlane(t[1]);
    return (const float*)(((unsigned long long)hi << 32) | lo);
}

__device__ __forceinline__ unsigned f2bf(float f) { unsigned u = __float_as_uint(f); return (u + 0x7fffu + ((u >> 16) & 1u)) >> 16; }
__device__ __forceinline__ unsigned pk2(float lo, float hi) { return f2bf(lo) | (f2bf(hi) << 16); }
__device__ __forceinline__ void cvt_item(const float* srcA, const float* srcB, const float* kscale, bf16_t* dst, int ld, int K, int nrows, int nvalid, int mode, int item, LAS float* scr, int lane) {
    const int nblk = nrows >> 5, kb = item / nblk, nb = item - kb * nblk, k0 = 64 * kb, n0 = 32 * nb;
    const float* src = srcA; int col = n0; bool valid = n0 < nvalid;
    if (mode == 1) { const int t = n0 >> 8, r = n0 & 255; src = r < 128 ? srcA : srcB; col = 128 * t + (r & 127); valid = true; }
    const int kk = lane >> 3, n4 = (lane & 7) * 4;
    f32x4 v[8];
    if (valid) {
        const float* sp = src + (size_t)(k0 + kk) * ld + col + n4;
#pragma unroll
        for (int i = 0; i < 8; ++i) v[i] = *(const f32x4*)(sp + (size_t)(8 * i) * ld);
        if (kscale) {
#pragma unroll
            for (int i = 0; i < 8; ++i) v[i] = v[i] * kscale[k0 + 8 * i + kk];
        }
    } else {
#pragma unroll
        for (int i = 0; i < 8; ++i) v[i] = (f32x4){0.f, 0.f, 0.f, 0.f};
    }
#pragma unroll
    for (int i = 0; i < 8; ++i) { LAS float* d = scr + (8 * i + kk) * 33 + n4; d[0] = v[i][0]; d[1] = v[i][1]; d[2] = v[i][2]; d[3] = v[i][3]; }
    asm volatile("s_waitcnt lgkmcnt(0)" ::: "memory");
    const int c = lane & 7;
#pragma unroll
    for (int j = 0; j < 4; ++j) { const int n = (lane >> 3) + 8 * j; const LAS float* s = scr + (8 * c) * 33 + n;
        u32x4 o; o.x = cvt_pk_bf16(s[0 * 33], s[1 * 33]); o.y = cvt_pk_bf16(s[2 * 33], s[3 * 33]); o.z = cvt_pk_bf16(s[4 * 33], s[5 * 33]); o.w = cvt_pk_bf16(s[6 * 33], s[7 * 33]);
        *(u32x4*)(dst + (size_t)(n0 + n) * K + k0 + 8 * c) = o; }
    asm volatile("s_waitcnt lgkmcnt(0)" ::: "memory");
}
constexpr int N_SMALL_JOBS = 11;
__device__ __forceinline__ void convert_small(const Args& a, Frame& F) {
    unsigned char* const wsl = opaque_ptr(a.ws);
    const int tid_ = opaque_tid(), lane_ = tid_ & 63, wave_ = __builtin_amdgcn_readfirstlane(tid_ >> 6);
    LAS float* scr = (LAS float*)(F.lds + wave_ * 16384);
    const int gw = F.vcu * NWAVES + wave_, NGW = F.G * NWAVES;
    unsigned char* ws = wsl;
    int base = 0;
#define SMALL_JOB(SA, SB, KS, DST, LD, KK, NR, NV, MODE) do { const int n_ = ((KK) >> 6) * ((NR) >> 5); const int first_ = ((gw - base) % NGW + NGW) % NGW; \
        for (int it = first_; it < n_; it += NGW) cvt_item(SA, SB, KS, DST, LD, KK, NR, NV, MODE, it, scr, lane_); base += n_; } while (0)
    SMALL_JOB(inp(F, 7), nullptr, nullptr, (bf16_t*)(ws + WS_WDQKV), 704, 1024, 768, 704, 0);
    SMALL_JOB(inp(F, 10), nullptr, inp(F, 8), (bf16_t*)(ws + WS_WUQ), 1536, 384, 1536, 1536, 0);
    SMALL_JOB(inp(F, 11), nullptr, inp(F, 9), (bf16_t*)(ws + WS_WUKV), 2048, 256, 2048, 2048, 0);
    SMALL_JOB(inp(F, 12), nullptr, nullptr, (bf16_t*)(ws + WS_WO), 1024, 1024, 1024, 1024, 0);
    SMALL_JOB(inp(F, 21), inp(F, 21) + 1024, nullptr, (bf16_t*)(ws + WS_WGLU), 2048, 1024, 2048, 2048, 1);
#pragma unroll 1
    for (int l = 0; l < 2; ++l) {
        SMALL_JOB(inp(F, 28) + (size_t)l * 1024 * 256, inp(F, 29) + (size_t)l * 1024 * 256, nullptr, (bf16_t*)(ws + WS_WSHR) + (size_t)l * 768 * 1024, 256, 1024, 512, 512, 1);
        SMALL_JOB(inp(F, 23) + (size_t)l * 1024 * 64, nullptr, nullptr, (bf16_t*)(ws + WS_WSHR) + (size_t)l * 768 * 1024 + (size_t)512 * 1024, 64, 1024, 256, 64, 0);
        SMALL_JOB(inp(F, 30) + (size_t)l * 256 * 1024, nullptr, nullptr, (bf16_t*)(ws + WS_WSHD) + (size_t)l * 1024 * 256, 1024, 256, 1024, 1024, 0);
    }
#undef SMALL_JOB
}
__device__ __forceinline__ void convert_experts(const Args& a, Frame& F, int layer, int skip) {
    unsigned char* const wsl = opaque_ptr(a.ws);
    const int tid_ = opaque_tid(), lane_ = tid_ & 63, wave_ = __builtin_amdgcn_readfirstlane(tid_ >> 6);
    LAS float* scr = (LAS float*)(F.lds + wave_ * 16384);
    const int gw = (F.vcu - skip) * NWAVES + wave_, NGW = (F.G - skip) * NWAVES;
    for (int it = gw; it < NEXP * 384; it += NGW) { const int e = it / 384, r = it - e * 384; const size_t eo = ((size_t)layer * NEXP + e) * 1024 * 256;
        if (r < 256) cvt_item(inp(F, 25) + eo, inp(F, 26) + eo, nullptr, (bf16_t*)(wsl + WS_W1) + (size_t)e * 512 * 1024, 256, 1024, 512, 512, 1, r, scr, lane_);
        else cvt_item(inp(F, 27) + eo, nullptr, nullptr, (bf16_t*)(wsl + WS_W2) + (size_t)e * 1024 * 256, 1024, 256, 1024, 1024, 0, r - 256, scr, lane_); }
}

__device__ __forceinline__ void mod_phase(const Args& a, Frame& F) {
    unsigned char* const wsl = opaque_ptr(a.ws);
    const int tid_ = opaque_tid(), lane_ = tid_ & 63, wave_ = __builtin_amdgcn_readfirstlane(tid_ >> 6);
    LAS float* sl = (LAS float*)F.lds;
    LAS float* red = sl + 17 * 1024;
    float* MOD = (float*)(wsl + WS_MOD);
    bool have = false;
    for (int u = F.vcu; u < 256; u += F.G) {
        if (!have) { for (int i = tid_; i < 17 * 1024; i += 512) { const float v = i < 16 * 1024 ? inp(F, 1)[i] : inp(F, 3)[i - 16 * 1024]; sl[i] = silu_f(v); } __syncthreads(); have = true; }
        const int l = u >> 7, n0 = (u & 127) * 48, kg = tid_ >> 6, cl = (tid_ & 63) < 48 ? (tid_ & 63) : 47, col = n0 + cl;
        const float* W = inp(F, 4) + (size_t)l * 1024 * MODW + col;
        float acc[17];
#pragma unroll
        for (int b = 0; b < 17; ++b) acc[b] = 0.f;
#pragma unroll 8
        for (int k = kg; k < 1024; k += 8) { const float w = W[(size_t)k * MODW];
#pragma unroll
            for (int b = 0; b < 17; ++b) acc[b] += sl[b * 1024 + k] * w; }
#pragma unroll
        for (int b = 0; b < 17; ++b) red[(kg * 17 + b) * 64 + (tid_ & 63)] = acc[b];
        __syncthreads();
        for (int i = tid_; i < 17 * 64; i += 512) { const int b = i >> 6, c = i & 63; if (c >= 48) continue; float s = inp(F, 5)[(size_t)l * MODW + n0 + c];
#pragma unroll
            for (int g = 0; g < 8; ++g) s += red[(g * 17 + b) * 64 + c];
            MOD[((size_t)l * 17 + b) * MODW + n0 + c] = s; }
        __syncthreads();
    }
}
__device__ __forceinline__ void sincos_red(float ang, float& c, float& s) {
    const float k = rintf(ang * 0.15915494309189535f);
    float r = fmaf(-k, 6.2831854820251465f, ang); r = fmaf(-k, -1.7484555314695172e-07f, r);
    s = __sinf(r); c = __cosf(r);
}
__device__ __forceinline__ void rope_phase(const Args& a, Frame& F) {
    unsigned char* const wsl = opaque_ptr(a.ws);
    const int tid_ = opaque_tid(), lane_ = tid_ & 63, wave_ = __builtin_amdgcn_readfirstlane(tid_ >> 6);
    float* ROPE = (float*)(wsl + WS_ROPE);
    for (int i = (F.vcu * 512 + tid_); i < SEQL * 32; i += F.G * 512) { const int t = i >> 5, p = i & 31, j = p & 15;
        const float f = exp2f(-(float)j * (13.287712379549449f / 16.f)); const float pos = (float)(p < 16 ? (t >> 6) : (t & 63));
        float c, s; sincos_red(pos * f, c, s); ROPE[2 * i] = c; ROPE[2 * i + 1] = s; }
}

__device__ __forceinline__ const float* xrow_in(const Args& a, const Frame& F, int layer, int row) {
    unsigned char* const wsl = opaque_ptr(a.ws);
    if (layer == 0) return row < NCTXR ? inp(F, 2) + (size_t)row * DM : inp(F, 0) + (size_t)(row - NCTXR) * DM;
    return row < NCTXR ? (const float*)(wsl + WS_XCTX) + (size_t)row * DM : a.out + (size_t)(row - NCTXR) * DM;
}
__device__ __forceinline__ float* xrow_st(const Args& a, int row) {
    unsigned char* const wsl = opaque_ptr(a.ws); return row < NCTXR ? (float*)(wsl + WS_XCTX) + (size_t)row * DM : a.out + (size_t)(row - NCTXR) * DM; }
struct NormMod { f32x4 A[4], B[4]; };
__device__ __forceinline__ void normmod_load(NormMod& p, const float* g, const float* shift, const float* scale, int lane) {
#pragma unroll
    for (int j = 0; j < 4; ++j) { const int c = 4 * lane + 256 * j; p.A[j] = *(const f32x4*)(g + c) * (*(const f32x4*)(scale + c) + 1.f); p.B[j] = *(const f32x4*)(shift + c); }
}
__device__ __forceinline__ void norm_mod_store(const f32x4 (&v)[4], const NormMod& p, bf16_t* orow, int lane) {
    float s = 0.f;
#pragma unroll
    for (int j = 0; j < 4; ++j) s += sq4(v[j]);
    const float rstd = __builtin_amdgcn_rsqf(wave_sum(s) * (1.f / DM) + NORM_EPS);
#pragma unroll
    for (int j = 0; j < 4; ++j) { const int c = 4 * lane + 256 * j; const f32x4 h = (v[j] * rstd) * p.A[j] + p.B[j];
        u32x2 w; w.x = cvt_pk_bf16(h[0], h[1]); w.y = cvt_pk_bf16(h[2], h[3]); *(u32x2*)(orow + c) = w; }
}
__device__ __forceinline__ void h_phase(const Args& a, Frame& F, int layer, int row_lo) {
    unsigned char* const wsl = opaque_ptr(a.ws);
    const int tid_ = opaque_tid(), lane_ = tid_ & 63, wave_ = __builtin_amdgcn_readfirstlane(tid_ >> 6);
    const float* MOD = (const float*)(wsl + WS_MOD) + (size_t)layer * 17 * MODW; const float* g = inp(F, 6) + (size_t)(layer * 4 + 0) * DM; bf16_t* XN = (bf16_t*)(wsl + WS_XN);
    const int rpw = (NROWS - row_lo) / (F.G * NWAVES); int row = row_lo + (F.vcu * NWAVES + wave_) * rpw; const int rend = row + rpw;
    f32x4 nx[4]; NormMod nm; int cur_mi = -1;
    if (row < rend) { const float* x = xrow_in(a, F, layer, row);
#pragma unroll
        for (int j = 0; j < 4; ++j) nx[j] = *(const f32x4*)(x + 4 * lane_ + 256 * j); }
    for (; row < rend; ++row) {
        f32x4 v[4];
#pragma unroll
        for (int j = 0; j < 4; ++j) v[j] = nx[j];
        if (row + 1 < rend) { const float* x = xrow_in(a, F, layer, row + 1);
#pragma unroll
            for (int j = 0; j < 4; ++j) nx[j] = *(const f32x4*)(x + 4 * lane_ + 256 * j); }
        const int mi = mod_index(row);
        if (mi != cur_mi) { const float* m = MOD + (size_t)mi * MODW; normmod_load(nm, g, m + 0 * DM, m + 1 * DM, lane_); cur_mi = mi; }
        norm_mod_store(v, nm, XN + (size_t)row * DM, lane_);
    }
}
__device__ __forceinline__ void postmix_phase(const Args& a, Frame& F, int layer, int row_lo, int NS) {
    unsigned char* const wsl = opaque_ptr(a.ws);
    const int tid_ = opaque_tid(), lane_ = tid_ & 63, wave_ = __builtin_amdgcn_readfirstlane(tid_ >> 6);
    const float* MOD = (const float*)(wsl + WS_MOD) + (size_t)layer * 17 * MODW; const float* g1 = inp(F, 6) + (size_t)(layer * 4 + 1) * DM; const float* g2 = inp(F, 6) + (size_t)(layer * 4 + 2) * DM;
    bf16_t* XN = (bf16_t*)(wsl + WS_XN); const bf16_t* OO = (const bf16_t*)(wsl + WS_OO); const float* SSQO = (const float*)(wsl + WS_SSQO);
    const int rpw = (NROWS - row_lo) / (F.G * NWAVES); int row = row_lo + (F.vcu * NWAVES + wave_) * rpw; const int rend = row + rpw;
    f32x4 nx[4]; u32x2 no[4]; float nss = 0.f; NormMod nm; f32x4 P1[4]; int cur_mi = -1;
#define PM_LOAD(R) do { const float* x_ = xrow_in(a, F, layer, (R)); \
        _Pragma("unroll") for (int j = 0; j < 4; ++j) { const int c = 4 * lane_ + 256 * j; nx[j] = *(const f32x4*)(x_ + c); no[j] = *(const u32x2*)(OO + (size_t)(R) * DM + c); } \
        nss = lane_ < NS ? SSQO[(size_t)(R) * 32 + lane_] : 0.f; } while (0)
    if (row < rend) PM_LOAD(row);
    for (; row < rend; ++row) {
        f32x4 xv[4]; u32x2 ov[4]; float ss = nss;
#pragma unroll
        for (int j = 0; j < 4; ++j) { xv[j] = nx[j]; ov[j] = no[j]; }
        if (row + 1 < rend) PM_LOAD(row + 1);
        const int mi = mod_index(row);
        if (mi != cur_mi) { const float* m = MOD + (size_t)mi * MODW; normmod_load(nm, g2, m + 3 * DM, m + 4 * DM, lane_);
#pragma unroll
            for (int j = 0; j < 4; ++j) { const int c = 4 * lane_ + 256 * j; P1[j] = *(const f32x4*)(g1 + c) * *(const f32x4*)(m + 2 * DM + c); }
            cur_mi = mi; }
        float* xo = xrow_st(a, row);
        ss = wave_sum(ss);
        const float rstd = __builtin_amdgcn_rsqf(ss * (1.f / DM) + NORM_EPS);
        f32x4 v[4];
#pragma unroll
        for (int j = 0; j < 4; ++j) { const int c = 4 * lane_ + 256 * j;
            const f32x4 o = {bf_lo(ov[j].x), bf_hi(ov[j].x), bf_lo(ov[j].y), bf_hi(ov[j].y)};
            v[j] = xv[j] + P1[j] * (o * rstd); *(f32x4*)(xo + c) = v[j]; }
        norm_mod_store(v, nm, XN + (size_t)row * DM, lane_);
    }
#undef PM_LOAD
}
constexpr size_t WS_Y     = WS_ST;
constexpr size_t WS_H0    = WS_ST + 216 * MiB;
constexpr size_t WS_H1    = WS_ST + 278 * MiB;
constexpr size_t WS_HSH   = WS_ST + 340 * MiB;
constexpr size_t WS_LOG   = WS_ST + 358 * MiB;
constexpr size_t WS_SELI  = WS_ST + 367 * MiB;
constexpr size_t WS_SELW  = WS_SELI + (size_t)NROWS * 32;
constexpr size_t WS_LDST  = WS_ST + 370 * MiB;
constexpr size_t WS_LW    = WS_LDST + 1536 * 1024;
constexpr size_t WS_BLKCNT= WS_ST + 373 * MiB;
constexpr size_t WS_TINFO = WS_BLKCNT + 256 * 192 * 4;
constexpr int NLIST = 192;
static_assert(WS_TINFO + 4 * (512 + 1600) <= WS_ST + 374 * MiB, "MoE stage map");

template <int NT_, int LDA_, bool PERM_> struct DenseRow0 : DenseBase<NT_, LDA_, PERM_> { int row0; };

struct PolShr : DenseRow0<16, 2048, true> {
    bf16_t* HSH; float* LOG;
    __device__ __forceinline__ void epi(const f32x4 (&acc)[2][2][4][2], const DUnit& u, int wr, int wc, int fr, int fq) const {
#pragma unroll
        for (int ai = 0; ai < 2; ++ai)
#pragma unroll
            for (int m = 0; m < 4; ++m) {
                const int row = row0 + u.pm * 256 + ai * 128 + wr * 64 + m * 16 + fr;
                if (u.pn < 2) {
                    f32x4 h0, h1;
#pragma unroll
                    for (int j = 0; j < 4; ++j) { h0[j] = silu_f(acc[ai][0][m][0][j]) * acc[ai][1][m][0][j]; h1[j] = silu_f(acc[ai][0][m][1][j]) * acc[ai][1][m][1][j]; }
                    store8(HSH + (size_t)row * 256 + u.pn * 128 + wc * 32 + 8 * fq, h0, h1);
                } else if (wc < 2) {
                    float* lp = LOG + (size_t)row * 64 + wc * 32 + 8 * fq; *(f32x4*)lp = acc[ai][0][m][0]; *(f32x4*)(lp + 4) = acc[ai][0][m][1];
                }
            }
    }
};

__device__ __forceinline__ int slot_round(int s) { return s < 2 ? 0 : (s < 5 ? 1 : 2); }
__device__ __forceinline__ int slot_yrow(int s) { return s < 2 ? s + 1 : (s < 5 ? s - 2 : s - 5); }
__device__ __forceinline__ void route_phase(const Args& a, Frame& F, int layer, int row_lo, int tpb) {
    unsigned char* const wsl = opaque_ptr(a.ws);
    const int tid_ = opaque_tid(), lane = tid_ & 63, wave = __builtin_amdgcn_readfirstlane(tid_ >> 6);
    LAS int* cnt = (LAS int*)F.lds;
    for (int i = tid_; i < NLIST; i += 512) cnt[i] = 0;
    __syncthreads();
    const float* LOG = (const float*)(wsl + WS_LOG); int* SELI = (int*)(wsl + WS_SELI); float* SELW = (float*)(wsl + WS_SELW);
    const float bias = inp(F, 24)[layer * NEXP + lane];
    const int blk = F.vcu;
    float lg_next = LOG[(size_t)(row_lo + blk * tpb + wave) * 64 + lane];
    for (int t = wave; t < tpb; t += NWAVES) {
        const int row = row_lo + blk * tpb + t;
        const float lg = lg_next; if (t + NWAVES < tpb) lg_next = LOG[(size_t)(row + NWAVES) * 64 + lane];
        const float sc = sigmoid_f(lg), bs = sc + bias;
        float m1 = bs;
        m1 = fmaxf(m1, __shfl_xor(m1, 1)); m1 = fmaxf(m1, __shfl_xor(m1, 2)); m1 = fmaxf(m1, __shfl_xor(m1, 4));
        const unsigned long long eqm = __ballot(bs == m1);
        const int grp = lane >> 3; const unsigned gm = (unsigned)((eqm >> (grp * 8)) & 0xffull);
        float v2 = (bs == m1) ? -INFINITY : bs;
        v2 = fmaxf(v2, __shfl_xor(v2, 1)); v2 = fmaxf(v2, __shfl_xor(v2, 2)); v2 = fmaxf(v2, __shfl_xor(v2, 4));
        const float m2 = (__popc(gm) >= 2) ? m1 : v2;
        const float gs = m1 + m2;
        int grank = 0;
#pragma unroll
        for (int j = 0; j < 8; ++j) { const float o = __shfl(gs, j * 8); grank += (o > gs || (o == gs && j < grp)) ? 1 : 0; }
        const float mv = grank < 4 ? bs : -INFINITY;
        int rank = 0;
#pragma unroll 8
        for (int j = 0; j < 64; ++j) { const float o = __shfl(mv, j); rank += (o > mv || (o == mv && j < lane)) ? 1 : 0; }
        const bool sel = rank < TOPK && grank < 4;
        const float ssum = wave_sum(sel ? sc : 0.f);
        if (sel) { const int s = rank, l = slot_round(s) * 64 + lane;
            SELI[(size_t)row * 8 + s] = l | (slot_yrow(s) << 8); SELW[(size_t)row * 8 + s] = sc / ssum * 2.5f;
            atomicAdd((int*)&cnt[l], 1); }
    }
    __syncthreads();
    int* BLKCNT = (int*)(wsl + WS_BLKCNT);
    for (int i = tid_; i < NLIST; i += 512) BLKCNT[blk * NLIST + i] = cnt[i];
}
__device__ __forceinline__ void place_phase(const Args& a, Frame& F, int row_lo, int tpb) {
    unsigned char* const wsl = opaque_ptr(a.ws);
    const int tid_ = opaque_tid();
    LAS int* tot = (LAS int*)F.lds; LAS int* mine = tot + 256; LAS int* tst = mine + 256; LAS int* cur = tst + 256;
    const int* BLKCNT = (const int*)(wsl + WS_BLKCNT); const int blk = F.vcu;
    if (tid_ < 256) { tot[tid_] = 0; mine[tid_] = 0; cur[tid_] = 0; }
    __syncthreads();
    if (tid_ < 2 * NLIST) { const int l = tid_ % NLIST, b0 = (tid_ / NLIST) * 128; int s = 0, m = 0;
#pragma unroll 16
        for (int b = b0; b < b0 + 128; ++b) { const int c = (b < F.G) ? BLKCNT[b * NLIST + l] : 0; m += (b < blk) ? c : 0; s += c; }
        atomicAdd((int*)&tot[l], s); atomicAdd((int*)&mine[l], m); }
    __syncthreads();
    if (tid_ == 0) { int acc = 0; for (int l = 0; l < NLIST; ++l) { tst[l] = acc; acc += (tot[l] + 255) >> 8; } tst[NLIST] = acc; }
    __syncthreads();
    int* TINFO = (int*)(wsl + WS_TINFO); int* LDST = (int*)(wsl + WS_LDST); float* LW = (float*)(wsl + WS_LW);
    if (blk == 0) {
        for (int i = tid_; i <= NLIST; i += 512) TINFO[i] = tst[i];
        for (int i = tid_; i < NLIST; i += 512) TINFO[256 + i] = tot[i];
        const int lane = tid_ & 63, wv = tid_ >> 6;
        for (int l = wv; l < NLIST; l += NWAVES) { const int t0 = tst[l], t1 = tst[l + 1];
            for (int t = t0 + lane; t < t1; t += 64) TINFO[512 + t] = l;
            const int c = tot[l], base = t0 * 256;
            for (int p = c + lane; p < (t1 - t0) * 256; p += 64) LDST[base + p] = -1; }
    }
    const int* SELI = (const int*)(wsl + WS_SELI); const float* SELW = (const float*)(wsl + WS_SELW);
    for (int i = tid_; i < tpb * 8; i += 512) { const int row = row_lo + blk * tpb + (i >> 3), s = i & 7;
        const int v = SELI[(size_t)row * 8 + s], l = v & 0xff, yr = v >> 8;
        const int pos = tst[l] * 256 + mine[l] + atomicAdd((int*)&cur[l], 1);
        LDST[pos] = row * 3 + yr; LW[pos] = SELW[(size_t)row * 8 + s]; }
}

struct MUnit { int T, pn; };
struct PolMoe1 {
    static constexpr bool PERM = true, GATHER = true, TWOSEG = false;
    static constexpr int NT = 16, KT0 = 16, KS0 = 128, KS1 = 128, LDB = 2048;
    typedef MUnit Unit;
    const char* XN; const char* W1; bf16_t* H; const int* TINFO; const int* LDST; int T0, T1, G, c;
    __device__ __forceinline__ bool next(int i, Unit& u) const { const int L = i * G + c; u.T = T0 + (L >> 1); u.pn = L & 1; return u.T < T1; }
    __device__ __forceinline__ void ctx(const Unit& u, pg8::UCtx<true>& x, const int (&R)[2], const int (&C)[2]) const {
        const int e = __builtin_amdgcn_readfirstlane(TINFO[512 + u.T]) & 63;
        x.a0[0] = XN; x.a0[1] = XN; x.a1[0] = XN; x.a1[1] = XN; x.b = W1 + ((size_t)e * 512 + u.pn * 256) * LDB;
#pragma unroll
        for (int h = 0; h < 2; ++h)
#pragma unroll
            for (int i = 0; i < 2; ++i) { const int d = LDST[u.T * 256 + h * 128 + R[i]]; const int tok = d < 0 ? 0 : d / 3; x.vg[h][i] = (unsigned)tok * 2048u + (unsigned)C[i] * 2u; }
    }
    __device__ __forceinline__ unsigned lane_a0(int, int) const { return 0u; }
    __device__ __forceinline__ unsigned lane_a1(int, int) const { return 0u; }
    __device__ __forceinline__ void epi(const f32x4 (&acc)[2][2][4][2], const Unit& u, int wr, int wc, int fr, int fq) const {
#pragma unroll
        for (int ai = 0; ai < 2; ++ai)
#pragma unroll
            for (int m = 0; m < 4; ++m) {
                const int hrow = (u.T - T0) * 256 + ai * 128 + wr * 64 + m * 16 + fr;
                f32x4 h0, h1;
#pragma unroll
                for (int j = 0; j < 4; ++j) { h0[j] = silu_f(acc[ai][0][m][0][j]) * acc[ai][1][m][0][j]; h1[j] = silu_f(acc[ai][0][m][1][j]) * acc[ai][1][m][1][j]; }
                store8(H + (size_t)hrow * 256 + u.pn * 128 + wc * 32 + 8 * fq, h0, h1);
            }
    }
};
template <bool RMW> struct PolMoe2 {
    static constexpr bool PERM = true, GATHER = false, TWOSEG = false;
    static constexpr int NT = 4, KT0 = 4, KS0 = 128, KS1 = 128, LDB = 512;
    typedef MUnit Unit;
    const char* H; const char* W2; unsigned char* Y; const int* TINFO; const int* LDST; const float* LW; int T0, T1, G, c;
    __device__ __forceinline__ bool next(int i, Unit& u) const { const int L = i * G + c; u.T = T0 + (L >> 2); u.pn = L & 3; return u.T < T1; }
    __device__ __forceinline__ void ctx(const Unit& u, pg8::UCtx<false>& x, const int (&)[2], const int (&)[2]) const {
        const int e = __builtin_amdgcn_readfirstlane(TINFO[512 + u.T]) & 63;
        x.a0[0] = H + (size_t)(u.T - T0) * 256 * 512; x.a0[1] = x.a0[0] + 128 * 512; x.a1[0] = x.a0[0]; x.a1[1] = x.a0[1];
        x.b = W2 + ((size_t)e * 1024 + u.pn * 256) * LDB;
    }
    __device__ __forceinline__ unsigned lane_a0(int R, int C) const { return (unsigned)(R * 512 + C * 2); }
    __device__ __forceinline__ unsigned lane_a1(int, int) const { return 0u; }
    __device__ __forceinline__ void epi(const f32x4 (&acc)[2][2][4][2], const Unit& u, int wr, int wc, int fr, int fq) const {
        const int cofs = u.pn * 256 + wc * 32 + 8 * fq;
#pragma unroll
        for (int ai = 0; ai < 2; ++ai) {
            int d[4]; float w[4];
#pragma unroll
            for (int m = 0; m < 4; ++m) { const int lp = u.T * 256 + ai * 128 + wr * 64 + m * 16 + fr; d[m] = LDST[lp]; w[m] = LW[lp]; }
            u32x2 o[4][2];
            if (RMW) {
#pragma unroll
                for (int m = 0; m < 4; ++m) { const unsigned char* yp = Y + (size_t)(d[m] < 0 ? 0 : d[m]) * DM + cofs; o[m][0] = *(const u32x2*)yp; o[m][1] = *(const u32x2*)(yp + 128); }
            }
#pragma unroll
            for (int m = 0; m < 4; ++m) {
                if (d[m] >= 0) {
                    unsigned char* yp = Y + (size_t)d[m] * DM + cofs; const float ww = w[m];
#pragma unroll
                    for (int bj = 0; bj < 2; ++bj) {
                        f32x4 v0 = acc[ai][bj][m][0] * ww, v1 = acc[ai][bj][m][1] * ww;
                        if (RMW) { v0 += fp8_unpack4(o[m][bj].x); v1 += fp8_unpack4(o[m][bj].y); }
                        u32x2 q; q.x = fp8_pack4(v0); q.y = fp8_pack4(v1); *(u32x2*)(yp + bj * 128) = q;
                    }
                }
            }
            asm volatile("" ::: "memory");
        }
    }
};
struct PolShd : DenseRow0<4, 512, true> {
    unsigned char* Y;
    __device__ __forceinline__ void epi(const f32x4 (&acc)[2][2][4][2], const DUnit& u, int wr, int wc, int fr, int fq) const {
#pragma unroll
        for (int ai = 0; ai < 2; ++ai)
#pragma unroll
            for (int m = 0; m < 4; ++m) {
                const int row = row0 + u.pm * 256 + ai * 128 + wr * 64 + m * 16 + fr;
                unsigned char* yp = Y + (size_t)row * 3 * DM + u.pn * 256 + wc * 32 + 8 * fq;
                u32x2 q0, q1; q0.x = fp8_pack4(acc[ai][0][m][0]); q0.y = fp8_pack4(acc[ai][0][m][1]); q1.x = fp8_pack4(acc[ai][1][m][0]); q1.y = fp8_pack4(acc[ai][1][m][1]);
                *(u32x2*)yp = q0; *(u32x2*)(yp + 128) = q1;
            }
    }
};

__device__ __forceinline__ void combine_phase(const Args& a, Frame& F, int layer, int row_lo) {
    unsigned char* const wsl = opaque_ptr(a.ws);
    const int tid_ = opaque_tid(), lane_ = tid_ & 63, wave_ = __builtin_amdgcn_readfirstlane(tid_ >> 6);
    const float* MOD = (const float*)(wsl + WS_MOD) + (size_t)layer * 17 * MODW; const float* g3 = inp(F, 6) + (size_t)(layer * 4 + 3) * DM;
    const float* MODn = (const float*)(wsl + WS_MOD) + (size_t)1 * 17 * MODW; const float* gn = inp(F, 6) + (size_t)(1 * 4 + 0) * DM;
    bf16_t* XN = (bf16_t*)(wsl + WS_XN); const unsigned char* Y = (const unsigned char*)(wsl + WS_Y);
    const int rpw = (NROWS - row_lo) / (F.G * NWAVES); int row = row_lo + (F.vcu * NWAVES + wave_) * rpw; const int rend = row + rpw;
    f32x4 nx[4]; unsigned ny[4][3]; NormMod nm; f32x4 P3[4]; int cur_mi = -1;
#define CB_LOAD(R) do { const float* x_ = xrow_st(a, (R)); \
        _Pragma("unroll") for (int j = 0; j < 4; ++j) { const int c = 4 * lane_ + 256 * j; nx[j] = *(const f32x4*)(x_ + c); \
            _Pragma("unroll") for (int r = 0; r < 3; ++r) ny[j][r] = *(const unsigned*)(Y + ((size_t)(R) * 3 + r) * DM + c); } } while (0)
    if (row < rend) CB_LOAD(row);
    for (; row < rend; ++row) {
        float* xo = xrow_st(a, row);
        f32x4 f[4], xv[4]; float ss = 0.f;
#pragma unroll
        for (int j = 0; j < 4; ++j) { xv[j] = nx[j]; f[j] = (f32x4){0.f, 0.f, 0.f, 0.f};
#pragma unroll
            for (int r = 0; r < 3; ++r) f[j] += fp8_unpack4(ny[j][r]);
            ss += sq4(f[j]); }
        if (row + 1 < rend) CB_LOAD(row + 1);
        const int mi = mod_index(row);
        if (mi != cur_mi) { const float* m = MOD + (size_t)mi * MODW;
#pragma unroll
            for (int j = 0; j < 4; ++j) { const int c = 4 * lane_ + 256 * j; P3[j] = *(const f32x4*)(g3 + c) * *(const f32x4*)(m + 5 * DM + c); }
            if (layer == 0) { const float* mn = MODn + (size_t)mi * MODW; normmod_load(nm, gn, mn + 0 * DM, mn + 1 * DM, lane_); }
            cur_mi = mi; }
        const float rstd = __builtin_amdgcn_rsqf(wave_sum(ss) * (1.f / DM) + NORM_EPS);
        f32x4 v[4];
#pragma unroll
        for (int j = 0; j < 4; ++j) { const int c = 4 * lane_ + 256 * j; v[j] = xv[j] + P3[j] * (f[j] * rstd); *(f32x4*)(xo + c) = v[j]; }
        if (layer == 0) norm_mod_store(v, nm, XN + (size_t)row * DM, lane_);
    }
#undef CB_LOAD
}
constexpr size_t WS_G    = WS_ST;
constexpr size_t WS_BTY  = WS_ST + 216 * MiB;
constexpr size_t WS_BTS  = WS_ST + 264 * MiB;
constexpr size_t WS_S    = WS_ST + 280 * MiB;
constexpr size_t WS_XIN  = WS_ST + 64 * MiB;
constexpr size_t WS_LAMT = WS_ROPE + 512 * 1024;
constexpr int S5_T = 32;

constexpr size_t WS_KD   = WS_ST + 130 * MiB;
__device__ __forceinline__ f32x2 cmul(f32x2 a, f32x2 b) { return (f32x2){a.x * b.x - a.y * b.y, a.x * b.y + a.y * b.x}; }
__device__ __forceinline__ void s5_tables_unit(const Args& a, Frame& F, int g, int d) {
    unsigned char* const wsl = opaque_ptr(a.ws);
    const int tid = opaque_tid();
    LAS f32x2* pw = (LAS f32x2*)F.lds; LAS f32x2* bb = pw + 33 * 64; LAS f32x2* cm = bb + 64 * 16;
    bf16_t* BTY = (bf16_t*)(wsl + WS_BTY) + (size_t)g * 512 * 768; bf16_t* BTS = (bf16_t*)(wsl + WS_BTS) + (size_t)g * 256 * 512; float* LAMT = (float*)(wsl + WS_LAMT);
    float* KD = (float*)(wsl + WS_KD) + (size_t)(g * 2 + d) * 8192;
    const float* lre = inp(F, 13); const float* lim = inp(F, 14); const float* lst = inp(F, 15);
    const float* bre = inp(F, 16); const float* bim = inp(F, 17); const float* cre = inp(F, 18); const float* cim = inp(F, 19);
    __syncthreads();
    const float step = __expf(lst[d * 64 + g]);
    for (int i = tid; i < 33 * 64; i += 512) { const int k = i >> 6, p = i & 63; const float lr = lre[(d * 64 + g) * 64 + p], li = lim[(d * 64 + g) * 64 + p];
        const float mag = __expf((float)k * lr * step); float c, s; sincos_red((float)k * (li * step), c, s); pw[i] = (f32x2){mag * c, mag * s}; }
    __syncthreads();
    for (int i = tid; i < 64 * 16; i += 512) { const int p = i >> 4; const float lr = lre[(d * 64 + g) * 64 + p], li = lim[(d * 64 + g) * 64 + p];
        const f32x2 lb = pw[64 + p]; const float inv = 1.f / (lr * lr + li * li);
        const f32x2 kap = {((lb.x - 1.f) * lr + lb.y * li) * inv, (lb.y * lr - (lb.x - 1.f) * li) * inv};
        const size_t o = ((size_t)(d * 64 + g) * 64 + p) * 16 + (i & 15); bb[i] = cmul(kap, (f32x2){bre[o], bim[o]}); }
    for (int i = tid; i < 16 * 64; i += 512) { const size_t o = (size_t)(d * 64 + g) * 1024 + i; cm[i] = (f32x2){cre[o], cim[o]}; }
    __syncthreads();
    if (tid < 64) { const f32x2 l32 = pw[32 * 64 + tid]; LAMT[((d * 64 + g) * 64 + tid) * 2] = l32.x; LAMT[((d * 64 + g) * 64 + tid) * 2 + 1] = l32.y; }
    { const int k = tid >> 4, ib = (tid >> 2) & 3, jb = tid & 3; float acc[4][4];
#pragma unroll
      for (int x = 0; x < 4; ++x)
#pragma unroll
        for (int y = 0; y < 4; ++y) acc[x][y] = 0.f;
      for (int p = 0; p < 64; ++p) { const f32x2 w = pw[k * 64 + p]; f32x2 t[4], b[4];
#pragma unroll
        for (int x = 0; x < 4; ++x) { t[x] = cmul(cm[(4 * ib + x) * 64 + p], w); b[x] = bb[p * 16 + 4 * jb + x]; }
#pragma unroll
        for (int x = 0; x < 4; ++x)
#pragma unroll
            for (int y = 0; y < 4; ++y) acc[x][y] += t[x].x * b[y].x - t[x].y * b[y].y; }
#pragma unroll
      for (int x = 0; x < 4; ++x) *(f32x4*)(KD + k * 256 + (4 * ib + x) * 16 + 4 * jb) = (f32x4){acc[x][0], acc[x][1], acc[x][2], acc[x][3]}; }
    for (int o = tid; o < 512 * 64; o += 512) { const int n = o >> 6, p = o & 63, to = n >> 4, i = n & 15;
        const f32x2 w = cmul(cm[i * 64 + p], pw[(d == 0 ? to + 1 : 32 - to) * 64 + p]);
        *(unsigned*)(BTY + (size_t)n * 768 + 512 + 128 * d + 2 * p) = cvt_pk_bf16(w.x, -w.y); }
    for (int o = tid; o < 64 * 256; o += 512) { const int p = o >> 8, kk = (o & 255) * 2, ti = kk >> 4, j = kk & 15;
        const f32x2 pwv = pw[(d == 0 ? 31 - ti : ti) * 64 + p]; const f32x2 v0 = cmul(pwv, bb[p * 16 + j]), v1 = cmul(pwv, bb[p * 16 + j + 1]);
        *(unsigned*)(BTS + (size_t)(128 * d + 2 * p) * 512 + kk) = cvt_pk_bf16(v0.x, v1.x); *(unsigned*)(BTS + (size_t)(128 * d + 2 * p + 1) * 512 + kk) = cvt_pk_bf16(v0.y, v1.y); }
    __syncthreads();
}
__device__ __forceinline__ void s5_tables_phase(const Args& a, Frame& F) { for (int u = F.vcu; u < 128; u += F.G) s5_tables_unit(a, F, u >> 1, u & 1); }
__device__ __forceinline__ void s5_toeplitz_phase(const Args& a, Frame& F) {
    unsigned char* const wsl = opaque_ptr(a.ws);
    const int tid = opaque_tid(); LAS float* Kd = (LAS float*)F.lds; const float* dsk = inp(F, 20);
    for (int u = F.vcu; u < 256; u += F.G) { const int g = u >> 2, q = u & 3;
        const float* KD = (const float*)(wsl + WS_KD) + (size_t)g * 16384; bf16_t* BTY = (bf16_t*)(wsl + WS_BTY) + (size_t)g * 512 * 768;
        __syncthreads();
        for (int i = tid; i < 4096; i += 512) *(f32x4*)(Kd + 4 * i) = *(const f32x4*)(KD + 4 * i);
        __syncthreads();
        for (int o = tid; o < 128 * 256; o += 512) { const int n = 128 * q + (o >> 8), kk = (o & 255) * 2, to = n >> 4, i = n & 15, ti = kk >> 4, j = kk & 15;
            float v0, v1;
            if (to > ti) { v0 = Kd[(to - ti) * 256 + i * 16 + j]; v1 = Kd[(to - ti) * 256 + i * 16 + j + 1]; }
            else if (to < ti) { v0 = Kd[8192 + (ti - to) * 256 + i * 16 + j]; v1 = Kd[8192 + (ti - to) * 256 + i * 16 + j + 1]; }
            else { v0 = Kd[i * 16 + j] + Kd[8192 + i * 16 + j] + (i == j ? dsk[g * 16 + i] : 0.f); v1 = Kd[i * 16 + j + 1] + Kd[8192 + i * 16 + j + 1] + (i == j + 1 ? dsk[g * 16 + i] : 0.f); }
            *(unsigned*)(BTY + (size_t)n * 768 + kk) = cvt_pk_bf16(v0, v1); }
    }
    __syncthreads();
}

struct SUnit { int g, pm, pn; };
struct PolS5S {
    static constexpr bool PERM = false, GATHER = false, TWOSEG = false;
    static constexpr int NT = 8, KT0 = 8, KS0 = 8192, KS1 = 128, LDB = 1024;
    typedef SUnit Unit;
    const char* XN; const char* BTS; float* S; int G, c;
    __device__ __forceinline__ bool next(int i, Unit& u) const { const int L = i * G + c; u.g = __builtin_amdgcn_readfirstlane(L / 5); u.pm = __builtin_amdgcn_readfirstlane(L % 5); u.pn = 0; return L < 320; }
    __device__ __forceinline__ void ctx(const Unit& u, pg8::UCtx<false>& x, const int (&)[2], const int (&)[2]) const {
        if (u.pm < 4) { x.a0[0] = XN + ((size_t)NCTXR + (size_t)u.pm * 256 * S5_T) * 2048 + u.g * 32; x.a0[1] = x.a0[0] + (size_t)128 * S5_T * 2048; }
        else { x.a0[0] = XN + u.g * 32; x.a0[1] = x.a0[0]; }
        x.a1[0] = x.a0[0]; x.a1[1] = x.a0[1]; x.b = BTS + (size_t)u.g * 256 * LDB;
    }
    __device__ __forceinline__ unsigned lane_a0(int R, int C) const { return (unsigned)(R * (S5_T * 2048) + (C >> 4) * 2048 + (C & 15) * 2); }
    __device__ __forceinline__ unsigned lane_a1(int, int) const { return 0u; }
    __device__ __forceinline__ void epi(const f32x4 (&acc)[2][2][4][2], const Unit& u, int wr, int wc, int fr, int fq) const {
#pragma unroll
        for (int ai = 0; ai < 2; ++ai) { if (u.pm == 4 && ai == 1) continue;
#pragma unroll
            for (int m = 0; m < 4; ++m) { const int r = u.pm * 256 + ai * 128 + wr * 64 + m * 16 + fr;
                float* sp = S + ((size_t)u.g * 1152 + r) * 256 + wc * 32 + 4 * fq;
#pragma unroll
                for (int bj = 0; bj < 2; ++bj)
#pragma unroll
                    for (int n = 0; n < 2; ++n) *(f32x4*)(sp + bj * 128 + n * 16) = acc[ai][bj][m][n]; } }
    }
};
__device__ __forceinline__ void s5_scan_phase(const Args& a, Frame& F) {
    unsigned char* const wsl = opaque_ptr(a.ws);
    const int tid = opaque_tid(); const float* S = (const float*)(wsl + WS_S); bf16_t* XIN = (bf16_t*)(wsl + WS_XIN); const float* LAMT = (const float*)(wsl + WS_LAMT);
    for (int idx = F.vcu * 512 + tid; idx < 64 * 16 * 2 * 64; idx += F.G * 512) {
        const int p = idx & 63, d = (idx >> 6) & 1, b = (idx >> 7) & 15, g = idx >> 11;
        const f32x2 Lm = *(const f32x2*)(LAMT + ((d * 64 + g) * 64 + p) * 2);
        const float* Sg = S + (size_t)g * 1152 * 256 + d * 128 + 2 * p; const int col = d * 128 + 2 * p; bf16_t* Xg = XIN + (size_t)(col >> 4) * 1024 + 16 * g + (col & 15);
        f32x2 x = {0.f, 0.f};
        f32x2 sv[8];
#pragma unroll
        for (int k = 0; k < 8; ++k) { const int c = d == 0 ? k : 7 - k; sv[k] = *(const f32x2*)(Sg + (size_t)(1024 + b * 8 + c) * 256); }
#pragma unroll
        for (int k = 0; k < 8; ++k) x = cmul(Lm, x) + sv[k];
        for (int c0 = 0; c0 < 64; c0 += 8) {
#pragma unroll
            for (int k = 0; k < 8; ++k) { const int c = d == 0 ? c0 + k : 63 - c0 - k; sv[k] = *(const f32x2*)(Sg + (size_t)(b * 64 + c) * 256); }
#pragma unroll
            for (int k = 0; k < 8; ++k) { const int c = d == 0 ? c0 + k : 63 - c0 - k; *(unsigned*)(Xg + (size_t)(b * 64 + c) * 32 * 1024) = cvt_pk_bf16(x.x, x.y); x = cmul(Lm, x) + sv[k]; }
        }
    }
}
struct PolS5Y {
    static constexpr bool PERM = true, GATHER = false, TWOSEG = true;
    static constexpr int NT = 12, KT0 = 8, KS0 = 8192, KS1 = 8192, LDB = 1536;
    typedef SUnit Unit;
    const char* XN; const char* XIN; const char* BTY; bf16_t* Gb; int G, c;
    __device__ __forceinline__ bool next(int i, Unit& u) const { const int L = i * G + c; u.g = __builtin_amdgcn_readfirstlane(L >> 3); u.pm = __builtin_amdgcn_readfirstlane((L >> 1) & 3); u.pn = L & 1; return L < 512; }
    __device__ __forceinline__ void ctx(const Unit& u, pg8::UCtx<false>& x, const int (&)[2], const int (&)[2]) const {
        x.a0[0] = XN + ((size_t)NCTXR + (size_t)u.pm * 256 * S5_T) * 2048 + u.g * 32; x.a0[1] = x.a0[0] + (size_t)128 * S5_T * 2048;
        x.a1[0] = XIN + (size_t)u.pm * 256 * S5_T * 2048 + u.g * 32; x.a1[1] = x.a1[0] + (size_t)128 * S5_T * 2048;
        x.b = BTY + ((size_t)u.g * 512 + u.pn * 256) * LDB;
    }
    __device__ __forceinline__ unsigned lane_a0(int R, int C) const { return (unsigned)(R * (S5_T * 2048) + (C >> 4) * 2048 + (C & 15) * 2); }
    __device__ __forceinline__ void epi(const f32x4 (&acc)[2][2][4][2], const Unit& u, int wr, int wc, int fr, int fq) const {
#pragma unroll
        for (int ai = 0; ai < 2; ++ai)
#pragma unroll
            for (int m = 0; m < 4; ++m) { const int r = u.pm * 256 + ai * 128 + wr * 64 + m * 16 + fr;
#pragma unroll
                for (int bj = 0; bj < 2; ++bj) { const int col = u.pn * 256 + bj * 128 + wc * 32 + 8 * fq, to = col >> 4, i0 = col & 15;
                    bf16_t* gp = Gb + ((size_t)r * S5_T + to) * DM + u.g * 16 + i0;
#pragma unroll
                    for (int n = 0; n < 2; ++n) { f32x4 v;
#pragma unroll
                        for (int j = 0; j < 4; ++j) v[j] = gelu_tanh(acc[ai][bj][m][n][j]);
                        u32x2 w; w.x = cvt_pk_bf16(v[0], v[1]); w.y = cvt_pk_bf16(v[2], v[3]); *(u32x2*)(gp + 4 * n) = w; asm volatile("" ::: "memory"); } } }
    }
};
struct PolGlu : DenseRow0<16, 2048, true> {
    bf16_t* OO; float* SSQO; const float* bias;
    __device__ __forceinline__ void epi(const f32x4 (&acc)[2][2][4][2], const DUnit& u, int wr, int wc, int fr, int fq) const {
        const int c0 = u.pn * 128 + wc * 32 + 8 * fq;
        const f32x4 b10 = *(const f32x4*)(bias + c0), b11 = *(const f32x4*)(bias + c0 + 4), b20 = *(const f32x4*)(bias + 1024 + c0), b21 = *(const f32x4*)(bias + 1024 + c0 + 4);
#pragma unroll
        for (int ai = 0; ai < 2; ++ai)
#pragma unroll
            for (int m = 0; m < 4; ++m) {
                const int row = row0 + u.pm * 256 + ai * 128 + wr * 64 + m * 16 + fr;
                f32x4 o0, o1;
#pragma unroll
                for (int j = 0; j < 4; ++j) { o0[j] = (acc[ai][0][m][0][j] + b10[j]) * sigmoid_f(acc[ai][1][m][0][j] + b20[j]); o1[j] = (acc[ai][0][m][1][j] + b11[j]) * sigmoid_f(acc[ai][1][m][1][j] + b21[j]); }
                float s = sq4(o0) + sq4(o1);
                store8(OO + (size_t)row * DM + c0, o0, o1);
                s += __shfl_xor(s, 16); s += __shfl_xor(s, 32);
                if (fq == 0) SSQO[(size_t)row * 32 + u.pn * 4 + wc] = s;
            }
    }
};
#ifndef REP_ATTN
#define REP_ATTN 1
#endif
#ifndef REP_MISC
#define REP_MISC 1
#endif
#ifndef REP_DENSE
#define REP_DENSE 1
#endif
#ifndef REP_G2A
#define REP_G2A 1
#endif
#ifndef REP_P11X
#define REP_P11X 1
#endif
#ifndef REP_PM0
#define REP_PM0 1
#endif
#ifndef REP_H
#define REP_H 1
#endif
#ifndef REP_G1
#define REP_G1 1
#endif
__device__ __forceinline__ void moe_stage(const Args& args, Frame& F, const XcdBarrier& bar, int layer, int row_lo) {
    const int nrows = NROWS - row_lo, tpb = nrows / F.G;
    {   unsigned char* ws = opaque_ptr(args.ws);
        PolShr p; p.A = (const char*)(ws + WS_XN) + (size_t)row_lo * 2048; p.Bt = (const char*)(ws + WS_WSHR) + (size_t)layer * 768 * 2048; p.nM = nrows / 256; p.nN = 3; p.G = F.G; p.c = (int)blockIdx.x;
        p.row0 = row_lo; p.HSH = (bf16_t*)(ws + WS_HSH); p.LOG = (float*)(ws + WS_LOG);
        for (int rep_ = 0; rep_ < REP_DENSE; ++rep_) pg8::gemm_phase(F.lds, p);
    }
    if (layer == 1 && args.stage == 7) return;
    xcd_barrier(bar);
    route_phase(args, F, layer, row_lo, tpb);
#if REP_MISC == 2
    __syncthreads(); route_phase(args, F, layer, row_lo, tpb);
#endif
    if (layer == 1 && args.stage == 8) return;
    xcd_barrier(bar);
    place_phase(args, F, row_lo, tpb);
#if REP_MISC == 2
    __syncthreads(); place_phase(args, F, row_lo, tpb);
#endif
    if (layer == 1 && args.stage == 9) return;
    xcd_barrier(bar);
    const int* TINFO = (const int*)(opaque_ptr(args.ws) + WS_TINFO);
    const int ts0 = __builtin_amdgcn_readfirstlane(TINFO[0]), ts1 = __builtin_amdgcn_readfirstlane(TINFO[64]), ts2 = __builtin_amdgcn_readfirstlane(TINFO[128]), ts3 = __builtin_amdgcn_readfirstlane(TINFO[192]);
#define MOE_G1(TA, TB, HBUF) for (int rep_ = 0; rep_ < REP_G1; ++rep_) do { unsigned char* ws = opaque_ptr(args.ws); PolMoe1 p; p.XN = (const char*)(ws + WS_XN); p.W1 = (const char*)(ws + WS_W1); p.H = (bf16_t*)(ws + (HBUF)); p.TINFO = (const int*)(ws + WS_TINFO); p.LDST = (const int*)(ws + WS_LDST); p.T0 = (TA); p.T1 = (TB); p.G = F.G; p.c = F.vcu; \
        pg8::gemm_phase(F.lds, p); } while (0)
#define MOE_G2(RMW, TA, TB, HBUF) do { unsigned char* ws = opaque_ptr(args.ws); PolMoe2<RMW> p; p.H = (const char*)(ws + (HBUF)); p.W2 = (const char*)(ws + WS_W2); p.Y = (unsigned char*)(ws + WS_Y); p.TINFO = (const int*)(ws + WS_TINFO); p.LDST = (const int*)(ws + WS_LDST); p.LW = (const float*)(ws + WS_LW); p.T0 = (TA); p.T1 = (TB); p.G = F.G; p.c = F.vcu; \
        pg8::gemm_phase(F.lds, p); } while (0)
    MOE_G1(ts0, ts1, WS_H0);
    if (layer == 1 && args.stage == 10) return;
    xcd_barrier(bar);
#define MOE_SHD() do { unsigned char* ws = opaque_ptr(args.ws); PolShd p; p.A = (const char*)(ws + WS_HSH) + (size_t)row_lo * 512; p.Bt = (const char*)(ws + WS_WSHD) + (size_t)layer * 1024 * 512; p.nM = nrows / 256; p.nN = 4; p.G = F.G; p.c = (int)blockIdx.x; \
        p.row0 = row_lo; p.Y = (unsigned char*)(ws + WS_Y); pg8::gemm_phase(F.lds, p); } while (0)
#if REP_G2A == 2
    MOE_G2(false, ts0, ts1, WS_H0); MOE_SHD();
#endif
    if (blockIdx.x & 1) { MOE_G1(ts1, ts2, WS_H1); MOE_G2(false, ts0, ts1, WS_H0); MOE_SHD(); }
    else { MOE_G2(false, ts0, ts1, WS_H0); MOE_SHD(); MOE_G1(ts1, ts2, WS_H1); }
    if (layer == 1 && args.stage == 11) return;
    xcd_barrier(bar);
    if (blockIdx.x & 1) { MOE_G1(ts2, ts3, WS_H0); MOE_G2(true, ts1, ts2, WS_H1); }
    else { MOE_G2(true, ts1, ts2, WS_H1); MOE_G1(ts2, ts3, WS_H0); }
    if (layer == 1 && args.stage == 12) return;
    xcd_barrier(bar);
    MOE_G2(true, ts2, ts3, WS_H0);
    if (layer == 1 && args.stage == 13) return;
    xcd_barrier(bar);
    if (layer == 0) { s5_tables_phase(args, F); convert_experts(args, F, 1, 0); }
#if REP_P11X == 2
    __syncthreads();
    if (layer == 0) { s5_tables_phase(args, F); convert_experts(args, F, 1, 0); }
#endif
    combine_phase(args, F, layer, row_lo);
#undef MOE_SHD
#undef MOE_G1
#undef MOE_G2
}

__global__ void __launch_bounds__(NWAVES * 64, 2) trunk_fwd(Args args) {
    extern __shared__ __attribute__((aligned(16))) unsigned char lds_raw[];
    Frame F;
    F.lds = (LAS unsigned char*)lds_raw;
    F.G = gridDim.x; { const int bx = blockIdx.x; F.vcu = (F.G % 8 == 0) ? (bx % 8) * (F.G / 8) + bx / 8 : bx; }
    F.ws = args.ws;
    volatile LAS unsigned* MISC = (volatile LAS unsigned*)(F.lds + LDSCTL_OFF);
    for (int u = threadIdx.x; u < (LDS_BYTES - LDSCTL_OFF) / 4; u += NWAVES * 64) ((LAS unsigned*)(F.lds + LDSCTL_OFF))[u] = 0u;
    __syncthreads();
    if (threadIdx.x < 31) ((LAS unsigned long long*)(F.lds + PTAB_OFF))[threadIdx.x] = (unsigned long long)args.in[threadIdx.x];
    __syncthreads();
    XcdBarrier bar = xcd_barrier_post((unsigned*)(args.ws + WS_CTL) + CW_BAR, MISC + 8);
#define GRID_BAR() xcd_barrier(bar)

    mod_phase(args, F);
    __syncthreads();
    convert_small(args, F);
    rope_phase(args, F);
    convert_experts(args, F, 0, 0);
#if REP_MISC == 2
    __syncthreads();
    mod_phase(args, F);
    __syncthreads();
    convert_small(args, F);
    rope_phase(args, F);
    convert_experts(args, F, 0, 0);
#endif
    GRID_BAR();
    h_phase(args, F, 0, 0);
#if REP_H == 2
    h_phase(args, F, 0, 0);
#endif
    GRID_BAR();
    {   unsigned char* ws = opaque_ptr(args.ws);
        PolDqkv p; p.A = (const char*)(ws + WS_XN); p.Bt = (const char*)(ws + WS_WDQKV); p.nM = NROWS / 256; p.nN = 3; p.G = F.G; p.c = (int)blockIdx.x;
        p.A1 = (bf16_t*)(ws + WS_A1); p.SSQ1 = (float*)(ws + WS_SSQ1); p.KPE = (bf16_t*)(ws + WS_KPE); p.ROPE = (const float*)(ws + WS_ROPE);
        for (int rep_ = 0; rep_ < REP_DENSE; ++rep_) pg8::gemm_phase(F.lds, p);
    }
    GRID_BAR();
    {   unsigned char* ws = opaque_ptr(args.ws);
        PolQup p; p.A = (const char*)(ws + WS_A1); p.Bt = (const char*)(ws + WS_WUQ); p.nM = NROWS / 256; p.nN = NQ / 256; p.G = F.G; p.c = (int)blockIdx.x;
        p.Q = (bf16_t*)(ws + WS_Q); p.SSQ1 = (const float*)(ws + WS_SSQ1);
        for (int rep_ = 0; rep_ < REP_DENSE; ++rep_) pg8::gemm_phase(F.lds, p);
    }
    {   unsigned char* ws = opaque_ptr(args.ws);
        PolKVup p; p.A = (const char*)(ws + WS_A1) + QLORA * 2; p.Bt = (const char*)(ws + WS_WUKV); p.nM = NROWS / 256; p.nN = NKV / 256; p.G = F.G; p.c = (int)blockIdx.x;
        p.KV = (bf16_t*)(ws + WS_KV); p.SSQ1 = (const float*)(ws + WS_SSQ1);
        for (int rep_ = 0; rep_ < REP_DENSE; ++rep_) pg8::gemm_phase(F.lds, p);
    }
    GRID_BAR();
    {   unsigned char* ws = opaque_ptr(args.ws);
        const bf16_t* Qg = (const bf16_t*)(ws + WS_Q); const bf16_t* KVb = (const bf16_t*)(ws + WS_KV); const bf16_t* KPE = (const bf16_t*)(ws + WS_KPE); bf16_t* Og = (bf16_t*)(ws + WS_O); const float* RP = (const float*)(ws + WS_ROPE);
        for (int rep_ = 0; rep_ < REP_ATTN; ++rep_)
        for (int u = F.vcu; u < 1024 + 128; u += F.G) {
            if (u < 1024) { const int bh = u >> 3, qb = u & 7, b = bh >> 3, h = bh & 7;
                attn::attn_unit(Qg, KVb, KPE, Og, RP, NCTXR + b * SEQL + qb * 256, qb * 256, h, b * NCTX, NCTXR + b * SEQL, 36, (char*)lds_raw); }
            else { const int bh = u - 1024, b = bh >> 3, h = bh & 7;
                attn::attn_unit(Qg, KVb, KPE, Og, RP, b * NCTX, -1, h, b * NCTX, 0, 4, (char*)lds_raw); }
        }
    }
    GRID_BAR();
    {   unsigned char* ws = opaque_ptr(args.ws);
        PolWo p; p.A = (const char*)(ws + WS_O); p.Bt = (const char*)(ws + WS_WO); p.nM = NROWS / 256; p.nN = 4; p.G = F.G; p.c = (int)blockIdx.x;
        p.OO = (bf16_t*)(ws + WS_OO); p.SSQO = (float*)(ws + WS_SSQO);
        for (int rep_ = 0; rep_ < REP_DENSE; ++rep_) pg8::gemm_phase(F.lds, p);
    }
    GRID_BAR();
    postmix_phase(args, F, 0, 0, 16);
#if REP_PM0 == 2
    postmix_phase(args, F, 0, 0, 16);
#endif
    GRID_BAR();
    moe_stage(args, F, bar, 0, 0);
    if (args.stage == 1) return;
    GRID_BAR();
    {   unsigned char* ws = opaque_ptr(args.ws);
        PolS5S p; p.XN = (const char*)(ws + WS_XN); p.BTS = (const char*)(ws + WS_BTS); p.S = (float*)(ws + WS_S); p.G = F.G; p.c = F.vcu;
        for (int rep_ = 0; rep_ < REP_DENSE; ++rep_) pg8::gemm_phase(F.lds, p);
    }
    if (args.stage == 2) return;
    GRID_BAR();
    s5_toeplitz_phase(args, F);
    s5_scan_phase(args, F);
#if REP_MISC == 2
    s5_scan_phase(args, F);
#endif
    if (args.stage == 3) return;
    GRID_BAR();
    {   unsigned char* ws = opaque_ptr(args.ws);
        PolS5Y p; p.XN = (const char*)(ws + WS_XN); p.XIN = (const char*)(ws + WS_XIN); p.BTY = (const char*)(ws + WS_BTY); p.Gb = (bf16_t*)(ws + WS_G); p.G = F.G; p.c = F.vcu;
        for (int rep_ = 0; rep_ < REP_DENSE; ++rep_) pg8::gemm_phase(F.lds, p);
    }
    if (args.stage == 4) return;
    GRID_BAR();
    {   unsigned char* ws = opaque_ptr(args.ws);
        PolGlu p; p.A = (const char*)(ws + WS_G); p.Bt = (const char*)(ws + WS_WGLU); p.nM = NLATR / 256; p.nN = 8; p.G = F.G; p.c = (int)blockIdx.x;
        p.row0 = NCTXR; p.OO = (bf16_t*)(ws + WS_OO); p.SSQO = (float*)(ws + WS_SSQO); p.bias = inp(F, 22);
        for (int rep_ = 0; rep_ < REP_DENSE; ++rep_) pg8::gemm_phase(F.lds, p);
    }
    if (args.stage == 5) return;
    GRID_BAR();
    postmix_phase(args, F, 1, NCTXR, 32);
    if (args.stage == 6) return;
    GRID_BAR();
    moe_stage(args, F, bar, 1, NCTXR);
}

#ifndef DBG_STAGE
#define DBG_STAGE 0
#endif
extern "C" void kernel_launch(void* const* d_in, const int* in_sizes, int n_in, void* d_out, int out_size, void* d_ws, size_t ws_size, hipStream_t stream) {
    static int grid = 0;
    if (grid == 0) {
        if (n_in != 31 || out_size != NLATR * DM || ws_size < WS_END) { fprintf(stderr, "kernel_launch: unexpected shapes (n_in %d out %d ws %zu)\n", n_in, out_size, ws_size); grid = -1; return; }
        int dev = 0, cus = 0;
        if (hipGetDevice(&dev) != hipSuccess || hipDeviceGetAttribute(&cus, hipDeviceAttributeMultiprocessorCount, dev) != hipSuccess) { grid = -1; return; }
        if (hipFuncSetAttribute((const void*)trunk_fwd, hipFuncAttributeMaxDynamicSharedMemorySize, LDS_BYTES) != hipSuccess) { fprintf(stderr, "kernel_launch: hipFuncSetAttribute failed\n"); grid = -1; return; }
        (void)hipGetLastError();
        grid = cus;
    }
    if (grid < 0) return;
    (void)hipMemsetAsync((char*)d_ws + WS_CTL, 0, CTL_BYTES, stream);
    Args a{};
    for (int i = 0; i < 31; ++i) a.in[i] = (const float*)d_in[i];
    a.out = (float*)d_out; a.ws = (unsigned char*)d_ws; a.stage = DBG_STAGE; a.pad = 0;
    hipLaunchKernelGGL(trunk_fwd, dim3(grid), dim3(NWAVES * 64), LDS_BYTES, stream, a);
}
```

```cpp
#include <hip/hip_runtime.h>
#include <cstdio>
#include <cstdint>

#define GAS __attribute__((address_space(1)))
#define LAS __attribute__((address_space(3)))
typedef unsigned short bf16_t;
typedef short bf16x8 __attribute__((ext_vector_type(8)));
typedef short s16x4 __attribute__((ext_vector_type(4)));
typedef float f32x2 __attribute__((ext_vector_type(2)));
typedef float f32x4 __attribute__((ext_vector_type(4)));
typedef float f32x16 __attribute__((ext_vector_type(16)));
typedef unsigned u32x2 __attribute__((ext_vector_type(2)));
typedef unsigned u32x4 __attribute__((ext_vector_type(4)));

constexpr int DM = 1024, NBATCH = 16, SEQL = 2048, NCTX = 256;
constexpr int NCTXR = NBATCH * NCTX;
constexpr int NLATR = NBATCH * SEQL;
constexpr int NROWS = NCTXR + NLATR;
constexpr int NHEAD = 8, QLORA = 384, KVLORA = 256, NOPE = 128, ROPED = 64, VDIM = 128;
constexpr int NDQKV = 768;
constexpr int NQ = NHEAD * (NOPE + ROPED);
constexpr int NKV = NHEAD * (NOPE + VDIM);
constexpr int NEXP = 64, TOPK = 8, DEXP = 256;
constexpr float NORM_EPS = 1e-6f;
constexpr int NMOD = 6, MODW = NMOD * DM;

constexpr size_t MiB = 1u << 20;
constexpr size_t WS_CTL = 0, CTL_BYTES = 1 * MiB;
constexpr size_t WS_WDQKV = 1 * MiB;
constexpr size_t WS_WUQ   = WS_WDQKV + 1536 * 1024;
constexpr size_t WS_WUKV  = WS_WUQ + 1280 * 1024;
constexpr size_t WS_WO    = WS_WUKV + 1 * MiB;
constexpr size_t WS_WGLU  = WS_WO + 2 * MiB;
constexpr size_t WS_WSHR  = WS_WGLU + 4 * MiB;
constexpr size_t WS_WSHD  = WS_WSHR + 3 * MiB;
constexpr size_t WS_MOD   = 15 * MiB;
constexpr size_t WS_ROPE  = 16 * MiB;
constexpr size_t WS_W1    = 17 * MiB;
constexpr size_t WS_W2    = 81 * MiB;
constexpr size_t WS_XCTX  = 113 * MiB;
constexpr size_t WS_XN    = 129 * MiB;
constexpr size_t WS_ST    = 201 * MiB;
static_assert(WS_WSHD + 1 * MiB <= WS_MOD, "small weights fit");
constexpr size_t WS_KV   = WS_ST;
constexpr size_t WS_Q    = WS_ST + 144 * MiB;
constexpr size_t WS_OO   = WS_Q;
constexpr size_t WS_A1   = WS_ST + 252 * MiB;
constexpr size_t WS_O    = WS_A1;
constexpr size_t WS_KPE  = WS_ST + 324 * MiB;
constexpr size_t WS_SSQ1 = WS_ST + 329 * MiB;
constexpr size_t WS_SSQO = WS_ST + 332 * MiB;
constexpr size_t WS_END  = WS_ST + 402 * MiB;

constexpr int CW_BAR = 4096;

__device__ __forceinline__ unsigned cvt_pk_bf16(float lo, float hi) { unsigned r; asm volatile("v_cvt_pk_bf16_f32 %0, %1, %2" : "=v"(r) : "v"(lo), "v"(hi)); return r; }
__device__ __forceinline__ float bf_lo(unsigned w) { return __uint_as_float(w << 16); }
__device__ __forceinline__ float bf_hi(unsigned w) { return __uint_as_float(w & 0xffff0000u); }
__device__ __forceinline__ float wave_sum(float v) {
#pragma unroll
    for (int o = 1; o < 64; o <<= 1) v += __shfl_xor(v, o);
    return v;
}
__device__ __forceinline__ float silu_f(float v) { return v * __builtin_amdgcn_rcpf(1.f + __builtin_amdgcn_exp2f(-1.4426950408889634f * v)); }
__device__ __forceinline__ float sigmoid_f(float v) { return __builtin_amdgcn_rcpf(1.f + __builtin_amdgcn_exp2f(-1.4426950408889634f * v)); }
__device__ __forceinline__ int mod_index(int row) { return row < NCTXR ? 16 : (row - NCTXR) / SEQL; }
__device__ __forceinline__ int opaque_tid() { int t = threadIdx.x; asm volatile("" : "+v"(t)); return t; }
__device__ __forceinline__ float gelu_tanh(float v) {
    const float z = 0.7978845608028654f * (v + 0.044715f * v * v * v);
    return v * __builtin_amdgcn_rcpf(1.f + __builtin_amdgcn_exp2f(-2.8853900817779268f * z));
}
__device__ __forceinline__ unsigned char* opaque_ptr(unsigned char* p) {
    unsigned lo = __builtin_amdgcn_readfirstlane((unsigned)(unsigned long long)p), hi = __builtin_amdgcn_readfirstlane((unsigned)((unsigned long long)p >> 32));
    asm volatile("" : "+s"(lo), "+s"(hi)); return (unsigned char*)(((unsigned long long)hi << 32) | lo); }
constexpr float Y_SCALE = 64.f, Y_INV = 1.f / 64.f, Y_MAX = 448.f;
__device__ __forceinline__ unsigned fp8_pack4(const f32x4& v) {
    const float a = fminf(fmaxf(v[0] * Y_SCALE, -Y_MAX), Y_MAX), b = fminf(fmaxf(v[1] * Y_SCALE, -Y_MAX), Y_MAX), c = fminf(fmaxf(v[2] * Y_SCALE, -Y_MAX), Y_MAX), d = fminf(fmaxf(v[3] * Y_SCALE, -Y_MAX), Y_MAX);
    int p = __builtin_amdgcn_cvt_pk_fp8_f32(a, b, 0, false); p = __builtin_amdgcn_cvt_pk_fp8_f32(c, d, p, true); return (unsigned)p; }
__device__ __forceinline__ f32x4 fp8_unpack4(unsigned w) {
    const f32x2 lo = __builtin_amdgcn_cvt_pk_f32_fp8((int)w, false), hi = __builtin_amdgcn_cvt_pk_f32_fp8((int)w, true);
    return (f32x4){lo.x * Y_INV, lo.y * Y_INV, hi.x * Y_INV, hi.y * Y_INV}; }
#define XB_TMO      128
#define XB_XCNT(j)  (256  + 64 * (j))
#define XB_XSUB(j)  (1280 + 64 * (j))
#define XB_XGEN(j)  (2304 + 64 * (j))
#define XB_TOP      3328
#define XB_TOPGEN   3392
#define XCD_BAR_WORDS 3456
#define XB_SPIN_CAP (1u << 18)
__device__ __forceinline__ unsigned xb_ld(unsigned* p)              { return __hip_atomic_load(p, __ATOMIC_RELAXED, __HIP_MEMORY_SCOPE_AGENT); }
__device__ __forceinline__ unsigned xb_add(unsigned* p, unsigned v) { return __hip_atomic_fetch_add(p, v, __ATOMIC_RELAXED, __HIP_MEMORY_SCOPE_AGENT); }
__device__ __forceinline__ unsigned xb_xcc_id() { return (unsigned)__builtin_amdgcn_s_getreg((3 << 11) | 20) & 0xFu; }
#define XB_SPIN(cond, bar) do { unsigned _sp = 0; while (cond) { __builtin_amdgcn_s_sleep(1); \
    if ((++_sp & 255u) == 0u) { if (xb_ld(&(bar)[XB_TMO])) break; if (_sp > XB_SPIN_CAP) { atomicAdd(&(bar)[XB_TMO], 1u); break; } } } } while (0)
struct XcdBarrier { unsigned* bar; unsigned x; volatile LAS unsigned* st; };
__device__ __forceinline__ XcdBarrier xcd_barrier_post(unsigned* bar, volatile LAS unsigned* st) {
    XcdBarrier b; b.bar = bar; b.x = xb_xcc_id(); b.st = st;
    if (threadIdx.x == 0) (void)xb_add(&bar[XB_XCNT(b.x)], 1u);
    return b;
}
__device__ __forceinline__ void xcd_barrier_complete(unsigned* bar, unsigned x, unsigned& nloc, unsigned& nx) {
    const unsigned G = gridDim.x * gridDim.y * gridDim.z;
    unsigned sum, cnt, mine, sp = 0u;
    for (;;) {
        sum = 0u; cnt = 0u; mine = 0u;
#pragma unroll
        for (unsigned j = 0; j < 16; ++j) { const unsigned c = xb_ld(&bar[XB_XCNT(j)]); sum += c; cnt += (c > 0u) ? 1u : 0u; mine = (j == x) ? c : mine; }
        if (sum == G) break;
        __builtin_amdgcn_s_sleep(1);
        if ((++sp & 255u) == 0u) { if (xb_ld(&bar[XB_TMO])) break; if (sp > XB_SPIN_CAP) { atomicAdd(&bar[XB_TMO], 1u); break; } }
    }
    nloc = mine > 0u ? mine : 1u; nx = cnt > 0u ? cnt : 1u;
}
__device__ __forceinline__ void xcd_barrier(const XcdBarrier& b) {
    asm volatile("s_waitcnt vmcnt(0)" ::: "memory");
    __syncthreads();
    if (threadIdx.x == 0) {
        unsigned* bar = b.bar;
        __builtin_amdgcn_s_waitcnt(0);
        unsigned nloc = b.st[0], nx = b.st[1];
        if (nloc == 0u) { xcd_barrier_complete(bar, b.x, nloc, nx); b.st[0] = nloc; b.st[1] = nx; }
        const unsigned old = xb_add(&bar[XB_XSUB(b.x)], 1u);
        const unsigned gen = old / nloc;
        if (old + 1u == (gen + 1u) * nloc) {
            __builtin_amdgcn_fence(__ATOMIC_RELEASE, "agent");
            asm volatile("s_waitcnt vmcnt(0)" ::: "memory");
            const unsigned og = xb_add(&bar[XB_TOP], 1u);
            const unsigned tg = og / nx;
            if (og + 1u == (tg + 1u) * nx) xb_add(&bar[XB_TOPGEN], 1u);
            else XB_SPIN(xb_ld(&bar[XB_TOPGEN]) == tg, bar);
            __builtin_amdgcn_fence(__ATOMIC_ACQUIRE, "agent");
            xb_add(&bar[XB_XGEN(b.x)], 1u);
            asm volatile("s_waitcnt vmcnt(0)" ::: "memory");
        } else {
            XB_SPIN(xb_ld(&bar[XB_XGEN(b.x)]) == gen, bar);
            __builtin_amdgcn_fence(__ATOMIC_ACQUIRE, "agent");
            asm volatile("s_waitcnt vmcnt(0)" ::: "memory");
        }
    }
    __syncthreads();
}

namespace pg8 {
constexpr int BM = 256, BK = 64, HALF = 128, HTB = HALF * BK * 2, STAGE_BYTES = 8 * HTB, NXCD = 8, WGM = 8;
__host__ __device__ __forceinline__ int lds_byte(int r, int c) { const int st = (r >> 4) * 2 + (c >> 5), rr = r & 15, cc = c & 31, ob = rr * 64 + cc * 2; return st * 1024 + (ob ^ (((ob >> 9) & 1) << 5)); }
__host__ __device__ __forceinline__ void stage_rc(int b, int& R, int& C) { const int st = b / 1024, sb = b % 1024, swz = sb ^ (((sb >> 9) & 1) << 5); R = (st >> 1) * 16 + swz / 64; C = (st & 1) * 32 + (swz % 64) / 2; }
__host__ __device__ __forceinline__ int perm32(int rho) { const int n = rho >> 4, i = rho & 15; return 8 * (i >> 2) + 4 * n + (i & 3); }

__device__ __forceinline__ bool dense_order(int i, int G, int c, int nM, int nN, int& pm, int& pn) {
    const int nwg = nM * nN; const long L = (long)i * G + c; if (L >= nwg) return false;
    int wgid = (int)L; { const int q = nwg / NXCD, r = nwg % NXCD, xcd = wgid % NXCD, off = wgid / NXCD; wgid = (xcd < r ? xcd * (q + 1) : r * (q + 1) + (xcd - r) * q) + off; }
    const int nig = WGM * nN, gid = wgid / nig, fm = gid * WGM, gsz = (nM - fm) < WGM ? (nM - fm) : WGM;
    pm = __builtin_amdgcn_readfirstlane(fm + ((wgid % nig) % gsz)); pn = __builtin_amdgcn_readfirstlane((wgid % nig) / gsz); return true;
}

template <bool GATHER> struct UCtx { const char* a0[2]; const char* a1[2]; const char* b; unsigned vg[2][2]; };
template <> struct UCtx<false> { const char* a0[2]; const char* a1[2]; const char* b; };

template <class P>
__device__ __forceinline__ void gemm_phase(LAS unsigned char* lds, const P& pol) {
    typedef typename P::Unit Unit;
    const int tid = opaque_tid(), wid = __builtin_amdgcn_readfirstlane(tid >> 6), lane = tid & 63, wr = wid >> 2, wc = wid & 3, fr = lane & 15, fq = lane >> 4;
    constexpr int nt = P::NT;
    int Rr[2], Cc[2]; unsigned voffB[2], va0[2];
#pragma unroll
    for (int i = 0; i < 2; ++i) { stage_rc(tid * 16 + i * 8192, Rr[i], Cc[i]); const int Rb = P::PERM ? ((Rr[i] & ~31) + perm32(Rr[i] & 31)) : Rr[i];
        voffB[i] = (unsigned)(Rb * P::LDB + Cc[i] * 2); va0[i] = pol.lane_a0(Rr[i], Cc[i]); }
    constexpr size_t hstepB = (size_t)HALF * P::LDB;
    const unsigned ldsw = (unsigned)wid * 1024u;
    const int aoff = lds_byte(wr * 64 + fr, fq * 8), boff = lds_byte(wc * 32 + fr, fq * 8);
#define PG8_SA(b, h) (((b) * 2 + (h)) * HTB)
#define PG8_SB(b, h) ((4 + (b) * 2 + (h)) * HTB)
#define PG8_GL(bufoff, p0, p1) do { __builtin_amdgcn_global_load_lds((const unsigned*)(p0), (LAS unsigned*)(lds + (bufoff) + ldsw), 16, 0, 0); \
        __builtin_amdgcn_global_load_lds((const unsigned*)(p1), (LAS unsigned*)(lds + (bufoff) + ldsw + 8192), 16, 0, 0); } while (0)
#define PG8_STB(bufoff, U, h, kt) do { const char* _b = (U).b + (size_t)(h) * hstepB + (size_t)(kt) * 128; asm volatile("" : "+s"(_b)); PG8_GL(bufoff, _b + voffB[0], _b + voffB[1]); } while (0)
#define PG8_STA(bufoff, U, h, kt) do { const char* _a = (U).a0[h] + (size_t)(kt) * P::KS0; if constexpr (P::TWOSEG) { if ((kt) >= P::KT0) _a = (U).a1[h] + (size_t)((kt) - P::KT0) * P::KS1; } \
        unsigned _o0, _o1; if constexpr (P::GATHER) { _o0 = (U).vg[h][0]; _o1 = (U).vg[h][1]; } else { _o0 = va0[0]; _o1 = va0[1]; } \
        asm volatile("" : "+s"(_a)); PG8_GL(bufoff, _a + _o0, _a + _o1); } while (0)
#define PG8_LDA(dst, b, h) do { _Pragma("unroll") for (int m = 0; m < 4; ++m) _Pragma("unroll") for (int k = 0; k < 2; ++k) dst[m][k] = *(const LAS bf16x8*)(lds + PG8_SA(b, h) + aoff + m * 2048 + k * 1024); } while (0)
#define PG8_LDB(dst, b, h) do { _Pragma("unroll") for (int n = 0; n < 2; ++n) _Pragma("unroll") for (int k = 0; k < 2; ++k) dst[n][k] = *(const LAS bf16x8*)(lds + PG8_SB(b, h) + boff + n * 2048 + k * 1024); } while (0)
#define PG8_MMA(ai, bj, At, Bt) do { __builtin_amdgcn_s_setprio(1); _Pragma("unroll") for (int m = 0; m < 4; ++m) _Pragma("unroll") for (int n = 0; n < 2; ++n) _Pragma("unroll") for (int k = 0; k < 2; ++k) \
        acc[ai][bj][m][n] = __builtin_amdgcn_mfma_f32_16x16x32_bf16(Bt[n][k], At[m][k], acc[ai][bj][m][n], 0, 0, 0); __builtin_amdgcn_s_setprio(0); } while (0)
#define PG8_WAIT_V(n) asm volatile("s_waitcnt vmcnt(" #n ")" ::: "memory")
#define PG8_WAIT_L(n) asm volatile("s_waitcnt lgkmcnt(" #n ")" ::: "memory")
#define PG8_BAR __builtin_amdgcn_s_barrier()
#define PG8_SCHED __builtin_amdgcn_sched_barrier(0)
    Unit cur, nxt; int ui = 0;
    if (!pol.next(0, cur)) return;
    UCtx<P::GATHER> cc, nc;
    pol.ctx(cur, cc, Rr, Cc);
    f32x4 acc[2][2][4][2];
#pragma unroll
    for (int a = 0; a < 2; ++a)
#pragma unroll
        for (int b = 0; b < 2; ++b)
#pragma unroll
            for (int m = 0; m < 4; ++m)
#pragma unroll
                for (int n = 0; n < 2; ++n) acc[a][b][m][n] = (f32x4){0.f, 0.f, 0.f, 0.f};
    bf16x8 At[4][2], B0[2][2], B1[2][2];
    PG8_STB(PG8_SB(0, 0), cc, 0, 0); PG8_STB(PG8_SB(0, 1), cc, 1, 0); PG8_STA(PG8_SA(0, 0), cc, 0, 0); PG8_STA(PG8_SA(0, 1), cc, 1, 0);
    if (wr == 1) PG8_BAR;
    PG8_WAIT_V(2); PG8_BAR;
    PG8_STB(PG8_SB(1, 0), cc, 0, 1); PG8_STA(PG8_SA(1, 0), cc, 0, 1); PG8_STB(PG8_SB(1, 1), cc, 1, 1);
    PG8_WAIT_V(6); PG8_BAR;
    for (;;) {
        const bool has_next = pol.next(ui + 1, nxt);
        if (has_next) pol.ctx(nxt, nc, Rr, Cc); else nc = cc;
        for (int t = 0; t < nt; t += 2) {
            const bool last = (t == nt - 2);
            const int k2 = last ? 0 : t + 2, k3 = k2 + 1;
            PG8_LDB(B0, 0, 0); PG8_LDB(B1, 0, 1); PG8_SCHED; PG8_LDA(At, 0, 0); PG8_STA(PG8_SA(1, 1), cc, 1, t + 1);
            PG8_WAIT_V(8); PG8_WAIT_L(0); PG8_BAR; PG8_MMA(0, 0, At, B0); PG8_MMA(0, 1, At, B1); PG8_BAR; PG8_SCHED;
            PG8_LDA(At, 0, 1);
            if (last) { PG8_STB(PG8_SB(0, 0), nc, 0, 0); PG8_STB(PG8_SB(0, 1), nc, 1, 0); PG8_STA(PG8_SA(0, 0), nc, 0, 0); }
            else      { PG8_STB(PG8_SB(0, 0), cc, 0, k2); PG8_STB(PG8_SB(0, 1), cc, 1, k2); PG8_STA(PG8_SA(0, 0), cc, 0, k2); }
            PG8_WAIT_V(8); PG8_WAIT_L(0); PG8_BAR; PG8_MMA(1, 0, At, B0); PG8_MMA(1, 1, At, B1); PG8_BAR; PG8_SCHED;
            PG8_LDB(B0, 1, 0); PG8_LDB(B1, 1, 1); PG8_SCHED; PG8_LDA(At, 1, 0);
            if (last) { PG8_STA(PG8_SA(0, 1), nc, 1, 0); } else { PG8_STA(PG8_SA(0, 1), cc, 1, k2); }
            PG8_WAIT_V(8); PG8_WAIT_L(0); PG8_BAR; PG8_MMA(0, 0, At, B0); PG8_MMA(0, 1, At, B1); PG8_BAR; PG8_SCHED;
            PG8_LDA(At, 1, 1);
            if (last) { PG8_STB(PG8_SB(1, 0), nc, 0, 1); PG8_STB(PG8_SB(1, 1), nc, 1, 1); PG8_STA(PG8_SA(1, 0), nc, 0, 1); }
            else      { PG8_STB(PG8_SB(1, 0), cc, 0, k3); PG8_STB(PG8_SB(1, 1), cc, 1, k3); PG8_STA(PG8_SA(1, 0), cc, 0, k3); }
            PG8_WAIT_V(8); PG8_WAIT_L(0); PG8_BAR; PG8_MMA(1, 0, At, B0); PG8_MMA(1, 1, At, B1); PG8_BAR; PG8_SCHED;
        }
        if (wr == 0) PG8_BAR;
        pol.epi(acc, cur, wr, wc, fr, fq);
        if (!has_next) break;
#pragma unroll
        for (int a = 0; a < 2; ++a)
#pragma unroll
            for (int b = 0; b < 2; ++b)
#pragma unroll
                for (int m = 0; m < 4; ++m)
#pragma unroll
                    for (int n = 0; n < 2; ++n) acc[a][b][m][n] = (f32x4){0.f, 0.f, 0.f, 0.f};
        cur = nxt; cc = nc; ++ui;
        if (wr == 1) PG8_BAR;
    }
    PG8_WAIT_V(0);
    PG8_BAR;
#undef PG8_SA
#undef PG8_SB
#undef PG8_GL
#undef PG8_STB
#undef PG8_STA
#undef PG8_LDA
#undef PG8_LDB
#undef PG8_MMA
#undef PG8_WAIT_V
#undef PG8_WAIT_L
#undef PG8_BAR
#undef PG8_SCHED
}
}
struct DUnit { int pm, pn; };

template <int NT_, int LDA_, bool PERM_> struct DenseBase {
    static constexpr bool PERM = PERM_, GATHER = false, TWOSEG = false;
    static constexpr int NT = NT_, KT0 = NT_, KS0 = 128, KS1 = 128, LDB = NT_ * 128;
    typedef DUnit Unit;
    const char* A; const char* Bt; int nM, nN, G, c;
    __device__ __forceinline__ bool next(int i, Unit& u) const { return pg8::dense_order(i, G, c, nM, nN, u.pm, u.pn); }
    __device__ __forceinline__ void ctx(const Unit& u, pg8::UCtx<false>& x, const int (&)[2], const int (&)[2]) const {
        x.a0[0] = A + (size_t)u.pm * 256 * LDA_; x.a0[1] = x.a0[0] + (size_t)128 * LDA_; x.a1[0] = x.a0[0]; x.a1[1] = x.a0[1];
        x.b = Bt + (size_t)u.pn * 256 * LDB; }
    __device__ __forceinline__ unsigned lane_a0(int R, int C) const { return (unsigned)(R * LDA_ + C * 2); }
    __device__ __forceinline__ unsigned lane_a1(int, int) const { return 0u; }
};

__device__ __forceinline__ void store8(bf16_t* p, const f32x4& v0, const f32x4& v1) {
    u32x4 w; w.x = cvt_pk_bf16(v0[0], v0[1]); w.y = cvt_pk_bf16(v0[2], v0[3]); w.z = cvt_pk_bf16(v1[0], v1[1]); w.w = cvt_pk_bf16(v1[2], v1[3]); *(u32x4*)p = w; }
__device__ __forceinline__ float sq4(const f32x4& v) { return (v[0] * v[0] + v[1] * v[1]) + (v[2] * v[2] + v[3] * v[3]); }
__device__ __forceinline__ void rope8(f32x4& v0, f32x4& v1, const float* cs) {
    const f32x4 a = *(const f32x4*)cs, b = *(const f32x4*)(cs + 4);
    float x0, x1;
    x0 = v0[0]; x1 = v0[1]; v0[0] = x0 * a[0] - x1 * a[1]; v0[1] = x0 * a[1] + x1 * a[0];
    x0 = v0[2]; x1 = v0[3]; v0[2] = x0 * a[2] - x1 * a[3]; v0[3] = x0 * a[3] + x1 * a[2];
    x0 = v1[0]; x1 = v1[1]; v1[0] = x0 * b[0] - x1 * b[1]; v1[1] = x0 * b[1] + x1 * b[0];
    x0 = v1[2]; x1 = v1[3]; v1[2] = x0 * b[2] - x1 * b[3]; v1[3] = x0 * b[3] + x1 * b[2];
}

struct PolDqkv : DenseBase<16, 2048, true> {
    bf16_t* A1; float* SSQ1; bf16_t* KPE; const float* ROPE;
    __device__ __forceinline__ void epi(const f32x4 (&acc)[2][2][4][2], const DUnit& u, int wr, int wc, int fr, int fq) const {
#pragma unroll
        for (int ai = 0; ai < 2; ++ai)
#pragma unroll
            for (int m = 0; m < 4; ++m) {
                const int row = u.pm * 256 + ai * 128 + wr * 64 + m * 16 + fr;
                bf16_t* rowp = A1 + (size_t)row * NDQKV + u.pn * 256 + wc * 32 + 8 * fq;
                float s0 = sq4(acc[ai][0][m][0]) + sq4(acc[ai][0][m][1]), s1 = sq4(acc[ai][1][m][0]) + sq4(acc[ai][1][m][1]);
                store8(rowp, acc[ai][0][m][0], acc[ai][0][m][1]); store8(rowp + 128, acc[ai][1][m][0], acc[ai][1][m][1]);
                s0 += __shfl_xor(s0, 16); s0 += __shfl_xor(s0, 32); s1 += __shfl_xor(s1, 16); s1 += __shfl_xor(s1, 32);
                if (fq == 0) {
                    float* sp = SSQ1 + (size_t)row * 16;
                    if (u.pn == 0) sp[wc] = s0 + s1; else if (u.pn == 1) { sp[4 + wc] = s0; sp[8 + wc] = s1; } else sp[12 + wc] = s0;
                }
                if (u.pn == 2 && wc < 2) {
                    f32x4 v0 = acc[ai][1][m][0], v1 = acc[ai][1][m][1];
                    if (row >= NCTXR) { const int t = (row - NCTXR) & (SEQL - 1); rope8(v0, v1, ROPE + ((size_t)t * 32 + 16 * wc + 4 * fq) * 2); }
                    store8(KPE + (size_t)row * 64 + 32 * wc + 8 * fq, v0, v1);
                }
            }
    }
};

struct PolQup : DenseBase<6, NDQKV * 2, true> {
    bf16_t* Q; const float* SSQ1;
    __device__ __forceinline__ void epi(const f32x4 (&acc)[2][2][4][2], const DUnit& u, int wr, int wc, int fr, int fq) const {
#pragma unroll
        for (int ai = 0; ai < 2; ++ai) {
            f32x4 p0[4], p1[4];
#pragma unroll
            for (int m = 0; m < 4; ++m) { const int row = u.pm * 256 + ai * 128 + wr * 64 + m * 16 + fr; p0[m] = *(const f32x4*)(SSQ1 + (size_t)row * 16); p1[m] = *(const f32x4*)(SSQ1 + (size_t)row * 16 + 4); }
#pragma unroll
            for (int m = 0; m < 4; ++m) {
                const int row = u.pm * 256 + ai * 128 + wr * 64 + m * 16 + fr;
                const float ss = ((p0[m][0] + p0[m][1]) + (p0[m][2] + p0[m][3])) + ((p1[m][0] + p1[m][1]) + (p1[m][2] + p1[m][3]));
                const float rstd = __builtin_amdgcn_rsqf(ss * (1.f / QLORA) + NORM_EPS);
                bf16_t* rowp = Q + (size_t)row * NQ + u.pn * 256 + wc * 32 + 8 * fq;
                store8(rowp, acc[ai][0][m][0] * rstd, acc[ai][0][m][1] * rstd); store8(rowp + 128, acc[ai][1][m][0] * rstd, acc[ai][1][m][1] * rstd);
            }
            asm volatile("" ::: "memory");
        }
    }
};

struct PolKVup : DenseBase<4, NDQKV * 2, true> {
    bf16_t* KV; const float* SSQ1;
    __device__ __forceinline__ void epi(const f32x4 (&acc)[2][2][4][2], const DUnit& u, int wr, int wc, int fr, int fq) const {
#pragma unroll
        for (int ai = 0; ai < 2; ++ai) {
            f32x4 p0[4], p1[4];
#pragma unroll
            for (int m = 0; m < 4; ++m) { const int row = u.pm * 256 + ai * 128 + wr * 64 + m * 16 + fr; p0[m] = *(const f32x4*)(SSQ1 + (size_t)row * 16 + 8); p1[m] = *(const f32x4*)(SSQ1 + (size_t)row * 16 + 12); }
#pragma unroll
            for (int m = 0; m < 4; ++m) {
                const int row = u.pm * 256 + ai * 128 + wr * 64 + m * 16 + fr;
                const float ss = ((p0[m][0] + p0[m][1]) + (p0[m][2] + p0[m][3])) + ((p1[m][0] + p1[m][1]) + (p1[m][2] + p1[m][3]));
                const float rstd = __builtin_amdgcn_rsqf(ss * (1.f / KVLORA) + NORM_EPS);
                bf16_t* rowp = KV + (size_t)row * NKV + u.pn * 256 + wc * 32 + 8 * fq;
                store8(rowp, acc[ai][0][m][0] * rstd, acc[ai][0][m][1] * rstd); store8(rowp + 128, acc[ai][1][m][0] * rstd, acc[ai][1][m][1] * rstd);
            }
            asm volatile("" ::: "memory");
        }
    }
};

struct PolWo : DenseBase<16, 2048, true> {
    bf16_t* OO; float* SSQO;
    __device__ __forceinline__ void epi(const f32x4 (&acc)[2][2][4][2], const DUnit& u, int wr, int wc, int fr, int fq) const {
#pragma unroll
        for (int ai = 0; ai < 2; ++ai)
#pragma unroll
            for (int m = 0; m < 4; ++m) {
                const int row = u.pm * 256 + ai * 128 + wr * 64 + m * 16 + fr;
                bf16_t* rowp = OO + (size_t)row * DM + u.pn * 256 + wc * 32 + 8 * fq;
                float s = (sq4(acc[ai][0][m][0]) + sq4(acc[ai][0][m][1])) + (sq4(acc[ai][1][m][0]) + sq4(acc[ai][1][m][1]));
                store8(rowp, acc[ai][0][m][0], acc[ai][0][m][1]); store8(rowp + 128, acc[ai][1][m][0], acc[ai][1][m][1]);
                s += __shfl_xor(s, 16); s += __shfl_xor(s, 32);
                if (fq == 0) SSQO[(size_t)row * 32 + u.pn * 4 + wc] = s;
            }
    }
};
namespace attn {
constexpr int NW = 8, QBLK = 32, KVBLK = 64, DQK = 192, DV = 128;
constexpr float SCALE = 0.07216878364870322f;
constexpr float THR = 8.f;
constexpr int SHM_V = KVBLK * DV * 2, SHM_K = KVBLK * DQK * 2;
constexpr int SHM_QPE = NW * 4096;
constexpr int SHM_ATTN = 2 * SHM_V + 2 * SHM_K + NW * 64 * 4 + SHM_QPE;
#define KSWZ(row, colB) ((row) * 384 + ((colB) ^ (((row) & 7) << 4)))
#define SBAR() __builtin_amdgcn_sched_barrier(0)
__device__ __forceinline__ int crow(int r, int hi) { return (r & 3) + 8 * (r >> 2) + 4 * hi; }
__device__ __forceinline__ unsigned cvtpk(float lo, float hi) { unsigned r; asm volatile("v_cvt_pk_bf16_f32 %0, %1, %2" : "=v"(r) : "v"(lo), "v"(hi)); return r; }

__device__ __forceinline__ void partialSM(f32x16& p0, f32x16& p1, float& m_reg, float& mn, float& alpha) {
  constexpr float C = SCALE * 1.4426950408889634f;
  float pmax = p0[0];
#pragma unroll
  for (int r = 1; r < 16; ++r) pmax = fmaxf(pmax, p0[r]);
#pragma unroll
  for (int r = 0; r < 16; ++r) pmax = fmaxf(pmax, p1[r]);
  { auto rr = __builtin_amdgcn_permlane32_swap(__float_as_uint(pmax), __float_as_uint(pmax), false, false);
    pmax = fmaxf(__uint_as_float(rr[0]), __uint_as_float(rr[1])); }
  if (__builtin_expect(__all(pmax - m_reg <= THR / SCALE), 1)) { mn = m_reg; alpha = 1.f; }
  else { mn = fmaxf(m_reg, pmax); alpha = __builtin_amdgcn_exp2f((m_reg - mn) * C); m_reg = mn; }
  float mnC = -mn * C;
#pragma unroll
  for (int r = 0; r < 16; ++r) p0[r] = fmaf(p0[r], C, mnC);
#pragma unroll
  for (int r = 0; r < 16; ++r) p1[r] = fmaf(p1[r], C, mnC);
#pragma unroll
  for (int r = 0; r < 16; ++r) p0[r] = __builtin_amdgcn_exp2f(p0[r]);
}
__device__ __forceinline__ void finishSM(f32x16& p0, f32x16& p1, float alpha, float& l_reg, bf16x8& pa0, bf16x8& pa1, bf16x8& pa2, bf16x8& pa3) {
#pragma unroll
  for (int r = 0; r < 16; ++r) p1[r] = __builtin_amdgcn_exp2f(p1[r]);
  float ps = 0;
#pragma unroll
  for (int r = 0; r < 16; ++r) ps += p0[r];
#pragma unroll
  for (int r = 0; r < 16; ++r) ps += p1[r];
  { auto rr = __builtin_amdgcn_permlane32_swap(__float_as_uint(ps), __float_as_uint(ps), false, false);
    ps = __uint_as_float(rr[0]) + __uint_as_float(rr[1]); }
  l_reg = l_reg * alpha + ps;
#define PK4(P, BASE, OUT) do { unsigned a0 = cvtpk(P[BASE + 0], P[BASE + 1]), a1 = cvtpk(P[BASE + 2], P[BASE + 3]);   \
    unsigned b0 = cvtpk(P[BASE + 4], P[BASE + 5]), b1 = cvtpk(P[BASE + 6], P[BASE + 7]);                              \
    auto r0 = __builtin_amdgcn_permlane32_swap(a0, b0, false, false); auto r1 = __builtin_amdgcn_permlane32_swap(a1, b1, false, false); \
    u32x4 w = {r0[0], r1[0], r0[1], r1[1]}; OUT = *reinterpret_cast<bf16x8*>(&w); } while (0)
  PK4(p0, 0, pa0); PK4(p0, 8, pa1); PK4(p1, 0, pa2); PK4(p1, 8, pa3);
#undef PK4
}
__device__ __forceinline__ void qkt(f32x16& p0, f32x16& p1, const char* Ks, const bf16x8* qr, const char* qpe, int r32, int hi) {
  p0 = f32x16{}; p1 = f32x16{};
#pragma unroll
  for (int d0 = 0; d0 < 12; ++d0) { int cb = (d0 * 16 + hi * 8) * 2;
    bf16x8 b0 = *reinterpret_cast<const bf16x8*>(Ks + KSWZ(r32, cb));
    bf16x8 b1 = *reinterpret_cast<const bf16x8*>(Ks + KSWZ(32 + r32, cb));
    const bf16x8 q = d0 < 8 ? qr[d0 < 8 ? d0 : 0] : *reinterpret_cast<const bf16x8*>(qpe + (d0 - 8) * 1024);
    p0 = __builtin_amdgcn_mfma_f32_32x32x16_bf16(b0, q, p0, 0, 0, 0);
    p1 = __builtin_amdgcn_mfma_f32_32x32x16_bf16(b1, q, p1, 0, 0, 0);
    if ((d0 & 3) == 3) SBAR(); }
}
__device__ __forceinline__ int v_st(int k, int c) { const int kk = (k & ~0xC) | ((k & 4) << 1) | ((k & 8) >> 1); return ((kk >> 3) * 4 + (c >> 5)) * 512 + ((kk & 7) * 32 + (c & 31)) * 2; }
__device__ __forceinline__ int v_rd_base(int lane) { return ((lane & 3) << 3) | (((lane >> 2) & 3) << 6) | (((lane >> 4) & 1) << 5) | (((lane >> 5) & 1) << 8); }
constexpr int v_rd_off(int d0, int ks, int half) { return d0 * 512 + ks * 4096 + half * 2048; }
template <int OFF> __device__ __forceinline__ s16x4 tr_read(int vb) {
  s16x4 r; asm volatile("ds_read_b64_tr_b16 %0, %1 offset:%2" : "=&v"(r) : "v"(vb), "i"(OFF) : "memory"); return r;
}
template <int D0> __device__ __forceinline__ void pv_one(f32x16& od, int vb, bf16x8 pa0, bf16x8 pa1, bf16x8 pa2, bf16x8 pa3) {
  const s16x4 l0 = tr_read<v_rd_off(D0, 0, 0)>(vb), h0 = tr_read<v_rd_off(D0, 0, 1)>(vb), l1 = tr_read<v_rd_off(D0, 1, 0)>(vb), h1 = tr_read<v_rd_off(D0, 1, 1)>(vb);
  const s16x4 l2 = tr_read<v_rd_off(D0, 2, 0)>(vb), h2 = tr_read<v_rd_off(D0, 2, 1)>(vb), l3 = tr_read<v_rd_off(D0, 3, 0)>(vb), h3 = tr_read<v_rd_off(D0, 3, 1)>(vb);
  asm volatile("s_waitcnt lgkmcnt(0)" ::: "memory"); SBAR();
#define PK(L, H) (bf16x8){L[0], L[1], L[2], L[3], H[0], H[1], H[2], H[3]}
  od = __builtin_amdgcn_mfma_f32_32x32x16_bf16(pa0, PK(l0, h0), od, 0, 0, 0);
  od = __builtin_amdgcn_mfma_f32_32x32x16_bf16(pa1, PK(l1, h1), od, 0, 0, 0);
  od = __builtin_amdgcn_mfma_f32_32x32x16_bf16(pa2, PK(l2, h2), od, 0, 0, 0);
  od = __builtin_amdgcn_mfma_f32_32x32x16_bf16(pa3, PK(l3, h3), od, 0, 0, 0);
#undef PK
}
__device__ __forceinline__ void pv_d0(f32x16* o, int vb, bf16x8 pa0, bf16x8 pa1, bf16x8 pa2, bf16x8 pa3) {
  pv_one<0>(o[0], vb, pa0, pa1, pa2, pa3); pv_one<1>(o[1], vb, pa0, pa1, pa2, pa3); pv_one<2>(o[2], vb, pa0, pa1, pa2, pa3); pv_one<3>(o[3], vb, pa0, pa1, pa2, pa3);
}

__device__ __forceinline__ void attn_unit(const bf16_t* __restrict__ Qg, const bf16_t* __restrict__ KVb, const bf16_t* __restrict__ KPE, bf16_t* __restrict__ Og, const float* __restrict__ ROPE,
                                          int qrow0, int qt0, int h, int crow0, int lrow0, int NT, char* lds) {
  const int tid = opaque_tid(), wid = tid >> 6, lane = tid & 63, r32 = lane & 31, hi = lane >> 5;
  char* V_lds = lds; char* K_lds = lds + 2 * SHM_V;
  float* ws = (float*)(lds + 2 * SHM_V + 2 * SHM_K) + wid * 64; float* li_l = ws; float* al_l = ws + 32;
  float m_reg = -1e30f, l_reg = 0; f32x16 o[4] = {}; bf16x8 qr[8];
  char* qpe = lds + 2 * SHM_V + 2 * SHM_K + NW * 64 * 4 + wid * 4096 + lane * 16;
  const bf16_t* Qw = Qg + (size_t)(qrow0 + wid * QBLK + r32) * NQ + h * DQK + hi * 8;
#pragma unroll
  for (int d0 = 0; d0 < 8; ++d0) qr[d0] = *reinterpret_cast<const bf16x8*>(Qw + d0 * 16);
#pragma unroll
  for (int d0 = 8; d0 < 12; ++d0) {
    u32x4 qv = *reinterpret_cast<const u32x4*>(Qw + d0 * 16);
    if (qt0 >= 0) { const float* cs = ROPE + ((size_t)(qt0 + wid * QBLK + r32) * 32 + 8 * (d0 - 8) + 4 * hi) * 2; const f32x4 ca = *(const f32x4*)cs, cb = *(const f32x4*)(cs + 4);
      float x0, x1;
      x0 = bf_lo(qv.x); x1 = bf_hi(qv.x); qv.x = cvtpk(x0 * ca[0] - x1 * ca[1], x0 * ca[1] + x1 * ca[0]);
      x0 = bf_lo(qv.y); x1 = bf_hi(qv.y); qv.y = cvtpk(x0 * ca[2] - x1 * ca[3], x0 * ca[3] + x1 * ca[2]);
      x0 = bf_lo(qv.z); x1 = bf_hi(qv.z); qv.z = cvtpk(x0 * cb[0] - x1 * cb[1], x0 * cb[1] + x1 * cb[0]);
      x0 = bf_lo(qv.w); x1 = bf_hi(qv.w); qv.w = cvtpk(x0 * cb[2] - x1 * cb[3], x0 * cb[3] + x1 * cb[2]); }
    *reinterpret_cast<u32x4*>(qpe + (d0 - 8) * 1024) = qv; }
  const int sr = tid >> 4, sc = (tid & 15) * 8, vst0 = v_st(sr, sc), vst1 = v_st(32 + sr, sc);
  const int pr = tid >> 3, pc = (tid & 7) * 8;
  const int vb0 = (int)(uintptr_t)V_lds + v_rd_base(lane);
  bf16x8 vs0, vs1, ks0, ks1, kp;
#define TROW(j) ((j) < 4 ? crow0 + 64 * (j) : lrow0 + 64 * ((j) - 4))
#define SLOAD(j) do { const int k0_ = TROW(j); const bf16_t* kv0_ = KVb + (size_t)(k0_ + sr) * NKV + h * 256 + sc; const bf16_t* kv1_ = kv0_ + (size_t)32 * NKV; \
    vs0 = *reinterpret_cast<const bf16x8*>(kv0_ + 128); vs1 = *reinterpret_cast<const bf16x8*>(kv1_ + 128); \
    ks0 = *reinterpret_cast<const bf16x8*>(kv0_); ks1 = *reinterpret_cast<const bf16x8*>(kv1_); \
    kp = *reinterpret_cast<const bf16x8*>(KPE + (size_t)(k0_ + pr) * 64 + pc); } while (0)
#define SWRITE(b) do { *(bf16x8*)(V_lds + (b) * SHM_V + vst0) = vs0; *(bf16x8*)(V_lds + (b) * SHM_V + vst1) = vs1; \
    *(bf16x8*)(K_lds + (b) * SHM_K + KSWZ(sr, sc * 2)) = ks0; *(bf16x8*)(K_lds + (b) * SHM_K + KSWZ(32 + sr, sc * 2)) = ks1; \
    *(bf16x8*)(K_lds + (b) * SHM_K + KSWZ(pr, (128 + pc) * 2)) = kp; } while (0)
#define SWAIT() asm volatile("s_waitcnt vmcnt(0)" ::: "memory")
#define RESC(a) do { if (__any((a) < 1.f)) { if (hi == 0) al_l[r32] = (a); asm volatile("s_waitcnt lgkmcnt(0)" ::: "memory"); \
    _Pragma("unroll") for (int d = 0; d < 4; ++d) _Pragma("unroll") for (int r = 0; r < 16; ++r) o[d][r] *= al_l[crow(r, hi)]; } } while (0)
  f32x16 pA0, pA1, pB0, pB1; float mnA, mnB, alA, alB; bf16x8 pa0, pa1, pa2, pa3;
  SLOAD(0); SWAIT(); SWRITE(0); __syncthreads();
  qkt(pA0, pA1, K_lds, qr, qpe, r32, hi); partialSM(pA0, pA1, m_reg, mnA, alA);
  SLOAD(1);
  SWAIT(); SWRITE(1); __syncthreads();
  for (int j = 1; j + 1 < NT; j += 2) {
    SBAR(); qkt(pB0, pB1, K_lds + SHM_K, qr, qpe, r32, hi);
    finishSM(pA0, pA1, alA, l_reg, pa0, pa1, pa2, pa3); SBAR();
    SLOAD(j + 1); SBAR();
    pv_d0(o, vb0, pa0, pa1, pa2, pa3); partialSM(pB0, pB1, m_reg, mnB, alB);
    __syncthreads(); SWAIT(); SWRITE(0);
    RESC(alB); __syncthreads();
    SBAR(); qkt(pA0, pA1, K_lds, qr, qpe, r32, hi);
    finishSM(pB0, pB1, alB, l_reg, pa0, pa1, pa2, pa3); SBAR();
    SLOAD(j + 2); SBAR();
    pv_d0(o, vb0 + SHM_V, pa0, pa1, pa2, pa3); partialSM(pA0, pA1, m_reg, mnA, alA);
    __syncthreads(); SWAIT(); SWRITE(1);
    RESC(alA); __syncthreads();
  }
  SBAR(); qkt(pB0, pB1, K_lds + SHM_K, qr, qpe, r32, hi);
  finishSM(pA0, pA1, alA, l_reg, pa0, pa1, pa2, pa3); SBAR();
  pv_d0(o, vb0, pa0, pa1, pa2, pa3); partialSM(pB0, pB1, m_reg, mnB, alB);
  __syncthreads(); RESC(alB);
  finishSM(pB0, pB1, alB, l_reg, pa0, pa1, pa2, pa3); SBAR();
  pv_d0(o, vb0 + SHM_V, pa0, pa1, pa2, pa3);
  if (hi == 0) li_l[r32] = l_reg; asm volatile("s_waitcnt lgkmcnt(0)" ::: "memory");
  float rli[16];
#pragma unroll
  for (int r = 0; r < 16; ++r) rli[r] = __builtin_amdgcn_rcpf(li_l[crow(r, hi)]);
  bf16_t* Ow = Og + (size_t)(qrow0 + wid * QBLK) * DM + h * DV;
#pragma unroll
  for (int r = 0; r < 16; ++r) { const int orow = crow(r, hi);
#pragma unroll
    for (int d0 = 0; d0 < 4; ++d0) Ow[(size_t)orow * DM + d0 * 32 + r32] = (bf16_t)(cvtpk(o[d0][r] * rli[r], 0.f) & 0xffffu); }
  __syncthreads();
#undef TROW
#undef SLOAD
#undef SWRITE
#undef SWAIT
#undef RESC
}
#undef KSWZ
#undef SBAR
}
constexpr int NWAVES = 8;
constexpr int RING_BYTES = 131072, LDSCTL_OFF = RING_BYTES, LDS_BYTES = 147456;

struct Args {
    const float* in[31]; float* out; unsigned char* ws; int stage; int pad;
};
struct Frame {
    LAS unsigned char* lds; int vcu, G; unsigned char* ws;
};
constexpr int PTAB_OFF = 131072 + 512;
__device__ __forceinline__ const float* inp(const Frame& F, int i) {
    const LAS unsigned* t = (const LAS unsigned*)(F.lds + PTAB_OFF) + 2 * i;
    const unsigned lo = __builtin_amdgcn_readfirstlane(t[0]), hi = __builtin_amdgcn_readfirstlane(t[1]);
    return (const float*)(((unsigned long long)hi << 32) | lo);
}

__device__ __forceinline__ unsigned f2bf(float f) { unsigned u = __float_as_uint(f); return (u + 0x7fffu + ((u >> 16) & 1u)) >> 16; }
__device__ __forceinline__ unsigned pk2(float lo, float hi) { return f2bf(lo) | (f2bf(hi) << 16); }
__device__ __forceinline__ void cvt_item(const float* srcA, const float* srcB, const float* kscale, bf16_t* dst, int ld, int K, int nrows, int nvalid, int mode, int item, LAS float* scr, int lane) {
    const int nblk = nrows >> 5, kb = item / nblk, nb = item - kb * nblk, k0 = 64 * kb, n0 = 32 * nb;
    const float* src = srcA; int col = n0; bool valid = n0 < nvalid;
    if (mode == 1) { const int t = n0 >> 8, r = n0 & 255; src = r < 128 ? srcA : srcB; col = 128 * t + (r & 127); valid = true; }
    const int kk = lane >> 3, n4 = (lane & 7) * 4;
    f32x4 v[8];
    if (valid) {
        const float* sp = src + (size_t)(k0 + kk) * ld + col + n4;
#pragma unroll
        for (int i = 0; i < 8; ++i) v[i] = *(const f32x4*)(sp + (size_t)(8 * i) * ld);
        if (kscale) {
#pragma unroll
            for (int i = 0; i < 8; ++i) v[i] = v[i] * kscale[k0 + 8 * i + kk];
        }
    } else {
#pragma unroll
        for (int i = 0; i < 8; ++i) v[i] = (f32x4){0.f, 0.f, 0.f, 0.f};
    }
#pragma unroll
    for (int i = 0; i < 8; ++i) { LAS float* d = scr + (8 * i + kk) * 33 + n4; d[0] = v[i][0]; d[1] = v[i][1]; d[2] = v[i][2]; d[3] = v[i][3]; }
    asm volatile("s_waitcnt lgkmcnt(0)" ::: "memory");
    const int c = lane & 7;
#pragma unroll
    for (int j = 0; j < 4; ++j) { const int n = (lane >> 3) + 8 * j; const LAS float* s = scr + (8 * c) * 33 + n;
        u32x4 o; o.x = cvt_pk_bf16(s[0 * 33], s[1 * 33]); o.y = cvt_pk_bf16(s[2 * 33], s[3 * 33]); o.z = cvt_pk_bf16(s[4 * 33], s[5 * 33]); o.w = cvt_pk_bf16(s[6 * 33], s[7 * 33]);
        *(u32x4*)(dst + (size_t)(n0 + n) * K + k0 + 8 * c) = o; }
    asm volatile("s_waitcnt lgkmcnt(0)" ::: "memory");
}
constexpr int N_SMALL_JOBS = 11;
__device__ __forceinline__ void convert_small(const Args& a, Frame& F) {
    unsigned char* const wsl = opaque_ptr(a.ws);
    const int tid_ = opaque_tid(), lane_ = tid_ & 63, wave_ = __builtin_amdgcn_readfirstlane(tid_ >> 6);
    LAS float* scr = (LAS float*)(F.lds + wave_ * 16384);
    const int gw = F.vcu * NWAVES + wave_, NGW = F.G * NWAVES;
    unsigned char* ws = wsl;
    int base = 0;
#define SMALL_JOB(SA, SB, KS, DST, LD, KK, NR, NV, MODE) do { const int n_ = ((KK) >> 6) * ((NR) >> 5); const int first_ = ((gw - base) % NGW + NGW) % NGW; \
        for (int it = first_; it < n_; it += NGW) cvt_item(SA, SB, KS, DST, LD, KK, NR, NV, MODE, it, scr, lane_); base += n_; } while (0)
    SMALL_JOB(inp(F, 7), nullptr, nullptr, (bf16_t*)(ws + WS_WDQKV), 704, 1024, 768, 704, 0);
    SMALL_JOB(inp(F, 10), nullptr, inp(F, 8), (bf16_t*)(ws + WS_WUQ), 1536, 384, 1536, 1536, 0);
    SMALL_JOB(inp(F, 11), nullptr, inp(F, 9), (bf16_t*)(ws + WS_WUKV), 2048, 256, 2048, 2048, 0);
    SMALL_JOB(inp(F, 12), nullptr, nullptr, (bf16_t*)(ws + WS_WO), 1024, 1024, 1024, 1024, 0);
    SMALL_JOB(inp(F, 21), inp(F, 21) + 1024, nullptr, (bf16_t*)(ws + WS_WGLU), 2048, 1024, 2048, 2048, 1);
#pragma unroll 1
    for (int l = 0; l < 2; ++l) {
        SMALL_JOB(inp(F, 28) + (size_t)l * 1024 * 256, inp(F, 29) + (size_t)l * 1024 * 256, nullptr, (bf16_t*)(ws + WS_WSHR) + (size_t)l * 768 * 1024, 256, 1024, 512, 512, 1);
        SMALL_JOB(inp(F, 23) + (size_t)l * 1024 * 64, nullptr, nullptr, (bf16_t*)(ws + WS_WSHR) + (size_t)l * 768 * 1024 + (size_t)512 * 1024, 64, 1024, 256, 64, 0);
        SMALL_JOB(inp(F, 30) + (size_t)l * 256 * 1024, nullptr, nullptr, (bf16_t*)(ws + WS_WSHD) + (size_t)l * 1024 * 256, 1024, 256, 1024, 1024, 0);
    }
#undef SMALL_JOB
}
__device__ __forceinline__ void convert_experts(const Args& a, Frame& F, int layer, int skip) {
    unsigned char* const wsl = opaque_ptr(a.ws);
    const int tid_ = opaque_tid(), lane_ = tid_ & 63, wave_ = __builtin_amdgcn_readfirstlane(tid_ >> 6);
    LAS float* scr = (LAS float*)(F.lds + wave_ * 16384);
    const int gw = (F.vcu - skip) * NWAVES + wave_, NGW = (F.G - skip) * NWAVES;
    for (int it = gw; it < NEXP * 384; it += NGW) { const int e = it / 384, r = it - e * 384; const size_t eo = ((size_t)layer * NEXP + e) * 1024 * 256;
        if (r < 256) cvt_item(inp(F, 25) + eo, inp(F, 26) + eo, nullptr, (bf16_t*)(wsl + WS_W1) + (size_t)e * 512 * 1024, 256, 1024, 512, 512, 1, r, scr, lane_);
        else cvt_item(inp(F, 27) + eo, nullptr, nullptr, (bf16_t*)(wsl + WS_W2) + (size_t)e * 1024 * 256, 1024, 256, 1024, 1024, 0, r - 256, scr, lane_); }
}

__device__ __forceinline__ void mod_phase(const Args& a, Frame& F) {
    unsigned char* const wsl = opaque_ptr(a.ws);
    const int tid_ = opaque_tid(), lane_ = tid_ & 63, wave_ = __builtin_amdgcn_readfirstlane(tid_ >> 6);
    LAS float* sl = (LAS float*)F.lds;
    LAS float* red = sl + 17 * 1024;
    float* MOD = (float*)(wsl + WS_MOD);
    bool have = false;
    for (int u = F.vcu; u < 256; u += F.G) {
        if (!have) { for (int i = tid_; i < 17 * 1024; i += 512) { const float v = i < 16 * 1024 ? inp(F, 1)[i] : inp(F, 3)[i - 16 * 1024]; sl[i] = silu_f(v); } __syncthreads(); have = true; }
        const int l = u >> 7, n0 = (u & 127) * 48, kg = tid_ >> 6, cl = (tid_ & 63) < 48 ? (tid_ & 63) : 47, col = n0 + cl;
        const float* W = inp(F, 4) + (size_t)l * 1024 * MODW + col;
        float acc[17];
#pragma unroll
        for (int b = 0; b < 17; ++b) acc[b] = 0.f;
#pragma unroll 8
        for (int k = kg; k < 1024; k += 8) { const float w = W[(size_t)k * MODW];
#pragma unroll
            for (int b = 0; b < 17; ++b) acc[b] += sl[b * 1024 + k] * w; }
#pragma unroll
        for (int b = 0; b < 17; ++b) red[(kg * 17 + b) * 64 + (tid_ & 63)] = acc[b];
        __syncthreads();
        for (int i = tid_; i < 17 * 64; i += 512) { const int b = i >> 6, c = i & 63; if (c >= 48) continue; float s = inp(F, 5)[(size_t)l * MODW + n0 + c];
#pragma unroll
            for (int g = 0; g < 8; ++g) s += red[(g * 17 + b) * 64 + c];
            MOD[((size_t)l * 17 + b) * MODW + n0 + c] = s; }
        __syncthreads();
    }
}
__device__ __forceinline__ void sincos_red(float ang, float& c, float& s) {
    const float k = rintf(ang * 0.15915494309189535f);
    float r = fmaf(-k, 6.2831854820251465f, ang); r = fmaf(-k, -1.7484555314695172e-07f, r);
    s = __sinf(r); c = __cosf(r);
}
__device__ __forceinline__ void rope_phase(const Args& a, Frame& F) {
    unsigned char* const wsl = opaque_ptr(a.ws);
    const int tid_ = opaque_tid(), lane_ = tid_ & 63, wave_ = __builtin_amdgcn_readfirstlane(tid_ >> 6);
    float* ROPE = (float*)(wsl + WS_ROPE);
    for (int i = (F.vcu * 512 + tid_); i < SEQL * 32; i += F.G * 512) { const int t = i >> 5, p = i & 31, j = p & 15;
        const float f = exp2f(-(float)j * (13.287712379549449f / 16.f)); const float pos = (float)(p < 16 ? (t >> 6) : (t & 63));
        float c, s; sincos_red(pos * f, c, s); ROPE[2 * i] = c; ROPE[2 * i + 1] = s; }
}

__device__ __forceinline__ const float* xrow_in(const Args& a, const Frame& F, int layer, int row) {
    unsigned char* const wsl = opaque_ptr(a.ws);
    if (layer == 0) return row < NCTXR ? inp(F, 2) + (size_t)row * DM : inp(F, 0) + (size_t)(row - NCTXR) * DM;
    return row < NCTXR ? (const float*)(wsl + WS_XCTX) + (size_t)row * DM : a.out + (size_t)(row - NCTXR) * DM;
}
__device__ __forceinline__ float* xrow_st(const Args& a, int row) {
    unsigned char* const wsl = opaque_ptr(a.ws); return row < NCTXR ? (float*)(wsl + WS_XCTX) + (size_t)row * DM : a.out + (size_t)(row - NCTXR) * DM; }
struct NormMod { f32x4 A[4], B[4]; };
__device__ __forceinline__ void normmod_load(NormMod& p, const float* g, const float* shift, const float* scale, int lane) {
#pragma unroll
    for (int j = 0; j < 4; ++j) { const int c = 4 * lane + 256 * j; p.A[j] = *(const f32x4*)(g + c) * (*(const f32x4*)(scale + c) + 1.f); p.B[j] = *(const f32x4*)(shift + c); }
}
__device__ __forceinline__ void norm_mod_store(const f32x4 (&v)[4], const NormMod& p, bf16_t* orow, int lane) {
    float s = 0.f;
#pragma unroll
    for (int j = 0; j < 4; ++j) s += sq4(v[j]);
    const float rstd = __builtin_amdgcn_rsqf(wave_sum(s) * (1.f / DM) + NORM_EPS);
#pragma unroll
    for (int j = 0; j < 4; ++j) { const int c = 4 * lane + 256 * j; const f32x4 h = (v[j] * rstd) * p.A[j] + p.B[j];
        u32x2 w; w.x = cvt_pk_bf16(h[0], h[1]); w.y = cvt_pk_bf16(h[2], h[3]); *(u32x2*)(orow + c) = w; }
}
__device__ __forceinline__ void h_phase(const Args& a, Frame& F, int layer, int row_lo) {
    unsigned char* const wsl = opaque_ptr(a.ws);
    const int tid_ = opaque_tid(), lane_ = tid_ & 63, wave_ = __builtin_amdgcn_readfirstlane(tid_ >> 6);
    const float* MOD = (const float*)(wsl + WS_MOD) + (size_t)layer * 17 * MODW; const float* g = inp(F, 6) + (size_t)(layer * 4 + 0) * DM; bf16_t* XN = (bf16_t*)(wsl + WS_XN);
    const int rpw = (NROWS - row_lo) / (F.G * NWAVES); int row = row_lo + (F.vcu * NWAVES + wave_) * rpw; const int rend = row + rpw;
    f32x4 nx[4]; NormMod nm; int cur_mi = -1;
    if (row < rend) { const float* x = xrow_in(a, F, layer, row);
#pragma unroll
        for (int j = 0; j < 4; ++j) nx[j] = *(const f32x4*)(x + 4 * lane_ + 256 * j); }
    for (; row < rend; ++row) {
        f32x4 v[4];
#pragma unroll
        for (int j = 0; j < 4; ++j) v[j] = nx[j];
        if (row + 1 < rend) { const float* x = xrow_in(a, F, layer, row + 1);
#pragma unroll
            for (int j = 0; j < 4; ++j) nx[j] = *(const f32x4*)(x + 4 * lane_ + 256 * j); }
        const int mi = mod_index(row);
        if (mi != cur_mi) { const float* m = MOD + (size_t)mi * MODW; normmod_load(nm, g, m + 0 * DM, m + 1 * DM, lane_); cur_mi = mi; }
        norm_mod_store(v, nm, XN + (size_t)row * DM, lane_);
    }
}
__device__ __forceinline__ void postmix_phase(const Args& a, Frame& F, int layer, int row_lo, int NS) {
    unsigned char* const wsl = opaque_ptr(a.ws);
    const int tid_ = opaque_tid(), lane_ = tid_ & 63, wave_ = __builtin_amdgcn_readfirstlane(tid_ >> 6);
    const float* MOD = (const float*)(wsl + WS_MOD) + (size_t)layer * 17 * MODW; const float* g1 = inp(F, 6) + (size_t)(layer * 4 + 1) * DM; const float* g2 = inp(F, 6) + (size_t)(layer * 4 + 2) * DM;
    bf16_t* XN = (bf16_t*)(wsl + WS_XN); const bf16_t* OO = (const bf16_t*)(wsl + WS_OO); const float* SSQO = (const float*)(wsl + WS_SSQO);
    const int rpw = (NROWS - row_lo) / (F.G * NWAVES); int row = row_lo + (F.vcu * NWAVES + wave_) * rpw; const int rend = row + rpw;
    f32x4 nx[4]; u32x2 no[4]; float nss = 0.f; NormMod nm; f32x4 P1[4]; int cur_mi = -1;
#define PM_LOAD(R) do { const float* x_ = xrow_in(a, F, layer, (R)); \
        _Pragma("unroll") for (int j = 0; j < 4; ++j) { const int c = 4 * lane_ + 256 * j; nx[j] = *(const f32x4*)(x_ + c); no[j] = *(const u32x2*)(OO + (size_t)(R) * DM + c); } \
        nss = lane_ < NS ? SSQO[(size_t)(R) * 32 + lane_] : 0.f; } while (0)
    if (row < rend) PM_LOAD(row);
    for (; row < rend; ++row) {
        f32x4 xv[4]; u32x2 ov[4]; float ss = nss;
#pragma unroll
        for (int j = 0; j < 4; ++j) { xv[j] = nx[j]; ov[j] = no[j]; }
        if (row + 1 < rend) PM_LOAD(row + 1);
        const int mi = mod_index(row);
        if (mi != cur_mi) { const float* m = MOD + (size_t)mi * MODW; normmod_load(nm, g2, m + 3 * DM, m + 4 * DM, lane_);
#pragma unroll
            for (int j = 0; j < 4; ++j) { const int c = 4 * lane_ + 256 * j; P1[j] = *(const f32x4*)(g1 + c) * *(const f32x4*)(m + 2 * DM + c); }
            cur_mi = mi; }
        float* xo = xrow_st(a, row);
        ss = wave_sum(ss);
        const float rstd = __builtin_amdgcn_rsqf(ss * (1.f / DM) + NORM_EPS);
        f32x4 v[4];
#pragma unroll
        for (int j = 0; j < 4; ++j) { const int c = 4 * lane_ + 256 * j;
            const f32x4 o = {bf_lo(ov[j].x), bf_hi(ov[j].x), bf_lo(ov[j].y), bf_hi(ov[j].y)};
            v[j] = xv[j] + P1[j] * (o * rstd); *(f32x4*)(xo + c) = v[j]; }
        norm_mod_store(v, nm, XN + (size_t)row * DM, lane_);
    }
#undef PM_LOAD
}
constexpr size_t WS_Y     = WS_ST;
constexpr size_t WS_H0    = WS_ST + 180 * MiB;
constexpr size_t WS_H1    = WS_ST + 260 * MiB;
constexpr size_t WS_HSH   = WS_ST + 340 * MiB;
constexpr size_t WS_LOG   = WS_ST + 358 * MiB;
constexpr size_t WS_SELI  = WS_ST + 367 * MiB;
constexpr size_t WS_SELW  = WS_SELI + (size_t)NROWS * 32;
constexpr size_t WS_LDST  = WS_ST + 370 * MiB;
constexpr size_t WS_LW    = WS_LDST + 1536 * 1024;
constexpr size_t WS_BLKCNT= WS_ST + 373 * MiB;
constexpr size_t WS_TINFO = WS_BLKCNT + 256 * 192 * 4;
constexpr int NLIST = 128, YROWS = 5;
static_assert(WS_TINFO + 4 * (512 + 1600) <= WS_ST + 374 * MiB, "MoE stage map");

template <int NT_, int LDA_, bool PERM_> struct DenseRow0 : DenseBase<NT_, LDA_, PERM_> { int row0; };

struct PolShr : DenseRow0<16, 2048, true> {
    bf16_t* HSH; float* LOG;
    __device__ __forceinline__ void epi(const f32x4 (&acc)[2][2][4][2], const DUnit& u, int wr, int wc, int fr, int fq) const {
#pragma unroll
        for (int ai = 0; ai < 2; ++ai)
#pragma unroll
            for (int m = 0; m < 4; ++m) {
                const int row = row0 + u.pm * 256 + ai * 128 + wr * 64 + m * 16 + fr;
                if (u.pn < 2) {
                    f32x4 h0, h1;
#pragma unroll
                    for (int j = 0; j < 4; ++j) { h0[j] = silu_f(acc[ai][0][m][0][j]) * acc[ai][1][m][0][j]; h1[j] = silu_f(acc[ai][0][m][1][j]) * acc[ai][1][m][1][j]; }
                    store8(HSH + (size_t)row * 256 + u.pn * 128 + wc * 32 + 8 * fq, h0, h1);
                } else if (wc < 2) {
                    float* lp = LOG + (size_t)row * 64 + wc * 32 + 8 * fq; *(f32x4*)lp = acc[ai][0][m][0]; *(f32x4*)(lp + 4) = acc[ai][0][m][1];
                }
            }
    }
};

__device__ __forceinline__ int slot_round(int s) { return s >> 2; }
__device__ __forceinline__ int slot_yrow(int s) { return (s & 3) + 1; }
__device__ __forceinline__ void route_phase(const Args& a, Frame& F, int layer, int row_lo, int tpb) {
    unsigned char* const wsl = opaque_ptr(a.ws);
    const int tid_ = opaque_tid(), lane = tid_ & 63, wave = __builtin_amdgcn_readfirstlane(tid_ >> 6);
    LAS int* cnt = (LAS int*)F.lds;
    for (int i = tid_; i < NLIST; i += 512) cnt[i] = 0;
    __syncthreads();
    const float* LOG = (const float*)(wsl + WS_LOG); int* SELI = (int*)(wsl + WS_SELI); float* SELW = (float*)(wsl + WS_SELW);
    const float bias = inp(F, 24)[layer * NEXP + lane];
    const int blk = F.vcu;
    float lg_next = LOG[(size_t)(row_lo + blk * tpb + wave) * 64 + lane];
    for (int t = wave; t < tpb; t += NWAVES) {
        const int row = row_lo + blk * tpb + t;
        const float lg = lg_next; if (t + NWAVES < tpb) lg_next = LOG[(size_t)(row + NWAVES) * 64 + lane];
        const float sc = sigmoid_f(lg), bs = sc + bias;
        float m1 = bs;
        m1 = fmaxf(m1, __shfl_xor(m1, 1)); m1 = fmaxf(m1, __shfl_xor(m1, 2)); m1 = fmaxf(m1, __shfl_xor(m1, 4));
        const unsigned long long eqm = __ballot(bs == m1);
        const int grp = lane >> 3; const unsigned gm = (unsigned)((eqm >> (grp * 8)) & 0xffull);
        float v2 = (bs == m1) ? -INFINITY : bs;
        v2 = fmaxf(v2, __shfl_xor(v2, 1)); v2 = fmaxf(v2, __shfl_xor(v2, 2)); v2 = fmaxf(v2, __shfl_xor(v2, 4));
        const float m2 = (__popc(gm) >= 2) ? m1 : v2;
        const float gs = m1 + m2;
        int grank = 0;
#pragma unroll
        for (int j = 0; j < 8; ++j) { const float o = __shfl(gs, j * 8); grank += (o > gs || (o == gs && j < grp)) ? 1 : 0; }
        const float mv = grank < 4 ? bs : -INFINITY;
        int rank = 0;
#pragma unroll 8
        for (int j = 0; j < 64; ++j) { const float o = __shfl(mv, j); rank += (o > mv || (o == mv && j < lane)) ? 1 : 0; }
        const bool sel = rank < TOPK && grank < 4;
        const float ssum = wave_sum(sel ? sc : 0.f);
        if (sel) { const int s = rank, l = slot_round(s) * 64 + lane;
            SELI[(size_t)row * 8 + s] = l | (slot_yrow(s) << 8); SELW[(size_t)row * 8 + s] = sc / ssum * 2.5f;
            atomicAdd((int*)&cnt[l], 1); }
    }
    __syncthreads();
    int* BLKCNT = (int*)(wsl + WS_BLKCNT);
    for (int i = tid_; i < NLIST; i += 512) BLKCNT[blk * NLIST + i] = cnt[i];
}
__device__ __forceinline__ void place_phase(const Args& a, Frame& F, int row_lo, int tpb) {
    unsigned char* const wsl = opaque_ptr(a.ws);
    const int tid_ = opaque_tid();
    LAS int* tot = (LAS int*)F.lds; LAS int* mine = tot + 256; LAS int* tst = mine + 256; LAS int* cur = tst + 256;
    const int* BLKCNT = (const int*)(wsl + WS_BLKCNT); const int blk = F.vcu;
    if (tid_ < 256) { tot[tid_] = 0; mine[tid_] = 0; cur[tid_] = 0; }
    __syncthreads();
    if (tid_ < 2 * NLIST) { const int l = tid_ % NLIST, b0 = (tid_ / NLIST) * 128; int s = 0, m = 0;
#pragma unroll 16
        for (int b = b0; b < b0 + 128; ++b) { const int c = (b < F.G) ? BLKCNT[b * NLIST + l] : 0; m += (b < blk) ? c : 0; s += c; }
        atomicAdd((int*)&tot[l], s); atomicAdd((int*)&mine[l], m); }
    __syncthreads();
    if (tid_ == 0) { int acc = 0; for (int l = 0; l < NLIST; ++l) { tst[l] = acc; acc += (tot[l] + 255) >> 8; } tst[NLIST] = acc; }
    __syncthreads();
    int* TINFO = (int*)(wsl + WS_TINFO); int* LDST = (int*)(wsl + WS_LDST); float* LW = (float*)(wsl + WS_LW);
    if (blk == 0) {
        for (int i = tid_; i <= NLIST; i += 512) TINFO[i] = tst[i];
        for (int i = tid_; i < NLIST; i += 512) TINFO[256 + i] = tot[i];
        const int lane = tid_ & 63, wv = tid_ >> 6;
        for (int l = wv; l < NLIST; l += NWAVES) { const int t0 = tst[l], t1 = tst[l + 1];
            for (int t = t0 + lane; t < t1; t += 64) TINFO[512 + t] = l;
            const int c = tot[l], base = t0 * 256;
            for (int p = c + lane; p < (t1 - t0) * 256; p += 64) LDST[base + p] = -1; }
    }
    const int* SELI = (const int*)(wsl + WS_SELI); const float* SELW = (const float*)(wsl + WS_SELW);
    for (int i = tid_; i < tpb * 8; i += 512) { const int row = row_lo + blk * tpb + (i >> 3), s = i & 7;
        const int v = SELI[(size_t)row * 8 + s], l = v & 0xff, yr = v >> 8;
        const int pos = tst[l] * 256 + mine[l] + atomicAdd((int*)&cur[l], 1);
        LDST[pos] = row * YROWS + yr; LW[pos] = SELW[(size_t)row * 8 + s]; }
}

struct MUnit { int T, pn; };
struct PolMoe1 {
    static constexpr bool PERM = true, GATHER = true, TWOSEG = false;
    static constexpr int NT = 16, KT0 = 16, KS0 = 128, KS1 = 128, LDB = 2048;
    typedef MUnit Unit;
    const char* XN; const char* W1; bf16_t* H; const int* TINFO; const int* LDST; int T0, T1, G, c;
    __device__ __forceinline__ bool next(int i, Unit& u) const { const int L = i * G + c; u.T = T0 + (L >> 1); u.pn = L & 1; return u.T < T1; }
    __device__ __forceinline__ void ctx(const Unit& u, pg8::UCtx<true>& x, const int (&R)[2], const int (&C)[2]) const {
        const int e = __builtin_amdgcn_readfirstlane(TINFO[512 + u.T]) & 63;
        x.a0[0] = XN; x.a0[1] = XN; x.a1[0] = XN; x.a1[1] = XN; x.b = W1 + ((size_t)e * 512 + u.pn * 256) * LDB;
#pragma unroll
        for (int h = 0; h < 2; ++h)
#pragma unroll
            for (int i = 0; i < 2; ++i) { const int d = LDST[u.T * 256 + h * 128 + R[i]]; const int tok = d < 0 ? 0 : d / YROWS; x.vg[h][i] = (unsigned)tok * 2048u + (unsigned)C[i] * 2u; }
    }
    __device__ __forceinline__ unsigned lane_a0(int, int) const { return 0u; }
    __device__ __forceinline__ unsigned goff(unsigned raw, int C) const { const int d = (int)raw; const unsigned tok = d < 0 ? 0u : (unsigned)d / 3u; return tok * 2048u + (unsigned)C * 2u; }
    __device__ __forceinline__ void epi(const f32x4 (&acc)[2][2][4][2], const Unit& u, int wr, int wc, int fr, int fq) const {
#pragma unroll
        for (int ai = 0; ai < 2; ++ai)
#pragma unroll
            for (int m = 0; m < 4; ++m) {
                const int hrow = (u.T - T0) * 256 + ai * 128 + wr * 64 + m * 16 + fr;
                f32x4 h0, h1;
#pragma unroll
                for (int j = 0; j < 4; ++j) { h0[j] = silu_f(acc[ai][0][m][0][j]) * acc[ai][1][m][0][j]; h1[j] = silu_f(acc[ai][0][m][1][j]) * acc[ai][1][m][1][j]; }
                store8(H + (size_t)hrow * 256 + u.pn * 128 + wc * 32 + 8 * fq, h0, h1);
            }
    }
};
template <bool RMW> struct PolMoe2 {
    static constexpr bool PERM = true, GATHER = false, TWOSEG = false;
    static constexpr int NT = 4, KT0 = 4, KS0 = 128, KS1 = 128, LDB = 512;
    typedef MUnit Unit;
    const char* H; const char* W2; unsigned char* Y; const int* TINFO; const int* LDST; const float* LW; int T0, T1, G, c;
    __device__ __forceinline__ bool next(int i, Unit& u) const { const int L = i * G + c; u.T = T0 + (L >> 2); u.pn = L & 3; return u.T < T1; }
    __device__ __forceinline__ void ctx(const Unit& u, pg8::UCtx<false>& x, const int (&)[2], const int (&)[2]) const {
        const int e = __builtin_amdgcn_readfirstlane(TINFO[512 + u.T]) & 63;
        x.a0[0] = H + (size_t)(u.T - T0) * 256 * 512; x.a0[1] = x.a0[0] + 128 * 512; x.a1[0] = x.a0[0]; x.a1[1] = x.a0[1];
        x.b = W2 + ((size_t)e * 1024 + u.pn * 256) * LDB;
    }
    __device__ __forceinline__ unsigned lane_a0(int R, int C) const { return (unsigned)(R * 512 + C * 2); }
    __device__ __forceinline__ unsigned lane_a1(int, int) const { return 0u; }
    __device__ __forceinline__ void epi(const f32x4 (&acc)[2][2][4][2], const Unit& u, int wr, int wc, int fr, int fq) const {
        const int cofs = u.pn * 256 + wc * 32 + 8 * fq;
#pragma unroll
        for (int ai = 0; ai < 2; ++ai) {
            int d[4]; float w[4];
#pragma unroll
            for (int m = 0; m < 4; ++m) { const int lp = u.T * 256 + ai * 128 + wr * 64 + m * 16 + fr; d[m] = LDST[lp]; w[m] = LW[lp]; }
            u32x2 o[4][2];
            if (RMW) {
#pragma unroll
                for (int m = 0; m < 4; ++m) { const unsigned char* yp = Y + (size_t)(d[m] < 0 ? 0 : d[m]) * DM + cofs; o[m][0] = *(const u32x2*)yp; o[m][1] = *(const u32x2*)(yp + 128); }
            }
#pragma unroll
            for (int m = 0; m < 4; ++m) {
                if (d[m] >= 0) {
                    unsigned char* yp = Y + (size_t)d[m] * DM + cofs; const float ww = w[m];
#pragma unroll
                    for (int bj = 0; bj < 2; ++bj) {
                        f32x4 v0 = acc[ai][bj][m][0] * ww, v1 = acc[ai][bj][m][1] * ww;
                        if (RMW) { v0 += fp8_unpack4(o[m][bj].x); v1 += fp8_unpack4(o[m][bj].y); }
                        u32x2 q; q.x = fp8_pack4(v0); q.y = fp8_pack4(v1); *(u32x2*)(yp + bj * 128) = q;
                    }
                }
            }
            asm volatile("" ::: "memory");
        }
    }
};
struct PolShd : DenseRow0<4, 512, true> {
    unsigned char* Y;
    __device__ __forceinline__ void epi(const f32x4 (&acc)[2][2][4][2], const DUnit& u, int wr, int wc, int fr, int fq) const {
#pragma unroll
        for (int ai = 0; ai < 2; ++ai)
#pragma unroll
            for (int m = 0; m < 4; ++m) {
                const int row = row0 + u.pm * 256 + ai * 128 + wr * 64 + m * 16 + fr;
                unsigned char* yp = Y + (size_t)row * YROWS * DM + u.pn * 256 + wc * 32 + 8 * fq;
                u32x2 q0, q1; q0.x = fp8_pack4(acc[ai][0][m][0]); q0.y = fp8_pack4(acc[ai][0][m][1]); q1.x = fp8_pack4(acc[ai][1][m][0]); q1.y = fp8_pack4(acc[ai][1][m][1]);
                *(u32x2*)yp = q0; *(u32x2*)(yp + 128) = q1;
            }
    }
};

__device__ __forceinline__ void combine_phase(const Args& a, Frame& F, int layer, int row_lo) {
    unsigned char* const wsl = opaque_ptr(a.ws);
    const int tid_ = opaque_tid(), lane_ = tid_ & 63, wave_ = __builtin_amdgcn_readfirstlane(tid_ >> 6);
    const float* MOD = (const float*)(wsl + WS_MOD) + (size_t)layer * 17 * MODW; const float* g3 = inp(F, 6) + (size_t)(layer * 4 + 3) * DM;
    const float* MODn = (const float*)(wsl + WS_MOD) + (size_t)1 * 17 * MODW; const float* gn = inp(F, 6) + (size_t)(1 * 4 + 0) * DM;
    bf16_t* XN = (bf16_t*)(wsl + WS_XN); const unsigned char* Y = (const unsigned char*)(wsl + WS_Y);
    const int rpw = (NROWS - row_lo) / (F.G * NWAVES); int row = row_lo + (F.vcu * NWAVES + wave_) * rpw; const int rend = row + rpw;
    f32x4 nx[4]; unsigned ny[4][YROWS]; NormMod nm; f32x4 P3[4]; int cur_mi = -1;
#define CB_LOAD(R) do { const float* x_ = xrow_st(a, (R)); \
        _Pragma("unroll") for (int j = 0; j < 4; ++j) { const int c = 4 * lane_ + 256 * j; nx[j] = *(const f32x4*)(x_ + c); \
            _Pragma("unroll") for (int r = 0; r < YROWS; ++r) ny[j][r] = *(const unsigned*)(Y + ((size_t)(R) * YROWS + r) * DM + c); } } while (0)
    if (row < rend) CB_LOAD(row);
    for (; row < rend; ++row) {
        float* xo = xrow_st(a, row);
        f32x4 f[4], xv[4]; float ss = 0.f;
#pragma unroll
        for (int j = 0; j < 4; ++j) { xv[j] = nx[j]; f[j] = (f32x4){0.f, 0.f, 0.f, 0.f};
#pragma unroll
            for (int r = 0; r < YROWS; ++r) f[j] += fp8_unpack4(ny[j][r]);
            ss += sq4(f[j]); }
        if (row + 1 < rend) CB_LOAD(row + 1);
        const int mi = mod_index(row);
        if (mi != cur_mi) { const float* m = MOD + (size_t)mi * MODW;
#pragma unroll
            for (int j = 0; j < 4; ++j) { const int c = 4 * lane_ + 256 * j; P3[j] = *(const f32x4*)(g3 + c) * *(const f32x4*)(m + 5 * DM + c); }
            if (layer == 0) { const float* mn = MODn + (size_t)mi * MODW; normmod_load(nm, gn, mn + 0 * DM, mn + 1 * DM, lane_); }
            cur_mi = mi; }
        const float rstd = __builtin_amdgcn_rsqf(wave_sum(ss) * (1.f / DM) + NORM_EPS);
        f32x4 v[4];
#pragma unroll
        for (int j = 0; j < 4; ++j) { const int c = 4 * lane_ + 256 * j; v[j] = xv[j] + P3[j] * (f[j] * rstd); *(f32x4*)(xo + c) = v[j]; }
        if (layer == 0) norm_mod_store(v, nm, XN + (size_t)row * DM, lane_);
    }
#undef CB_LOAD
}
constexpr size_t WS_G    = WS_ST;
constexpr size_t WS_BTY  = WS_ST + 216 * MiB;
constexpr size_t WS_BTS  = WS_ST + 264 * MiB;
constexpr size_t WS_S    = WS_ST + 280 * MiB;
constexpr size_t WS_XIN  = WS_ST + 64 * MiB;
constexpr size_t WS_LAMT = WS_ROPE + 512 * 1024;
constexpr int S5_T = 32;

constexpr size_t WS_KD   = WS_ST + 352 * MiB;
__device__ __forceinline__ f32x2 cmul(f32x2 a, f32x2 b) { return (f32x2){a.x * b.x - a.y * b.y, a.x * b.y + a.y * b.x}; }
__device__ __forceinline__ void s5_tables_unit(const Args& a, Frame& F, int g, int d) {
    unsigned char* const wsl = opaque_ptr(a.ws);
    const int tid = opaque_tid();
    LAS f32x2* pw = (LAS f32x2*)F.lds; LAS f32x2* bb = pw + 33 * 64; LAS f32x2* cm = bb + 64 * 16;
    bf16_t* BTY = (bf16_t*)(wsl + WS_BTY) + (size_t)g * 512 * 768; bf16_t* BTS = (bf16_t*)(wsl + WS_BTS) + (size_t)g * 256 * 512; float* LAMT = (float*)(wsl + WS_LAMT);
    float* KD = (float*)(wsl + WS_KD) + (size_t)(g * 2 + d) * 8192;
    const float* lre = inp(F, 13); const float* lim = inp(F, 14); const float* lst = inp(F, 15);
    const float* bre = inp(F, 16); const float* bim = inp(F, 17); const float* cre = inp(F, 18); const float* cim = inp(F, 19);
    __syncthreads();
    const float step = __expf(lst[d * 64 + g]);
    for (int i = tid; i < 33 * 64; i += 512) { const int k = i >> 6, p = i & 63; const float lr = lre[(d * 64 + g) * 64 + p], li = lim[(d * 64 + g) * 64 + p];
        const float mag = __expf((float)k * lr * step); float c, s; sincos_red((float)k * (li * step), c, s); pw[i] = (f32x2){mag * c, mag * s}; }
    __syncthreads();
    for (int i = tid; i < 64 * 16; i += 512) { const int p = i >> 4; const float lr = lre[(d * 64 + g) * 64 + p], li = lim[(d * 64 + g) * 64 + p];
        const f32x2 lb = pw[64 + p]; const float inv = 1.f / (lr * lr + li * li);
        const f32x2 kap = {((lb.x - 1.f) * lr + lb.y * li) * inv, (lb.y * lr - (lb.x - 1.f) * li) * inv};
        const size_t o = ((size_t)(d * 64 + g) * 64 + p) * 16 + (i & 15); bb[i] = cmul(kap, (f32x2){bre[o], bim[o]}); }
    for (int i = tid; i < 16 * 64; i += 512) { const size_t o = (size_t)(d * 64 + g) * 1024 + i; cm[i] = (f32x2){cre[o], cim[o]}; }
    __syncthreads();
    if (tid < 64) { const f32x2 l32 = pw[32 * 64 + tid]; LAMT[((d * 64 + g) * 64 + tid) * 2] = l32.x; LAMT[((d * 64 + g) * 64 + tid) * 2 + 1] = l32.y; }
    { const int k = tid >> 4, ib = (tid >> 2) & 3, jb = tid & 3; float acc[4][4];
#pragma unroll
      for (int x = 0; x < 4; ++x)
#pragma unroll
        for (int y = 0; y < 4; ++y) acc[x][y] = 0.f;
      for (int p = 0; p < 64; ++p) { const f32x2 w = pw[k * 64 + p]; f32x2 t[4], b[4];
#pragma unroll
        for (int x = 0; x < 4; ++x) { t[x] = cmul(cm[(4 * ib + x) * 64 + p], w); b[x] = bb[p * 16 + 4 * jb + x]; }
#pragma unroll
        for (int x = 0; x < 4; ++x)
#pragma unroll
            for (int y = 0; y < 4; ++y) acc[x][y] += t[x].x * b[y].x - t[x].y * b[y].y; }
#pragma unroll
      for (int x = 0; x < 4; ++x) *(f32x4*)(KD + k * 256 + (4 * ib + x) * 16 + 4 * jb) = (f32x4){acc[x][0], acc[x][1], acc[x][2], acc[x][3]}; }
    for (int o = tid; o < 512 * 64; o += 512) { const int n = o >> 6, p = o & 63, to = n >> 4, i = n & 15;
        const f32x2 w = cmul(cm[i * 64 + p], pw[(d == 0 ? to + 1 : 32 - to) * 64 + p]);
        *(unsigned*)(BTY + (size_t)n * 768 + 512 + 128 * d + 2 * p) = cvt_pk_bf16(w.x, -w.y); }
    for (int o = tid; o < 64 * 256; o += 512) { const int p = o >> 8, kk = (o & 255) * 2, ti = kk >> 4, j = kk & 15;
        const f32x2 pwv = pw[(d == 0 ? 31 - ti : ti) * 64 + p]; const f32x2 v0 = cmul(pwv, bb[p * 16 + j]), v1 = cmul(pwv, bb[p * 16 + j + 1]);
        *(unsigned*)(BTS + (size_t)(128 * d + 2 * p) * 512 + kk) = cvt_pk_bf16(v0.x, v1.x); *(unsigned*)(BTS + (size_t)(128 * d + 2 * p + 1) * 512 + kk) = cvt_pk_bf16(v0.y, v1.y); }
    __syncthreads();
}
__device__ __forceinline__ void s5_tables_phase(const Args& a, Frame& F) { for (int u = F.vcu; u < 128; u += F.G) s5_tables_unit(a, F, u >> 1, u & 1); }
__device__ __forceinline__ void s5_toeplitz_phase(const Args& a, Frame& F) {
    unsigned char* const wsl = opaque_ptr(a.ws);
    const int tid = opaque_tid(); LAS float* Kd = (LAS float*)F.lds; const float* dsk = inp(F, 20);
    for (int u = F.vcu; u < 256; u += F.G) { const int g = u >> 2, q = u & 3;
        const float* KD = (const float*)(wsl + WS_KD) + (size_t)g * 16384; bf16_t* BTY = (bf16_t*)(wsl + WS_BTY) + (size_t)g * 512 * 768;
        __syncthreads();
        for (int i = tid; i < 4096; i += 512) *(f32x4*)(Kd + 4 * i) = *(const f32x4*)(KD + 4 * i);
        __syncthreads();
        for (int o = tid; o < 128 * 256; o += 512) { const int n = 128 * q + (o >> 8), kk = (o & 255) * 2, to = n >> 4, i = n & 15, ti = kk >> 4, j = kk & 15;
            float v0, v1;
            if (to > ti) { v0 = Kd[(to - ti) * 256 + i * 16 + j]; v1 = Kd[(to - ti) * 256 + i * 16 + j + 1]; }
            else if (to < ti) { v0 = Kd[8192 + (ti - to) * 256 + i * 16 + j]; v1 = Kd[8192 + (ti - to) * 256 + i * 16 + j + 1]; }
            else { v0 = Kd[i * 16 + j] + Kd[8192 + i * 16 + j] + (i == j ? dsk[g * 16 + i] : 0.f); v1 = Kd[i * 16 + j + 1] + Kd[8192 + i * 16 + j + 1] + (i == j + 1 ? dsk[g * 16 + i] : 0.f); }
            *(unsigned*)(BTY + (size_t)n * 768 + kk) = cvt_pk_bf16(v0, v1); }
    }
    __syncthreads();
}

struct SUnit { int g, pm, pn; };
struct PolS5S {
    static constexpr bool PERM = false, GATHER = false, TWOSEG = false;
    static constexpr int NT = 8, KT0 = 8, KS0 = 8192, KS1 = 128, LDB = 1024;
    typedef SUnit Unit;
    const char* XN; const char* BTS; float* S; int G, c;
    __device__ __forceinline__ bool next(int i, Unit& u) const { const int L = i * G + c; u.g = __builtin_amdgcn_readfirstlane(L / 5); u.pm = __builtin_amdgcn_readfirstlane(L % 5); u.pn = 0; return L < 320; }
    __device__ __forceinline__ void ctx(const Unit& u, pg8::UCtx<false>& x, const int (&)[2], const int (&)[2]) const {
        if (u.pm < 4) { x.a0[0] = XN + ((size_t)NCTXR + (size_t)u.pm * 256 * S5_T) * 2048 + u.g * 32; x.a0[1] = x.a0[0] + (size_t)128 * S5_T * 2048; }
        else { x.a0[0] = XN + u.g * 32; x.a0[1] = x.a0[0]; }
        x.a1[0] = x.a0[0]; x.a1[1] = x.a0[1]; x.b = BTS + (size_t)u.g * 256 * LDB;
    }
    __device__ __forceinline__ unsigned lane_a0(int R, int C) const { return (unsigned)(R * (S5_T * 2048) + (C >> 4) * 2048 + (C & 15) * 2); }
    __device__ __forceinline__ unsigned lane_a1(int, int) const { return 0u; }
    __device__ __forceinline__ void epi(const f32x4 (&acc)[2][2][4][2], const Unit& u, int wr, int wc, int fr, int fq) const {
#pragma unroll
        for (int ai = 0; ai < 2; ++ai) { if (u.pm == 4 && ai == 1) continue;
#pragma unroll
            for (int m = 0; m < 4; ++m) { const int r = u.pm * 256 + ai * 128 + wr * 64 + m * 16 + fr;
                float* sp = S + ((size_t)u.g * 1152 + r) * 256 + wc * 32 + 4 * fq;
#pragma unroll
                for (int bj = 0; bj < 2; ++bj)
#pragma unroll
                    for (int n = 0; n < 2; ++n) *(f32x4*)(sp + bj * 128 + n * 16) = acc[ai][bj][m][n]; } }
    }
};
__device__ __forceinline__ void s5_scan_phase(const Args& a, Frame& F) {
    unsigned char* const wsl = opaque_ptr(a.ws);
    const int tid = opaque_tid(); const float* S = (const float*)(wsl + WS_S); bf16_t* XIN = (bf16_t*)(wsl + WS_XIN); const float* LAMT = (const float*)(wsl + WS_LAMT);
    for (int idx = F.vcu * 512 + tid; idx < 64 * 16 * 2 * 64; idx += F.G * 512) {
        const int p = idx & 63, d = (idx >> 6) & 1, b = (idx >> 7) & 15, g = idx >> 11;
        const f32x2 Lm = *(const f32x2*)(LAMT + ((d * 64 + g) * 64 + p) * 2);
        const float* Sg = S + (size_t)g * 1152 * 256 + d * 128 + 2 * p; const int col = d * 128 + 2 * p; bf16_t* Xg = XIN + (size_t)(col >> 4) * 1024 + 16 * g + (col & 15);
        f32x2 x = {0.f, 0.f};
        f32x2 sv[8];
#pragma unroll
        for (int k = 0; k < 8; ++k) { const int c = d == 0 ? k : 7 - k; sv[k] = *(const f32x2*)(Sg + (size_t)(1024 + b * 8 + c) * 256); }
#pragma unroll
        for (int k = 0; k < 8; ++k) x = cmul(Lm, x) + sv[k];
        for (int c0 = 0; c0 < 64; c0 += 8) {
#pragma unroll
            for (int k = 0; k < 8; ++k) { const int c = d == 0 ? c0 + k : 63 - c0 - k; sv[k] = *(const f32x2*)(Sg + (size_t)(b * 64 + c) * 256); }
#pragma unroll
            for (int k = 0; k < 8; ++k) { const int c = d == 0 ? c0 + k : 63 - c0 - k; *(unsigned*)(Xg + (size_t)(b * 64 + c) * 32 * 1024) = cvt_pk_bf16(x.x, x.y); x = cmul(Lm, x) + sv[k]; }
        }
    }
}
struct PolS5Y {
    static constexpr bool PERM = true, GATHER = false, TWOSEG = true;
    static constexpr int NT = 12, KT0 = 8, KS0 = 8192, KS1 = 8192, LDB = 1536;
    typedef SUnit Unit;
    const char* XN; const char* XIN; const char* BTY; bf16_t* Gb; int G, c;
    __device__ __forceinline__ bool next(int i, Unit& u) const { const int L = i * G + c; u.g = __builtin_amdgcn_readfirstlane(L >> 3); u.pm = __builtin_amdgcn_readfirstlane((L >> 1) & 3); u.pn = L & 1; return L < 512; }
    __device__ __forceinline__ void ctx(const Unit& u, pg8::UCtx<false>& x, const int (&)[2], const int (&)[2]) const {
        x.a0[0] = XN + ((size_t)NCTXR + (size_t)u.pm * 256 * S5_T) * 2048 + u.g * 32; x.a0[1] = x.a0[0] + (size_t)128 * S5_T * 2048;
        x.a1[0] = XIN + (size_t)u.pm * 256 * S5_T * 2048 + u.g * 32; x.a1[1] = x.a1[0] + (size_t)128 * S5_T * 2048;
        x.b = BTY + ((size_t)u.g * 512 + u.pn * 256) * LDB;
    }
    __device__ __forceinline__ unsigned lane_a0(int R, int C) const { return (unsigned)(R * (S5_T * 2048) + (C >> 4) * 2048 + (C & 15) * 2); }
    __device__ __forceinline__ void epi(const f32x4 (&acc)[2][2][4][2], const Unit& u, int wr, int wc, int fr, int fq) const {
#pragma unroll
        for (int ai = 0; ai < 2; ++ai)
#pragma unroll
            for (int m = 0; m < 4; ++m) { const int r = u.pm * 256 + ai * 128 + wr * 64 + m * 16 + fr;
#pragma unroll
                for (int bj = 0; bj < 2; ++bj) { const int col = u.pn * 256 + bj * 128 + wc * 32 + 8 * fq, to = col >> 4, i0 = col & 15;
                    bf16_t* gp = Gb + ((size_t)r * S5_T + to) * DM + u.g * 16 + i0;
#pragma unroll
                    for (int n = 0; n < 2; ++n) { f32x4 v;
#pragma unroll
                        for (int j = 0; j < 4; ++j) v[j] = gelu_tanh(acc[ai][bj][m][n][j]);
                        u32x2 w; w.x = cvt_pk_bf16(v[0], v[1]); w.y = cvt_pk_bf16(v[2], v[3]); *(u32x2*)(gp + 4 * n) = w; asm volatile("" ::: "memory"); } } }
    }
};
struct PolGlu : DenseRow0<16, 2048, true> {
    bf16_t* OO; float* SSQO; const float* bias;
    __device__ __forceinline__ void epi(const f32x4 (&acc)[2][2][4][2], const DUnit& u, int wr, int wc, int fr, int fq) const {
        const int c0 = u.pn * 128 + wc * 32 + 8 * fq;
        const f32x4 b10 = *(const f32x4*)(bias + c0), b11 = *(const f32x4*)(bias + c0 + 4), b20 = *(const f32x4*)(bias + 1024 + c0), b21 = *(const f32x4*)(bias + 1024 + c0 + 4);
#pragma unroll
        for (int ai = 0; ai < 2; ++ai)
#pragma unroll
            for (int m = 0; m < 4; ++m) {
                const int row = row0 + u.pm * 256 + ai * 128 + wr * 64 + m * 16 + fr;
                f32x4 o0, o1;
#pragma unroll
                for (int j = 0; j < 4; ++j) { o0[j] = (acc[ai][0][m][0][j] + b10[j]) * sigmoid_f(acc[ai][1][m][0][j] + b20[j]); o1[j] = (acc[ai][0][m][1][j] + b11[j]) * sigmoid_f(acc[ai][1][m][1][j] + b21[j]); }
                float s = sq4(o0) + sq4(o1);
                store8(OO + (size_t)row * DM + c0, o0, o1);
                s += __shfl_xor(s, 16); s += __shfl_xor(s, 32);
                if (fq == 0) SSQO[(size_t)row * 32 + u.pn * 4 + wc] = s;
            }
    }
};
#ifndef REP_ATTN
#define REP_ATTN 1
#endif
#ifndef REP_MISC
#define REP_MISC 1
#endif
#ifndef REP_DENSE
#define REP_DENSE 1
#endif
#ifndef REP_G2A
#define REP_G2A 1
#endif
#ifndef REP_P11X
#define REP_P11X 1
#endif
#ifndef REP_PM0
#define REP_PM0 1
#endif
#ifndef REP_H
#define REP_H 1
#endif
#ifndef REP_G1
#define REP_G1 1
#endif
__device__ __forceinline__ void moe_stage(const Args& args, Frame& F, const XcdBarrier& bar, int layer, int row_lo) {
    const int nrows = NROWS - row_lo, tpb = nrows / F.G;
    {   unsigned char* ws = opaque_ptr(args.ws);
        PolShr p; p.A = (const char*)(ws + WS_XN) + (size_t)row_lo * 2048; p.Bt = (const char*)(ws + WS_WSHR) + (size_t)layer * 768 * 2048; p.nM = nrows / 256; p.nN = 3; p.G = F.G; p.c = (int)blockIdx.x;
        p.row0 = row_lo; p.HSH = (bf16_t*)(ws + WS_HSH); p.LOG = (float*)(ws + WS_LOG);
        for (int rep_ = 0; rep_ < REP_DENSE; ++rep_) pg8::gemm_phase(F.lds, p);
    }
    if (layer == 1 && args.stage == 7) return;
    xcd_barrier(bar);
    route_phase(args, F, layer, row_lo, tpb);
#if REP_MISC == 2
    __syncthreads(); route_phase(args, F, layer, row_lo, tpb);
#endif
    if (layer == 1 && args.stage == 8) return;
    xcd_barrier(bar);
    place_phase(args, F, row_lo, tpb);
#if REP_MISC == 2
    __syncthreads(); place_phase(args, F, row_lo, tpb);
#endif
    if (layer == 1 && args.stage == 9) return;
    xcd_barrier(bar);
    const int* TINFO = (const int*)(opaque_ptr(args.ws) + WS_TINFO);
    const int ts0 = __builtin_amdgcn_readfirstlane(TINFO[0]), ts1 = __builtin_amdgcn_readfirstlane(TINFO[64]), ts2 = __builtin_amdgcn_readfirstlane(TINFO[128]);
#define MOE_G1(TA, TB, HBUF) for (int rep_ = 0; rep_ < REP_G1; ++rep_) do { unsigned char* ws = opaque_ptr(args.ws); PolMoe1 p; p.XN = (const char*)(ws + WS_XN); p.W1 = (const char*)(ws + WS_W1); p.H = (bf16_t*)(ws + (HBUF)); p.TINFO = (const int*)(ws + WS_TINFO); p.LDST = (const int*)(ws + WS_LDST); p.T0 = (TA); p.T1 = (TB); p.G = F.G; p.c = F.vcu; \
        pg8::gemm_phase(F.lds, p); } while (0)
#define MOE_G2(RMW, TA, TB, HBUF) do { unsigned char* ws = opaque_ptr(args.ws); PolMoe2<RMW> p; p.H = (const char*)(ws + (HBUF)); p.W2 = (const char*)(ws + WS_W2); p.Y = (unsigned char*)(ws + WS_Y); p.TINFO = (const int*)(ws + WS_TINFO); p.LDST = (const int*)(ws + WS_LDST); p.LW = (const float*)(ws + WS_LW); p.T0 = (TA); p.T1 = (TB); p.G = F.G; p.c = F.vcu; \
        pg8::gemm_phase(F.lds, p); } while (0)
    MOE_G1(ts0, ts1, WS_H0);
    if (layer == 1 && args.stage == 10) return;
    xcd_barrier(bar);
#define MOE_SHD() do { unsigned char* ws = opaque_ptr(args.ws); PolShd p; p.A = (const char*)(ws + WS_HSH) + (size_t)row_lo * 512; p.Bt = (const char*)(ws + WS_WSHD) + (size_t)layer * 1024 * 512; p.nM = nrows / 256; p.nN = 4; p.G = F.G; p.c = (int)blockIdx.x; \
        p.row0 = row_lo; p.Y = (unsigned char*)(ws + WS_Y); pg8::gemm_phase(F.lds, p); } while (0)
#if REP_G2A == 2
    MOE_G2(false, ts0, ts1, WS_H0); MOE_SHD();
#endif
    if (blockIdx.x & 1) { MOE_G1(ts1, ts2, WS_H1); MOE_G2(false, ts0, ts1, WS_H0); MOE_SHD(); }
    else { MOE_G2(false, ts0, ts1, WS_H0); MOE_SHD(); MOE_G1(ts1, ts2, WS_H1); }
    xcd_barrier(bar);
    MOE_G2(true, ts1, ts2, WS_H1);
    if (layer == 1 && args.stage == 13) return;
    xcd_barrier(bar);
    if (layer == 0) { s5_tables_phase(args, F); convert_experts(args, F, 1, 0); }
#if REP_P11X == 2
    __syncthreads();
    if (layer == 0) { s5_tables_phase(args, F); convert_experts(args, F, 1, 0); }
#endif
    combine_phase(args, F, layer, row_lo);
#undef MOE_SHD
#undef MOE_G1
#undef MOE_G2
}

__global__ void __launch_bounds__(NWAVES * 64, 2) trunk_fwd(Args args) {
    extern __shared__ __attribute__((aligned(16))) unsigned char lds_raw[];
    Frame F;
    F.lds = (LAS unsigned char*)lds_raw;
    F.G = gridDim.x; { const int bx = blockIdx.x; F.vcu = (F.G % 8 == 0) ? (bx % 8) * (F.G / 8) + bx / 8 : bx; }
    F.ws = args.ws;
    volatile LAS unsigned* MISC = (volatile LAS unsigned*)(F.lds + LDSCTL_OFF);
    for (int u = threadIdx.x; u < (LDS_BYTES - LDSCTL_OFF) / 4; u += NWAVES * 64) ((LAS unsigned*)(F.lds + LDSCTL_OFF))[u] = 0u;
    __syncthreads();
    if (threadIdx.x < 31) ((LAS unsigned long long*)(F.lds + PTAB_OFF))[threadIdx.x] = (unsigned long long)args.in[threadIdx.x];
    __syncthreads();
    XcdBarrier bar = xcd_barrier_post((unsigned*)(args.ws + WS_CTL) + CW_BAR, MISC + 8);
#define GRID_BAR() xcd_barrier(bar)

    mod_phase(args, F);
    __syncthreads();
    convert_small(args, F);
    rope_phase(args, F);
    convert_experts(args, F, 0, 0);
#if REP_MISC == 2
    __syncthreads();
    mod_phase(args, F);
    __syncthreads();
    convert_small(args, F);
    rope_phase(args, F);
    convert_experts(args, F, 0, 0);
#endif
    GRID_BAR();
    h_phase(args, F, 0, 0);
#if REP_H == 2
    h_phase(args, F, 0, 0);
#endif
    GRID_BAR();
    {   unsigned char* ws = opaque_ptr(args.ws);
        PolDqkv p; p.A = (const char*)(ws + WS_XN); p.Bt = (const char*)(ws + WS_WDQKV); p.nM = NROWS / 256; p.nN = 3; p.G = F.G; p.c = (int)blockIdx.x;
        p.A1 = (bf16_t*)(ws + WS_A1); p.SSQ1 = (float*)(ws + WS_SSQ1); p.KPE = (bf16_t*)(ws + WS_KPE); p.ROPE = (const float*)(ws + WS_ROPE);
        for (int rep_ = 0; rep_ < REP_DENSE; ++rep_) pg8::gemm_phase(F.lds, p);
    }
    GRID_BAR();
    {   unsigned char* ws = opaque_ptr(args.ws);
        PolQup p; p.A = (const char*)(ws + WS_A1); p.Bt = (const char*)(ws + WS_WUQ); p.nM = NROWS / 256; p.nN = NQ / 256; p.G = F.G; p.c = (int)blockIdx.x;
        p.Q = (bf16_t*)(ws + WS_Q); p.SSQ1 = (const float*)(ws + WS_SSQ1);
        for (int rep_ = 0; rep_ < REP_DENSE; ++rep_) pg8::gemm_phase(F.lds, p);
    }
    {   unsigned char* ws = opaque_ptr(args.ws);
        PolKVup p; p.A = (const char*)(ws + WS_A1) + QLORA * 2; p.Bt = (const char*)(ws + WS_WUKV); p.nM = NROWS / 256; p.nN = NKV / 256; p.G = F.G; p.c = (int)blockIdx.x;
        p.KV = (bf16_t*)(ws + WS_KV); p.SSQ1 = (const float*)(ws + WS_SSQ1);
        for (int rep_ = 0; rep_ < REP_DENSE; ++rep_) pg8::gemm_phase(F.lds, p);
    }
    GRID_BAR();
    {   unsigned char* ws = opaque_ptr(args.ws);
        const bf16_t* Qg = (const bf16_t*)(ws + WS_Q); const bf16_t* KVb = (const bf16_t*)(ws + WS_KV); const bf16_t* KPE = (const bf16_t*)(ws + WS_KPE); bf16_t* Og = (bf16_t*)(ws + WS_O); const float* RP = (const float*)(ws + WS_ROPE);
        for (int rep_ = 0; rep_ < REP_ATTN; ++rep_)
        for (int u = F.vcu; u < 1024 + 128; u += F.G) {
            if (u < 1024) { const int bh = u >> 3, qb = u & 7, b = bh >> 3, h = bh & 7;
                attn::attn_unit(Qg, KVb, KPE, Og, RP, NCTXR + b * SEQL + qb * 256, qb * 256, h, b * NCTX, NCTXR + b * SEQL, 36, (char*)lds_raw); }
            else { const int bh = u - 1024, b = bh >> 3, h = bh & 7;
                attn::attn_unit(Qg, KVb, KPE, Og, RP, b * NCTX, -1, h, b * NCTX, 0, 4, (char*)lds_raw); }
        }
    }
    GRID_BAR();
    {   unsigned char* ws = opaque_ptr(args.ws);
        PolWo p; p.A = (const char*)(ws + WS_O); p.Bt = (const char*)(ws + WS_WO); p.nM = NROWS / 256; p.nN = 4; p.G = F.G; p.c = (int)blockIdx.x;
        p.OO = (bf16_t*)(ws + WS_OO); p.SSQO = (float*)(ws + WS_SSQO);
        for (int rep_ = 0; rep_ < REP_DENSE; ++rep_) pg8::gemm_phase(F.lds, p);
    }
    GRID_BAR();
    postmix_phase(args, F, 0, 0, 16);
#if REP_PM0 == 2
    postmix_phase(args, F, 0, 0, 16);
#endif
    GRID_BAR();
    moe_stage(args, F, bar, 0, 0);
    if (args.stage == 1) return;
    GRID_BAR();
    {   unsigned char* ws = opaque_ptr(args.ws);
        PolS5S p; p.XN = (const char*)(ws + WS_XN); p.BTS = (const char*)(ws + WS_BTS); p.S = (float*)(ws + WS_S); p.G = F.G; p.c = F.vcu;
        for (int rep_ = 0; rep_ < REP_DENSE; ++rep_) pg8::gemm_phase(F.lds, p);
    }
    if (args.stage == 2) return;
    GRID_BAR();
    s5_toeplitz_phase(args, F);
    s5_scan_phase(args, F);
#if REP_MISC == 2
    s5_scan_phase(args, F);
#endif
    if (args.stage == 3) return;
    GRID_BAR();
    {   unsigned char* ws = opaque_ptr(args.ws);
        PolS5Y p; p.XN = (const char*)(ws + WS_XN); p.XIN = (const char*)(ws + WS_XIN); p.BTY = (const char*)(ws + WS_BTY); p.Gb = (bf16_t*)(ws + WS_G); p.G = F.G; p.c = F.vcu;
        for (int rep_ = 0; rep_ < REP_DENSE; ++rep_) pg8::gemm_phase(F.lds, p);
    }
    if (args.stage == 4) return;
    GRID_BAR();
    {   unsigned char* ws = opaque_ptr(args.ws);
        PolGlu p; p.A = (const char*)(ws + WS_G); p.Bt = (const char*)(ws + WS_WGLU); p.nM = NLATR / 256; p.nN = 8; p.G = F.G; p.c = (int)blockIdx.x;
        p.row0 = NCTXR; p.OO = (bf16_t*)(ws + WS_OO); p.SSQO = (float*)(ws + WS_SSQO); p.bias = inp(F, 22);
        for (int rep_ = 0; rep_ < REP_DENSE; ++rep_) pg8::gemm_phase(F.lds, p);
    }
    if (args.stage == 5) return;
    GRID_BAR();
    postmix_phase(args, F, 1, NCTXR, 32);
    if (args.stage == 6) return;
    GRID_BAR();
    moe_stage(args, F, bar, 1, NCTXR);
}

#ifndef DBG_STAGE
#define DBG_STAGE 0
#endif
extern "C" void kernel_launch(void* const* d_in, const int* in_sizes, int n_in, void* d_out, int out_size, void* d_ws, size_t ws_size, hipStream_t stream) {
    static int grid = 0;
    if (grid == 0) {
        if (n_in != 31 || out_size != NLATR * DM || ws_size < WS_END) { fprintf(stderr, "kernel_launch: unexpected shapes (n_in %d out %d ws %zu)\n", n_in, out_size, ws_size); grid = -1; return; }
        int dev = 0, cus = 0;
        if (hipGetDevice(&dev) != hipSuccess || hipDeviceGetAttribute(&cus, hipDeviceAttributeMultiprocessorCount, dev) != hipSuccess) { grid = -1; return; }
        if (hipFuncSetAttribute((const void*)trunk_fwd, hipFuncAttributeMaxDynamicSharedMemorySize, LDS_BYTES) != hipSuccess) { fprintf(stderr, "kernel_launch: hipFuncSetAttribute failed\n"); grid = -1; return; }
        (void)hipGetLastError();
        grid = cus;
    }
    if (grid < 0) return;
    (void)hipMemsetAsync((char*)d_ws + WS_CTL, 0, CTL_BYTES, stream);
    Args a{};
    for (int i = 0; i < 31; ++i) a.in[i] = (const float*)d_in[i];
    a.out = (float*)d_out; a.ws = (unsigned char*)d_ws; a.stage = DBG_STAGE; a.pad = 0;
    hipLaunchKernelGGL(trunk_fwd, dim3(grid), dim3(NWAVES * 64), LDS_BYTES, stream, a);
}
```

```cpp
#include <hip/hip_runtime.h>
#include <cstdio>
#include <cstdint>

#define GAS __attribute__((address_space(1)))
#define LAS __attribute__((address_space(3)))
typedef unsigned short bf16_t;
typedef short bf16x8 __attribute__((ext_vector_type(8)));
typedef short s16x4 __attribute__((ext_vector_type(4)));
typedef float f32x2 __attribute__((ext_vector_type(2)));
typedef float f32x4 __attribute__((ext_vector_type(4)));
typedef float f32x16 __attribute__((ext_vector_type(16)));
typedef unsigned u32x2 __attribute__((ext_vector_type(2)));
typedef unsigned u32x4 __attribute__((ext_vector_type(4)));
typedef int i32x4 __attribute__((ext_vector_type(4)));
typedef int i32x8 __attribute__((ext_vector_type(8)));

constexpr int DM = 1024, NBATCH = 16, SEQL = 2048, NCTX = 256;
constexpr int NCTXR = NBATCH * NCTX;
constexpr int NLATR = NBATCH * SEQL;
constexpr int NROWS = NCTXR + NLATR;
constexpr int NHEAD = 8, QLORA = 384, KVLORA = 256, NOPE = 128, ROPED = 64, VDIM = 128;
constexpr int NDQKV = 768;
constexpr int NQ = NHEAD * (NOPE + ROPED);
constexpr int NKV = NHEAD * (NOPE + VDIM);
constexpr int NEXP = 64, TOPK = 8, DEXP = 256;
constexpr float NORM_EPS = 1e-6f;
constexpr int NMOD = 6, MODW = NMOD * DM;

constexpr size_t MiB = 1u << 20;
constexpr size_t WS_CTL = 0, CTL_BYTES = 64 * 1024;
constexpr size_t WS_WDQKV = 1 * MiB;
constexpr size_t WS_WUQ   = WS_WDQKV + 1536 * 1024;
constexpr size_t WS_WUKV  = WS_WUQ + 1280 * 1024;
constexpr size_t WS_WO    = WS_WUKV + 1 * MiB;
constexpr size_t WS_WGLU  = WS_WO + 2 * MiB;
constexpr size_t WS_WSHR  = WS_WGLU + 4 * MiB;
constexpr size_t WS_WSHD  = WS_WSHR + 3 * MiB;
constexpr size_t WS_MOD   = 15 * MiB;
constexpr size_t WS_ROPE  = 16 * MiB;
constexpr size_t WS_W1    = 17 * MiB;
constexpr size_t WS_W2    = 81 * MiB;
constexpr size_t WS_XCTX  = 113 * MiB;
constexpr size_t WS_XN    = 129 * MiB;
constexpr size_t WS_ST    = 201 * MiB;
static_assert(WS_WSHD + 1 * MiB <= WS_MOD, "small weights fit");
constexpr size_t WS_KV   = WS_ST;
constexpr size_t WS_Q    = WS_ST + 144 * MiB;
constexpr size_t WS_OO   = WS_Q;
constexpr size_t WS_A1   = WS_ST + 252 * MiB;
constexpr size_t WS_O    = WS_A1;
constexpr size_t WS_KPE  = WS_ST + 324 * MiB;
constexpr size_t WS_SSQ1 = WS_ST + 329 * MiB;
constexpr size_t WS_SSQO = WS_ST + 332 * MiB;
constexpr size_t WS_END  = WS_ST + 402 * MiB;
constexpr size_t WS_XN8  = WS_ST + 358 * MiB;

constexpr int CW_BAR = 4096;

__device__ __forceinline__ unsigned cvt_pk_bf16(float lo, float hi) { unsigned r; asm volatile("v_cvt_pk_bf16_f32 %0, %1, %2" : "=v"(r) : "v"(lo), "v"(hi)); return r; }
__device__ __forceinline__ float bf_lo(unsigned w) { return __uint_as_float(w << 16); }
__device__ __forceinline__ float bf_hi(unsigned w) { return __uint_as_float(w & 0xffff0000u); }
__device__ __forceinline__ float wave_sum(float v) {
#pragma unroll
    for (int o = 1; o < 64; o <<= 1) v += __shfl_xor(v, o);
    return v;
}
__device__ __forceinline__ float silu_f(float v) { return v * __builtin_amdgcn_rcpf(1.f + __builtin_amdgcn_exp2f(-1.4426950408889634f * v)); }
__device__ __forceinline__ float sigmoid_f(float v) { return __builtin_amdgcn_rcpf(1.f + __builtin_amdgcn_exp2f(-1.4426950408889634f * v)); }
__device__ __forceinline__ int mod_index(int row) { return row < NCTXR ? 16 : (row - NCTXR) / SEQL; }
__device__ __forceinline__ int opaque_tid() { int t = threadIdx.x; asm volatile("" : "+v"(t)); return t; }
__device__ __forceinline__ float gelu_tanh(float v) {
    const float z = 0.7978845608028654f * (v + 0.044715f * v * v * v);
    return v * __builtin_amdgcn_rcpf(1.f + __builtin_amdgcn_exp2f(-2.8853900817779268f * z));
}
__device__ __forceinline__ unsigned char* opaque_ptr(unsigned char* p) {
    unsigned lo = __builtin_amdgcn_readfirstlane((unsigned)(unsigned long long)p), hi = __builtin_amdgcn_readfirstlane((unsigned)((unsigned long long)p >> 32));
    asm volatile("" : "+s"(lo), "+s"(hi)); return (unsigned char*)(GAS unsigned char*)(((unsigned long long)hi << 32) | lo); }
constexpr float Y_SCALE = 64.f, Y_INV = 1.f / 64.f, Y_MAX = 448.f;
__device__ __forceinline__ unsigned fp8_pack4(const f32x4& v) {
    const float a = fminf(fmaxf(v[0] * Y_SCALE, -Y_MAX), Y_MAX), b = fminf(fmaxf(v[1] * Y_SCALE, -Y_MAX), Y_MAX), c = fminf(fmaxf(v[2] * Y_SCALE, -Y_MAX), Y_MAX), d = fminf(fmaxf(v[3] * Y_SCALE, -Y_MAX), Y_MAX);
    int p = __builtin_amdgcn_cvt_pk_fp8_f32(a, b, 0, false); p = __builtin_amdgcn_cvt_pk_fp8_f32(c, d, p, true); return (unsigned)p; }
__device__ __forceinline__ f32x4 fp8_unpack4(unsigned w) {
    const f32x2 lo = __builtin_amdgcn_cvt_pk_f32_fp8((int)w, false), hi = __builtin_amdgcn_cvt_pk_f32_fp8((int)w, true);
    return (f32x4){lo.x * Y_INV, lo.y * Y_INV, hi.x * Y_INV, hi.y * Y_INV}; }
constexpr int FP8_G1_LAYERS = 3;
constexpr float XN8_SCALE = 16.f, W18_SCALE = 1024.f, G1_DESCALE = 1.f / (16.f * 1024.f);
constexpr bool FP8_G2 = true;
constexpr float H8_SCALE = 16.f, W28_SCALE = 512.f, G2_DESCALE = 1.f / (16.f * 512.f);
constexpr bool FP8_GLU = true;
constexpr float G8_SCALE = 4.f, WG8_SCALE = 1024.f, GLU_DESCALE = 1.f / (4.f * 1024.f);
constexpr bool FP8_WO = false;
constexpr float O8_SCALE = 64.f, WO8_SCALE = 1024.f, WO_DESCALE = 1.f / (64.f * 1024.f);
constexpr bool FP8_DQKV = true;
constexpr float WD8_SCALE = 1024.f, DQKV_DESCALE = 1.f / (16.f * 1024.f);
constexpr bool FP8_SH = true;
constexpr bool FP8_SHD = true;
constexpr bool FP8_S5 = true;
constexpr float BS8_SCALE = 2048.f, TY8_SCALE = 64.f, QY8_SCALE = 16.f, XI8_SCALE = 64.f, S5S_DESCALE = 1.f / (16.f * 2048.f), S5Y_DESCALE = 1.f / 1024.f;
__device__ __forceinline__ unsigned fp8_pack2_s(float a, float b, float s) {
    const float x = fminf(fmaxf(a * s, -Y_MAX), Y_MAX), y = fminf(fmaxf(b * s, -Y_MAX), Y_MAX);
    return (unsigned)__builtin_amdgcn_cvt_pk_fp8_f32(x, y, 0, false) & 0xffffu; }
static_assert(!FP8_G2 || FP8_G1_LAYERS == 3, "fp8 hidden rows need the fp8 gate/up policy in both layers");
__device__ __forceinline__ unsigned fp8_pack4_s(const f32x4& v, float s) {
    const float a = fminf(fmaxf(v[0] * s, -Y_MAX), Y_MAX), b = fminf(fmaxf(v[1] * s, -Y_MAX), Y_MAX), c = fminf(fmaxf(v[2] * s, -Y_MAX), Y_MAX), d = fminf(fmaxf(v[3] * s, -Y_MAX), Y_MAX);
    int p = __builtin_amdgcn_cvt_pk_fp8_f32(a, b, 0, false); p = __builtin_amdgcn_cvt_pk_fp8_f32(c, d, p, true); return (unsigned)p; }
#define XB_TMO      128
#define XB_XCNT(j)  (256  + 64 * (j))
#define XB_XSUB(j)  (1280 + 64 * (j))
#define XB_XGEN(j)  (2304 + 64 * (j))
#define XB_TOP      3328
#define XB_TOPGEN   3392
#define XCD_BAR_WORDS 3456
#define XB_SPIN_CAP (1u << 18)
__device__ __forceinline__ unsigned xb_ld(unsigned* p)              { return __hip_atomic_load(p, __ATOMIC_RELAXED, __HIP_MEMORY_SCOPE_AGENT); }
__device__ __forceinline__ unsigned xb_add(unsigned* p, unsigned v) { return __hip_atomic_fetch_add(p, v, __ATOMIC_RELAXED, __HIP_MEMORY_SCOPE_AGENT); }
__device__ __forceinline__ unsigned xb_xcc_id() { return (unsigned)__builtin_amdgcn_s_getreg((3 << 11) | 20) & 0xFu; }
#define XB_SPIN(cond, bar) do { unsigned _sp = 0; while (cond) { __builtin_amdgcn_s_sleep(1); \
    if ((++_sp & 255u) == 0u) { if (xb_ld(&(bar)[XB_TMO])) break; if (_sp > XB_SPIN_CAP) { atomicAdd(&(bar)[XB_TMO], 1u); break; } } } } while (0)
struct XcdBarrier { unsigned* bar; unsigned x; volatile LAS unsigned* st; };
__device__ __forceinline__ XcdBarrier xcd_barrier_post(unsigned* bar, volatile LAS unsigned* st) {
    XcdBarrier b; b.bar = bar; b.x = xb_xcc_id(); b.st = st;
    if (threadIdx.x == 0) (void)xb_add(&bar[XB_XCNT(b.x)], 1u);
    return b;
}
__device__ __forceinline__ void xcd_barrier_complete(unsigned* bar, unsigned x, unsigned& nloc, unsigned& nx) {
    const unsigned G = gridDim.x * gridDim.y * gridDim.z;
    unsigned sum, cnt, mine, sp = 0u;
    for (;;) {
        sum = 0u; cnt = 0u; mine = 0u;
#pragma unroll
        for (unsigned j = 0; j < 16; ++j) { const unsigned c = xb_ld(&bar[XB_XCNT(j)]); sum += c; cnt += (c > 0u) ? 1u : 0u; mine = (j == x) ? c : mine; }
        if (sum == G) break;
        __builtin_amdgcn_s_sleep(1);
        if ((++sp & 255u) == 0u) { if (xb_ld(&bar[XB_TMO])) break; if (sp > XB_SPIN_CAP) { atomicAdd(&bar[XB_TMO], 1u); break; } }
    }
    nloc = mine > 0u ? mine : 1u; nx = cnt > 0u ? cnt : 1u;
}
__device__ __forceinline__ void xcd_barrier(const XcdBarrier& b) {
    asm volatile("s_waitcnt vmcnt(0)" ::: "memory");
    __syncthreads();
    if (threadIdx.x == 0) {
        unsigned* bar = b.bar;
        __builtin_amdgcn_s_waitcnt(0);
        unsigned nloc = b.st[0], nx = b.st[1];
        if (nloc == 0u) { xcd_barrier_complete(bar, b.x, nloc, nx); b.st[0] = nloc; b.st[1] = nx; }
        const unsigned old = xb_add(&bar[XB_XSUB(b.x)], 1u);
        const unsigned gen = old / nloc;
        if (old + 1u == (gen + 1u) * nloc) {
            __builtin_amdgcn_fence(__ATOMIC_RELEASE, "agent");
            asm volatile("s_waitcnt vmcnt(0)" ::: "memory");
            const unsigned og = xb_add(&bar[XB_TOP], 1u);
            const unsigned tg = og / nx;
            if (og + 1u == (tg + 1u) * nx) xb_add(&bar[XB_TOPGEN], 1u);
            else XB_SPIN(xb_ld(&bar[XB_TOPGEN]) == tg, bar);
            __builtin_amdgcn_fence(__ATOMIC_ACQUIRE, "agent");
            xb_add(&bar[XB_XGEN(b.x)], 1u);
            asm volatile("s_waitcnt vmcnt(0)" ::: "memory");
        } else {
            XB_SPIN(xb_ld(&bar[XB_XGEN(b.x)]) == gen, bar);
            __builtin_amdgcn_fence(__ATOMIC_ACQUIRE, "agent");
            asm volatile("s_waitcnt vmcnt(0)" ::: "memory");
        }
    }
    __syncthreads();
}

namespace pg8 {
constexpr int BM = 256, BK = 64, HALF = 128, HTB = HALF * BK * 2, STAGE_BYTES = 8 * HTB, NXCD = 8, WGM = 8;
__host__ __device__ __forceinline__ int lds_byte(int r, int c) { const int st = (r >> 4) * 2 + (c >> 5), rr = r & 15, cc = c & 31, ob = rr * 64 + cc * 2; return st * 1024 + (ob ^ (((ob >> 9) & 1) << 5)); }
__host__ __device__ __forceinline__ void stage_rc(int b, int& R, int& C) { const int st = b / 1024, sb = b % 1024, swz = sb ^ (((sb >> 9) & 1) << 5); R = (st >> 1) * 16 + swz / 64; C = (st & 1) * 32 + (swz % 64) / 2; }
__host__ __device__ __forceinline__ int perm32(int rho) { const int n = rho >> 4, i = rho & 15; return 8 * (i >> 2) + 4 * n + (i & 3); }

__device__ __forceinline__ bool dense_order(int i, int G, int c, int nM, int nN, int& pm, int& pn) {
    const int nwg = nM * nN; const long L = (long)i * G + c; if (L >= nwg) return false;
    int wgid = (int)L; { const int q = nwg / NXCD, r = nwg % NXCD, xcd = wgid % NXCD, off = wgid / NXCD; wgid = (xcd < r ? xcd * (q + 1) : r * (q + 1) + (xcd - r) * q) + off; }
    const int nig = WGM * nN, gid = wgid / nig, fm = gid * WGM, gsz = (nM - fm) < WGM ? (nM - fm) : WGM;
    pm = __builtin_amdgcn_readfirstlane(fm + ((wgid % nig) % gsz)); pn = __builtin_amdgcn_readfirstlane((wgid % nig) / gsz); return true;
}

template <bool GATHER> struct UCtx { const char* a0[2]; const char* a1[2]; const char* b; unsigned vg[2][2]; };
template <> struct UCtx<false> { const char* a0[2]; const char* a1[2]; const char* b; };

template <class P> constexpr auto pol_nob1(int) -> decltype(P::NOB1) { return P::NOB1; }
template <class P> constexpr bool pol_nob1(long) { return false; }
template <class P> constexpr auto pol_fp8(int) -> decltype(P::FP8) { return P::FP8; }
template <class P> constexpr bool pol_fp8(long) { return false; }
template <class P>
__device__ __forceinline__ void gemm_phase(LAS unsigned char* lds, const P& pol, bool do_epi = true, int stagger_ticks = 0) {
    typedef typename P::Unit Unit;
    const int tid = opaque_tid(), wid = __builtin_amdgcn_readfirstlane(tid >> 6), lane = tid & 63, wr = wid >> 2, wc = wid & 3, fr = lane & 15, fq = lane >> 4;
    constexpr int nt = P::NT; constexpr bool FP8 = pol_fp8<P>(0); constexpr bool NOB1 = pol_nob1<P>(0);
    int Rr[2], Cc[2]; unsigned voffB[2], va0[2];
#pragma unroll
    for (int i = 0; i < 2; ++i) { stage_rc(tid * 16 + i * 8192, Rr[i], Cc[i]); const int Rb = P::PERM ? ((Rr[i] & ~31) + perm32(Rr[i] & 31)) : Rr[i];
        voffB[i] = (unsigned)(Rb * P::LDB + Cc[i] * 2); va0[i] = pol.lane_a0(Rr[i], Cc[i]); }
    constexpr size_t hstepB = (size_t)HALF * P::LDB;
    const unsigned ldsw = (unsigned)wid * 1024u;
    const int aoff = lds_byte(wr * 64 + fr, fq * 8), boff = lds_byte(wc * 32 + fr, fq * 8);
#define PG8_SA(b, h) (((b) * 2 + (h)) * HTB)
#define PG8_SB(b, h) ((4 + (b) * 2 + (h)) * HTB)
#define PG8_GL(bufoff, p0, p1) do { __builtin_amdgcn_global_load_lds((const unsigned*)(p0), (LAS unsigned*)(lds + (bufoff) + ldsw), 16, 0, 0); \
        __builtin_amdgcn_global_load_lds((const unsigned*)(p1), (LAS unsigned*)(lds + (bufoff) + ldsw + 8192), 16, 0, 0); } while (0)
#define PG8_STB(bufoff, U, h, kt) do { const char* _b = (U).b + (size_t)(h) * hstepB + (size_t)(kt) * 128; asm volatile("" : "+s"(_b)); PG8_GL(bufoff, _b + voffB[0], _b + voffB[1]); } while (0)
#define PG8_STA(bufoff, U, h, kt) do { const char* _a = (U).a0[h] + (size_t)(kt) * P::KS0; if constexpr (P::TWOSEG) { if ((kt) >= P::KT0) _a = (U).a1[h] + (size_t)((kt) - P::KT0) * P::KS1; } \
        unsigned _o0, _o1; if constexpr (P::GATHER) { _o0 = (U).vg[h][0]; _o1 = (U).vg[h][1]; } else { _o0 = va0[0]; _o1 = va0[1]; } \
        asm volatile("" : "+s"(_a)); PG8_GL(bufoff, _a + _o0, _a + _o1); } while (0)
#define PG8_LDA(dst, b, h) do { if constexpr (FP8) { _Pragma("unroll") for (int m = 0; m < 4; ++m) { const LAS unsigned char* p_ = lds + PG8_SA(b, h) + aoff + m * 2048; dst##8[m] = __builtin_shufflevector(*(const LAS i32x4*)p_, *(const LAS i32x4*)(p_ + 1024), 0, 1, 2, 3, 4, 5, 6, 7); } } \
        else { _Pragma("unroll") for (int m = 0; m < 4; ++m) _Pragma("unroll") for (int k = 0; k < 2; ++k) dst[m][k] = *(const LAS bf16x8*)(lds + PG8_SA(b, h) + aoff + m * 2048 + k * 1024); } } while (0)
#define PG8_LDB(dst, b, h) do { if constexpr (NOB1 && (h) == 1) { } else if constexpr (FP8) { _Pragma("unroll") for (int n = 0; n < 2; ++n) { const LAS unsigned char* p_ = lds + PG8_SB(b, h) + boff + n * 2048; dst##8[n] = __builtin_shufflevector(*(const LAS i32x4*)p_, *(const LAS i32x4*)(p_ + 1024), 0, 1, 2, 3, 4, 5, 6, 7); } } \
        else { _Pragma("unroll") for (int n = 0; n < 2; ++n) _Pragma("unroll") for (int k = 0; k < 2; ++k) dst[n][k] = *(const LAS bf16x8*)(lds + PG8_SB(b, h) + boff + n * 2048 + k * 1024); } } while (0)
#define PG8_MMA(ai, bj, At, Bt) do { __builtin_amdgcn_s_setprio(1); if constexpr (NOB1 && (bj) == 1) { } else if constexpr (FP8) { _Pragma("unroll") for (int m = 0; m < 4; ++m) _Pragma("unroll") for (int n = 0; n < 2; ++n) \
        acc[ai][bj][m][n] = __builtin_amdgcn_mfma_scale_f32_16x16x128_f8f6f4(Bt##8[n], At##8[m], acc[ai][bj][m][n], 0, 0, 0, 0, 0, 0); } \
        else { _Pragma("unroll") for (int m = 0; m < 4; ++m) _Pragma("unroll") for (int n = 0; n < 2; ++n) _Pragma("unroll") for (int k = 0; k < 2; ++k) \
        acc[ai][bj][m][n] = __builtin_amdgcn_mfma_f32_16x16x32_bf16(Bt[n][k], At[m][k], acc[ai][bj][m][n], 0, 0, 0); } __builtin_amdgcn_s_setprio(0); } while (0)
#define PG8_WAIT_V(n) asm volatile("s_waitcnt vmcnt(" #n ")" ::: "memory")
#define PG8_WAIT_L(n) asm volatile("s_waitcnt lgkmcnt(" #n ")" ::: "memory")
#define PG8_BAR __builtin_amdgcn_s_barrier()
#define PG8_SCHED __builtin_amdgcn_sched_barrier(0)
    Unit cur, nxt; int ui = 0;
    if (!pol.next(0, cur)) return;
    if (stagger_ticks > 0 && (blockIdx.x & 1)) {
        const unsigned long long t0 = __builtin_amdgcn_s_memrealtime(); while (__builtin_amdgcn_s_memrealtime() - t0 < (unsigned long long)stagger_ticks) __builtin_amdgcn_s_sleep(8); }
    UCtx<P::GATHER> cc, nc;
    pol.ctx(cur, cc, Rr, Cc);
    f32x4 acc[2][2][4][2];
#pragma unroll
    for (int a = 0; a < 2; ++a)
#pragma unroll
        for (int b = 0; b < 2; ++b)
#pragma unroll
            for (int m = 0; m < 4; ++m)
#pragma unroll
                for (int n = 0; n < 2; ++n) acc[a][b][m][n] = (f32x4){0.f, 0.f, 0.f, 0.f};
    bf16x8 At[4][2], B0[2][2], B1[2][2]; [[maybe_unused]] i32x8 At8[4], B08[2], B18[2];
    PG8_STB(PG8_SB(0, 0), cc, 0, 0); PG8_STB(PG8_SB(0, 1), cc, 1, 0); PG8_STA(PG8_SA(0, 0), cc, 0, 0); PG8_STA(PG8_SA(0, 1), cc, 1, 0);
    if (wr == 1) PG8_BAR;
    PG8_WAIT_V(2); PG8_BAR;
    PG8_STB(PG8_SB(1, 0), cc, 0, 1); PG8_STA(PG8_SA(1, 0), cc, 0, 1); PG8_STB(PG8_SB(1, 1), cc, 1, 1);
    PG8_WAIT_V(6); PG8_BAR;
    for (;;) {
        if constexpr (P::HOOK) pol.unit_begin(cur, ui, lds, wid, lane);
        const bool has_next = pol.next(ui + 1, nxt);
        if (has_next) pol.ctx(nxt, nc, Rr, Cc); else nc = cc;
        int ntv = nt; if constexpr (FP8) asm volatile("" : "+s"(ntv));
        for (int t = 0; t < ntv; t += 2) {
            const bool last = (t == ntv - 2);
            const int k2 = last ? 0 : t + 2, k3 = k2 + 1;
            PG8_LDB(B0, 0, 0); PG8_LDB(B1, 0, 1); PG8_SCHED; PG8_LDA(At, 0, 0); PG8_STA(PG8_SA(1, 1), cc, 1, t + 1);
            PG8_WAIT_V(8); PG8_WAIT_L(0); PG8_BAR; PG8_MMA(0, 0, At, B0); PG8_MMA(0, 1, At, B1); PG8_BAR; PG8_SCHED;
            PG8_LDA(At, 0, 1);
            if (last) { PG8_STB(PG8_SB(0, 0), nc, 0, 0); PG8_STB(PG8_SB(0, 1), nc, 1, 0); PG8_STA(PG8_SA(0, 0), nc, 0, 0); }
            else      { PG8_STB(PG8_SB(0, 0), cc, 0, k2); PG8_STB(PG8_SB(0, 1), cc, 1, k2); PG8_STA(PG8_SA(0, 0), cc, 0, k2); }
            PG8_WAIT_V(8); PG8_WAIT_L(0); PG8_BAR; PG8_MMA(1, 0, At, B0); PG8_MMA(1, 1, At, B1); PG8_BAR; PG8_SCHED;
            PG8_LDB(B0, 1, 0); PG8_LDB(B1, 1, 1); PG8_SCHED; PG8_LDA(At, 1, 0);
            if (last) { PG8_STA(PG8_SA(0, 1), nc, 1, 0); } else { PG8_STA(PG8_SA(0, 1), cc, 1, k2); }
            PG8_WAIT_V(8); PG8_WAIT_L(0); PG8_BAR; PG8_MMA(0, 0, At, B0); PG8_MMA(0, 1, At, B1); PG8_BAR; PG8_SCHED;
            PG8_LDA(At, 1, 1);
            if (last) { PG8_STB(PG8_SB(1, 0), nc, 0, 1); PG8_STB(PG8_SB(1, 1), nc, 1, 1); PG8_STA(PG8_SA(1, 0), nc, 0, 1); }
            else      { PG8_STB(PG8_SB(1, 0), cc, 0, k3); PG8_STB(PG8_SB(1, 1), cc, 1, k3); PG8_STA(PG8_SA(1, 0), cc, 0, k3); }
            PG8_WAIT_V(8); PG8_WAIT_L(0); PG8_BAR; PG8_MMA(1, 0, At, B0); PG8_MMA(1, 1, At, B1); PG8_BAR; PG8_SCHED;
        }
        if (wr == 0) PG8_BAR;
        if (do_epi) { if constexpr (P::HOOK) pol.epi_h(acc, cur, ui, lds, wr, wc, fr, fq); else pol.epi(acc, cur, wr, wc, fr, fq); }
        if (!has_next) break;
#pragma unroll
        for (int a = 0; a < 2; ++a)
#pragma unroll
            for (int b = 0; b < 2; ++b)
#pragma unroll
                for (int m = 0; m < 4; ++m)
#pragma unroll
                    for (int n = 0; n < 2; ++n) acc[a][b][m][n] = (f32x4){0.f, 0.f, 0.f, 0.f};
        cur = nxt; cc = nc; ++ui;
        if (wr == 1) PG8_BAR;
    }
    PG8_WAIT_V(0);
    PG8_BAR;
#undef PG8_SA
#undef PG8_SB
#undef PG8_GL
#undef PG8_STB
#undef PG8_STA
#undef PG8_LDA
#undef PG8_LDB
#undef PG8_MMA
#undef PG8_WAIT_V
#undef PG8_WAIT_L
#undef PG8_BAR
#undef PG8_SCHED
}
}
struct DUnit { int pm, pn; };

template <int NT_, int LDA_, bool PERM_> struct DenseBase {
    static constexpr bool PERM = PERM_, GATHER = false, TWOSEG = false, HOOK = false;
    static constexpr int NT = NT_, KT0 = NT_, KS0 = 128, KS1 = 128, LDB = NT_ * 128;
    typedef DUnit Unit;
    const char* A; const char* Bt; int nM, nN, G, c;
    __device__ __forceinline__ bool next(int i, Unit& u) const { return pg8::dense_order(i, G, c, nM, nN, u.pm, u.pn); }
    __device__ __forceinline__ void ctx(const Unit& u, pg8::UCtx<false>& x, const int (&)[2], const int (&)[2]) const {
        x.a0[0] = A + (size_t)u.pm * 256 * LDA_; x.a0[1] = x.a0[0] + (size_t)128 * LDA_; x.a1[0] = x.a0[0]; x.a1[1] = x.a0[1];
        x.b = Bt + (size_t)u.pn * 256 * LDB; }
    __device__ __forceinline__ unsigned lane_a0(int R, int C) const { return (unsigned)(R * LDA_ + C * 2); }
    __device__ __forceinline__ unsigned lane_a1(int, int) const { return 0u; }
};

__device__ __forceinline__ void store8(bf16_t* p, const f32x4& v0, const f32x4& v1) {
    u32x4 w; w.x = cvt_pk_bf16(v0[0], v0[1]); w.y = cvt_pk_bf16(v0[2], v0[3]); w.z = cvt_pk_bf16(v1[0], v1[1]); w.w = cvt_pk_bf16(v1[2], v1[3]); *(u32x4*)p = w; }
__device__ __forceinline__ float sq4(const f32x4& v) { return (v[0] * v[0] + v[1] * v[1]) + (v[2] * v[2] + v[3] * v[3]); }
__device__ __forceinline__ void rope8(f32x4& v0, f32x4& v1, const float* cs) {
    const f32x4 a = *(const f32x4*)cs, b = *(const f32x4*)(cs + 4);
    float x0, x1;
    x0 = v0[0]; x1 = v0[1]; v0[0] = x0 * a[0] - x1 * a[1]; v0[1] = x0 * a[1] + x1 * a[0];
    x0 = v0[2]; x1 = v0[3]; v0[2] = x0 * a[2] - x1 * a[3]; v0[3] = x0 * a[3] + x1 * a[2];
    x0 = v1[0]; x1 = v1[1]; v1[0] = x0 * b[0] - x1 * b[1]; v1[1] = x0 * b[1] + x1 * b[0];
    x0 = v1[2]; x1 = v1[3]; v1[2] = x0 * b[2] - x1 * b[3]; v1[3] = x0 * b[3] + x1 * b[2];
}

struct PolDqkv : DenseBase<FP8_DQKV ? 8 : 16, FP8_DQKV ? 1024 : 2048, true> {
    static constexpr bool FP8 = FP8_DQKV;
    bf16_t* A1; float* SSQ1; bf16_t* KPE; const float* ROPE;
    __device__ __forceinline__ void epi(const f32x4 (&acc_)[2][2][4][2], const DUnit& u, int wr, int wc, int fr, int fq) const {
        constexpr float ds = FP8_DQKV ? DQKV_DESCALE : 1.f;
#pragma unroll
        for (int ai = 0; ai < 2; ++ai)
#pragma unroll
            for (int m = 0; m < 4; ++m) {
                const f32x4 acc[2][2] = {{acc_[ai][0][m][0] * ds, acc_[ai][0][m][1] * ds}, {acc_[ai][1][m][0] * ds, acc_[ai][1][m][1] * ds}};
                const int row = u.pm * 256 + ai * 128 + wr * 64 + m * 16 + fr;
                bf16_t* rowp = A1 + (size_t)row * NDQKV + u.pn * 256 + wc * 32 + 8 * fq;
                float s0 = sq4(acc[0][0]) + sq4(acc[0][1]), s1 = sq4(acc[1][0]) + sq4(acc[1][1]);
                store8(rowp, acc[0][0], acc[0][1]); store8(rowp + 128, acc[1][0], acc[1][1]);
                s0 += __shfl_xor(s0, 16); s0 += __shfl_xor(s0, 32); s1 += __shfl_xor(s1, 16); s1 += __shfl_xor(s1, 32);
                if (fq == 0) {
                    float* sp = SSQ1 + (size_t)row * 16;
                    if (u.pn == 0) sp[wc] = s0 + s1; else if (u.pn == 1) { sp[4 + wc] = s0; sp[8 + wc] = s1; } else sp[12 + wc] = s0;
                }
                if (u.pn == 2 && wc < 2) {
                    f32x4 v0 = acc[1][0], v1 = acc[1][1];
                    if (row >= NCTXR) { const int t = (row - NCTXR) & (SEQL - 1); rope8(v0, v1, ROPE + ((size_t)t * 32 + 16 * wc + 4 * fq) * 2); }
                    {
                        int x = __builtin_amdgcn_cvt_pk_fp8_f32(v0[0], v0[1], 0, false); x = __builtin_amdgcn_cvt_pk_fp8_f32(v0[2], v0[3], x, true);
                        int y = __builtin_amdgcn_cvt_pk_fp8_f32(v1[0], v1[1], 0, false); y = __builtin_amdgcn_cvt_pk_fp8_f32(v1[2], v1[3], y, true);
                        *(u32x2*)((unsigned char*)KPE + (size_t)row * 64 + 32 * (fq & 1) + 8 * (2 * wc + (fq >> 1))) = (u32x2){(unsigned)x, (unsigned)y}; }
                }
            }
    }
};

struct PolQup : DenseBase<6, NDQKV * 2, true> {
    bf16_t* Q; const float* SSQ1;
    __device__ __forceinline__ void epi(const f32x4 (&acc)[2][2][4][2], const DUnit& u, int wr, int wc, int fr, int fq) const {
#pragma unroll
        for (int ai = 0; ai < 2; ++ai) {
            f32x4 p0[4], p1[4];
#pragma unroll
            for (int m = 0; m < 4; ++m) { const int row = u.pm * 256 + ai * 128 + wr * 64 + m * 16 + fr; p0[m] = *(const f32x4*)(SSQ1 + (size_t)row * 16); p1[m] = *(const f32x4*)(SSQ1 + (size_t)row * 16 + 4); }
#pragma unroll
            for (int m = 0; m < 4; ++m) {
                const int row = u.pm * 256 + ai * 128 + wr * 64 + m * 16 + fr;
                const float ss = ((p0[m][0] + p0[m][1]) + (p0[m][2] + p0[m][3])) + ((p1[m][0] + p1[m][1]) + (p1[m][2] + p1[m][3]));
                const float rstd = __builtin_amdgcn_rsqf(ss * (1.f / QLORA) + NORM_EPS);
                if (u.pn < 4) {
                    unsigned char* qp = (unsigned char*)Q + (size_t)row * 1024 + u.pn * 256 + wc * 32 + 8 * fq;
#pragma unroll
                    for (int bj = 0; bj < 2; ++bj) { const f32x4 a = acc[ai][bj][m][0] * rstd, b = acc[ai][bj][m][1] * rstd;
                        int x = __builtin_amdgcn_cvt_pk_fp8_f32(a[0], a[1], 0, false); x = __builtin_amdgcn_cvt_pk_fp8_f32(a[2], a[3], x, true);
                        int y = __builtin_amdgcn_cvt_pk_fp8_f32(b[0], b[1], 0, false); y = __builtin_amdgcn_cvt_pk_fp8_f32(b[2], b[3], y, true);
                        *(u32x2*)(qp + 128 * bj) = (u32x2){(unsigned)x, (unsigned)y}; }
                } else {
                    bf16_t* rowp = (bf16_t*)((unsigned char*)Q + (size_t)NROWS * 1024) + (size_t)row * 512 + (u.pn - 4) * 256 + wc * 32 + 8 * fq;
                    store8(rowp, acc[ai][0][m][0] * rstd, acc[ai][0][m][1] * rstd); store8(rowp + 128, acc[ai][1][m][0] * rstd, acc[ai][1][m][1] * rstd); }
            }
            asm volatile("" ::: "memory");
        }
    }
};

struct PolKVup : DenseBase<4, NDQKV * 2, true> {
    bf16_t* KV; const float* SSQ1; unsigned char* VT8;
    __device__ __forceinline__ void epi(const f32x4 (&acc)[2][2][4][2], const DUnit& u, int wr, int wc, int fr, int fq) const {
#pragma unroll
        for (int ai = 0; ai < 2; ++ai) {
            f32x4 p0[4], p1[4]; float rs[4];
#pragma unroll
            for (int m = 0; m < 4; ++m) { const int row = u.pm * 256 + ai * 128 + wr * 64 + m * 16 + fr; p0[m] = *(const f32x4*)(SSQ1 + (size_t)row * 16 + 8); p1[m] = *(const f32x4*)(SSQ1 + (size_t)row * 16 + 12); }
#pragma unroll
            for (int m = 0; m < 4; ++m) {
                const int row = u.pm * 256 + ai * 128 + wr * 64 + m * 16 + fr;
                const float ss = ((p0[m][0] + p0[m][1]) + (p0[m][2] + p0[m][3])) + ((p1[m][0] + p1[m][1]) + (p1[m][2] + p1[m][3]));
                const float rstd = __builtin_amdgcn_rsqf(ss * (1.f / KVLORA) + NORM_EPS);
                u32x2 k8; { const f32x4 a = acc[ai][0][m][0] * rstd, b = acc[ai][0][m][1] * rstd;
                    int x = __builtin_amdgcn_cvt_pk_fp8_f32(a[0], a[1], 0, false); x = __builtin_amdgcn_cvt_pk_fp8_f32(a[2], a[3], x, true);
                    int y = __builtin_amdgcn_cvt_pk_fp8_f32(b[0], b[1], 0, false); y = __builtin_amdgcn_cvt_pk_fp8_f32(b[2], b[3], y, true); k8.x = (unsigned)x; k8.y = (unsigned)y; }
                *(u32x2*)((unsigned char*)KV + (size_t)row * 1024 + u.pn * 128 + wc * 32 + 8 * fq) = k8; rs[m] = rstd;
            }
            {   unsigned char* vp = VT8 + ((size_t)((u.pm * 4 + ai * 2 + wr) * 8 + u.pn) * 128 + wc * 32 + 8 * fq) * 64 + 32 * (fr & 1) + 16 * (fr >> 3) + 4 * ((fr >> 1) & 3);
#pragma unroll
                for (int n = 0; n < 2; ++n)
#pragma unroll
                    for (int j = 0; j < 4; ++j) {
                        int w_ = __builtin_amdgcn_cvt_pk_fp8_f32(acc[ai][1][0][n][j] * rs[0], acc[ai][1][1][n][j] * rs[1], 0, false);
                        w_ = __builtin_amdgcn_cvt_pk_fp8_f32(acc[ai][1][2][n][j] * rs[2], acc[ai][1][3][n][j] * rs[3], w_, true);
                        *(int*)(vp + (4 * n + j) * 64) = w_; } }
            asm volatile("" ::: "memory");
        }
    }
};

struct PolWo : DenseBase<FP8_WO ? 8 : 16, FP8_WO ? 1024 : 2048, true> {
    static constexpr bool FP8 = FP8_WO;
    bf16_t* OO; float* SSQO;
    __device__ __forceinline__ void epi(const f32x4 (&acc_)[2][2][4][2], const DUnit& u, int wr, int wc, int fr, int fq) const {
        constexpr float ds = FP8_WO ? WO_DESCALE : 1.f;
#pragma unroll
        for (int ai = 0; ai < 2; ++ai)
#pragma unroll
            for (int m = 0; m < 4; ++m) {
                const f32x4 a00 = acc_[ai][0][m][0] * ds, a01 = acc_[ai][0][m][1] * ds, a10 = acc_[ai][1][m][0] * ds, a11 = acc_[ai][1][m][1] * ds;
                const int row = u.pm * 256 + ai * 128 + wr * 64 + m * 16 + fr;
                bf16_t* rowp = OO + (size_t)row * DM + u.pn * 256 + wc * 32 + 8 * fq;
                float s = (sq4(a00) + sq4(a01)) + (sq4(a10) + sq4(a11));
                store8(rowp, a00, a01); store8(rowp + 128, a10, a11);
                s += __shfl_xor(s, 16); s += __shfl_xor(s, 32);
                if (fq == 0) SSQO[(size_t)row * 32 + u.pn * 4 + wc] = s;
            }
    }
};
namespace attn {
constexpr int NW = 8, QBLK = 32, KVBLK = 64, DQK = 192, DV = 128;
constexpr float SCALE = 0.07216878364870322f;
constexpr float THR = 4.f;
constexpr int KP = 208;
constexpr int VP = 80;
constexpr int SHM_V = DV * VP, SHM_K = KVBLK * KP;
constexpr int SHM_ATTN = 2 * SHM_V + 2 * SHM_K + NW * 64 * 4;
#define SBAR() __builtin_amdgcn_sched_barrier(0)
__device__ __forceinline__ int crow(int r, int hi) { return (r & 3) + 8 * (r >> 2) + 4 * hi; }
__device__ __forceinline__ unsigned cvtpk(float lo, float hi) { unsigned r; asm volatile("v_cvt_pk_bf16_f32 %0, %1, %2" : "=v"(r) : "v"(lo), "v"(hi)); return r; }

__device__ __forceinline__ void partialSM(f32x16& p0, f32x16& p1, float& m_reg, float& mn, float& alpha) {
  constexpr float C = SCALE * 1.4426950408889634f;
  float pmax = p0[0];
#pragma unroll
  for (int r = 1; r < 16; ++r) pmax = fmaxf(pmax, p0[r]);
#pragma unroll
  for (int r = 0; r < 16; ++r) pmax = fmaxf(pmax, p1[r]);
  { auto rr = __builtin_amdgcn_permlane32_swap(__float_as_uint(pmax), __float_as_uint(pmax), false, false);
    pmax = fmaxf(__uint_as_float(rr[0]), __uint_as_float(rr[1])); }
  if (__builtin_expect(__all(pmax - m_reg <= THR / SCALE), 1)) { mn = m_reg; alpha = 1.f; }
  else { mn = fmaxf(m_reg, pmax); alpha = __builtin_amdgcn_exp2f((m_reg - mn) * C); m_reg = mn; }
  float mnC = 2.f - mn * C;
#pragma unroll
  for (int r = 0; r < 16; ++r) p0[r] = fmaf(p0[r], C, mnC);
#pragma unroll
  for (int r = 0; r < 16; ++r) p1[r] = fmaf(p1[r], C, mnC);
#pragma unroll
  for (int r = 0; r < 16; ++r) p0[r] = __builtin_amdgcn_exp2f(p0[r]);
}
__device__ __forceinline__ void finishSM(f32x16& p0, f32x16& p1, float alpha, float& l_reg, i32x8& pa) {
#pragma unroll
  for (int r = 0; r < 16; ++r) p1[r] = __builtin_amdgcn_exp2f(p1[r]);
  float ps = 0;
#pragma unroll
  for (int r = 0; r < 16; ++r) ps += p0[r];
#pragma unroll
  for (int r = 0; r < 16; ++r) ps += p1[r];
  { auto rr = __builtin_amdgcn_permlane32_swap(__float_as_uint(ps), __float_as_uint(ps), false, false);
    ps = __uint_as_float(rr[0]) + __uint_as_float(rr[1]); }
  l_reg = l_reg * alpha + ps;
#define PK4(P, BASE) ({ int a_ = __builtin_amdgcn_cvt_pk_fp8_f32(P[BASE + 0], P[BASE + 1], 0, false); a_ = __builtin_amdgcn_cvt_pk_fp8_f32(P[BASE + 2], P[BASE + 3], a_, true); a_; })
  pa = (i32x8){PK4(p0, 0), PK4(p0, 4), PK4(p0, 8), PK4(p0, 12), PK4(p1, 0), PK4(p1, 4), PK4(p1, 8), PK4(p1, 12)};
#undef PK4
}
__device__ __forceinline__ u32x2 bf8_fp8(const bf16x8& v) {
  const u32x4 w = *reinterpret_cast<const u32x4*>(&v);
  int a = __builtin_amdgcn_cvt_pk_fp8_f32(bf_lo(w.x), bf_hi(w.x), 0, false); a = __builtin_amdgcn_cvt_pk_fp8_f32(bf_lo(w.y), bf_hi(w.y), a, true);
  int b = __builtin_amdgcn_cvt_pk_fp8_f32(bf_lo(w.z), bf_hi(w.z), 0, false); b = __builtin_amdgcn_cvt_pk_fp8_f32(bf_lo(w.w), bf_hi(w.w), b, true);
  return (u32x2){(unsigned)a, (unsigned)b};
}
__device__ __forceinline__ void qkt(f32x16& p0, f32x16& p1, const char* Ks, const i32x8 (&q8)[3], int koff) {
  p0 = f32x16{}; p1 = f32x16{};
#pragma unroll
  for (int s = 0; s < 3; ++s) { const char* a = Ks + koff + 64 * s;
    const i32x8 b0 = __builtin_shufflevector(*reinterpret_cast<const i32x4*>(a), *reinterpret_cast<const i32x4*>(a + 16), 0, 1, 2, 3, 4, 5, 6, 7);
    const i32x8 b1 = __builtin_shufflevector(*reinterpret_cast<const i32x4*>(a + 32 * KP), *reinterpret_cast<const i32x4*>(a + 32 * KP + 16), 0, 1, 2, 3, 4, 5, 6, 7);
    p0 = __builtin_amdgcn_mfma_scale_f32_32x32x64_f8f6f4(b0, q8[s], p0, 0, 0, 0, 0, 0, 0);
    p1 = __builtin_amdgcn_mfma_scale_f32_32x32x64_f8f6f4(b1, q8[s], p1, 0, 0, 0, 0, 0, 0); }
}
__device__ __forceinline__ int v_st(int k, int c) { const int kk = (k & ~0xC) | ((k & 4) << 1) | ((k & 8) >> 1); return ((kk >> 3) * 4 + (c >> 5)) * 512 + ((kk & 7) * 32 + (c & 31)) * 2; }
__device__ __forceinline__ int v_rd_base(int lane) { return ((lane & 3) << 3) | (((lane >> 2) & 3) << 6) | (((lane >> 4) & 1) << 5) | (((lane >> 5) & 1) << 8); }
constexpr int v_rd_off(int d0, int ks, int half) { return d0 * 512 + ks * 4096 + half * 2048; }
template <int OFF> __device__ __forceinline__ s16x4 tr_read(int vb) {
  s16x4 r; asm volatile("ds_read_b64_tr_b16 %0, %1 offset:%2" : "=&v"(r) : "v"(vb), "i"(OFF) : "memory"); return r;
}
template <int D0> __device__ __forceinline__ void pv_one(f32x16& od, const char* vb, const i32x8& pa) {
  const i32x8 v = __builtin_shufflevector(*reinterpret_cast<const i32x4*>(vb + D0 * 32 * VP), *reinterpret_cast<const i32x4*>(vb + D0 * 32 * VP + 16), 0, 1, 2, 3, 4, 5, 6, 7);
  od = __builtin_amdgcn_mfma_scale_f32_32x32x64_f8f6f4(pa, v, od, 0, 0, 0, 0, 0, 0);
}
__device__ __forceinline__ void pv_d0(f32x16* o, const char* vb, const i32x8& pa) {
  pv_one<0>(o[0], vb, pa); pv_one<1>(o[1], vb, pa); pv_one<2>(o[2], vb, pa); pv_one<3>(o[3], vb, pa);
}

__device__ __forceinline__ void attn_unit(const bf16_t* __restrict__ Qg, const bf16_t* __restrict__ KVb, const unsigned char* __restrict__ VT8, const bf16_t* __restrict__ KPE, bf16_t* __restrict__ Og, const float* __restrict__ ROPE,
                                          int qrow0, int qt0, int h, int crow0, int lrow0, int NT, char* lds) {
  const int tid = opaque_tid(), wid = tid >> 6, lane = tid & 63, r32 = lane & 31, hi = lane >> 5;
  char* V_lds = lds; char* K_lds = lds + 2 * SHM_V;
  float* ws = (float*)(lds + 2 * SHM_V + 2 * SHM_K) + wid * 64; float* li_l = ws; float* al_l = ws + 32;
  float m_reg = -1e30f, l_reg = 0; f32x16 o[4] = {}; i32x8 q8[3];
  { const unsigned char* Q8w = (const unsigned char*)Qg + (size_t)(qrow0 + wid * QBLK + r32) * 1024 + h * 128 + 32 * hi;
#pragma unroll
    for (int s = 0; s < 2; ++s) q8[s] = __builtin_shufflevector(*reinterpret_cast<const i32x4*>(Q8w + 64 * s), *reinterpret_cast<const i32x4*>(Q8w + 64 * s + 16), 0, 1, 2, 3, 4, 5, 6, 7); }
  const bf16_t* Qw = (const bf16_t*)((const unsigned char*)Qg + (size_t)NROWS * 1024) + (size_t)(qrow0 + wid * QBLK + r32) * 512 + h * 64 + hi * 8 - 128;
  { u32x2 c[4];
#pragma unroll
    for (int d0 = 8; d0 < 12; ++d0) {
      const u32x4 qv = *reinterpret_cast<const u32x4*>(Qw + d0 * 16);
      f32x4 ca = {1.f, 0.f, 1.f, 0.f}, cb = {1.f, 0.f, 1.f, 0.f};
      if (qt0 >= 0) { const float* cs = ROPE + ((size_t)(qt0 + wid * QBLK + r32) * 32 + 8 * (d0 - 8) + 4 * hi) * 2; ca = *(const f32x4*)cs; cb = *(const f32x4*)(cs + 4); }
      float x0, x1; int a, b;
      x0 = bf_lo(qv.x); x1 = bf_hi(qv.x); a = __builtin_amdgcn_cvt_pk_fp8_f32(x0 * ca[0] - x1 * ca[1], x0 * ca[1] + x1 * ca[0], 0, false);
      x0 = bf_lo(qv.y); x1 = bf_hi(qv.y); a = __builtin_amdgcn_cvt_pk_fp8_f32(x0 * ca[2] - x1 * ca[3], x0 * ca[3] + x1 * ca[2], a, true);
      x0 = bf_lo(qv.z); x1 = bf_hi(qv.z); b = __builtin_amdgcn_cvt_pk_fp8_f32(x0 * cb[0] - x1 * cb[1], x0 * cb[1] + x1 * cb[0], 0, false);
      x0 = bf_lo(qv.w); x1 = bf_hi(qv.w); b = __builtin_amdgcn_cvt_pk_fp8_f32(x0 * cb[2] - x1 * cb[3], x0 * cb[3] + x1 * cb[2], b, true);
      c[d0 - 8] = (u32x2){(unsigned)a, (unsigned)b}; }
    q8[2] = (i32x8){(int)c[0].x, (int)c[0].y, (int)c[1].x, (int)c[1].y, (int)c[2].x, (int)c[2].y, (int)c[3].x, (int)c[3].y}; }
  const int koff = r32 * KP + 32 * hi;
  const int pr = tid >> 3, pc = tid & 7, prt = 16 * (pr & 3) + (pr >> 2);
  const int vrow = tid >> 2, vpc = (tid & 3) * 16;
  const int kst = pr * KP + 16 * pc, pst = pr * KP + 128 + 8 * pc;
  const char* vb0 = V_lds + r32 * VP + 32 * hi;
  u32x4 vs0, ks0; u32x2 kp;
#define TROW(j) ((j) < 4 ? crow0 + 64 * (j) : lrow0 + 64 * ((j) - 4))
#define SLOAD(j) do { const int k0_ = TROW(j); \
    vs0 = *reinterpret_cast<const u32x4*>(VT8 + ((size_t)((k0_ >> 6) * 8 + h) * DV + vrow) * 64 + vpc); \
    ks0 = *reinterpret_cast<const u32x4*>((const unsigned char*)KVb + (size_t)(k0_ + prt) * 1024 + h * 128 + 16 * pc); } while (0)
#define PLOAD(j) do { kp = *reinterpret_cast<const u32x2*>((const unsigned char*)KPE + (size_t)(TROW(j) + prt) * 64 + 8 * pc); } while (0)
#define SWRITE(b) do { *(u32x4*)(V_lds + (b) * SHM_V + vrow * VP + vpc) = vs0; \
    *(u32x4*)(K_lds + (b) * SHM_K + kst) = ks0; *(u32x2*)(K_lds + (b) * SHM_K + pst) = kp; } while (0)
#define SWAIT() asm volatile("s_waitcnt vmcnt(0)" ::: "memory")
#define RESC(a) do { if (__any((a) < 1.f)) { if (hi == 0) al_l[r32] = (a); asm volatile("s_waitcnt lgkmcnt(0)" ::: "memory"); \
    _Pragma("unroll") for (int d = 0; d < 4; ++d) _Pragma("unroll") for (int r = 0; r < 16; ++r) o[d][r] *= al_l[crow(r, hi)]; } } while (0)
  f32x16 pA0, pA1, pB0, pB1; float mnA, mnB, alA, alB; i32x8 pa;
  SLOAD(0); PLOAD(0); SWAIT(); SWRITE(0); __syncthreads();
  qkt(pA0, pA1, K_lds, q8, koff); partialSM(pA0, pA1, m_reg, mnA, alA);
  SLOAD(1); PLOAD(1);
  SWAIT(); SWRITE(1); __syncthreads();
  for (int j = 1; j + 1 < NT; j += 2) {
    SLOAD(j + 1); SBAR();
    qkt(pB0, pB1, K_lds + SHM_K, q8, koff);
    finishSM(pA0, pA1, alA, l_reg, pa);
    PLOAD(j + 1);
    pv_d0(o, vb0, pa); partialSM(pB0, pB1, m_reg, mnB, alB);
    __syncthreads(); SWAIT(); SWRITE(0);
    RESC(alB); __syncthreads();
    SLOAD(j + 2); SBAR();
    qkt(pA0, pA1, K_lds, q8, koff);
    finishSM(pB0, pB1, alB, l_reg, pa);
    PLOAD(j + 2);
    pv_d0(o, vb0 + SHM_V, pa); partialSM(pA0, pA1, m_reg, mnA, alA);
    __syncthreads(); SWAIT(); SWRITE(1);
    RESC(alA); __syncthreads();
  }
  SBAR(); qkt(pB0, pB1, K_lds + SHM_K, q8, koff);
  finishSM(pA0, pA1, alA, l_reg, pa); SBAR();
  pv_d0(o, vb0, pa); partialSM(pB0, pB1, m_reg, mnB, alB);
  __syncthreads(); RESC(alB);
  finishSM(pB0, pB1, alB, l_reg, pa); SBAR();
  pv_d0(o, vb0 + SHM_V, pa);
  if (hi == 0) li_l[r32] = l_reg; asm volatile("s_waitcnt lgkmcnt(0)" ::: "memory");
  float rli[16];
#pragma unroll
  for (int r = 0; r < 16; ++r) rli[r] = __builtin_amdgcn_rcpf(li_l[crow(r, hi)]);
  bf16_t* Ow = Og + (size_t)(qrow0 + wid * QBLK) * DM + h * DV;
#pragma unroll
  for (int r = 0; r < 16; ++r) { const int orow = crow(r, hi);
#pragma unroll
    for (int d0 = 0; d0 < 4; ++d0) Ow[(size_t)orow * DM + d0 * 32 + r32] = (bf16_t)(cvtpk(o[d0][r] * rli[r], 0.f) & 0xffffu); }
  __syncthreads();
#undef TROW
#undef SLOAD
#undef PLOAD
#undef SWRITE
#undef SWAIT
#undef RESC
}
#undef SBAR
}
constexpr int NWAVES = 8;
constexpr int RING_BYTES = 131072, LDSCTL_OFF = RING_BYTES, LDS_BYTES = 147456;

struct Args {
    const float* in[31]; float* out; unsigned char* ws; int stage; int pad;
};
struct Frame {
    LAS unsigned char* lds; int vcu, G; unsigned char* ws;
};
constexpr int PTAB_OFF = 131072 + 512;
__device__ __forceinline__ const float* inp(const Frame& F, int i) {
    const LAS unsigned* t = (const LAS unsigned*)(F.lds + PTAB_OFF) + 2 * i;
    const unsigned lo = __builtin_amdgcn_readfirstlane(t[0]), hi = __builtin_amdgcn_readfirstlane(t[1]);
    return (const float*)(GAS const float*)(((unsigned long long)hi << 32) | lo);
}

__device__ __forceinline__ unsigned f2bf(float f) { unsigned u = __float_as_uint(f); return (u + 0x7fffu + ((u >> 16) & 1u)) >> 16; }
__device__ __forceinline__ unsigned pk2(float lo, float hi) { return f2bf(lo) | (f2bf(hi) << 16); }
__device__ __forceinline__ void cvt_item(const float* srcA, const float* srcB, const float* kscale, bf16_t* dst, int ld, int K, int nrows, int nvalid, int mode, int item, LAS float* scr, int lane, bool fp8 = false, float fscale = W18_SCALE, bool kperm = false) {
    const int nblk = nrows >> 5, kb = item / nblk, nb = item - kb * nblk, k0 = 64 * kb, n0 = 32 * nb;
    const float* src = srcA; int col = n0; bool valid = n0 < nvalid;
    if (mode == 1) { const int t = n0 >> 8, r = n0 & 255; src = r < 128 ? srcA : srcB; col = 128 * t + (r & 127); valid = true; }
    const int kk = lane >> 3, n4 = (lane & 7) * 4;
    f32x4 v[8];
    if (valid) {
        int cofs = col + n4;
        if (mode == 2) { const int t = n0 >> 8, L = n0 & 255, bj = L >> 7, wc = (L >> 5) & 3; cofs = 256 * t + 64 * wc + 16 * (n4 >> 3) + 8 * bj + (n4 & 7); }
        if (mode == 4) { const int np = n0 + n4;
            if (np < 1024) { const int p = np & 127; cofs = 192 * (np >> 7) + 64 * (p >> 6) + 16 * ((p >> 3) & 3) + 8 * ((p >> 5) & 1) + (p & 7); }
            else { const int r = np - 1024; cofs = 192 * (r >> 6) + 128 + (r & 63); } }
        if (mode == 3) { const int p = (n0 + n4) & 255;
            if (p < 128) cofs = ((n0 + n4) & ~255) + 64 * (p >> 6) + 16 * ((p >> 3) & 3) + 8 * ((p >> 5) & 1) + (p & 7); }
        const float* sp = src + (size_t)(k0 + kk) * ld + cofs;
        if (kperm) {
#pragma unroll
            for (int i = 0; i < 8; ++i) { const int rho = k0 + kk + 8 * i; v[i] = *(const f32x4*)(src + (size_t)((rho & ~127) + 32 * (rho & 3) + ((rho & 127) >> 2)) * ld + cofs); }
        } else {
#pragma unroll
        for (int i = 0; i < 8; ++i) v[i] = *(const f32x4*)(sp + (size_t)(8 * i) * ld);
        }
        if (kscale) {
#pragma unroll
            for (int i = 0; i < 8; ++i) v[i] = v[i] * kscale[k0 + 8 * i + kk];
        }
    } else {
#pragma unroll
        for (int i = 0; i < 8; ++i) v[i] = (f32x4){0.f, 0.f, 0.f, 0.f};
    }
#pragma unroll
    for (int i = 0; i < 8; ++i) { LAS float* d = scr + (8 * i + kk) * 33 + n4; d[0] = v[i][0]; d[1] = v[i][1]; d[2] = v[i][2]; d[3] = v[i][3]; }
    asm volatile("s_waitcnt lgkmcnt(0)" ::: "memory");
    const int c = lane & 7;
    if (fp8) {
#pragma unroll
        for (int j = 0; j < 4; ++j) { const int n = (lane >> 3) + 8 * j; const LAS float* s = scr + (8 * c) * 33 + n;
            u32x2 o; o.x = fp8_pack4_s((f32x4){s[0 * 33], s[1 * 33], s[2 * 33], s[3 * 33]}, fscale); o.y = fp8_pack4_s((f32x4){s[4 * 33], s[5 * 33], s[6 * 33], s[7 * 33]}, fscale);
            *(u32x2*)((unsigned char*)dst + (size_t)(n0 + n) * K + k0 + 8 * c) = o; }
    } else {
#pragma unroll
    for (int j = 0; j < 4; ++j) { const int n = (lane >> 3) + 8 * j; const LAS float* s = scr + (8 * c) * 33 + n;
        u32x4 o; o.x = cvt_pk_bf16(s[0 * 33], s[1 * 33]); o.y = cvt_pk_bf16(s[2 * 33], s[3 * 33]); o.z = cvt_pk_bf16(s[4 * 33], s[5 * 33]); o.w = cvt_pk_bf16(s[6 * 33], s[7 * 33]);
        *(u32x4*)(dst + (size_t)(n0 + n) * K + k0 + 8 * c) = o; }
    }
    asm volatile("s_waitcnt lgkmcnt(0)" ::: "memory");
}
constexpr int N_SMALL_JOBS = 11;
__device__ __forceinline__ void convert_small(const Args& a, Frame& F) {
    unsigned char* const wsl = opaque_ptr(a.ws);
    const int tid_ = opaque_tid(), lane_ = tid_ & 63, wave_ = __builtin_amdgcn_readfirstlane(tid_ >> 6);
    LAS float* scr = (LAS float*)(F.lds + wave_ * 16384);
    const int gw = F.vcu * NWAVES + wave_, NGW = F.G * NWAVES;
    unsigned char* ws = wsl;
    int base = 0;
#define SMALL_JOB9(SA, SB, KS, DST, LD, KK, NR, NV, MODE, F8, FS, KP) do { const int n_ = ((KK) >> 6) * ((NR) >> 5); const int first_ = ((gw - base) % NGW + NGW) % NGW; \
        for (int it = first_; it < n_; it += NGW) cvt_item(SA, SB, KS, DST, LD, KK, NR, NV, MODE, it, scr, lane_, F8, FS, KP); base += n_; } while (0)
#define SMALL_JOB8(SA, SB, KS, DST, LD, KK, NR, NV, MODE, F8, FS) SMALL_JOB9(SA, SB, KS, DST, LD, KK, NR, NV, MODE, F8, FS, false)
#define SMALL_JOB(SA, SB, KS, DST, LD, KK, NR, NV, MODE) SMALL_JOB8(SA, SB, KS, DST, LD, KK, NR, NV, MODE, false, 1.f)
    SMALL_JOB8(inp(F, 7), nullptr, nullptr, (bf16_t*)(ws + WS_WDQKV), 704, 1024, 768, 704, 0, FP8_DQKV, WD8_SCALE);
    SMALL_JOB(inp(F, 10), nullptr, inp(F, 8), (bf16_t*)(ws + WS_WUQ), 1536, 384, 1536, 1536, 4);
    SMALL_JOB(inp(F, 11), nullptr, inp(F, 9), (bf16_t*)(ws + WS_WUKV), 2048, 256, 2048, 2048, 3);
    SMALL_JOB9(inp(F, 12), nullptr, nullptr, (bf16_t*)(ws + WS_WO), 1024, 1024, 1024, 1024, 0, FP8_WO, WO8_SCALE, FP8_WO);
    SMALL_JOB8(inp(F, 21), inp(F, 21) + 1024, nullptr, (bf16_t*)(ws + WS_WGLU), 2048, 1024, 2048, 2048, 1, FP8_GLU, WG8_SCALE);
#pragma unroll 1
    for (int l = 0; l < 2; ++l) {
        if (FP8_SH) {
            SMALL_JOB8(inp(F, 28) + (size_t)l * 1024 * 256, inp(F, 29) + (size_t)l * 1024 * 256, nullptr, (bf16_t*)(ws + WS_WSHR + (size_t)l * 512 * 1024), 256, 1024, 512, 512, 1, true, W18_SCALE);
            SMALL_JOB(inp(F, 23) + (size_t)l * 1024 * 64, nullptr, nullptr, (bf16_t*)(ws + WS_WSHR + MiB + (size_t)l * 512 * 1024), 64, 1024, 256, 64, 0);
            if (FP8_SHD) SMALL_JOB8(inp(F, 30) + (size_t)l * 256 * 1024, nullptr, nullptr, (bf16_t*)(ws + WS_WSHD + (size_t)l * 256 * 1024), 1024, 256, 1024, 1024, 2, true, W28_SCALE);
            else SMALL_JOB(inp(F, 30) + (size_t)l * 256 * 1024, nullptr, nullptr, (bf16_t*)(ws + WS_WSHD) + (size_t)l * 1024 * 256, 1024, 256, 1024, 1024, 2);
        } else {
        SMALL_JOB(inp(F, 28) + (size_t)l * 1024 * 256, inp(F, 29) + (size_t)l * 1024 * 256, nullptr, (bf16_t*)(ws + WS_WSHR) + (size_t)l * 768 * 1024, 256, 1024, 512, 512, 1);
        SMALL_JOB(inp(F, 23) + (size_t)l * 1024 * 64, nullptr, nullptr, (bf16_t*)(ws + WS_WSHR) + (size_t)l * 768 * 1024 + (size_t)512 * 1024, 64, 1024, 256, 64, 0);
        SMALL_JOB(inp(F, 30) + (size_t)l * 256 * 1024, nullptr, nullptr, (bf16_t*)(ws + WS_WSHD) + (size_t)l * 1024 * 256, 1024, 256, 1024, 1024, 2);
        }
    }
#undef SMALL_JOB
#undef SMALL_JOB8
#undef SMALL_JOB9
}
__device__ __forceinline__ void convert_experts(const Args& a, Frame& F, int layer, int skip) {
    unsigned char* const wsl = opaque_ptr(a.ws);
    const int tid_ = opaque_tid(), lane_ = tid_ & 63, wave_ = __builtin_amdgcn_readfirstlane(tid_ >> 6);
    LAS float* scr = (LAS float*)(F.lds + wave_ * 16384);
    const int gw = (F.vcu - skip) * NWAVES + wave_, NGW = (F.G - skip) * NWAVES;
    for (int it = gw; it < NEXP * 384; it += NGW) { const int e = it / 384, r = it - e * 384; const size_t eo = ((size_t)layer * NEXP + e) * 1024 * 256;
        if (r < 256) { if ((FP8_G1_LAYERS >> layer) & 1) cvt_item(inp(F, 25) + eo, inp(F, 26) + eo, nullptr, (bf16_t*)(wsl + WS_W1 + (size_t)e * 512 * 1024), 256, 1024, 512, 512, 1, r, scr, lane_, true);
            else cvt_item(inp(F, 25) + eo, inp(F, 26) + eo, nullptr, (bf16_t*)(wsl + WS_W1) + (size_t)e * 512 * 1024, 256, 1024, 512, 512, 1, r, scr, lane_); }
        else if (FP8_G2) cvt_item(inp(F, 27) + eo, nullptr, nullptr, (bf16_t*)(wsl + WS_W2 + (size_t)e * 1024 * 256), 1024, 256, 1024, 1024, 2, r - 256, scr, lane_, true, W28_SCALE);
        else cvt_item(inp(F, 27) + eo, nullptr, nullptr, (bf16_t*)(wsl + WS_W2) + (size_t)e * 1024 * 256, 1024, 256, 1024, 1024, 2, r - 256, scr, lane_); }
}

__device__ __forceinline__ void mod_phase(const Args& a, Frame& F) {
    unsigned char* const wsl = opaque_ptr(a.ws);
    const int tid_ = opaque_tid(), lane_ = tid_ & 63, wave_ = __builtin_amdgcn_readfirstlane(tid_ >> 6);
    LAS float* sl = (LAS float*)F.lds;
    LAS float* red = sl + 17 * 1024;
    float* MOD = (float*)(wsl + WS_MOD);
    bool have = false;
    for (int u = F.vcu; u < 256; u += F.G) {
        if (!have) { for (int i = tid_; i < 17 * 1024; i += 512) { const float v = i < 16 * 1024 ? inp(F, 1)[i] : inp(F, 3)[i - 16 * 1024]; sl[i] = silu_f(v); } __syncthreads(); have = true; }
        const int l = u >> 7, n0 = (u & 127) * 48, kg = tid_ >> 6, cl = (tid_ & 63) < 48 ? (tid_ & 63) : 47, col = n0 + cl;
        const float* W = inp(F, 4) + (size_t)l * 1024 * MODW + col;
        float acc[17];
#pragma unroll
        for (int b = 0; b < 17; ++b) acc[b] = 0.f;
#pragma unroll 2
        for (int k = 128 * kg; k < 128 * kg + 128; k += 4) {
            const float w0 = W[(size_t)k * MODW], w1 = W[(size_t)(k + 1) * MODW], w2 = W[(size_t)(k + 2) * MODW], w3 = W[(size_t)(k + 3) * MODW];
#pragma unroll
            for (int b = 0; b < 17; ++b) { const f32x4 sv = *(const LAS f32x4*)(sl + b * 1024 + k); acc[b] += (sv[0] * w0 + sv[1] * w1) + (sv[2] * w2 + sv[3] * w3); } }
#pragma unroll
        for (int b = 0; b < 17; ++b) red[(kg * 17 + b) * 64 + (tid_ & 63)] = acc[b];
        __syncthreads();
        for (int i = tid_; i < 17 * 64; i += 512) { const int b = i >> 6, c = i & 63; if (c >= 48) continue; float s = inp(F, 5)[(size_t)l * MODW + n0 + c];
#pragma unroll
            for (int g = 0; g < 8; ++g) s += red[(g * 17 + b) * 64 + c];
            MOD[((size_t)l * 17 + b) * MODW + n0 + c] = s; }
        __syncthreads();
    }
}
__device__ __forceinline__ void sincos_red(float ang, float& c, float& s) {
    const float k = rintf(ang * 0.15915494309189535f);
    float r = fmaf(-k, 6.2831854820251465f, ang); r = fmaf(-k, -1.7484555314695172e-07f, r);
    s = __sinf(r); c = __cosf(r);
}
__device__ __forceinline__ void rope_phase(const Args& a, Frame& F) {
    unsigned char* const wsl = opaque_ptr(a.ws);
    const int tid_ = opaque_tid(), lane_ = tid_ & 63, wave_ = __builtin_amdgcn_readfirstlane(tid_ >> 6);
    float* ROPE = (float*)(wsl + WS_ROPE);
    for (int i = (F.vcu * 512 + tid_); i < SEQL * 32; i += F.G * 512) { const int t = i >> 5, p = i & 31, j = p & 15;
        const float f = exp2f(-(float)j * (13.287712379549449f / 16.f)); const float pos = (float)(p < 16 ? (t >> 6) : (t & 63));
        float c, s; sincos_red(pos * f, c, s); ROPE[2 * i] = c; ROPE[2 * i + 1] = s; }
}

__device__ __forceinline__ const float* xrow_in0(const Args& a, const Frame& F, int row) {
    return row < NCTXR ? inp(F, 2) + (size_t)row * DM : inp(F, 0) + (size_t)(row - NCTXR) * DM;
}
__device__ __forceinline__ bf16_t* xrow_bf(const Args& a, int row) {
    unsigned char* const wsl = opaque_ptr(a.ws);
    return row < NCTXR ? (bf16_t*)(wsl + WS_XCTX) + (size_t)row * DM : (bf16_t*)a.out + (size_t)(row - NCTXR) * (2 * DM);
}
__device__ __forceinline__ f32x4 bf4_to_f32(u32x2 w) { return (f32x4){bf_lo(w.x), bf_hi(w.x), bf_lo(w.y), bf_hi(w.y)}; }
__device__ __forceinline__ u32x2 f32_to_bf4(const f32x4& v) { u32x2 w; w.x = cvt_pk_bf16(v[0], v[1]); w.y = cvt_pk_bf16(v[2], v[3]); return w; }
struct NormMod { f32x4 A[4], B[4]; };
__device__ __forceinline__ void normmod_load(NormMod& p, const float* g, const float* shift, const float* scale, int lane) {
#pragma unroll
    for (int j = 0; j < 4; ++j) { const int c = 4 * lane + 256 * j; p.A[j] = *(const f32x4*)(g + c) * (*(const f32x4*)(scale + c) + 1.f); p.B[j] = *(const f32x4*)(shift + c); }
}
__device__ __forceinline__ void norm_mod_store(const f32x4 (&v)[4], const NormMod& p, bf16_t* orow, int lane) {
    float s = 0.f;
#pragma unroll
    for (int j = 0; j < 4; ++j) s += sq4(v[j]);
    const float rstd = __builtin_amdgcn_rsqf(wave_sum(s) * (1.f / DM) + NORM_EPS);
#pragma unroll
    for (int j = 0; j < 4; ++j) { const int c = 4 * lane + 256 * j; const f32x4 h = (v[j] * rstd) * p.A[j] + p.B[j];
        u32x2 w; w.x = cvt_pk_bf16(h[0], h[1]); w.y = cvt_pk_bf16(h[2], h[3]); *(u32x2*)(orow + c) = w; }
}
__device__ __forceinline__ void norm_mod_store8(const f32x4 (&v)[4], const NormMod& p, bf16_t* orow, unsigned char* o8, int lane) {
    float s = 0.f;
#pragma unroll
    for (int j = 0; j < 4; ++j) s += sq4(v[j]);
    const float rstd = __builtin_amdgcn_rsqf(wave_sum(s) * (1.f / DM) + NORM_EPS);
#pragma unroll
    for (int j = 0; j < 4; ++j) { const int c = 4 * lane + 256 * j; const f32x4 h = (v[j] * rstd) * p.A[j] + p.B[j];
        u32x2 w; w.x = cvt_pk_bf16(h[0], h[1]); w.y = cvt_pk_bf16(h[2], h[3]); *(u32x2*)(orow + c) = w; *(unsigned*)(o8 + c) = fp8_pack4_s(h, XN8_SCALE); }
}
__device__ __forceinline__ void norm_mod_store_f8(const f32x4 (&v)[4], const NormMod& p, unsigned char* o8, int lane) {
    float s = 0.f;
#pragma unroll
    for (int j = 0; j < 4; ++j) s += sq4(v[j]);
    const float rstd = __builtin_amdgcn_rsqf(wave_sum(s) * (1.f / DM) + NORM_EPS);
#pragma unroll
    for (int j = 0; j < 4; ++j) { const int c = 4 * lane + 256 * j; const f32x4 h = (v[j] * rstd) * p.A[j] + p.B[j]; *(unsigned*)(o8 + c) = fp8_pack4_s(h, XN8_SCALE); }
}
__device__ __forceinline__ void h_phase(const Args& a, Frame& F, int layer, int row_lo) {
    unsigned char* const wsl = opaque_ptr(a.ws);
    const int tid_ = opaque_tid(), lane_ = tid_ & 63, wave_ = __builtin_amdgcn_readfirstlane(tid_ >> 6);
    const float* MOD = (const float*)(wsl + WS_MOD) + (size_t)layer * 17 * MODW; const float* g = inp(F, 6) + (size_t)(layer * 4 + 0) * DM; bf16_t* XN = (bf16_t*)(wsl + WS_XN);
    const int rpw = (NROWS - row_lo) / (F.G * NWAVES); int row = row_lo + (F.vcu * NWAVES + wave_) * rpw; const int rend = row + rpw;
    f32x4 nx[4]; NormMod nm; int cur_mi = -1;
    if (row < rend) { const float* x = xrow_in0(a, F, row);
#pragma unroll
        for (int j = 0; j < 4; ++j) nx[j] = *(const f32x4*)(x + 4 * lane_ + 256 * j); }
    for (; row < rend; ++row) {
        f32x4 v[4];
#pragma unroll
        for (int j = 0; j < 4; ++j) v[j] = nx[j];
        if (row + 1 < rend) { const float* x = xrow_in0(a, F, row + 1);
#pragma unroll
            for (int j = 0; j < 4; ++j) nx[j] = *(const f32x4*)(x + 4 * lane_ + 256 * j); }
        const int mi = mod_index(row);
        if (mi != cur_mi) { const float* m = MOD + (size_t)mi * MODW; normmod_load(nm, g, m + 0 * DM, m + 1 * DM, lane_); cur_mi = mi; }
        if (FP8_DQKV) norm_mod_store_f8(v, nm, wsl + WS_XN8 + (size_t)row * DM, lane_);
        else norm_mod_store(v, nm, XN + (size_t)row * DM, lane_);
    }
}
__device__ __forceinline__ void postmix_phase(const Args& a, Frame& F, int layer, int row_lo, int NS) {
    unsigned char* const wsl = opaque_ptr(a.ws);
    const int tid_ = opaque_tid(), lane_ = tid_ & 63, wave_ = __builtin_amdgcn_readfirstlane(tid_ >> 6);
    const float* MOD = (const float*)(wsl + WS_MOD) + (size_t)layer * 17 * MODW; const float* g1 = inp(F, 6) + (size_t)(layer * 4 + 1) * DM; const float* g2 = inp(F, 6) + (size_t)(layer * 4 + 2) * DM;
    bf16_t* XN = (bf16_t*)(wsl + WS_XN); const bf16_t* OO = (const bf16_t*)(wsl + WS_OO); const float* SSQO = (const float*)(wsl + WS_SSQO);
    const int rpw = (NROWS - row_lo) / (F.G * NWAVES); int row = row_lo + (F.vcu * NWAVES + wave_) * rpw; const int rend = row + rpw;
    f32x4 nx[4]; u32x2 no[4]; float nss = 0.f; NormMod nm; f32x4 P1[4]; int cur_mi = -1;
#define PM_LOAD(R) do { if (layer == 0) { const float* x_ = xrow_in0(a, F, (R)); _Pragma("unroll") for (int j = 0; j < 4; ++j) nx[j] = *(const f32x4*)(x_ + 4 * lane_ + 256 * j); } \
        else { const bf16_t* x_ = xrow_bf(a, (R)); _Pragma("unroll") for (int j = 0; j < 4; ++j) nx[j] = bf4_to_f32(*(const u32x2*)(x_ + 4 * lane_ + 256 * j)); } \
        _Pragma("unroll") for (int j = 0; j < 4; ++j) { const int c = 4 * lane_ + 256 * j; no[j] = *(const u32x2*)(OO + (size_t)(R) * DM + c); } \
        nss = lane_ < NS ? SSQO[(size_t)(R) * 32 + lane_] : 0.f; } while (0)
    if (row < rend) PM_LOAD(row);
    for (; row < rend; ++row) {
        f32x4 xv[4]; u32x2 ov[4]; float ss = nss;
#pragma unroll
        for (int j = 0; j < 4; ++j) { xv[j] = nx[j]; ov[j] = no[j]; }
        if (row + 1 < rend) PM_LOAD(row + 1);
        const int mi = mod_index(row);
        if (mi != cur_mi) { const float* m = MOD + (size_t)mi * MODW; normmod_load(nm, g2, m + 3 * DM, m + 4 * DM, lane_);
#pragma unroll
            for (int j = 0; j < 4; ++j) { const int c = 4 * lane_ + 256 * j; P1[j] = *(const f32x4*)(g1 + c) * *(const f32x4*)(m + 2 * DM + c); }
            cur_mi = mi; }
        bf16_t* xo = xrow_bf(a, row);
        ss = wave_sum(ss);
        const float rstd = __builtin_amdgcn_rsqf(ss * (1.f / DM) + NORM_EPS);
        f32x4 v[4];
#pragma unroll
        for (int j = 0; j < 4; ++j) { const int c = 4 * lane_ + 256 * j;
            const f32x4 o = {bf_lo(ov[j].x), bf_hi(ov[j].x), bf_lo(ov[j].y), bf_hi(ov[j].y)};
            v[j] = xv[j] + P1[j] * (o * rstd); *(u32x2*)(xo + c) = f32_to_bf4(v[j]); }
        if ((FP8_G1_LAYERS >> layer) & 1) norm_mod_store8(v, nm, XN + (size_t)row * DM, wsl + WS_XN8 + (size_t)row * DM, lane_);
        else norm_mod_store(v, nm, XN + (size_t)row * DM, lane_);
    }
#undef PM_LOAD
}
constexpr size_t WS_Y     = WS_ST;
constexpr size_t WS_H0    = WS_ST + 180 * MiB;
constexpr size_t WS_H1    = WS_ST + 260 * MiB;
constexpr size_t WS_HSH   = WS_ST + 340 * MiB;
constexpr size_t WS_LOG   = WS_H1;
constexpr size_t WS_SELI  = WS_ST + 394 * MiB;
constexpr size_t WS_SELW  = WS_SELI + (size_t)NROWS * 32;
constexpr size_t WS_LDST  = WS_ST + 397 * MiB;
constexpr size_t WS_LW    = WS_LDST + 1536 * 1024;
constexpr size_t WS_BLKCNT= WS_ST + 400 * MiB;
constexpr size_t WS_TINFO = WS_BLKCNT + 256 * 192 * 4;
constexpr int NLIST = 128, YROWS = 5;
static_assert(WS_TINFO + 4 * (512 + 1600) <= WS_END && WS_SELW + (size_t)NROWS * 32 <= WS_LDST && WS_XN8 + 36 * MiB <= WS_SELI && WS_HSH + 18 * MiB <= WS_XN8, "MoE stage map");

template <int NT_, int LDA_, bool PERM_> struct DenseRow0 : DenseBase<NT_, LDA_, PERM_> { int row0; };

struct PolShr : DenseRow0<16, 2048, true> {
    bf16_t* HSH; float* LOG;
    __device__ __forceinline__ void epi(const f32x4 (&acc)[2][2][4][2], const DUnit& u, int wr, int wc, int fr, int fq) const {
#pragma unroll
        for (int ai = 0; ai < 2; ++ai)
#pragma unroll
            for (int m = 0; m < 4; ++m) {
                const int row = row0 + u.pm * 256 + ai * 128 + wr * 64 + m * 16 + fr;
                if (u.pn < 2) {
                    f32x4 h0, h1;
#pragma unroll
                    for (int j = 0; j < 4; ++j) { h0[j] = silu_f(acc[ai][0][m][0][j]) * acc[ai][1][m][0][j]; h1[j] = silu_f(acc[ai][0][m][1][j]) * acc[ai][1][m][1][j]; }
                    store8(HSH + (size_t)row * 256 + u.pn * 128 + wc * 32 + 8 * fq, h0, h1);
                } else if (wc < 2) {
                    float* lp = LOG + (size_t)row * 64 + wc * 32 + 8 * fq; *(f32x4*)lp = acc[ai][0][m][0]; *(f32x4*)(lp + 4) = acc[ai][0][m][1];
                }
            }
    }
};

struct PolShr8 : DenseRow0<8, 1024, true> {
    static constexpr bool FP8 = true;
    unsigned char* HSH;
    __device__ __forceinline__ void epi(const f32x4 (&acc)[2][2][4][2], const DUnit& u, int wr, int wc, int fr, int fq) const {
#pragma unroll
        for (int ai = 0; ai < 2; ++ai)
#pragma unroll
            for (int m = 0; m < 4; ++m) {
                const int row = row0 + u.pm * 256 + ai * 128 + wr * 64 + m * 16 + fr;
                f32x4 h0, h1;
#pragma unroll
                for (int j = 0; j < 4; ++j) { h0[j] = silu_f(acc[ai][0][m][0][j] * G1_DESCALE) * (acc[ai][1][m][0][j] * G1_DESCALE); h1[j] = silu_f(acc[ai][0][m][1][j] * G1_DESCALE) * (acc[ai][1][m][1][j] * G1_DESCALE); }
                if (FP8_SHD) { u32x2 q; q.x = fp8_pack4_s(h0, H8_SCALE); q.y = fp8_pack4_s(h1, H8_SCALE); *(u32x2*)(HSH + (size_t)row * 256 + u.pn * 128 + wc * 32 + 8 * fq) = q; }
                else store8((bf16_t*)HSH + (size_t)row * 256 + u.pn * 128 + wc * 32 + 8 * fq, h0, h1);
            }
    }
};
struct PolRtr : DenseRow0<16, 2048, true> {
    static constexpr bool NOB1 = true;
    float* LOG;
    __device__ __forceinline__ void epi(const f32x4 (&acc)[2][2][4][2], const DUnit& u, int wr, int wc, int fr, int fq) const {
        if (wc >= 2) return;
#pragma unroll
        for (int ai = 0; ai < 2; ++ai)
#pragma unroll
            for (int m = 0; m < 4; ++m) {
                const int row = row0 + u.pm * 256 + ai * 128 + wr * 64 + m * 16 + fr;
                float* lp = LOG + (size_t)row * 64 + wc * 32 + 8 * fq; *(f32x4*)lp = acc[ai][0][m][0]; *(f32x4*)(lp + 4) = acc[ai][0][m][1];
            }
    }
};
__device__ __forceinline__ float grp8_max(float v) {
    v = fmaxf(v, __int_as_float(__builtin_amdgcn_update_dpp(__float_as_int(v), __float_as_int(v), 0xB1, 0xf, 0xf, false)));
    v = fmaxf(v, __int_as_float(__builtin_amdgcn_update_dpp(__float_as_int(v), __float_as_int(v), 0x4E, 0xf, 0xf, false)));
    v = fmaxf(v, __int_as_float(__builtin_amdgcn_update_dpp(__float_as_int(v), __float_as_int(v), 0x141, 0xf, 0xf, false)));
    return v;
}
__device__ __forceinline__ float wave_sum_dpp(float v) {
    v += __int_as_float(__builtin_amdgcn_update_dpp(0, __float_as_int(v), 0xB1, 0xf, 0xf, false));
    v += __int_as_float(__builtin_amdgcn_update_dpp(0, __float_as_int(v), 0x4E, 0xf, 0xf, false));
    v += __int_as_float(__builtin_amdgcn_update_dpp(0, __float_as_int(v), 0x141, 0xf, 0xf, false));
    v += __int_as_float(__builtin_amdgcn_update_dpp(0, __float_as_int(v), 0x140, 0xf, 0xf, false));
    const float a = __int_as_float(__builtin_amdgcn_readlane(__float_as_int(v), 0)), b = __int_as_float(__builtin_amdgcn_readlane(__float_as_int(v), 16));
    const float c = __int_as_float(__builtin_amdgcn_readlane(__float_as_int(v), 32)), d = __int_as_float(__builtin_amdgcn_readlane(__float_as_int(v), 48));
    return (a + b) + (c + d);
}
__device__ __forceinline__ float wave_max(float v) {
    v = fmaxf(v, __int_as_float(__builtin_amdgcn_update_dpp(__float_as_int(v), __float_as_int(v), 0xB1, 0xf, 0xf, false)));
    v = fmaxf(v, __int_as_float(__builtin_amdgcn_update_dpp(__float_as_int(v), __float_as_int(v), 0x4E, 0xf, 0xf, false)));
    v = fmaxf(v, __int_as_float(__builtin_amdgcn_update_dpp(__float_as_int(v), __float_as_int(v), 0x141, 0xf, 0xf, false)));
    v = fmaxf(v, __int_as_float(__builtin_amdgcn_update_dpp(__float_as_int(v), __float_as_int(v), 0x140, 0xf, 0xf, false)));
    const float a = __int_as_float(__builtin_amdgcn_readlane(__float_as_int(v), 0)), b = __int_as_float(__builtin_amdgcn_readlane(__float_as_int(v), 16));
    const float c = __int_as_float(__builtin_amdgcn_readlane(__float_as_int(v), 32)), d = __int_as_float(__builtin_amdgcn_readlane(__float_as_int(v), 48));
    return fmaxf(fmaxf(a, b), fmaxf(c, d));
}
__device__ __forceinline__ int slot_round(int s) { return s >> 2; }
__device__ __forceinline__ int slot_yrow(int s) { return (s & 3) + 1; }
__device__ __forceinline__ void route_one(float lg, float bias, int lane, int& rank_o, bool& sel_o, float& w_o) {
    const float sc = sigmoid_f(lg), bs = sc + bias;
    float m1 = bs;
    m1 = grp8_max(m1);
    const unsigned long long eqm = __ballot(bs == m1);
    const int grp = lane >> 3; const unsigned gm = (unsigned)((eqm >> (grp * 8)) & 0xffull);
    float v2 = (bs == m1) ? -INFINITY : bs;
    v2 = grp8_max(v2);
    const float m2 = (__popc(gm) >= 2) ? m1 : v2;
    const float gs = m1 + m2;
    int grank = 0;
#pragma unroll
    for (int j = 0; j < 8; ++j) { const float o = __int_as_float(__builtin_amdgcn_readlane(__float_as_int(gs), j * 8)); grank += (o > gs || (o == gs && j < grp)) ? 1 : 0; }
    const float mv = grank < 4 ? bs : -INFINITY;
    int rank = TOPK; float cur = mv;
#pragma unroll
    for (int it = 0; it < TOPK; ++it) {
        const float m = wave_max(cur);
        const unsigned long long hit = __ballot(cur == m);
        const int jl = __ffsll((long long)hit) - 1;
        if (lane == jl) { rank = it; cur = -INFINITY; }
    }
    const bool sel = rank < TOPK && grank < 4;
    const float ssum = wave_sum_dpp(sel ? sc : 0.f);
    rank_o = rank; sel_o = sel; w_o = sc / ssum * 2.5f;
}
__device__ __forceinline__ void route_phase(const Args& a, Frame& F, int layer, int row_lo, int tpb) {
    unsigned char* const wsl = opaque_ptr(a.ws);
    const int tid_ = opaque_tid(), lane = tid_ & 63, wave = __builtin_amdgcn_readfirstlane(tid_ >> 6);
    LAS int* cnt = (LAS int*)F.lds;
    for (int i = tid_; i < NLIST; i += 512) cnt[i] = 0;
    __syncthreads();
    const float* LOG = (const float*)(wsl + WS_LOG); int* SELI = (int*)(wsl + WS_SELI); float* SELW = (float*)(wsl + WS_SELW);
    const float bias = inp(F, 24)[layer * NEXP + lane];
    const int blk = F.vcu;
    const int rbase = row_lo + blk * tpb;
    float lgA_n = LOG[(size_t)(rbase + wave) * 64 + lane], lgB_n = LOG[(size_t)(rbase + (wave + NWAVES < tpb ? wave + NWAVES : wave)) * 64 + lane];
    for (int t = wave; t < tpb; t += 2 * NWAVES) {
        const bool hasB = t + NWAVES < tpb;
        const int rowA = rbase + t, rowB = rbase + (hasB ? t + NWAVES : t);
        const float lgA = lgA_n, lgB = lgB_n;
        if (t + 2 * NWAVES < tpb) { lgA_n = LOG[(size_t)(rowA + 2 * NWAVES) * 64 + lane]; lgB_n = LOG[(size_t)(rbase + (t + 3 * NWAVES < tpb ? t + 3 * NWAVES : t + 2 * NWAVES)) * 64 + lane]; }
        int rkA, rkB; bool selA, selB; float wA, wB;
        route_one(lgA, bias, lane, rkA, selA, wA); route_one(lgB, bias, lane, rkB, selB, wB);
        if (selA) { const int s = rkA, l = slot_round(s) * 64 + lane;
            SELI[(size_t)rowA * 8 + s] = l | (slot_yrow(s) << 8); SELW[(size_t)rowA * 8 + s] = wA;
            atomicAdd((int*)&cnt[l], 1); }
        if (selB && hasB) { const int s = rkB, l = slot_round(s) * 64 + lane;
            SELI[(size_t)rowB * 8 + s] = l | (slot_yrow(s) << 8); SELW[(size_t)rowB * 8 + s] = wB;
            atomicAdd((int*)&cnt[l], 1); }
    }
    __syncthreads();
    int* BLKCNT = (int*)(wsl + WS_BLKCNT);
    for (int i = tid_; i < NLIST; i += 512) BLKCNT[blk * NLIST + i] = cnt[i];
}
__device__ __forceinline__ void place_phase(const Args& a, Frame& F, int row_lo, int tpb) {
    unsigned char* const wsl = opaque_ptr(a.ws);
    const int tid_ = opaque_tid();
    LAS int* tot = (LAS int*)F.lds; LAS int* mine = tot + 256; LAS int* tst = mine + 256; LAS int* cur = tst + 256;
    const int* BLKCNT = (const int*)(wsl + WS_BLKCNT); const int blk = F.vcu;
    if (tid_ < 256) { tot[tid_] = 0; mine[tid_] = 0; cur[tid_] = 0; }
    __syncthreads();
    if (tid_ < 2 * NLIST) { const int l = tid_ % NLIST, b0 = (tid_ / NLIST) * 128; int s = 0, m = 0;
#pragma unroll 16
        for (int b = b0; b < b0 + 128; ++b) { const int c = (b < F.G) ? BLKCNT[b * NLIST + l] : 0; m += (b < blk) ? c : 0; s += c; }
        atomicAdd((int*)&tot[l], s); atomicAdd((int*)&mine[l], m); }
    __syncthreads();
    if (tid_ == 0) { int acc = 0; for (int l = 0; l < NLIST; ++l) { tst[l] = acc; acc += (tot[l] + 255) >> 8; } tst[NLIST] = acc; }
    __syncthreads();
    int* TINFO = (int*)(wsl + WS_TINFO); int* LDST = (int*)(wsl + WS_LDST); float* LW = (float*)(wsl + WS_LW);
    if (blk == 0) {
        for (int i = tid_; i <= NLIST; i += 512) TINFO[i] = tst[i];
        for (int i = tid_; i < NLIST; i += 512) TINFO[256 + i] = tot[i];
        const int lane = tid_ & 63, wv = tid_ >> 6;
        for (int l = wv; l < NLIST; l += NWAVES) { const int t0 = tst[l], t1 = tst[l + 1];
            for (int t = t0 + lane; t < t1; t += 64) TINFO[512 + t] = l;
            const int c = tot[l], base = t0 * 256;
            for (int p = c + lane; p < (t1 - t0) * 256; p += 64) LDST[base + p] = -1; }
    }
    const int* SELI = (const int*)(wsl + WS_SELI); const float* SELW = (const float*)(wsl + WS_SELW);
    for (int i = tid_; i < tpb * 8; i += 512) { const int row = row_lo + blk * tpb + (i >> 3), s = i & 7;
        const int v = SELI[(size_t)row * 8 + s], l = v & 0xff, yr = v >> 8;
        const int pos = tst[l] * 256 + mine[l] + atomicAdd((int*)&cur[l], 1);
        LDST[pos] = row * YROWS + yr; LW[pos] = SELW[(size_t)row * 8 + s]; }
}

struct MUnit { int T, pn; };
struct PolMoe1 {
    static constexpr bool PERM = true, GATHER = true, TWOSEG = false, HOOK = false;
    static constexpr int NT = 16, KT0 = 16, KS0 = 128, KS1 = 128, LDB = 2048;
    typedef MUnit Unit;
    const char* XN; const char* W1; bf16_t* H; const int* TINFO; const int* LDST; int T0, T1, G, c;
    __device__ __forceinline__ bool next(int i, Unit& u) const { const int L = i * G + c; u.T = T0 + (L >> 1); u.pn = L & 1; return u.T < T1; }
    __device__ __forceinline__ void ctx(const Unit& u, pg8::UCtx<true>& x, const int (&R)[2], const int (&C)[2]) const {
        const int e = __builtin_amdgcn_readfirstlane(TINFO[512 + u.T]) & 63;
        x.a0[0] = XN; x.a0[1] = XN; x.a1[0] = XN; x.a1[1] = XN; x.b = W1 + ((size_t)e * 512 + u.pn * 256) * LDB;
#pragma unroll
        for (int h = 0; h < 2; ++h)
#pragma unroll
            for (int i = 0; i < 2; ++i) { const int d = LDST[u.T * 256 + h * 128 + R[i]]; const int tok = d < 0 ? 0 : d / YROWS; x.vg[h][i] = (unsigned)tok * 2048u + (unsigned)C[i] * 2u; }
    }
    __device__ __forceinline__ unsigned lane_a0(int, int) const { return 0u; }
    __device__ __forceinline__ unsigned goff(unsigned raw, int C) const { const int d = (int)raw; const unsigned tok = d < 0 ? 0u : (unsigned)d / 3u; return tok * 2048u + (unsigned)C * 2u; }
    __device__ __forceinline__ void epi(const f32x4 (&acc)[2][2][4][2], const Unit& u, int wr, int wc, int fr, int fq) const {
#pragma unroll
        for (int ai = 0; ai < 2; ++ai)
#pragma unroll
            for (int m = 0; m < 4; ++m) {
                const int hrow = (u.T - T0) * 256 + ai * 128 + wr * 64 + m * 16 + fr;
                f32x4 h0, h1;
#pragma unroll
                for (int j = 0; j < 4; ++j) { h0[j] = silu_f(acc[ai][0][m][0][j]) * acc[ai][1][m][0][j]; h1[j] = silu_f(acc[ai][0][m][1][j]) * acc[ai][1][m][1][j]; }
                store8(H + (size_t)hrow * 256 + u.pn * 128 + wc * 32 + 8 * fq, h0, h1);
            }
    }
};
struct PolMoe1F {
    static constexpr bool PERM = true, GATHER = true, TWOSEG = false, HOOK = false, FP8 = true;
    static constexpr int NT = 8, KT0 = 8, KS0 = 128, KS1 = 128, LDB = 1024;
    typedef MUnit Unit;
    const char* XN; const char* W1; bf16_t* H; const int* TINFO; const int* LDST; int T0, T1, G, c;
    __device__ __forceinline__ bool next(int i, Unit& u) const { const int L = i * G + c; u.T = T0 + (L >> 1); u.pn = L & 1; return u.T < T1; }
    __device__ __forceinline__ void ctx(const Unit& u, pg8::UCtx<true>& x, const int (&R)[2], const int (&C)[2]) const {
        const int e = __builtin_amdgcn_readfirstlane(TINFO[512 + u.T]) & 63;
        x.a0[0] = XN; x.a0[1] = XN; x.a1[0] = XN; x.a1[1] = XN; x.b = W1 + ((size_t)e * 512 + u.pn * 256) * LDB;
#pragma unroll
        for (int h = 0; h < 2; ++h)
#pragma unroll
            for (int i = 0; i < 2; ++i) { const int d = LDST[u.T * 256 + h * 128 + R[i]]; const int tok = d < 0 ? 0 : d / YROWS; x.vg[h][i] = (unsigned)tok * 1024u + (unsigned)C[i] * 2u; }
    }
    __device__ __forceinline__ unsigned lane_a0(int, int) const { return 0u; }
    __device__ __forceinline__ void epi(const f32x4 (&acc)[2][2][4][2], const Unit& u, int wr, int wc, int fr, int fq) const {
#pragma unroll
        for (int ai = 0; ai < 2; ++ai)
#pragma unroll
            for (int m = 0; m < 4; ++m) {
                const int hrow = (u.T - T0) * 256 + ai * 128 + wr * 64 + m * 16 + fr;
                f32x4 h0, h1;
#pragma unroll
                for (int j = 0; j < 4; ++j) { h0[j] = silu_f(acc[ai][0][m][0][j] * G1_DESCALE) * (acc[ai][1][m][0][j] * G1_DESCALE); h1[j] = silu_f(acc[ai][0][m][1][j] * G1_DESCALE) * (acc[ai][1][m][1][j] * G1_DESCALE); }
                if (FP8_G2) { u32x2 q; q.x = fp8_pack4_s(h0, H8_SCALE); q.y = fp8_pack4_s(h1, H8_SCALE); *(u32x2*)((unsigned char*)H + (size_t)hrow * 256 + u.pn * 128 + wc * 32 + 8 * fq) = q; }
                else store8(H + (size_t)hrow * 256 + u.pn * 128 + wc * 32 + 8 * fq, h0, h1);
            }
    }
};
constexpr int IDX_LDS_OFF = 131072 + 2048;
template <bool RMW> struct PolMoe2 {
    static constexpr bool PERM = true, GATHER = false, TWOSEG = false, HOOK = true, FP8 = FP8_G2;
    static constexpr int NT = FP8_G2 ? 2 : 4, KT0 = NT, KS0 = 128, KS1 = 128, LDB = FP8_G2 ? 256 : 512;
    typedef MUnit Unit;
    const char* H; const char* W2; unsigned char* Y; const int* TINFO; const int* LDST; const float* LW; int T0, T1, G, c;
    __device__ __forceinline__ bool next(int i, Unit& u) const { const int L = i * G + c; u.T = T0 + (L >> 2); u.pn = L & 3; return u.T < T1; }
    __device__ __forceinline__ void ctx(const Unit& u, pg8::UCtx<false>& x, const int (&)[2], const int (&)[2]) const {
        const int e = __builtin_amdgcn_readfirstlane(TINFO[512 + u.T]) & 63;
        x.a0[0] = H + (size_t)(u.T - T0) * 256 * LDB; x.a0[1] = x.a0[0] + 128 * LDB; x.a1[0] = x.a0[0]; x.a1[1] = x.a0[1];
        x.b = W2 + ((size_t)e * 1024 + u.pn * 256) * LDB;
    }
    __device__ __forceinline__ unsigned lane_a0(int R, int C) const { return (unsigned)(R * LDB + C * 2); }
    __device__ __forceinline__ void unit_begin(const Unit& u, int ui, LAS unsigned char* lds, int wid, int lane) const {
        const int par = ui & 1, arr = wid >> 2, r0 = (wid & 3) * 64;
        const unsigned* src = (arr == 0 ? (const unsigned*)LDST : (const unsigned*)LW) + (size_t)u.T * 256 + r0 + lane;
        __builtin_amdgcn_global_load_lds(src, (LAS unsigned*)(lds + IDX_LDS_OFF + ((par * 2 + arr) * 256 + r0) * 4), 4, 0, 0);
    }
    __device__ __forceinline__ void epi_h(const f32x4 (&acc)[2][2][4][2], const Unit& u, int ui, LAS unsigned char* lds, int wr, int wc, int fr, int fq) const {
        const LAS int* dl = (const LAS int*)(lds + IDX_LDS_OFF + ((ui & 1) * 2) * 1024); const LAS float* wl = (const LAS float*)(lds + IDX_LDS_OFF + ((ui & 1) * 2 + 1) * 1024);
        const int cofs = u.pn * 256 + wc * 64 + 16 * fq;
        int d[2][4]; float w[2][4];
#pragma unroll
        for (int ai = 0; ai < 2; ++ai)
#pragma unroll
            for (int m = 0; m < 4; ++m) { const int r = ai * 128 + wr * 64 + m * 16 + fr; d[ai][m] = dl[r]; w[ai][m] = wl[r]; }
        u32x4 o[2][4];
        if (RMW) {
#pragma unroll
            for (int ai = 0; ai < 2; ++ai)
#pragma unroll
                for (int m = 0; m < 4; ++m) o[ai][m] = *(const u32x4*)(Y + (size_t)(d[ai][m] < 0 ? 0 : d[ai][m]) * DM + cofs);
        }
#pragma unroll
        for (int ai = 0; ai < 2; ++ai)
#pragma unroll
            for (int m = 0; m < 4; ++m) {
                if (d[ai][m] >= 0) {
                    const float ww = FP8_G2 ? w[ai][m] * G2_DESCALE : w[ai][m];
                    f32x4 v00 = acc[ai][0][m][0] * ww, v01 = acc[ai][0][m][1] * ww, v10 = acc[ai][1][m][0] * ww, v11 = acc[ai][1][m][1] * ww;
                    if (RMW) { v00 += fp8_unpack4(o[ai][m].x); v01 += fp8_unpack4(o[ai][m].y); v10 += fp8_unpack4(o[ai][m].z); v11 += fp8_unpack4(o[ai][m].w); }
                    u32x4 q; q.x = fp8_pack4(v00); q.y = fp8_pack4(v01); q.z = fp8_pack4(v10); q.w = fp8_pack4(v11);
                    *(u32x4*)(Y + (size_t)d[ai][m] * DM + cofs) = q;
                }
            }
    }
};
struct PolShd : DenseRow0<FP8_SHD ? 2 : 4, FP8_SHD ? 256 : 512, true> {
    static constexpr bool FP8 = FP8_SHD;
    unsigned char* Y;
    __device__ __forceinline__ void epi(const f32x4 (&acc)[2][2][4][2], const DUnit& u, int wr, int wc, int fr, int fq) const {
#pragma unroll
        for (int ai = 0; ai < 2; ++ai)
#pragma unroll
            for (int m = 0; m < 4; ++m) {
                const int row = row0 + u.pm * 256 + ai * 128 + wr * 64 + m * 16 + fr;
                unsigned char* yp = Y + (size_t)row * YROWS * DM + u.pn * 256 + wc * 64 + 16 * fq;
                constexpr float ds = FP8_SHD ? G2_DESCALE : 1.f;
                u32x4 q; q.x = fp8_pack4(acc[ai][0][m][0] * ds); q.y = fp8_pack4(acc[ai][0][m][1] * ds); q.z = fp8_pack4(acc[ai][1][m][0] * ds); q.w = fp8_pack4(acc[ai][1][m][1] * ds);
                *(u32x4*)yp = q;
            }
    }
};

__device__ __forceinline__ void combine_phase(const Args& a, Frame& F, int layer, int row_lo) {
    unsigned char* const wsl = opaque_ptr(a.ws);
    const int tid_ = opaque_tid(), lane_ = tid_ & 63, wave_ = __builtin_amdgcn_readfirstlane(tid_ >> 6);
    const float* MOD = (const float*)(wsl + WS_MOD) + (size_t)layer * 17 * MODW; const float* g3 = inp(F, 6) + (size_t)(layer * 4 + 3) * DM;
    const float* MODn = (const float*)(wsl + WS_MOD) + (size_t)1 * 17 * MODW; const float* gn = inp(F, 6) + (size_t)(1 * 4 + 0) * DM;
    bf16_t* XN = (bf16_t*)(wsl + WS_XN); const unsigned char* Y = (const unsigned char*)(wsl + WS_Y);
    const int rpw = (NROWS - row_lo) / (F.G * NWAVES); int row = row_lo + (F.vcu * NWAVES + wave_) * rpw; const int rend = row + rpw;
    f32x4 nx[4]; unsigned ny[4][YROWS]; NormMod nm; f32x4 P3[4]; int cur_mi = -1;
#define CB_LOAD(R) do { const bf16_t* x_ = xrow_bf(a, (R)); \
        _Pragma("unroll") for (int j = 0; j < 4; ++j) { const int c = 4 * lane_ + 256 * j; nx[j] = bf4_to_f32(*(const u32x2*)(x_ + c)); \
            _Pragma("unroll") for (int r = 0; r < YROWS; ++r) ny[j][r] = *(const unsigned*)(Y + ((size_t)(R) * YROWS + r) * DM + c); } } while (0)
    if (row < rend) CB_LOAD(row);
    for (; row < rend; ++row) {
        bf16_t* xo = xrow_bf(a, row);
        f32x4 f[4], xv[4]; float ss = 0.f;
#pragma unroll
        for (int j = 0; j < 4; ++j) { xv[j] = nx[j]; f[j] = (f32x4){0.f, 0.f, 0.f, 0.f};
#pragma unroll
            for (int r = 0; r < YROWS; ++r) f[j] += fp8_unpack4(ny[j][r]);
            ss += sq4(f[j]); }
        if (row + 1 < rend) CB_LOAD(row + 1);
        const int mi = mod_index(row);
        if (mi != cur_mi) { const float* m = MOD + (size_t)mi * MODW;
#pragma unroll
            for (int j = 0; j < 4; ++j) { const int c = 4 * lane_ + 256 * j; P3[j] = *(const f32x4*)(g3 + c) * *(const f32x4*)(m + 5 * DM + c); }
            if (layer == 0) { const float* mn = MODn + (size_t)mi * MODW; normmod_load(nm, gn, mn + 0 * DM, mn + 1 * DM, lane_); }
            cur_mi = mi; }
        const float rstd = __builtin_amdgcn_rsqf(wave_sum(ss) * (1.f / DM) + NORM_EPS);
        f32x4 v[4];
#pragma unroll
        for (int j = 0; j < 4; ++j) { const int c = 4 * lane_ + 256 * j; v[j] = xv[j] + P3[j] * (f[j] * rstd);
            if (layer == 0) *(u32x2*)(xo + c) = f32_to_bf4(v[j]); else *(f32x4*)((float*)xo + c) = v[j]; }
        if (layer == 0) { if (FP8_S5) norm_mod_store_f8(v, nm, wsl + WS_XN8 + (size_t)row * DM, lane_); else norm_mod_store(v, nm, XN + (size_t)row * DM, lane_); }
    }
#undef CB_LOAD
}
constexpr size_t WS_G    = WS_ST;
constexpr size_t WS_BTY  = FP8_S5 ? 49 * MiB : WS_ST + 180 * MiB;
constexpr size_t WS_BTS  = FP8_S5 ? 73 * MiB : WS_ST + 228 * MiB;
constexpr size_t WS_S    = WS_ST + 280 * MiB;
constexpr size_t WS_XIN  = WS_ST + 64 * MiB;
constexpr size_t WS_LAMT = WS_ROPE + 512 * 1024;
constexpr int S5_T = 32;

static_assert(!FP8_S5 || (FP8_G1_LAYERS == 3 && FP8_G2), "the relocated S5 tables use the halves of the weight regions that fp8 expert weights leave free");
constexpr size_t WS_KD   = FP8_S5 ? 97 * MiB : WS_ST + 352 * MiB;
__device__ __forceinline__ f32x2 cmul(f32x2 a, f32x2 b) { return (f32x2){a.x * b.x - a.y * b.y, a.x * b.y + a.y * b.x}; }
__device__ __forceinline__ void s5_tables_unit(const Args& a, Frame& F, int g, int d, int half) {
    unsigned char* const wsl = opaque_ptr(a.ws);
    const int tid = opaque_tid();
    LAS f32x2* pw = (LAS f32x2*)F.lds; LAS f32x2* bb = pw + 33 * 64; LAS f32x2* cm = bb + 64 * 16;
    bf16_t* BTY = (bf16_t*)(wsl + WS_BTY) + (size_t)g * 512 * 768; bf16_t* BTS = (bf16_t*)(wsl + WS_BTS) + (size_t)g * 256 * 512; float* LAMT = (float*)(wsl + WS_LAMT);
    float* KD = (float*)(wsl + WS_KD) + (size_t)(g * 2 + d) * 8192;
    const float* lre = inp(F, 13); const float* lim = inp(F, 14); const float* lst = inp(F, 15);
    const float* bre = inp(F, 16); const float* bim = inp(F, 17); const float* cre = inp(F, 18); const float* cim = inp(F, 19);
    __syncthreads();
    const float step = __expf(lst[d * 64 + g]);
    for (int i = tid; i < 33 * 64; i += 512) { const int k = i >> 6, p = i & 63; const float lr = lre[(d * 64 + g) * 64 + p], li = lim[(d * 64 + g) * 64 + p];
        const float mag = __expf((float)k * lr * step); float c, s; sincos_red((float)k * (li * step), c, s); pw[i] = (f32x2){mag * c, mag * s}; }
    __syncthreads();
    for (int i = tid; i < 64 * 16; i += 512) { const int p = i >> 4; const float lr = lre[(d * 64 + g) * 64 + p], li = lim[(d * 64 + g) * 64 + p];
        const f32x2 lb = pw[64 + p]; const float inv = 1.f / (lr * lr + li * li);
        const f32x2 kap = {((lb.x - 1.f) * lr + lb.y * li) * inv, (lb.y * lr - (lb.x - 1.f) * li) * inv};
        const size_t o = ((size_t)(d * 64 + g) * 64 + p) * 16 + (i & 15); bb[i] = cmul(kap, (f32x2){bre[o], bim[o]}); }
    for (int i = tid; i < 16 * 64; i += 512) { const size_t o = (size_t)(d * 64 + g) * 1024 + i; cm[i] = (f32x2){cre[o], cim[o]}; }
    __syncthreads();
    if (tid < 64 && half == 0) { const f32x2 l32 = pw[32 * 64 + tid]; LAMT[((d * 64 + g) * 64 + tid) * 2] = l32.x; LAMT[((d * 64 + g) * 64 + tid) * 2 + 1] = l32.y; }
    if ((tid >> 8) == half) { const int k = tid >> 4, ib = (tid >> 2) & 3, jb = tid & 3; float acc[4][4];
#pragma unroll
      for (int x = 0; x < 4; ++x)
#pragma unroll
        for (int y = 0; y < 4; ++y) acc[x][y] = 0.f;
      for (int p = 0; p < 64; ++p) { const f32x2 w = pw[k * 64 + p]; f32x2 t[4], b[4];
#pragma unroll
        for (int x = 0; x < 4; ++x) { t[x] = cmul(cm[(4 * ib + x) * 64 + p], w); b[x] = bb[p * 16 + 4 * jb + x]; }
#pragma unroll
        for (int x = 0; x < 4; ++x)
#pragma unroll
            for (int y = 0; y < 4; ++y) acc[x][y] += t[x].x * b[y].x - t[x].y * b[y].y; }
#pragma unroll
      for (int x = 0; x < 4; ++x) *(f32x4*)(KD + k * 256 + (4 * ib + x) * 16 + 4 * jb) = (f32x4){acc[x][0], acc[x][1], acc[x][2], acc[x][3]}; }
    for (int o = half * 256 * 64 + tid; o < (half + 1) * 256 * 64; o += 512) { const int n = o >> 6, p = o & 63, to = n >> 4, i = n & 15;
        const f32x2 w = cmul(cm[i * 64 + p], pw[(d == 0 ? to + 1 : 32 - to) * 64 + p]);
        if (FP8_S5) *(unsigned short*)((unsigned char*)BTY - (size_t)g * 512 * 768 + (size_t)n * 768 + 512 + 128 * d + 2 * p) = (unsigned short)fp8_pack2_s(w.x, -w.y, QY8_SCALE);
        else *(unsigned*)(BTY + (size_t)n * 768 + 512 + 128 * d + 2 * p) = cvt_pk_bf16(w.x, -w.y); }
    for (int o = half * 32 * 256 + tid; o < (half + 1) * 32 * 256; o += 512) { const int p = o >> 8, kk = (o & 255) * 2, ti = kk >> 4, j = kk & 15;
        const f32x2 pwv = pw[(d == 0 ? 31 - ti : ti) * 64 + p]; const f32x2 v0 = cmul(pwv, bb[p * 16 + j]), v1 = cmul(pwv, bb[p * 16 + j + 1]);
        if (FP8_S5) { unsigned char* b8 = (unsigned char*)BTS - (size_t)g * 256 * 512 + (size_t)(128 * d + 2 * p) * 512 + kk;
            *(unsigned short*)b8 = (unsigned short)fp8_pack2_s(v0.x, v1.x, BS8_SCALE); *(unsigned short*)(b8 + 512) = (unsigned short)fp8_pack2_s(v0.y, v1.y, BS8_SCALE); }
        else { *(unsigned*)(BTS + (size_t)(128 * d + 2 * p) * 512 + kk) = cvt_pk_bf16(v0.x, v1.x); *(unsigned*)(BTS + (size_t)(128 * d + 2 * p + 1) * 512 + kk) = cvt_pk_bf16(v0.y, v1.y); } }
    __syncthreads();
}
__device__ __forceinline__ void s5_tables_phase(const Args& a, Frame& F) { for (int u = F.vcu; u < 256; u += F.G) s5_tables_unit(a, F, u >> 2, (u >> 1) & 1, u & 1); }
__device__ __forceinline__ void s5_toeplitz_phase(const Args& a, Frame& F) {
    unsigned char* const wsl = opaque_ptr(a.ws);
    const int tid = opaque_tid(); LAS float* Kd = (LAS float*)F.lds; const float* dsk = inp(F, 20);
    for (int u = F.vcu; u < 256; u += F.G) { const int g = u >> 2, q = u & 3;
        const float* KD = (const float*)(wsl + WS_KD) + (size_t)g * 16384; bf16_t* BTY = (bf16_t*)(wsl + WS_BTY) + (size_t)g * 512 * 768;
        __syncthreads();
        for (int i = tid; i < 4096; i += 512) *(f32x4*)(Kd + 4 * i) = *(const f32x4*)(KD + 4 * i);
        __syncthreads();
        for (int o = tid; o < 128 * 64; o += 512) { const int n = 128 * q + (o >> 6), kk = (o & 63) * 8, to = n >> 4, i = n & 15, ti = kk >> 4, j0 = kk & 15;
            float v[8];
            const LAS float* kf = Kd + (to >= ti ? (to - ti) * 256 : 8192 + (ti - to) * 256) + i * 16 + j0;
#pragma unroll
            for (int e = 0; e < 8; ++e) v[e] = kf[e];
            if (to == ti) {
#pragma unroll
                for (int e = 0; e < 8; ++e) v[e] += Kd[8192 + i * 16 + j0 + e] + (i == j0 + e ? dsk[g * 16 + i] : 0.f); }
            if (FP8_S5) { u32x2 w; w.x = fp8_pack4_s((f32x4){v[0], v[1], v[2], v[3]}, TY8_SCALE); w.y = fp8_pack4_s((f32x4){v[4], v[5], v[6], v[7]}, TY8_SCALE);
                *(u32x2*)((unsigned char*)BTY - (size_t)g * 512 * 768 + (size_t)n * 768 + kk) = w; }
            else { u32x4 w; w.x = cvt_pk_bf16(v[0], v[1]); w.y = cvt_pk_bf16(v[2], v[3]); w.z = cvt_pk_bf16(v[4], v[5]); w.w = cvt_pk_bf16(v[6], v[7]);
            *(u32x4*)(BTY + (size_t)n * 768 + kk) = w; } }
    }
    __syncthreads();
}

struct SUnit { int g, pm, pn; };
struct PolS5S {
    static constexpr bool PERM = true, GATHER = false, TWOSEG = false, HOOK = false, FP8 = FP8_S5;
    static constexpr int NT = FP8_S5 ? 4 : 8, KT0 = NT, KS0 = 8192, KS1 = 128, LDB = FP8_S5 ? 512 : 1024, TB = FP8_S5 ? 1024 : 2048;
    typedef SUnit Unit;
    const char* XN; const char* BTS; bf16_t* S; int G, c;
    __device__ __forceinline__ bool next(int i, Unit& u) const { const int L = i * G + c; u.g = __builtin_amdgcn_readfirstlane(L / 5); u.pm = __builtin_amdgcn_readfirstlane(L % 5); u.pn = 0; return L < 320; }
    __device__ __forceinline__ void ctx(const Unit& u, pg8::UCtx<false>& x, const int (&)[2], const int (&)[2]) const {
        if (u.pm < 4) { x.a0[0] = XN + ((size_t)NCTXR + (size_t)u.pm * 256 * S5_T) * TB + u.g * (TB / 64); x.a0[1] = x.a0[0] + (size_t)128 * S5_T * TB; }
        else { x.a0[0] = XN + u.g * (TB / 64); x.a0[1] = x.a0[0]; }
        x.a1[0] = x.a0[0]; x.a1[1] = x.a0[1]; x.b = BTS + (size_t)u.g * 256 * LDB;
    }
    __device__ __forceinline__ unsigned lane_a0(int R, int C) const { return FP8_S5 ? (unsigned)(R * (S5_T * 1024) + (C >> 3) * 1024 + (C & 7) * 2) : (unsigned)(R * (S5_T * 2048) + (C >> 4) * 2048 + (C & 15) * 2); }
    __device__ __forceinline__ unsigned lane_a1(int, int) const { return 0u; }
    __device__ __forceinline__ void epi(const f32x4 (&acc)[2][2][4][2], const Unit& u, int wr, int wc, int fr, int fq) const {
#pragma unroll
        for (int ai = 0; ai < 2; ++ai) { if (u.pm == 4 && ai == 1) continue;
#pragma unroll
            for (int m = 0; m < 4; ++m) { const int r = u.pm * 256 + ai * 128 + wr * 64 + m * 16 + fr;
                bf16_t* sp = S + ((size_t)u.g * 1152 + r) * 256 + wc * 32 + 8 * fq;
                constexpr float ds = FP8_S5 ? S5S_DESCALE : 1.f;
                store8(sp, acc[ai][0][m][0] * ds, acc[ai][0][m][1] * ds); store8(sp + 128, acc[ai][1][m][0] * ds, acc[ai][1][m][1] * ds); } }
    }
};
__device__ __forceinline__ void s5_scan_phase(const Args& a, Frame& F) {
    unsigned char* const wsl = opaque_ptr(a.ws);
    const int tid = opaque_tid(); const bf16_t* S = (const bf16_t*)(wsl + WS_S); bf16_t* XIN = (bf16_t*)(wsl + WS_XIN); const float* LAMT = (const float*)(wsl + WS_LAMT);
    for (int idx = F.vcu * 512 + tid; idx < 64 * 16 * 2 * 64; idx += F.G * 512) {
        const int p = idx & 63, d = (idx >> 6) & 1, b = (idx >> 7) & 15, g = idx >> 11;
        const f32x2 Lm = *(const f32x2*)(LAMT + ((d * 64 + g) * 64 + p) * 2);
        const bf16_t* Sg = S + (size_t)g * 1152 * 256 + d * 128 + 2 * p; const int col = d * 128 + 2 * p; bf16_t* Xg = XIN + (size_t)(col >> 4) * 1024 + 16 * g + (col & 15); unsigned char* Xg8 = (unsigned char*)XIN + (size_t)(col >> 4) * 1024 + 16 * g + (col & 15);
        f32x2 x = {0.f, 0.f};
        unsigned sv[8];
#pragma unroll
        for (int k = 0; k < 8; ++k) { const int c = d == 0 ? k : 7 - k; sv[k] = *(const unsigned*)(Sg + (size_t)(1024 + b * 8 + c) * 256); }
#pragma unroll
        for (int k = 0; k < 8; ++k) x = cmul(Lm, x) + (f32x2){bf_lo(sv[k]), bf_hi(sv[k])};
        for (int c0 = 0; c0 < 64; c0 += 8) {
#pragma unroll
            for (int k = 0; k < 8; ++k) { const int c = d == 0 ? c0 + k : 63 - c0 - k; sv[k] = *(const unsigned*)(Sg + (size_t)(b * 64 + c) * 256); }
#pragma unroll
            for (int k = 0; k < 8; ++k) { const int c = d == 0 ? c0 + k : 63 - c0 - k; if (FP8_S5) *(unsigned short*)(Xg8 + (size_t)(b * 64 + c) * 32 * 1024) = (unsigned short)fp8_pack2_s(x.x, x.y, XI8_SCALE); else *(unsigned*)(Xg + (size_t)(b * 64 + c) * 32 * 1024) = cvt_pk_bf16(x.x, x.y); x = cmul(Lm, x) + (f32x2){bf_lo(sv[k]), bf_hi(sv[k])}; }
        }
    }
}
struct PolS5Y {
    static constexpr bool PERM = true, GATHER = false, TWOSEG = true, HOOK = false, FP8 = FP8_S5;
    static constexpr int NT = FP8_S5 ? 6 : 12, KT0 = FP8_S5 ? 4 : 8, KS0 = 8192, KS1 = 8192, LDB = FP8_S5 ? 768 : 1536, TB = FP8_S5 ? 1024 : 2048;
    typedef SUnit Unit;
    const char* XN; const char* XIN; const char* BTY; bf16_t* Gb; int G, c;
    __device__ __forceinline__ bool next(int i, Unit& u) const { const int L = i * G + c; u.g = __builtin_amdgcn_readfirstlane(L >> 3); u.pm = __builtin_amdgcn_readfirstlane((L >> 1) & 3); u.pn = L & 1; return L < 512; }
    __device__ __forceinline__ void ctx(const Unit& u, pg8::UCtx<false>& x, const int (&)[2], const int (&)[2]) const {
        x.a0[0] = XN + ((size_t)NCTXR + (size_t)u.pm * 256 * S5_T) * TB + u.g * (TB / 64); x.a0[1] = x.a0[0] + (size_t)128 * S5_T * TB;
        x.a1[0] = XIN + (size_t)u.pm * 256 * S5_T * TB + u.g * (TB / 64); x.a1[1] = x.a1[0] + (size_t)128 * S5_T * TB;
        x.b = BTY + ((size_t)u.g * 512 + u.pn * 256) * LDB;
    }
    __device__ __forceinline__ unsigned lane_a0(int R, int C) const { return FP8_S5 ? (unsigned)(R * (S5_T * 1024) + (C >> 3) * 1024 + (C & 7) * 2) : (unsigned)(R * (S5_T * 2048) + (C >> 4) * 2048 + (C & 15) * 2); }
    __device__ __forceinline__ void epi(const f32x4 (&acc_)[2][2][4][2], const Unit& u, int wr, int wc, int fr, int fq) const {
        constexpr float ds = FP8_S5 ? S5Y_DESCALE : 1.f;
#pragma unroll
        for (int ai = 0; ai < 2; ++ai)
#pragma unroll
            for (int m = 0; m < 4; ++m) { const int r = u.pm * 256 + ai * 128 + wr * 64 + m * 16 + fr;
                const f32x4 acc[2][2] = {{acc_[ai][0][m][0] * ds, acc_[ai][0][m][1] * ds}, {acc_[ai][1][m][0] * ds, acc_[ai][1][m][1] * ds}};
#pragma unroll
                for (int bj = 0; bj < 2; ++bj) { const int col = u.pn * 256 + bj * 128 + wc * 32 + 8 * fq, to = col >> 4, i0 = col & 15;
                    if (FP8_GLU) { unsigned char* gp8 = (unsigned char*)Gb + ((size_t)r * S5_T + to) * DM + u.g * 16 + i0; u32x2 w;
#pragma unroll
                        for (int n = 0; n < 2; ++n) { f32x4 v;
#pragma unroll
                            for (int j = 0; j < 4; ++j) v[j] = gelu_tanh(acc[bj][n][j]);
                            if (n == 0) w.x = fp8_pack4_s(v, G8_SCALE); else w.y = fp8_pack4_s(v, G8_SCALE); }
                        *(u32x2*)gp8 = w; asm volatile("" ::: "memory"); continue; }
                    bf16_t* gp = Gb + ((size_t)r * S5_T + to) * DM + u.g * 16 + i0;
#pragma unroll
                    for (int n = 0; n < 2; ++n) { f32x4 v;
#pragma unroll
                        for (int j = 0; j < 4; ++j) v[j] = gelu_tanh(acc[bj][n][j]);
                        u32x2 w; w.x = cvt_pk_bf16(v[0], v[1]); w.y = cvt_pk_bf16(v[2], v[3]); *(u32x2*)(gp + 4 * n) = w; asm volatile("" ::: "memory"); } } }
    }
};
struct PolGlu : DenseRow0<FP8_GLU ? 8 : 16, FP8_GLU ? 1024 : 2048, true> {
    static constexpr bool FP8 = FP8_GLU;
    bf16_t* OO; float* SSQO; const float* bias;
    __device__ __forceinline__ void epi(const f32x4 (&acc)[2][2][4][2], const DUnit& u, int wr, int wc, int fr, int fq) const {
        const int c0 = u.pn * 128 + wc * 32 + 8 * fq;
        const f32x4 b10 = *(const f32x4*)(bias + c0), b11 = *(const f32x4*)(bias + c0 + 4), b20 = *(const f32x4*)(bias + 1024 + c0), b21 = *(const f32x4*)(bias + 1024 + c0 + 4);
#pragma unroll
        for (int ai = 0; ai < 2; ++ai)
#pragma unroll
            for (int m = 0; m < 4; ++m) {
                const int row = row0 + u.pm * 256 + ai * 128 + wr * 64 + m * 16 + fr;
                f32x4 o0, o1;
#pragma unroll
                for (int j = 0; j < 4; ++j) { constexpr float ds = FP8_GLU ? GLU_DESCALE : 1.f;
                    o0[j] = (acc[ai][0][m][0][j] * ds + b10[j]) * sigmoid_f(acc[ai][1][m][0][j] * ds + b20[j]); o1[j] = (acc[ai][0][m][1][j] * ds + b11[j]) * sigmoid_f(acc[ai][1][m][1][j] * ds + b21[j]); }
                float s = sq4(o0) + sq4(o1);
                store8(OO + (size_t)row * DM + c0, o0, o1);
                s += __shfl_xor(s, 16); s += __shfl_xor(s, 32);
                if (fq == 0) SSQO[(size_t)row * 32 + u.pn * 4 + wc] = s;
            }
    }
};
#ifndef REP_ATTN
#define REP_ATTN 1
#endif
#ifndef REP_MISC
#define REP_MISC 1
#endif
#ifndef REP_DENSE
#define REP_DENSE 1
#endif
#ifndef REP_G2A
#define REP_G2A 1
#endif
#ifndef STAGGER
#define STAGGER 0
#endif
#ifndef REP_P11X
#define REP_P11X 1
#endif
#ifndef REP_PM0
#define REP_PM0 1
#endif
#ifndef REP_H
#define REP_H 1
#endif
#ifndef REP_G1
#define REP_G1 1
#endif
__device__ __forceinline__ void moe_stage(const Args& args, Frame& F, const XcdBarrier& bar, int layer, int row_lo) {
    const int nrows = NROWS - row_lo, tpb = nrows / F.G;
    if (FP8_SH) {
        {   unsigned char* ws = opaque_ptr(args.ws);
            PolShr8 p; p.A = (const char*)(ws + WS_XN8) + (size_t)row_lo * 1024; p.Bt = (const char*)(ws + WS_WSHR) + (size_t)layer * 512 * 1024; p.nM = nrows / 256; p.nN = 2; p.G = F.G; p.c = (int)blockIdx.x;
            p.row0 = row_lo; p.HSH = (unsigned char*)(ws + WS_HSH); pg8::gemm_phase(F.lds, p); }
        {   unsigned char* ws = opaque_ptr(args.ws);
            PolRtr p; p.A = (const char*)(ws + WS_XN) + (size_t)row_lo * 2048; p.Bt = (const char*)(ws + WS_WSHR) + MiB + (size_t)layer * 512 * 1024; p.nM = nrows / 256; p.nN = 1; p.G = F.G; p.c = F.G - 1 - (int)blockIdx.x;
            p.row0 = row_lo; p.LOG = (float*)(ws + WS_LOG); pg8::gemm_phase(F.lds, p); }
    } else
    {   unsigned char* ws = opaque_ptr(args.ws);
        PolShr p; p.A = (const char*)(ws + WS_XN) + (size_t)row_lo * 2048; p.Bt = (const char*)(ws + WS_WSHR) + (size_t)layer * 768 * 2048; p.nM = nrows / 256; p.nN = 3; p.G = F.G; p.c = (int)blockIdx.x;
        p.row0 = row_lo; p.HSH = (bf16_t*)(ws + WS_HSH); p.LOG = (float*)(ws + WS_LOG);
        for (int rep_ = 0; rep_ < REP_DENSE; ++rep_) pg8::gemm_phase(F.lds, p, rep_ == REP_DENSE - 1, STAGGER);
    }
    if (layer == 1 && args.stage == 7) return;
    xcd_barrier(bar);
    route_phase(args, F, layer, row_lo, tpb);
#if REP_MISC == 2
    __syncthreads(); route_phase(args, F, layer, row_lo, tpb);
#endif
    if (layer == 1 && args.stage == 8) return;
    xcd_barrier(bar);
    place_phase(args, F, row_lo, tpb);
#if REP_MISC == 2
    __syncthreads(); place_phase(args, F, row_lo, tpb);
#endif
    if (layer == 1 && args.stage == 9) return;
    xcd_barrier(bar);
    const int* TINFO = (const int*)(opaque_ptr(args.ws) + WS_TINFO);
    const int ts0 = __builtin_amdgcn_readfirstlane(TINFO[0]), ts1 = __builtin_amdgcn_readfirstlane(TINFO[64]), ts2 = __builtin_amdgcn_readfirstlane(TINFO[128]);
#define MOE_G1(TA, TB, HBUF) do { if ((FP8_G1_LAYERS >> layer) & 1) { unsigned char* ws = opaque_ptr(args.ws); PolMoe1F p; p.XN = (const char*)(ws + WS_XN8); p.W1 = (const char*)(ws + WS_W1); p.H = (bf16_t*)(ws + (HBUF)); p.TINFO = (const int*)(ws + WS_TINFO); p.LDST = (const int*)(ws + WS_LDST); p.T0 = (TA); p.T1 = (TB); p.G = F.G; p.c = F.vcu; \
        for (int rep_ = 0; rep_ < REP_G1; ++rep_) pg8::gemm_phase(F.lds, p, rep_ == REP_G1 - 1); } else MOE_G1B(TA, TB, HBUF); } while (0)
#define MOE_G1B(TA, TB, HBUF) for (int rep_ = 0; rep_ < REP_G1; ++rep_) do { unsigned char* ws = opaque_ptr(args.ws); PolMoe1 p; p.XN = (const char*)(ws + WS_XN); p.W1 = (const char*)(ws + WS_W1); p.H = (bf16_t*)(ws + (HBUF)); p.TINFO = (const int*)(ws + WS_TINFO); p.LDST = (const int*)(ws + WS_LDST); p.T0 = (TA); p.T1 = (TB); p.G = F.G; p.c = F.vcu; \
        pg8::gemm_phase(F.lds, p); } while (0)
#define MOE_G2(RMW, TA, TB, HBUF) do { unsigned char* ws = opaque_ptr(args.ws); PolMoe2<RMW> p; p.H = (const char*)(ws + (HBUF)); p.W2 = (const char*)(ws + WS_W2); p.Y = (unsigned char*)(ws + WS_Y); p.TINFO = (const int*)(ws + WS_TINFO); p.LDST = (const int*)(ws + WS_LDST); p.LW = (const float*)(ws + WS_LW); p.T0 = (TA); p.T1 = (TB); p.G = F.G; p.c = F.vcu; \
        for (int rep_ = 0; rep_ < ((RMW) ? 1 : REP_G2A); ++rep_) pg8::gemm_phase(F.lds, p); } while (0)
#define MOE_SHD() do { unsigned char* ws = opaque_ptr(args.ws); PolShd p; p.A = (const char*)(ws + WS_HSH) + (size_t)row_lo * (FP8_SHD ? 256 : 512); p.Bt = (const char*)(ws + WS_WSHD) + (size_t)layer * 1024 * (FP8_SHD ? 256 : 512); p.nM = nrows / 256; p.nN = 4; p.G = F.G; p.c = (int)blockIdx.x; \
        p.row0 = row_lo; p.Y = (unsigned char*)(ws + WS_Y); pg8::gemm_phase(F.lds, p); } while (0)
    if (blockIdx.x & 1) { MOE_SHD(); MOE_G1(ts0, ts1, WS_H0); } else { MOE_G1(ts0, ts1, WS_H0); MOE_SHD(); }
    if (layer == 1 && args.stage == 10) return;
    xcd_barrier(bar);
    if (blockIdx.x & 1) { MOE_G1(ts1, ts2, WS_H1); MOE_G2(false, ts0, ts1, WS_H0); }
    else { MOE_G2(false, ts0, ts1, WS_H0); MOE_G1(ts1, ts2, WS_H1); }
    xcd_barrier(bar);
    if (!FP8_S5 && layer == 0 && (blockIdx.x & 1)) { s5_tables_phase(args, F); __syncthreads(); }
    MOE_G2(true, ts1, ts2, WS_H1);
    if (!FP8_S5 && layer == 0 && !(blockIdx.x & 1)) { __syncthreads(); s5_tables_phase(args, F); }
    if (layer == 1 && args.stage == 13) return;
    xcd_barrier(bar);
#if REP_P11X == 2
    __syncthreads();
#endif
    if (layer == 0 && (blockIdx.x & 1)) { s5_toeplitz_phase(args, F); __syncthreads(); }
    combine_phase(args, F, layer, row_lo);
    if (layer == 0 && !(blockIdx.x & 1)) { __syncthreads(); s5_toeplitz_phase(args, F); }
#undef MOE_SHD
#undef MOE_G1
#undef MOE_G1B
#undef MOE_G2
}

__global__ void __launch_bounds__(NWAVES * 64, 2) trunk_fwd(Args args) {
    extern __shared__ __attribute__((aligned(16))) unsigned char lds_raw[];
    Frame F;
    F.lds = (LAS unsigned char*)lds_raw;
    F.G = gridDim.x; { const int bx = blockIdx.x; F.vcu = (F.G % 8 == 0) ? (bx % 8) * (F.G / 8) + bx / 8 : bx; }
    F.ws = args.ws;
    volatile LAS unsigned* MISC = (volatile LAS unsigned*)(F.lds + LDSCTL_OFF);
    for (int u = threadIdx.x; u < (LDS_BYTES - LDSCTL_OFF) / 4; u += NWAVES * 64) ((LAS unsigned*)(F.lds + LDSCTL_OFF))[u] = 0u;
    __syncthreads();
    if (threadIdx.x < 31) ((LAS unsigned long long*)(F.lds + PTAB_OFF))[threadIdx.x] = (unsigned long long)args.in[threadIdx.x];
    __syncthreads();
    XcdBarrier bar = xcd_barrier_post((unsigned*)(args.ws + WS_CTL) + CW_BAR, MISC + 8);
#define GRID_BAR() xcd_barrier(bar)

    mod_phase(args, F);
    __syncthreads();
    convert_small(args, F);
    rope_phase(args, F);
#if REP_MISC == 2
    __syncthreads();
    mod_phase(args, F);
    __syncthreads();
    convert_small(args, F);
    rope_phase(args, F);
#endif
    GRID_BAR();
    h_phase(args, F, 0, 0);
#if REP_H == 2
    h_phase(args, F, 0, 0);
#endif
    GRID_BAR();
    {   unsigned char* ws = opaque_ptr(args.ws);
        PolDqkv p; p.A = (const char*)(ws + (FP8_DQKV ? WS_XN8 : WS_XN)); p.Bt = (const char*)(ws + WS_WDQKV); p.nM = NROWS / 256; p.nN = 3; p.G = F.G; p.c = (int)blockIdx.x;
        p.A1 = (bf16_t*)(ws + WS_A1); p.SSQ1 = (float*)(ws + WS_SSQ1); p.KPE = (bf16_t*)(ws + WS_KPE); p.ROPE = (const float*)(ws + WS_ROPE);
        for (int rep_ = 0; rep_ < REP_DENSE; ++rep_) pg8::gemm_phase(F.lds, p, rep_ == REP_DENSE - 1, STAGGER);
    }
    GRID_BAR();
#define RUN_QUP() do { unsigned char* ws = opaque_ptr(args.ws); PolQup p; p.A = (const char*)(ws + WS_A1); p.Bt = (const char*)(ws + WS_WUQ); p.nM = NROWS / 256; p.nN = NQ / 256; p.G = F.G; p.c = (int)blockIdx.x; \
        p.Q = (bf16_t*)(ws + WS_Q); p.SSQ1 = (const float*)(ws + WS_SSQ1); pg8::gemm_phase(F.lds, p); } while (0)
#define RUN_KVUP() do { unsigned char* ws = opaque_ptr(args.ws); PolKVup p; p.A = (const char*)(ws + WS_A1) + QLORA * 2; p.Bt = (const char*)(ws + WS_WUKV); p.nM = NROWS / 256; p.nN = NKV / 256; p.G = F.G; p.c = (int)blockIdx.x; \
        p.KV = (bf16_t*)(ws + WS_KV); p.SSQ1 = (const float*)(ws + WS_SSQ1); p.VT8 = ws + WS_XN8; pg8::gemm_phase(F.lds, p); } while (0)
    if (blockIdx.x & 1) { RUN_KVUP(); RUN_QUP(); } else { RUN_QUP(); RUN_KVUP(); }
#undef RUN_QUP
#undef RUN_KVUP
    GRID_BAR();
    {   unsigned char* ws = opaque_ptr(args.ws);
        const bf16_t* Qg = (const bf16_t*)(ws + WS_Q); const bf16_t* KVb = (const bf16_t*)(ws + WS_KV); const bf16_t* KPE = (const bf16_t*)(ws + WS_KPE); bf16_t* Og = (bf16_t*)(ws + WS_O); const float* RP = (const float*)(ws + WS_ROPE);
        if (blockIdx.x & 1) { convert_experts(args, F, 0, 0); __syncthreads(); }
        for (int rep_ = 0; rep_ < REP_ATTN; ++rep_)
        for (int u = F.vcu; u < 1024 + 128; u += F.G) {
            if (u < 1024) { const int bh = u >> 3, qb = u & 7, b = bh >> 3, h = bh & 7;
                attn::attn_unit(Qg, KVb, (const unsigned char*)(ws + WS_XN8), KPE, Og, RP, NCTXR + b * SEQL + qb * 256, qb * 256, h, b * NCTX, NCTXR + b * SEQL, 36, (char*)lds_raw); }
            else { const int bh = u - 1024, b = bh >> 3, h = bh & 7;
                attn::attn_unit(Qg, KVb, (const unsigned char*)(ws + WS_XN8), KPE, Og, RP, b * NCTX, -1, h, b * NCTX, 0, 4, (char*)lds_raw); }
        }
        if (!(blockIdx.x & 1)) { __syncthreads(); convert_experts(args, F, 0, 0); }
    }
    GRID_BAR();
    {   unsigned char* ws = opaque_ptr(args.ws);
        PolWo p; p.A = (const char*)(ws + WS_O); p.Bt = (const char*)(ws + WS_WO); p.nM = NROWS / 256; p.nN = 4; p.G = F.G; p.c = (int)blockIdx.x;
        p.OO = (bf16_t*)(ws + WS_OO); p.SSQO = (float*)(ws + WS_SSQO);
        for (int rep_ = 0; rep_ < REP_DENSE; ++rep_) pg8::gemm_phase(F.lds, p, rep_ == REP_DENSE - 1, STAGGER);
    }
    GRID_BAR();
    if (FP8_S5 && (blockIdx.x & 1)) { s5_tables_phase(args, F); __syncthreads(); }
    postmix_phase(args, F, 0, 0, 16);
    if (FP8_S5 && !(blockIdx.x & 1)) { __syncthreads(); s5_tables_phase(args, F); }
#if REP_PM0 == 2
    postmix_phase(args, F, 0, 0, 16);
#endif
    GRID_BAR();
    moe_stage(args, F, bar, 0, 0);
    if (args.stage == 1) return;
    GRID_BAR();
    {   unsigned char* ws = opaque_ptr(args.ws);
        PolS5S p; p.XN = (const char*)(ws + (FP8_S5 ? WS_XN8 : WS_XN)); p.BTS = (const char*)(ws + WS_BTS); p.S = (bf16_t*)(ws + WS_S); p.G = F.G; p.c = F.vcu;
        for (int rep_ = 0; rep_ < REP_DENSE; ++rep_) pg8::gemm_phase(F.lds, p, rep_ == REP_DENSE - 1, STAGGER);
    }
    if (args.stage == 2) return;
    GRID_BAR();
    s5_scan_phase(args, F);
#if REP_MISC == 2
    s5_scan_phase(args, F);
#endif
    if (args.stage == 3) return;
    GRID_BAR();
    {   unsigned char* ws = opaque_ptr(args.ws);
        PolS5Y p; p.XN = (const char*)(ws + (FP8_S5 ? WS_XN8 : WS_XN)); p.XIN = (const char*)(ws + WS_XIN); p.BTY = (const char*)(ws + WS_BTY); p.Gb = (bf16_t*)(ws + WS_G); p.G = F.G; p.c = F.vcu;
        for (int rep_ = 0; rep_ < REP_DENSE; ++rep_) pg8::gemm_phase(F.lds, p, rep_ == REP_DENSE - 1, STAGGER);
    }
    if (args.stage == 4) return;
    GRID_BAR();
    if (blockIdx.x & 1) { convert_experts(args, F, 1, 0); __syncthreads(); }
    {   unsigned char* ws = opaque_ptr(args.ws);
        PolGlu p; p.A = (const char*)(ws + WS_G); p.Bt = (const char*)(ws + WS_WGLU); p.nM = NLATR / 256; p.nN = 8; p.G = F.G; p.c = (int)blockIdx.x;
        p.row0 = NCTXR; p.OO = (bf16_t*)(ws + WS_OO); p.SSQO = (float*)(ws + WS_SSQO); p.bias = inp(F, 22);
        for (int rep_ = 0; rep_ < REP_DENSE; ++rep_) pg8::gemm_phase(F.lds, p, rep_ == REP_DENSE - 1, STAGGER);
    }
    if (!(blockIdx.x & 1)) { __syncthreads(); convert_experts(args, F, 1, 0); }
    if (args.stage == 5) return;
    GRID_BAR();
    postmix_phase(args, F, 1, NCTXR, 32);
    if (args.stage == 6) return;
    GRID_BAR();
    moe_stage(args, F, bar, 1, NCTXR);
}

#ifndef DBG_STAGE
#define DBG_STAGE 0
#endif
extern "C" void kernel_launch(void* const* d_in, const int* in_sizes, int n_in, void* d_out, int out_size, void* d_ws, size_t ws_size, hipStream_t stream) {
    static int grid = 0;
    if (grid == 0) {
        if (n_in != 31 || out_size != NLATR * DM || ws_size < WS_END) { fprintf(stderr, "kernel_launch: unexpected shapes (n_in %d out %d ws %zu)\n", n_in, out_size, ws_size); grid = -1; return; }
        int dev = 0, cus = 0;
        if (hipGetDevice(&dev) != hipSuccess || hipDeviceGetAttribute(&cus, hipDeviceAttributeMultiprocessorCount, dev) != hipSuccess) { grid = -1; return; }
        if (hipFuncSetAttribute((const void*)trunk_fwd, hipFuncAttributeMaxDynamicSharedMemorySize, LDS_BYTES) != hipSuccess) { fprintf(stderr, "kernel_launch: hipFuncSetAttribute failed\n"); grid = -1; return; }
        (void)hipGetLastError();
        grid = cus;
    }
    if (grid < 0) return;
    (void)hipMemsetAsync((char*)d_ws + WS_CTL, 0, CTL_BYTES, stream);
    Args a{};
    for (int i = 0; i < 31; ++i) a.in[i] = (const float*)d_in[i];
    a.out = (float*)d_out; a.ws = (unsigned char*)d_ws; a.stage = DBG_STAGE; a.pad = 0;
    hipLaunchKernelGGL(trunk_fwd, dim3(grid), dim3(NWAVES * 64), LDS_BYTES, stream, a);
}
```

```cpp
#include <hip/hip_runtime.h>
#include <cstdio>
#include <cstdint>

#define GAS __attribute__((address_space(1)))
#define LAS __attribute__((address_space(3)))
typedef unsigned short bf16_t;
typedef short bf16x8 __attribute__((ext_vector_type(8)));
typedef short s16x4 __attribute__((ext_vector_type(4)));
typedef float f32x2 __attribute__((ext_vector_type(2)));
typedef float f32x4 __attribute__((ext_vector_type(4)));
typedef float f32x16 __attribute__((ext_vector_type(16)));
typedef unsigned u32x2 __attribute__((ext_vector_type(2)));
typedef unsigned u32x4 __attribute__((ext_vector_type(4)));
typedef int i32x4 __attribute__((ext_vector_type(4)));
typedef int i32x8 __attribute__((ext_vector_type(8)));

constexpr int DM = 1024, NBATCH = 16, SEQL = 2048, NCTX = 256;
constexpr int NCTXR = NBATCH * NCTX;
constexpr int NLATR = NBATCH * SEQL;
constexpr int NROWS = NCTXR + NLATR;
constexpr int NHEAD = 8, QLORA = 384, KVLORA = 256, NOPE = 128, ROPED = 64, VDIM = 128;
constexpr int NDQKV = 768;
constexpr int NQ = NHEAD * (NOPE + ROPED);
constexpr int NKV = NHEAD * (NOPE + VDIM);
constexpr int NEXP = 64, TOPK = 8, DEXP = 256;
constexpr float NORM_EPS = 1e-6f;
constexpr int NMOD = 6, MODW = NMOD * DM;

constexpr size_t MiB = 1u << 20;
constexpr size_t WS_CTL = 0, CTL_BYTES = 64 * 1024;
constexpr size_t WS_WDQKV = 1 * MiB;
constexpr size_t WS_WUQ   = WS_WDQKV + 1536 * 1024;
constexpr size_t WS_WUKV  = WS_WUQ + 1280 * 1024;
constexpr size_t WS_WO    = WS_WUKV + 1 * MiB;
constexpr size_t WS_WGLU  = WS_WO + 2 * MiB;
constexpr size_t WS_WSHR  = WS_WGLU + 4 * MiB;
constexpr size_t WS_WSHD  = WS_WSHR + 3 * MiB;
constexpr size_t WS_MOD   = 15 * MiB;
constexpr size_t WS_ROPE  = 16 * MiB;
constexpr size_t WS_W1    = 17 * MiB;
constexpr size_t WS_W2    = 81 * MiB;
constexpr size_t WS_XCTX  = 113 * MiB;
constexpr size_t WS_XN    = 129 * MiB;
constexpr size_t WS_ST    = 201 * MiB;
static_assert(WS_WSHD + 1 * MiB <= WS_MOD, "small weights fit");
constexpr size_t WS_KV   = WS_ST;
constexpr size_t WS_Q    = WS_ST + 144 * MiB;
constexpr size_t WS_OO   = WS_Q;
constexpr size_t WS_A1   = WS_ST + 252 * MiB;
constexpr size_t WS_O    = WS_A1;
constexpr size_t WS_KPE  = WS_ST + 324 * MiB;
constexpr size_t WS_SSQ1 = WS_ST + 329 * MiB;
constexpr size_t WS_SSQO = WS_ST + 332 * MiB;
constexpr size_t WS_END  = WS_ST + 402 * MiB;
constexpr size_t WS_XN8  = WS_ST + 358 * MiB;

constexpr int CW_BAR = 4096;

__device__ __forceinline__ unsigned cvt_pk_bf16(float lo, float hi) { unsigned r; asm volatile("v_cvt_pk_bf16_f32 %0, %1, %2" : "=v"(r) : "v"(lo), "v"(hi)); return r; }
__device__ __forceinline__ float bf_lo(unsigned w) { return __uint_as_float(w << 16); }
__device__ __forceinline__ float bf_hi(unsigned w) { return __uint_as_float(w & 0xffff0000u); }
__device__ __forceinline__ float wave_sum(float v) {
#pragma unroll
    for (int o = 1; o < 64; o <<= 1) v += __shfl_xor(v, o);
    return v;
}
__device__ __forceinline__ float silu_f(float v) { return v * __builtin_amdgcn_rcpf(1.f + __builtin_amdgcn_exp2f(-1.4426950408889634f * v)); }
__device__ __forceinline__ float sigmoid_f(float v) { return __builtin_amdgcn_rcpf(1.f + __builtin_amdgcn_exp2f(-1.4426950408889634f * v)); }
__device__ __forceinline__ int mod_index(int row) { return row < NCTXR ? 16 : (row - NCTXR) / SEQL; }
__device__ __forceinline__ int opaque_tid() { int t = threadIdx.x; asm volatile("" : "+v"(t)); return t; }
__device__ __forceinline__ float gelu_tanh(float v) {
    const float z = 0.7978845608028654f * (v + 0.044715f * v * v * v);
    return v * __builtin_amdgcn_rcpf(1.f + __builtin_amdgcn_exp2f(-2.8853900817779268f * z));
}
__device__ __forceinline__ unsigned char* opaque_ptr(unsigned char* p) {
    unsigned lo = __builtin_amdgcn_readfirstlane((unsigned)(unsigned long long)p), hi = __builtin_amdgcn_readfirstlane((unsigned)((unsigned long long)p >> 32));
    asm volatile("" : "+s"(lo), "+s"(hi)); return (unsigned char*)(GAS unsigned char*)(((unsigned long long)hi << 32) | lo); }
constexpr float Y_SCALE = 64.f, Y_INV = 1.f / 64.f, Y_MAX = 448.f;
__device__ __forceinline__ unsigned fp8_pack4(const f32x4& v) {
    const float a = fminf(fmaxf(v[0] * Y_SCALE, -Y_MAX), Y_MAX), b = fminf(fmaxf(v[1] * Y_SCALE, -Y_MAX), Y_MAX), c = fminf(fmaxf(v[2] * Y_SCALE, -Y_MAX), Y_MAX), d = fminf(fmaxf(v[3] * Y_SCALE, -Y_MAX), Y_MAX);
    int p = __builtin_amdgcn_cvt_pk_fp8_f32(a, b, 0, false); p = __builtin_amdgcn_cvt_pk_fp8_f32(c, d, p, true); return (unsigned)p; }
__device__ __forceinline__ f32x4 fp8_unpack4(unsigned w) {
    const f32x2 lo = __builtin_amdgcn_cvt_pk_f32_fp8((int)w, false), hi = __builtin_amdgcn_cvt_pk_f32_fp8((int)w, true);
    return (f32x4){lo.x * Y_INV, lo.y * Y_INV, hi.x * Y_INV, hi.y * Y_INV}; }
constexpr int FP8_G1_LAYERS = 3;
constexpr float XN8_SCALE = 16.f, W18_SCALE = 1024.f, G1_DESCALE = 1.f / (16.f * 1024.f);
constexpr bool FP8_G2 = true;
constexpr float H8_SCALE = 16.f, W28_SCALE = 512.f, G2_DESCALE = 1.f / (16.f * 512.f);
constexpr bool FP8_GLU = true;
constexpr float G8_SCALE = 4.f, WG8_SCALE = 1024.f, GLU_DESCALE = 1.f / (4.f * 1024.f);
constexpr bool FP8_WO = false;
constexpr float O8_SCALE = 64.f, WO8_SCALE = 1024.f, WO_DESCALE = 1.f / (64.f * 1024.f);
constexpr bool FP8_DQKV = true;
constexpr float WD8_SCALE = 1024.f, DQKV_DESCALE = 1.f / (16.f * 1024.f);
constexpr bool FP8_SH = true;
constexpr bool FP8_SHD = true;
constexpr bool FP8_S5 = true;
constexpr float BS8_SCALE = 2048.f, TY8_SCALE = 64.f, QY8_SCALE = 16.f, XI8_SCALE = 64.f, S5S_DESCALE = 1.f / (16.f * 2048.f), S5Y_DESCALE = 1.f / 1024.f;
__device__ __forceinline__ unsigned fp8_pack2_s(float a, float b, float s) {
    const float x = fminf(fmaxf(a * s, -Y_MAX), Y_MAX), y = fminf(fmaxf(b * s, -Y_MAX), Y_MAX);
    return (unsigned)__builtin_amdgcn_cvt_pk_fp8_f32(x, y, 0, false) & 0xffffu; }
static_assert(!FP8_G2 || FP8_G1_LAYERS == 3, "fp8 hidden rows need the fp8 gate/up policy in both layers");
__device__ __forceinline__ unsigned fp8_pack4_s(const f32x4& v, float s) {
    const float a = fminf(fmaxf(v[0] * s, -Y_MAX), Y_MAX), b = fminf(fmaxf(v[1] * s, -Y_MAX), Y_MAX), c = fminf(fmaxf(v[2] * s, -Y_MAX), Y_MAX), d = fminf(fmaxf(v[3] * s, -Y_MAX), Y_MAX);
    int p = __builtin_amdgcn_cvt_pk_fp8_f32(a, b, 0, false); p = __builtin_amdgcn_cvt_pk_fp8_f32(c, d, p, true); return (unsigned)p; }
#define XB_TMO      128
#define XB_XCNT(j)  (256  + 64 * (j))
#define XB_XSUB(j)  (1280 + 64 * (j))
#define XB_XGEN(j)  (2304 + 64 * (j))
#define XB_TOP      3328
#define XB_TOPGEN   3392
#define XCD_BAR_WORDS 3456
#define XB_SPIN_CAP (1u << 18)
__device__ __forceinline__ unsigned xb_ld(unsigned* p)              { return __hip_atomic_load(p, __ATOMIC_RELAXED, __HIP_MEMORY_SCOPE_AGENT); }
__device__ __forceinline__ unsigned xb_add(unsigned* p, unsigned v) { return __hip_atomic_fetch_add(p, v, __ATOMIC_RELAXED, __HIP_MEMORY_SCOPE_AGENT); }
__device__ __forceinline__ unsigned xb_xcc_id() { return (unsigned)__builtin_amdgcn_s_getreg((3 << 11) | 20) & 0xFu; }
#define XB_SPIN(cond, bar) do { unsigned _sp = 0; while (cond) { __builtin_amdgcn_s_sleep(1); \
    if ((++_sp & 255u) == 0u) { if (xb_ld(&(bar)[XB_TMO])) break; if (_sp > XB_SPIN_CAP) { atomicAdd(&(bar)[XB_TMO], 1u); break; } } } } while (0)
struct XcdBarrier { unsigned* bar; unsigned x; volatile LAS unsigned* st; };
__device__ __forceinline__ XcdBarrier xcd_barrier_post(unsigned* bar, volatile LAS unsigned* st) {
    XcdBarrier b; b.bar = bar; b.x = xb_xcc_id(); b.st = st;
    if (threadIdx.x == 0) (void)xb_add(&bar[XB_XCNT(b.x)], 1u);
    return b;
}
__device__ __forceinline__ void xcd_barrier_complete(unsigned* bar, unsigned x, unsigned& nloc, unsigned& nx) {
    const unsigned G = gridDim.x * gridDim.y * gridDim.z;
    unsigned sum, cnt, mine, sp = 0u;
    for (;;) {
        sum = 0u; cnt = 0u; mine = 0u;
#pragma unroll
        for (unsigned j = 0; j < 16; ++j) { const unsigned c = xb_ld(&bar[XB_XCNT(j)]); sum += c; cnt += (c > 0u) ? 1u : 0u; mine = (j == x) ? c : mine; }
        if (sum == G) break;
        __builtin_amdgcn_s_sleep(1);
        if ((++sp & 255u) == 0u) { if (xb_ld(&bar[XB_TMO])) break; if (sp > XB_SPIN_CAP) { atomicAdd(&bar[XB_TMO], 1u); break; } }
    }
    nloc = mine > 0u ? mine : 1u; nx = cnt > 0u ? cnt : 1u;
}
__device__ __forceinline__ void xcd_barrier(const XcdBarrier& b) {
    asm volatile("s_waitcnt vmcnt(0)" ::: "memory");
    __syncthreads();
    if (threadIdx.x == 0) {
        unsigned* bar = b.bar;
        __builtin_amdgcn_s_waitcnt(0);
        unsigned nloc = b.st[0], nx = b.st[1];
        if (nloc == 0u) { xcd_barrier_complete(bar, b.x, nloc, nx); b.st[0] = nloc; b.st[1] = nx; }
        const unsigned old = xb_add(&bar[XB_XSUB(b.x)], 1u);
        const unsigned gen = old / nloc;
        if (old + 1u == (gen + 1u) * nloc) {
            __builtin_amdgcn_fence(__ATOMIC_RELEASE, "agent");
            asm volatile("s_waitcnt vmcnt(0)" ::: "memory");
            const unsigned og = xb_add(&bar[XB_TOP], 1u);
            const unsigned tg = og / nx;
            if (og + 1u == (tg + 1u) * nx) xb_add(&bar[XB_TOPGEN], 1u);
            else XB_SPIN(xb_ld(&bar[XB_TOPGEN]) == tg, bar);
            __builtin_amdgcn_fence(__ATOMIC_ACQUIRE, "agent");
            xb_add(&bar[XB_XGEN(b.x)], 1u);
            asm volatile("s_waitcnt vmcnt(0)" ::: "memory");
        } else {
            XB_SPIN(xb_ld(&bar[XB_XGEN(b.x)]) == gen, bar);
            __builtin_amdgcn_fence(__ATOMIC_ACQUIRE, "agent");
            asm volatile("s_waitcnt vmcnt(0)" ::: "memory");
        }
    }
    __syncthreads();
}

namespace pg8 {
constexpr int BM = 256, BK = 64, HALF = 128, HTB = HALF * BK * 2, STAGE_BYTES = 8 * HTB, NXCD = 8, WGM = 8;
__host__ __device__ __forceinline__ int lds_byte(int r, int c) { const int st = (r >> 4) * 2 + (c >> 5), rr = r & 15, cc = c & 31, ob = rr * 64 + cc * 2; return st * 1024 + (ob ^ (((ob >> 9) & 1) << 5)); }
__host__ __device__ __forceinline__ void stage_rc(int b, int& R, int& C) { const int st = b / 1024, sb = b % 1024, swz = sb ^ (((sb >> 9) & 1) << 5); R = (st >> 1) * 16 + swz / 64; C = (st & 1) * 32 + (swz % 64) / 2; }
__host__ __device__ __forceinline__ int perm32(int rho) { const int n = rho >> 4, i = rho & 15; return 8 * (i >> 2) + 4 * n + (i & 3); }

__device__ __forceinline__ bool dense_order(int i, int G, int c, int nM, int nN, int& pm, int& pn) {
    const int nwg = nM * nN; const long L = (long)i * G + c; if (L >= nwg) return false;
    int wgid = (int)L; { const int q = nwg / NXCD, r = nwg % NXCD, xcd = wgid % NXCD, off = wgid / NXCD; wgid = (xcd < r ? xcd * (q + 1) : r * (q + 1) + (xcd - r) * q) + off; }
    const int nig = WGM * nN, gid = wgid / nig, fm = gid * WGM, gsz = (nM - fm) < WGM ? (nM - fm) : WGM;
    pm = __builtin_amdgcn_readfirstlane(fm + ((wgid % nig) % gsz)); pn = __builtin_amdgcn_readfirstlane((wgid % nig) / gsz); return true;
}

template <bool GATHER> struct UCtx { const char* a0[2]; const char* a1[2]; const char* b; unsigned vg[2][2]; };
template <> struct UCtx<false> { const char* a0[2]; const char* a1[2]; const char* b; };

template <class P> constexpr auto pol_nob1(int) -> decltype(P::NOB1) { return P::NOB1; }
template <class P> constexpr bool pol_nob1(long) { return false; }
template <class P> constexpr auto pol_fp8(int) -> decltype(P::FP8) { return P::FP8; }
template <class P> constexpr bool pol_fp8(long) { return false; }
template <class P>
__device__ __forceinline__ void gemm_phase(LAS unsigned char* lds, const P& pol, bool do_epi = true, int stagger_ticks = 0) {
    typedef typename P::Unit Unit;
    const int tid = opaque_tid(), wid = __builtin_amdgcn_readfirstlane(tid >> 6), lane = tid & 63, wr = wid >> 2, wc = wid & 3, fr = lane & 15, fq = lane >> 4;
    constexpr int nt = P::NT; constexpr bool FP8 = pol_fp8<P>(0); constexpr bool NOB1 = pol_nob1<P>(0);
    int Rr[2], Cc[2]; unsigned voffB[2], va0[2];
#pragma unroll
    for (int i = 0; i < 2; ++i) { stage_rc(tid * 16 + i * 8192, Rr[i], Cc[i]); const int Rb = P::PERM ? ((Rr[i] & ~31) + perm32(Rr[i] & 31)) : Rr[i];
        voffB[i] = (unsigned)(Rb * P::LDB + Cc[i] * 2); va0[i] = pol.lane_a0(Rr[i], Cc[i]); }
    constexpr size_t hstepB = (size_t)HALF * P::LDB;
    const unsigned ldsw = (unsigned)wid * 1024u;
    const int aoff = lds_byte(wr * 64 + fr, fq * 8), boff = lds_byte(wc * 32 + fr, fq * 8);
#define PG8_SA(b, h) (((b) * 2 + (h)) * HTB)
#define PG8_SB(b, h) ((4 + (b) * 2 + (h)) * HTB)
#define PG8_GL(bufoff, p0, p1) do { __builtin_amdgcn_global_load_lds((const unsigned*)(p0), (LAS unsigned*)(lds + (bufoff) + ldsw), 16, 0, 0); \
        __builtin_amdgcn_global_load_lds((const unsigned*)(p1), (LAS unsigned*)(lds + (bufoff) + ldsw + 8192), 16, 0, 0); } while (0)
#define PG8_STB(bufoff, U, h, kt) do { const char* _b = (U).b + (size_t)(h) * hstepB + (size_t)(kt) * 128; asm volatile("" : "+s"(_b)); PG8_GL(bufoff, _b + voffB[0], _b + voffB[1]); } while (0)
#define PG8_STA(bufoff, U, h, kt) do { const char* _a = (U).a0[h] + (size_t)(kt) * P::KS0; if constexpr (P::TWOSEG) { if ((kt) >= P::KT0) _a = (U).a1[h] + (size_t)((kt) - P::KT0) * P::KS1; } \
        unsigned _o0, _o1; if constexpr (P::GATHER) { _o0 = (U).vg[h][0]; _o1 = (U).vg[h][1]; } else { _o0 = va0[0]; _o1 = va0[1]; } \
        asm volatile("" : "+s"(_a)); PG8_GL(bufoff, _a + _o0, _a + _o1); } while (0)
#define PG8_LDA(dst, b, h) do { if constexpr (FP8) { _Pragma("unroll") for (int m = 0; m < 4; ++m) { const LAS unsigned char* p_ = lds + PG8_SA(b, h) + aoff + m * 2048; dst##8[m] = __builtin_shufflevector(*(const LAS i32x4*)p_, *(const LAS i32x4*)(p_ + 1024), 0, 1, 2, 3, 4, 5, 6, 7); } } \
        else { _Pragma("unroll") for (int m = 0; m < 4; ++m) _Pragma("unroll") for (int k = 0; k < 2; ++k) dst[m][k] = *(const LAS bf16x8*)(lds + PG8_SA(b, h) + aoff + m * 2048 + k * 1024); } } while (0)
#define PG8_LDB(dst, b, h) do { if constexpr (NOB1 && (h) == 1) { } else if constexpr (FP8) { _Pragma("unroll") for (int n = 0; n < 2; ++n) { const LAS unsigned char* p_ = lds + PG8_SB(b, h) + boff + n * 2048; dst##8[n] = __builtin_shufflevector(*(const LAS i32x4*)p_, *(const LAS i32x4*)(p_ + 1024), 0, 1, 2, 3, 4, 5, 6, 7); } } \
        else { _Pragma("unroll") for (int n = 0; n < 2; ++n) _Pragma("unroll") for (int k = 0; k < 2; ++k) dst[n][k] = *(const LAS bf16x8*)(lds + PG8_SB(b, h) + boff + n * 2048 + k * 1024); } } while (0)
#define PG8_MMA(ai, bj, At, Bt) do { __builtin_amdgcn_s_setprio(1); if constexpr (NOB1 && (bj) == 1) { } else if constexpr (FP8) { _Pragma("unroll") for (int m = 0; m < 4; ++m) _Pragma("unroll") for (int n = 0; n < 2; ++n) \
        acc[ai][bj][m][n] = __builtin_amdgcn_mfma_scale_f32_16x16x128_f8f6f4(Bt##8[n], At##8[m], acc[ai][bj][m][n], 0, 0, 0, 0, 0, 0); } \
        else { _Pragma("unroll") for (int m = 0; m < 4; ++m) _Pragma("unroll") for (int n = 0; n < 2; ++n) _Pragma("unroll") for (int k = 0; k < 2; ++k) \
        acc[ai][bj][m][n] = __builtin_amdgcn_mfma_f32_16x16x32_bf16(Bt[n][k], At[m][k], acc[ai][bj][m][n], 0, 0, 0); } __builtin_amdgcn_s_setprio(0); } while (0)
#define PG8_WAIT_V(n) asm volatile("s_waitcnt vmcnt(" #n ")" ::: "memory")
#define PG8_WAIT_L(n) asm volatile("s_waitcnt lgkmcnt(" #n ")" ::: "memory")
#define PG8_BAR __builtin_amdgcn_s_barrier()
#define PG8_SCHED __builtin_amdgcn_sched_barrier(0)
    Unit cur, nxt; int ui = 0;
    if (!pol.next(0, cur)) return;
    if (stagger_ticks > 0 && (blockIdx.x & 1)) {
        const unsigned long long t0 = __builtin_amdgcn_s_memrealtime(); while (__builtin_amdgcn_s_memrealtime() - t0 < (unsigned long long)stagger_ticks) __builtin_amdgcn_s_sleep(8); }
    UCtx<P::GATHER> cc, nc;
    pol.ctx(cur, cc, Rr, Cc);
    f32x4 acc[2][2][4][2];
#pragma unroll
    for (int a = 0; a < 2; ++a)
#pragma unroll
        for (int b = 0; b < 2; ++b)
#pragma unroll
            for (int m = 0; m < 4; ++m)
#pragma unroll
                for (int n = 0; n < 2; ++n) acc[a][b][m][n] = (f32x4){0.f, 0.f, 0.f, 0.f};
    bf16x8 At[4][2], B0[2][2], B1[2][2]; [[maybe_unused]] i32x8 At8[4], B08[2], B18[2];
    PG8_STB(PG8_SB(0, 0), cc, 0, 0); PG8_STB(PG8_SB(0, 1), cc, 1, 0); PG8_STA(PG8_SA(0, 0), cc, 0, 0); PG8_STA(PG8_SA(0, 1), cc, 1, 0);
    if (wr == 1) PG8_BAR;
    PG8_WAIT_V(2); PG8_BAR;
    PG8_STB(PG8_SB(1, 0), cc, 0, 1); PG8_STA(PG8_SA(1, 0), cc, 0, 1); PG8_STB(PG8_SB(1, 1), cc, 1, 1);
    PG8_WAIT_V(6); PG8_BAR;
    for (;;) {
        if constexpr (P::HOOK) pol.unit_begin(cur, ui, lds, wid, lane);
        const bool has_next = pol.next(ui + 1, nxt);
        if (has_next) pol.ctx(nxt, nc, Rr, Cc); else nc = cc;
        int ntv = nt; if constexpr (FP8) asm volatile("" : "+s"(ntv));
        for (int t = 0; t < ntv; t += 2) {
            const bool last = (t == ntv - 2);
            const int k2 = last ? 0 : t + 2, k3 = k2 + 1;
            PG8_LDB(B0, 0, 0); PG8_LDB(B1, 0, 1); PG8_SCHED; PG8_LDA(At, 0, 0); PG8_STA(PG8_SA(1, 1), cc, 1, t + 1);
            PG8_WAIT_V(8); PG8_WAIT_L(0); PG8_BAR; PG8_MMA(0, 0, At, B0); PG8_MMA(0, 1, At, B1); PG8_BAR; PG8_SCHED;
            PG8_LDA(At, 0, 1);
            if (last) { PG8_STB(PG8_SB(0, 0), nc, 0, 0); PG8_STB(PG8_SB(0, 1), nc, 1, 0); PG8_STA(PG8_SA(0, 0), nc, 0, 0); }
            else      { PG8_STB(PG8_SB(0, 0), cc, 0, k2); PG8_STB(PG8_SB(0, 1), cc, 1, k2); PG8_STA(PG8_SA(0, 0), cc, 0, k2); }
            PG8_WAIT_V(8); PG8_WAIT_L(0); PG8_BAR; PG8_MMA(1, 0, At, B0); PG8_MMA(1, 1, At, B1); PG8_BAR; PG8_SCHED;
            PG8_LDB(B0, 1, 0); PG8_LDB(B1, 1, 1); PG8_SCHED; PG8_LDA(At, 1, 0);
            if (last) { PG8_STA(PG8_SA(0, 1), nc, 1, 0); } else { PG8_STA(PG8_SA(0, 1), cc, 1, k2); }
            PG8_WAIT_V(8); PG8_WAIT_L(0); PG8_BAR; PG8_MMA(0, 0, At, B0); PG8_MMA(0, 1, At, B1); PG8_BAR; PG8_SCHED;
            PG8_LDA(At, 1, 1);
            if (last) { PG8_STB(PG8_SB(1, 0), nc, 0, 1); PG8_STB(PG8_SB(1, 1), nc, 1, 1); PG8_STA(PG8_SA(1, 0), nc, 0, 1); }
            else      { PG8_STB(PG8_SB(1, 0), cc, 0, k3); PG8_STB(PG8_SB(1, 1), cc, 1, k3); PG8_STA(PG8_SA(1, 0), cc, 0, k3); }
            PG8_WAIT_V(8); PG8_WAIT_L(0); PG8_BAR; PG8_MMA(1, 0, At, B0); PG8_MMA(1, 1, At, B1); PG8_BAR; PG8_SCHED;
        }
        if (wr == 0) PG8_BAR;
        if (do_epi) { if constexpr (P::HOOK) pol.epi_h(acc, cur, ui, lds, wr, wc, fr, fq); else pol.epi(acc, cur, wr, wc, fr, fq); }
        if (!has_next) break;
#pragma unroll
        for (int a = 0; a < 2; ++a)
#pragma unroll
            for (int b = 0; b < 2; ++b)
#pragma unroll
                for (int m = 0; m < 4; ++m)
#pragma unroll
                    for (int n = 0; n < 2; ++n) acc[a][b][m][n] = (f32x4){0.f, 0.f, 0.f, 0.f};
        cur = nxt; cc = nc; ++ui;
        if (wr == 1) PG8_BAR;
    }
    PG8_WAIT_V(0);
    PG8_BAR;
#undef PG8_SA
#undef PG8_SB
#undef PG8_GL
#undef PG8_STB
#undef PG8_STA
#undef PG8_LDA
#undef PG8_LDB
#undef PG8_MMA
#undef PG8_WAIT_V
#undef PG8_WAIT_L
#undef PG8_BAR
#undef PG8_SCHED
}
}
struct DUnit { int pm, pn; };

template <int NT_, int LDA_, bool PERM_> struct DenseBase {
    static constexpr bool PERM = PERM_, GATHER = false, TWOSEG = false, HOOK = false;
    static constexpr int NT = NT_, KT0 = NT_, KS0 = 128, KS1 = 128, LDB = NT_ * 128;
    typedef DUnit Unit;
    const char* A; const char* Bt; int nM, nN, G, c;
    __device__ __forceinline__ bool next(int i, Unit& u) const { return pg8::dense_order(i, G, c, nM, nN, u.pm, u.pn); }
    __device__ __forceinline__ void ctx(const Unit& u, pg8::UCtx<false>& x, const int (&)[2], const int (&)[2]) const {
        x.a0[0] = A + (size_t)u.pm * 256 * LDA_; x.a0[1] = x.a0[0] + (size_t)128 * LDA_; x.a1[0] = x.a0[0]; x.a1[1] = x.a0[1];
        x.b = Bt + (size_t)u.pn * 256 * LDB; }
    __device__ __forceinline__ unsigned lane_a0(int R, int C) const { return (unsigned)(R * LDA_ + C * 2); }
    __device__ __forceinline__ unsigned lane_a1(int, int) const { return 0u; }
};

__device__ __forceinline__ void store8(bf16_t* p, const f32x4& v0, const f32x4& v1) {
    u32x4 w; w.x = cvt_pk_bf16(v0[0], v0[1]); w.y = cvt_pk_bf16(v0[2], v0[3]); w.z = cvt_pk_bf16(v1[0], v1[1]); w.w = cvt_pk_bf16(v1[2], v1[3]); *(u32x4*)p = w; }
__device__ __forceinline__ float sq4(const f32x4& v) { return (v[0] * v[0] + v[1] * v[1]) + (v[2] * v[2] + v[3] * v[3]); }
__device__ __forceinline__ void rope8(f32x4& v0, f32x4& v1, const float* cs) {
    const f32x4 a = *(const f32x4*)cs, b = *(const f32x4*)(cs + 4);
    float x0, x1;
    x0 = v0[0]; x1 = v0[1]; v0[0] = x0 * a[0] - x1 * a[1]; v0[1] = x0 * a[1] + x1 * a[0];
    x0 = v0[2]; x1 = v0[3]; v0[2] = x0 * a[2] - x1 * a[3]; v0[3] = x0 * a[3] + x1 * a[2];
    x0 = v1[0]; x1 = v1[1]; v1[0] = x0 * b[0] - x1 * b[1]; v1[1] = x0 * b[1] + x1 * b[0];
    x0 = v1[2]; x1 = v1[3]; v1[2] = x0 * b[2] - x1 * b[3]; v1[3] = x0 * b[3] + x1 * b[2];
}

struct PolDqkv : DenseBase<FP8_DQKV ? 8 : 16, FP8_DQKV ? 1024 : 2048, true> {
    static constexpr bool FP8 = FP8_DQKV;
    bf16_t* A1; float* SSQ1; bf16_t* KPE; const float* ROPE;
    __device__ __forceinline__ void epi(const f32x4 (&acc_)[2][2][4][2], const DUnit& u, int wr, int wc, int fr, int fq) const {
        constexpr float ds = FP8_DQKV ? DQKV_DESCALE : 1.f;
#pragma unroll
        for (int ai = 0; ai < 2; ++ai)
#pragma unroll
            for (int m = 0; m < 4; ++m) {
                const f32x4 acc[2][2] = {{acc_[ai][0][m][0] * ds, acc_[ai][0][m][1] * ds}, {acc_[ai][1][m][0] * ds, acc_[ai][1][m][1] * ds}};
                const int row = u.pm * 256 + ai * 128 + wr * 64 + m * 16 + fr;
                bf16_t* rowp = A1 + (size_t)row * NDQKV + u.pn * 256 + wc * 32 + 8 * fq;
                float s0 = sq4(acc[0][0]) + sq4(acc[0][1]), s1 = sq4(acc[1][0]) + sq4(acc[1][1]);
                store8(rowp, acc[0][0], acc[0][1]); store8(rowp + 128, acc[1][0], acc[1][1]);
                s0 += __shfl_xor(s0, 16); s0 += __shfl_xor(s0, 32); s1 += __shfl_xor(s1, 16); s1 += __shfl_xor(s1, 32);
                if (fq == 0) {
                    float* sp = SSQ1 + (size_t)row * 16;
                    if (u.pn == 0) sp[wc] = s0 + s1; else if (u.pn == 1) { sp[4 + wc] = s0; sp[8 + wc] = s1; } else sp[12 + wc] = s0;
                }
                if (u.pn == 2 && wc < 2) {
                    f32x4 v0 = acc[1][0], v1 = acc[1][1];
                    if (row >= NCTXR) { const int t = (row - NCTXR) & (SEQL - 1); rope8(v0, v1, ROPE + ((size_t)t * 32 + 16 * wc + 4 * fq) * 2); }
                    {
                        int x = __builtin_amdgcn_cvt_pk_fp8_f32(v0[0], v0[1], 0, false); x = __builtin_amdgcn_cvt_pk_fp8_f32(v0[2], v0[3], x, true);
                        int y = __builtin_amdgcn_cvt_pk_fp8_f32(v1[0], v1[1], 0, false); y = __builtin_amdgcn_cvt_pk_fp8_f32(v1[2], v1[3], y, true);
                        *(u32x2*)((unsigned char*)KPE + (size_t)row * 64 + 32 * (fq & 1) + 8 * (2 * wc + (fq >> 1))) = (u32x2){(unsigned)x, (unsigned)y}; }
                }
            }
    }
};

struct PolQup : DenseBase<6, NDQKV * 2, true> {
    bf16_t* Q; const float* SSQ1;
    __device__ __forceinline__ void epi(const f32x4 (&acc)[2][2][4][2], const DUnit& u, int wr, int wc, int fr, int fq) const {
#pragma unroll
        for (int ai = 0; ai < 2; ++ai) {
            f32x4 p0[4], p1[4];
#pragma unroll
            for (int m = 0; m < 4; ++m) { const int row = u.pm * 256 + ai * 128 + wr * 64 + m * 16 + fr; p0[m] = *(const f32x4*)(SSQ1 + (size_t)row * 16); p1[m] = *(const f32x4*)(SSQ1 + (size_t)row * 16 + 4); }
#pragma unroll
            for (int m = 0; m < 4; ++m) {
                const int row = u.pm * 256 + ai * 128 + wr * 64 + m * 16 + fr;
                const float ss = ((p0[m][0] + p0[m][1]) + (p0[m][2] + p0[m][3])) + ((p1[m][0] + p1[m][1]) + (p1[m][2] + p1[m][3]));
                const float rstd = __builtin_amdgcn_rsqf(ss * (1.f / QLORA) + NORM_EPS);
                if (u.pn < 4) {
                    unsigned char* qp = (unsigned char*)Q + (size_t)row * 1024 + u.pn * 256 + wc * 32 + 8 * fq;
#pragma unroll
                    for (int bj = 0; bj < 2; ++bj) { const f32x4 a = acc[ai][bj][m][0] * rstd, b = acc[ai][bj][m][1] * rstd;
                        int x = __builtin_amdgcn_cvt_pk_fp8_f32(a[0], a[1], 0, false); x = __builtin_amdgcn_cvt_pk_fp8_f32(a[2], a[3], x, true);
                        int y = __builtin_amdgcn_cvt_pk_fp8_f32(b[0], b[1], 0, false); y = __builtin_amdgcn_cvt_pk_fp8_f32(b[2], b[3], y, true);
                        *(u32x2*)(qp + 128 * bj) = (u32x2){(unsigned)x, (unsigned)y}; }
                } else {
                    bf16_t* rowp = (bf16_t*)((unsigned char*)Q + (size_t)NROWS * 1024) + (size_t)row * 512 + (u.pn - 4) * 256 + wc * 32 + 8 * fq;
                    store8(rowp, acc[ai][0][m][0] * rstd, acc[ai][0][m][1] * rstd); store8(rowp + 128, acc[ai][1][m][0] * rstd, acc[ai][1][m][1] * rstd); }
            }
            asm volatile("" ::: "memory");
        }
    }
};

struct PolKVup : DenseBase<4, NDQKV * 2, true> {
    bf16_t* KV; const float* SSQ1; unsigned char* VT8;
    __device__ __forceinline__ void epi(const f32x4 (&acc)[2][2][4][2], const DUnit& u, int wr, int wc, int fr, int fq) const {
#pragma unroll
        for (int ai = 0; ai < 2; ++ai) {
            f32x4 p0[4], p1[4]; float rs[4];
#pragma unroll
            for (int m = 0; m < 4; ++m) { const int row = u.pm * 256 + ai * 128 + wr * 64 + m * 16 + fr; p0[m] = *(const f32x4*)(SSQ1 + (size_t)row * 16 + 8); p1[m] = *(const f32x4*)(SSQ1 + (size_t)row * 16 + 12); }
#pragma unroll
            for (int m = 0; m < 4; ++m) {
                const int row = u.pm * 256 + ai * 128 + wr * 64 + m * 16 + fr;
                const float ss = ((p0[m][0] + p0[m][1]) + (p0[m][2] + p0[m][3])) + ((p1[m][0] + p1[m][1]) + (p1[m][2] + p1[m][3]));
                const float rstd = __builtin_amdgcn_rsqf(ss * (1.f / KVLORA) + NORM_EPS);
                u32x2 k8; { const f32x4 a = acc[ai][0][m][0] * rstd, b = acc[ai][0][m][1] * rstd;
                    int x = __builtin_amdgcn_cvt_pk_fp8_f32(a[0], a[1], 0, false); x = __builtin_amdgcn_cvt_pk_fp8_f32(a[2], a[3], x, true);
                    int y = __builtin_amdgcn_cvt_pk_fp8_f32(b[0], b[1], 0, false); y = __builtin_amdgcn_cvt_pk_fp8_f32(b[2], b[3], y, true); k8.x = (unsigned)x; k8.y = (unsigned)y; }
                *(u32x2*)((unsigned char*)KV + (size_t)row * 1024 + u.pn * 128 + wc * 32 + 8 * fq) = k8; rs[m] = rstd;
            }
            {   unsigned char* vp = VT8 + ((size_t)((u.pm * 4 + ai * 2 + wr) * 8 + u.pn) * 128 + wc * 32 + 8 * fq) * 64 + 32 * (fr & 1) + 16 * (fr >> 3) + 4 * ((fr >> 1) & 3);
#pragma unroll
                for (int n = 0; n < 2; ++n)
#pragma unroll
                    for (int j = 0; j < 4; ++j) {
                        int w_ = __builtin_amdgcn_cvt_pk_fp8_f32(acc[ai][1][0][n][j] * rs[0], acc[ai][1][1][n][j] * rs[1], 0, false);
                        w_ = __builtin_amdgcn_cvt_pk_fp8_f32(acc[ai][1][2][n][j] * rs[2], acc[ai][1][3][n][j] * rs[3], w_, true);
                        *(int*)(vp + (4 * n + j) * 64) = w_; } }
            asm volatile("" ::: "memory");
        }
    }
};

struct PolWo : DenseBase<FP8_WO ? 8 : 16, FP8_WO ? 1024 : 2048, true> {
    static constexpr bool FP8 = FP8_WO;
    bf16_t* OO; float* SSQO;
    __device__ __forceinline__ void epi(const f32x4 (&acc_)[2][2][4][2], const DUnit& u, int wr, int wc, int fr, int fq) const {
        constexpr float ds = FP8_WO ? WO_DESCALE : 1.f;
#pragma unroll
        for (int ai = 0; ai < 2; ++ai)
#pragma unroll
            for (int m = 0; m < 4; ++m) {
                const f32x4 a00 = acc_[ai][0][m][0] * ds, a01 = acc_[ai][0][m][1] * ds, a10 = acc_[ai][1][m][0] * ds, a11 = acc_[ai][1][m][1] * ds;
                const int row = u.pm * 256 + ai * 128 + wr * 64 + m * 16 + fr;
                bf16_t* rowp = OO + (size_t)row * DM + u.pn * 256 + wc * 32 + 8 * fq;
                float s = (sq4(a00) + sq4(a01)) + (sq4(a10) + sq4(a11));
                store8(rowp, a00, a01); store8(rowp + 128, a10, a11);
                s += __shfl_xor(s, 16); s += __shfl_xor(s, 32);
                if (fq == 0) SSQO[(size_t)row * 32 + u.pn * 4 + wc] = s;
            }
    }
};
namespace attn {
constexpr int NW = 8, QBLK = 32, KVBLK = 64, DQK = 192, DV = 128;
constexpr float SCALE = 0.07216878364870322f;
constexpr float THR = 4.f;
constexpr int KP = 208;
constexpr int VP = 80;
constexpr int SHM_V = DV * VP, SHM_K = KVBLK * KP;
constexpr int SHM_ATTN = 2 * SHM_V + 2 * SHM_K + NW * 64 * 4;
#define SBAR() __builtin_amdgcn_sched_barrier(0)
__device__ __forceinline__ int crow(int r, int hi) { return (r & 3) + 8 * (r >> 2) + 4 * hi; }
__device__ __forceinline__ unsigned cvtpk(float lo, float hi) { unsigned r; asm volatile("v_cvt_pk_bf16_f32 %0, %1, %2" : "=v"(r) : "v"(lo), "v"(hi)); return r; }

__device__ __forceinline__ void partialSM(f32x16& p0, f32x16& p1, float& m_reg, float& mn, float& alpha) {
  constexpr float C = SCALE * 1.4426950408889634f;
  float pmax = p0[0];
#pragma unroll
  for (int r = 1; r < 16; ++r) pmax = fmaxf(pmax, p0[r]);
#pragma unroll
  for (int r = 0; r < 16; ++r) pmax = fmaxf(pmax, p1[r]);
  { auto rr = __builtin_amdgcn_permlane32_swap(__float_as_uint(pmax), __float_as_uint(pmax), false, false);
    pmax = fmaxf(__uint_as_float(rr[0]), __uint_as_float(rr[1])); }
  if (__builtin_expect(__all(pmax - m_reg <= THR / SCALE), 1)) { mn = m_reg; alpha = 1.f; }
  else { mn = fmaxf(m_reg, pmax); alpha = __builtin_amdgcn_exp2f((m_reg - mn) * C); m_reg = mn; }
  float mnC = 2.f - mn * C;
#pragma unroll
  for (int r = 0; r < 16; ++r) p0[r] = fmaf(p0[r], C, mnC);
#pragma unroll
  for (int r = 0; r < 16; ++r) p1[r] = fmaf(p1[r], C, mnC);
#pragma unroll
  for (int r = 0; r < 16; ++r) p0[r] = __builtin_amdgcn_exp2f(p0[r]);
}
__device__ __forceinline__ void finishSM(f32x16& p0, f32x16& p1, float alpha, float& l_reg, i32x8& pa) {
#pragma unroll
  for (int r = 0; r < 16; ++r) p1[r] = __builtin_amdgcn_exp2f(p1[r]);
  float ps = 0;
#pragma unroll
  for (int r = 0; r < 16; ++r) ps += p0[r];
#pragma unroll
  for (int r = 0; r < 16; ++r) ps += p1[r];
  { auto rr = __builtin_amdgcn_permlane32_swap(__float_as_uint(ps), __float_as_uint(ps), false, false);
    ps = __uint_as_float(rr[0]) + __uint_as_float(rr[1]); }
  l_reg = l_reg * alpha + ps;
#define PK4(P, BASE) ({ int a_ = __builtin_amdgcn_cvt_pk_fp8_f32(P[BASE + 0], P[BASE + 1], 0, false); a_ = __builtin_amdgcn_cvt_pk_fp8_f32(P[BASE + 2], P[BASE + 3], a_, true); a_; })
  pa = (i32x8){PK4(p0, 0), PK4(p0, 4), PK4(p0, 8), PK4(p0, 12), PK4(p1, 0), PK4(p1, 4), PK4(p1, 8), PK4(p1, 12)};
#undef PK4
}
__device__ __forceinline__ u32x2 bf8_fp8(const bf16x8& v) {
  const u32x4 w = *reinterpret_cast<const u32x4*>(&v);
  int a = __builtin_amdgcn_cvt_pk_fp8_f32(bf_lo(w.x), bf_hi(w.x), 0, false); a = __builtin_amdgcn_cvt_pk_fp8_f32(bf_lo(w.y), bf_hi(w.y), a, true);
  int b = __builtin_amdgcn_cvt_pk_fp8_f32(bf_lo(w.z), bf_hi(w.z), 0, false); b = __builtin_amdgcn_cvt_pk_fp8_f32(bf_lo(w.w), bf_hi(w.w), b, true);
  return (u32x2){(unsigned)a, (unsigned)b};
}
__device__ __forceinline__ void qkt(f32x16& p0, f32x16& p1, const char* Ks, const i32x8 (&q8)[3], int koff) {
  p0 = f32x16{}; p1 = f32x16{};
#pragma unroll
  for (int s = 0; s < 3; ++s) { const char* a = Ks + koff + 64 * s;
    const i32x8 b0 = __builtin_shufflevector(*reinterpret_cast<const i32x4*>(a), *reinterpret_cast<const i32x4*>(a + 16), 0, 1, 2, 3, 4, 5, 6, 7);
    const i32x8 b1 = __builtin_shufflevector(*reinterpret_cast<const i32x4*>(a + 32 * KP), *reinterpret_cast<const i32x4*>(a + 32 * KP + 16), 0, 1, 2, 3, 4, 5, 6, 7);
    p0 = __builtin_amdgcn_mfma_scale_f32_32x32x64_f8f6f4(b0, q8[s], p0, 0, 0, 0, 0, 0, 0);
    p1 = __builtin_amdgcn_mfma_scale_f32_32x32x64_f8f6f4(b1, q8[s], p1, 0, 0, 0, 0, 0, 0); }
}
__device__ __forceinline__ int v_st(int k, int c) { const int kk = (k & ~0xC) | ((k & 4) << 1) | ((k & 8) >> 1); return ((kk >> 3) * 4 + (c >> 5)) * 512 + ((kk & 7) * 32 + (c & 31)) * 2; }
__device__ __forceinline__ int v_rd_base(int lane) { return ((lane & 3) << 3) | (((lane >> 2) & 3) << 6) | (((lane >> 4) & 1) << 5) | (((lane >> 5) & 1) << 8); }
constexpr int v_rd_off(int d0, int ks, int half) { return d0 * 512 + ks * 4096 + half * 2048; }
template <int OFF> __device__ __forceinline__ s16x4 tr_read(int vb) {
  s16x4 r; asm volatile("ds_read_b64_tr_b16 %0, %1 offset:%2" : "=&v"(r) : "v"(vb), "i"(OFF) : "memory"); return r;
}
template <int D0> __device__ __forceinline__ void pv_one(f32x16& od, const char* vb, const i32x8& pa) {
  const i32x8 v = __builtin_shufflevector(*reinterpret_cast<const i32x4*>(vb + D0 * 32 * VP), *reinterpret_cast<const i32x4*>(vb + D0 * 32 * VP + 16), 0, 1, 2, 3, 4, 5, 6, 7);
  od = __builtin_amdgcn_mfma_scale_f32_32x32x64_f8f6f4(pa, v, od, 0, 0, 0, 0, 0, 0);
}
__device__ __forceinline__ void pv_d0(f32x16* o, const char* vb, const i32x8& pa) {
  pv_one<0>(o[0], vb, pa); pv_one<1>(o[1], vb, pa); pv_one<2>(o[2], vb, pa); pv_one<3>(o[3], vb, pa);
}

__device__ __forceinline__ void attn_unit(const bf16_t* __restrict__ Qg, const bf16_t* __restrict__ KVb, const unsigned char* __restrict__ VT8, const bf16_t* __restrict__ KPE, bf16_t* __restrict__ Og, const float* __restrict__ ROPE,
                                          int qrow0, int qt0, int h, int crow0, int lrow0, int NT, char* lds) {
  const int tid = opaque_tid(), wid = tid >> 6, lane = tid & 63, r32 = lane & 31, hi = lane >> 5;
  char* V_lds = lds; char* K_lds = lds + 2 * SHM_V;
  float* ws = (float*)(lds + 2 * SHM_V + 2 * SHM_K) + wid * 64; float* li_l = ws; float* al_l = ws + 32;
  float m_reg = -1e30f, l_reg = 0; f32x16 o[4] = {}; i32x8 q8[3];
  { const unsigned char* Q8w = (const unsigned char*)Qg + (size_t)(qrow0 + wid * QBLK + r32) * 1024 + h * 128 + 32 * hi;
#pragma unroll
    for (int s = 0; s < 2; ++s) q8[s] = __builtin_shufflevector(*reinterpret_cast<const i32x4*>(Q8w + 64 * s), *reinterpret_cast<const i32x4*>(Q8w + 64 * s + 16), 0, 1, 2, 3, 4, 5, 6, 7); }
  const bf16_t* Qw = (const bf16_t*)((const unsigned char*)Qg + (size_t)NROWS * 1024) + (size_t)(qrow0 + wid * QBLK + r32) * 512 + h * 64 + hi * 8 - 128;
  { u32x2 c[4];
#pragma unroll
    for (int d0 = 8; d0 < 12; ++d0) {
      const u32x4 qv = *reinterpret_cast<const u32x4*>(Qw + d0 * 16);
      f32x4 ca = {1.f, 0.f, 1.f, 0.f}, cb = {1.f, 0.f, 1.f, 0.f};
      if (qt0 >= 0) { const float* cs = ROPE + ((size_t)(qt0 + wid * QBLK + r32) * 32 + 8 * (d0 - 8) + 4 * hi) * 2; ca = *(const f32x4*)cs; cb = *(const f32x4*)(cs + 4); }
      float x0, x1; int a, b;
      x0 = bf_lo(qv.x); x1 = bf_hi(qv.x); a = __builtin_amdgcn_cvt_pk_fp8_f32(x0 * ca[0] - x1 * ca[1], x0 * ca[1] + x1 * ca[0], 0, false);
      x0 = bf_lo(qv.y); x1 = bf_hi(qv.y); a = __builtin_amdgcn_cvt_pk_fp8_f32(x0 * ca[2] - x1 * ca[3], x0 * ca[3] + x1 * ca[2], a, true);
      x0 = bf_lo(qv.z); x1 = bf_hi(qv.z); b = __builtin_amdgcn_cvt_pk_fp8_f32(x0 * cb[0] - x1 * cb[1], x0 * cb[1] + x1 * cb[0], 0, false);
      x0 = bf_lo(qv.w); x1 = bf_hi(qv.w); b = __builtin_amdgcn_cvt_pk_fp8_f32(x0 * cb[2] - x1 * cb[3], x0 * cb[3] + x1 * cb[2], b, true);
      c[d0 - 8] = (u32x2){(unsigned)a, (unsigned)b}; }
    q8[2] = (i32x8){(int)c[0].x, (int)c[0].y, (int)c[1].x, (int)c[1].y, (int)c[2].x, (int)c[2].y, (int)c[3].x, (int)c[3].y}; }
  const int koff = r32 * KP + 32 * hi;
  const int pr = tid >> 3, pc = tid & 7, prt = 16 * (pr & 3) + (pr >> 2);
  const int vrow = tid >> 2, vpc = (tid & 3) * 16;
  const int kst = pr * KP + 16 * pc, pst = pr * KP + 128 + 8 * pc;
  const char* vb0 = V_lds + r32 * VP + 32 * hi;
  u32x4 vs0, ks0; u32x2 kp;
#define TROW(j) ((j) < 4 ? crow0 + 64 * (j) : lrow0 + 64 * ((j) - 4))
#define SLOAD(j) do { const int k0_ = TROW(j); \
    vs0 = *reinterpret_cast<const u32x4*>(VT8 + ((size_t)((k0_ >> 6) * 8 + h) * DV + vrow) * 64 + vpc); \
    ks0 = *reinterpret_cast<const u32x4*>((const unsigned char*)KVb + (size_t)(k0_ + prt) * 1024 + h * 128 + 16 * pc); } while (0)
#define PLOAD(j) do { kp = *reinterpret_cast<const u32x2*>((const unsigned char*)KPE + (size_t)(TROW(j) + prt) * 64 + 8 * pc); } while (0)
#define SWRITE(b) do { *(u32x4*)(V_lds + (b) * SHM_V + vrow * VP + vpc) = vs0; \
    *(u32x4*)(K_lds + (b) * SHM_K + kst) = ks0; *(u32x2*)(K_lds + (b) * SHM_K + pst) = kp; } while (0)
#define SWAIT() asm volatile("s_waitcnt vmcnt(0)" ::: "memory")
#define RESC(a) do { if (__any((a) < 1.f)) { if (hi == 0) al_l[r32] = (a); asm volatile("s_waitcnt lgkmcnt(0)" ::: "memory"); \
    _Pragma("unroll") for (int d = 0; d < 4; ++d) _Pragma("unroll") for (int r = 0; r < 16; ++r) o[d][r] *= al_l[crow(r, hi)]; } } while (0)
  f32x16 pA0, pA1, pB0, pB1; float mnA, mnB, alA, alB; i32x8 pa;
  SLOAD(0); PLOAD(0); SWAIT(); SWRITE(0); __syncthreads();
  qkt(pA0, pA1, K_lds, q8, koff); partialSM(pA0, pA1, m_reg, mnA, alA);
  SLOAD(1); PLOAD(1);
  SWAIT(); SWRITE(1); __syncthreads();
  for (int j = 1; j + 1 < NT; j += 2) {
    SLOAD(j + 1); SBAR();
    qkt(pB0, pB1, K_lds + SHM_K, q8, koff);
    finishSM(pA0, pA1, alA, l_reg, pa); SBAR();
    PLOAD(j + 1); SBAR();
    pv_d0(o, vb0, pa); partialSM(pB0, pB1, m_reg, mnB, alB);
    __syncthreads(); SWAIT(); SWRITE(0);
    RESC(alB); __syncthreads();
    SLOAD(j + 2); SBAR();
    qkt(pA0, pA1, K_lds, q8, koff);
    finishSM(pB0, pB1, alB, l_reg, pa); SBAR();
    PLOAD(j + 2); SBAR();
    pv_d0(o, vb0 + SHM_V, pa); partialSM(pA0, pA1, m_reg, mnA, alA);
    __syncthreads(); SWAIT(); SWRITE(1);
    RESC(alA); __syncthreads();
  }
  SBAR(); qkt(pB0, pB1, K_lds + SHM_K, q8, koff);
  finishSM(pA0, pA1, alA, l_reg, pa); SBAR();
  pv_d0(o, vb0, pa); partialSM(pB0, pB1, m_reg, mnB, alB);
  __syncthreads(); RESC(alB);
  finishSM(pB0, pB1, alB, l_reg, pa); SBAR();
  pv_d0(o, vb0 + SHM_V, pa);
  if (hi == 0) li_l[r32] = l_reg; asm volatile("s_waitcnt lgkmcnt(0)" ::: "memory");
  float rli[16];
#pragma unroll
  for (int r = 0; r < 16; ++r) rli[r] = __builtin_amdgcn_rcpf(li_l[crow(r, hi)]);
  bf16_t* Ow = Og + (size_t)(qrow0 + wid * QBLK) * DM + h * DV;
#pragma unroll
  for (int r = 0; r < 16; ++r) { const int orow = crow(r, hi);
#pragma unroll
    for (int d0 = 0; d0 < 4; ++d0) Ow[(size_t)orow * DM + d0 * 32 + r32] = (bf16_t)(cvtpk(o[d0][r] * rli[r], 0.f) & 0xffffu); }
  __syncthreads();
#undef TROW
#undef SLOAD
#undef PLOAD
#undef SWRITE
#undef SWAIT
#undef RESC
}
#undef SBAR
}
constexpr int NWAVES = 8;
constexpr int RING_BYTES = 131072, LDSCTL_OFF = RING_BYTES, LDS_BYTES = 147456;

struct Args {
    const float* in[31]; float* out; unsigned char* ws; int stage; int pad;
};
struct Frame {
    LAS unsigned char* lds; int vcu, G; unsigned char* ws;
};
constexpr int PTAB_OFF = 131072 + 512;
__device__ __forceinline__ const float* inp(const Frame& F, int i) {
    const LAS unsigned* t = (const LAS unsigned*)(F.lds + PTAB_OFF) + 2 * i;
    const unsigned lo = __builtin_amdgcn_readfirstlane(t[0]), hi = __builtin_amdgcn_readfirstlane(t[1]);
    return (const float*)(GAS const float*)(((unsigned long long)hi << 32) | lo);
}

__device__ __forceinline__ unsigned f2bf(float f) { unsigned u = __float_as_uint(f); return (u + 0x7fffu + ((u >> 16) & 1u)) >> 16; }
__device__ __forceinline__ unsigned pk2(float lo, float hi) { return f2bf(lo) | (f2bf(hi) << 16); }
__device__ __forceinline__ void cvt_item(const float* srcA, const float* srcB, const float* kscale, bf16_t* dst, int ld, int K, int nrows, int nvalid, int mode, int item, LAS float* scr, int lane, bool fp8 = false, float fscale = W18_SCALE, bool kperm = false) {
    const int nblk = nrows >> 5, kb = item / nblk, nb = item - kb * nblk, k0 = 64 * kb, n0 = 32 * nb;
    const float* src = srcA; int col = n0; bool valid = n0 < nvalid;
    if (mode == 1) { const int t = n0 >> 8, r = n0 & 255; src = r < 128 ? srcA : srcB; col = 128 * t + (r & 127); valid = true; }
    const int kk = lane >> 3, n4 = (lane & 7) * 4;
    f32x4 v[8];
    if (valid) {
        int cofs = col + n4;
        if (mode == 2) { const int t = n0 >> 8, L = n0 & 255, bj = L >> 7, wc = (L >> 5) & 3; cofs = 256 * t + 64 * wc + 16 * (n4 >> 3) + 8 * bj + (n4 & 7); }
        if (mode == 4) { const int np = n0 + n4;
            if (np < 1024) { const int p = np & 127; cofs = 192 * (np >> 7) + 64 * (p >> 6) + 16 * ((p >> 3) & 3) + 8 * ((p >> 5) & 1) + (p & 7); }
            else { const int r = np - 1024; cofs = 192 * (r >> 6) + 128 + (r & 63); } }
        if (mode == 3) { const int p = (n0 + n4) & 255;
            if (p < 128) cofs = ((n0 + n4) & ~255) + 64 * (p >> 6) + 16 * ((p >> 3) & 3) + 8 * ((p >> 5) & 1) + (p & 7); }
        const float* sp = src + (size_t)(k0 + kk) * ld + cofs;
        if (kperm) {
#pragma unroll
            for (int i = 0; i < 8; ++i) { const int rho = k0 + kk + 8 * i; v[i] = *(const f32x4*)(src + (size_t)((rho & ~127) + 32 * (rho & 3) + ((rho & 127) >> 2)) * ld + cofs); }
        } else {
#pragma unroll
        for (int i = 0; i < 8; ++i) v[i] = *(const f32x4*)(sp + (size_t)(8 * i) * ld);
        }
        if (kscale) {
#pragma unroll
            for (int i = 0; i < 8; ++i) v[i] = v[i] * kscale[k0 + 8 * i + kk];
        }
    } else {
#pragma unroll
        for (int i = 0; i < 8; ++i) v[i] = (f32x4){0.f, 0.f, 0.f, 0.f};
    }
#pragma unroll
    for (int i = 0; i < 8; ++i) { LAS float* d = scr + (8 * i + kk) * 33 + n4; d[0] = v[i][0]; d[1] = v[i][1]; d[2] = v[i][2]; d[3] = v[i][3]; }
    asm volatile("s_waitcnt lgkmcnt(0)" ::: "memory");
    const int c = lane & 7;
    if (fp8) {
#pragma unroll
        for (int j = 0; j < 4; ++j) { const int n = (lane >> 3) + 8 * j; const LAS float* s = scr + (8 * c) * 33 + n;
            u32x2 o; o.x = fp8_pack4_s((f32x4){s[0 * 33], s[1 * 33], s[2 * 33], s[3 * 33]}, fscale); o.y = fp8_pack4_s((f32x4){s[4 * 33], s[5 * 33], s[6 * 33], s[7 * 33]}, fscale);
            *(u32x2*)((unsigned char*)dst + (size_t)(n0 + n) * K + k0 + 8 * c) = o; }
    } else {
#pragma unroll
    for (int j = 0; j < 4; ++j) { const int n = (lane >> 3) + 8 * j; const LAS float* s = scr + (8 * c) * 33 + n;
        u32x4 o; o.x = cvt_pk_bf16(s[0 * 33], s[1 * 33]); o.y = cvt_pk_bf16(s[2 * 33], s[3 * 33]); o.z = cvt_pk_bf16(s[4 * 33], s[5 * 33]); o.w = cvt_pk_bf16(s[6 * 33], s[7 * 33]);
        *(u32x4*)(dst + (size_t)(n0 + n) * K + k0 + 8 * c) = o; }
    }
    asm volatile("s_waitcnt lgkmcnt(0)" ::: "memory");
}
constexpr int N_SMALL_JOBS = 11;
__device__ __forceinline__ void convert_small(const Args& a, Frame& F) {
    unsigned char* const wsl = opaque_ptr(a.ws);
    const int tid_ = opaque_tid(), lane_ = tid_ & 63, wave_ = __builtin_amdgcn_readfirstlane(tid_ >> 6);
    LAS float* scr = (LAS float*)(F.lds + wave_ * 16384);
    const int gw = F.vcu * NWAVES + wave_, NGW = F.G * NWAVES;
    unsigned char* ws = wsl;
    int base = 0;
#define SMALL_JOB9(SA, SB, KS, DST, LD, KK, NR, NV, MODE, F8, FS, KP) do { const int n_ = ((KK) >> 6) * ((NR) >> 5); const int first_ = ((gw - base) % NGW + NGW) % NGW; \
        for (int it = first_; it < n_; it += NGW) cvt_item(SA, SB, KS, DST, LD, KK, NR, NV, MODE, it, scr, lane_, F8, FS, KP); base += n_; } while (0)
#define SMALL_JOB8(SA, SB, KS, DST, LD, KK, NR, NV, MODE, F8, FS) SMALL_JOB9(SA, SB, KS, DST, LD, KK, NR, NV, MODE, F8, FS, false)
#define SMALL_JOB(SA, SB, KS, DST, LD, KK, NR, NV, MODE) SMALL_JOB8(SA, SB, KS, DST, LD, KK, NR, NV, MODE, false, 1.f)
    SMALL_JOB8(inp(F, 7), nullptr, nullptr, (bf16_t*)(ws + WS_WDQKV), 704, 1024, 768, 704, 0, FP8_DQKV, WD8_SCALE);
    SMALL_JOB(inp(F, 10), nullptr, inp(F, 8), (bf16_t*)(ws + WS_WUQ), 1536, 384, 1536, 1536, 4);
    SMALL_JOB(inp(F, 11), nullptr, inp(F, 9), (bf16_t*)(ws + WS_WUKV), 2048, 256, 2048, 2048, 3);
    SMALL_JOB9(inp(F, 12), nullptr, nullptr, (bf16_t*)(ws + WS_WO), 1024, 1024, 1024, 1024, 0, FP8_WO, WO8_SCALE, FP8_WO);
    SMALL_JOB8(inp(F, 21), inp(F, 21) + 1024, nullptr, (bf16_t*)(ws + WS_WGLU), 2048, 1024, 2048, 2048, 1, FP8_GLU, WG8_SCALE);
#pragma unroll 1
    for (int l = 0; l < 2; ++l) {
        if (FP8_SH) {
            SMALL_JOB8(inp(F, 28) + (size_t)l * 1024 * 256, inp(F, 29) + (size_t)l * 1024 * 256, nullptr, (bf16_t*)(ws + WS_WSHR + (size_t)l * 512 * 1024), 256, 1024, 512, 512, 1, true, W18_SCALE);
            SMALL_JOB(inp(F, 23) + (size_t)l * 1024 * 64, nullptr, nullptr, (bf16_t*)(ws + WS_WSHR + MiB + (size_t)l * 512 * 1024), 64, 1024, 256, 64, 0);
            if (FP8_SHD) SMALL_JOB8(inp(F, 30) + (size_t)l * 256 * 1024, nullptr, nullptr, (bf16_t*)(ws + WS_WSHD + (size_t)l * 256 * 1024), 1024, 256, 1024, 1024, 2, true, W28_SCALE);
            else SMALL_JOB(inp(F, 30) + (size_t)l * 256 * 1024, nullptr, nullptr, (bf16_t*)(ws + WS_WSHD) + (size_t)l * 1024 * 256, 1024, 256, 1024, 1024, 2);
        } else {
        SMALL_JOB(inp(F, 28) + (size_t)l * 1024 * 256, inp(F, 29) + (size_t)l * 1024 * 256, nullptr, (bf16_t*)(ws + WS_WSHR) + (size_t)l * 768 * 1024, 256, 1024, 512, 512, 1);
        SMALL_JOB(inp(F, 23) + (size_t)l * 1024 * 64, nullptr, nullptr, (bf16_t*)(ws + WS_WSHR) + (size_t)l * 768 * 1024 + (size_t)512 * 1024, 64, 1024, 256, 64, 0);
        SMALL_JOB(inp(F, 30) + (size_t)l * 256 * 1024, nullptr, nullptr, (bf16_t*)(ws + WS_WSHD) + (size_t)l * 1024 * 256, 1024, 256, 1024, 1024, 2);
        }
    }
#undef SMALL_JOB
#undef SMALL_JOB8
#undef SMALL_JOB9
}
__device__ __forceinline__ void convert_experts(const Args& a, Frame& F, int layer, int skip) {
    unsigned char* const wsl = opaque_ptr(a.ws);
    const int tid_ = opaque_tid(), lane_ = tid_ & 63, wave_ = __builtin_amdgcn_readfirstlane(tid_ >> 6);
    LAS float* scr = (LAS float*)(F.lds + wave_ * 16384);
    const int gw = (F.vcu - skip) * NWAVES + wave_, NGW = (F.G - skip) * NWAVES;
    for (int it = gw; it < NEXP * 384; it += NGW) { const int e = it / 384, r = it - e * 384; const size_t eo = ((size_t)layer * NEXP + e) * 1024 * 256;
        if (r < 256) { if ((FP8_G1_LAYERS >> layer) & 1) cvt_item(inp(F, 25) + eo, inp(F, 26) + eo, nullptr, (bf16_t*)(wsl + WS_W1 + (size_t)e * 512 * 1024), 256, 1024, 512, 512, 1, r, scr, lane_, true);
            else cvt_item(inp(F, 25) + eo, inp(F, 26) + eo, nullptr, (bf16_t*)(wsl + WS_W1) + (size_t)e * 512 * 1024, 256, 1024, 512, 512, 1, r, scr, lane_); }
        else if (FP8_G2) cvt_item(inp(F, 27) + eo, nullptr, nullptr, (bf16_t*)(wsl + WS_W2 + (size_t)e * 1024 * 256), 1024, 256, 1024, 1024, 2, r - 256, scr, lane_, true, W28_SCALE);
        else cvt_item(inp(F, 27) + eo, nullptr, nullptr, (bf16_t*)(wsl + WS_W2) + (size_t)e * 1024 * 256, 1024, 256, 1024, 1024, 2, r - 256, scr, lane_); }
}

__device__ __forceinline__ void mod_phase(const Args& a, Frame& F) {
    unsigned char* const wsl = opaque_ptr(a.ws);
    const int tid_ = opaque_tid(), lane_ = tid_ & 63, wave_ = __builtin_amdgcn_readfirstlane(tid_ >> 6);
    LAS float* sl = (LAS float*)F.lds;
    LAS float* red = sl + 17 * 1024;
    float* MOD = (float*)(wsl + WS_MOD);
    bool have = false;
    for (int u = F.vcu; u < 256; u += F.G) {
        if (!have) { for (int i = tid_; i < 17 * 1024; i += 512) { const float v = i < 16 * 1024 ? inp(F, 1)[i] : inp(F, 3)[i - 16 * 1024]; sl[i] = silu_f(v); } __syncthreads(); have = true; }
        const int l = u >> 7, n0 = (u & 127) * 48, kg = tid_ >> 6, cl = (tid_ & 63) < 48 ? (tid_ & 63) : 47, col = n0 + cl;
        const float* W = inp(F, 4) + (size_t)l * 1024 * MODW + col;
        float acc[17];
#pragma unroll
        for (int b = 0; b < 17; ++b) acc[b] = 0.f;
#pragma unroll 2
        for (int k = 128 * kg; k < 128 * kg + 128; k += 4) {
            const float w0 = W[(size_t)k * MODW], w1 = W[(size_t)(k + 1) * MODW], w2 = W[(size_t)(k + 2) * MODW], w3 = W[(size_t)(k + 3) * MODW];
#pragma unroll
            for (int b = 0; b < 17; ++b) { const f32x4 sv = *(const LAS f32x4*)(sl + b * 1024 + k); acc[b] += (sv[0] * w0 + sv[1] * w1) + (sv[2] * w2 + sv[3] * w3); } }
#pragma unroll
        for (int b = 0; b < 17; ++b) red[(kg * 17 + b) * 64 + (tid_ & 63)] = acc[b];
        __syncthreads();
        for (int i = tid_; i < 17 * 64; i += 512) { const int b = i >> 6, c = i & 63; if (c >= 48) continue; float s = inp(F, 5)[(size_t)l * MODW + n0 + c];
#pragma unroll
            for (int g = 0; g < 8; ++g) s += red[(g * 17 + b) * 64 + c];
            MOD[((size_t)l * 17 + b) * MODW + n0 + c] = s; }
        __syncthreads();
    }
}
__device__ __forceinline__ void sincos_red(float ang, float& c, float& s) {
    const float k = rintf(ang * 0.15915494309189535f);
    float r = fmaf(-k, 6.2831854820251465f, ang); r = fmaf(-k, -1.7484555314695172e-07f, r);
    s = __sinf(r); c = __cosf(r);
}
__device__ __forceinline__ void rope_phase(const Args& a, Frame& F) {
    unsigned char* const wsl = opaque_ptr(a.ws);
    const int tid_ = opaque_tid(), lane_ = tid_ & 63, wave_ = __builtin_amdgcn_readfirstlane(tid_ >> 6);
    float* ROPE = (float*)(wsl + WS_ROPE);
    for (int i = (F.vcu * 512 + tid_); i < SEQL * 32; i += F.G * 512) { const int t = i >> 5, p = i & 31, j = p & 15;
        const float f = exp2f(-(float)j * (13.287712379549449f / 16.f)); const float pos = (float)(p < 16 ? (t >> 6) : (t & 63));
        float c, s; sincos_red(pos * f, c, s); ROPE[2 * i] = c; ROPE[2 * i + 1] = s; }
}

__device__ __forceinline__ const float* xrow_in0(const Args& a, const Frame& F, int row) {
    return row < NCTXR ? inp(F, 2) + (size_t)row * DM : inp(F, 0) + (size_t)(row - NCTXR) * DM;
}
__device__ __forceinline__ bf16_t* xrow_bf(const Args& a, int row) {
    unsigned char* const wsl = opaque_ptr(a.ws);
    return row < NCTXR ? (bf16_t*)(wsl + WS_XCTX) + (size_t)row * DM : (bf16_t*)a.out + (size_t)(row - NCTXR) * (2 * DM);
}
__device__ __forceinline__ f32x4 bf4_to_f32(u32x2 w) { return (f32x4){bf_lo(w.x), bf_hi(w.x), bf_lo(w.y), bf_hi(w.y)}; }
__device__ __forceinline__ u32x2 f32_to_bf4(const f32x4& v) { u32x2 w; w.x = cvt_pk_bf16(v[0], v[1]); w.y = cvt_pk_bf16(v[2], v[3]); return w; }
struct NormMod { f32x4 A[4], B[4]; };
__device__ __forceinline__ void normmod_load(NormMod& p, const float* g, const float* shift, const float* scale, int lane) {
#pragma unroll
    for (int j = 0; j < 4; ++j) { const int c = 4 * lane + 256 * j; p.A[j] = *(const f32x4*)(g + c) * (*(const f32x4*)(scale + c) + 1.f); p.B[j] = *(const f32x4*)(shift + c); }
}
__device__ __forceinline__ void norm_mod_store(const f32x4 (&v)[4], const NormMod& p, bf16_t* orow, int lane) {
    float s = 0.f;
#pragma unroll
    for (int j = 0; j < 4; ++j) s += sq4(v[j]);
    const float rstd = __builtin_amdgcn_rsqf(wave_sum(s) * (1.f / DM) + NORM_EPS);
#pragma unroll
    for (int j = 0; j < 4; ++j) { const int c = 4 * lane + 256 * j; const f32x4 h = (v[j] * rstd) * p.A[j] + p.B[j];
        u32x2 w; w.x = cvt_pk_bf16(h[0], h[1]); w.y = cvt_pk_bf16(h[2], h[3]); *(u32x2*)(orow + c) = w; }
}
__device__ __forceinline__ void norm_mod_store8(const f32x4 (&v)[4], const NormMod& p, bf16_t* orow, unsigned char* o8, int lane) {
    float s = 0.f;
#pragma unroll
    for (int j = 0; j < 4; ++j) s += sq4(v[j]);
    const float rstd = __builtin_amdgcn_rsqf(wave_sum(s) * (1.f / DM) + NORM_EPS);
#pragma unroll
    for (int j = 0; j < 4; ++j) { const int c = 4 * lane + 256 * j; const f32x4 h = (v[j] * rstd) * p.A[j] + p.B[j];
        u32x2 w; w.x = cvt_pk_bf16(h[0], h[1]); w.y = cvt_pk_bf16(h[2], h[3]); *(u32x2*)(orow + c) = w; *(unsigned*)(o8 + c) = fp8_pack4_s(h, XN8_SCALE); }
}
__device__ __forceinline__ void norm_mod_store_f8(const f32x4 (&v)[4], const NormMod& p, unsigned char* o8, int lane) {
    float s = 0.f;
#pragma unroll
    for (int j = 0; j < 4; ++j) s += sq4(v[j]);
    const float rstd = __builtin_amdgcn_rsqf(wave_sum(s) * (1.f / DM) + NORM_EPS);
#pragma unroll
    for (int j = 0; j < 4; ++j) { const int c = 4 * lane + 256 * j; const f32x4 h = (v[j] * rstd) * p.A[j] + p.B[j]; *(unsigned*)(o8 + c) = fp8_pack4_s(h, XN8_SCALE); }
}
__device__ __forceinline__ void h_phase(const Args& a, Frame& F, int layer, int row_lo) {
    unsigned char* const wsl = opaque_ptr(a.ws);
    const int tid_ = opaque_tid(), lane_ = tid_ & 63, wave_ = __builtin_amdgcn_readfirstlane(tid_ >> 6);
    const float* MOD = (const float*)(wsl + WS_MOD) + (size_t)layer * 17 * MODW; const float* g = inp(F, 6) + (size_t)(layer * 4 + 0) * DM; bf16_t* XN = (bf16_t*)(wsl + WS_XN);
    const int rpw = (NROWS - row_lo) / (F.G * NWAVES); int row = row_lo + (F.vcu * NWAVES + wave_) * rpw; const int rend = row + rpw;
    f32x4 nx[4]; NormMod nm; int cur_mi = -1;
    if (row < rend) { const float* x = xrow_in0(a, F, row);
#pragma unroll
        for (int j = 0; j < 4; ++j) nx[j] = *(const f32x4*)(x + 4 * lane_ + 256 * j); }
    for (; row < rend; ++row) {
        f32x4 v[4];
#pragma unroll
        for (int j = 0; j < 4; ++j) v[j] = nx[j];
        if (row + 1 < rend) { const float* x = xrow_in0(a, F, row + 1);
#pragma unroll
            for (int j = 0; j < 4; ++j) nx[j] = *(const f32x4*)(x + 4 * lane_ + 256 * j); }
        const int mi = mod_index(row);
        if (mi != cur_mi) { const float* m = MOD + (size_t)mi * MODW; normmod_load(nm, g, m + 0 * DM, m + 1 * DM, lane_); cur_mi = mi; }
        if (FP8_DQKV) norm_mod_store_f8(v, nm, wsl + WS_XN8 + (size_t)row * DM, lane_);
        else norm_mod_store(v, nm, XN + (size_t)row * DM, lane_);
    }
}
__device__ __forceinline__ void postmix_phase(const Args& a, Frame& F, int layer, int row_lo, int NS) {
    unsigned char* const wsl = opaque_ptr(a.ws);
    const int tid_ = opaque_tid(), lane_ = tid_ & 63, wave_ = __builtin_amdgcn_readfirstlane(tid_ >> 6);
    const float* MOD = (const float*)(wsl + WS_MOD) + (size_t)layer * 17 * MODW; const float* g1 = inp(F, 6) + (size_t)(layer * 4 + 1) * DM; const float* g2 = inp(F, 6) + (size_t)(layer * 4 + 2) * DM;
    bf16_t* XN = (bf16_t*)(wsl + WS_XN); const bf16_t* OO = (const bf16_t*)(wsl + WS_OO); const float* SSQO = (const float*)(wsl + WS_SSQO);
    const int rpw = (NROWS - row_lo) / (F.G * NWAVES); int row = row_lo + (F.vcu * NWAVES + wave_) * rpw; const int rend = row + rpw;
    f32x4 nx[4]; u32x2 no[4]; float nss = 0.f; NormMod nm; f32x4 P1[4]; int cur_mi = -1;
#define PM_LOAD(R) do { if (layer == 0) { const float* x_ = xrow_in0(a, F, (R)); _Pragma("unroll") for (int j = 0; j < 4; ++j) nx[j] = *(const f32x4*)(x_ + 4 * lane_ + 256 * j); } \
        else { const bf16_t* x_ = xrow_bf(a, (R)); _Pragma("unroll") for (int j = 0; j < 4; ++j) nx[j] = bf4_to_f32(*(const u32x2*)(x_ + 4 * lane_ + 256 * j)); } \
        _Pragma("unroll") for (int j = 0; j < 4; ++j) { const int c = 4 * lane_ + 256 * j; no[j] = *(const u32x2*)(OO + (size_t)(R) * DM + c); } \
        nss = lane_ < NS ? SSQO[(size_t)(R) * 32 + lane_] : 0.f; } while (0)
    if (row < rend) PM_LOAD(row);
    for (; row < rend; ++row) {
        f32x4 xv[4]; u32x2 ov[4]; float ss = nss;
#pragma unroll
        for (int j = 0; j < 4; ++j) { xv[j] = nx[j]; ov[j] = no[j]; }
        if (row + 1 < rend) PM_LOAD(row + 1);
        const int mi = mod_index(row);
        if (mi != cur_mi) { const float* m = MOD + (size_t)mi * MODW; normmod_load(nm, g2, m + 3 * DM, m + 4 * DM, lane_);
#pragma unroll
            for (int j = 0; j < 4; ++j) { const int c = 4 * lane_ + 256 * j; P1[j] = *(const f32x4*)(g1 + c) * *(const f32x4*)(m + 2 * DM + c); }
            cur_mi = mi; }
        bf16_t* xo = xrow_bf(a, row);
        ss = wave_sum(ss);
        const float rstd = __builtin_amdgcn_rsqf(ss * (1.f / DM) + NORM_EPS);
        f32x4 v[4];
#pragma unroll
        for (int j = 0; j < 4; ++j) { const int c = 4 * lane_ + 256 * j;
            const f32x4 o = {bf_lo(ov[j].x), bf_hi(ov[j].x), bf_lo(ov[j].y), bf_hi(ov[j].y)};
            v[j] = xv[j] + P1[j] * (o * rstd); *(u32x2*)(xo + c) = f32_to_bf4(v[j]); }
        if ((FP8_G1_LAYERS >> layer) & 1) norm_mod_store8(v, nm, XN + (size_t)row * DM, wsl + WS_XN8 + (size_t)row * DM, lane_);
        else norm_mod_store(v, nm, XN + (size_t)row * DM, lane_);
    }
#undef PM_LOAD
}
constexpr size_t WS_Y     = WS_ST;
constexpr size_t WS_H0    = WS_ST + 180 * MiB;
constexpr size_t WS_H1    = WS_ST + 260 * MiB;
constexpr size_t WS_HSH   = WS_ST + 340 * MiB;
constexpr size_t WS_LOG   = WS_H1;
constexpr size_t WS_SELI  = WS_ST + 394 * MiB;
constexpr size_t WS_SELW  = WS_SELI + (size_t)NROWS * 32;
constexpr size_t WS_LDST  = WS_ST + 397 * MiB;
constexpr size_t WS_LW    = WS_LDST + 1536 * 1024;
constexpr size_t WS_BLKCNT= WS_ST + 400 * MiB;
constexpr size_t WS_TINFO = WS_BLKCNT + 256 * 192 * 4;
constexpr int NLIST = 128, YROWS = 5;
static_assert(WS_TINFO + 4 * (512 + 1600) <= WS_END && WS_SELW + (size_t)NROWS * 32 <= WS_LDST && WS_XN8 + 36 * MiB <= WS_SELI && WS_HSH + 18 * MiB <= WS_XN8, "MoE stage map");

template <int NT_, int LDA_, bool PERM_> struct DenseRow0 : DenseBase<NT_, LDA_, PERM_> { int row0; };

struct PolShr : DenseRow0<16, 2048, true> {
    bf16_t* HSH; float* LOG;
    __device__ __forceinline__ void epi(const f32x4 (&acc)[2][2][4][2], const DUnit& u, int wr, int wc, int fr, int fq) const {
#pragma unroll
        for (int ai = 0; ai < 2; ++ai)
#pragma unroll
            for (int m = 0; m < 4; ++m) {
                const int row = row0 + u.pm * 256 + ai * 128 + wr * 64 + m * 16 + fr;
                if (u.pn < 2) {
                    f32x4 h0, h1;
#pragma unroll
                    for (int j = 0; j < 4; ++j) { h0[j] = silu_f(acc[ai][0][m][0][j]) * acc[ai][1][m][0][j]; h1[j] = silu_f(acc[ai][0][m][1][j]) * acc[ai][1][m][1][j]; }
                    store8(HSH + (size_t)row * 256 + u.pn * 128 + wc * 32 + 8 * fq, h0, h1);
                } else if (wc < 2) {
                    float* lp = LOG + (size_t)row * 64 + wc * 32 + 8 * fq; *(f32x4*)lp = acc[ai][0][m][0]; *(f32x4*)(lp + 4) = acc[ai][0][m][1];
                }
            }
    }
};

struct PolShr8 : DenseRow0<8, 1024, true> {
    static constexpr bool FP8 = true;
    unsigned char* HSH;
    __device__ __forceinline__ void epi(const f32x4 (&acc)[2][2][4][2], const DUnit& u, int wr, int wc, int fr, int fq) const {
#pragma unroll
        for (int ai = 0; ai < 2; ++ai)
#pragma unroll
            for (int m = 0; m < 4; ++m) {
                const int row = row0 + u.pm * 256 + ai * 128 + wr * 64 + m * 16 + fr;
                f32x4 h0, h1;
#pragma unroll
                for (int j = 0; j < 4; ++j) { h0[j] = silu_f(acc[ai][0][m][0][j] * G1_DESCALE) * (acc[ai][1][m][0][j] * G1_DESCALE); h1[j] = silu_f(acc[ai][0][m][1][j] * G1_DESCALE) * (acc[ai][1][m][1][j] * G1_DESCALE); }
                if (FP8_SHD) { u32x2 q; q.x = fp8_pack4_s(h0, H8_SCALE); q.y = fp8_pack4_s(h1, H8_SCALE); *(u32x2*)(HSH + (size_t)row * 256 + u.pn * 128 + wc * 32 + 8 * fq) = q; }
                else store8((bf16_t*)HSH + (size_t)row * 256 + u.pn * 128 + wc * 32 + 8 * fq, h0, h1);
            }
    }
};
struct PolRtr : DenseRow0<16, 2048, true> {
    static constexpr bool NOB1 = true;
    float* LOG;
    __device__ __forceinline__ void epi(const f32x4 (&acc)[2][2][4][2], const DUnit& u, int wr, int wc, int fr, int fq) const {
        if (wc >= 2) return;
#pragma unroll
        for (int ai = 0; ai < 2; ++ai)
#pragma unroll
            for (int m = 0; m < 4; ++m) {
                const int row = row0 + u.pm * 256 + ai * 128 + wr * 64 + m * 16 + fr;
                float* lp = LOG + (size_t)row * 64 + wc * 32 + 8 * fq; *(f32x4*)lp = acc[ai][0][m][0]; *(f32x4*)(lp + 4) = acc[ai][0][m][1];
            }
    }
};
__device__ __forceinline__ float grp8_max(float v) {
    v = fmaxf(v, __int_as_float(__builtin_amdgcn_update_dpp(__float_as_int(v), __float_as_int(v), 0xB1, 0xf, 0xf, false)));
    v = fmaxf(v, __int_as_float(__builtin_amdgcn_update_dpp(__float_as_int(v), __float_as_int(v), 0x4E, 0xf, 0xf, false)));
    v = fmaxf(v, __int_as_float(__builtin_amdgcn_update_dpp(__float_as_int(v), __float_as_int(v), 0x141, 0xf, 0xf, false)));
    return v;
}
__device__ __forceinline__ float wave_sum_dpp(float v) {
    v += __int_as_float(__builtin_amdgcn_update_dpp(0, __float_as_int(v), 0xB1, 0xf, 0xf, false));
    v += __int_as_float(__builtin_amdgcn_update_dpp(0, __float_as_int(v), 0x4E, 0xf, 0xf, false));
    v += __int_as_float(__builtin_amdgcn_update_dpp(0, __float_as_int(v), 0x141, 0xf, 0xf, false));
    v += __int_as_float(__builtin_amdgcn_update_dpp(0, __float_as_int(v), 0x140, 0xf, 0xf, false));
    const float a = __int_as_float(__builtin_amdgcn_readlane(__float_as_int(v), 0)), b = __int_as_float(__builtin_amdgcn_readlane(__float_as_int(v), 16));
    const float c = __int_as_float(__builtin_amdgcn_readlane(__float_as_int(v), 32)), d = __int_as_float(__builtin_amdgcn_readlane(__float_as_int(v), 48));
    return (a + b) + (c + d);
}
__device__ __forceinline__ float wave_max(float v) {
    v = fmaxf(v, __int_as_float(__builtin_amdgcn_update_dpp(__float_as_int(v), __float_as_int(v), 0xB1, 0xf, 0xf, false)));
    v = fmaxf(v, __int_as_float(__builtin_amdgcn_update_dpp(__float_as_int(v), __float_as_int(v), 0x4E, 0xf, 0xf, false)));
    v = fmaxf(v, __int_as_float(__builtin_amdgcn_update_dpp(__float_as_int(v), __float_as_int(v), 0x141, 0xf, 0xf, false)));
    v = fmaxf(v, __int_as_float(__builtin_amdgcn_update_dpp(__float_as_int(v), __float_as_int(v), 0x140, 0xf, 0xf, false)));
    const float a = __int_as_float(__builtin_amdgcn_readlane(__float_as_int(v), 0)), b = __int_as_float(__builtin_amdgcn_readlane(__float_as_int(v), 16));
    const float c = __int_as_float(__builtin_amdgcn_readlane(__float_as_int(v), 32)), d = __int_as_float(__builtin_amdgcn_readlane(__float_as_int(v), 48));
    return fmaxf(fmaxf(a, b), fmaxf(c, d));
}
__device__ __forceinline__ int slot_round(int s) { return s >> 2; }
__device__ __forceinline__ int slot_yrow(int s) { return (s & 3) + 1; }
__device__ __forceinline__ void route_one(float lg, float bias, int lane, int& rank_o, bool& sel_o, float& w_o) {
    const float sc = sigmoid_f(lg), bs = sc + bias;
    float m1 = bs;
    m1 = grp8_max(m1);
    const unsigned long long eqm = __ballot(bs == m1);
    const int grp = lane >> 3; const unsigned gm = (unsigned)((eqm >> (grp * 8)) & 0xffull);
    float v2 = (bs == m1) ? -INFINITY : bs;
    v2 = grp8_max(v2);
    const float m2 = (__popc(gm) >= 2) ? m1 : v2;
    const float gs = m1 + m2;
    int grank = 0;
#pragma unroll
    for (int j = 0; j < 8; ++j) { const float o = __int_as_float(__builtin_amdgcn_readlane(__float_as_int(gs), j * 8)); grank += (o > gs || (o == gs && j < grp)) ? 1 : 0; }
    const float mv = grank < 4 ? bs : -INFINITY;
    int rank = TOPK; float cur = mv;
#pragma unroll
    for (int it = 0; it < TOPK; ++it) {
        const float m = wave_max(cur);
        const unsigned long long hit = __ballot(cur == m);
        const int jl = __ffsll((long long)hit) - 1;
        if (lane == jl) { rank = it; cur = -INFINITY; }
    }
    const bool sel = rank < TOPK && grank < 4;
    const float ssum = wave_sum_dpp(sel ? sc : 0.f);
    rank_o = rank; sel_o = sel; w_o = sc / ssum * 2.5f;
}
__device__ __forceinline__ void route_phase(const Args& a, Frame& F, int layer, int row_lo, int tpb) {
    unsigned char* const wsl = opaque_ptr(a.ws);
    const int tid_ = opaque_tid(), lane = tid_ & 63, wave = __builtin_amdgcn_readfirstlane(tid_ >> 6);
    LAS int* cnt = (LAS int*)F.lds;
    for (int i = tid_; i < NLIST; i += 512) cnt[i] = 0;
    __syncthreads();
    const float* LOG = (const float*)(wsl + WS_LOG); int* SELI = (int*)(wsl + WS_SELI); float* SELW = (float*)(wsl + WS_SELW);
    const float bias = inp(F, 24)[layer * NEXP + lane];
    const int blk = F.vcu;
    const int rbase = row_lo + blk * tpb;
    float lgA_n = LOG[(size_t)(rbase + wave) * 64 + lane], lgB_n = LOG[(size_t)(rbase + (wave + NWAVES < tpb ? wave + NWAVES : wave)) * 64 + lane];
    for (int t = wave; t < tpb; t += 2 * NWAVES) {
        const bool hasB = t + NWAVES < tpb;
        const int rowA = rbase + t, rowB = rbase + (hasB ? t + NWAVES : t);
        const float lgA = lgA_n, lgB = lgB_n;
        if (t + 2 * NWAVES < tpb) { lgA_n = LOG[(size_t)(rowA + 2 * NWAVES) * 64 + lane]; lgB_n = LOG[(size_t)(rbase + (t + 3 * NWAVES < tpb ? t + 3 * NWAVES : t + 2 * NWAVES)) * 64 + lane]; }
        int rkA, rkB; bool selA, selB; float wA, wB;
        route_one(lgA, bias, lane, rkA, selA, wA); route_one(lgB, bias, lane, rkB, selB, wB);
        if (selA) { const int s = rkA, l = slot_round(s) * 64 + lane;
            SELI[(size_t)rowA * 8 + s] = l | (slot_yrow(s) << 8); SELW[(size_t)rowA * 8 + s] = wA;
            atomicAdd((int*)&cnt[l], 1); }
        if (selB && hasB) { const int s = rkB, l = slot_round(s) * 64 + lane;
            SELI[(size_t)rowB * 8 + s] = l | (slot_yrow(s) << 8); SELW[(size_t)rowB * 8 + s] = wB;
            atomicAdd((int*)&cnt[l], 1); }
    }
    __syncthreads();
    int* BLKCNT = (int*)(wsl + WS_BLKCNT);
    for (int i = tid_; i < NLIST; i += 512) BLKCNT[blk * NLIST + i] = cnt[i];
}
__device__ __forceinline__ void place_phase(const Args& a, Frame& F, int row_lo, int tpb) {
    unsigned char* const wsl = opaque_ptr(a.ws);
    const int tid_ = opaque_tid();
    LAS int* tot = (LAS int*)F.lds; LAS int* mine = tot + 256; LAS int* tst = mine + 256; LAS int* cur = tst + 256;
    const int* BLKCNT = (const int*)(wsl + WS_BLKCNT); const int blk = F.vcu;
    if (tid_ < 256) { tot[tid_] = 0; mine[tid_] = 0; cur[tid_] = 0; }
    __syncthreads();
    if (tid_ < 2 * NLIST) { const int l = tid_ % NLIST, b0 = (tid_ / NLIST) * 128; int s = 0, m = 0;
#pragma unroll 16
        for (int b = b0; b < b0 + 128; ++b) { const int c = (b < F.G) ? BLKCNT[b * NLIST + l] : 0; m += (b < blk) ? c : 0; s += c; }
        atomicAdd((int*)&tot[l], s); atomicAdd((int*)&mine[l], m); }
    __syncthreads();
    if (tid_ == 0) { int acc = 0; for (int l = 0; l < NLIST; ++l) { tst[l] = acc; acc += (tot[l] + 255) >> 8; } tst[NLIST] = acc; }
    __syncthreads();
    int* TINFO = (int*)(wsl + WS_TINFO); int* LDST = (int*)(wsl + WS_LDST); float* LW = (float*)(wsl + WS_LW);
    if (blk == 0) {
        for (int i = tid_; i <= NLIST; i += 512) TINFO[i] = tst[i];
        for (int i = tid_; i < NLIST; i += 512) TINFO[256 + i] = tot[i];
        const int lane = tid_ & 63, wv = tid_ >> 6;
        for (int l = wv; l < NLIST; l += NWAVES) { const int t0 = tst[l], t1 = tst[l + 1];
            for (int t = t0 + lane; t < t1; t += 64) TINFO[512 + t] = l;
            const int c = tot[l], base = t0 * 256;
            for (int p = c + lane; p < (t1 - t0) * 256; p += 64) LDST[base + p] = -1; }
    }
    const int* SELI = (const int*)(wsl + WS_SELI); const float* SELW = (const float*)(wsl + WS_SELW);
    for (int i = tid_; i < tpb * 8; i += 512) { const int row = row_lo + blk * tpb + (i >> 3), s = i & 7;
        const int v = SELI[(size_t)row * 8 + s], l = v & 0xff, yr = v >> 8;
        const int pos = tst[l] * 256 + mine[l] + atomicAdd((int*)&cur[l], 1);
        LDST[pos] = row * YROWS + yr; LW[pos] = SELW[(size_t)row * 8 + s]; }
}

struct MUnit { int T, pn; };
struct PolMoe1 {
    static constexpr bool PERM = true, GATHER = true, TWOSEG = false, HOOK = false;
    static constexpr int NT = 16, KT0 = 16, KS0 = 128, KS1 = 128, LDB = 2048;
    typedef MUnit Unit;
    const char* XN; const char* W1; bf16_t* H; const int* TINFO; const int* LDST; int T0, T1, G, c;
    __device__ __forceinline__ bool next(int i, Unit& u) const { const int L = i * G + c; u.T = T0 + (L >> 1); u.pn = L & 1; return u.T < T1; }
    __device__ __forceinline__ void ctx(const Unit& u, pg8::UCtx<true>& x, const int (&R)[2], const int (&C)[2]) const {
        const int e = __builtin_amdgcn_readfirstlane(TINFO[512 + u.T]) & 63;
        x.a0[0] = XN; x.a0[1] = XN; x.a1[0] = XN; x.a1[1] = XN; x.b = W1 + ((size_t)e * 512 + u.pn * 256) * LDB;
#pragma unroll
        for (int h = 0; h < 2; ++h)
#pragma unroll
            for (int i = 0; i < 2; ++i) { const int d = LDST[u.T * 256 + h * 128 + R[i]]; const int tok = d < 0 ? 0 : d / YROWS; x.vg[h][i] = (unsigned)tok * 2048u + (unsigned)C[i] * 2u; }
    }
    __device__ __forceinline__ unsigned lane_a0(int, int) const { return 0u; }
    __device__ __forceinline__ unsigned goff(unsigned raw, int C) const { const int d = (int)raw; const unsigned tok = d < 0 ? 0u : (unsigned)d / 3u; return tok * 2048u + (unsigned)C * 2u; }
    __device__ __forceinline__ void epi(const f32x4 (&acc)[2][2][4][2], const Unit& u, int wr, int wc, int fr, int fq) const {
#pragma unroll
        for (int ai = 0; ai < 2; ++ai)
#pragma unroll
            for (int m = 0; m < 4; ++m) {
                const int hrow = (u.T - T0) * 256 + ai * 128 + wr * 64 + m * 16 + fr;
                f32x4 h0, h1;
#pragma unroll
                for (int j = 0; j < 4; ++j) { h0[j] = silu_f(acc[ai][0][m][0][j]) * acc[ai][1][m][0][j]; h1[j] = silu_f(acc[ai][0][m][1][j]) * acc[ai][1][m][1][j]; }
                store8(H + (size_t)hrow * 256 + u.pn * 128 + wc * 32 + 8 * fq, h0, h1);
            }
    }
};
struct PolMoe1F {
    static constexpr bool PERM = true, GATHER = true, TWOSEG = false, HOOK = false, FP8 = true;
    static constexpr int NT = 8, KT0 = 8, KS0 = 128, KS1 = 128, LDB = 1024;
    typedef MUnit Unit;
    const char* XN; const char* W1; bf16_t* H; const int* TINFO; const int* LDST; int T0, T1, G, c;
    __device__ __forceinline__ bool next(int i, Unit& u) const { const int L = i * G + c; u.T = T0 + (L >> 1); u.pn = L & 1; return u.T < T1; }
    __device__ __forceinline__ void ctx(const Unit& u, pg8::UCtx<true>& x, const int (&R)[2], const int (&C)[2]) const {
        const int e = __builtin_amdgcn_readfirstlane(TINFO[512 + u.T]) & 63;
        x.a0[0] = XN; x.a0[1] = XN; x.a1[0] = XN; x.a1[1] = XN; x.b = W1 + ((size_t)e * 512 + u.pn * 256) * LDB;
#pragma unroll
        for (int h = 0; h < 2; ++h)
#pragma unroll
            for (int i = 0; i < 2; ++i) { const int d = LDST[u.T * 256 + h * 128 + R[i]]; const int tok = d < 0 ? 0 : d / YROWS; x.vg[h][i] = (unsigned)tok * 1024u + (unsigned)C[i] * 2u; }
    }
    __device__ __forceinline__ unsigned lane_a0(int, int) const { return 0u; }
    __device__ __forceinline__ void epi(const f32x4 (&acc)[2][2][4][2], const Unit& u, int wr, int wc, int fr, int fq) const {
#pragma unroll
        for (int ai = 0; ai < 2; ++ai)
#pragma unroll
            for (int m = 0; m < 4; ++m) {
                const int hrow = (u.T - T0) * 256 + ai * 128 + wr * 64 + m * 16 + fr;
                f32x4 h0, h1;
#pragma unroll
                for (int j = 0; j < 4; ++j) { h0[j] = silu_f(acc[ai][0][m][0][j] * G1_DESCALE) * (acc[ai][1][m][0][j] * G1_DESCALE); h1[j] = silu_f(acc[ai][0][m][1][j] * G1_DESCALE) * (acc[ai][1][m][1][j] * G1_DESCALE); }
                if (FP8_G2) { u32x2 q; q.x = fp8_pack4_s(h0, H8_SCALE); q.y = fp8_pack4_s(h1, H8_SCALE); *(u32x2*)((unsigned char*)H + (size_t)hrow * 256 + u.pn * 128 + wc * 32 + 8 * fq) = q; }
                else store8(H + (size_t)hrow * 256 + u.pn * 128 + wc * 32 + 8 * fq, h0, h1);
            }
    }
};
constexpr int IDX_LDS_OFF = 131072 + 2048;
template <bool RMW> struct PolMoe2 {
    static constexpr bool PERM = true, GATHER = false, TWOSEG = false, HOOK = true, FP8 = FP8_G2;
    static constexpr int NT = FP8_G2 ? 2 : 4, KT0 = NT, KS0 = 128, KS1 = 128, LDB = FP8_G2 ? 256 : 512;
    typedef MUnit Unit;
    const char* H; const char* W2; unsigned char* Y; const int* TINFO; const int* LDST; const float* LW; int T0, T1, G, c;
    __device__ __forceinline__ bool next(int i, Unit& u) const { const int L = i * G + c; u.T = T0 + (L >> 2); u.pn = L & 3; return u.T < T1; }
    __device__ __forceinline__ void ctx(const Unit& u, pg8::UCtx<false>& x, const int (&)[2], const int (&)[2]) const {
        const int e = __builtin_amdgcn_readfirstlane(TINFO[512 + u.T]) & 63;
        x.a0[0] = H + (size_t)(u.T - T0) * 256 * LDB; x.a0[1] = x.a0[0] + 128 * LDB; x.a1[0] = x.a0[0]; x.a1[1] = x.a0[1];
        x.b = W2 + ((size_t)e * 1024 + u.pn * 256) * LDB;
    }
    __device__ __forceinline__ unsigned lane_a0(int R, int C) const { return (unsigned)(R * LDB + C * 2); }
    __device__ __forceinline__ void unit_begin(const Unit& u, int ui, LAS unsigned char* lds, int wid, int lane) const {
        const int par = ui & 1, arr = wid >> 2, r0 = (wid & 3) * 64;
        const unsigned* src = (arr == 0 ? (const unsigned*)LDST : (const unsigned*)LW) + (size_t)u.T * 256 + r0 + lane;
        __builtin_amdgcn_global_load_lds(src, (LAS unsigned*)(lds + IDX_LDS_OFF + ((par * 2 + arr) * 256 + r0) * 4), 4, 0, 0);
    }
    __device__ __forceinline__ void epi_h(const f32x4 (&acc)[2][2][4][2], const Unit& u, int ui, LAS unsigned char* lds, int wr, int wc, int fr, int fq) const {
        const LAS int* dl = (const LAS int*)(lds + IDX_LDS_OFF + ((ui & 1) * 2) * 1024); const LAS float* wl = (const LAS float*)(lds + IDX_LDS_OFF + ((ui & 1) * 2 + 1) * 1024);
        const int cofs = u.pn * 256 + wc * 64 + 16 * fq;
        int d[2][4]; float w[2][4];
#pragma unroll
        for (int ai = 0; ai < 2; ++ai)
#pragma unroll
            for (int m = 0; m < 4; ++m) { const int r = ai * 128 + wr * 64 + m * 16 + fr; d[ai][m] = dl[r]; w[ai][m] = wl[r]; }
        u32x4 o[2][4];
        if (RMW) {
#pragma unroll
            for (int ai = 0; ai < 2; ++ai)
#pragma unroll
                for (int m = 0; m < 4; ++m) o[ai][m] = *(const u32x4*)(Y + (size_t)(d[ai][m] < 0 ? 0 : d[ai][m]) * DM + cofs);
        }
#pragma unroll
        for (int ai = 0; ai < 2; ++ai)
#pragma unroll
            for (int m = 0; m < 4; ++m) {
                if (d[ai][m] >= 0) {
                    const float ww = FP8_G2 ? w[ai][m] * G2_DESCALE : w[ai][m];
                    f32x4 v00 = acc[ai][0][m][0] * ww, v01 = acc[ai][0][m][1] * ww, v10 = acc[ai][1][m][0] * ww, v11 = acc[ai][1][m][1] * ww;
                    if (RMW) { v00 += fp8_unpack4(o[ai][m].x); v01 += fp8_unpack4(o[ai][m].y); v10 += fp8_unpack4(o[ai][m].z); v11 += fp8_unpack4(o[ai][m].w); }
                    u32x4 q; q.x = fp8_pack4(v00); q.y = fp8_pack4(v01); q.z = fp8_pack4(v10); q.w = fp8_pack4(v11);
                    *(u32x4*)(Y + (size_t)d[ai][m] * DM + cofs) = q;
                }
            }
    }
};
struct PolShd : DenseRow0<FP8_SHD ? 2 : 4, FP8_SHD ? 256 : 512, true> {
    static constexpr bool FP8 = FP8_SHD;
    unsigned char* Y;
    __device__ __forceinline__ void epi(const f32x4 (&acc)[2][2][4][2], const DUnit& u, int wr, int wc, int fr, int fq) const {
#pragma unroll
        for (int ai = 0; ai < 2; ++ai)
#pragma unroll
            for (int m = 0; m < 4; ++m) {
                const int row = row0 + u.pm * 256 + ai * 128 + wr * 64 + m * 16 + fr;
                unsigned char* yp = Y + (size_t)row * YROWS * DM + u.pn * 256 + wc * 64 + 16 * fq;
                constexpr float ds = FP8_SHD ? G2_DESCALE : 1.f;
                u32x4 q; q.x = fp8_pack4(acc[ai][0][m][0] * ds); q.y = fp8_pack4(acc[ai][0][m][1] * ds); q.z = fp8_pack4(acc[ai][1][m][0] * ds); q.w = fp8_pack4(acc[ai][1][m][1] * ds);
                *(u32x4*)yp = q;
            }
    }
};

__device__ __forceinline__ void combine_phase(const Args& a, Frame& F, int layer, int row_lo) {
    unsigned char* const wsl = opaque_ptr(a.ws);
    const int tid_ = opaque_tid(), lane_ = tid_ & 63, wave_ = __builtin_amdgcn_readfirstlane(tid_ >> 6);
    const float* MOD = (const float*)(wsl + WS_MOD) + (size_t)layer * 17 * MODW; const float* g3 = inp(F, 6) + (size_t)(layer * 4 + 3) * DM;
    const float* MODn = (const float*)(wsl + WS_MOD) + (size_t)1 * 17 * MODW; const float* gn = inp(F, 6) + (size_t)(1 * 4 + 0) * DM;
    bf16_t* XN = (bf16_t*)(wsl + WS_XN); const unsigned char* Y = (const unsigned char*)(wsl + WS_Y);
    const int rpw = (NROWS - row_lo) / (F.G * NWAVES); int row = row_lo + (F.vcu * NWAVES + wave_) * rpw; const int rend = row + rpw;
    f32x4 nx[4]; unsigned ny[4][YROWS]; NormMod nm; f32x4 P3[4]; int cur_mi = -1;
#define CB_LOAD(R) do { const bf16_t* x_ = xrow_bf(a, (R)); \
        _Pragma("unroll") for (int j = 0; j < 4; ++j) { const int c = 4 * lane_ + 256 * j; nx[j] = bf4_to_f32(*(const u32x2*)(x_ + c)); \
            _Pragma("unroll") for (int r = 0; r < YROWS; ++r) ny[j][r] = *(const unsigned*)(Y + ((size_t)(R) * YROWS + r) * DM + c); } } while (0)
    if (row < rend) CB_LOAD(row);
    for (; row < rend; ++row) {
        bf16_t* xo = xrow_bf(a, row);
        f32x4 f[4], xv[4]; float ss = 0.f;
#pragma unroll
        for (int j = 0; j < 4; ++j) { xv[j] = nx[j]; f[j] = (f32x4){0.f, 0.f, 0.f, 0.f};
#pragma unroll
            for (int r = 0; r < YROWS; ++r) f[j] += fp8_unpack4(ny[j][r]);
            ss += sq4(f[j]); }
        if (row + 1 < rend) CB_LOAD(row + 1);
        const int mi = mod_index(row);
        if (mi != cur_mi) { const float* m = MOD + (size_t)mi * MODW;
#pragma unroll
            for (int j = 0; j < 4; ++j) { const int c = 4 * lane_ + 256 * j; P3[j] = *(const f32x4*)(g3 + c) * *(const f32x4*)(m + 5 * DM + c); }
            if (layer == 0) { const float* mn = MODn + (size_t)mi * MODW; normmod_load(nm, gn, mn + 0 * DM, mn + 1 * DM, lane_); }
            cur_mi = mi; }
        const float rstd = __builtin_amdgcn_rsqf(wave_sum(ss) * (1.f / DM) + NORM_EPS);
        f32x4 v[4];
#pragma unroll
        for (int j = 0; j < 4; ++j) { const int c = 4 * lane_ + 256 * j; v[j] = xv[j] + P3[j] * (f[j] * rstd);
            if (layer == 0) *(u32x2*)(xo + c) = f32_to_bf4(v[j]); else *(f32x4*)((float*)xo + c) = v[j]; }
        if (layer == 0) { if (FP8_S5) norm_mod_store_f8(v, nm, wsl + WS_XN8 + (size_t)row * DM, lane_); else norm_mod_store(v, nm, XN + (size_t)row * DM, lane_); }
    }
#undef CB_LOAD
}
constexpr size_t WS_G    = WS_ST;
constexpr size_t WS_BTY  = FP8_S5 ? 49 * MiB : WS_ST + 180 * MiB;
constexpr size_t WS_BTS  = FP8_S5 ? 73 * MiB : WS_ST + 228 * MiB;
constexpr size_t WS_S    = WS_ST + 280 * MiB;
constexpr size_t WS_XIN  = WS_ST + 64 * MiB;
constexpr size_t WS_LAMT = WS_ROPE + 512 * 1024;
constexpr int S5_T = 32;

static_assert(!FP8_S5 || (FP8_G1_LAYERS == 3 && FP8_G2), "the relocated S5 tables use the halves of the weight regions that fp8 expert weights leave free");
constexpr size_t WS_KD   = FP8_S5 ? 97 * MiB : WS_ST + 352 * MiB;
__device__ __forceinline__ f32x2 cmul(f32x2 a, f32x2 b) { return (f32x2){a.x * b.x - a.y * b.y, a.x * b.y + a.y * b.x}; }
__device__ __forceinline__ void s5_tables_unit(const Args& a, Frame& F, int g, int d, int half) {
    unsigned char* const wsl = opaque_ptr(a.ws);
    const int tid = opaque_tid();
    LAS f32x2* pw = (LAS f32x2*)F.lds; LAS f32x2* bb = pw + 33 * 64; LAS f32x2* cm = bb + 64 * 16;
    bf16_t* BTY = (bf16_t*)(wsl + WS_BTY) + (size_t)g * 512 * 768; bf16_t* BTS = (bf16_t*)(wsl + WS_BTS) + (size_t)g * 256 * 512; float* LAMT = (float*)(wsl + WS_LAMT);
    float* KD = (float*)(wsl + WS_KD) + (size_t)(g * 2 + d) * 8192;
    const float* lre = inp(F, 13); const float* lim = inp(F, 14); const float* lst = inp(F, 15);
    const float* bre = inp(F, 16); const float* bim = inp(F, 17); const float* cre = inp(F, 18); const float* cim = inp(F, 19);
    __syncthreads();
    const float step = __expf(lst[d * 64 + g]);
    for (int i = tid; i < 33 * 64; i += 512) { const int k = i >> 6, p = i & 63; const float lr = lre[(d * 64 + g) * 64 + p], li = lim[(d * 64 + g) * 64 + p];
        const float mag = __expf((float)k * lr * step); float c, s; sincos_red((float)k * (li * step), c, s); pw[i] = (f32x2){mag * c, mag * s}; }
    __syncthreads();
    for (int i = tid; i < 64 * 16; i += 512) { const int p = i >> 4; const float lr = lre[(d * 64 + g) * 64 + p], li = lim[(d * 64 + g) * 64 + p];
        const f32x2 lb = pw[64 + p]; const float inv = 1.f / (lr * lr + li * li);
        const f32x2 kap = {((lb.x - 1.f) * lr + lb.y * li) * inv, (lb.y * lr - (lb.x - 1.f) * li) * inv};
        const size_t o = ((size_t)(d * 64 + g) * 64 + p) * 16 + (i & 15); bb[i] = cmul(kap, (f32x2){bre[o], bim[o]}); }
    for (int i = tid; i < 16 * 64; i += 512) { const size_t o = (size_t)(d * 64 + g) * 1024 + i; cm[i] = (f32x2){cre[o], cim[o]}; }
    __syncthreads();
    if (tid < 64 && half == 0) { const f32x2 l32 = pw[32 * 64 + tid]; LAMT[((d * 64 + g) * 64 + tid) * 2] = l32.x; LAMT[((d * 64 + g) * 64 + tid) * 2 + 1] = l32.y; }
    if ((tid >> 8) == half) { const int k = tid >> 4, ib = (tid >> 2) & 3, jb = tid & 3; float acc[4][4];
#pragma unroll
      for (int x = 0; x < 4; ++x)
#pragma unroll
        for (int y = 0; y < 4; ++y) acc[x][y] = 0.f;
      for (int p = 0; p < 64; ++p) { const f32x2 w = pw[k * 64 + p]; f32x2 t[4], b[4];
#pragma unroll
        for (int x = 0; x < 4; ++x) { t[x] = cmul(cm[(4 * ib + x) * 64 + p], w); b[x] = bb[p * 16 + 4 * jb + x]; }
#pragma unroll
        for (int x = 0; x < 4; ++x)
#pragma unroll
            for (int y = 0; y < 4; ++y) acc[x][y] += t[x].x * b[y].x - t[x].y * b[y].y; }
#pragma unroll
      for (int x = 0; x < 4; ++x) *(f32x4*)(KD + k * 256 + (4 * ib + x) * 16 + 4 * jb) = (f32x4){acc[x][0], acc[x][1], acc[x][2], acc[x][3]}; }
    for (int o = half * 256 * 64 + tid; o < (half + 1) * 256 * 64; o += 512) { const int n = o >> 6, p = o & 63, to = n >> 4, i = n & 15;
        const f32x2 w = cmul(cm[i * 64 + p], pw[(d == 0 ? to + 1 : 32 - to) * 64 + p]);
        if (FP8_S5) *(unsigned short*)((unsigned char*)BTY - (size_t)g * 512 * 768 + (size_t)n * 768 + 512 + 128 * d + 2 * p) = (unsigned short)fp8_pack2_s(w.x, -w.y, QY8_SCALE);
        else *(unsigned*)(BTY + (size_t)n * 768 + 512 + 128 * d + 2 * p) = cvt_pk_bf16(w.x, -w.y); }
    for (int o = half * 32 * 256 + tid; o < (half + 1) * 32 * 256; o += 512) { const int p = o >> 8, kk = (o & 255) * 2, ti = kk >> 4, j = kk & 15;
        const f32x2 pwv = pw[(d == 0 ? 31 - ti : ti) * 64 + p]; const f32x2 v0 = cmul(pwv, bb[p * 16 + j]), v1 = cmul(pwv, bb[p * 16 + j + 1]);
        if (FP8_S5) { unsigned char* b8 = (unsigned char*)BTS - (size_t)g * 256 * 512 + (size_t)(128 * d + 2 * p) * 512 + kk;
            *(unsigned short*)b8 = (unsigned short)fp8_pack2_s(v0.x, v1.x, BS8_SCALE); *(unsigned short*)(b8 + 512) = (unsigned short)fp8_pack2_s(v0.y, v1.y, BS8_SCALE); }
        else { *(unsigned*)(BTS + (size_t)(128 * d + 2 * p) * 512 + kk) = cvt_pk_bf16(v0.x, v1.x); *(unsigned*)(BTS + (size_t)(128 * d + 2 * p + 1) * 512 + kk) = cvt_pk_bf16(v0.y, v1.y); } }
    __syncthreads();
}
__device__ __forceinline__ void s5_tables_phase(const Args& a, Frame& F) { for (int u = F.vcu; u < 256; u += F.G) s5_tables_unit(a, F, u >> 2, (u >> 1) & 1, u & 1); }
__device__ __forceinline__ void s5_toeplitz_phase(const Args& a, Frame& F) {
    unsigned char* const wsl = opaque_ptr(a.ws);
    const int tid = opaque_tid(); LAS float* Kd = (LAS float*)F.lds; const float* dsk = inp(F, 20);
    for (int u = F.vcu; u < 256; u += F.G) { const int g = u >> 2, q = u & 3;
        const float* KD = (const float*)(wsl + WS_KD) + (size_t)g * 16384; bf16_t* BTY = (bf16_t*)(wsl + WS_BTY) + (size_t)g * 512 * 768;
        __syncthreads();
        for (int i = tid; i < 4096; i += 512) *(f32x4*)(Kd + 4 * i) = *(const f32x4*)(KD + 4 * i);
        __syncthreads();
        for (int o = tid; o < 128 * 64; o += 512) { const int n = 128 * q + (o >> 6), kk = (o & 63) * 8, to = n >> 4, i = n & 15, ti = kk >> 4, j0 = kk & 15;
            float v[8];
            const LAS float* kf = Kd + (to >= ti ? (to - ti) * 256 : 8192 + (ti - to) * 256) + i * 16 + j0;
#pragma unroll
            for (int e = 0; e < 8; ++e) v[e] = kf[e];
            if (to == ti) {
#pragma unroll
                for (int e = 0; e < 8; ++e) v[e] += Kd[8192 + i * 16 + j0 + e] + (i == j0 + e ? dsk[g * 16 + i] : 0.f); }
            if (FP8_S5) { u32x2 w; w.x = fp8_pack4_s((f32x4){v[0], v[1], v[2], v[3]}, TY8_SCALE); w.y = fp8_pack4_s((f32x4){v[4], v[5], v[6], v[7]}, TY8_SCALE);
                *(u32x2*)((unsigned char*)BTY - (size_t)g * 512 * 768 + (size_t)n * 768 + kk) = w; }
            else { u32x4 w; w.x = cvt_pk_bf16(v[0], v[1]); w.y = cvt_pk_bf16(v[2], v[3]); w.z = cvt_pk_bf16(v[4], v[5]); w.w = cvt_pk_bf16(v[6], v[7]);
            *(u32x4*)(BTY + (size_t)n * 768 + kk) = w; } }
    }
    __syncthreads();
}

struct SUnit { int g, pm, pn; };
struct PolS5S {
    static constexpr bool PERM = true, GATHER = false, TWOSEG = false, HOOK = false, FP8 = FP8_S5;
    static constexpr int NT = FP8_S5 ? 4 : 8, KT0 = NT, KS0 = 8192, KS1 = 128, LDB = FP8_S5 ? 512 : 1024, TB = FP8_S5 ? 1024 : 2048;
    typedef SUnit Unit;
    const char* XN; const char* BTS; bf16_t* S; int G, c;
    __device__ __forceinline__ bool next(int i, Unit& u) const { const int L = i * G + c; u.g = __builtin_amdgcn_readfirstlane(L / 5); u.pm = __builtin_amdgcn_readfirstlane(L % 5); u.pn = 0; return L < 320; }
    __device__ __forceinline__ void ctx(const Unit& u, pg8::UCtx<false>& x, const int (&)[2], const int (&)[2]) const {
        if (u.pm < 4) { x.a0[0] = XN + ((size_t)NCTXR + (size_t)u.pm * 256 * S5_T) * TB + u.g * (TB / 64); x.a0[1] = x.a0[0] + (size_t)128 * S5_T * TB; }
        else { x.a0[0] = XN + u.g * (TB / 64); x.a0[1] = x.a0[0]; }
        x.a1[0] = x.a0[0]; x.a1[1] = x.a0[1]; x.b = BTS + (size_t)u.g * 256 * LDB;
    }
    __device__ __forceinline__ unsigned lane_a0(int R, int C) const { return FP8_S5 ? (unsigned)(R * (S5_T * 1024) + (C >> 3) * 1024 + (C & 7) * 2) : (unsigned)(R * (S5_T * 2048) + (C >> 4) * 2048 + (C & 15) * 2); }
    __device__ __forceinline__ unsigned lane_a1(int, int) const { return 0u; }
    __device__ __forceinline__ void epi(const f32x4 (&acc)[2][2][4][2], const Unit& u, int wr, int wc, int fr, int fq) const {
#pragma unroll
        for (int ai = 0; ai < 2; ++ai) { if (u.pm == 4 && ai == 1) continue;
#pragma unroll
            for (int m = 0; m < 4; ++m) { const int r = u.pm * 256 + ai * 128 + wr * 64 + m * 16 + fr;
                bf16_t* sp = S + ((size_t)u.g * 1152 + r) * 256 + wc * 32 + 8 * fq;
                constexpr float ds = FP8_S5 ? S5S_DESCALE : 1.f;
                store8(sp, acc[ai][0][m][0] * ds, acc[ai][0][m][1] * ds); store8(sp + 128, acc[ai][1][m][0] * ds, acc[ai][1][m][1] * ds); } }
    }
};
__device__ __forceinline__ void s5_scan_phase(const Args& a, Frame& F) {
    unsigned char* const wsl = opaque_ptr(a.ws);
    const int tid = opaque_tid(); const bf16_t* S = (const bf16_t*)(wsl + WS_S); bf16_t* XIN = (bf16_t*)(wsl + WS_XIN); const float* LAMT = (const float*)(wsl + WS_LAMT);
    for (int idx = F.vcu * 512 + tid; idx < 64 * 16 * 2 * 64; idx += F.G * 512) {
        const int p = idx & 63, d = (idx >> 6) & 1, b = (idx >> 7) & 15, g = idx >> 11;
        const f32x2 Lm = *(const f32x2*)(LAMT + ((d * 64 + g) * 64 + p) * 2);
        const bf16_t* Sg = S + (size_t)g * 1152 * 256 + d * 128 + 2 * p; const int col = d * 128 + 2 * p; bf16_t* Xg = XIN + (size_t)(col >> 4) * 1024 + 16 * g + (col & 15); unsigned char* Xg8 = (unsigned char*)XIN + (size_t)(col >> 4) * 1024 + 16 * g + (col & 15);
        f32x2 x = {0.f, 0.f};
        unsigned sv[8];
#pragma unroll
        for (int k = 0; k < 8; ++k) { const int c = d == 0 ? k : 7 - k; sv[k] = *(const unsigned*)(Sg + (size_t)(1024 + b * 8 + c) * 256); }
#pragma unroll
        for (int k = 0; k < 8; ++k) x = cmul(Lm, x) + (f32x2){bf_lo(sv[k]), bf_hi(sv[k])};
        for (int c0 = 0; c0 < 64; c0 += 8) {
#pragma unroll
            for (int k = 0; k < 8; ++k) { const int c = d == 0 ? c0 + k : 63 - c0 - k; sv[k] = *(const unsigned*)(Sg + (size_t)(b * 64 + c) * 256); }
#pragma unroll
            for (int k = 0; k < 8; ++k) { const int c = d == 0 ? c0 + k : 63 - c0 - k; if (FP8_S5) *(unsigned short*)(Xg8 + (size_t)(b * 64 + c) * 32 * 1024) = (unsigned short)fp8_pack2_s(x.x, x.y, XI8_SCALE); else *(unsigned*)(Xg + (size_t)(b * 64 + c) * 32 * 1024) = cvt_pk_bf16(x.x, x.y); x = cmul(Lm, x) + (f32x2){bf_lo(sv[k]), bf_hi(sv[k])}; }
        }
    }
}
struct PolS5Y {
    static constexpr bool PERM = true, GATHER = false, TWOSEG = true, HOOK = false, FP8 = FP8_S5;
    static constexpr int NT = FP8_S5 ? 6 : 12, KT0 = FP8_S5 ? 4 : 8, KS0 = 8192, KS1 = 8192, LDB = FP8_S5 ? 768 : 1536, TB = FP8_S5 ? 1024 : 2048;
    typedef SUnit Unit;
    const char* XN; const char* XIN; const char* BTY; bf16_t* Gb; int G, c;
    __device__ __forceinline__ bool next(int i, Unit& u) const { const int L = i * G + c; u.g = __builtin_amdgcn_readfirstlane(L >> 3); u.pm = __builtin_amdgcn_readfirstlane((L >> 1) & 3); u.pn = L & 1; return L < 512; }
    __device__ __forceinline__ void ctx(const Unit& u, pg8::UCtx<false>& x, const int (&)[2], const int (&)[2]) const {
        x.a0[0] = XN + ((size_t)NCTXR + (size_t)u.pm * 256 * S5_T) * TB + u.g * (TB / 64); x.a0[1] = x.a0[0] + (size_t)128 * S5_T * TB;
        x.a1[0] = XIN + (size_t)u.pm * 256 * S5_T * TB + u.g * (TB / 64); x.a1[1] = x.a1[0] + (size_t)128 * S5_T * TB;
        x.b = BTY + ((size_t)u.g * 512 + u.pn * 256) * LDB;
    }
    __device__ __forceinline__ unsigned lane_a0(int R, int C) const { return FP8_S5 ? (unsigned)(R * (S5_T * 1024) + (C >> 3) * 1024 + (C & 7) * 2) : (unsigned)(R * (S5_T * 2048) + (C >> 4) * 2048 + (C & 15) * 2); }
    __device__ __forceinline__ void epi(const f32x4 (&acc_)[2][2][4][2], const Unit& u, int wr, int wc, int fr, int fq) const {
        constexpr float ds = FP8_S5 ? S5Y_DESCALE : 1.f;
#pragma unroll
        for (int ai = 0; ai < 2; ++ai)
#pragma unroll
            for (int m = 0; m < 4; ++m) { const int r = u.pm * 256 + ai * 128 + wr * 64 + m * 16 + fr;
                const f32x4 acc[2][2] = {{acc_[ai][0][m][0] * ds, acc_[ai][0][m][1] * ds}, {acc_[ai][1][m][0] * ds, acc_[ai][1][m][1] * ds}};
#pragma unroll
                for (int bj = 0; bj < 2; ++bj) { const int col = u.pn * 256 + bj * 128 + wc * 32 + 8 * fq, to = col >> 4, i0 = col & 15;
                    if (FP8_GLU) { unsigned char* gp8 = (unsigned char*)Gb + ((size_t)r * S5_T + to) * DM + u.g * 16 + i0; u32x2 w;
#pragma unroll
                        for (int n = 0; n < 2; ++n) { f32x4 v;
#pragma unroll
                            for (int j = 0; j < 4; ++j) v[j] = gelu_tanh(acc[bj][n][j]);
                            if (n == 0) w.x = fp8_pack4_s(v, G8_SCALE); else w.y = fp8_pack4_s(v, G8_SCALE); }
                        *(u32x2*)gp8 = w; asm volatile("" ::: "memory"); continue; }
                    bf16_t* gp = Gb + ((size_t)r * S5_T + to) * DM + u.g * 16 + i0;
#pragma unroll
                    for (int n = 0; n < 2; ++n) { f32x4 v;
#pragma unroll
                        for (int j = 0; j < 4; ++j) v[j] = gelu_tanh(acc[bj][n][j]);
                        u32x2 w; w.x = cvt_pk_bf16(v[0], v[1]); w.y = cvt_pk_bf16(v[2], v[3]); *(u32x2*)(gp + 4 * n) = w; asm volatile("" ::: "memory"); } } }
    }
};
struct PolGlu : DenseRow0<FP8_GLU ? 8 : 16, FP8_GLU ? 1024 : 2048, true> {
    static constexpr bool FP8 = FP8_GLU;
    bf16_t* OO; float* SSQO; const float* bias;
    __device__ __forceinline__ void epi(const f32x4 (&acc)[2][2][4][2], const DUnit& u, int wr, int wc, int fr, int fq) const {
        const int c0 = u.pn * 128 + wc * 32 + 8 * fq;
        const f32x4 b10 = *(const f32x4*)(bias + c0), b11 = *(const f32x4*)(bias + c0 + 4), b20 = *(const f32x4*)(bias + 1024 + c0), b21 = *(const f32x4*)(bias + 1024 + c0 + 4);
#pragma unroll
        for (int ai = 0; ai < 2; ++ai)
#pragma unroll
            for (int m = 0; m < 4; ++m) {
                const int row = row0 + u.pm * 256 + ai * 128 + wr * 64 + m * 16 + fr;
                f32x4 o0, o1;
#pragma unroll
                for (int j = 0; j < 4; ++j) { constexpr float ds = FP8_GLU ? GLU_DESCALE : 1.f;
                    o0[j] = (acc[ai][0][m][0][j] * ds + b10[j]) * sigmoid_f(acc[ai][1][m][0][j] * ds + b20[j]); o1[j] = (acc[ai][0][m][1][j] * ds + b11[j]) * sigmoid_f(acc[ai][1][m][1][j] * ds + b21[j]); }
                float s = sq4(o0) + sq4(o1);
                store8(OO + (size_t)row * DM + c0, o0, o1);
                s += __shfl_xor(s, 16); s += __shfl_xor(s, 32);
                if (fq == 0) SSQO[(size_t)row * 32 + u.pn * 4 + wc] = s;
            }
    }
};
#ifndef REP_ATTN
#define REP_ATTN 1
#endif
#ifndef REP_MISC
#define REP_MISC 1
#endif
#ifndef REP_DENSE
#define REP_DENSE 1
#endif
#ifndef REP_G2A
#define REP_G2A 1
#endif
#ifndef STAGGER
#define STAGGER 0
#endif
#ifndef REP_P11X
#define REP_P11X 1
#endif
#ifndef REP_PM0
#define REP_PM0 1
#endif
#ifndef REP_H
#define REP_H 1
#endif
#ifndef REP_G1
#define REP_G1 1
#endif
__device__ __forceinline__ void moe_stage(const Args& args, Frame& F, const XcdBarrier& bar, int layer, int row_lo) {
    const int nrows = NROWS - row_lo, tpb = nrows / F.G;
    if (FP8_SH) {
        {   unsigned char* ws = opaque_ptr(args.ws);
            PolShr8 p; p.A = (const char*)(ws + WS_XN8) + (size_t)row_lo * 1024; p.Bt = (const char*)(ws + WS_WSHR) + (size_t)layer * 512 * 1024; p.nM = nrows / 256; p.nN = 2; p.G = F.G; p.c = (int)blockIdx.x;
            p.row0 = row_lo; p.HSH = (unsigned char*)(ws + WS_HSH); pg8::gemm_phase(F.lds, p); }
        {   unsigned char* ws = opaque_ptr(args.ws);
            PolRtr p; p.A = (const char*)(ws + WS_XN) + (size_t)row_lo * 2048; p.Bt = (const char*)(ws + WS_WSHR) + MiB + (size_t)layer * 512 * 1024; p.nM = nrows / 256; p.nN = 1; p.G = F.G; p.c = F.G - 1 - (int)blockIdx.x;
            p.row0 = row_lo; p.LOG = (float*)(ws + WS_LOG); pg8::gemm_phase(F.lds, p); }
    } else
    {   unsigned char* ws = opaque_ptr(args.ws);
        PolShr p; p.A = (const char*)(ws + WS_XN) + (size_t)row_lo * 2048; p.Bt = (const char*)(ws + WS_WSHR) + (size_t)layer * 768 * 2048; p.nM = nrows / 256; p.nN = 3; p.G = F.G; p.c = (int)blockIdx.x;
        p.row0 = row_lo; p.HSH = (bf16_t*)(ws + WS_HSH); p.LOG = (float*)(ws + WS_LOG);
        for (int rep_ = 0; rep_ < REP_DENSE; ++rep_) pg8::gemm_phase(F.lds, p, rep_ == REP_DENSE - 1, STAGGER);
    }
    if (layer == 1 && args.stage == 7) return;
    xcd_barrier(bar);
    route_phase(args, F, layer, row_lo, tpb);
#if REP_MISC == 2
    __syncthreads(); route_phase(args, F, layer, row_lo, tpb);
#endif
    if (layer == 1 && args.stage == 8) return;
    xcd_barrier(bar);
    place_phase(args, F, row_lo, tpb);
#if REP_MISC == 2
    __syncthreads(); place_phase(args, F, row_lo, tpb);
#endif
    if (layer == 1 && args.stage == 9) return;
    xcd_barrier(bar);
    const int* TINFO = (const int*)(opaque_ptr(args.ws) + WS_TINFO);
    const int ts0 = __builtin_amdgcn_readfirstlane(TINFO[0]), ts1 = __builtin_amdgcn_readfirstlane(TINFO[64]), ts2 = __builtin_amdgcn_readfirstlane(TINFO[128]);
#define MOE_G1(TA, TB, HBUF) do { if ((FP8_G1_LAYERS >> layer) & 1) { unsigned char* ws = opaque_ptr(args.ws); PolMoe1F p; p.XN = (const char*)(ws + WS_XN8); p.W1 = (const char*)(ws + WS_W1); p.H = (bf16_t*)(ws + (HBUF)); p.TINFO = (const int*)(ws + WS_TINFO); p.LDST = (const int*)(ws + WS_LDST); p.T0 = (TA); p.T1 = (TB); p.G = F.G; p.c = F.vcu; \
        for (int rep_ = 0; rep_ < REP_G1; ++rep_) pg8::gemm_phase(F.lds, p, rep_ == REP_G1 - 1); } else MOE_G1B(TA, TB, HBUF); } while (0)
#define MOE_G1B(TA, TB, HBUF) for (int rep_ = 0; rep_ < REP_G1; ++rep_) do { unsigned char* ws = opaque_ptr(args.ws); PolMoe1 p; p.XN = (const char*)(ws + WS_XN); p.W1 = (const char*)(ws + WS_W1); p.H = (bf16_t*)(ws + (HBUF)); p.TINFO = (const int*)(ws + WS_TINFO); p.LDST = (const int*)(ws + WS_LDST); p.T0 = (TA); p.T1 = (TB); p.G = F.G; p.c = F.vcu; \
        pg8::gemm_phase(F.lds, p); } while (0)
#define MOE_G2(RMW, TA, TB, HBUF) do { unsigned char* ws = opaque_ptr(args.ws); PolMoe2<RMW> p; p.H = (const char*)(ws + (HBUF)); p.W2 = (const char*)(ws + WS_W2); p.Y = (unsigned char*)(ws + WS_Y); p.TINFO = (const int*)(ws + WS_TINFO); p.LDST = (const int*)(ws + WS_LDST); p.LW = (const float*)(ws + WS_LW); p.T0 = (TA); p.T1 = (TB); p.G = F.G; p.c = (RMW) ? F.vcu : F.G - 1 - F.vcu; \
        for (int rep_ = 0; rep_ < ((RMW) ? 1 : REP_G2A); ++rep_) pg8::gemm_phase(F.lds, p); } while (0)
#define MOE_SHD() do { unsigned char* ws = opaque_ptr(args.ws); PolShd p; p.A = (const char*)(ws + WS_HSH) + (size_t)row_lo * (FP8_SHD ? 256 : 512); p.Bt = (const char*)(ws + WS_WSHD) + (size_t)layer * 1024 * (FP8_SHD ? 256 : 512); p.nM = nrows / 256; p.nN = 4; p.G = F.G; p.c = F.G - 1 - (int)blockIdx.x;     \
        p.row0 = row_lo; p.Y = (unsigned char*)(ws + WS_Y); pg8::gemm_phase(F.lds, p); } while (0)
    if (blockIdx.x & 1) { MOE_SHD(); MOE_G1(ts0, ts1, WS_H0); } else { MOE_G1(ts0, ts1, WS_H0); MOE_SHD(); }
    if (layer == 1 && args.stage == 10) return;
    xcd_barrier(bar);
    if (blockIdx.x & 1) { MOE_G1(ts1, ts2, WS_H1); MOE_G2(false, ts0, ts1, WS_H0); }
    else { MOE_G2(false, ts0, ts1, WS_H0); MOE_G1(ts1, ts2, WS_H1); }
    xcd_barrier(bar);
    if (!FP8_S5 && layer == 0 && (blockIdx.x & 1)) { s5_tables_phase(args, F); __syncthreads(); }
    MOE_G2(true, ts1, ts2, WS_H1);
    if (!FP8_S5 && layer == 0 && !(blockIdx.x & 1)) { __syncthreads(); s5_tables_phase(args, F); }
    if (layer == 1 && args.stage == 13) return;
    xcd_barrier(bar);
#if REP_P11X == 2
    __syncthreads();
#endif
    if (layer == 0 && (blockIdx.x & 1)) { s5_toeplitz_phase(args, F); __syncthreads(); }
    combine_phase(args, F, layer, row_lo);
    if (layer == 0 && !(blockIdx.x & 1)) { __syncthreads(); s5_toeplitz_phase(args, F); }
#undef MOE_SHD
#undef MOE_G1
#undef MOE_G1B
#undef MOE_G2
}

__global__ void __launch_bounds__(NWAVES * 64, 2) trunk_fwd(Args args) {
    extern __shared__ __attribute__((aligned(16))) unsigned char lds_raw[];
    Frame F;
    F.lds = (LAS unsigned char*)lds_raw;
    F.G = gridDim.x; { const int bx = blockIdx.x; F.vcu = (F.G % 8 == 0) ? (bx % 8) * (F.G / 8) + bx / 8 : bx; }
    F.ws = args.ws;
    volatile LAS unsigned* MISC = (volatile LAS unsigned*)(F.lds + LDSCTL_OFF);
    for (int u = threadIdx.x; u < (LDS_BYTES - LDSCTL_OFF) / 4; u += NWAVES * 64) ((LAS unsigned*)(F.lds + LDSCTL_OFF))[u] = 0u;
    __syncthreads();
    if (threadIdx.x < 31) ((LAS unsigned long long*)(F.lds + PTAB_OFF))[threadIdx.x] = (unsigned long long)args.in[threadIdx.x];
    __syncthreads();
    XcdBarrier bar = xcd_barrier_post((unsigned*)(args.ws + WS_CTL) + CW_BAR, MISC + 8);
#define GRID_BAR() xcd_barrier(bar)

    mod_phase(args, F);
    __syncthreads();
    convert_small(args, F);
    rope_phase(args, F);
#if REP_MISC == 2
    __syncthreads();
    mod_phase(args, F);
    __syncthreads();
    convert_small(args, F);
    rope_phase(args, F);
#endif
    GRID_BAR();
    h_phase(args, F, 0, 0);
#if REP_H == 2
    h_phase(args, F, 0, 0);
#endif
    GRID_BAR();
    {   unsigned char* ws = opaque_ptr(args.ws);
        PolDqkv p; p.A = (const char*)(ws + (FP8_DQKV ? WS_XN8 : WS_XN)); p.Bt = (const char*)(ws + WS_WDQKV); p.nM = NROWS / 256; p.nN = 3; p.G = F.G; p.c = (int)blockIdx.x;
        p.A1 = (bf16_t*)(ws + WS_A1); p.SSQ1 = (float*)(ws + WS_SSQ1); p.KPE = (bf16_t*)(ws + WS_KPE); p.ROPE = (const float*)(ws + WS_ROPE);
        for (int rep_ = 0; rep_ < REP_DENSE; ++rep_) pg8::gemm_phase(F.lds, p, rep_ == REP_DENSE - 1, STAGGER);
    }
    GRID_BAR();
#define RUN_QUP() do { unsigned char* ws = opaque_ptr(args.ws); PolQup p; p.A = (const char*)(ws + WS_A1); p.Bt = (const char*)(ws + WS_WUQ); p.nM = NROWS / 256; p.nN = NQ / 256; p.G = F.G; p.c = (int)blockIdx.x; \
        p.Q = (bf16_t*)(ws + WS_Q); p.SSQ1 = (const float*)(ws + WS_SSQ1); pg8::gemm_phase(F.lds, p); } while (0)
#define RUN_KVUP() do { unsigned char* ws = opaque_ptr(args.ws); PolKVup p; p.A = (const char*)(ws + WS_A1) + QLORA * 2; p.Bt = (const char*)(ws + WS_WUKV); p.nM = NROWS / 256; p.nN = NKV / 256; p.G = F.G; p.c = F.G - 1 - (int)blockIdx.x; \
        p.KV = (bf16_t*)(ws + WS_KV); p.SSQ1 = (const float*)(ws + WS_SSQ1); p.VT8 = ws + WS_XN8; pg8::gemm_phase(F.lds, p); } while (0)
    if (blockIdx.x & 1) { RUN_KVUP(); RUN_QUP(); } else { RUN_QUP(); RUN_KVUP(); }
#undef RUN_QUP
#undef RUN_KVUP
    GRID_BAR();
    {   unsigned char* ws = opaque_ptr(args.ws);
        const bf16_t* Qg = (const bf16_t*)(ws + WS_Q); const bf16_t* KVb = (const bf16_t*)(ws + WS_KV); const bf16_t* KPE = (const bf16_t*)(ws + WS_KPE); bf16_t* Og = (bf16_t*)(ws + WS_O); const float* RP = (const float*)(ws + WS_ROPE);
        if (blockIdx.x & 1) { convert_experts(args, F, 0, 0); __syncthreads(); }
        for (int rep_ = 0; rep_ < REP_ATTN; ++rep_)
        for (int u = F.vcu; u < 1024 + 128; u += F.G) {
            if (u < 1024) { const int bh = u >> 3, qb = u & 7, b = bh >> 3, h = bh & 7;
                attn::attn_unit(Qg, KVb, (const unsigned char*)(ws + WS_XN8), KPE, Og, RP, NCTXR + b * SEQL + qb * 256, qb * 256, h, b * NCTX, NCTXR + b * SEQL, 36, (char*)lds_raw); }
            else { const int bh = u - 1024, b = bh >> 3, h = bh & 7;
                attn::attn_unit(Qg, KVb, (const unsigned char*)(ws + WS_XN8), KPE, Og, RP, b * NCTX, -1, h, b * NCTX, 0, 4, (char*)lds_raw); }
        }
        if (!(blockIdx.x & 1)) { __syncthreads(); convert_experts(args, F, 0, 0); }
    }
    GRID_BAR();
    {   unsigned char* ws = opaque_ptr(args.ws);
        PolWo p; p.A = (const char*)(ws + WS_O); p.Bt = (const char*)(ws + WS_WO); p.nM = NROWS / 256; p.nN = 4; p.G = F.G; p.c = (int)blockIdx.x;
        p.OO = (bf16_t*)(ws + WS_OO); p.SSQO = (float*)(ws + WS_SSQO);
        for (int rep_ = 0; rep_ < REP_DENSE; ++rep_) pg8::gemm_phase(F.lds, p, rep_ == REP_DENSE - 1, STAGGER);
    }
    GRID_BAR();
    if (FP8_S5 && (blockIdx.x & 1)) { s5_tables_phase(args, F); __syncthreads(); }
    postmix_phase(args, F, 0, 0, 16);
    if (FP8_S5 && !(blockIdx.x & 1)) { __syncthreads(); s5_tables_phase(args, F); }
#if REP_PM0 == 2
    postmix_phase(args, F, 0, 0, 16);
#endif
    GRID_BAR();
    moe_stage(args, F, bar, 0, 0);
    if (args.stage == 1) return;
    GRID_BAR();
    {   unsigned char* ws = opaque_ptr(args.ws);
        PolS5S p; p.XN = (const char*)(ws + (FP8_S5 ? WS_XN8 : WS_XN)); p.BTS = (const char*)(ws + WS_BTS); p.S = (bf16_t*)(ws + WS_S); p.G = F.G; p.c = F.vcu;
        for (int rep_ = 0; rep_ < REP_DENSE; ++rep_) pg8::gemm_phase(F.lds, p, rep_ == REP_DENSE - 1, STAGGER);
    }
    if (args.stage == 2) return;
    GRID_BAR();
    s5_scan_phase(args, F);
#if REP_MISC == 2
    s5_scan_phase(args, F);
#endif
    if (args.stage == 3) return;
    GRID_BAR();
    {   unsigned char* ws = opaque_ptr(args.ws);
        PolS5Y p; p.XN = (const char*)(ws + (FP8_S5 ? WS_XN8 : WS_XN)); p.XIN = (const char*)(ws + WS_XIN); p.BTY = (const char*)(ws + WS_BTY); p.Gb = (bf16_t*)(ws + WS_G); p.G = F.G; p.c = F.vcu;
        for (int rep_ = 0; rep_ < REP_DENSE; ++rep_) pg8::gemm_phase(F.lds, p, rep_ == REP_DENSE - 1, STAGGER);
    }
    if (args.stage == 4) return;
    GRID_BAR();
    if (blockIdx.x & 1) { convert_experts(args, F, 1, 0); __syncthreads(); }
    {   unsigned char* ws = opaque_ptr(args.ws);
        PolGlu p; p.A = (const char*)(ws + WS_G); p.Bt = (const char*)(ws + WS_WGLU); p.nM = NLATR / 256; p.nN = 8; p.G = F.G; p.c = (int)blockIdx.x;
        p.row0 = NCTXR; p.OO = (bf16_t*)(ws + WS_OO); p.SSQO = (float*)(ws + WS_SSQO); p.bias = inp(F, 22);
        for (int rep_ = 0; rep_ < REP_DENSE; ++rep_) pg8::gemm_phase(F.lds, p, rep_ == REP_DENSE - 1, STAGGER);
    }
    if (!(blockIdx.x & 1)) { __syncthreads(); convert_experts(args, F, 1, 0); }
    if (args.stage == 5) return;
    GRID_BAR();
    postmix_phase(args, F, 1, NCTXR, 32);
    if (args.stage == 6) return;
    GRID_BAR();
    moe_stage(args, F, bar, 1, NCTXR);
}

#ifndef DBG_STAGE
#define DBG_STAGE 0
#endif
extern "C" void kernel_launch(void* const* d_in, const int* in_sizes, int n_in, void* d_out, int out_size, void* d_ws, size_t ws_size, hipStream_t stream) {
    static int grid = 0;
    if (grid == 0) {
        if (n_in != 31 || out_size != NLATR * DM || ws_size < WS_END) { fprintf(stderr, "kernel_launch: unexpected shapes (n_in %d out %d ws %zu)\n", n_in, out_size, ws_size); grid = -1; return; }
        int dev = 0, cus = 0;
        if (hipGetDevice(&dev) != hipSuccess || hipDeviceGetAttribute(&cus, hipDeviceAttributeMultiprocessorCount, dev) != hipSuccess) { grid = -1; return; }
        if (hipFuncSetAttribute((const void*)trunk_fwd, hipFuncAttributeMaxDynamicSharedMemorySize, LDS_BYTES) != hipSuccess) { fprintf(stderr, "kernel_launch: hipFuncSetAttribute failed\n"); grid = -1; return; }
        (void)hipGetLastError();
        grid = cus;
    }
    if (grid < 0) return;
    (void)hipMemsetAsync((char*)d_ws + WS_CTL, 0, CTL_BYTES, stream);
    Args a{};
    for (int i = 0; i < 31; ++i) a.in[i] = (const float*)d_in[i];
    a.out = (float*)d_out; a.ws = (unsigned char*)d_ws; a.stage = DBG_STAGE; a.pad = 0;
    hipLaunchKernelGGL(trunk_fwd, dim3(grid), dim3(NWAVES * 64), LDS_BYTES, stream, a);
}
```
